# Optimizing an MI355X kernel written in HIP

```python
import jax, jax.numpy as jnp
from jax import lax
import numpy as np

D_MODEL = 1024
BATCH = 16
SEQ = 2048
DEPTH = 2

CHUNK = 64
N_HEADS = 16
HEAD_DIM = D_MODEL // N_HEADS
Q_BLOCK = 128
N_MIXERS = 2
N_FOX = DEPTH // 2
N_EXPERTS = 32
TOP_K = 4
D_FF = D_MODEL
SWIGLU_LIMIT = 7.0
SWIGLU_ALPHA = 1.702
PLE_DIM = 256
EXPERT_BLOCK = 256
RMS_EPS = 1e-6

kernel_name = "hybrid_stickbreak_fox_moe_ple"


def rmsnorm(x, g):
    xf = x.astype(jnp.float32)
    var = jnp.mean(xf * xf, axis=-1, keepdims=True)
    return (xf * lax.rsqrt(var + RMS_EPS) * g.astype(jnp.float32)).astype(x.dtype)


def split_heads(t):
    b, s, _ = t.shape
    return t.reshape(b, s, N_HEADS, HEAD_DIM).transpose(0, 2, 1, 3)


def merge_heads(t):
    b, h, s, d = t.shape
    return t.transpose(0, 2, 1, 3).reshape(b, s, h * d)


def stick_breaking_attention(q, k, v):
    seq = q.shape[2]
    scale = HEAD_DIM ** -0.5
    outs = []
    for t0 in range(0, seq, Q_BLOCK):
        t1 = t0 + Q_BLOCK
        z = jnp.einsum('bhqd,bhkd->bhqk', q[:, :, t0:t1], k[:, :, :t1],
                       preferred_element_type=jnp.float32) * scale
        strict = jnp.arange(t1)[None, :] < jnp.arange(t0, t1)[:, None]
        log_not = jnp.where(strict, jax.nn.log_sigmoid(-z), 0.0)
        between = lax.cumsum(log_not, axis=3, reverse=True) - log_not
        a = jnp.where(strict, jnp.exp(jax.nn.log_sigmoid(z) + between), 0.0)
        outs.append(jnp.einsum('bhqk,bhkd->bhqd', a.astype(v.dtype), v[:, :, :t1]))
    return jnp.concatenate(outs, axis=2)


def forgetting_attention(q, k, v, log_f):
    seq = q.shape[2]
    scale = HEAD_DIM ** -0.5
    c = jnp.cumsum(log_f, axis=-1)
    outs = []
    for t0 in range(0, seq, Q_BLOCK):
        t1 = t0 + Q_BLOCK
        z = jnp.einsum('bhqd,bhkd->bhqk', q[:, :, t0:t1], k[:, :, :t1],
                       preferred_element_type=jnp.float32) * scale
        z = z + c[:, :, t0:t1, None] - c[:, :, None, :t1]
        causal = jnp.arange(t1)[None, :] <= jnp.arange(t0, t1)[:, None]
        a = jax.nn.softmax(jnp.where(causal, z, -jnp.inf), axis=-1)
        outs.append(jnp.einsum('bhqk,bhkd->bhqd', a.astype(v.dtype), v[:, :, :t1]))
    return jnp.concatenate(outs, axis=2)


def moe_ffn(xn, w_router, b_router, w_gu, b_gu, w_down, b_down):
    b, s, d = xn.shape
    n = b * s
    nk = n * TOP_K
    xt = xn.reshape(n, d)
    logits = jnp.matmul(xt, w_router, preferred_element_type=jnp.float32) + b_router.astype(jnp.float32)
    top_val, top_idx = lax.top_k(logits, TOP_K)
    gate = jax.nn.softmax(top_val, axis=-1).astype(xn.dtype)
    flat_e = top_idx.reshape(-1).astype(jnp.int32)
    flat_g = gate.reshape(-1)
    counts = jnp.bincount(flat_e, length=N_EXPERTS).astype(jnp.int32)
    padded = (counts + EXPERT_BLOCK - 1) // EXPERT_BLOCK * EXPERT_BLOCK
    pad_end = jnp.cumsum(padded)
    pad_start = pad_end - padded
    cnt_start = jnp.cumsum(counts) - counts
    order = jnp.argsort(flat_e).astype(jnp.int32)
    sorted_e = flat_e[order]
    rank = jnp.arange(nk, dtype=jnp.int32) - cnt_start[sorted_e]
    dest = pad_start[sorted_e] + rank
    n_blocks = -(-(nk + N_EXPERTS * (EXPERT_BLOCK - 1)) // EXPERT_BLOCK)
    n_rows = n_blocks * EXPERT_BLOCK
    row_token = jnp.full((n_rows,), n, jnp.int32).at[dest].set(order // TOP_K)
    row_gate = jnp.zeros((n_rows,), xn.dtype).at[dest].set(flat_g[order])
    block_start = jnp.arange(n_blocks, dtype=jnp.int32) * EXPERT_BLOCK
    block_expert = jnp.minimum(jnp.searchsorted(pad_end, block_start, side='right'), N_EXPERTS - 1)
    x_rows = jnp.concatenate([xt, jnp.zeros((1, d), xt.dtype)], axis=0)[row_token]
    x_rows = x_rows.reshape(n_blocks, EXPERT_BLOCK, d)

    def expert_block(args):
        xb, e = args
        hgu = xb @ w_gu[e] + b_gu[e]
        glu = jnp.minimum(hgu[:, :D_FF], SWIGLU_LIMIT)
        lin = jnp.clip(hgu[:, D_FF:], -SWIGLU_LIMIT, SWIGLU_LIMIT)
        act = glu * jax.nn.sigmoid(SWIGLU_ALPHA * glu) * (lin + 1.0)
        return act @ w_down[e] + b_down[e]

    y_rows = lax.map(expert_block, (x_rows, block_expert)).reshape(n_rows, d)
    y = jax.ops.segment_sum(y_rows * row_gate[:, None], row_token, num_segments=n + 1)[:n]
    return y.reshape(b, s, d)


def setup_inputs(seed: int = 0) -> dict:
    key = jax.random.key(seed)
    ks = jax.random.split(key, 20)
    D, E, F, H = D_MODEL, N_EXPERTS, D_FF, N_HEADS
    nrm = lambda k, shape, fan_in: jax.random.normal(k, shape, jnp.float32) * (fan_in ** -0.5)
    gain = lambda k, shape: 1.0 + 0.05 * jax.random.normal(k, shape, jnp.float32)
    return {
        "x": jax.random.normal(ks[0], (BATCH, SEQ, D), jnp.float32),
        "p": jax.random.normal(ks[1], (DEPTH, BATCH, SEQ, PLE_DIM), jnp.float32),
        "g_mix": gain(ks[2], (DEPTH, D)),
        "w_qkv": nrm(ks[3], (DEPTH, D, 3 * D), D),
        "w_fgate": nrm(ks[4], (N_FOX, D, H), D),
        "b_fgate": jax.random.uniform(ks[5], (N_FOX, H), jnp.float32, 1.0, 6.0),
        "w_o": nrm(ks[6], (DEPTH, D, D), D),
        "g_moe": gain(ks[7], (DEPTH, D)),
        "w_router": nrm(ks[8], (DEPTH, D, E), D),
        "b_router": 0.01 * jax.random.normal(ks[9], (DEPTH, E), jnp.float32),
        "w_gu": nrm(ks[10], (DEPTH, E, D, 2 * F), D),
        "b_gu": 0.01 * jax.random.normal(ks[11], (DEPTH, E, 2 * F), jnp.float32),
        "w_down": nrm(ks[12], (DEPTH, E, F, D), F),
        "b_down": 0.01 * jax.random.normal(ks[13], (DEPTH, E, D), jnp.float32),
        "g_ple": gain(ks[14], (DEPTH, D)),
        "w_ple_gate": nrm(ks[15], (DEPTH, D, D), D),
        "w_ple_proj": nrm(ks[16], (DEPTH, PLE_DIM, D), PLE_DIM),
        "g_final": gain(ks[17], (D,)),
    }


def reference(x, p, g_mix, w_qkv, w_fgate, b_fgate, w_o, g_moe, w_router, b_router,
              w_gu, b_gu, w_down, b_down, g_ple, w_ple_gate, w_ple_proj, g_final):
    D = D_MODEL
    h = x
    for i in range(DEPTH):
        hn = rmsnorm(h, g_mix[i])
        if i % N_MIXERS == 0:
            qkv = hn @ w_qkv[i]
            q, k, v = (split_heads(qkv[..., j * D:(j + 1) * D]) for j in range(3))
            o = stick_breaking_attention(q, k, v)
        else:
            j = i // N_MIXERS
            proj = hn @ jnp.concatenate([w_qkv[i], w_fgate[j]], axis=1)
            q, k, v = (split_heads(proj[..., m * D:(m + 1) * D]) for m in range(3))
            f_logit = (proj[..., 3 * D:] + b_fgate[j]).astype(jnp.float32)
            log_f = jax.nn.log_sigmoid(f_logit).transpose(0, 2, 1)
            o = forgetting_attention(q, k, v, log_f)
        h = h + merge_heads(o) @ w_o[i]
        h = h + moe_ffn(rmsnorm(h, g_moe[i]), w_router[i], b_router[i],
                        w_gu[i], b_gu[i], w_down[i], b_down[i])
        ple_gate = jax.nn.sigmoid(rmsnorm(h, g_ple[i]) @ w_ple_gate[i])
        h = h + ple_gate * (p[i] @ w_ple_proj[i])
    return rmsnorm(h, g_final)
```

```cpp
#include <hip/hip_runtime.h>
#include <cstdio>
#include <cstdint>

typedef unsigned short bf16_t;
typedef short bf16x8 __attribute__((ext_vector_type(8)));
typedef float f32x4 __attribute__((ext_vector_type(4)));
typedef float f32x16 __attribute__((ext_vector_type(16)));
typedef unsigned u32x4 __attribute__((ext_vector_type(4)));
typedef unsigned u32x2 __attribute__((ext_vector_type(2)));

constexpr int NTOK = 32768, DM = 1024, SEQ = 2048, NB = 16, NH = 16, HD = 64, NE = 32, TOPK = 4, FF = 1024, PLE = 256, DEPTH = 2;
constexpr int CAP = NTOK;
constexpr int MAXT = 544;
constexpr int NSLOT = MAXT * 256;
constexpr float EPS = 1e-6f;
constexpr float LOG2E = 1.4426950408889634f;
constexpr float C2 = 0.125f * LOG2E;

constexpr size_t MiB = 1u << 20;
constexpr size_t WS_CTL = 0;
constexpr size_t WS_WQKV = 2 * MiB;
constexpr size_t WS_WO = WS_WQKV + 12 * MiB;
constexpr size_t WS_WG = WS_WO + 4 * MiB;
constexpr size_t WS_WP = WS_WG + 4 * MiB;
constexpr size_t WS_WGU = WS_WP + 2 * MiB;
constexpr size_t WS_WD = WS_WGU + 256 * MiB;
constexpr size_t WS_H = WS_WD + 128 * MiB;
constexpr size_t WS_HB = WS_H + 128 * MiB;
constexpr size_t WS_Q = WS_HB + 64 * MiB;
constexpr size_t WS_K = WS_Q + 64 * MiB;
constexpr size_t WS_V = WS_K + 64 * MiB;
constexpr size_t WS_O = WS_V + 64 * MiB;
constexpr size_t WS_PB = WS_O + 64 * MiB;
constexpr size_t WS_PJ = WS_PB + 32 * MiB;
constexpr size_t WS_ACT = WS_PJ + 128 * MiB;
constexpr size_t WS_Y = WS_ACT + 272 * MiB;
constexpr size_t WS_TOK = WS_Y + 272 * MiB;
constexpr size_t WS_GATE = WS_TOK + 4 * MiB;
constexpr size_t WS_PAIR = WS_GATE + 4 * MiB;
constexpr size_t WS_RSTD = WS_PAIR + 1 * MiB;
constexpr size_t WS_FL = WS_RSTD + 1 * MiB;
constexpr size_t WS_CB = WS_FL + 2 * MiB;
constexpr size_t WS_END = WS_CB + 2 * MiB;
constexpr int CW_CNT = 64;

__device__ __forceinline__ float bf2f(bf16_t v) { return __uint_as_float((unsigned)v << 16); }
__device__ __forceinline__ unsigned f2bf(float f) { unsigned u = __float_as_uint(f); return (u + 0x7fffu + ((u >> 16) & 1u)) >> 16; }
__device__ __forceinline__ unsigned pk2(float lo, float hi) { return f2bf(lo) | (f2bf(hi) << 16); }
__device__ __forceinline__ float wave_sum(float v) {
#pragma unroll
    for (int o = 1; o < 64; o <<= 1) v += __shfl_xor(v, o);
    return v;
}
__device__ __forceinline__ float wave_max(float v) {
#pragma unroll
    for (int o = 1; o < 64; o <<= 1) v = fmaxf(v, __shfl_xor(v, o));
    return v;
}
__device__ __forceinline__ int crow(int r, int hi) { return (r & 3) + 8 * (r >> 2) + 4 * hi; }
__device__ __forceinline__ float sigmoidf_(float x) { return 1.f / (1.f + __expf(-x)); }
__device__ __forceinline__ float log_sigmoid(float x) { return fminf(x, 0.f) - log1pf(__expf(-fabsf(x))); }

struct MoeTile { int e, rank0, cnt, tstart; bool ok; };
__device__ __forceinline__ MoeTile moe_tile(const unsigned* cnt, int T) {
    const int lane = threadIdx.x & 63;
    const int c = (lane < NE) ? (int)cnt[lane] : 0;
    const int nt = (c + 255) >> 8;
    int incl = nt;
#pragma unroll
    for (int o = 1; o < 32; o <<= 1) { int t = __shfl_up(incl, o); if ((lane & 31) >= o) incl += t; }
    const int excl = incl - nt;
    const unsigned long long m = __ballot(lane < NE && excl <= T && nt > 0 && T < incl);
    MoeTile r; r.ok = (m != 0ull);
    const int e = r.ok ? (int)__builtin_ctzll(m) : 0;
    r.e = e; r.tstart = __shfl(excl, e); r.cnt = __shfl(c, e); r.rank0 = (T - r.tstart) * 256;
    return r;
}
__device__ __forceinline__ int moe_tstart(const unsigned* cnt, int e) {
    const int lane = threadIdx.x & 63;
    const int c = (lane < NE) ? (int)cnt[lane] : 0;
    const int nt = (c + 255) >> 8;
    int incl = nt;
#pragma unroll
    for (int o = 1; o < 32; o <<= 1) { int t = __shfl_up(incl, o); if ((lane & 31) >= o) incl += t; }
    return __shfl(incl - nt, e);
}

__global__ void __launch_bounds__(256) k_rowstat(const float* __restrict__ h, bf16_t* __restrict__ hb, float* __restrict__ rstd) {
    const int lane = threadIdx.x & 63, row = blockIdx.x * 4 + (threadIdx.x >> 6);
    const f32x4* p = (const f32x4*)(h + (size_t)row * DM) + lane;
    f32x4 v[4]; float s = 0.f;
#pragma unroll
    for (int j = 0; j < 4; ++j) { v[j] = p[64 * j]; s += v[j].x * v[j].x + v[j].y * v[j].y + v[j].z * v[j].z + v[j].w * v[j].w; }
    s = wave_sum(s);
    if (lane == 0) rstd[row] = rsqrtf(s * (1.f / DM) + EPS);
    u32x2* o = (u32x2*)(hb + (size_t)row * DM) + lane;
#pragma unroll
    for (int j = 0; j < 4; ++j) { u32x2 w; w.x = pk2(v[j].x, v[j].y); w.y = pk2(v[j].z, v[j].w); o[64 * j] = w; }
}
__global__ void __launch_bounds__(256) k_cvt(const float* __restrict__ s, bf16_t* __restrict__ d, size_t n4) {
    size_t i = (size_t)blockIdx.x * 256 + threadIdx.x;
    if (i < n4) { f32x4 v = ((const f32x4*)s)[i]; u32x2 w; w.x = pk2(v.x, v.y); w.y = pk2(v.z, v.w); ((u32x2*)d)[i] = w; }
}
template <int MODE>
__global__ void __launch_bounds__(256) k_cvt_t(const float* __restrict__ src, const float* __restrict__ g, bf16_t* __restrict__ dst, int K, int N) {
    __shared__ float tile[64][65];
    const int n0 = blockIdx.x * 64, k0 = blockIdx.y * 64, b = blockIdx.z, tid = threadIdx.x;
    const float* s = src + (size_t)b * K * N; bf16_t* d = dst + (size_t)b * K * N;
#pragma unroll
    for (int i = 0; i < 16; ++i) { const int kk = i * 4 + (tid >> 6), nn = tid & 63; const float gg = g ? g[k0 + kk] : 1.f; tile[kk][nn] = s[(size_t)(k0 + kk) * N + n0 + nn] * gg; }
    __syncthreads();
#pragma unroll
    for (int j = 0; j < 2; ++j) {
        const int c = tid + 256 * j, n = c >> 3, kc = c & 7;
        u32x4 w; w.x = pk2(tile[kc * 8 + 0][n], tile[kc * 8 + 1][n]); w.y = pk2(tile[kc * 8 + 2][n], tile[kc * 8 + 3][n]);
        w.z = pk2(tile[kc * 8 + 4][n], tile[kc * 8 + 5][n]); w.w = pk2(tile[kc * 8 + 6][n], tile[kc * 8 + 7][n]);
        int nn = n0 + n;
        if (MODE == 1) { const int half = nn / FF, j2 = nn % FF; nn = (j2 >> 7) * 256 + half * 128 + (j2 & 127); }
        *(u32x4*)(d + (size_t)nn * K + k0 + kc * 8) = w;
    }
}

template <bool DUAL>
__device__ __forceinline__ void gemm_tile64(const bf16_t* a0, const bf16_t* a1, const bf16_t* B1, const bf16_t* B2, int K, f32x16 (&acc)[2][2], f32x16 (&acc2)[2][2]) {
    const int lane = threadIdx.x & 63, r32 = lane & 31, hi = lane >> 5;
    const bf16_t* b0 = B1 + (size_t)r32 * K + 8 * hi; const bf16_t* b1 = B1 + (size_t)(32 + r32) * K + 8 * hi;
    const bf16_t* c0 = DUAL ? B2 + (size_t)r32 * K + 8 * hi : nullptr; const bf16_t* c1 = DUAL ? B2 + (size_t)(32 + r32) * K + 8 * hi : nullptr;
    a0 += 8 * hi; a1 += 8 * hi;
#pragma unroll
    for (int i = 0; i < 2; ++i)
#pragma unroll
        for (int j = 0; j < 2; ++j) { acc[i][j] = f32x16{}; acc2[i][j] = f32x16{}; }
    for (int k = 0; k < K; k += 16) {
        const bf16x8 fa0 = *(const bf16x8*)(a0 + k), fa1 = *(const bf16x8*)(a1 + k), fb0 = *(const bf16x8*)(b0 + k), fb1 = *(const bf16x8*)(b1 + k);
        acc[0][0] = __builtin_amdgcn_mfma_f32_32x32x16_bf16(fa0, fb0, acc[0][0], 0, 0, 0);
        acc[0][1] = __builtin_amdgcn_mfma_f32_32x32x16_bf16(fa0, fb1, acc[0][1], 0, 0, 0);
        acc[1][0] = __builtin_amdgcn_mfma_f32_32x32x16_bf16(fa1, fb0, acc[1][0], 0, 0, 0);
        acc[1][1] = __builtin_amdgcn_mfma_f32_32x32x16_bf16(fa1, fb1, acc[1][1], 0, 0, 0);
        if (DUAL) {
            const bf16x8 fc0 = *(const bf16x8*)(c0 + k), fc1 = *(const bf16x8*)(c1 + k);
            acc2[0][0] = __builtin_amdgcn_mfma_f32_32x32x16_bf16(fa0, fc0, acc2[0][0], 0, 0, 0);
            acc2[0][1] = __builtin_amdgcn_mfma_f32_32x32x16_bf16(fa0, fc1, acc2[0][1], 0, 0, 0);
            acc2[1][0] = __builtin_amdgcn_mfma_f32_32x32x16_bf16(fa1, fc0, acc2[1][0], 0, 0, 0);
            acc2[1][1] = __builtin_amdgcn_mfma_f32_32x32x16_bf16(fa1, fc1, acc2[1][1], 0, 0, 0);
        }
    }
}
#define TILE_FOREACH(...) _Pragma("unroll") for (int mi = 0; mi < 2; ++mi) _Pragma("unroll") for (int ni = 0; ni < 2; ++ni) _Pragma("unroll") for (int r = 0; r < 16; ++r) { \
        const int lrow = 32 * mi + crow(r, hi), lcol = 32 * ni + r32; const float v = acc[mi][ni][r]; const float v2 = acc2[mi][ni][r]; (void)v2; __VA_ARGS__ }

__global__ void __launch_bounds__(64) k_gemm_qkv(const bf16_t* __restrict__ A, const bf16_t* __restrict__ Bt, const float* __restrict__ rstd, bf16_t* __restrict__ Q) {
    const int lane = threadIdx.x, r32 = lane & 31, hi = lane >> 5; const int m0 = blockIdx.y * 64, n0 = blockIdx.x * 64;
    f32x16 acc[2][2], acc2[2][2];
    gemm_tile64<false>(A + (size_t)(m0 + r32) * DM, A + (size_t)(m0 + 32 + r32) * DM, Bt + (size_t)n0 * DM, nullptr, DM, acc, acc2);
    const int t = n0 / DM; bf16_t* out = Q + (size_t)t * ((WS_K - WS_Q) / 2); const float sc = (t == 0) ? C2 : 1.f;
    TILE_FOREACH({ const int row = m0 + lrow, col = n0 - t * DM + lcol; out[(size_t)row * DM + col] = (bf16_t)f2bf(v * rstd[row] * sc); })
}
__global__ void __launch_bounds__(64) k_gemm_wo(const bf16_t* __restrict__ A, const bf16_t* __restrict__ Bt, const float* hin, float* hout, bf16_t* __restrict__ hb) {
    const int lane = threadIdx.x, r32 = lane & 31, hi = lane >> 5; const int m0 = blockIdx.y * 64, n0 = blockIdx.x * 64;
    f32x16 acc[2][2], acc2[2][2];
    gemm_tile64<false>(A + (size_t)(m0 + r32) * DM, A + (size_t)(m0 + 32 + r32) * DM, Bt + (size_t)n0 * DM, nullptr, DM, acc, acc2);
    TILE_FOREACH({ const size_t o = (size_t)(m0 + lrow) * DM + n0 + lcol; const float x = hin[o] + v; hout[o] = x; hb[o] = (bf16_t)f2bf(x); })
}
__global__ void __launch_bounds__(64) k_gemm_pj(const bf16_t* __restrict__ A, const bf16_t* __restrict__ Bt, bf16_t* __restrict__ PJ) {
    const int lane = threadIdx.x, r32 = lane & 31, hi = lane >> 5; const int m0 = blockIdx.y * 64, n0 = blockIdx.x * 64;
    f32x16 acc[2][2], acc2[2][2];
    gemm_tile64<false>(A + (size_t)(m0 + r32) * PLE, A + (size_t)(m0 + 32 + r32) * PLE, Bt + (size_t)n0 * PLE, nullptr, PLE, acc, acc2);
    TILE_FOREACH({ PJ[(size_t)(m0 + lrow) * DM + n0 + lcol] = (bf16_t)f2bf(v); })
}
__global__ void __launch_bounds__(64) k_gemm_ple(const bf16_t* __restrict__ A, const bf16_t* __restrict__ Bt, const float* __restrict__ rstd, const bf16_t* __restrict__ PJ, float* h, bf16_t* hb) {
    const int lane = threadIdx.x, r32 = lane & 31, hi = lane >> 5; const int m0 = blockIdx.y * 64, n0 = blockIdx.x * 64;
    f32x16 acc[2][2], acc2[2][2];
    gemm_tile64<false>(A + (size_t)(m0 + r32) * DM, A + (size_t)(m0 + 32 + r32) * DM, Bt + (size_t)n0 * DM, nullptr, DM, acc, acc2);
    TILE_FOREACH({ const int row = m0 + lrow; const size_t o = (size_t)row * DM + n0 + lcol; const float x = h[o] + sigmoidf_(v * rstd[row]) * bf2f(PJ[o]); h[o] = x; })
}
__global__ void __launch_bounds__(64) k_gemm_gu(const bf16_t* __restrict__ HB, const bf16_t* __restrict__ Wgu, const float* __restrict__ bgu, const float* __restrict__ rstd,
                                                const unsigned* __restrict__ cnt, const int* __restrict__ tok_of, bf16_t* __restrict__ ACT) {
    const int lane = threadIdx.x, r32 = lane & 31, hi = lane >> 5; const int rt = blockIdx.y, T = rt >> 2, j0 = blockIdx.x * 64;
    const MoeTile mt = moe_tile(cnt, T); if (!mt.ok) return;
    const int lr0 = (rt & 3) * 64; const int rk0 = mt.rank0 + lr0 + r32, rk1 = rk0 + 32;
    const int t0 = rk0 < mt.cnt ? tok_of[(size_t)mt.e * CAP + rk0] : 0, t1 = rk1 < mt.cnt ? tok_of[(size_t)mt.e * CAP + rk1] : 0;
    const bf16_t* Be = Wgu + (size_t)mt.e * 2048 * DM + (size_t)((j0 >> 7) * 256 + (j0 & 127)) * DM;
    f32x16 acc[2][2], acc2[2][2];
    gemm_tile64<true>(HB + (size_t)t0 * DM, HB + (size_t)t1 * DM, Be, Be + (size_t)128 * DM, DM, acc, acc2);
    const size_t slot0 = (size_t)T * 256 + lr0;
    TILE_FOREACH({ const int rk = mt.rank0 + lr0 + lrow; if (rk < mt.cnt) { const int tk = tok_of[(size_t)mt.e * CAP + rk]; const float rs = rstd[tk]; const int j = j0 + lcol;
        float gl = v * rs + bgu[(size_t)mt.e * 2048 + j], ln = v2 * rs + bgu[(size_t)mt.e * 2048 + FF + j];
        gl = fminf(gl, 7.f); ln = fminf(fmaxf(ln, -7.f), 7.f);
        const float a = gl * sigmoidf_(1.702f * gl) * (ln + 1.f);
        ACT[(slot0 + lrow) * FF + j] = (bf16_t)f2bf(a); } })
}
__global__ void __launch_bounds__(64) k_gemm_down(const bf16_t* __restrict__ ACT, const bf16_t* __restrict__ Wd, const float* __restrict__ bd, const unsigned* __restrict__ cnt,
                                                  const float* __restrict__ gate_of, bf16_t* __restrict__ Y) {
    const int lane = threadIdx.x, r32 = lane & 31, hi = lane >> 5; const int rt = blockIdx.y, T = rt >> 2, n0 = blockIdx.x * 64;
    const MoeTile mt = moe_tile(cnt, T); if (!mt.ok) return;
    const int lr0 = (rt & 3) * 64; const size_t slot0 = (size_t)T * 256 + lr0;
    const int rk0 = mt.rank0 + lr0 + r32, rk1 = rk0 + 32;
    const size_t s0 = rk0 < mt.cnt ? slot0 + r32 : (size_t)T * 256, s1 = rk1 < mt.cnt ? slot0 + 32 + r32 : (size_t)T * 256;
    f32x16 acc[2][2], acc2[2][2];
    gemm_tile64<false>(ACT + s0 * FF, ACT + s1 * FF, Wd + (size_t)mt.e * DM * FF + (size_t)n0 * FF, nullptr, FF, acc, acc2);
    TILE_FOREACH({ const int rk = mt.rank0 + lr0 + lrow; if (rk < mt.cnt) { const float gt = gate_of[(size_t)mt.e * CAP + rk]; const int n = n0 + lcol;
        Y[(slot0 + lrow) * DM + n] = (bf16_t)f2bf((v + bd[(size_t)mt.e * DM + n]) * gt); } })
}

__global__ void __launch_bounds__(256) k_router(const float* __restrict__ h, const float* __restrict__ g, const float* __restrict__ wr, const float* __restrict__ br,
                                                float* __restrict__ rstd, unsigned* cnt, int* __restrict__ tok_of, float* __restrict__ gate_of, unsigned* __restrict__ pair) {
    const int lane = threadIdx.x & 63, t = blockIdx.x * 4 + (threadIdx.x >> 6); const int e = lane & 31, half = lane >> 5;
    const float* hr = h + (size_t)t * DM;
    float ss = 0.f;
#pragma unroll
    for (int j = 0; j < 4; ++j) { const f32x4 v = ((const f32x4*)hr)[lane + 64 * j]; ss += v.x * v.x + v.y * v.y + v.z * v.z + v.w * v.w; }
    const float rs = rsqrtf(wave_sum(ss) * (1.f / DM) + EPS);
    float a = 0.f;
    for (int d = half * 512; d < half * 512 + 512; ++d) a += hr[d] * g[d] * wr[(size_t)d * NE + e];
    a += __shfl_xor(a, 32);
    float lg = a * rs + br[e];
    float tv[4]; int ti[4];
#pragma unroll
    for (int k = 0; k < 4; ++k) {
        float bv = lg; int bi = e;
#pragma unroll
        for (int o = 1; o < 32; o <<= 1) { const float ov = __shfl_xor(bv, o); const int oi = __shfl_xor(bi, o); if (ov > bv || (ov == bv && oi < bi)) { bv = ov; bi = oi; } }
        tv[k] = bv; ti[k] = bi; if (e == bi) lg = -INFINITY;
    }
    float w[4], sw = 0.f;
#pragma unroll
    for (int k = 0; k < 4; ++k) { w[k] = __expf(tv[k] - tv[0]); sw += w[k]; }
    if (lane == 0) rstd[t] = rs;
    if (lane < 4) {
        const int k = lane; const int ee = (k == 0) ? ti[0] : (k == 1) ? ti[1] : (k == 2) ? ti[2] : ti[3]; const float ww = (k == 0) ? w[0] : (k == 1) ? w[1] : (k == 2) ? w[2] : w[3];
        const unsigned rk = atomicAdd(&cnt[ee], 1u);
        tok_of[(size_t)ee * CAP + rk] = t; gate_of[(size_t)ee * CAP + rk] = ww / sw; pair[(size_t)t * 4 + k] = ((unsigned)ee << 16) | rk;
    }
}
__global__ void __launch_bounds__(256) k_combine(float* h, bf16_t* __restrict__ hb, float* __restrict__ rstd, const unsigned* __restrict__ cnt, const unsigned* __restrict__ pair, const bf16_t* __restrict__ Y) {
    const int lane = threadIdx.x & 63, t = blockIdx.x * 4 + (threadIdx.x >> 6);
    f32x4 v[4]; f32x4* hr = (f32x4*)(h + (size_t)t * DM) + lane;
#pragma unroll
    for (int j = 0; j < 4; ++j) v[j] = hr[64 * j];
    for (int k = 0; k < 4; ++k) {
        const unsigned pr = pair[(size_t)t * 4 + k]; const int e = pr >> 16, rk = pr & 0xffff;
        const size_t slot = (size_t)moe_tstart(cnt, e) * 256 + rk;
        const u32x2* yr = (const u32x2*)(Y + slot * DM) + lane;
#pragma unroll
        for (int j = 0; j < 4; ++j) { const u32x2 w = yr[64 * j]; v[j].x += __uint_as_float(w.x << 16); v[j].y += __uint_as_float(w.x & 0xffff0000u); v[j].z += __uint_as_float(w.y << 16); v[j].w += __uint_as_float(w.y & 0xffff0000u); }
    }
    float s = 0.f;
#pragma unroll
    for (int j = 0; j < 4; ++j) { hr[64 * j] = v[j]; s += v[j].x * v[j].x + v[j].y * v[j].y + v[j].z * v[j].z + v[j].w * v[j].w; }
    s = wave_sum(s); if (lane == 0) rstd[t] = rsqrtf(s * (1.f / DM) + EPS);
    u32x2* o = (u32x2*)(hb + (size_t)t * DM) + lane;
#pragma unroll
    for (int j = 0; j < 4; ++j) { u32x2 w; w.x = pk2(v[j].x, v[j].y); w.y = pk2(v[j].z, v[j].w); o[64 * j] = w; }
}
__global__ void __launch_bounds__(256) k_final(const float* __restrict__ h, const float* __restrict__ g, float* __restrict__ out) {
    const int lane = threadIdx.x & 63, row = blockIdx.x * 4 + (threadIdx.x >> 6);
    const f32x4* p = (const f32x4*)(h + (size_t)row * DM) + lane; f32x4 v[4]; float s = 0.f;
#pragma unroll
    for (int j = 0; j < 4; ++j) { v[j] = p[64 * j]; s += v[j].x * v[j].x + v[j].y * v[j].y + v[j].z * v[j].z + v[j].w * v[j].w; }
    const float rs = rsqrtf(wave_sum(s) * (1.f / DM) + EPS);
    f32x4* o = (f32x4*)(out + (size_t)row * DM) + lane;
#pragma unroll
    for (int j = 0; j < 4; ++j) { const f32x4 gg = ((const f32x4*)g)[lane + 64 * j]; o[64 * j] = v[j] * rs * gg; }
}
__global__ void __launch_bounds__(256) k_fgate(const float* __restrict__ h, const float* __restrict__ g, const float* __restrict__ wf, const float* __restrict__ bfg, const float* __restrict__ rstd, float* __restrict__ fl) {
    const int lane = threadIdx.x & 63, t = blockIdx.x * 4 + (threadIdx.x >> 6); const int hh = lane & 15, q = lane >> 4;
    const float* hr = h + (size_t)t * DM; float a = 0.f;
    for (int d = q * 256; d < q * 256 + 256; ++d) a += hr[d] * g[d] * wf[(size_t)d * NH + hh];
    a += __shfl_xor(a, 16); a += __shfl_xor(a, 32);
    if (lane < 16) fl[(size_t)t * NH + hh] = a * rstd[t] + bfg[hh];
}
__global__ void __launch_bounds__(64) k_scan(const float* __restrict__ fl, float* __restrict__ cb) {
    const int lane = threadIdx.x, bh = blockIdx.x, b = bh / NH, hh = bh % NH;
    float loc[32]; float run = 0.f;
#pragma unroll
    for (int i = 0; i < 32; ++i) { run += log_sigmoid(fl[(size_t)(b * SEQ + lane * 32 + i) * NH + hh]); loc[i] = run; }
    float incl = run;
#pragma unroll
    for (int o = 1; o < 64; o <<= 1) { const float t = __shfl_up(incl, o); if (lane >= o) incl += t; }
    const float base = incl - run;
#pragma unroll
    for (int i = 0; i < 32; ++i) cb[(size_t)bh * SEQ + lane * 32 + i] = (base + loc[i]) * LOG2E;
}

__device__ __forceinline__ float dot64(const float (&q)[64], const bf16_t* kr) {
    float a = 0.f;
#pragma unroll
    for (int c = 0; c < 8; ++c) { const u32x4 w = ((const u32x4*)kr)[c];
        a += q[8 * c + 0] * __uint_as_float(w.x << 16) + q[8 * c + 1] * __uint_as_float(w.x & 0xffff0000u) + q[8 * c + 2] * __uint_as_float(w.y << 16) + q[8 * c + 3] * __uint_as_float(w.y & 0xffff0000u)
           + q[8 * c + 4] * __uint_as_float(w.z << 16) + q[8 * c + 5] * __uint_as_float(w.z & 0xffff0000u) + q[8 * c + 6] * __uint_as_float(w.w << 16) + q[8 * c + 7] * __uint_as_float(w.w & 0xffff0000u); }
    return a;
}
__device__ __forceinline__ void loadq(float (&q)[64], const bf16_t* qr) {
#pragma unroll
    for (int c = 0; c < 8; ++c) { const u32x4 w = ((const u32x4*)qr)[c];
        q[8 * c + 0] = __uint_as_float(w.x << 16); q[8 * c + 1] = __uint_as_float(w.x & 0xffff0000u); q[8 * c + 2] = __uint_as_float(w.y << 16); q[8 * c + 3] = __uint_as_float(w.y & 0xffff0000u);
        q[8 * c + 4] = __uint_as_float(w.z << 16); q[8 * c + 5] = __uint_as_float(w.z & 0xffff0000u); q[8 * c + 6] = __uint_as_float(w.w << 16); q[8 * c + 7] = __uint_as_float(w.w & 0xffff0000u); }
}
__global__ void __launch_bounds__(256) k_attn_sb(const bf16_t* __restrict__ Q, const bf16_t* __restrict__ K, const bf16_t* __restrict__ V, bf16_t* __restrict__ O) {
    const int lane = threadIdx.x & 63; const int gw = blockIdx.x * 4 + (threadIdx.x >> 6); const int t = gw % SEQ, bh = gw / SEQ, b = bh / NH, hh = bh % NH;
    const size_t rowb = (size_t)b * SEQ; float q[64]; loadq(q, Q + (rowb + t) * DM + hh * HD);
    float o = 0.f, carry = 1.f;
    for (int jt = (t - 1) >> 6; jt >= 0 && t > 0; --jt) {
        const int s = 64 * jt + lane; const bool valid = s < t;
        float x = dot64(q, K + (rowb + s) * DM + hh * HD); x = fminf(x, 64.f);
        const float ex = exp2f(x), r = 1.f / (1.f + ex);
        const float beta = valid ? ex * r : 0.f, nb = valid ? r : 1.f;
        float P = nb;
#pragma unroll
        for (int off = 1; off < 64; off <<= 1) { const float t2 = __shfl_down(P, off); if (lane + off < 64) P *= t2; }
        float Pex = __shfl_down(P, 1); if (lane == 63) Pex = 1.f;
        const float a = beta * carry * Pex;
        carry *= __shfl(P, 0);
        const bf16_t* vb = V + (rowb + 64 * jt) * DM + hh * HD + lane;
        for (int l = 0; l < 64; ++l) { const float al = __shfl(a, l); o += al * bf2f(vb[(size_t)l * DM]); }
        if (carry < 1e-30f) break;
    }
    O[(rowb + t) * DM + hh * HD + lane] = (bf16_t)f2bf(o);
}
__global__ void __launch_bounds__(256) k_attn_fox(const bf16_t* __restrict__ Q, const bf16_t* __restrict__ K, const bf16_t* __restrict__ V, const float* __restrict__ cb, bf16_t* __restrict__ O) {
    const int lane = threadIdx.x & 63; const int gw = blockIdx.x * 4 + (threadIdx.x >> 6); const int t = gw % SEQ, bh = gw / SEQ, b = bh / NH, hh = bh % NH;
    const size_t rowb = (size_t)b * SEQ; float q[64]; loadq(q, Q + (rowb + t) * DM + hh * HD);
    float o = 0.f, m = -INFINITY, l = 0.f;
    for (int jt = 0; jt <= (t >> 6); ++jt) {
        const int s = 64 * jt + lane; const bool valid = s <= t;
        float x = dot64(q, K + (rowb + s) * DM + hh * HD) - cb[(size_t)bh * SEQ + s];
        x = valid ? x : -INFINITY;
        const float mn = fmaxf(m, wave_max(x)); const float alpha = exp2f(m - mn); const float p = exp2f(x - mn);
        l = l * alpha + wave_sum(p); o *= alpha; m = mn;
        const bf16_t* vb = V + (rowb + 64 * jt) * DM + hh * HD + lane;
        const int nl = min(64, t - 64 * jt + 1);
        for (int i = 0; i < nl; ++i) { const float pi = __shfl(p, i); o += pi * bf2f(vb[(size_t)i * DM]); }
    }
    O[(rowb + t) * DM + hh * HD + lane] = (bf16_t)f2bf(o / l);
}

extern "C" void kernel_launch(void* const* d_in, const int* in_sizes, int n_in, void* d_out, int out_size, void* d_ws, size_t ws_size, hipStream_t stream) {
    if (n_in != 18 || in_sizes[0] != NTOK * DM || out_size != NTOK * DM || ws_size < WS_END) { fprintf(stderr, "kernel_launch: unexpected shapes / workspace (%d inputs, ws %zu, need %zu)\n", n_in, ws_size, (size_t)WS_END); return; }
    const float* x = (const float*)d_in[0]; const float* p = (const float*)d_in[1]; const float* g_mix = (const float*)d_in[2]; const float* w_qkv = (const float*)d_in[3];
    const float* w_fgate = (const float*)d_in[4]; const float* b_fgate = (const float*)d_in[5]; const float* w_o = (const float*)d_in[6]; const float* g_moe = (const float*)d_in[7];
    const float* w_router = (const float*)d_in[8]; const float* b_router = (const float*)d_in[9]; const float* w_gu = (const float*)d_in[10]; const float* b_gu = (const float*)d_in[11];
    const float* w_down = (const float*)d_in[12]; const float* b_down = (const float*)d_in[13]; const float* g_ple = (const float*)d_in[14]; const float* w_ple_gate = (const float*)d_in[15];
    const float* w_ple_proj = (const float*)d_in[16]; const float* g_final = (const float*)d_in[17];
    unsigned char* ws = (unsigned char*)d_ws;
    unsigned* ctl = (unsigned*)(ws + WS_CTL);
    bf16_t *Wqkv = (bf16_t*)(ws + WS_WQKV), *Wo = (bf16_t*)(ws + WS_WO), *Wg = (bf16_t*)(ws + WS_WG), *Wp = (bf16_t*)(ws + WS_WP), *Wgu = (bf16_t*)(ws + WS_WGU), *Wd = (bf16_t*)(ws + WS_WD);
    float* H = (float*)(ws + WS_H); bf16_t *HB = (bf16_t*)(ws + WS_HB), *Q = (bf16_t*)(ws + WS_Q), *Kb = (bf16_t*)(ws + WS_K), *Vb = (bf16_t*)(ws + WS_V), *O = (bf16_t*)(ws + WS_O);
    bf16_t *PB = (bf16_t*)(ws + WS_PB), *PJ = (bf16_t*)(ws + WS_PJ), *ACT = (bf16_t*)(ws + WS_ACT), *Y = (bf16_t*)(ws + WS_Y);
    int* tok_of = (int*)(ws + WS_TOK); float* gate_of = (float*)(ws + WS_GATE); unsigned* pair = (unsigned*)(ws + WS_PAIR);
    float* rstd_mix = (float*)(ws + WS_RSTD); float* rstd_moe = rstd_mix + NTOK; float* rstd_ple = rstd_moe + NTOK;
    float* FL = (float*)(ws + WS_FL); float* CB = (float*)(ws + WS_CB);
    hipMemsetAsync(ws + WS_CTL, 0, 1 * MiB, stream);
    for (int i = 0; i < DEPTH; ++i) {
        k_cvt_t<0><<<dim3(3 * DM / 64, DM / 64, 1), 256, 0, stream>>>(w_qkv + (size_t)i * DM * 3 * DM, g_mix + i * DM, Wqkv + (size_t)i * 3 * DM * DM, DM, 3 * DM);
        k_cvt_t<0><<<dim3(DM / 64, DM / 64, 1), 256, 0, stream>>>(w_o + (size_t)i * DM * DM, nullptr, Wo + (size_t)i * DM * DM, DM, DM);
        k_cvt_t<0><<<dim3(DM / 64, DM / 64, 1), 256, 0, stream>>>(w_ple_gate + (size_t)i * DM * DM, g_ple + i * DM, Wg + (size_t)i * DM * DM, DM, DM);
        k_cvt_t<0><<<dim3(DM / 64, PLE / 64, 1), 256, 0, stream>>>(w_ple_proj + (size_t)i * PLE * DM, nullptr, Wp + (size_t)i * DM * PLE, PLE, DM);
        k_cvt_t<1><<<dim3(2 * FF / 64, DM / 64, NE), 256, 0, stream>>>(w_gu + (size_t)i * NE * DM * 2 * FF, g_moe + i * DM, Wgu + (size_t)i * NE * 2 * FF * DM, DM, 2 * FF);
        k_cvt_t<0><<<dim3(DM / 64, FF / 64, NE), 256, 0, stream>>>(w_down + (size_t)i * NE * FF * DM, nullptr, Wd + (size_t)i * NE * DM * FF, FF, DM);
    }
    k_cvt<<<(unsigned)((size_t)DEPTH * NTOK * PLE / 4 / 256), 256, 0, stream>>>(p, PB, (size_t)DEPTH * NTOK * PLE / 4);
    for (int i = 0; i < DEPTH; ++i)
        k_gemm_pj<<<dim3(DM / 64, NTOK / 64), 64, 0, stream>>>(PB + (size_t)i * NTOK * PLE, Wp + (size_t)i * DM * PLE, PJ + (size_t)i * NTOK * DM);
    k_rowstat<<<NTOK / 4, 256, 0, stream>>>(x, HB, rstd_mix);
    for (int i = 0; i < DEPTH; ++i) {
        const float* hin = (i == 0) ? x : H;
        k_gemm_qkv<<<dim3(3 * DM / 64, NTOK / 64), 64, 0, stream>>>(HB, Wqkv + (size_t)i * 3 * DM * DM, rstd_mix, Q);
        if (i == 0) k_attn_sb<<<NB * NH * SEQ / 4, 256, 0, stream>>>(Q, Kb, Vb, O);
        else {
            k_fgate<<<NTOK / 4, 256, 0, stream>>>(hin, g_mix + i * DM, w_fgate, b_fgate, rstd_mix, FL);
            k_scan<<<NB * NH, 64, 0, stream>>>(FL, CB);
            k_attn_fox<<<NB * NH * SEQ / 4, 256, 0, stream>>>(Q, Kb, Vb, CB, O);
        }
        k_gemm_wo<<<dim3(DM / 64, NTOK / 64), 64, 0, stream>>>(O, Wo + (size_t)i * DM * DM, hin, H, HB);
        unsigned* cnt = ctl + CW_CNT + 64 * i;
        k_router<<<NTOK / 4, 256, 0, stream>>>(H, g_moe + i * DM, w_router + (size_t)i * DM * NE, b_router + i * NE, rstd_moe, cnt, tok_of, gate_of, pair);
        k_gemm_gu<<<dim3(FF / 64, MAXT * 4), 64, 0, stream>>>(HB, Wgu + (size_t)i * NE * 2 * FF * DM, b_gu + (size_t)i * NE * 2 * FF, rstd_moe, cnt, tok_of, ACT);
        k_gemm_down<<<dim3(DM / 64, MAXT * 4), 64, 0, stream>>>(ACT, Wd + (size_t)i * NE * DM * FF, b_down + (size_t)i * NE * DM, cnt, gate_of, Y);
        k_combine<<<NTOK / 4, 256, 0, stream>>>(H, HB, rstd_ple, cnt, pair, Y);
        k_gemm_ple<<<dim3(DM / 64, NTOK / 64), 64, 0, stream>>>(HB, Wg + (size_t)i * DM * DM, rstd_ple, PJ + (size_t)i * NTOK * DM, H, HB);
        if (i + 1 < DEPTH) k_rowstat<<<NTOK / 4, 256, 0, stream>>>(H, HB, rstd_mix);
    }
    k_final<<<NTOK / 4, 256, 0, stream>>>(H, g_final, (float*)d_out);
}
```

```cpp
#include <hip/hip_runtime.h>
#include <cstdio>
#include <cstdint>

typedef unsigned short bf16_t;
typedef short bf16x8 __attribute__((ext_vector_type(8)));
typedef float f32x4 __attribute__((ext_vector_type(4)));
typedef float f32x16 __attribute__((ext_vector_type(16)));
typedef unsigned u32x4 __attribute__((ext_vector_type(4)));
typedef unsigned u32x2 __attribute__((ext_vector_type(2)));

constexpr int NTOK = 32768, DM = 1024, SEQ = 2048, NB = 16, NH = 16, HD = 64, NE = 32, TOPK = 4, FF = 1024, PLE = 256, DEPTH = 2;
constexpr int CAP = NTOK;
constexpr int MAXT = 544;
constexpr int NSLOT = MAXT * 256;
constexpr float EPS = 1e-6f;
constexpr float LOG2E = 1.4426950408889634f;
constexpr float C2 = 0.125f * LOG2E;

constexpr size_t MiB = 1u << 20;
constexpr size_t WS_CTL = 0;
constexpr size_t WS_WQKV = 2 * MiB;
constexpr size_t WS_WO = WS_WQKV + 12 * MiB;
constexpr size_t WS_WG = WS_WO + 4 * MiB;
constexpr size_t WS_WP = WS_WG + 4 * MiB;
constexpr size_t WS_WGU = WS_WP + 2 * MiB;
constexpr size_t WS_WD = WS_WGU + 256 * MiB;
constexpr size_t WS_H = WS_WD + 128 * MiB;
constexpr size_t WS_HB = WS_H + 128 * MiB;
constexpr size_t WS_Q = WS_HB + 64 * MiB;
constexpr size_t WS_K = WS_Q + 64 * MiB;
constexpr size_t WS_V = WS_K + 64 * MiB;
constexpr size_t WS_O = WS_V + 64 * MiB;
constexpr size_t WS_PB = WS_O + 64 * MiB;
constexpr size_t WS_PJ = WS_PB + 32 * MiB;
constexpr size_t WS_ACT = WS_PJ + 128 * MiB;
constexpr size_t WS_Y = WS_ACT + 272 * MiB;
constexpr size_t WS_TOK = WS_Y + 272 * MiB;
constexpr size_t WS_GATE = WS_TOK + 4 * MiB;
constexpr size_t WS_PAIR = WS_GATE + 4 * MiB;
constexpr size_t WS_RSTD = WS_PAIR + 1 * MiB;
constexpr size_t WS_FL = WS_RSTD + 1 * MiB;
constexpr size_t WS_CB = WS_FL + 2 * MiB;
constexpr size_t WS_END = WS_CB + 2 * MiB;
constexpr int CW_CNT = 64;

__device__ __forceinline__ float bf2f(bf16_t v) { return __uint_as_float((unsigned)v << 16); }
__device__ __forceinline__ unsigned f2bf(float f) { unsigned u = __float_as_uint(f); return (u + 0x7fffu + ((u >> 16) & 1u)) >> 16; }
__device__ __forceinline__ unsigned pk2(float lo, float hi) { return f2bf(lo) | (f2bf(hi) << 16); }
__device__ __forceinline__ float wave_sum(float v) {
#pragma unroll
    for (int o = 1; o < 64; o <<= 1) v += __shfl_xor(v, o);
    return v;
}
__device__ __forceinline__ float wave_max(float v) {
#pragma unroll
    for (int o = 1; o < 64; o <<= 1) v = fmaxf(v, __shfl_xor(v, o));
    return v;
}
__device__ __forceinline__ int crow(int r, int hi) { return (r & 3) + 8 * (r >> 2) + 4 * hi; }
__device__ __forceinline__ float sigmoidf_(float x) { return 1.f / (1.f + __expf(-x)); }
__device__ __forceinline__ float log_sigmoid(float x) { return fminf(x, 0.f) - log1pf(__expf(-fabsf(x))); }

struct MoeTile { int e, rank0, cnt, tstart; bool ok; };
__device__ __forceinline__ MoeTile moe_tile(const unsigned* cnt, int T) {
    const int lane = threadIdx.x & 63;
    const int c = (lane < NE) ? (int)cnt[lane] : 0;
    const int nt = (c + 255) >> 8;
    int incl = nt;
#pragma unroll
    for (int o = 1; o < 32; o <<= 1) { int t = __shfl_up(incl, o); if ((lane & 31) >= o) incl += t; }
    const int excl = incl - nt;
    const unsigned long long m = __ballot(lane < NE && excl <= T && nt > 0 && T < incl);
    MoeTile r; r.ok = (m != 0ull);
    const int e = r.ok ? (int)__builtin_ctzll(m) : 0;
    r.e = e; r.tstart = __shfl(excl, e); r.cnt = __shfl(c, e); r.rank0 = (T - r.tstart) * 256;
    return r;
}
__device__ __forceinline__ int moe_tstart(const unsigned* cnt, int e) {
    const int lane = threadIdx.x & 63;
    const int c = (lane < NE) ? (int)cnt[lane] : 0;
    const int nt = (c + 255) >> 8;
    int incl = nt;
#pragma unroll
    for (int o = 1; o < 32; o <<= 1) { int t = __shfl_up(incl, o); if ((lane & 31) >= o) incl += t; }
    return __shfl(incl - nt, e);
}

__global__ void __launch_bounds__(256) k_rowstat(const float* __restrict__ h, bf16_t* __restrict__ hb, float* __restrict__ rstd) {
    const int lane = threadIdx.x & 63, row = blockIdx.x * 4 + (threadIdx.x >> 6);
    const f32x4* p = (const f32x4*)(h + (size_t)row * DM) + lane;
    f32x4 v[4]; float s = 0.f;
#pragma unroll
    for (int j = 0; j < 4; ++j) { v[j] = p[64 * j]; s += v[j].x * v[j].x + v[j].y * v[j].y + v[j].z * v[j].z + v[j].w * v[j].w; }
    s = wave_sum(s);
    if (lane == 0) rstd[row] = rsqrtf(s * (1.f / DM) + EPS);
    u32x2* o = (u32x2*)(hb + (size_t)row * DM) + lane;
#pragma unroll
    for (int j = 0; j < 4; ++j) { u32x2 w; w.x = pk2(v[j].x, v[j].y); w.y = pk2(v[j].z, v[j].w); o[64 * j] = w; }
}
__global__ void __launch_bounds__(256) k_cvt(const float* __restrict__ s, bf16_t* __restrict__ d, size_t n4) {
    size_t i = (size_t)blockIdx.x * 256 + threadIdx.x;
    if (i < n4) { f32x4 v = ((const f32x4*)s)[i]; u32x2 w; w.x = pk2(v.x, v.y); w.y = pk2(v.z, v.w); ((u32x2*)d)[i] = w; }
}
template <int MODE>
__global__ void __launch_bounds__(256) k_cvt_t(const float* __restrict__ src, const float* __restrict__ g, bf16_t* __restrict__ dst, int K, int N) {
    __shared__ float tile[64][65];
    const int n0 = blockIdx.x * 64, k0 = blockIdx.y * 64, b = blockIdx.z, tid = threadIdx.x;
    const float* s = src + (size_t)b * K * N; bf16_t* d = dst + (size_t)b * K * N;
#pragma unroll
    for (int i = 0; i < 16; ++i) { const int kk = i * 4 + (tid >> 6), nn = tid & 63; const float gg = g ? g[k0 + kk] : 1.f; tile[kk][nn] = s[(size_t)(k0 + kk) * N + n0 + nn] * gg; }
    __syncthreads();
#pragma unroll
    for (int j = 0; j < 2; ++j) {
        const int c = tid + 256 * j, n = c >> 3, kc = c & 7;
        u32x4 w; w.x = pk2(tile[kc * 8 + 0][n], tile[kc * 8 + 1][n]); w.y = pk2(tile[kc * 8 + 2][n], tile[kc * 8 + 3][n]);
        w.z = pk2(tile[kc * 8 + 4][n], tile[kc * 8 + 5][n]); w.w = pk2(tile[kc * 8 + 6][n], tile[kc * 8 + 7][n]);
        int nn = n0 + n;
        if (MODE == 1) { const int half = nn / FF, j2 = nn % FF; nn = (j2 >> 7) * 256 + half * 128 + (j2 & 127); }
        *(u32x4*)(d + (size_t)nn * K + k0 + kc * 8) = w;
    }
}

template <bool DUAL>
__device__ __forceinline__ void gemm_tile64(const bf16_t* a0, const bf16_t* a1, const bf16_t* B1, const bf16_t* B2, int K, f32x16 (&acc)[2][2], f32x16 (&acc2)[2][2]) {
    const int lane = threadIdx.x & 63, r32 = lane & 31, hi = lane >> 5;
    const bf16_t* b0 = B1 + (size_t)r32 * K + 8 * hi; const bf16_t* b1 = B1 + (size_t)(32 + r32) * K + 8 * hi;
    const bf16_t* c0 = DUAL ? B2 + (size_t)r32 * K + 8 * hi : nullptr; const bf16_t* c1 = DUAL ? B2 + (size_t)(32 + r32) * K + 8 * hi : nullptr;
    a0 += 8 * hi; a1 += 8 * hi;
#pragma unroll
    for (int i = 0; i < 2; ++i)
#pragma unroll
        for (int j = 0; j < 2; ++j) { acc[i][j] = f32x16{}; acc2[i][j] = f32x16{}; }
    for (int k = 0; k < K; k += 16) {
        const bf16x8 fa0 = *(const bf16x8*)(a0 + k), fa1 = *(const bf16x8*)(a1 + k), fb0 = *(const bf16x8*)(b0 + k), fb1 = *(const bf16x8*)(b1 + k);
        acc[0][0] = __builtin_amdgcn_mfma_f32_32x32x16_bf16(fa0, fb0, acc[0][0], 0, 0, 0);
        acc[0][1] = __builtin_amdgcn_mfma_f32_32x32x16_bf16(fa0, fb1, acc[0][1], 0, 0, 0);
        acc[1][0] = __builtin_amdgcn_mfma_f32_32x32x16_bf16(fa1, fb0, acc[1][0], 0, 0, 0);
        acc[1][1] = __builtin_amdgcn_mfma_f32_32x32x16_bf16(fa1, fb1, acc[1][1], 0, 0, 0);
        if (DUAL) {
            const bf16x8 fc0 = *(const bf16x8*)(c0 + k), fc1 = *(const bf16x8*)(c1 + k);
            acc2[0][0] = __builtin_amdgcn_mfma_f32_32x32x16_bf16(fa0, fc0, acc2[0][0], 0, 0, 0);
            acc2[0][1] = __builtin_amdgcn_mfma_f32_32x32x16_bf16(fa0, fc1, acc2[0][1], 0, 0, 0);
            acc2[1][0] = __builtin_amdgcn_mfma_f32_32x32x16_bf16(fa1, fc0, acc2[1][0], 0, 0, 0);
            acc2[1][1] = __builtin_amdgcn_mfma_f32_32x32x16_bf16(fa1, fc1, acc2[1][1], 0, 0, 0);
        }
    }
}
#define TILE_FOREACH(...) _Pragma("unroll") for (int mi = 0; mi < 2; ++mi) _Pragma("unroll") for (int ni = 0; ni < 2; ++ni) _Pragma("unroll") for (int r = 0; r < 16; ++r) { \
        const int lrow = 32 * mi + crow(r, hi), lcol = 32 * ni + r32; const float v = acc[mi][ni][r]; const float v2 = acc2[mi][ni][r]; (void)v2; __VA_ARGS__ }

__global__ void __launch_bounds__(64) k_gemm_qkv(const bf16_t* __restrict__ A, const bf16_t* __restrict__ Bt, const float* __restrict__ rstd, bf16_t* __restrict__ Q) {
    const int lane = threadIdx.x, r32 = lane & 31, hi = lane >> 5; const int m0 = blockIdx.y * 64, n0 = blockIdx.x * 64;
    f32x16 acc[2][2], acc2[2][2];
    gemm_tile64<false>(A + (size_t)(m0 + r32) * DM, A + (size_t)(m0 + 32 + r32) * DM, Bt + (size_t)n0 * DM, nullptr, DM, acc, acc2);
    const int t = n0 / DM; bf16_t* out = Q + (size_t)t * ((WS_K - WS_Q) / 2); const float sc = (t == 0) ? C2 : 1.f;
    TILE_FOREACH({ const int row = m0 + lrow, col = n0 - t * DM + lcol; out[(size_t)row * DM + col] = (bf16_t)f2bf(v * rstd[row] * sc); })
}
__global__ void __launch_bounds__(64) k_gemm_wo(const bf16_t* __restrict__ A, const bf16_t* __restrict__ Bt, const float* hin, float* hout, bf16_t* __restrict__ hb) {
    const int lane = threadIdx.x, r32 = lane & 31, hi = lane >> 5; const int m0 = blockIdx.y * 64, n0 = blockIdx.x * 64;
    f32x16 acc[2][2], acc2[2][2];
    gemm_tile64<false>(A + (size_t)(m0 + r32) * DM, A + (size_t)(m0 + 32 + r32) * DM, Bt + (size_t)n0 * DM, nullptr, DM, acc, acc2);
    TILE_FOREACH({ const size_t o = (size_t)(m0 + lrow) * DM + n0 + lcol; const float x = hin[o] + v; hout[o] = x; hb[o] = (bf16_t)f2bf(x); })
}
__global__ void __launch_bounds__(64) k_gemm_pj(const bf16_t* __restrict__ A, const bf16_t* __restrict__ Bt, bf16_t* __restrict__ PJ) {
    const int lane = threadIdx.x, r32 = lane & 31, hi = lane >> 5; const int m0 = blockIdx.y * 64, n0 = blockIdx.x * 64;
    f32x16 acc[2][2], acc2[2][2];
    gemm_tile64<false>(A + (size_t)(m0 + r32) * PLE, A + (size_t)(m0 + 32 + r32) * PLE, Bt + (size_t)n0 * PLE, nullptr, PLE, acc, acc2);
    TILE_FOREACH({ PJ[(size_t)(m0 + lrow) * DM + n0 + lcol] = (bf16_t)f2bf(v); })
}
__global__ void __launch_bounds__(64) k_gemm_ple(const bf16_t* __restrict__ A, const bf16_t* __restrict__ Bt, const float* __restrict__ rstd, const bf16_t* __restrict__ PJ, float* h, bf16_t* hb) {
    const int lane = threadIdx.x, r32 = lane & 31, hi = lane >> 5; const int m0 = blockIdx.y * 64, n0 = blockIdx.x * 64;
    f32x16 acc[2][2], acc2[2][2];
    gemm_tile64<false>(A + (size_t)(m0 + r32) * DM, A + (size_t)(m0 + 32 + r32) * DM, Bt + (size_t)n0 * DM, nullptr, DM, acc, acc2);
    TILE_FOREACH({ const int row = m0 + lrow; const size_t o = (size_t)row * DM + n0 + lcol; const float x = h[o] + sigmoidf_(v * rstd[row]) * bf2f(PJ[o]); h[o] = x; })
}
__global__ void __launch_bounds__(64) k_gemm_gu(const bf16_t* __restrict__ HB, const bf16_t* __restrict__ Wgu, const float* __restrict__ bgu, const float* __restrict__ rstd,
                                                const unsigned* __restrict__ cnt, const int* __restrict__ tok_of, bf16_t* __restrict__ ACT) {
    const int lane = threadIdx.x, r32 = lane & 31, hi = lane >> 5; const int rt = blockIdx.y, T = rt >> 2, j0 = blockIdx.x * 64;
    const MoeTile mt = moe_tile(cnt, T); if (!mt.ok) return;
    const int lr0 = (rt & 3) * 64; const int rk0 = mt.rank0 + lr0 + r32, rk1 = rk0 + 32;
    const int t0 = rk0 < mt.cnt ? tok_of[(size_t)mt.e * CAP + rk0] : 0, t1 = rk1 < mt.cnt ? tok_of[(size_t)mt.e * CAP + rk1] : 0;
    const bf16_t* Be = Wgu + (size_t)mt.e * 2048 * DM + (size_t)((j0 >> 7) * 256 + (j0 & 127)) * DM;
    f32x16 acc[2][2], acc2[2][2];
    gemm_tile64<true>(HB + (size_t)t0 * DM, HB + (size_t)t1 * DM, Be, Be + (size_t)128 * DM, DM, acc, acc2);
    const size_t slot0 = (size_t)T * 256 + lr0;
    TILE_FOREACH({ const int rk = mt.rank0 + lr0 + lrow; if (rk < mt.cnt) { const int tk = tok_of[(size_t)mt.e * CAP + rk]; const float rs = rstd[tk]; const int j = j0 + lcol;
        float gl = v * rs + bgu[(size_t)mt.e * 2048 + j], ln = v2 * rs + bgu[(size_t)mt.e * 2048 + FF + j];
        gl = fminf(gl, 7.f); ln = fminf(fmaxf(ln, -7.f), 7.f);
        const float a = gl * sigmoidf_(1.702f * gl) * (ln + 1.f);
        ACT[(slot0 + lrow) * FF + j] = (bf16_t)f2bf(a); } })
}
__global__ void __launch_bounds__(64) k_gemm_down(const bf16_t* __restrict__ ACT, const bf16_t* __restrict__ Wd, const float* __restrict__ bd, const unsigned* __restrict__ cnt,
                                                  const float* __restrict__ gate_of, bf16_t* __restrict__ Y) {
    const int lane = threadIdx.x, r32 = lane & 31, hi = lane >> 5; const int rt = blockIdx.y, T = rt >> 2, n0 = blockIdx.x * 64;
    const MoeTile mt = moe_tile(cnt, T); if (!mt.ok) return;
    const int lr0 = (rt & 3) * 64; const size_t slot0 = (size_t)T * 256 + lr0;
    const int rk0 = mt.rank0 + lr0 + r32, rk1 = rk0 + 32;
    const size_t s0 = rk0 < mt.cnt ? slot0 + r32 : (size_t)T * 256, s1 = rk1 < mt.cnt ? slot0 + 32 + r32 : (size_t)T * 256;
    f32x16 acc[2][2], acc2[2][2];
    gemm_tile64<false>(ACT + s0 * FF, ACT + s1 * FF, Wd + (size_t)mt.e * DM * FF + (size_t)n0 * FF, nullptr, FF, acc, acc2);
    TILE_FOREACH({ const int rk = mt.rank0 + lr0 + lrow; if (rk < mt.cnt) { const float gt = gate_of[(size_t)mt.e * CAP + rk]; const int n = n0 + lcol;
        Y[(slot0 + lrow) * DM + n] = (bf16_t)f2bf((v + bd[(size_t)mt.e * DM + n]) * gt); } })
}

__global__ void __launch_bounds__(256) k_router(const float* __restrict__ h, const float* __restrict__ g, const float* __restrict__ wr, const float* __restrict__ br,
                                                float* __restrict__ rstd, unsigned* cnt, int* __restrict__ tok_of, float* __restrict__ gate_of, unsigned* __restrict__ pair) {
    const int lane = threadIdx.x & 63, t = blockIdx.x * 4 + (threadIdx.x >> 6); const int e = lane & 31, half = lane >> 5;
    const float* hr = h + (size_t)t * DM;
    float ss = 0.f;
#pragma unroll
    for (int j = 0; j < 4; ++j) { const f32x4 v = ((const f32x4*)hr)[lane + 64 * j]; ss += v.x * v.x + v.y * v.y + v.z * v.z + v.w * v.w; }
    const float rs = rsqrtf(wave_sum(ss) * (1.f / DM) + EPS);
    float a = 0.f;
    for (int d = half * 512; d < half * 512 + 512; ++d) a += hr[d] * g[d] * wr[(size_t)d * NE + e];
    a += __shfl_xor(a, 32);
    float lg = a * rs + br[e];
    float tv[4]; int ti[4];
#pragma unroll
    for (int k = 0; k < 4; ++k) {
        float bv = lg; int bi = e;
#pragma unroll
        for (int o = 1; o < 32; o <<= 1) { const float ov = __shfl_xor(bv, o); const int oi = __shfl_xor(bi, o); if (ov > bv || (ov == bv && oi < bi)) { bv = ov; bi = oi; } }
        tv[k] = bv; ti[k] = bi; if (e == bi) lg = -INFINITY;
    }
    float w[4], sw = 0.f;
#pragma unroll
    for (int k = 0; k < 4; ++k) { w[k] = __expf(tv[k] - tv[0]); sw += w[k]; }
    if (lane == 0) rstd[t] = rs;
    if (lane < 4) {
        const int k = lane; const int ee = (k == 0) ? ti[0] : (k == 1) ? ti[1] : (k == 2) ? ti[2] : ti[3]; const float ww = (k == 0) ? w[0] : (k == 1) ? w[1] : (k == 2) ? w[2] : w[3];
        const unsigned rk = atomicAdd(&cnt[ee], 1u);
        tok_of[(size_t)ee * CAP + rk] = t; gate_of[(size_t)ee * CAP + rk] = ww / sw; pair[(size_t)t * 4 + k] = ((unsigned)ee << 16) | rk;
    }
}
__global__ void __launch_bounds__(256) k_combine(float* h, bf16_t* __restrict__ hb, float* __restrict__ rstd, const unsigned* __restrict__ cnt, const unsigned* __restrict__ pair, const bf16_t* __restrict__ Y) {
    const int lane = threadIdx.x & 63, t = blockIdx.x * 4 + (threadIdx.x >> 6);
    f32x4 v[4]; f32x4* hr = (f32x4*)(h + (size_t)t * DM) + lane;
#pragma unroll
    for (int j = 0; j < 4; ++j) v[j] = hr[64 * j];
    for (int k = 0; k < 4; ++k) {
        const unsigned pr = pair[(size_t)t * 4 + k]; const int e = pr >> 16, rk = pr & 0xffff;
        const size_t slot = (size_t)moe_tstart(cnt, e) * 256 + rk;
        const u32x2* yr = (const u32x2*)(Y + slot * DM) + lane;
#pragma unroll
        for (int j = 0; j < 4; ++j) { const u32x2 w = yr[64 * j]; v[j].x += __uint_as_float(w.x << 16); v[j].y += __uint_as_float(w.x & 0xffff0000u); v[j].z += __uint_as_float(w.y << 16); v[j].w += __uint_as_float(w.y & 0xffff0000u); }
    }
    float s = 0.f;
#pragma unroll
    for (int j = 0; j < 4; ++j) { hr[64 * j] = v[j]; s += v[j].x * v[j].x + v[j].y * v[j].y + v[j].z * v[j].z + v[j].w * v[j].w; }
    s = wave_sum(s); if (lane == 0) rstd[t] = rsqrtf(s * (1.f / DM) + EPS);
    u32x2* o = (u32x2*)(hb + (size_t)t * DM) + lane;
#pragma unroll
    for (int j = 0; j < 4; ++j) { u32x2 w; w.x = pk2(v[j].x, v[j].y); w.y = pk2(v[j].z, v[j].w); o[64 * j] = w; }
}
__global__ void __launch_bounds__(256) k_final(const float* __restrict__ h, const float* __restrict__ g, float* __restrict__ out) {
    const int lane = threadIdx.x & 63, row = blockIdx.x * 4 + (threadIdx.x >> 6);
    const f32x4* p = (const f32x4*)(h + (size_t)row * DM) + lane; f32x4 v[4]; float s = 0.f;
#pragma unroll
    for (int j = 0; j < 4; ++j) { v[j] = p[64 * j]; s += v[j].x * v[j].x + v[j].y * v[j].y + v[j].z * v[j].z + v[j].w * v[j].w; }
    const float rs = rsqrtf(wave_sum(s) * (1.f / DM) + EPS);
    f32x4* o = (f32x4*)(out + (size_t)row * DM) + lane;
#pragma unroll
    for (int j = 0; j < 4; ++j) { const f32x4 gg = ((const f32x4*)g)[lane + 64 * j]; o[64 * j] = v[j] * rs * gg; }
}
__global__ void __launch_bounds__(256) k_fgate(const float* __restrict__ h, const float* __restrict__ g, const float* __restrict__ wf, const float* __restrict__ bfg, const float* __restrict__ rstd, float* __restrict__ fl) {
    const int lane = threadIdx.x & 63, t = blockIdx.x * 4 + (threadIdx.x >> 6); const int hh = lane & 15, q = lane >> 4;
    const float* hr = h + (size_t)t * DM; float a = 0.f;
    for (int d = q * 256; d < q * 256 + 256; ++d) a += hr[d] * g[d] * wf[(size_t)d * NH + hh];
    a += __shfl_xor(a, 16); a += __shfl_xor(a, 32);
    if (lane < 16) fl[(size_t)t * NH + hh] = a * rstd[t] + bfg[hh];
}
__global__ void __launch_bounds__(64) k_scan(const float* __restrict__ fl, float* __restrict__ cb) {
    const int lane = threadIdx.x, bh = blockIdx.x, b = bh / NH, hh = bh % NH;
    float loc[32]; float run = 0.f;
#pragma unroll
    for (int i = 0; i < 32; ++i) { run += log_sigmoid(fl[(size_t)(b * SEQ + lane * 32 + i) * NH + hh]); loc[i] = run; }
    float incl = run;
#pragma unroll
    for (int o = 1; o < 64; o <<= 1) { const float t = __shfl_up(incl, o); if (lane >= o) incl += t; }
    const float base = incl - run;
#pragma unroll
    for (int i = 0; i < 32; ++i) cb[(size_t)bh * SEQ + lane * 32 + i] = (base + loc[i]) * LOG2E;
}

__device__ __forceinline__ float dot64(const float (&q)[64], const bf16_t* kr) {
    float a = 0.f;
#pragma unroll
    for (int c = 0; c < 8; ++c) { const u32x4 w = ((const u32x4*)kr)[c];
        a += q[8 * c + 0] * __uint_as_float(w.x << 16) + q[8 * c + 1] * __uint_as_float(w.x & 0xffff0000u) + q[8 * c + 2] * __uint_as_float(w.y << 16) + q[8 * c + 3] * __uint_as_float(w.y & 0xffff0000u)
           + q[8 * c + 4] * __uint_as_float(w.z << 16) + q[8 * c + 5] * __uint_as_float(w.z & 0xffff0000u) + q[8 * c + 6] * __uint_as_float(w.w << 16) + q[8 * c + 7] * __uint_as_float(w.w & 0xffff0000u); }
    return a;
}
__device__ __forceinline__ void loadq(float (&q)[64], const bf16_t* qr) {
#pragma unroll
    for (int c = 0; c < 8; ++c) { const u32x4 w = ((const u32x4*)qr)[c];
        q[8 * c + 0] = __uint_as_float(w.x << 16); q[8 * c + 1] = __uint_as_float(w.x & 0xffff0000u); q[8 * c + 2] = __uint_as_float(w.y << 16); q[8 * c + 3] = __uint_as_float(w.y & 0xffff0000u);
        q[8 * c + 4] = __uint_as_float(w.z << 16); q[8 * c + 5] = __uint_as_float(w.z & 0xffff0000u); q[8 * c + 6] = __uint_as_float(w.w << 16); q[8 * c + 7] = __uint_as_float(w.w & 0xffff0000u); }
}
__global__ void __launch_bounds__(256) k_attn_sb(const bf16_t* __restrict__ Q, const bf16_t* __restrict__ K, const bf16_t* __restrict__ V, bf16_t* __restrict__ O) {
    const int lane = threadIdx.x & 63; const int gw = blockIdx.x * 4 + (threadIdx.x >> 6); const int t = gw % SEQ, bh = gw / SEQ, b = bh / NH, hh = bh % NH;
    const size_t rowb = (size_t)b * SEQ; float q[64]; loadq(q, Q + (rowb + t) * DM + hh * HD);
    float o = 0.f, carry = 1.f;
    for (int jt = (t - 1) >> 6; jt >= 0 && t > 0; --jt) {
        const int s = 64 * jt + lane; const bool valid = s < t;
        float x = dot64(q, K + (rowb + s) * DM + hh * HD); x = fminf(x, 64.f);
        const float ex = exp2f(x), r = 1.f / (1.f + ex);
        const float beta = valid ? ex * r : 0.f, nb = valid ? r : 1.f;
        float P = nb;
#pragma unroll
        for (int off = 1; off < 64; off <<= 1) { const float t2 = __shfl_down(P, off); if (lane + off < 64) P *= t2; }
        float Pex = __shfl_down(P, 1); if (lane == 63) Pex = 1.f;
        const float a = beta * carry * Pex;
        carry *= __shfl(P, 0);
        const bf16_t* vb = V + (rowb + 64 * jt) * DM + hh * HD + lane;
        for (int l = 0; l < 64; ++l) { const float al = __shfl(a, l); o += al * bf2f(vb[(size_t)l * DM]); }
        if (carry < 1e-30f) break;
    }
    O[(rowb + t) * DM + hh * HD + lane] = (bf16_t)f2bf(o);
}
__global__ void __launch_bounds__(256) k_attn_fox(const bf16_t* __restrict__ Q, const bf16_t* __restrict__ K, const bf16_t* __restrict__ V, const float* __restrict__ cb, bf16_t* __restrict__ O) {
    const int lane = threadIdx.x & 63; const int gw = blockIdx.x * 4 + (threadIdx.x >> 6); const int t = gw % SEQ, bh = gw / SEQ, b = bh / NH, hh = bh % NH;
    const size_t rowb = (size_t)b * SEQ; float q[64]; loadq(q, Q + (rowb + t) * DM + hh * HD);
    float o = 0.f, m = -INFINITY, l = 0.f;
    for (int jt = 0; jt <= (t >> 6); ++jt) {
        const int s = 64 * jt + lane; const bool valid = s <= t;
        float x = dot64(q, K + (rowb + s) * DM + hh * HD) - cb[(size_t)bh * SEQ + s];
        x = valid ? x : -INFINITY;
        const float mn = fmaxf(m, wave_max(x)); const float alpha = exp2f(m - mn); const float p = exp2f(x - mn);
        l = l * alpha + wave_sum(p); o *= alpha; m = mn;
        const bf16_t* vb = V + (rowb + 64 * jt) * DM + hh * HD + lane;
        const int nl = min(64, t - 64 * jt + 1);
        for (int i = 0; i < nl; ++i) { const float pi = __shfl(p, i); o += pi * bf2f(vb[(size_t)i * DM]); }
    }
    O[(rowb + t) * DM + hh * HD + lane] = (bf16_t)f2bf(o / l);
}


#define LAS __attribute__((address_space(3)))
#define GAS __attribute__((address_space(1)))
constexpr size_t WS_SS = WS_END;
constexpr size_t WS_WR = WS_SS + 2 * MiB;
constexpr size_t WS_WF = WS_WR + 1 * MiB;
constexpr size_t WS_HB2 = WS_WF + 1 * MiB;
constexpr size_t WS_END2 = WS_HB2 + 64 * MiB;
constexpr int CW_BAR = 4096;

namespace pg8 {
constexpr int BM = 256, BK = 64, HALF = 128, HTB = HALF * BK * 2, STAGE_BYTES = 8 * HTB, NXCD = 8, WGM = 8;
__device__ __forceinline__ int lds_byte(int r, int c) { const int st = (r >> 4) * 2 + (c >> 5), rr = r & 15, cc = c & 31, ob = rr * 64 + cc * 2; return st * 1024 + (ob ^ (((ob >> 9) & 1) << 5)); }
__device__ __forceinline__ void stage_rc(int b, int& R, int& C) { const int st = b / 1024, sb = b % 1024, swz = sb ^ (((sb >> 9) & 1) << 5); R = (st >> 1) * 16 + swz / 64; C = (st & 1) * 32 + (swz % 64) / 2; }
__device__ __forceinline__ int perm32(int rho) { const int n = rho >> 4, i = rho & 15; return 8 * (i >> 2) + 4 * n + (i & 3); }
__device__ __forceinline__ unsigned cvt_pk_bf16(float lo, float hi) { unsigned r; asm volatile("v_cvt_pk_bf16_f32 %0, %1, %2" : "=v"(r) : "v"(lo), "v"(hi)); return r; }

struct Unit { int arow0, brow0, pn, e, rank0, cnt, ui; };

__device__ __forceinline__ int xcd_remap(int L, int nwg) { const int q = nwg / NXCD, r = nwg % NXCD, xcd = L % NXCD, off = L / NXCD; return (xcd < r ? xcd * (q + 1) : r * (q + 1) + (xcd - r) * q) + off; }

struct DenseOrder {
    int nM, nN, nwg, G, c;
    __device__ __forceinline__ void init(int M, int N, int G_, int c_) { nM = M / BM; nN = N / BM; nwg = nM * nN; G = G_; c = c_; }
    __device__ __forceinline__ bool next(int i, Unit& u) const {
        const long L = (long)i * G + c; if (L >= nwg) return false;
        const int wgid = xcd_remap((int)L, nwg);
        const int nig = WGM * nN, gid = wgid / nig, fm = gid * WGM, gsz = (nM - fm) < WGM ? (nM - fm) : WGM;
        const int pm = fm + ((wgid % nig) % gsz), pn = (wgid % nig) / gsz;
        u.arow0 = pm * BM; u.brow0 = pn * BM; u.pn = pn; u.e = 0; u.rank0 = 0; u.cnt = 0; u.ui = i; return true;
    }
    __device__ __forceinline__ int arow(const Unit& u, int lr) const { return u.arow0 + lr; }
};
struct PJOrder {
    DenseOrder d; int G, c;
    __device__ __forceinline__ void init(int G_, int c_) { d.init(NTOK, DM, G_, 0); G = G_; c = c_; }
    __device__ __forceinline__ bool next(int i, Unit& u) const {
        const long L = (long)i * G + c; if (L >= 2 * d.nwg) return false;
        const int l2 = (L >= d.nwg) ? 1 : 0; const int wgid = xcd_remap((int)L - l2 * d.nwg, d.nwg);
        const int nig = WGM * d.nN, gid = wgid / nig, fm = gid * WGM, gsz = (d.nM - fm) < WGM ? (d.nM - fm) : WGM;
        const int pm = fm + ((wgid % nig) % gsz), pn = (wgid % nig) / gsz;
        u.arow0 = l2 * NTOK + pm * BM; u.brow0 = l2 * DM + pn * BM; u.pn = pn; u.e = 0; u.rank0 = 0; u.cnt = 0; u.ui = i; return true;
    }
    __device__ __forceinline__ int arow(const Unit& u, int lr) const { return u.arow0 + lr; }
};
struct MoeOrder {
    int NN, nwg, G, c; const LAS int* tstartL; const LAS int* cntL; const LAS unsigned short* tokL; bool gather;
    __device__ __forceinline__ bool next(int i, Unit& u) const {
        const long L = (long)i * G + c; if (L >= nwg) return false;
        const int wgid = xcd_remap((int)L, nwg);
        const int T = wgid / NN, pn = wgid - T * NN;
        const int lane = threadIdx.x & 63;
        const int lo = (lane < NE) ? tstartL[lane] : 0x7fffffff, hi = (lane < NE) ? tstartL[lane + 1] : 0x7fffffff;
        const unsigned long long m = __ballot(lo <= T && T < hi);
        const int e = __builtin_amdgcn_readfirstlane((int)__builtin_ctzll(m | (1ull << 63)));
        u.e = e; u.rank0 = (T - tstartL[e]) * 256; u.cnt = cntL[e]; u.arow0 = T * 256; u.brow0 = (e * NN + pn) * 256; u.pn = pn; u.ui = i; return true;
    }
    __device__ __forceinline__ int arow(const Unit& u, int lr) const { return gather ? (int)tokL[u.ui * 256 + lr] : u.arow0 + lr; }
};

typedef const f32x4 (&AccRef)[2][2][4][2];
struct EpiQKV {
    bf16_t* Q; const LAS float* rowL;
    __device__ __forceinline__ void operator()(AccRef acc, const Unit& u, int wr, int wc, int fr, int fq) const {
        const int t = u.brow0 >> 10, colt = u.brow0 & 1023; bf16_t* base = Q + (size_t)t * ((size_t)NTOK * DM); const float sc = (t == 0) ? C2 : 1.f;
        const int col0 = colt + wc * 32 + 8 * fq;
#pragma unroll
        for (int ai = 0; ai < 2; ++ai)
#pragma unroll
            for (int m = 0; m < 4; ++m) { const int lr = ai * HALF + wr * 64 + m * 16 + fr; const int row = u.arow0 + lr;
                const float rs = rowL[u.ui * 256 + lr] * sc; bf16_t* rowp = base + (size_t)row * DM + col0;
#pragma unroll
                for (int bj = 0; bj < 2; ++bj) { const f32x4 v0 = acc[ai][bj][m][0] * rs, v1 = acc[ai][bj][m][1] * rs; u32x4 w;
                    w.x = cvt_pk_bf16(v0[0], v0[1]); w.y = cvt_pk_bf16(v0[2], v0[3]); w.z = cvt_pk_bf16(v1[0], v1[1]); w.w = cvt_pk_bf16(v1[2], v1[3]); *(u32x4*)(rowp + bj * HALF) = w; } }
    }
};
struct EpiPJ {
    bf16_t* O;
    __device__ __forceinline__ void operator()(AccRef acc, const Unit& u, int wr, int wc, int fr, int fq) const {
        const int col0 = u.pn * BM + wc * 32 + 8 * fq;
#pragma unroll
        for (int ai = 0; ai < 2; ++ai)
#pragma unroll
            for (int m = 0; m < 4; ++m) { const int row = u.arow0 + ai * HALF + wr * 64 + m * 16 + fr; bf16_t* rowp = O + (size_t)row * DM + col0;
#pragma unroll
                for (int bj = 0; bj < 2; ++bj) { const f32x4 v0 = acc[ai][bj][m][0], v1 = acc[ai][bj][m][1]; u32x4 w;
                    w.x = cvt_pk_bf16(v0[0], v0[1]); w.y = cvt_pk_bf16(v0[2], v0[3]); w.z = cvt_pk_bf16(v1[0], v1[1]); w.w = cvt_pk_bf16(v1[2], v1[3]); *(u32x4*)(rowp + bj * HALF) = w; } }
    }
};
struct EpiWo {
    const float* hin; float* hout; bf16_t* hb;
    __device__ __forceinline__ void operator()(AccRef acc, const Unit& u, int wr, int wc, int fr, int fq) const {
        const int col0 = u.brow0 + wc * 32 + 8 * fq;
#pragma unroll
        for (int ai = 0; ai < 2; ++ai)
#pragma unroll
            for (int m = 0; m < 4; ++m) { const int row = u.arow0 + ai * HALF + wr * 64 + m * 16 + fr; const size_t off = (size_t)row * DM + col0;
#pragma unroll
                for (int bj = 0; bj < 2; ++bj) { const size_t o = off + bj * HALF; const f32x4 x0 = *(const f32x4*)(hin + o) + acc[ai][bj][m][0], x1 = *(const f32x4*)(hin + o + 4) + acc[ai][bj][m][1];
                    *(f32x4*)(hout + o) = x0; *(f32x4*)(hout + o + 4) = x1; u32x4 w;
                    w.x = cvt_pk_bf16(x0[0], x0[1]); w.y = cvt_pk_bf16(x0[2], x0[3]); w.z = cvt_pk_bf16(x1[0], x1[1]); w.w = cvt_pk_bf16(x1[2], x1[3]); *(u32x4*)(hb + o) = w; }
                asm volatile("" ::: "memory"); }
    }
};
__device__ __forceinline__ float fast_sigmoid(float x) { return __builtin_amdgcn_rcpf(1.f + __builtin_amdgcn_exp2f(-LOG2E * x)); }
struct EpiPLE {
    float* h; bf16_t* hb; const bf16_t* PJ; const LAS float* rowL; float* SS;
    __device__ __forceinline__ void operator()(AccRef acc, const Unit& u, int wr, int wc, int fr, int fq) const {
        const int col0 = u.brow0 + wc * 32 + 8 * fq;
#pragma unroll
        for (int ai = 0; ai < 2; ++ai)
#pragma unroll
            for (int m = 0; m < 4; ++m) { const int lr = ai * HALF + wr * 64 + m * 16 + fr; const int row = u.arow0 + lr; const size_t off = (size_t)row * DM + col0; const float rs = rowL[u.ui * 256 + lr]; float ssq = 0.f;
#pragma unroll
                for (int bj = 0; bj < 2; ++bj) { const size_t o = off + bj * HALF; const u32x4 pj = *(const u32x4*)(PJ + o); f32x4 x0 = *(const f32x4*)(h + o), x1 = *(const f32x4*)(h + o + 4);
                    const f32x4 a0 = acc[ai][bj][m][0] * rs, a1 = acc[ai][bj][m][1] * rs;
                    x0[0] += fast_sigmoid(a0[0]) * __uint_as_float(pj.x << 16); x0[1] += fast_sigmoid(a0[1]) * __uint_as_float(pj.x & 0xffff0000u);
                    x0[2] += fast_sigmoid(a0[2]) * __uint_as_float(pj.y << 16); x0[3] += fast_sigmoid(a0[3]) * __uint_as_float(pj.y & 0xffff0000u);
                    x1[0] += fast_sigmoid(a1[0]) * __uint_as_float(pj.z << 16); x1[1] += fast_sigmoid(a1[1]) * __uint_as_float(pj.z & 0xffff0000u);
                    x1[2] += fast_sigmoid(a1[2]) * __uint_as_float(pj.w << 16); x1[3] += fast_sigmoid(a1[3]) * __uint_as_float(pj.w & 0xffff0000u);
                    ssq += (x0[0] * x0[0] + x0[1] * x0[1]) + (x0[2] * x0[2] + x0[3] * x0[3]) + (x1[0] * x1[0] + x1[1] * x1[1]) + (x1[2] * x1[2] + x1[3] * x1[3]);
                    *(f32x4*)(h + o) = x0; *(f32x4*)(h + o + 4) = x1; u32x4 w;
                    w.x = cvt_pk_bf16(x0[0], x0[1]); w.y = cvt_pk_bf16(x0[2], x0[3]); w.z = cvt_pk_bf16(x1[0], x1[1]); w.w = cvt_pk_bf16(x1[2], x1[3]); *(u32x4*)(hb + o) = w; }
                ssq += __shfl_xor(ssq, 16); ssq += __shfl_xor(ssq, 32);
                if (fq == 0) SS[(size_t)row * 16 + u.pn * 4 + wc] = ssq;
                asm volatile("" ::: "memory"); }
    }
};
struct EpiGU {
    bf16_t* ACT; const float* bgu; const LAS float* rowL;
    __device__ __forceinline__ void operator()(AccRef acc, const Unit& u, int wr, int wc, int fr, int fq) const {
        const int jc = u.pn * 128 + wc * 32 + 8 * fq; const float* bp = bgu + (size_t)u.e * (2 * FF) + jc;
        const f32x4 bg0 = *(const f32x4*)(bp), bg1 = *(const f32x4*)(bp + 4), bl0 = *(const f32x4*)(bp + FF), bl1 = *(const f32x4*)(bp + FF + 4);
#pragma unroll
        for (int ai = 0; ai < 2; ++ai)
#pragma unroll
            for (int m = 0; m < 4; ++m) { const int lr = ai * HALF + wr * 64 + m * 16 + fr; const float rs = rowL[u.ui * 256 + lr];
                f32x4 g0 = acc[ai][0][m][0] * rs + bg0, g1 = acc[ai][0][m][1] * rs + bg1, l0 = acc[ai][1][m][0] * rs + bl0, l1 = acc[ai][1][m][1] * rs + bl1; float a[8];
#pragma unroll
                for (int c = 0; c < 4; ++c) { const float gl = fminf(g0[c], 7.f), ln = fminf(fmaxf(l0[c], -7.f), 7.f); a[c] = gl * fast_sigmoid(1.702f * gl) * (ln + 1.f);
                    const float gl2 = fminf(g1[c], 7.f), ln2 = fminf(fmaxf(l1[c], -7.f), 7.f); a[4 + c] = gl2 * fast_sigmoid(1.702f * gl2) * (ln2 + 1.f); }
                u32x4 w; w.x = cvt_pk_bf16(a[0], a[1]); w.y = cvt_pk_bf16(a[2], a[3]); w.z = cvt_pk_bf16(a[4], a[5]); w.w = cvt_pk_bf16(a[6], a[7]);
                *(u32x4*)(ACT + (size_t)(u.arow0 + lr) * FF + jc) = w; }
    }
};
struct EpiDown {
    bf16_t* Y; const float* bd; const LAS float* rowL;
    __device__ __forceinline__ void operator()(AccRef acc, const Unit& u, int wr, int wc, int fr, int fq) const {
        const int col0 = u.pn * 256 + wc * 32 + 8 * fq; const float* bp = bd + (size_t)u.e * DM + col0;
        f32x4 bv[2][2];
#pragma unroll
        for (int bj = 0; bj < 2; ++bj) { bv[bj][0] = *(const f32x4*)(bp + bj * HALF); bv[bj][1] = *(const f32x4*)(bp + bj * HALF + 4); }
#pragma unroll
        for (int ai = 0; ai < 2; ++ai)
#pragma unroll
            for (int m = 0; m < 4; ++m) { const int lr = ai * HALF + wr * 64 + m * 16 + fr; const float gt = rowL[u.ui * 256 + lr];
                bf16_t* rowp = Y + (size_t)(u.arow0 + lr) * DM + col0;
#pragma unroll
                for (int bj = 0; bj < 2; ++bj) { const f32x4 v0 = (acc[ai][bj][m][0] + bv[bj][0]) * gt, v1 = (acc[ai][bj][m][1] + bv[bj][1]) * gt; u32x4 w;
                    w.x = cvt_pk_bf16(v0[0], v0[1]); w.y = cvt_pk_bf16(v0[2], v0[3]); w.z = cvt_pk_bf16(v1[0], v1[1]); w.w = cvt_pk_bf16(v1[2], v1[3]); *(u32x4*)(rowp + bj * HALF) = w; } }
    }
};

template <class Epi, class Sched>
__device__ __forceinline__ void gemm_phase(LAS unsigned char* lds, const bf16_t* gA, const bf16_t* gBt, const int K, const Sched& S, const Epi& E) {
    int tid_ = threadIdx.x; asm volatile("" : "+v"(tid_));
    const int tid = tid_, wid = __builtin_amdgcn_readfirstlane(tid >> 6), lane = tid & 63, wr = wid >> 2, wc = wid & 3, fr = lane & 15, fq = lane >> 4;
    const int nt = K / BK;
    unsigned voffB[2];
#pragma unroll
    for (int i = 0; i < 2; ++i) { int R, C; stage_rc(tid * 16 + i * 8192, R, C); const int Rb = (R & ~31) + perm32(R & 31); voffB[i] = (unsigned)(Rb * K + C) * 2u; }
#define PG8_AOFF(u, o0, o1) do { int t2_ = threadIdx.x; asm volatile("" : "+v"(t2_)); _Pragma("unroll") for (int i = 0; i < 2; ++i) { int R, C; stage_rc(t2_ * 16 + i * 8192, R, C); \
        o0[i] = ((unsigned)S.arow(u, R) * (unsigned)K + (unsigned)C) * 2u; o1[i] = ((unsigned)S.arow(u, HALF + R) * (unsigned)K + (unsigned)C) * 2u; } } while (0)
    const size_t kstep = (size_t)(BK * 2);
    const size_t hstep = (size_t)HALF * K * 2;
    const unsigned ldsw = (unsigned)wid * 1024u;
    const int aoff = lds_byte(wr * 64 + fr, fq * 8), boff = lds_byte(wc * 32 + fr, fq * 8);
#define PG8_SA(b, h) (((b) * 2 + (h)) * HTB)
#define PG8_SB(b, h) ((4 + (b) * 2 + (h)) * HTB)
#define PG8_STAGE(bufoff, gbase, voff) do { _Pragma("unroll") for (int _i = 0; _i < 2; ++_i) \
        __builtin_amdgcn_global_load_lds((const unsigned*)((const char*)(gbase) + (voff)[_i]), (LAS unsigned*)(lds + (bufoff) + ldsw + _i * 8192), 16, 0, 0); } while (0)
#define PG8_LDA(dst, b, h) do { _Pragma("unroll") for (int m = 0; m < 4; ++m) _Pragma("unroll") for (int k = 0; k < 2; ++k) dst[m][k] = *(const LAS bf16x8*)(lds + PG8_SA(b, h) + aoff + m * 2048 + k * 1024); } while (0)
#define PG8_LDB(dst, b, h) do { _Pragma("unroll") for (int n = 0; n < 2; ++n) _Pragma("unroll") for (int k = 0; k < 2; ++k) dst[n][k] = *(const LAS bf16x8*)(lds + PG8_SB(b, h) + boff + n * 2048 + k * 1024); } while (0)
#define PG8_MMA(ai, bj, At, Bt) do { __builtin_amdgcn_s_setprio(1); _Pragma("unroll") for (int m = 0; m < 4; ++m) _Pragma("unroll") for (int n = 0; n < 2; ++n) _Pragma("unroll") for (int k = 0; k < 2; ++k) \
        acc[ai][bj][m][n] = __builtin_amdgcn_mfma_f32_16x16x32_bf16(Bt[n][k], At[m][k], acc[ai][bj][m][n], 0, 0, 0); __builtin_amdgcn_s_setprio(0); } while (0)
#define PG8_WAIT_V(n) asm volatile("s_waitcnt vmcnt(" #n ")" ::: "memory")
#define PG8_WAIT_L(n) asm volatile("s_waitcnt lgkmcnt(" #n ")" ::: "memory")
#define PG8_BAR __builtin_amdgcn_s_barrier()
#define PG8_SCHED __builtin_amdgcn_sched_barrier(0)
    Unit cur, nxt; int ui = 0;
    if (!S.next(0, cur)) return;
    f32x4 acc[2][2][4][2];
#pragma unroll
    for (int a = 0; a < 2; ++a)
#pragma unroll
        for (int b = 0; b < 2; ++b)
#pragma unroll
            for (int m = 0; m < 4; ++m)
#pragma unroll
                for (int n = 0; n < 2; ++n) acc[a][b][m][n] = (f32x4){0.f, 0.f, 0.f, 0.f};
    bf16x8 At[4][2], B0[2][2], B1[2][2];
    unsigned ao0[2], ao1[2];
    PG8_AOFF(cur, ao0, ao1);
    const char* const bA = (const char*)gA;
    const char* cB = (const char*)gBt + (size_t)cur.brow0 * K * 2;
    PG8_STAGE(PG8_SB(0, 0), cB, voffB); PG8_STAGE(PG8_SB(0, 1), cB + hstep, voffB); PG8_STAGE(PG8_SA(0, 0), bA, ao0); PG8_STAGE(PG8_SA(0, 1), bA, ao1);
    if (wr == 1) PG8_BAR;
    PG8_WAIT_V(2); PG8_BAR;
    PG8_STAGE(PG8_SB(1, 0), cB + kstep, voffB); PG8_STAGE(PG8_SA(1, 0), bA + kstep, ao0); PG8_STAGE(PG8_SB(1, 1), cB + hstep + kstep, voffB);
    PG8_WAIT_V(6); PG8_BAR;
    for (;;) {
        const bool has_next = S.next(ui + 1, nxt);
        const char* nB = has_next ? (const char*)gBt + (size_t)nxt.brow0 * K * 2 : cB;
        _Pragma("clang loop unroll(disable)") for (int t = 0; t < nt; t += 2) {
            const bool last = (t == nt - 2);
            const char* a1 = bA + (size_t)(t + 1) * kstep;
            const char* a2 = last ? bA : bA + (size_t)(t + 2) * kstep; const char* b2 = last ? nB : cB + (size_t)(t + 2) * kstep;
            const char* a3 = a2 + kstep; const char* b3 = b2 + kstep;
            unsigned o20[2], o21[2];
            if (last && has_next) { PG8_AOFF(nxt, o20, o21); } else {
#pragma unroll
                for (int i = 0; i < 2; ++i) { o20[i] = ao0[i]; o21[i] = ao1[i]; } }
            PG8_LDB(B0, 0, 0); PG8_LDB(B1, 0, 1); PG8_SCHED; PG8_LDA(At, 0, 0); PG8_STAGE(PG8_SA(1, 1), a1, ao1);
            PG8_WAIT_V(8); PG8_WAIT_L(0); PG8_BAR; PG8_MMA(0, 0, At, B0); PG8_MMA(0, 1, At, B1); PG8_BAR; PG8_SCHED;
            PG8_LDA(At, 0, 1); PG8_STAGE(PG8_SB(0, 0), b2, voffB); PG8_STAGE(PG8_SB(0, 1), b2 + hstep, voffB); PG8_STAGE(PG8_SA(0, 0), a2, o20);
            PG8_WAIT_V(8); PG8_WAIT_L(0); PG8_BAR; PG8_MMA(1, 0, At, B0); PG8_MMA(1, 1, At, B1); PG8_BAR; PG8_SCHED;
            PG8_LDB(B0, 1, 0); PG8_LDB(B1, 1, 1); PG8_SCHED; PG8_LDA(At, 1, 0); PG8_STAGE(PG8_SA(0, 1), a2, o21);
            PG8_WAIT_V(8); PG8_WAIT_L(0); PG8_BAR; PG8_MMA(0, 0, At, B0); PG8_MMA(0, 1, At, B1); PG8_BAR; PG8_SCHED;
            PG8_LDA(At, 1, 1); PG8_STAGE(PG8_SB(1, 0), b3, voffB); PG8_STAGE(PG8_SB(1, 1), b3 + hstep, voffB); PG8_STAGE(PG8_SA(1, 0), a3, o20);
            PG8_WAIT_V(8); PG8_WAIT_L(0); PG8_BAR; PG8_MMA(1, 0, At, B0); PG8_MMA(1, 1, At, B1); PG8_BAR; PG8_SCHED;
        }
        if (wr == 0) PG8_BAR;
        E(acc, cur, wr, wc, fr, fq);
        if (!has_next) break;
#pragma unroll
        for (int a = 0; a < 2; ++a)
#pragma unroll
            for (int b = 0; b < 2; ++b)
#pragma unroll
                for (int m = 0; m < 4; ++m)
#pragma unroll
                    for (int n = 0; n < 2; ++n) acc[a][b][m][n] = (f32x4){0.f, 0.f, 0.f, 0.f};
        cur = nxt; cB = nB; ++ui;
        PG8_AOFF(cur, ao0, ao1);
        if (wr == 1) PG8_BAR;
    }
    PG8_WAIT_V(0);
    PG8_BAR;
#undef PG8_AOFF
#undef PG8_SA
#undef PG8_SB
#undef PG8_STAGE
#undef PG8_LDA
#undef PG8_LDB
#undef PG8_MMA
#undef PG8_WAIT_V
#undef PG8_WAIT_L
#undef PG8_BAR
#undef PG8_SCHED
}
}

#define XB_TMO      128
#define XB_XCNT(j)  (256  + 64 * (j))
#define XB_XSUB(j)  (1280 + 64 * (j))
#define XB_XGEN(j)  (2304 + 64 * (j))
#define XB_TOP      3328
#define XB_TOPGEN   3392
#define XCD_BAR_WORDS 3456
#define XB_SPIN_CAP (1u << 18)
__device__ __forceinline__ unsigned xb_ld(unsigned* p)              { return __hip_atomic_load(p, __ATOMIC_RELAXED, __HIP_MEMORY_SCOPE_AGENT); }
__device__ __forceinline__ unsigned xb_add(unsigned* p, unsigned v) { return __hip_atomic_fetch_add(p, v, __ATOMIC_RELAXED, __HIP_MEMORY_SCOPE_AGENT); }
__device__ __forceinline__ unsigned xb_xcc_id() { return (unsigned)__builtin_amdgcn_s_getreg((3 << 11) | 20) & 0xFu; }
#define XB_SPIN(cond, bar) do { unsigned _sp = 0; while (cond) { __builtin_amdgcn_s_sleep(1); \
    if ((++_sp & 255u) == 0u) { if (xb_ld(&(bar)[XB_TMO])) break; if (_sp > XB_SPIN_CAP) { atomicAdd(&(bar)[XB_TMO], 1u); break; } } } } while (0)
struct XcdBarrier { unsigned* bar; unsigned x; volatile LAS unsigned* st; };
__device__ __forceinline__ XcdBarrier xcd_barrier_post(unsigned* bar, volatile LAS unsigned* st) {
    XcdBarrier b; b.bar = bar; b.x = xb_xcc_id(); b.st = st;
    if (threadIdx.x == 0) (void)xb_add(&bar[XB_XCNT(b.x)], 1u);
    return b;
}
__device__ __forceinline__ void xcd_barrier_complete(unsigned* bar, unsigned x, unsigned& nloc, unsigned& nx) {
    const unsigned G = gridDim.x * gridDim.y * gridDim.z;
    unsigned sum, cnt, mine, sp = 0u;
    for (;;) {
        sum = 0u; cnt = 0u; mine = 0u;
#pragma unroll
        for (unsigned j = 0; j < 16; ++j) { const unsigned c = xb_ld(&bar[XB_XCNT(j)]); sum += c; cnt += (c > 0u) ? 1u : 0u; mine = (j == x) ? c : mine; }
        if (sum == G) break;
        __builtin_amdgcn_s_sleep(1);
        if ((++sp & 255u) == 0u) { if (xb_ld(&bar[XB_TMO])) break; if (sp > XB_SPIN_CAP) { atomicAdd(&bar[XB_TMO], 1u); break; } }
    }
    nloc = mine > 0u ? mine : 1u; nx = cnt > 0u ? cnt : 1u;
}
__device__ __forceinline__ void xcd_barrier(const XcdBarrier& b) {
    asm volatile("s_waitcnt vmcnt(0)" ::: "memory");
    __syncthreads();
    if (threadIdx.x == 0) {
        unsigned* bar = b.bar;
        __builtin_amdgcn_s_waitcnt(0);
        unsigned nloc = b.st[0], nx = b.st[1];
        if (nloc == 0u) { xcd_barrier_complete(bar, b.x, nloc, nx); b.st[0] = nloc; b.st[1] = nx; }
        const unsigned old = xb_add(&bar[XB_XSUB(b.x)], 1u);
        const unsigned gen = old / nloc;
        if (old + 1u == (gen + 1u) * nloc) {
            __builtin_amdgcn_fence(__ATOMIC_RELEASE, "agent");
            asm volatile("s_waitcnt vmcnt(0)" ::: "memory");
            const unsigned og = xb_add(&bar[XB_TOP], 1u);
            const unsigned tg = og / nx;
            if (og + 1u == (tg + 1u) * nx) xb_add(&bar[XB_TOPGEN], 1u);
            else XB_SPIN(xb_ld(&bar[XB_TOPGEN]) == tg, bar);
            __builtin_amdgcn_fence(__ATOMIC_ACQUIRE, "agent");
            xb_add(&bar[XB_XGEN(b.x)], 1u);
            asm volatile("s_waitcnt vmcnt(0)" ::: "memory");
        } else {
            XB_SPIN(xb_ld(&bar[XB_XGEN(b.x)]) == gen, bar);
            __builtin_amdgcn_fence(__ATOMIC_ACQUIRE, "agent");
            asm volatile("s_waitcnt vmcnt(0)" ::: "memory");
        }
    }
    __syncthreads();
}

constexpr int MK_WAVES = 8;
constexpr int RING_BYTES = 131072;
constexpr int ROW_OFF = RING_BYTES, TOK_UNITS = 18;
constexpr int TOK_OFF = ROW_OFF + TOK_UNITS * 1024;
constexpr int TBL_OFF = TOK_OFF + TOK_UNITS * 512;
constexpr int LDSCTL_OFF = TBL_OFF + 512;
constexpr int MK_LDS_BYTES = LDSCTL_OFF + 256;
static_assert(MK_LDS_BYTES <= 160 * 1024, "LDS map");

struct MArgs { const float* in[18]; float* out; unsigned char* ws; int ph_lo, ph_hi; };
struct Frame {
    LAS unsigned char* lds; int tid, lane, wave, vcu, G;
    unsigned char* ws; unsigned* ctl;
};
__device__ __forceinline__ unsigned pkb(float lo, float hi) { return pg8::cvt_pk_bf16(lo, hi); }

template <int MODE>
__device__ __forceinline__ void p0_transpose_item(const float* W, const float* g, int K, int N, bf16_t* WT, LAS float* scr, int item, int lane) {
    const int nblk = N / 32, kb = item / nblk, nb = item % nblk, k0 = 64 * kb, n0 = 32 * nb;
    float v[32];
#pragma unroll
    for (int i = 0; i < 32; ++i) { const int kk = 2 * i + (lane >> 5); v[i] = W[(size_t)(k0 + kk) * N + n0 + (lane & 31)]; }
    const float g0 = g ? g[k0 + lane] : 1.f;
#pragma unroll
    for (int i = 0; i < 32; ++i) { const int kk = 2 * i + (lane >> 5); const float gg = __shfl(g0, kk); scr[kk * 33 + (lane & 31)] = v[i] * gg; }
    asm volatile("s_waitcnt lgkmcnt(0)" ::: "memory");
    const int c = lane & 7;
#pragma unroll
    for (int j = 0; j < 4; ++j) { const int n = (lane >> 3) + 8 * j; const LAS float* s = scr + (8 * c) * 33 + n;
        u32x4 o; o.x = pkb(s[0 * 33], s[1 * 33]); o.y = pkb(s[2 * 33], s[3 * 33]); o.z = pkb(s[4 * 33], s[5 * 33]); o.w = pkb(s[6 * 33], s[7 * 33]);
        int nn = n0 + n;
        if (MODE == 1) { const int half = nn / FF, j2 = nn % FF; nn = (j2 >> 7) * 256 + half * 128 + (j2 & 127); }
        *(u32x4*)(WT + (size_t)nn * K + k0 + 8 * c) = o; }
    asm volatile("s_waitcnt lgkmcnt(0)" ::: "memory");
}
__device__ __forceinline__ void p0_prologue(Frame& F, const MArgs& args) {
    LAS float* scr = (LAS float*)(F.lds + F.wave * 16384);
    const int gw = F.vcu * MK_WAVES + F.wave, NGW = F.G * MK_WAVES, lane = F.lane;
    unsigned char* ws = F.ws;
    {
        const float* x = args.in[0]; bf16_t* HB = (bf16_t*)(ws + WS_HB); float* SS = (float*)(ws + WS_SS);
        for (int row = gw; row < NTOK; row += NGW) {
            const f32x4* p = (const f32x4*)(x + (size_t)row * DM) + lane; f32x4 v[4]; float s = 0.f;
#pragma unroll
            for (int j = 0; j < 4; ++j) { v[j] = p[64 * j]; s += v[j].x * v[j].x + v[j].y * v[j].y + v[j].z * v[j].z + v[j].w * v[j].w; }
            s = wave_sum(s);
            if (lane < 16) SS[(size_t)row * 16 + lane] = (lane == 0) ? s : 0.f;
            u32x2* o = (u32x2*)(HB + (size_t)row * DM) + lane;
#pragma unroll
            for (int j = 0; j < 4; ++j) { u32x2 w; w.x = pkb(v[j].x, v[j].y); w.y = pkb(v[j].z, v[j].w); o[64 * j] = w; }
        }
        const float* pp = args.in[1]; bf16_t* PB = (bf16_t*)(ws + WS_PB);
        const size_t n4 = (size_t)DEPTH * NTOK * PLE / 4;
        for (size_t i = (size_t)gw * 64 + lane; i < n4; i += (size_t)NGW * 64) { const f32x4 v = ((const f32x4*)pp)[i]; u32x2 w; w.x = pkb(v.x, v.y); w.y = pkb(v.z, v.w); ((u32x2*)PB)[i] = w; }
    }
    constexpr int I_QKV = (DM / 64) * (3 * DM / 32), I_SQ = (DM / 64) * (DM / 32), I_WP = (PLE / 64) * (DM / 32), I_GU = (DM / 64) * (2 * FF / 32), I_WD = (FF / 64) * (DM / 32), I_WR = (DM / 64) * (NE / 32);
    constexpr int PER_LAYER = I_QKV + 2 * I_SQ + I_WP + NE * I_GU + NE * I_WD + I_WR;
    const float* g_mix = args.in[2]; const float* w_qkv = args.in[3]; const float* w_fgate = args.in[4]; const float* w_o = args.in[6]; const float* g_moe = args.in[7]; const float* w_router = args.in[8];
    const float* w_gu = args.in[10]; const float* w_down = args.in[12]; const float* g_ple = args.in[14]; const float* w_ple_gate = args.in[15]; const float* w_ple_proj = args.in[16];
    for (int it = gw; it < DEPTH * PER_LAYER; it += NGW) {
        const int L = it / PER_LAYER; int r = it - L * PER_LAYER;
        if (r < I_QKV) { p0_transpose_item<0>(w_qkv + (size_t)L * DM * 3 * DM, g_mix + L * DM, DM, 3 * DM, (bf16_t*)(ws + WS_WQKV) + (size_t)L * 3 * DM * DM, scr, r, lane); continue; } r -= I_QKV;
        if (r < I_SQ) { p0_transpose_item<0>(w_o + (size_t)L * DM * DM, nullptr, DM, DM, (bf16_t*)(ws + WS_WO) + (size_t)L * DM * DM, scr, r, lane); continue; } r -= I_SQ;
        if (r < I_SQ) { p0_transpose_item<0>(w_ple_gate + (size_t)L * DM * DM, g_ple + L * DM, DM, DM, (bf16_t*)(ws + WS_WG) + (size_t)L * DM * DM, scr, r, lane); continue; } r -= I_SQ;
        if (r < I_WP) { p0_transpose_item<0>(w_ple_proj + (size_t)L * PLE * DM, nullptr, PLE, DM, (bf16_t*)(ws + WS_WP) + (size_t)L * DM * PLE, scr, r, lane); continue; } r -= I_WP;
        if (r < I_WR) { p0_transpose_item<0>(w_router + (size_t)L * DM * NE, g_moe + L * DM, DM, NE, (bf16_t*)(ws + WS_WR) + (size_t)L * NE * DM, scr, r, lane); continue; } r -= I_WR;
        if (r < NE * I_GU) { const int e = r / I_GU; p0_transpose_item<1>(w_gu + ((size_t)L * NE + e) * DM * 2 * FF, g_moe + L * DM, DM, 2 * FF, (bf16_t*)(ws + WS_WGU) + ((size_t)L * NE + e) * 2 * FF * DM, scr, r - e * I_GU, lane); continue; } r -= NE * I_GU;
        { const int e = r / I_WD; p0_transpose_item<0>(w_down + ((size_t)L * NE + e) * FF * DM, nullptr, FF, DM, (bf16_t*)(ws + WS_WD) + ((size_t)L * NE + e) * DM * FF, scr, r - e * I_WD, lane); }
    }
    if (gw < 256) { bf16_t* WF = (bf16_t*)(ws + WS_WF); const int idx = gw * 64 + lane; const int n = idx >> 10, k = idx & 1023; WF[idx] = (bf16_t)f2bf(w_fgate[(size_t)k * NH + n] * g_mix[DM + k]); }
}

__device__ __forceinline__ void moe_tables(Frame& F, const unsigned* cnt) {
    LAS int* tstartL = (LAS int*)(F.lds + TBL_OFF); LAS int* cntL = tstartL + 64;
    if (F.wave == 0) {
        const int lane = F.lane; const int c = (lane < NE) ? (int)__hip_atomic_load(cnt + (lane & 31), __ATOMIC_RELAXED, __HIP_MEMORY_SCOPE_AGENT) : 0; const int nt = (c + 255) >> 8; int incl = nt;
#pragma unroll
        for (int o = 1; o < 32; o <<= 1) { const int t = __shfl_up(incl, o); if ((lane & 31) >= o) incl += t; }
        if (lane < NE) { tstartL[lane] = incl - nt; cntL[lane] = c; if (lane == NE - 1) tstartL[NE] = incl; }
    }
    __syncthreads();
}
__device__ __forceinline__ void router_phase(Frame& F, const bf16_t* HB, const bf16_t* WR, const float* br, float* rstd, unsigned* cnt, int* tok_of, float* gate_of, unsigned* pair) {
    const int gw = F.vcu * MK_WAVES + F.wave, NGW = F.G * MK_WAVES, lane = F.lane, r = lane & 15, quad = lane >> 4;
    for (int blk = gw; blk < NTOK / 16; blk += NGW) {
        const int t0 = blk * 16;
        const bf16_t* ap = HB + (size_t)(t0 + r) * DM + quad * 8; const bf16_t* bp0 = WR + (size_t)r * DM + quad * 8; const bf16_t* bp1 = bp0 + (size_t)16 * DM;
        f32x4 acc0 = {0.f, 0.f, 0.f, 0.f}, acc1 = {0.f, 0.f, 0.f, 0.f}; float ssq = 0.f;
#pragma unroll 8
        for (int ks = 0; ks < 32; ++ks) { const bf16x8 a = *(const bf16x8*)(ap + 32 * ks), b0 = *(const bf16x8*)(bp0 + 32 * ks), b1 = *(const bf16x8*)(bp1 + 32 * ks);
            acc0 = __builtin_amdgcn_mfma_f32_16x16x32_bf16(a, b0, acc0, 0, 0, 0); acc1 = __builtin_amdgcn_mfma_f32_16x16x32_bf16(a, b1, acc1, 0, 0, 0);
#pragma unroll
            for (int j = 0; j < 8; ++j) { const float f = __uint_as_float(((unsigned)(unsigned short)a[j]) << 16); ssq += f * f; } }
        ssq += __shfl_xor(ssq, 16); ssq += __shfl_xor(ssq, 32);
        const float rs_r = rsqrtf(ssq * (1.f / DM) + EPS);
        const float b_lo = br[r], b_hi = br[16 + r];
#pragma unroll
        for (int j = 0; j < 4; ++j) {
            const float rsj = __shfl(rs_r, quad * 4 + j); const int t = t0 + quad * 4 + j;
            float v0 = acc0[j] * rsj + b_lo, v1 = acc1[j] * rsj + b_hi; float tv[4]; int ti[4];
#pragma unroll
            for (int k = 0; k < 4; ++k) {
                float bv = (v0 >= v1) ? v0 : v1; int bi = (v0 >= v1) ? r : 16 + r;
#pragma unroll
                for (int o = 1; o < 16; o <<= 1) { const float ov = __shfl_xor(bv, o); const int oi = __shfl_xor(bi, o); if (ov > bv || (ov == bv && oi < bi)) { bv = ov; bi = oi; } }
                tv[k] = bv; ti[k] = bi; if (bi == r) v0 = -INFINITY; if (bi == 16 + r) v1 = -INFINITY;
            }
            float w[4], sw = 0.f;
#pragma unroll
            for (int k = 0; k < 4; ++k) { w[k] = __expf(tv[k] - tv[0]); sw += w[k]; }
            if (r < 4) { const int ee = (r == 0) ? ti[0] : (r == 1) ? ti[1] : (r == 2) ? ti[2] : ti[3]; const float ww = (r == 0) ? w[0] : (r == 1) ? w[1] : (r == 2) ? w[2] : w[3];
                const unsigned rk = __hip_atomic_fetch_add(&cnt[ee], 1u, __ATOMIC_RELAXED, __HIP_MEMORY_SCOPE_AGENT);
                tok_of[(size_t)ee * CAP + rk] = t; gate_of[(size_t)ee * CAP + rk] = ww / sw; pair[(size_t)t * 4 + r] = ((unsigned)ee << 16) | rk; }
            if (r == 4) rstd[t] = rsj;
        }
    }
}
__device__ __forceinline__ void fgate_phase(Frame& F, const bf16_t* HB, const bf16_t* WF, const float* bfg, const float* SS, float* FL) {
    const int gw = F.vcu * MK_WAVES + F.wave, NGW = F.G * MK_WAVES, lane = F.lane, r = lane & 15, quad = lane >> 4;
    for (int blk = gw; blk < NTOK / 16; blk += NGW) {
        const int t0 = blk * 16;
        const bf16_t* ap = HB + (size_t)(t0 + r) * DM + quad * 8; const bf16_t* bp0 = WF + (size_t)r * DM + quad * 8;
        f32x4 acc0 = {0.f, 0.f, 0.f, 0.f};
#pragma unroll 8
        for (int ks = 0; ks < 32; ++ks) { const bf16x8 a = *(const bf16x8*)(ap + 32 * ks), b0 = *(const bf16x8*)(bp0 + 32 * ks); acc0 = __builtin_amdgcn_mfma_f32_16x16x32_bf16(a, b0, acc0, 0, 0, 0); }
        const f32x4 sp = *(const f32x4*)(SS + (size_t)(t0 + r) * 16 + quad * 4); float ss = (sp.x + sp.y) + (sp.z + sp.w); ss += __shfl_xor(ss, 16); ss += __shfl_xor(ss, 32);
        const float rs_r = rsqrtf(ss * (1.f / DM) + EPS); const float bb = bfg[r];
#pragma unroll
        for (int j = 0; j < 4; ++j) { const float rsj = __shfl(rs_r, quad * 4 + j); FL[(size_t)(t0 + quad * 4 + j) * NH + r] = acc0[j] * rsj + bb; }
    }
}
__device__ __forceinline__ void combine_phase(Frame& F, float* h, bf16_t* hb, float* rstd, const unsigned* pair, const bf16_t* Y) {
    const int gw = F.vcu * MK_WAVES + F.wave, NGW = F.G * MK_WAVES, lane = F.lane; const LAS int* tstartL = (const LAS int*)(F.lds + TBL_OFF);
    for (int t = gw; t < NTOK; t += NGW) {
        f32x4 v[4]; f32x4* hr = (f32x4*)(h + (size_t)t * DM) + lane;
        const u32x4 pr4 = *(const u32x4*)(pair + (size_t)t * 4);
#pragma unroll
        for (int j = 0; j < 4; ++j) v[j] = hr[64 * j];
#pragma unroll
        for (int k = 0; k < 4; ++k) {
            const unsigned pr = (k == 0) ? pr4.x : (k == 1) ? pr4.y : (k == 2) ? pr4.z : pr4.w; const int e = __builtin_amdgcn_readfirstlane((int)(pr >> 16)), rk = __builtin_amdgcn_readfirstlane((int)(pr & 0xffffu));
            const size_t slot = (size_t)tstartL[e] * 256 + rk; const u32x2* yr = (const u32x2*)(Y + slot * DM) + lane;
#pragma unroll
            for (int j = 0; j < 4; ++j) { const u32x2 w = yr[64 * j]; v[j].x += __uint_as_float(w.x << 16); v[j].y += __uint_as_float(w.x & 0xffff0000u); v[j].z += __uint_as_float(w.y << 16); v[j].w += __uint_as_float(w.y & 0xffff0000u); }
        }
        float s = 0.f;
#pragma unroll
        for (int j = 0; j < 4; ++j) { hr[64 * j] = v[j]; s += v[j].x * v[j].x + v[j].y * v[j].y + v[j].z * v[j].z + v[j].w * v[j].w; }
        s = wave_sum(s); if (lane == 0) rstd[t] = rsqrtf(s * (1.f / DM) + EPS);
        u32x2* o = (u32x2*)(hb + (size_t)t * DM) + lane;
#pragma unroll
        for (int j = 0; j < 4; ++j) { u32x2 w; w.x = pkb(v[j].x, v[j].y); w.y = pkb(v[j].z, v[j].w); o[64 * j] = w; }
    }
}
__device__ __forceinline__ void final_phase(Frame& F, const float* h, const float* SS, const float* g, float* out) {
    const int gw = F.vcu * MK_WAVES + F.wave, NGW = F.G * MK_WAVES, lane = F.lane;
    f32x4 gg[4];
#pragma unroll
    for (int j = 0; j < 4; ++j) gg[j] = ((const f32x4*)g)[lane + 64 * j];
    for (int row = gw; row < NTOK; row += NGW) {
        const f32x4* p = (const f32x4*)(h + (size_t)row * DM) + lane; f32x4 v[4];
#pragma unroll
        for (int j = 0; j < 4; ++j) v[j] = p[64 * j];
        float ss = (lane < 16) ? SS[(size_t)row * 16 + lane] : 0.f; ss = wave_sum(ss);
        const float rs = rsqrtf(ss * (1.f / DM) + EPS);
        f32x4* o = (f32x4*)(out + (size_t)row * DM) + lane;
#pragma unroll
        for (int j = 0; j < 4; ++j) o[64 * j] = v[j] * rs * gg[j];
    }
}
__device__ __forceinline__ void attn_sb_head(Frame& F, int bh, const bf16_t* Q, const bf16_t* K, const bf16_t* V, bf16_t* O) {
    const int lane = F.lane, b = bh / NH, hh = bh % NH; const size_t rowb = (size_t)b * SEQ;
    for (int t = F.wave; t < SEQ; t += MK_WAVES) {
        float q[64]; loadq(q, Q + (rowb + t) * DM + hh * HD);
        float o = 0.f, carry = 1.f;
        for (int jt = (t - 1) >> 6; jt >= 0 && t > 0; --jt) {
            const int s = 64 * jt + lane; const bool valid = s < t;
            float x = dot64(q, K + (rowb + s) * DM + hh * HD); x = fminf(x, 64.f);
            const float ex = exp2f(x), r = 1.f / (1.f + ex);
            const float beta = valid ? ex * r : 0.f, nb = valid ? r : 1.f;
            float P = nb;
#pragma unroll
            for (int off = 1; off < 64; off <<= 1) { const float t2 = __shfl_down(P, off); if (lane + off < 64) P *= t2; }
            float Pex = __shfl_down(P, 1); if (lane == 63) Pex = 1.f;
            const float a = beta * carry * Pex;
            carry *= __shfl(P, 0);
            const bf16_t* vb = V + (rowb + 64 * jt) * DM + hh * HD + lane;
            for (int l = 0; l < 64; ++l) { const float al = __shfl(a, l); o += al * bf2f(vb[(size_t)l * DM]); }
            if (carry < 1e-30f) break;
        }
        O[(rowb + t) * DM + hh * HD + lane] = (bf16_t)f2bf(o);
    }
}
__device__ __forceinline__ void attn_fox_head(Frame& F, int bh, const bf16_t* Q, const bf16_t* K, const bf16_t* V, const float* FL, bf16_t* O) {
    const int lane = F.lane, b = bh / NH, hh = bh % NH; const size_t rowb = (size_t)b * SEQ;
    LAS float* cbL = (LAS float*)(F.lds); LAS float* wtot = (LAS float*)(F.lds + 8192);
    {
        float loc[4]; float run = 0.f;
#pragma unroll
        for (int i = 0; i < 4; ++i) { run += log_sigmoid(FL[(size_t)(rowb + F.tid * 4 + i) * NH + hh]); loc[i] = run; }
        float incl = run;
#pragma unroll
        for (int o = 1; o < 64; o <<= 1) { const float t = __shfl_up(incl, o); if (lane >= o) incl += t; }
        if (lane == 63) wtot[F.wave] = incl;
        __syncthreads();
        float base = incl - run;
        for (int w = 0; w < F.wave; ++w) base += wtot[w];
#pragma unroll
        for (int i = 0; i < 4; ++i) cbL[F.tid * 4 + i] = (base + loc[i]) * LOG2E;
        __syncthreads();
    }
    for (int t = F.wave; t < SEQ; t += MK_WAVES) {
        float q[64]; loadq(q, Q + (rowb + t) * DM + hh * HD);
        float o = 0.f, m = -INFINITY, l = 0.f;
        for (int jt = 0; jt <= (t >> 6); ++jt) {
            const int s = 64 * jt + lane; const bool valid = s <= t;
            float x = dot64(q, K + (rowb + s) * DM + hh * HD) - cbL[s];
            x = valid ? x : -INFINITY;
            const float mn = fmaxf(m, wave_max(x)); const float alpha = exp2f(m - mn); const float p = exp2f(x - mn);
            l = l * alpha + wave_sum(p); o *= alpha; m = mn;
            const bf16_t* vb = V + (rowb + 64 * jt) * DM + hh * HD + lane;
            const int nl = min(64, t - 64 * jt + 1);
            for (int i = 0; i < nl; ++i) { const float pi = __shfl(p, i); o += pi * bf2f(vb[(size_t)i * DM]); }
        }
        O[(rowb + t) * DM + hh * HD + lane] = (bf16_t)f2bf(o / l);
    }
    __syncthreads();
}

constexpr int N_PHASES = 18;
__global__ void __launch_bounds__(MK_WAVES * 64, 2) mega_fwd(MArgs args) {
    extern __shared__ __attribute__((aligned(16))) unsigned char lds_raw[];
    Frame F;
    F.lds = (LAS unsigned char*)lds_raw;
    F.tid = threadIdx.x; F.lane = F.tid & 63; F.wave = __builtin_amdgcn_readfirstlane(F.tid >> 6);
    F.G = gridDim.x; { const int bx = blockIdx.x; F.vcu = (F.G % 8 == 0) ? (bx % 8) * (F.G / 8) + bx / 8 : bx; }
    F.ws = args.ws; F.ctl = (unsigned*)(args.ws + WS_CTL);
    unsigned char* ws = args.ws;
    for (int u = F.tid; u < (MK_LDS_BYTES - LDSCTL_OFF) / 4; u += MK_WAVES * 64) ((LAS unsigned*)(F.lds + LDSCTL_OFF))[u] = 0u;
    __syncthreads();
    const int lo = args.ph_lo, hi = args.ph_hi;
    const bool use_bar = (hi - lo) > 1;
    XcdBarrier bar; bar.bar = F.ctl + CW_BAR; bar.x = 0; bar.st = nullptr;
    if (use_bar) bar = xcd_barrier_post(F.ctl + CW_BAR, (volatile LAS unsigned*)(F.lds + LDSCTL_OFF + 32));
#ifndef MK_P0SUB
#define MK_P0SUB 7
#endif
#ifndef MK_PHMASK
#define MK_PHMASK 0x3ff
#endif
#define IN(k) (lo <= (k) && (k) < hi)
#define EN(j) ((MK_PHMASK >> (j)) & 1)
#define PHASE_BEGIN() do { int t_ = threadIdx.x; asm volatile("" : "+v"(t_)); F.tid = t_; F.lane = t_ & 63; } while (0)
#define SEAM(k) do { if (IN(k) && IN((k) + 1)) xcd_barrier(bar); } while (0)
    bf16_t* const HB0 = (bf16_t*)(ws + WS_HB); bf16_t* const HB1 = (bf16_t*)(ws + WS_HB2); float* const H = (float*)(ws + WS_H); float* const SS = (float*)(ws + WS_SS);
    bf16_t* const Qb = (bf16_t*)(ws + WS_Q); bf16_t* const Kb = (bf16_t*)(ws + WS_K); bf16_t* const Vb = (bf16_t*)(ws + WS_V); bf16_t* const Ob = (bf16_t*)(ws + WS_O);
    float* const rstd_moe = (float*)(ws + WS_RSTD) + NTOK; float* const rstd_ple = rstd_moe + NTOK;
    int* const tok_of = (int*)(ws + WS_TOK); float* const gate_of = (float*)(ws + WS_GATE); unsigned* const pair = (unsigned*)(ws + WS_PAIR);
    bf16_t* const ACT = (bf16_t*)(ws + WS_ACT); bf16_t* const Yb = (bf16_t*)(ws + WS_Y); float* const FL = (float*)(ws + WS_FL);
    LAS int* const tstartL = (LAS int*)(F.lds + TBL_OFF); LAS int* const cntL = tstartL + 64; LAS unsigned short* const tokL = (LAS unsigned short*)(F.lds + TOK_OFF); LAS float* const rowL = (LAS float*)(F.lds + ROW_OFF);

    if (EN(8) && IN(0)) { p0_prologue(F, args); }
    SEAM(0);
    for (int L = 0; L < DEPTH; ++L) {
        const int pb = 1 + 8 * L;
        unsigned* const cnt = F.ctl + CW_CNT + 64 * L;
        bf16_t* const HBa = (L & 1) ? HB1 : HB0; bf16_t* const HBb = (L & 1) ? HB0 : HB1;
        if (EN(0) && IN(pb + 0)) { PHASE_BEGIN();
            if (MK_P0SUB & 1) if (L == 1) fgate_phase(F, HBa, (const bf16_t*)(ws + WS_WF), args.in[5], SS, FL);
            if (MK_P0SUB & 2) { pg8::DenseOrder S; S.init(NTOK, 3 * DM, F.G, (int)blockIdx.x); pg8::EpiQKV E{Qb, rowL};
              _Pragma("clang loop unroll(disable)") for (int i0 = 0; i0 < TOK_UNITS; i0 += 2) { const int i = i0 + (F.wave >> 2); pg8::Unit u; if (S.next(i, u)) { const int lr = F.tid & 255; const f32x4* sp = (const f32x4*)(SS + (size_t)(u.arow0 + lr) * 16);
                  const f32x4 s0 = sp[0], s1 = sp[1], s2 = sp[2], s3 = sp[3]; const float ss = ((s0.x + s0.y) + (s0.z + s0.w)) + ((s1.x + s1.y) + (s1.z + s1.w)) + ((s2.x + s2.y) + (s2.z + s2.w)) + ((s3.x + s3.y) + (s3.z + s3.w));
                  rowL[i * 256 + lr] = rsqrtf(ss * (1.f / DM) + EPS); } }
              __syncthreads();
              pg8::gemm_phase(F.lds, HBa, (const bf16_t*)(ws + WS_WQKV) + (size_t)L * 3 * DM * DM, DM, S, E); }
            if (MK_P0SUB & 4) if (L == 0) { pg8::PJOrder S; S.init(F.G, (int)blockIdx.x); pg8::EpiPJ E{(bf16_t*)(ws + WS_PJ)};
                pg8::gemm_phase(F.lds, (const bf16_t*)(ws + WS_PB), (const bf16_t*)(ws + WS_WP), PLE, S, E); }
        }
        SEAM(pb + 0);
        if (EN(1) && IN(pb + 1)) { PHASE_BEGIN();
            for (int bh = blockIdx.x; bh < NB * NH; bh += F.G) { if (L == 0) attn_sb_head(F, bh, Qb, Kb, Vb, Ob); else attn_fox_head(F, bh, Qb, Kb, Vb, FL, Ob); }
        }
        SEAM(pb + 1);
        if (EN(2) && IN(pb + 2)) { PHASE_BEGIN();
            pg8::DenseOrder S; S.init(NTOK, DM, F.G, (int)blockIdx.x); pg8::EpiWo E{(L == 0) ? args.in[0] : (const float*)H, H, HBb};
            pg8::gemm_phase(F.lds, Ob, (const bf16_t*)(ws + WS_WO) + (size_t)L * DM * DM, DM, S, E);
        }
        SEAM(pb + 2);
        if (EN(3) && IN(pb + 3)) { PHASE_BEGIN(); router_phase(F, HBb, (const bf16_t*)(ws + WS_WR) + (size_t)L * NE * DM, args.in[9] + L * NE, rstd_moe, cnt, tok_of, gate_of, pair); }
        SEAM(pb + 3);
        if (EN(4) && IN(pb + 4)) { PHASE_BEGIN();
            moe_tables(F, cnt);
            pg8::MoeOrder S; S.NN = 8; S.nwg = tstartL[NE] * 8; S.G = F.G; S.c = (int)blockIdx.x; S.tstartL = tstartL; S.cntL = cntL; S.tokL = tokL; S.gather = true;
            _Pragma("clang loop unroll(disable)") for (int i0 = 0; i0 < TOK_UNITS; i0 += 2) { const int i = i0 + (F.wave >> 2); pg8::Unit u;
                if (S.next(i, u)) { const int lr = F.tid & 255; const int rk = u.rank0 + lr; const int tok = tok_of[(size_t)u.e * CAP + (rk < u.cnt ? rk : u.rank0)]; tokL[i * 256 + lr] = (unsigned short)tok; rowL[i * 256 + lr] = rstd_moe[tok]; } }
            __syncthreads();
            pg8::EpiGU E{ACT, args.in[11] + (size_t)L * NE * 2 * FF, rowL};
            pg8::gemm_phase(F.lds, HBb, (const bf16_t*)(ws + WS_WGU) + (size_t)L * NE * 2 * FF * DM, DM, S, E);
        }
        SEAM(pb + 4);
        if (EN(5) && IN(pb + 5)) { PHASE_BEGIN();
            moe_tables(F, cnt);
            pg8::MoeOrder S; S.NN = 4; S.nwg = tstartL[NE] * 4; S.G = F.G; S.c = (int)blockIdx.x; S.tstartL = tstartL; S.cntL = cntL; S.tokL = tokL; S.gather = false;
            _Pragma("clang loop unroll(disable)") for (int i0 = 0; i0 < TOK_UNITS; i0 += 2) { const int i = i0 + (F.wave >> 2); pg8::Unit u;
                if (S.next(i, u)) { const int lr = F.tid & 255; const int rk = u.rank0 + lr; rowL[i * 256 + lr] = (rk < u.cnt) ? gate_of[(size_t)u.e * CAP + rk] : 0.f; } }
            __syncthreads();
            pg8::EpiDown E{Yb, args.in[13] + (size_t)L * NE * DM, rowL};
            pg8::gemm_phase(F.lds, ACT, (const bf16_t*)(ws + WS_WD) + (size_t)L * NE * DM * FF, FF, S, E);
        }
        SEAM(pb + 5);
        if (EN(6) && IN(pb + 6)) { PHASE_BEGIN(); moe_tables(F, cnt); combine_phase(F, H, HBa, rstd_ple, pair, Yb); }
        SEAM(pb + 6);
        if (EN(7) && IN(pb + 7)) { PHASE_BEGIN();
            pg8::DenseOrder S; S.init(NTOK, DM, F.G, (int)blockIdx.x); pg8::EpiPLE E{H, HBb, (const bf16_t*)(ws + WS_PJ) + (size_t)L * NTOK * DM, rowL, SS};
            _Pragma("clang loop unroll(disable)") for (int i0 = 0; i0 < TOK_UNITS; i0 += 2) { const int i = i0 + (F.wave >> 2); pg8::Unit u; if (S.next(i, u)) { const int lr = F.tid & 255; rowL[i * 256 + lr] = rstd_ple[u.arow0 + lr]; } }
            __syncthreads();
            pg8::gemm_phase(F.lds, HBa, (const bf16_t*)(ws + WS_WG) + (size_t)L * DM * DM, DM, S, E);
        }
        SEAM(pb + 7);
    }
    if (EN(9) && IN(17)) { PHASE_BEGIN(); final_phase(F, H, SS, args.in[17], args.out); }
#undef IN
#undef SEAM
}
#define MK_MODE 2

#ifndef MK_MODE
#define MK_MODE 2
#endif
extern "C" void kernel_launch(void* const* d_in, const int* in_sizes, int n_in, void* d_out, int out_size, void* d_ws, size_t ws_size, hipStream_t stream) {
    if (n_in != 18 || in_sizes[0] != NTOK * DM || out_size != NTOK * DM || ws_size < WS_END2) { fprintf(stderr, "kernel_launch: unexpected shapes / workspace (%d inputs, ws %zu, need %zu)\n", n_in, ws_size, (size_t)WS_END2); return; }
    unsigned char* ws = (unsigned char*)d_ws;
    (void)hipMemsetAsync(ws + WS_CTL, 0, 1 * MiB, stream);
#if MK_MODE != 0
    static int grid = 0;
    if (grid == 0) {
        int dev = 0, cus = 0, per_cu = 0;
        if (hipGetDevice(&dev) != hipSuccess || hipDeviceGetAttribute(&cus, hipDeviceAttributeMultiprocessorCount, dev) != hipSuccess) { fprintf(stderr, "kernel_launch: device query failed\n"); grid = -1; return; }
        if (hipFuncSetAttribute((const void*)mega_fwd, hipFuncAttributeMaxDynamicSharedMemorySize, MK_LDS_BYTES) != hipSuccess) { fprintf(stderr, "kernel_launch: hipFuncSetAttribute failed\n"); grid = -1; return; }
        if (hipOccupancyMaxActiveBlocksPerMultiprocessor(&per_cu, (const void*)mega_fwd, MK_WAVES * 64, MK_LDS_BYTES) != hipSuccess || per_cu < 1) fprintf(stderr, "kernel_launch: occupancy query reports %d\n", per_cu);
        (void)hipGetLastError();
        grid = cus;
        grid -= grid % 8;
    }
    if (grid <= 0) return;
    MArgs a{};
    for (int i = 0; i < 18; ++i) a.in[i] = (const float*)d_in[i];
    a.out = (float*)d_out; a.ws = ws;
#if MK_MODE == 2
    a.ph_lo = 0; a.ph_hi = N_PHASES;
    hipLaunchKernelGGL(mega_fwd, dim3(grid), dim3(MK_WAVES * 64), MK_LDS_BYTES, stream, a);
#else
    for (int ph = 0; ph < N_PHASES; ++ph) { a.ph_lo = ph; a.ph_hi = ph + 1; hipLaunchKernelGGL(mega_fwd, dim3(grid), dim3(MK_WAVES * 64), MK_LDS_BYTES, stream, a); }
#endif
    { const hipError_t le = hipPeekAtLastError(); if (le != hipSuccess) fprintf(stderr, "kernel_launch: launch failed: %s\n", hipGetErrorName(le)); }
#else
    const float* x = (const float*)d_in[0]; const float* p = (const float*)d_in[1]; const float* g_mix = (const float*)d_in[2]; const float* w_qkv = (const float*)d_in[3];
    const float* w_fgate = (const float*)d_in[4]; const float* b_fgate = (const float*)d_in[5]; const float* w_o = (const float*)d_in[6]; const float* g_moe = (const float*)d_in[7];
    const float* w_router = (const float*)d_in[8]; const float* b_router = (const float*)d_in[9]; const float* w_gu = (const float*)d_in[10]; const float* b_gu = (const float*)d_in[11];
    const float* w_down = (const float*)d_in[12]; const float* b_down = (const float*)d_in[13]; const float* g_ple = (const float*)d_in[14]; const float* w_ple_gate = (const float*)d_in[15];
    const float* w_ple_proj = (const float*)d_in[16]; const float* g_final = (const float*)d_in[17];
    unsigned* ctl = (unsigned*)(ws + WS_CTL);
    bf16_t *Wqkv = (bf16_t*)(ws + WS_WQKV), *Wo = (bf16_t*)(ws + WS_WO), *Wg = (bf16_t*)(ws + WS_WG), *Wp = (bf16_t*)(ws + WS_WP), *Wgu = (bf16_t*)(ws + WS_WGU), *Wd = (bf16_t*)(ws + WS_WD);
    float* H = (float*)(ws + WS_H); bf16_t *HB = (bf16_t*)(ws + WS_HB), *Q = (bf16_t*)(ws + WS_Q), *Kb = (bf16_t*)(ws + WS_K), *Vb = (bf16_t*)(ws + WS_V), *O = (bf16_t*)(ws + WS_O);
    bf16_t *PB = (bf16_t*)(ws + WS_PB), *PJ = (bf16_t*)(ws + WS_PJ), *ACT = (bf16_t*)(ws + WS_ACT), *Y = (bf16_t*)(ws + WS_Y);
    int* tok_of = (int*)(ws + WS_TOK); float* gate_of = (float*)(ws + WS_GATE); unsigned* pair = (unsigned*)(ws + WS_PAIR);
    float* rstd_mix = (float*)(ws + WS_RSTD); float* rstd_moe = rstd_mix + NTOK; float* rstd_ple = rstd_moe + NTOK;
    float* FL = (float*)(ws + WS_FL); float* CB = (float*)(ws + WS_CB);
    for (int i = 0; i < DEPTH; ++i) {
        k_cvt_t<0><<<dim3(3 * DM / 64, DM / 64, 1), 256, 0, stream>>>(w_qkv + (size_t)i * DM * 3 * DM, g_mix + i * DM, Wqkv + (size_t)i * 3 * DM * DM, DM, 3 * DM);
        k_cvt_t<0><<<dim3(DM / 64, DM / 64, 1), 256, 0, stream>>>(w_o + (size_t)i * DM * DM, nullptr, Wo + (size_t)i * DM * DM, DM, DM);
        k_cvt_t<0><<<dim3(DM / 64, DM / 64, 1), 256, 0, stream>>>(w_ple_gate + (size_t)i * DM * DM, g_ple + i * DM, Wg + (size_t)i * DM * DM, DM, DM);
        k_cvt_t<0><<<dim3(DM / 64, PLE / 64, 1), 256, 0, stream>>>(w_ple_proj + (size_t)i * PLE * DM, nullptr, Wp + (size_t)i * DM * PLE, PLE, DM);
        k_cvt_t<1><<<dim3(2 * FF / 64, DM / 64, NE), 256, 0, stream>>>(w_gu + (size_t)i * NE * DM * 2 * FF, g_moe + i * DM, Wgu + (size_t)i * NE * 2 * FF * DM, DM, 2 * FF);
        k_cvt_t<0><<<dim3(DM / 64, FF / 64, NE), 256, 0, stream>>>(w_down + (size_t)i * NE * FF * DM, nullptr, Wd + (size_t)i * NE * DM * FF, FF, DM);
    }
    k_cvt<<<(unsigned)((size_t)DEPTH * NTOK * PLE / 4 / 256), 256, 0, stream>>>(p, PB, (size_t)DEPTH * NTOK * PLE / 4);
    for (int i = 0; i < DEPTH; ++i)
        k_gemm_pj<<<dim3(DM / 64, NTOK / 64), 64, 0, stream>>>(PB + (size_t)i * NTOK * PLE, Wp + (size_t)i * DM * PLE, PJ + (size_t)i * NTOK * DM);
    k_rowstat<<<NTOK / 4, 256, 0, stream>>>(x, HB, rstd_mix);
    for (int i = 0; i < DEPTH; ++i) {
        const float* hin = (i == 0) ? x : H;
        k_gemm_qkv<<<dim3(3 * DM / 64, NTOK / 64), 64, 0, stream>>>(HB, Wqkv + (size_t)i * 3 * DM * DM, rstd_mix, Q);
        if (i == 0) k_attn_sb<<<NB * NH * SEQ / 4, 256, 0, stream>>>(Q, Kb, Vb, O);
        else {
            k_fgate<<<NTOK / 4, 256, 0, stream>>>(hin, g_mix + i * DM, w_fgate, b_fgate, rstd_mix, FL);
            k_scan<<<NB * NH, 64, 0, stream>>>(FL, CB);
            k_attn_fox<<<NB * NH * SEQ / 4, 256, 0, stream>>>(Q, Kb, Vb, CB, O);
        }
        k_gemm_wo<<<dim3(DM / 64, NTOK / 64), 64, 0, stream>>>(O, Wo + (size_t)i * DM * DM, hin, H, HB);
        unsigned* cnt = ctl + CW_CNT + 64 * i;
        k_router<<<NTOK / 4, 256, 0, stream>>>(H, g_moe + i * DM, w_router + (size_t)i * DM * NE, b_router + i * NE, rstd_moe, cnt, tok_of, gate_of, pair);
        k_gemm_gu<<<dim3(FF / 64, MAXT * 4), 64, 0, stream>>>(HB, Wgu + (size_t)i * NE * 2 * FF * DM, b_gu + (size_t)i * NE * 2 * FF, rstd_moe, cnt, tok_of, ACT);
        k_gemm_down<<<dim3(DM / 64, MAXT * 4), 64, 0, stream>>>(ACT, Wd + (size_t)i * NE * DM * FF, b_down + (size_t)i * NE * DM, cnt, gate_of, Y);
        k_combine<<<NTOK / 4, 256, 0, stream>>>(H, HB, rstd_ple, cnt, pair, Y);
        k_gemm_ple<<<dim3(DM / 64, NTOK / 64), 64, 0, stream>>>(HB, Wg + (size_t)i * DM * DM, rstd_ple, PJ + (size_t)i * NTOK * DM, H, HB);
        if (i + 1 < DEPTH) k_rowstat<<<NTOK / 4, 256, 0, stream>>>(H, HB, rstd_mix);
    }
    k_final<<<NTOK / 4, 256, 0, stream>>>(H, g_final, (float*)d_out);
#endif
}
```

```cpp
#include <hip/hip_runtime.h>
#include <cstdio>
#include <cstdint>

typedef unsigned short bf16_t;
typedef short bf16x8 __attribute__((ext_vector_type(8)));
typedef float f32x4 __attribute__((ext_vector_type(4)));
typedef float f32x16 __attribute__((ext_vector_type(16)));
typedef unsigned u32x4 __attribute__((ext_vector_type(4)));
typedef unsigned u32x2 __attribute__((ext_vector_type(2)));

constexpr int NTOK = 32768, DM = 1024, SEQ = 2048, NB = 16, NH = 16, HD = 64, NE = 32, TOPK = 4, FF = 1024, PLE = 256, DEPTH = 2;
constexpr int CAP = NTOK;
constexpr int MAXT = 544;
constexpr int NSLOT = MAXT * 256;
constexpr float EPS = 1e-6f;
constexpr float LOG2E = 1.4426950408889634f;
constexpr float C2 = 0.125f * LOG2E;

constexpr size_t MiB = 1u << 20;
constexpr size_t WS_CTL = 0;
constexpr size_t WS_WQKV = 2 * MiB;
constexpr size_t WS_WO = WS_WQKV + 12 * MiB;
constexpr size_t WS_WG = WS_WO + 4 * MiB;
constexpr size_t WS_WP = WS_WG + 4 * MiB;
constexpr size_t WS_WGU = WS_WP + 2 * MiB;
constexpr size_t WS_WD = WS_WGU + 256 * MiB;
constexpr size_t WS_H = WS_WD + 128 * MiB;
constexpr size_t WS_HB = WS_H + 128 * MiB;
constexpr size_t WS_Q = WS_HB + 64 * MiB;
constexpr size_t WS_K = WS_Q + 64 * MiB;
constexpr size_t WS_V = WS_K + 64 * MiB;
constexpr size_t WS_O = WS_V + 64 * MiB;
constexpr size_t WS_PB = WS_O + 64 * MiB;
constexpr size_t WS_PJ = WS_PB + 32 * MiB;
constexpr size_t WS_ACT = WS_PJ + 128 * MiB;
constexpr size_t WS_Y = WS_ACT + 272 * MiB;
constexpr size_t WS_TOK = WS_Y + 272 * MiB;
constexpr size_t WS_GATE = WS_TOK + 4 * MiB;
constexpr size_t WS_PAIR = WS_GATE + 4 * MiB;
constexpr size_t WS_RSTD = WS_PAIR + 1 * MiB;
constexpr size_t WS_FL = WS_RSTD + 1 * MiB;
constexpr size_t WS_CB = WS_FL + 2 * MiB;
constexpr size_t WS_END = WS_CB + 2 * MiB;
constexpr int CW_CNT = 64;

__device__ __forceinline__ float bf2f(bf16_t v) { return __uint_as_float((unsigned)v << 16); }
__device__ __forceinline__ unsigned f2bf(float f) { unsigned u = __float_as_uint(f); return (u + 0x7fffu + ((u >> 16) & 1u)) >> 16; }
__device__ __forceinline__ unsigned pk2(float lo, float hi) { return f2bf(lo) | (f2bf(hi) << 16); }
__device__ __forceinline__ float wave_sum(float v) {
#pragma unroll
    for (int o = 1; o < 64; o <<= 1) v += __shfl_xor(v, o);
    return v;
}
__device__ __forceinline__ float wave_max(float v) {
#pragma unroll
    for (int o = 1; o < 64; o <<= 1) v = fmaxf(v, __shfl_xor(v, o));
    return v;
}
__device__ __forceinline__ int crow(int r, int hi) { return (r & 3) + 8 * (r >> 2) + 4 * hi; }
__device__ __forceinline__ float sigmoidf_(float x) { return 1.f / (1.f + __expf(-x)); }
__device__ __forceinline__ float log_sigmoid(float x) { return fminf(x, 0.f) - log1pf(__expf(-fabsf(x))); }

struct MoeTile { int e, rank0, cnt, tstart; bool ok; };
__device__ __forceinline__ MoeTile moe_tile(const unsigned* cnt, int T) {
    const int lane = threadIdx.x & 63;
    const int c = (lane < NE) ? (int)cnt[lane] : 0;
    const int nt = (c + 255) >> 8;
    int incl = nt;
#pragma unroll
    for (int o = 1; o < 32; o <<= 1) { int t = __shfl_up(incl, o); if ((lane & 31) >= o) incl += t; }
    const int excl = incl - nt;
    const unsigned long long m = __ballot(lane < NE && excl <= T && nt > 0 && T < incl);
    MoeTile r; r.ok = (m != 0ull);
    const int e = r.ok ? (int)__builtin_ctzll(m) : 0;
    r.e = e; r.tstart = __shfl(excl, e); r.cnt = __shfl(c, e); r.rank0 = (T - r.tstart) * 256;
    return r;
}
__device__ __forceinline__ int moe_tstart(const unsigned* cnt, int e) {
    const int lane = threadIdx.x & 63;
    const int c = (lane < NE) ? (int)cnt[lane] : 0;
    const int nt = (c + 255) >> 8;
    int incl = nt;
#pragma unroll
    for (int o = 1; o < 32; o <<= 1) { int t = __shfl_up(incl, o); if ((lane & 31) >= o) incl += t; }
    return __shfl(incl - nt, e);
}

__global__ void __launch_bounds__(256) k_rowstat(const float* __restrict__ h, bf16_t* __restrict__ hb, float* __restrict__ rstd) {
    const int lane = threadIdx.x & 63, row = blockIdx.x * 4 + (threadIdx.x >> 6);
    const f32x4* p = (const f32x4*)(h + (size_t)row * DM) + lane;
    f32x4 v[4]; float s = 0.f;
#pragma unroll
    for (int j = 0; j < 4; ++j) { v[j] = p[64 * j]; s += v[j].x * v[j].x + v[j].y * v[j].y + v[j].z * v[j].z + v[j].w * v[j].w; }
    s = wave_sum(s);
    if (lane == 0) rstd[row] = rsqrtf(s * (1.f / DM) + EPS);
    u32x2* o = (u32x2*)(hb + (size_t)row * DM) + lane;
#pragma unroll
    for (int j = 0; j < 4; ++j) { u32x2 w; w.x = pk2(v[j].x, v[j].y); w.y = pk2(v[j].z, v[j].w); o[64 * j] = w; }
}
__global__ void __launch_bounds__(256) k_cvt(const float* __restrict__ s, bf16_t* __restrict__ d, size_t n4) {
    size_t i = (size_t)blockIdx.x * 256 + threadIdx.x;
    if (i < n4) { f32x4 v = ((const f32x4*)s)[i]; u32x2 w; w.x = pk2(v.x, v.y); w.y = pk2(v.z, v.w); ((u32x2*)d)[i] = w; }
}
template <int MODE>
__global__ void __launch_bounds__(256) k_cvt_t(const float* __restrict__ src, const float* __restrict__ g, bf16_t* __restrict__ dst, int K, int N) {
    __shared__ float tile[64][65];
    const int n0 = blockIdx.x * 64, k0 = blockIdx.y * 64, b = blockIdx.z, tid = threadIdx.x;
    const float* s = src + (size_t)b * K * N; bf16_t* d = dst + (size_t)b * K * N;
#pragma unroll
    for (int i = 0; i < 16; ++i) { const int kk = i * 4 + (tid >> 6), nn = tid & 63; const float gg = g ? g[k0 + kk] : 1.f; tile[kk][nn] = s[(size_t)(k0 + kk) * N + n0 + nn] * gg; }
    __syncthreads();
#pragma unroll
    for (int j = 0; j < 2; ++j) {
        const int c = tid + 256 * j, n = c >> 3, kc = c & 7;
        u32x4 w; w.x = pk2(tile[kc * 8 + 0][n], tile[kc * 8 + 1][n]); w.y = pk2(tile[kc * 8 + 2][n], tile[kc * 8 + 3][n]);
        w.z = pk2(tile[kc * 8 + 4][n], tile[kc * 8 + 5][n]); w.w = pk2(tile[kc * 8 + 6][n], tile[kc * 8 + 7][n]);
        int nn = n0 + n;
        if (MODE == 1) { const int half = nn / FF, j2 = nn % FF; nn = (j2 >> 7) * 256 + half * 128 + (j2 & 127); }
        *(u32x4*)(d + (size_t)nn * K + k0 + kc * 8) = w;
    }
}

template <bool DUAL>
__device__ __forceinline__ void gemm_tile64(const bf16_t* a0, const bf16_t* a1, const bf16_t* B1, const bf16_t* B2, int K, f32x16 (&acc)[2][2], f32x16 (&acc2)[2][2]) {
    const int lane = threadIdx.x & 63, r32 = lane & 31, hi = lane >> 5;
    const bf16_t* b0 = B1 + (size_t)r32 * K + 8 * hi; const bf16_t* b1 = B1 + (size_t)(32 + r32) * K + 8 * hi;
    const bf16_t* c0 = DUAL ? B2 + (size_t)r32 * K + 8 * hi : nullptr; const bf16_t* c1 = DUAL ? B2 + (size_t)(32 + r32) * K + 8 * hi : nullptr;
    a0 += 8 * hi; a1 += 8 * hi;
#pragma unroll
    for (int i = 0; i < 2; ++i)
#pragma unroll
        for (int j = 0; j < 2; ++j) { acc[i][j] = f32x16{}; acc2[i][j] = f32x16{}; }
    for (int k = 0; k < K; k += 16) {
        const bf16x8 fa0 = *(const bf16x8*)(a0 + k), fa1 = *(const bf16x8*)(a1 + k), fb0 = *(const bf16x8*)(b0 + k), fb1 = *(const bf16x8*)(b1 + k);
        acc[0][0] = __builtin_amdgcn_mfma_f32_32x32x16_bf16(fa0, fb0, acc[0][0], 0, 0, 0);
        acc[0][1] = __builtin_amdgcn_mfma_f32_32x32x16_bf16(fa0, fb1, acc[0][1], 0, 0, 0);
        acc[1][0] = __builtin_amdgcn_mfma_f32_32x32x16_bf16(fa1, fb0, acc[1][0], 0, 0, 0);
        acc[1][1] = __builtin_amdgcn_mfma_f32_32x32x16_bf16(fa1, fb1, acc[1][1], 0, 0, 0);
        if (DUAL) {
            const bf16x8 fc0 = *(const bf16x8*)(c0 + k), fc1 = *(const bf16x8*)(c1 + k);
            acc2[0][0] = __builtin_amdgcn_mfma_f32_32x32x16_bf16(fa0, fc0, acc2[0][0], 0, 0, 0);
            acc2[0][1] = __builtin_amdgcn_mfma_f32_32x32x16_bf16(fa0, fc1, acc2[0][1], 0, 0, 0);
            acc2[1][0] = __builtin_amdgcn_mfma_f32_32x32x16_bf16(fa1, fc0, acc2[1][0], 0, 0, 0);
            acc2[1][1] = __builtin_amdgcn_mfma_f32_32x32x16_bf16(fa1, fc1, acc2[1][1], 0, 0, 0);
        }
    }
}
#define TILE_FOREACH(...) _Pragma("unroll") for (int mi = 0; mi < 2; ++mi) _Pragma("unroll") for (int ni = 0; ni < 2; ++ni) _Pragma("unroll") for (int r = 0; r < 16; ++r) { \
        const int lrow = 32 * mi + crow(r, hi), lcol = 32 * ni + r32; const float v = acc[mi][ni][r]; const float v2 = acc2[mi][ni][r]; (void)v2; __VA_ARGS__ }

__global__ void __launch_bounds__(64) k_gemm_qkv(const bf16_t* __restrict__ A, const bf16_t* __restrict__ Bt, const float* __restrict__ rstd, bf16_t* __restrict__ Q) {
    const int lane = threadIdx.x, r32 = lane & 31, hi = lane >> 5; const int m0 = blockIdx.y * 64, n0 = blockIdx.x * 64;
    f32x16 acc[2][2], acc2[2][2];
    gemm_tile64<false>(A + (size_t)(m0 + r32) * DM, A + (size_t)(m0 + 32 + r32) * DM, Bt + (size_t)n0 * DM, nullptr, DM, acc, acc2);
    const int t = n0 / DM; bf16_t* out = Q + (size_t)t * ((WS_K - WS_Q) / 2); const float sc = (t == 0) ? C2 : 1.f;
    TILE_FOREACH({ const int row = m0 + lrow, col = n0 - t * DM + lcol; out[(size_t)row * DM + col] = (bf16_t)f2bf(v * rstd[row] * sc); })
}
__global__ void __launch_bounds__(64) k_gemm_wo(const bf16_t* __restrict__ A, const bf16_t* __restrict__ Bt, const float* hin, float* hout, bf16_t* __restrict__ hb) {
    const int lane = threadIdx.x, r32 = lane & 31, hi = lane >> 5; const int m0 = blockIdx.y * 64, n0 = blockIdx.x * 64;
    f32x16 acc[2][2], acc2[2][2];
    gemm_tile64<false>(A + (size_t)(m0 + r32) * DM, A + (size_t)(m0 + 32 + r32) * DM, Bt + (size_t)n0 * DM, nullptr, DM, acc, acc2);
    TILE_FOREACH({ const size_t o = (size_t)(m0 + lrow) * DM + n0 + lcol; const float x = hin[o] + v; hout[o] = x; hb[o] = (bf16_t)f2bf(x); })
}
__global__ void __launch_bounds__(64) k_gemm_pj(const bf16_t* __restrict__ A, const bf16_t* __restrict__ Bt, bf16_t* __restrict__ PJ) {
    const int lane = threadIdx.x, r32 = lane & 31, hi = lane >> 5; const int m0 = blockIdx.y * 64, n0 = blockIdx.x * 64;
    f32x16 acc[2][2], acc2[2][2];
    gemm_tile64<false>(A + (size_t)(m0 + r32) * PLE, A + (size_t)(m0 + 32 + r32) * PLE, Bt + (size_t)n0 * PLE, nullptr, PLE, acc, acc2);
    TILE_FOREACH({ PJ[(size_t)(m0 + lrow) * DM + n0 + lcol] = (bf16_t)f2bf(v); })
}
__global__ void __launch_bounds__(64) k_gemm_ple(const bf16_t* __restrict__ A, const bf16_t* __restrict__ Bt, const float* __restrict__ rstd, const bf16_t* __restrict__ PJ, float* h, bf16_t* hb) {
    const int lane = threadIdx.x, r32 = lane & 31, hi = lane >> 5; const int m0 = blockIdx.y * 64, n0 = blockIdx.x * 64;
    f32x16 acc[2][2], acc2[2][2];
    gemm_tile64<false>(A + (size_t)(m0 + r32) * DM, A + (size_t)(m0 + 32 + r32) * DM, Bt + (size_t)n0 * DM, nullptr, DM, acc, acc2);
    TILE_FOREACH({ const int row = m0 + lrow; const size_t o = (size_t)row * DM + n0 + lcol; const float x = h[o] + sigmoidf_(v * rstd[row]) * bf2f(PJ[o]); h[o] = x; })
}
__global__ void __launch_bounds__(64) k_gemm_gu(const bf16_t* __restrict__ HB, const bf16_t* __restrict__ Wgu, const float* __restrict__ bgu, const float* __restrict__ rstd,
                                                const unsigned* __restrict__ cnt, const int* __restrict__ tok_of, bf16_t* __restrict__ ACT) {
    const int lane = threadIdx.x, r32 = lane & 31, hi = lane >> 5; const int rt = blockIdx.y, T = rt >> 2, j0 = blockIdx.x * 64;
    const MoeTile mt = moe_tile(cnt, T); if (!mt.ok) return;
    const int lr0 = (rt & 3) * 64; const int rk0 = mt.rank0 + lr0 + r32, rk1 = rk0 + 32;
    const int t0 = rk0 < mt.cnt ? tok_of[(size_t)mt.e * CAP + rk0] : 0, t1 = rk1 < mt.cnt ? tok_of[(size_t)mt.e * CAP + rk1] : 0;
    const bf16_t* Be = Wgu + (size_t)mt.e * 2048 * DM + (size_t)((j0 >> 7) * 256 + (j0 & 127)) * DM;
    f32x16 acc[2][2], acc2[2][2];
    gemm_tile64<true>(HB + (size_t)t0 * DM, HB + (size_t)t1 * DM, Be, Be + (size_t)128 * DM, DM, acc, acc2);
    const size_t slot0 = (size_t)T * 256 + lr0;
    TILE_FOREACH({ const int rk = mt.rank0 + lr0 + lrow; if (rk < mt.cnt) { const int tk = tok_of[(size_t)mt.e * CAP + rk]; const float rs = rstd[tk]; const int j = j0 + lcol;
        float gl = v * rs + bgu[(size_t)mt.e * 2048 + j], ln = v2 * rs + bgu[(size_t)mt.e * 2048 + FF + j];
        gl = fminf(gl, 7.f); ln = fminf(fmaxf(ln, -7.f), 7.f);
        const float a = gl * sigmoidf_(1.702f * gl) * (ln + 1.f);
        ACT[(slot0 + lrow) * FF + j] = (bf16_t)f2bf(a); } })
}
__global__ void __launch_bounds__(64) k_gemm_down(const bf16_t* __restrict__ ACT, const bf16_t* __restrict__ Wd, const float* __restrict__ bd, const unsigned* __restrict__ cnt,
                                                  const float* __restrict__ gate_of, bf16_t* __restrict__ Y) {
    const int lane = threadIdx.x, r32 = lane & 31, hi = lane >> 5; const int rt = blockIdx.y, T = rt >> 2, n0 = blockIdx.x * 64;
    const MoeTile mt = moe_tile(cnt, T); if (!mt.ok) return;
    const int lr0 = (rt & 3) * 64; const size_t slot0 = (size_t)T * 256 + lr0;
    const int rk0 = mt.rank0 + lr0 + r32, rk1 = rk0 + 32;
    const size_t s0 = rk0 < mt.cnt ? slot0 + r32 : (size_t)T * 256, s1 = rk1 < mt.cnt ? slot0 + 32 + r32 : (size_t)T * 256;
    f32x16 acc[2][2], acc2[2][2];
    gemm_tile64<false>(ACT + s0 * FF, ACT + s1 * FF, Wd + (size_t)mt.e * DM * FF + (size_t)n0 * FF, nullptr, FF, acc, acc2);
    TILE_FOREACH({ const int rk = mt.rank0 + lr0 + lrow; if (rk < mt.cnt) { const float gt = gate_of[(size_t)mt.e * CAP + rk]; const int n = n0 + lcol;
        Y[(slot0 + lrow) * DM + n] = (bf16_t)f2bf((v + bd[(size_t)mt.e * DM + n]) * gt); } })
}

__global__ void __launch_bounds__(256) k_router(const float* __restrict__ h, const float* __restrict__ g, const float* __restrict__ wr, const float* __restrict__ br,
                                                float* __restrict__ rstd, unsigned* cnt, int* __restrict__ tok_of, float* __restrict__ gate_of, unsigned* __restrict__ pair) {
    const int lane = threadIdx.x & 63, t = blockIdx.x * 4 + (threadIdx.x >> 6); const int e = lane & 31, half = lane >> 5;
    const float* hr = h + (size_t)t * DM;
    float ss = 0.f;
#pragma unroll
    for (int j = 0; j < 4; ++j) { const f32x4 v = ((const f32x4*)hr)[lane + 64 * j]; ss += v.x * v.x + v.y * v.y + v.z * v.z + v.w * v.w; }
    const float rs = rsqrtf(wave_sum(ss) * (1.f / DM) + EPS);
    float a = 0.f;
    for (int d = half * 512; d < half * 512 + 512; ++d) a += hr[d] * g[d] * wr[(size_t)d * NE + e];
    a += __shfl_xor(a, 32);
    float lg = a * rs + br[e];
    float tv[4]; int ti[4];
#pragma unroll
    for (int k = 0; k < 4; ++k) {
        float bv = lg; int bi = e;
#pragma unroll
        for (int o = 1; o < 32; o <<= 1) { const float ov = __shfl_xor(bv, o); const int oi = __shfl_xor(bi, o); if (ov > bv || (ov == bv && oi < bi)) { bv = ov; bi = oi; } }
        tv[k] = bv; ti[k] = bi; if (e == bi) lg = -INFINITY;
    }
    float w[4], sw = 0.f;
#pragma unroll
    for (int k = 0; k < 4; ++k) { w[k] = __expf(tv[k] - tv[0]); sw += w[k]; }
    if (lane == 0) rstd[t] = rs;
    if (lane < 4) {
        const int k = lane; const int ee = (k == 0) ? ti[0] : (k == 1) ? ti[1] : (k == 2) ? ti[2] : ti[3]; const float ww = (k == 0) ? w[0] : (k == 1) ? w[1] : (k == 2) ? w[2] : w[3];
        const unsigned rk = atomicAdd(&cnt[ee], 1u);
        tok_of[(size_t)ee * CAP + rk] = t; gate_of[(size_t)ee * CAP + rk] = ww / sw; pair[(size_t)t * 4 + k] = ((unsigned)ee << 16) | rk;
    }
}
__global__ void __launch_bounds__(256) k_combine(float* h, bf16_t* __restrict__ hb, float* __restrict__ rstd, const unsigned* __restrict__ cnt, const unsigned* __restrict__ pair, const bf16_t* __restrict__ Y) {
    const int lane = threadIdx.x & 63, t = blockIdx.x * 4 + (threadIdx.x >> 6);
    f32x4 v[4]; f32x4* hr = (f32x4*)(h + (size_t)t * DM) + lane;
#pragma unroll
    for (int j = 0; j < 4; ++j) v[j] = hr[64 * j];
    for (int k = 0; k < 4; ++k) {
        const unsigned pr = pair[(size_t)t * 4 + k]; const int e = pr >> 16, rk = pr & 0xffff;
        const size_t slot = (size_t)moe_tstart(cnt, e) * 256 + rk;
        const u32x2* yr = (const u32x2*)(Y + slot * DM) + lane;
#pragma unroll
        for (int j = 0; j < 4; ++j) { const u32x2 w = yr[64 * j]; v[j].x += __uint_as_float(w.x << 16); v[j].y += __uint_as_float(w.x & 0xffff0000u); v[j].z += __uint_as_float(w.y << 16); v[j].w += __uint_as_float(w.y & 0xffff0000u); }
    }
    float s = 0.f;
#pragma unroll
    for (int j = 0; j < 4; ++j) { hr[64 * j] = v[j]; s += v[j].x * v[j].x + v[j].y * v[j].y + v[j].z * v[j].z + v[j].w * v[j].w; }
    s = wave_sum(s); if (lane == 0) rstd[t] = rsqrtf(s * (1.f / DM) + EPS);
    u32x2* o = (u32x2*)(hb + (size_t)t * DM) + lane;
#pragma unroll
    for (int j = 0; j < 4; ++j) { u32x2 w; w.x = pk2(v[j].x, v[j].y); w.y = pk2(v[j].z, v[j].w); o[64 * j] = w; }
}
__global__ void __launch_bounds__(256) k_final(const float* __restrict__ h, const float* __restrict__ g, float* __restrict__ out) {
    const int lane = threadIdx.x & 63, row = blockIdx.x * 4 + (threadIdx.x >> 6);
    const f32x4* p = (const f32x4*)(h + (size_t)row * DM) + lane; f32x4 v[4]; float s = 0.f;
#pragma unroll
    for (int j = 0; j < 4; ++j) { v[j] = p[64 * j]; s += v[j].x * v[j].x + v[j].y * v[j].y + v[j].z * v[j].z + v[j].w * v[j].w; }
    const float rs = rsqrtf(wave_sum(s) * (1.f / DM) + EPS);
    f32x4* o = (f32x4*)(out + (size_t)row * DM) + lane;
#pragma unroll
    for (int j = 0; j < 4; ++j) { const f32x4 gg = ((const f32x4*)g)[lane + 64 * j]; o[64 * j] = v[j] * rs * gg; }
}
__global__ void __launch_bounds__(256) k_fgate(const float* __restrict__ h, const float* __restrict__ g, const float* __restrict__ wf, const float* __restrict__ bfg, const float* __restrict__ rstd, float* __restrict__ fl) {
    const int lane = threadIdx.x & 63, t = blockIdx.x * 4 + (threadIdx.x >> 6); const int hh = lane & 15, q = lane >> 4;
    const float* hr = h + (size_t)t * DM; float a = 0.f;
    for (int d = q * 256; d < q * 256 + 256; ++d) a += hr[d] * g[d] * wf[(size_t)d * NH + hh];
    a += __shfl_xor(a, 16); a += __shfl_xor(a, 32);
    if (lane < 16) fl[(size_t)t * NH + hh] = a * rstd[t] + bfg[hh];
}
__global__ void __launch_bounds__(64) k_scan(const float* __restrict__ fl, float* __restrict__ cb) {
    const int lane = threadIdx.x, bh = blockIdx.x, b = bh / NH, hh = bh % NH;
    float loc[32]; float run = 0.f;
#pragma unroll
    for (int i = 0; i < 32; ++i) { run += log_sigmoid(fl[(size_t)(b * SEQ + lane * 32 + i) * NH + hh]); loc[i] = run; }
    float incl = run;
#pragma unroll
    for (int o = 1; o < 64; o <<= 1) { const float t = __shfl_up(incl, o); if (lane >= o) incl += t; }
    const float base = incl - run;
#pragma unroll
    for (int i = 0; i < 32; ++i) cb[(size_t)bh * SEQ + lane * 32 + i] = (base + loc[i]) * LOG2E;
}

__device__ __forceinline__ float dot64(const float (&q)[64], const bf16_t* kr) {
    float a = 0.f;
#pragma unroll
    for (int c = 0; c < 8; ++c) { const u32x4 w = ((const u32x4*)kr)[c];
        a += q[8 * c + 0] * __uint_as_float(w.x << 16) + q[8 * c + 1] * __uint_as_float(w.x & 0xffff0000u) + q[8 * c + 2] * __uint_as_float(w.y << 16) + q[8 * c + 3] * __uint_as_float(w.y & 0xffff0000u)
           + q[8 * c + 4] * __uint_as_float(w.z << 16) + q[8 * c + 5] * __uint_as_float(w.z & 0xffff0000u) + q[8 * c + 6] * __uint_as_float(w.w << 16) + q[8 * c + 7] * __uint_as_float(w.w & 0xffff0000u); }
    return a;
}
__device__ __forceinline__ void loadq(float (&q)[64], const bf16_t* qr) {
#pragma unroll
    for (int c = 0; c < 8; ++c) { const u32x4 w = ((const u32x4*)qr)[c];
        q[8 * c + 0] = __uint_as_float(w.x << 16); q[8 * c + 1] = __uint_as_float(w.x & 0xffff0000u); q[8 * c + 2] = __uint_as_float(w.y << 16); q[8 * c + 3] = __uint_as_float(w.y & 0xffff0000u);
        q[8 * c + 4] = __uint_as_float(w.z << 16); q[8 * c + 5] = __uint_as_float(w.z & 0xffff0000u); q[8 * c + 6] = __uint_as_float(w.w << 16); q[8 * c + 7] = __uint_as_float(w.w & 0xffff0000u); }
}
__global__ void __launch_bounds__(256) k_attn_sb(const bf16_t* __restrict__ Q, const bf16_t* __restrict__ K, const bf16_t* __restrict__ V, bf16_t* __restrict__ O) {
    const int lane = threadIdx.x & 63; const int gw = blockIdx.x * 4 + (threadIdx.x >> 6); const int t = gw % SEQ, bh = gw / SEQ, b = bh / NH, hh = bh % NH;
    const size_t rowb = (size_t)b * SEQ; float q[64]; loadq(q, Q + (rowb + t) * DM + hh * HD);
    float o = 0.f, carry = 1.f;
    for (int jt = (t - 1) >> 6; jt >= 0 && t > 0; --jt) {
        const int s = 64 * jt + lane; const bool valid = s < t;
        float x = dot64(q, K + (rowb + s) * DM + hh * HD); x = fminf(x, 64.f);
        const float ex = exp2f(x), r = 1.f / (1.f + ex);
        const float beta = valid ? ex * r : 0.f, nb = valid ? r : 1.f;
        float P = nb;
#pragma unroll
        for (int off = 1; off < 64; off <<= 1) { const float t2 = __shfl_down(P, off); if (lane + off < 64) P *= t2; }
        float Pex = __shfl_down(P, 1); if (lane == 63) Pex = 1.f;
        const float a = beta * carry * Pex;
        carry *= __shfl(P, 0);
        const bf16_t* vb = V + (rowb + 64 * jt) * DM + hh * HD + lane;
        for (int l = 0; l < 64; ++l) { const float al = __shfl(a, l); o += al * bf2f(vb[(size_t)l * DM]); }
        if (carry < 1e-30f) break;
    }
    O[(rowb + t) * DM + hh * HD + lane] = (bf16_t)f2bf(o);
}
__global__ void __launch_bounds__(256) k_attn_fox(const bf16_t* __restrict__ Q, const bf16_t* __restrict__ K, const bf16_t* __restrict__ V, const float* __restrict__ cb, bf16_t* __restrict__ O) {
    const int lane = threadIdx.x & 63; const int gw = blockIdx.x * 4 + (threadIdx.x >> 6); const int t = gw % SEQ, bh = gw / SEQ, b = bh / NH, hh = bh % NH;
    const size_t rowb = (size_t)b * SEQ; float q[64]; loadq(q, Q + (rowb + t) * DM + hh * HD);
    float o = 0.f, m = -INFINITY, l = 0.f;
    for (int jt = 0; jt <= (t >> 6); ++jt) {
        const int s = 64 * jt + lane; const bool valid = s <= t;
        float x = dot64(q, K + (rowb + s) * DM + hh * HD) - cb[(size_t)bh * SEQ + s];
        x = valid ? x : -INFINITY;
        const float mn = fmaxf(m, wave_max(x)); const float alpha = exp2f(m - mn); const float p = exp2f(x - mn);
        l = l * alpha + wave_sum(p); o *= alpha; m = mn;
        const bf16_t* vb = V + (rowb + 64 * jt) * DM + hh * HD + lane;
        const int nl = min(64, t - 64 * jt + 1);
        for (int i = 0; i < nl; ++i) { const float pi = __shfl(p, i); o += pi * bf2f(vb[(size_t)i * DM]); }
    }
    O[(rowb + t) * DM + hh * HD + lane] = (bf16_t)f2bf(o / l);
}


#include <hip/hip_bf16.h>
#include <cmath>
namespace attn_body {
using bf16=__hip_bfloat16;
using bf16x8=__attribute__((ext_vector_type(8)))short;
using s16x4=__attribute__((ext_vector_type(4)))short;
using f32x16=__attribute__((ext_vector_type(16)))float;
using u32x4=__attribute__((ext_vector_type(4)))unsigned;
constexpr int BATCH=16,NHEAD=16,SEQ=2048,D=64,DM=NHEAD*D;
constexpr int NW=8,QBLK=32,QB=QBLK*NW,KVBLK=64,NQB=SEQ/QB;
constexpr int ATTN_PITCH=DM, ATTN_UNIT_ROWS=QB;
__device__ __forceinline__ int crow(int r,int hi){return (r&3)+8*(r>>2)+4*hi;}
#define SBAR() __builtin_amdgcn_sched_barrier(0)
__device__ __forceinline__ void cmask(f32x16&p0,f32x16&p1,int jb,int qrel,int hi){
  const float NEG=-INFINITY; int kb=64*jb+4*hi;
  #pragma unroll
  for(int r=0;r<16;++r){int kv=kb+(r&3)+8*(r>>2); if(kv>qrel)p0[r]=NEG; if(kv+32>qrel)p1[r]=NEG;}
}

constexpr int NSLOT=3, SLOTB=8192;
constexpr int LDS_K=0, LDS_V=NSLOT*SLOTB, LDS_WS=2*NSLOT*SLOTB, LDS_OST=LDS_WS+NW*64*4, LDS_BYTES=LDS_OST+NW*4096;
constexpr float C2=0.125f*1.4426950408889634f;
__device__ __forceinline__ void glds16(const void*gsrc,unsigned lds_dst){unsigned keep;
  asm volatile("s_mov_b32 %0, m0\n\ts_mov_b32 m0, %2\n\ts_nop 0\n\tglobal_load_lds_dwordx4 %1, off\n\ts_mov_b32 m0, %0":"=&s"(keep):"v"(gsrc),"s"(lds_dst):"memory");}
__device__ __forceinline__ float max3f(float a,float b,float c){float r;asm("v_max3_f32 %0, %1, %2, %3":"=v"(r):"v"(a),"v"(b),"v"(c));return r;}
__device__ __forceinline__ float max2f(float a,float b){float r;asm("v_max_f32_e32 %0, %1, %2":"=v"(r):"v"(a),"v"(b));return r;}
__device__ __forceinline__ float fadd_s(float a,float b){float r;asm("v_add_f32_e32 %0, %1, %2":"=v"(r):"v"(a),"v"(b));return r;}
__device__ __forceinline__ float fsub_s(float a,float b){float r;asm("v_sub_f32_e32 %0, %1, %2":"=v"(r):"v"(a),"v"(b));return r;}
typedef float f32x2_t __attribute__((ext_vector_type(2))); typedef __bf16 bf16x2_t __attribute__((ext_vector_type(2)));
__device__ __forceinline__ unsigned cvtpk_s(float lo,float hi){f32x2_t v={lo,hi};bf16x2_t b=__builtin_convertvector(v,bf16x2_t);return __builtin_bit_cast(unsigned,b);}
#define WAIT_BAR(N) asm volatile("s_waitcnt vmcnt(" #N ") lgkmcnt(0)\n\ts_barrier":::"memory")

__device__ __forceinline__ void qkt(f32x16&p0,f32x16&p1,const char*Kslot,const bf16x8*qr,const f32x16&negm,int r32,int hi){
  const char*kb=Kslot+hi*1024+r32*16;
  #pragma unroll
  for(int d0=0;d0<4;++d0){
    const bf16x8 b0=*reinterpret_cast<const bf16x8*>(kb+d0*2048);
    const bf16x8 b1=*reinterpret_cast<const bf16x8*>(kb+d0*2048+512);
    if(d0==0){p0=__builtin_amdgcn_mfma_f32_32x32x16_bf16(b0,qr[0],negm,0,0,0);p1=__builtin_amdgcn_mfma_f32_32x32x16_bf16(b1,qr[0],negm,0,0,0);}
    else{p0=__builtin_amdgcn_mfma_f32_32x32x16_bf16(b0,qr[d0],p0,0,0,0);p1=__builtin_amdgcn_mfma_f32_32x32x16_bf16(b1,qr[d0],p1,0,0,0);}}
}
typedef __attribute__((address_space(3))) const char* lds_cptr;
typedef short v4i16_t __attribute__((ext_vector_type(4)));
__device__ __forceinline__ void kload8(bf16x8*kf,lds_cptr kp){
  kf[0]=*(const __attribute__((address_space(3))) bf16x8*)(kp);      kf[1]=*(const __attribute__((address_space(3))) bf16x8*)(kp+512);
  kf[2]=*(const __attribute__((address_space(3))) bf16x8*)(kp+2048); kf[3]=*(const __attribute__((address_space(3))) bf16x8*)(kp+2560);
  kf[4]=*(const __attribute__((address_space(3))) bf16x8*)(kp+4096); kf[5]=*(const __attribute__((address_space(3))) bf16x8*)(kp+4608);
  kf[6]=*(const __attribute__((address_space(3))) bf16x8*)(kp+6144); kf[7]=*(const __attribute__((address_space(3))) bf16x8*)(kp+6656);
}
__device__ __forceinline__ void kload2(bf16x8*kf,lds_cptr kp,int j){ kf[2*j]=*(const __attribute__((address_space(3))) bf16x8*)(kp+j*2048); kf[2*j+1]=*(const __attribute__((address_space(3))) bf16x8*)(kp+j*2048+512); }
__device__ __forceinline__ s16x4 vtr(lds_cptr p){ return __builtin_bit_cast(s16x4,__builtin_amdgcn_ds_read_tr16_b64_v4i16((__attribute__((address_space(3))) v4i16_t*)p)); }
__device__ __forceinline__ float rowmax(const f32x16&p0,const f32x16&p1){
  float a=max3f(p0[0],p0[1],p1[0]),b=max3f(p0[2],p0[3],p1[1]);a=max3f(a,p1[2],p1[3]);
  #pragma unroll
  for(int r=4;r<16;r+=4){a=max3f(a,p0[r],p0[r+1]);b=max3f(b,p0[r+2],p0[r+3]);a=max3f(a,p1[r],p1[r+1]);b=max3f(b,p1[r+2],p1[r+3]);}
  const float m=max2f(a,b);
  auto rr=__builtin_amdgcn_permlane32_swap(__float_as_uint(m),__float_as_uint(m),false,false);
  return max2f(__uint_as_float(rr[0]),__uint_as_float(rr[1]));
}
__device__ __forceinline__ void pv(f32x16*o,int vb,bf16x8 pa0,bf16x8 pa1,bf16x8 pa2,bf16x8 pa3){
  #pragma unroll
  for(int d0=0;d0<2;++d0){s16x4 lo[4],hi[4];
    #pragma unroll
    for(int ks=0;ks<4;++ks){
      asm volatile("ds_read_b64_tr_b16 %0,%1 offset:%c2":"=&v"(lo[ks]):"v"(vb),"i"(d0*4096+ks*1024):"memory");
      asm volatile("ds_read_b64_tr_b16 %0,%1 offset:%c2":"=&v"(hi[ks]):"v"(vb),"i"(d0*4096+ks*1024+512):"memory");}
    asm volatile("s_waitcnt lgkmcnt(0)":::"memory");SBAR();
    #define PK(k) (bf16x8){lo[k][0],lo[k][1],lo[k][2],lo[k][3],hi[k][0],hi[k][1],hi[k][2],hi[k][3]}
    o[d0]=__builtin_amdgcn_mfma_f32_32x32x16_bf16(pa0,PK(0),o[d0],0,0,0);
    o[d0]=__builtin_amdgcn_mfma_f32_32x32x16_bf16(pa1,PK(1),o[d0],0,0,0);
    o[d0]=__builtin_amdgcn_mfma_f32_32x32x16_bf16(pa2,PK(2),o[d0],0,0,0);
    o[d0]=__builtin_amdgcn_mfma_f32_32x32x16_bf16(pa3,PK(3),o[d0],0,0,0);
    #undef PK
  }
}

#ifndef ATTN_STORE16
#define ATTN_STORE16(p,v) (*(u32x4*)(p)=(v))
#endif
typedef float f32x4b __attribute__((ext_vector_type(4)));
template<int THRL> __device__ __forceinline__ void attn_unit(int b,int h,int qb,const bf16*Q,const bf16*__restrict__ K,const bf16*__restrict__ V,bf16*O,char*shm,const __attribute__((address_space(3))) float*cb){
  int tid_=threadIdx.x; asm volatile("":"+v"(tid_));
  const int tid=tid_,lane=tid&63,r32=lane&31,hi=lane>>5; const int wid=__builtin_amdgcn_readfirstlane(tid>>6);
  const long rowbase=(long)b*SEQ; const int q0=qb*QB;
  const bf16*Qw=Q+(rowbase+q0+wid*QBLK)*DM+h*D;
  const bf16*Kh=K+rowbase*DM+h*D,*Vh=V+rowbase*DM+h*D;
  const unsigned lds0=(unsigned)(uintptr_t)shm;
  float*wsf=(float*)(shm+LDS_WS)+wid*64;
  const bf16*ksrc=Kh+(long)lane*DM+wid*8;
  const bf16*vsrc=Vh+(long)(16*(wid&3)+(lane>>2))*DM+(wid>>2)*32+(lane&3)*8;
  const unsigned kdst=lds0+LDS_K+wid*1024, vdst=lds0+LDS_V+wid*1024;
  #define DMA_K(t,slot) glds16(ksrc+(long)(t)*KVBLK*DM,(unsigned)__builtin_amdgcn_readfirstlane(kdst+(slot)))
  #define DMA_V(t,slot) glds16(vsrc+(long)(t)*KVBLK*DM,(unsigned)__builtin_amdgcn_readfirstlane(vdst+(slot)))
  const int vb0=(int)(lds0+LDS_V)+((lane>>4)&1)*32+(lane&3)*8+(4*hi+((lane&15)>>2))*64;
  const char*Kbase=shm+LDS_K; bf16x8 kf[8];
  const lds_cptr shm3=(lds_cptr)shm; const lds_cptr kp0=shm3+LDS_K+hi*1024+r32*16; const lds_cptr vp0=shm3+LDS_V+((lane>>4)&1)*32+(lane&3)*8+(4*hi+((lane&15)>>2))*64;
  const int NT=(q0+QB)/KVBLK;
  DMA_K(0,0);DMA_V(0,0);DMA_K(1,SLOTB);
  bf16x8 qr[4];
  #pragma unroll
  for(int d0=0;d0<4;++d0)qr[d0]=*reinterpret_cast<const bf16x8*>(&Qw[(long)r32*DM+d0*16+hi*8]);
  float mhat=0.f,l_reg=0.f;f32x16 o[2];o[0]=f32x16{};o[1]=f32x16{};const f32x16 negm=f32x16{};
  const int qrel=wid*QBLK+r32;
  #define CMASK(P0,P1,t) do{int jb_=(t)-(NT-4); if(jb_>=0)cmask(P0,P1,jb_,qrel,hi);}while(0)
  #define ABIAS(P0,P1,t) do{ const __attribute__((address_space(3))) f32x4b*cbp_=(const __attribute__((address_space(3))) f32x4b*)(cb+64*(t)+4*hi); const float mh_=mhat; \
    _Pragma("unroll") for(int g_=0;g_<4;++g_){ const f32x4b b0_=cbp_[2*g_]+mh_; \
      P0[4*g_+0]-=b0_[0];P0[4*g_+1]-=b0_[1];P0[4*g_+2]-=b0_[2];P0[4*g_+3]-=b0_[3]; SBAR(); const f32x4b b1_=cbp_[8+2*g_]+mh_; P1[4*g_+0]-=b1_[0];P1[4*g_+1]-=b1_[1];P1[4*g_+2]-=b1_[2];P1[4*g_+3]-=b1_[3]; SBAR(); } }while(0)
  bool resc=false;
  #define START(P0,P1) do{ const float rm=rowmax(P0,P1); resc=false; \
    { const float dl=rm; mhat=fadd_s(mhat,dl); \
      _Pragma("unroll") for(int r=0;r<16;++r){P0[r]=fsub_s(P0[r],dl);P1[r]=fsub_s(P1[r],dl);} \
      } \
    _Pragma("unroll") for(int r=0;r<16;++r)P0[r]=__builtin_amdgcn_exp2f(P0[r]); }while(0)
  #define RESC() do{ if(resc){ asm volatile("s_waitcnt lgkmcnt(0)":::"memory"); \
      _Pragma("unroll") for(int d_=0;d_<2;++d_) _Pragma("unroll") for(int r=0;r<16;++r)o[d_][r]*=wsf[crow(r,hi)]; } }while(0)
  f32x16 pA0,pA1,pB0,pB1;
  int sl_prev=0,sl_cur=0,sl_next=SLOTB;
  #define ROT() do{sl_prev=sl_cur;sl_cur=sl_next;sl_next=(sl_next==(NSLOT-1)*SLOTB)?0:sl_next+SLOTB;}while(0)
  DMA_K(2,2*SLOTB);
  WAIT_BAR(3);
  qkt(pA0,pA1,Kbase,qr,negm,r32,hi);asm volatile("s_nop 15\n\ts_nop 7":"+v"(pA0),"+v"(pA1));ABIAS(pA0,pA1,0);CMASK(pA0,pA1,0);
  START(pA0,pA1);
  _Pragma("unroll") for(int r=0;r<16;++r)pA1[r]=__builtin_amdgcn_exp2f(pA1[r]);
  WAIT_BAR(0);
  DMA_K(3,0);DMA_V(1,SLOTB);
  ROT();
  kload8(kf,kp0+sl_cur);
  WAIT_BAR(2);
  s16x4 vlo[8],vhi[8]; u32x4 pw0,pw1,pw2,pw3;
  #define PKW(P,B) cvtpk_s(P[B],P[B+1])
  #define PAF(k) __builtin_bit_cast(bf16x8,pw##k)
  #define VFR(i) (bf16x8){vlo[i][0],vlo[i][1],vlo[i][2],vlo[i][3],vhi[i][0],vhi[i][1],vhi[i][2],vhi[i][3]}
  #define PIN(x) asm volatile("":"+v"(x))
  #define MX3(a,b,c) __builtin_fmaxf(__builtin_fmaxf((a),(b)),(c))
  #define GAPA(MF,A0,A1,A2,A3,W0,W1,PW) do{ MF; sacc+=A0; sacc+=A1; sacc+=A2; sacc+=A3; PIN(sacc); W0; W1; PIN(PW); SBAR(); }while(0)
  #define EX(v) __builtin_amdgcn_exp2f(v)
  #define GAPB(MF,X,B) do{ MF; X[B]=EX(X[B]); X[B+1]=EX(X[B+1]); X[B+2]=EX(X[B+2]); X[B+3]=EX(X[B+3]); PIN(X); SBAR(); }while(0)
  #define VRD(i) do{ vlo[i]=vtr(vp_+(((i)>>2)*4096+((i)&3)*1024)); vhi[i]=vtr(vp_+(((i)>>2)*4096+((i)&3)*1024+512)); }while(0)
  #define KRD(G,j) do{ if(G){ kload2(kf,kp0+sl_next,j); SBAR(); } }while(0)
  #define STEP(C0,C1,P0,P1,t,GK,GV,GL) do{ SBAR(); \
    const lds_cptr vp_=vp0+sl_prev; \
    VRD(0); SBAR(); float sacc=(P0[0]+P0[1]); \
    GAPA(C0=__builtin_amdgcn_mfma_f32_32x32x16_bf16(kf[0],qr[0],negm,0,0,0), P0[2],P0[3],P0[4],P0[5],     pw0[0]=PKW(P0,0), pw0[1]=PKW(P0,2), pw0); \
    VRD(4); SBAR(); GAPA(C1=__builtin_amdgcn_mfma_f32_32x32x16_bf16(kf[1],qr[0],negm,0,0,0), P0[6],P0[7],P0[8],P0[9],     pw0[2]=PKW(P0,4), pw0[3]=PKW(P0,6), pw0); \
    VRD(1); SBAR(); GAPA(C0=__builtin_amdgcn_mfma_f32_32x32x16_bf16(kf[2],qr[1],C0,0,0,0),   P0[10],P0[11],P0[12],P0[13], pw1[0]=PKW(P0,8), pw1[1]=PKW(P0,10), pw1); \
    VRD(5); SBAR(); GAPA(C1=__builtin_amdgcn_mfma_f32_32x32x16_bf16(kf[3],qr[1],C1,0,0,0),   P0[14],P0[15],P1[0],P1[1],   pw1[2]=PKW(P0,12),pw1[3]=PKW(P0,14), pw1); \
    VRD(2); SBAR(); GAPA(C0=__builtin_amdgcn_mfma_f32_32x32x16_bf16(kf[4],qr[2],C0,0,0,0),   P1[2],P1[3],P1[4],P1[5],     pw2[0]=PKW(P1,0), pw2[1]=PKW(P1,2), pw2); \
    VRD(6); SBAR(); GAPA(C1=__builtin_amdgcn_mfma_f32_32x32x16_bf16(kf[5],qr[2],C1,0,0,0),   P1[6],P1[7],P1[8],P1[9],     pw2[2]=PKW(P1,4), pw2[3]=PKW(P1,6), pw2); \
    VRD(3); SBAR(); GAPA(C0=__builtin_amdgcn_mfma_f32_32x32x16_bf16(kf[6],qr[3],C0,0,0,0),   P1[10],P1[11],P1[12],P1[13], pw3[0]=PKW(P1,8), pw3[1]=PKW(P1,10), pw3); \
    VRD(7); SBAR(); GAPA(C1=__builtin_amdgcn_mfma_f32_32x32x16_bf16(kf[7],qr[3],C1,0,0,0),   P1[14],P1[15],0.f,0.f,       pw3[2]=PKW(P1,12),pw3[3]=PKW(P1,14), pw3); \
    l_reg+=sacc; \
    if(GK){DMA_K((t)+3,sl_cur);} if(GV){DMA_V((t)+1,sl_next);} \
    ABIAS(C0,C1,t); CMASK(C0,C1,t); \
    { float a=MX3(C0[0],C0[1],C1[0]),b=MX3(C0[2],C0[3],C1[1]); a=MX3(a,C1[2],C1[3]); \
      _Pragma("unroll") for(int r=4;r<16;r+=4){a=MX3(a,C0[r],C0[r+1]);b=MX3(b,C0[r+2],C0[r+3]);a=MX3(a,C1[r],C1[r+1]);b=MX3(b,C1[r+2],C1[r+3]);} \
      float rm=__builtin_fmaxf(a,b); { auto rr=__builtin_amdgcn_permlane32_swap(__float_as_uint(rm),__float_as_uint(rm),false,false); rm=__builtin_fmaxf(__uint_as_float(rr[0]),__uint_as_float(rr[1])); } \
      resc=false; \
      if(__builtin_expect(__any(rm>(float)THRL),0)){ const float dl=__builtin_fmaxf(rm,0.f); mhat+=dl; \
        _Pragma("unroll") for(int r=0;r<16;++r){C0[r]-=dl;C1[r]-=dl;} \
        const float f=__builtin_amdgcn_exp2f(-dl); l_reg*=f; if(hi==0)wsf[r32]=f; resc=true; } } \
    SBAR(); \
    GAPB(o[0]=__builtin_amdgcn_mfma_f32_32x32x16_bf16(PAF(0),VFR(0),o[0],0,0,0), C0,0); \
    GAPB(o[1]=__builtin_amdgcn_mfma_f32_32x32x16_bf16(PAF(0),VFR(4),o[1],0,0,0), C0,4); \
    KRD(GL,0); GAPB(o[0]=__builtin_amdgcn_mfma_f32_32x32x16_bf16(PAF(1),VFR(1),o[0],0,0,0), C0,8); \
    KRD(GL,1); GAPB(o[1]=__builtin_amdgcn_mfma_f32_32x32x16_bf16(PAF(1),VFR(5),o[1],0,0,0), C0,12); \
    KRD(GL,2); GAPB(o[0]=__builtin_amdgcn_mfma_f32_32x32x16_bf16(PAF(2),VFR(2),o[0],0,0,0), C1,0); \
    KRD(GL,3); GAPB(o[1]=__builtin_amdgcn_mfma_f32_32x32x16_bf16(PAF(2),VFR(6),o[1],0,0,0), C1,4); \
    GAPB(o[0]=__builtin_amdgcn_mfma_f32_32x32x16_bf16(PAF(3),VFR(3),o[0],0,0,0), C1,8); \
    GAPB(o[1]=__builtin_amdgcn_mfma_f32_32x32x16_bf16(PAF(3),VFR(7),o[1],0,0,0), C1,12); \
    }while(0)
  int t=1;
  #undef CMASK
  #define CMASK(P0,P1,t) do{}while(0)
  for(;t+5<NT;t+=2){
    STEP(pB0,pB1,pA0,pA1,t,true,true,true);     WAIT_BAR(2); RESC(); ROT();
    STEP(pA0,pA1,pB0,pB1,t+1,true,true,true);   WAIT_BAR(2); RESC(); ROT();
  }
  #undef CMASK
  #define CMASK(P0,P1,t) do{int jb_=(t)-(NT-4); if(jb_>=0)cmask(P0,P1,jb_,qrel,hi);}while(0)
  #define ENDW(tt) do{ if((tt)+3<NT){WAIT_BAR(2);} else if((tt)+2<NT){WAIT_BAR(1);} else {WAIT_BAR(0);} }while(0)
  for(;t+1<NT;t+=2){
    STEP(pB0,pB1,pA0,pA1,t,(t+3<NT),(t+1<NT),(t+1<NT));       ENDW(t);   RESC(); ROT();
    STEP(pA0,pA1,pB0,pB1,t+1,(t+4<NT),(t+2<NT),(t+2<NT));     ENDW(t+1); RESC(); ROT();
  }
  STEP(pB0,pB1,pA0,pA1,NT-1,false,false,false); RESC();
  { float sacc=pB0[0]+pB0[1]; _Pragma("unroll") for(int r=2;r<16;++r)sacc+=pB0[r]; _Pragma("unroll") for(int r=0;r<16;++r)sacc+=pB1[r]; l_reg+=sacc;
    pw0=(u32x4){PKW(pB0,0),PKW(pB0,2),PKW(pB0,4),PKW(pB0,6)};pw1=(u32x4){PKW(pB0,8),PKW(pB0,10),PKW(pB0,12),PKW(pB0,14)};pw2=(u32x4){PKW(pB1,0),PKW(pB1,2),PKW(pB1,4),PKW(pB1,6)};pw3=(u32x4){PKW(pB1,8),PKW(pB1,10),PKW(pB1,12),PKW(pB1,14)};
    SBAR(); pv(o,vb0+sl_cur,PAF(0),PAF(1),PAF(2),PAF(3)); }
  #undef PKW
  #undef PAF
  #undef VFR
  #undef PIN
  #undef MX3
  #undef GAPA
  #undef GAPB
  #undef EX
  #undef VRD
  #undef KRD
  #undef STEP
  #undef ENDW
  {auto rr=__builtin_amdgcn_permlane32_swap(__float_as_uint(l_reg),__float_as_uint(l_reg),false,false);l_reg=__uint_as_float(rr[0])+__uint_as_float(rr[1]);}
  if(hi==0)wsf[32+r32]=l_reg;asm volatile("s_waitcnt lgkmcnt(0)":::"memory");
  float rli[16];
  #pragma unroll
  for(int r=0;r<16;++r)rli[r]=__builtin_amdgcn_rcpf(wsf[32+crow(r,hi)]);
  bf16*Ow=O+(rowbase+q0+wid*QBLK)*DM+h*D;
  { bf16*stg=(bf16*)(shm+LDS_OST)+wid*2048;
    #pragma unroll
    for(int r=0;r<16;++r){const int orow=crow(r,hi);
      #pragma unroll
      for(int d0=0;d0<2;++d0)stg[orow*64+d0*32+r32]=__float2bfloat16(o[d0][r]*rli[r]);}
    asm volatile("s_waitcnt lgkmcnt(0)":::"memory");
    #pragma unroll
    for(int i=0;i<4;++i){const int row=i*8+(lane>>3),ch=lane&7; const u32x4 v=*(const u32x4*)(stg+row*64+ch*8); ATTN_STORE16(Ow+(long)row*DM+ch*8,v);} }
  asm volatile("s_waitcnt lgkmcnt(0)\n\ts_barrier":::"memory");
  #undef DMA_K
  #undef DMA_V
  #undef CMASK
  #undef ABIAS
  #undef START
  #undef RESC
  #undef ROT
}
constexpr int ATTN_LDS_BYTES=LDS_BYTES;
#undef SBAR
#undef WAIT_BAR
}

#ifndef LAS
#define LAS __attribute__((address_space(3)))
#endif
constexpr int MK_WAVES = 8;
namespace pg8 { __device__ __forceinline__ unsigned cvt_pk_bf16(float lo, float hi); }

namespace sb_body {
typedef short bf16x8 __attribute__((ext_vector_type(8)));
typedef float f32x16 __attribute__((ext_vector_type(16)));
__device__ __forceinline__ void sb_head(LAS unsigned char* lds, int lane, int wid, int bh, const bf16_t* Q, const bf16_t* K, const bf16_t* V, bf16_t* O) {
    const int r32 = lane & 31, hi = lane >> 5;
    const int b = bh / NH, hh = bh % NH; const size_t rowb = (size_t)b * SEQ;
    const bf16_t* Qh = Q + rowb * DM + hh * HD; const bf16_t* Kh = K + rowb * DM + hh * HD; const bf16_t* Vh = V + rowb * DM + hh * HD; bf16_t* Oh = O + rowb * DM + hh * HD;
    LAS unsigned char* slot0 = lds + wid * 16384;
    const int vb0 = (int)(unsigned)(size_t)slot0 + ((lane >> 4) & 1) * 32 + (lane & 3) * 8 + (4 * hi + ((lane & 15) >> 2)) * 64;
    const bf16_t* vsrc0 = Vh + (size_t)(lane >> 2) * DM + (lane & 3) * 8;
#define SB_DMAV(t, sc) do { _Pragma("unroll") for (int p_ = 0; p_ < 8; ++p_) \
        __builtin_amdgcn_global_load_lds((const unsigned*)(vsrc0 + (size_t)(64 * (t) + 16 * (p_ & 3)) * DM + 32 * (p_ >> 2)), (LAS unsigned*)(slot0 + (sc) * 8192 + p_ * 1024), 16, 0, 0); } while (0)
#define SB_LOADK(kf, t) do { const bf16_t* kp_ = Kh + (size_t)(64 * (t) + r32) * DM + 8 * hi; _Pragma("unroll") for (int d0_ = 0; d0_ < 4; ++d0_) { \
        kf[2 * d0_] = *(const bf16x8*)(kp_ + 16 * d0_); kf[2 * d0_ + 1] = *(const bf16x8*)(kp_ + (size_t)32 * DM + 16 * d0_); } } while (0)
    for (int uu = wid; uu < SEQ / 32; uu += MK_WAVES) {
        const int q0w = uu * 32, qabs = q0w + r32;
        bf16x8 qr[4];
#pragma unroll
        for (int d0 = 0; d0 < 4; ++d0) qr[d0] = *(const bf16x8*)(Qh + (size_t)qabs * DM + d0 * 16 + hi * 8);
        f32x16 o[2]; o[0] = f32x16{}; o[1] = f32x16{};
        float carry = 1.f; int jt = (q0w + 30) >> 6, sc = 0; bool first = true;
        bf16x8 kf[8], kfn[8];
        SB_DMAV(jt, 0); asm volatile("" ::: "memory"); SB_LOADK(kf, jt);
        for (;;) {
            f32x16 p0 = f32x16{}, p1 = f32x16{};
#pragma unroll
            for (int d0 = 0; d0 < 4; ++d0) { p0 = __builtin_amdgcn_mfma_f32_32x32x16_bf16(kf[2 * d0], qr[d0], p0, 0, 0, 0); p1 = __builtin_amdgcn_mfma_f32_32x32x16_bf16(kf[2 * d0 + 1], qr[d0], p1, 0, 0, 0); }
            const bool more = jt > 0;
            asm volatile("" ::: "memory");
            if (more) { SB_DMAV(jt - 1, sc ^ 1); asm volatile("" ::: "memory"); SB_LOADK(kfn, jt - 1); }
            asm volatile("" ::: "memory");
            float nb[8][4], be[8][4];
#pragma unroll
            for (int w = 0; w < 8; ++w)
#pragma unroll
                for (int i = 0; i < 4; ++i) { const int r = (w & 3) * 4 + i; float x = (w < 4) ? p0[r] : p1[r]; x = fminf(x, 64.f);
                    const float e = __builtin_amdgcn_exp2f(x), rr = __builtin_amdgcn_rcpf(1.f + e);
                    const int kv = 64 * jt + 32 * (w >> 2) + 8 * (w & 3) + 4 * hi + i; const bool valid = !first || (kv < qabs);
                    be[w][i] = valid ? e * rr : 0.f; nb[w][i] = valid ? rr : 1.f; }
            float Xs[8];
            float Te[8], To[8];
#pragma unroll
            for (int w = 0; w < 8; ++w) { const float s2 = nb[w][3], s1 = s2 * nb[w][2], s0 = s1 * nb[w][1], T = s0 * nb[w][0];
                be[w][2] *= s2; be[w][1] *= s1; be[w][0] *= s0;
                auto rr2 = __builtin_amdgcn_permlane32_swap(__float_as_uint(T), __float_as_uint(T), false, false); Te[w] = __uint_as_float(rr2[0]); To[w] = __uint_as_float(rr2[1]); }
            float W = 1.f;
#pragma unroll
            for (int w = 7; w >= 0; --w) { const float xe = W * To[w]; Xs[w] = hi ? W : xe; W = xe * Te[w]; }
            unsigned pw[16];
#pragma unroll
            for (int w = 0; w < 8; ++w) { const float sc2 = Xs[w] * carry; pw[2 * w] = pg8::cvt_pk_bf16(be[w][0] * sc2, be[w][1] * sc2); pw[2 * w + 1] = pg8::cvt_pk_bf16(be[w][2] * sc2, be[w][3] * sc2); }
            carry *= W;
            const bf16x8 pa0 = __builtin_bit_cast(bf16x8, (u32x4){pw[0], pw[1], pw[2], pw[3]}), pa1 = __builtin_bit_cast(bf16x8, (u32x4){pw[4], pw[5], pw[6], pw[7]});
            const bf16x8 pa2 = __builtin_bit_cast(bf16x8, (u32x4){pw[8], pw[9], pw[10], pw[11]}), pa3 = __builtin_bit_cast(bf16x8, (u32x4){pw[12], pw[13], pw[14], pw[15]});
            if (more) asm volatile("s_waitcnt vmcnt(16)" ::: "memory"); else asm volatile("s_waitcnt vmcnt(0)" ::: "memory");
            attn_body::pv(o, vb0 + sc * 8192, pa0, pa1, pa2, pa3);
            if (!more || __all(carry < 1e-30f)) break;
#pragma unroll
            for (int i = 0; i < 8; ++i) kf[i] = kfn[i];
            sc ^= 1; --jt; first = false;
        }
        asm volatile("s_waitcnt vmcnt(0)" ::: "memory");
#pragma unroll
        for (int d0 = 0; d0 < 2; ++d0)
#pragma unroll
            for (int r = 0; r < 16; ++r) Oh[(size_t)(q0w + crow(r, hi)) * DM + d0 * 32 + r32] = (bf16_t)f2bf(o[d0][r]);
    }
#undef SB_DMAV
#undef SB_LOADK
}
}

#ifndef LAS
#define LAS __attribute__((address_space(3)))
#endif
#define GAS __attribute__((address_space(1)))
constexpr size_t WS_SS = WS_END;
constexpr size_t WS_WR = WS_SS + 2 * MiB;
constexpr size_t WS_WF = WS_WR + 1 * MiB;
constexpr size_t WS_HB2 = WS_WF + 1 * MiB;
constexpr size_t WS_END2 = WS_HB2 + 64 * MiB;
constexpr int CW_BAR = 4096;

namespace pg8 {
constexpr int BM = 256, BK = 64, HALF = 128, HTB = HALF * BK * 2, STAGE_BYTES = 8 * HTB, NXCD = 8, WGM = 8;
__device__ __forceinline__ int lds_byte(int r, int c) { const int st = (r >> 4) * 2 + (c >> 5), rr = r & 15, cc = c & 31, ob = rr * 64 + cc * 2; return st * 1024 + (ob ^ (((ob >> 9) & 1) << 5)); }
__device__ __forceinline__ void stage_rc(int b, int& R, int& C) { const int st = b / 1024, sb = b % 1024, swz = sb ^ (((sb >> 9) & 1) << 5); R = (st >> 1) * 16 + swz / 64; C = (st & 1) * 32 + (swz % 64) / 2; }
__device__ __forceinline__ int perm32(int rho) { const int n = rho >> 4, i = rho & 15; return 8 * (i >> 2) + 4 * n + (i & 3); }
__device__ __forceinline__ unsigned cvt_pk_bf16(float lo, float hi) { unsigned r; asm volatile("v_cvt_pk_bf16_f32 %0, %1, %2" : "=v"(r) : "v"(lo), "v"(hi)); return r; }

struct Unit { int arow0, brow0, pn, e, rank0, cnt, ui; };

__device__ __forceinline__ int xcd_remap(int L, int nwg) { const int q = nwg / NXCD, r = nwg % NXCD, xcd = L % NXCD, off = L / NXCD; return (xcd < r ? xcd * (q + 1) : r * (q + 1) + (xcd - r) * q) + off; }

struct DenseOrder {
    int nM, nN, nwg, G, c;
    __device__ __forceinline__ void init(int M, int N, int G_, int c_) { nM = M / BM; nN = N / BM; nwg = nM * nN; G = G_; c = c_; }
    __device__ __forceinline__ bool next(int i, Unit& u) const {
        const long L = (long)i * G + c; if (L >= nwg) return false;
        const int wgid = xcd_remap((int)L, nwg);
        const int nig = WGM * nN, gid = wgid / nig, fm = gid * WGM, gsz = (nM - fm) < WGM ? (nM - fm) : WGM;
        const int pm = fm + ((wgid % nig) % gsz), pn = (wgid % nig) / gsz;
        u.arow0 = pm * BM; u.brow0 = pn * BM; u.pn = pn; u.e = 0; u.rank0 = 0; u.cnt = 0; u.ui = i; return true;
    }
    __device__ __forceinline__ int arow(const Unit& u, int lr) const { return u.arow0 + lr; }
};
struct PJOrder {
    DenseOrder d; int G, c;
    __device__ __forceinline__ void init(int G_, int c_) { d.init(NTOK, DM, G_, 0); G = G_; c = c_; }
    __device__ __forceinline__ bool next(int i, Unit& u) const {
        const long L = (long)i * G + c; if (L >= 2 * d.nwg) return false;
        const int l2 = (L >= d.nwg) ? 1 : 0; const int wgid = xcd_remap((int)L - l2 * d.nwg, d.nwg);
        const int nig = WGM * d.nN, gid = wgid / nig, fm = gid * WGM, gsz = (d.nM - fm) < WGM ? (d.nM - fm) : WGM;
        const int pm = fm + ((wgid % nig) % gsz), pn = (wgid % nig) / gsz;
        u.arow0 = l2 * NTOK + pm * BM; u.brow0 = l2 * DM + pn * BM; u.pn = pn; u.e = 0; u.rank0 = 0; u.cnt = 0; u.ui = i; return true;
    }
    __device__ __forceinline__ int arow(const Unit& u, int lr) const { return u.arow0 + lr; }
};
struct MoeOrder {
    int NN, nwg, G, c; const LAS int* tstartL; const LAS int* cntL; const LAS unsigned short* tokL; bool gather;
    __device__ __forceinline__ bool next(int i, Unit& u) const {
        const long L = (long)i * G + c; if (L >= nwg) return false;
        const int wgid = xcd_remap((int)L, nwg);
        const int T = wgid / NN, pn = wgid - T * NN;
        const int lane = threadIdx.x & 63;
        const int lo = (lane < NE) ? tstartL[lane] : 0x7fffffff, hi = (lane < NE) ? tstartL[lane + 1] : 0x7fffffff;
        const unsigned long long m = __ballot(lo <= T && T < hi);
        const int e = __builtin_amdgcn_readfirstlane((int)__builtin_ctzll(m | (1ull << 63)));
        u.e = e; u.rank0 = (T - tstartL[e]) * 256; u.cnt = cntL[e]; u.arow0 = T * 256; u.brow0 = (e * NN + pn) * 256; u.pn = pn; u.ui = i; return true;
    }
    __device__ __forceinline__ int arow(const Unit& u, int lr) const { return gather ? (int)tokL[u.ui * 256 + lr] : u.arow0 + lr; }
};

typedef const f32x4 (&AccRef)[2][2][4][2];
struct EpiQKV {
    bf16_t* Q; const LAS float* rowL;
    __device__ __forceinline__ void operator()(AccRef acc, const Unit& u, int wr, int wc, int fr, int fq) const {
        const int t = u.brow0 >> 10, colt = u.brow0 & 1023; bf16_t* base = Q + (size_t)t * ((size_t)NTOK * DM); const float sc = (t == 0) ? C2 : 1.f;
        const int col0 = colt + wc * 32 + 8 * fq;
#pragma unroll
        for (int ai = 0; ai < 2; ++ai)
#pragma unroll
            for (int m = 0; m < 4; ++m) { const int lr = ai * HALF + wr * 64 + m * 16 + fr; const int row = u.arow0 + lr;
                const float rs = rowL[u.ui * 256 + lr] * sc; bf16_t* rowp = base + (size_t)row * DM + col0;
#pragma unroll
                for (int bj = 0; bj < 2; ++bj) { const f32x4 v0 = acc[ai][bj][m][0] * rs, v1 = acc[ai][bj][m][1] * rs; u32x4 w;
                    w.x = cvt_pk_bf16(v0[0], v0[1]); w.y = cvt_pk_bf16(v0[2], v0[3]); w.z = cvt_pk_bf16(v1[0], v1[1]); w.w = cvt_pk_bf16(v1[2], v1[3]); *(u32x4*)(rowp + bj * HALF) = w; } }
    }
};
struct EpiPJ {
    bf16_t* O;
    __device__ __forceinline__ void operator()(AccRef acc, const Unit& u, int wr, int wc, int fr, int fq) const {
        const int col0 = u.pn * BM + wc * 32 + 8 * fq;
#pragma unroll
        for (int ai = 0; ai < 2; ++ai)
#pragma unroll
            for (int m = 0; m < 4; ++m) { const int row = u.arow0 + ai * HALF + wr * 64 + m * 16 + fr; bf16_t* rowp = O + (size_t)row * DM + col0;
#pragma unroll
                for (int bj = 0; bj < 2; ++bj) { const f32x4 v0 = acc[ai][bj][m][0], v1 = acc[ai][bj][m][1]; u32x4 w;
                    w.x = cvt_pk_bf16(v0[0], v0[1]); w.y = cvt_pk_bf16(v0[2], v0[3]); w.z = cvt_pk_bf16(v1[0], v1[1]); w.w = cvt_pk_bf16(v1[2], v1[3]); *(u32x4*)(rowp + bj * HALF) = w; } }
    }
};
struct EpiWo {
    const float* hin; float* hout; bf16_t* hb;
    __device__ __forceinline__ void operator()(AccRef acc, const Unit& u, int wr, int wc, int fr, int fq) const {
        const int col0 = u.brow0 + wc * 32 + 8 * fq;
#pragma unroll
        for (int ai = 0; ai < 2; ++ai)
#pragma unroll
            for (int m = 0; m < 4; ++m) { const int row = u.arow0 + ai * HALF + wr * 64 + m * 16 + fr; const size_t off = (size_t)row * DM + col0;
#pragma unroll
                for (int bj = 0; bj < 2; ++bj) { const size_t o = off + bj * HALF; const f32x4 x0 = *(const f32x4*)(hin + o) + acc[ai][bj][m][0], x1 = *(const f32x4*)(hin + o + 4) + acc[ai][bj][m][1];
                    *(f32x4*)(hout + o) = x0; *(f32x4*)(hout + o + 4) = x1; u32x4 w;
                    w.x = cvt_pk_bf16(x0[0], x0[1]); w.y = cvt_pk_bf16(x0[2], x0[3]); w.z = cvt_pk_bf16(x1[0], x1[1]); w.w = cvt_pk_bf16(x1[2], x1[3]); *(u32x4*)(hb + o) = w; }
                asm volatile("" ::: "memory"); }
    }
};
__device__ __forceinline__ float fast_sigmoid(float x) { return __builtin_amdgcn_rcpf(1.f + __builtin_amdgcn_exp2f(-LOG2E * x)); }
struct EpiPLE {
    float* h; bf16_t* hb; const bf16_t* PJ; const LAS float* rowL; float* SS;
    __device__ __forceinline__ void operator()(AccRef acc, const Unit& u, int wr, int wc, int fr, int fq) const {
        const int col0 = u.brow0 + wc * 32 + 8 * fq;
#pragma unroll
        for (int ai = 0; ai < 2; ++ai)
#pragma unroll
            for (int m = 0; m < 4; ++m) { const int lr = ai * HALF + wr * 64 + m * 16 + fr; const int row = u.arow0 + lr; const size_t off = (size_t)row * DM + col0; const float rs = rowL[u.ui * 256 + lr]; float ssq = 0.f;
#pragma unroll
                for (int bj = 0; bj < 2; ++bj) { const size_t o = off + bj * HALF; const u32x4 pj = *(const u32x4*)(PJ + o); f32x4 x0 = *(const f32x4*)(h + o), x1 = *(const f32x4*)(h + o + 4);
                    const f32x4 a0 = acc[ai][bj][m][0] * rs, a1 = acc[ai][bj][m][1] * rs;
                    x0[0] += fast_sigmoid(a0[0]) * __uint_as_float(pj.x << 16); x0[1] += fast_sigmoid(a0[1]) * __uint_as_float(pj.x & 0xffff0000u);
                    x0[2] += fast_sigmoid(a0[2]) * __uint_as_float(pj.y << 16); x0[3] += fast_sigmoid(a0[3]) * __uint_as_float(pj.y & 0xffff0000u);
                    x1[0] += fast_sigmoid(a1[0]) * __uint_as_float(pj.z << 16); x1[1] += fast_sigmoid(a1[1]) * __uint_as_float(pj.z & 0xffff0000u);
                    x1[2] += fast_sigmoid(a1[2]) * __uint_as_float(pj.w << 16); x1[3] += fast_sigmoid(a1[3]) * __uint_as_float(pj.w & 0xffff0000u);
                    ssq += (x0[0] * x0[0] + x0[1] * x0[1]) + (x0[2] * x0[2] + x0[3] * x0[3]) + (x1[0] * x1[0] + x1[1] * x1[1]) + (x1[2] * x1[2] + x1[3] * x1[3]);
                    *(f32x4*)(h + o) = x0; *(f32x4*)(h + o + 4) = x1; u32x4 w;
                    w.x = cvt_pk_bf16(x0[0], x0[1]); w.y = cvt_pk_bf16(x0[2], x0[3]); w.z = cvt_pk_bf16(x1[0], x1[1]); w.w = cvt_pk_bf16(x1[2], x1[3]); *(u32x4*)(hb + o) = w; }
                ssq += __shfl_xor(ssq, 16); ssq += __shfl_xor(ssq, 32);
                if (fq == 0) SS[(size_t)row * 16 + u.pn * 4 + wc] = ssq;
                asm volatile("" ::: "memory"); }
    }
};
struct EpiGU {
    bf16_t* ACT; const float* bgu; const LAS float* rowL;
    __device__ __forceinline__ void operator()(AccRef acc, const Unit& u, int wr, int wc, int fr, int fq) const {
        const int jc = u.pn * 128 + wc * 32 + 8 * fq; const float* bp = bgu + (size_t)u.e * (2 * FF) + jc;
        const f32x4 bg0 = *(const f32x4*)(bp), bg1 = *(const f32x4*)(bp + 4), bl0 = *(const f32x4*)(bp + FF), bl1 = *(const f32x4*)(bp + FF + 4);
#pragma unroll
        for (int ai = 0; ai < 2; ++ai)
#pragma unroll
            for (int m = 0; m < 4; ++m) { const int lr = ai * HALF + wr * 64 + m * 16 + fr; const float rs = rowL[u.ui * 256 + lr];
                f32x4 g0 = acc[ai][0][m][0] * rs + bg0, g1 = acc[ai][0][m][1] * rs + bg1, l0 = acc[ai][1][m][0] * rs + bl0, l1 = acc[ai][1][m][1] * rs + bl1; float a[8];
#pragma unroll
                for (int c = 0; c < 4; ++c) { const float gl = fminf(g0[c], 7.f), ln = fminf(fmaxf(l0[c], -7.f), 7.f); a[c] = gl * fast_sigmoid(1.702f * gl) * (ln + 1.f);
                    const float gl2 = fminf(g1[c], 7.f), ln2 = fminf(fmaxf(l1[c], -7.f), 7.f); a[4 + c] = gl2 * fast_sigmoid(1.702f * gl2) * (ln2 + 1.f); }
                u32x4 w; w.x = cvt_pk_bf16(a[0], a[1]); w.y = cvt_pk_bf16(a[2], a[3]); w.z = cvt_pk_bf16(a[4], a[5]); w.w = cvt_pk_bf16(a[6], a[7]);
                *(u32x4*)(ACT + (size_t)(u.arow0 + lr) * FF + jc) = w; }
    }
};
struct EpiDown {
    bf16_t* Y; const float* bd; const LAS float* rowL;
    __device__ __forceinline__ void operator()(AccRef acc, const Unit& u, int wr, int wc, int fr, int fq) const {
        const int col0 = u.pn * 256 + wc * 32 + 8 * fq; const float* bp = bd + (size_t)u.e * DM + col0;
        f32x4 bv[2][2];
#pragma unroll
        for (int bj = 0; bj < 2; ++bj) { bv[bj][0] = *(const f32x4*)(bp + bj * HALF); bv[bj][1] = *(const f32x4*)(bp + bj * HALF + 4); }
#pragma unroll
        for (int ai = 0; ai < 2; ++ai)
#pragma unroll
            for (int m = 0; m < 4; ++m) { const int lr = ai * HALF + wr * 64 + m * 16 + fr; const float gt = rowL[u.ui * 256 + lr];
                bf16_t* rowp = Y + (size_t)(u.arow0 + lr) * DM + col0;
#pragma unroll
                for (int bj = 0; bj < 2; ++bj) { const f32x4 v0 = (acc[ai][bj][m][0] + bv[bj][0]) * gt, v1 = (acc[ai][bj][m][1] + bv[bj][1]) * gt; u32x4 w;
                    w.x = cvt_pk_bf16(v0[0], v0[1]); w.y = cvt_pk_bf16(v0[2], v0[3]); w.z = cvt_pk_bf16(v1[0], v1[1]); w.w = cvt_pk_bf16(v1[2], v1[3]); *(u32x4*)(rowp + bj * HALF) = w; } }
    }
};

template <class Epi, class Sched>
__device__ __forceinline__ void gemm_phase(LAS unsigned char* lds, const bf16_t* gA, const bf16_t* gBt, const int K, const Sched& S, const Epi& E) {
    int tid_ = threadIdx.x; asm volatile("" : "+v"(tid_));
    const int tid = tid_, wid = __builtin_amdgcn_readfirstlane(tid >> 6), lane = tid & 63, wr = wid >> 2, wc = wid & 3, fr = lane & 15, fq = lane >> 4;
    const int nt = K / BK;
    unsigned voffB[2];
#pragma unroll
    for (int i = 0; i < 2; ++i) { int R, C; stage_rc(tid * 16 + i * 8192, R, C); const int Rb = (R & ~31) + perm32(R & 31); voffB[i] = (unsigned)(Rb * K + C) * 2u; }
#define PG8_AOFF(u, o0, o1) do { int t2_ = threadIdx.x; asm volatile("" : "+v"(t2_)); _Pragma("unroll") for (int i = 0; i < 2; ++i) { int R, C; stage_rc(t2_ * 16 + i * 8192, R, C); \
        o0[i] = ((unsigned)S.arow(u, R) * (unsigned)K + (unsigned)C) * 2u; o1[i] = ((unsigned)S.arow(u, HALF + R) * (unsigned)K + (unsigned)C) * 2u; } } while (0)
    const size_t kstep = (size_t)(BK * 2);
    const size_t hstep = (size_t)HALF * K * 2;
    const unsigned ldsw = (unsigned)wid * 1024u;
    const int aoff = lds_byte(wr * 64 + fr, fq * 8), boff = lds_byte(wc * 32 + fr, fq * 8);
#define PG8_SA(b, h) (((b) * 2 + (h)) * HTB)
#define PG8_SB(b, h) ((4 + (b) * 2 + (h)) * HTB)
#define PG8_STAGE(bufoff, gbase, voff) do { _Pragma("unroll") for (int _i = 0; _i < 2; ++_i) \
        __builtin_amdgcn_global_load_lds((const unsigned*)((const char*)(gbase) + (voff)[_i]), (LAS unsigned*)(lds + (bufoff) + ldsw + _i * 8192), 16, 0, 0); } while (0)
#define PG8_LDA(dst, b, h) do { _Pragma("unroll") for (int m = 0; m < 4; ++m) _Pragma("unroll") for (int k = 0; k < 2; ++k) dst[m][k] = *(const LAS bf16x8*)(lds + PG8_SA(b, h) + aoff + m * 2048 + k * 1024); } while (0)
#define PG8_LDB(dst, b, h) do { _Pragma("unroll") for (int n = 0; n < 2; ++n) _Pragma("unroll") for (int k = 0; k < 2; ++k) dst[n][k] = *(const LAS bf16x8*)(lds + PG8_SB(b, h) + boff + n * 2048 + k * 1024); } while (0)
#define PG8_MMA(ai, bj, At, Bt) do { __builtin_amdgcn_s_setprio(1); _Pragma("unroll") for (int m = 0; m < 4; ++m) _Pragma("unroll") for (int n = 0; n < 2; ++n) _Pragma("unroll") for (int k = 0; k < 2; ++k) \
        acc[ai][bj][m][n] = __builtin_amdgcn_mfma_f32_16x16x32_bf16(Bt[n][k], At[m][k], acc[ai][bj][m][n], 0, 0, 0); __builtin_amdgcn_s_setprio(0); } while (0)
#define PG8_WAIT_V(n) asm volatile("s_waitcnt vmcnt(" #n ")" ::: "memory")
#define PG8_WAIT_L(n) asm volatile("s_waitcnt lgkmcnt(" #n ")" ::: "memory")
#define PG8_BAR __builtin_amdgcn_s_barrier()
#define PG8_SCHED __builtin_amdgcn_sched_barrier(0)
    Unit cur, nxt; int ui = 0;
    if (!S.next(0, cur)) return;
    f32x4 acc[2][2][4][2];
#pragma unroll
    for (int a = 0; a < 2; ++a)
#pragma unroll
        for (int b = 0; b < 2; ++b)
#pragma unroll
            for (int m = 0; m < 4; ++m)
#pragma unroll
                for (int n = 0; n < 2; ++n) acc[a][b][m][n] = (f32x4){0.f, 0.f, 0.f, 0.f};
    bf16x8 At[4][2], B0[2][2], B1[2][2];
    unsigned ao0[2], ao1[2];
    PG8_AOFF(cur, ao0, ao1);
    const char* const bA = (const char*)gA;
    const char* cB = (const char*)gBt + (size_t)cur.brow0 * K * 2;
    PG8_STAGE(PG8_SB(0, 0), cB, voffB); PG8_STAGE(PG8_SB(0, 1), cB + hstep, voffB); PG8_STAGE(PG8_SA(0, 0), bA, ao0); PG8_STAGE(PG8_SA(0, 1), bA, ao1);
    if (wr == 1) PG8_BAR;
    PG8_WAIT_V(2); PG8_BAR;
    PG8_STAGE(PG8_SB(1, 0), cB + kstep, voffB); PG8_STAGE(PG8_SA(1, 0), bA + kstep, ao0); PG8_STAGE(PG8_SB(1, 1), cB + hstep + kstep, voffB);
    PG8_WAIT_V(6); PG8_BAR;
    for (;;) {
        const bool has_next = S.next(ui + 1, nxt);
        const char* nB = has_next ? (const char*)gBt + (size_t)nxt.brow0 * K * 2 : cB;
        _Pragma("clang loop unroll(disable)") for (int t = 0; t < nt; t += 2) {
            const bool last = (t == nt - 2);
            const char* a1 = bA + (size_t)(t + 1) * kstep;
            const char* a2 = last ? bA : bA + (size_t)(t + 2) * kstep; const char* b2 = last ? nB : cB + (size_t)(t + 2) * kstep;
            const char* a3 = a2 + kstep; const char* b3 = b2 + kstep;
            unsigned o20[2], o21[2];
            if (last && has_next) { PG8_AOFF(nxt, o20, o21); } else {
#pragma unroll
                for (int i = 0; i < 2; ++i) { o20[i] = ao0[i]; o21[i] = ao1[i]; } }
            PG8_LDB(B0, 0, 0); PG8_LDB(B1, 0, 1); PG8_SCHED; PG8_LDA(At, 0, 0); PG8_STAGE(PG8_SA(1, 1), a1, ao1);
            PG8_WAIT_V(8); PG8_WAIT_L(0); PG8_BAR; PG8_MMA(0, 0, At, B0); PG8_MMA(0, 1, At, B1); PG8_BAR; PG8_SCHED;
            PG8_LDA(At, 0, 1); PG8_STAGE(PG8_SB(0, 0), b2, voffB); PG8_STAGE(PG8_SB(0, 1), b2 + hstep, voffB); PG8_STAGE(PG8_SA(0, 0), a2, o20);
            PG8_WAIT_V(8); PG8_WAIT_L(0); PG8_BAR; PG8_MMA(1, 0, At, B0); PG8_MMA(1, 1, At, B1); PG8_BAR; PG8_SCHED;
            PG8_LDB(B0, 1, 0); PG8_LDB(B1, 1, 1); PG8_SCHED; PG8_LDA(At, 1, 0); PG8_STAGE(PG8_SA(0, 1), a2, o21);
            PG8_WAIT_V(8); PG8_WAIT_L(0); PG8_BAR; PG8_MMA(0, 0, At, B0); PG8_MMA(0, 1, At, B1); PG8_BAR; PG8_SCHED;
            PG8_LDA(At, 1, 1); PG8_STAGE(PG8_SB(1, 0), b3, voffB); PG8_STAGE(PG8_SB(1, 1), b3 + hstep, voffB); PG8_STAGE(PG8_SA(1, 0), a3, o20);
            PG8_WAIT_V(8); PG8_WAIT_L(0); PG8_BAR; PG8_MMA(1, 0, At, B0); PG8_MMA(1, 1, At, B1); PG8_BAR; PG8_SCHED;
        }
        if (wr == 0) PG8_BAR;
        E(acc, cur, wr, wc, fr, fq);
        if (!has_next) break;
#pragma unroll
        for (int a = 0; a < 2; ++a)
#pragma unroll
            for (int b = 0; b < 2; ++b)
#pragma unroll
                for (int m = 0; m < 4; ++m)
#pragma unroll
                    for (int n = 0; n < 2; ++n) acc[a][b][m][n] = (f32x4){0.f, 0.f, 0.f, 0.f};
        cur = nxt; cB = nB; ++ui;
        PG8_AOFF(cur, ao0, ao1);
        if (wr == 1) PG8_BAR;
    }
    PG8_WAIT_V(0);
    PG8_BAR;
#undef PG8_AOFF
#undef PG8_SA
#undef PG8_SB
#undef PG8_STAGE
#undef PG8_LDA
#undef PG8_LDB
#undef PG8_MMA
#undef PG8_WAIT_V
#undef PG8_WAIT_L
#undef PG8_BAR
#undef PG8_SCHED
}
}

#define XB_TMO      128
#define XB_XCNT(j)  (256  + 64 * (j))
#define XB_XSUB(j)  (1280 + 64 * (j))
#define XB_XGEN(j)  (2304 + 64 * (j))
#define XB_TOP      3328
#define XB_TOPGEN   3392
#define XCD_BAR_WORDS 3456
#define XB_SPIN_CAP (1u << 18)
__device__ __forceinline__ unsigned xb_ld(unsigned* p)              { return __hip_atomic_load(p, __ATOMIC_RELAXED, __HIP_MEMORY_SCOPE_AGENT); }
__device__ __forceinline__ unsigned xb_add(unsigned* p, unsigned v) { return __hip_atomic_fetch_add(p, v, __ATOMIC_RELAXED, __HIP_MEMORY_SCOPE_AGENT); }
__device__ __forceinline__ unsigned xb_xcc_id() { return (unsigned)__builtin_amdgcn_s_getreg((3 << 11) | 20) & 0xFu; }
#define XB_SPIN(cond, bar) do { unsigned _sp = 0; while (cond) { __builtin_amdgcn_s_sleep(1); \
    if ((++_sp & 255u) == 0u) { if (xb_ld(&(bar)[XB_TMO])) break; if (_sp > XB_SPIN_CAP) { atomicAdd(&(bar)[XB_TMO], 1u); break; } } } } while (0)
struct XcdBarrier { unsigned* bar; unsigned x; volatile LAS unsigned* st; };
__device__ __forceinline__ XcdBarrier xcd_barrier_post(unsigned* bar, volatile LAS unsigned* st) {
    XcdBarrier b; b.bar = bar; b.x = xb_xcc_id(); b.st = st;
    if (threadIdx.x == 0) (void)xb_add(&bar[XB_XCNT(b.x)], 1u);
    return b;
}
__device__ __forceinline__ void xcd_barrier_complete(unsigned* bar, unsigned x, unsigned& nloc, unsigned& nx) {
    const unsigned G = gridDim.x * gridDim.y * gridDim.z;
    unsigned sum, cnt, mine, sp = 0u;
    for (;;) {
        sum = 0u; cnt = 0u; mine = 0u;
#pragma unroll
        for (unsigned j = 0; j < 16; ++j) { const unsigned c = xb_ld(&bar[XB_XCNT(j)]); sum += c; cnt += (c > 0u) ? 1u : 0u; mine = (j == x) ? c : mine; }
        if (sum == G) break;
        __builtin_amdgcn_s_sleep(1);
        if ((++sp & 255u) == 0u) { if (xb_ld(&bar[XB_TMO])) break; if (sp > XB_SPIN_CAP) { atomicAdd(&bar[XB_TMO], 1u); break; } }
    }
    nloc = mine > 0u ? mine : 1u; nx = cnt > 0u ? cnt : 1u;
}
__device__ __forceinline__ void xcd_barrier(const XcdBarrier& b) {
    asm volatile("s_waitcnt vmcnt(0)" ::: "memory");
    __syncthreads();
    if (threadIdx.x == 0) {
        unsigned* bar = b.bar;
        __builtin_amdgcn_s_waitcnt(0);
        unsigned nloc = b.st[0], nx = b.st[1];
        if (nloc == 0u) { xcd_barrier_complete(bar, b.x, nloc, nx); b.st[0] = nloc; b.st[1] = nx; }
        const unsigned old = xb_add(&bar[XB_XSUB(b.x)], 1u);
        const unsigned gen = old / nloc;
        if (old + 1u == (gen + 1u) * nloc) {
            __builtin_amdgcn_fence(__ATOMIC_RELEASE, "agent");
            asm volatile("s_waitcnt vmcnt(0)" ::: "memory");
            const unsigned og = xb_add(&bar[XB_TOP], 1u);
            const unsigned tg = og / nx;
            if (og + 1u == (tg + 1u) * nx) xb_add(&bar[XB_TOPGEN], 1u);
            else XB_SPIN(xb_ld(&bar[XB_TOPGEN]) == tg, bar);
            __builtin_amdgcn_fence(__ATOMIC_ACQUIRE, "agent");
            xb_add(&bar[XB_XGEN(b.x)], 1u);
            asm volatile("s_waitcnt vmcnt(0)" ::: "memory");
        } else {
            XB_SPIN(xb_ld(&bar[XB_XGEN(b.x)]) == gen, bar);
            __builtin_amdgcn_fence(__ATOMIC_ACQUIRE, "agent");
            asm volatile("s_waitcnt vmcnt(0)" ::: "memory");
        }
    }
    __syncthreads();
}

constexpr int RING_BYTES = 131072;
constexpr int ROW_OFF = RING_BYTES, TOK_UNITS = 18;
constexpr int TOK_OFF = ROW_OFF + TOK_UNITS * 1024;
constexpr int TBL_OFF = TOK_OFF + TOK_UNITS * 512;
constexpr int LDSCTL_OFF = TBL_OFF + 512;
constexpr int MK_LDS_BYTES = LDSCTL_OFF + 256;
static_assert(MK_LDS_BYTES <= 160 * 1024, "LDS map");

struct MArgs { const float* in[18]; float* out; unsigned char* ws; int ph_lo, ph_hi; };
struct Frame {
    LAS unsigned char* lds; int tid, lane, wave, vcu, G;
    unsigned char* ws; unsigned* ctl;
};
__device__ __forceinline__ unsigned pkb(float lo, float hi) { return pg8::cvt_pk_bf16(lo, hi); }

template <int MODE>
__device__ __forceinline__ void p0_transpose_item(const float* W, const float* g, int K, int N, bf16_t* WT, LAS float* scr, int item, int lane) {
    const int nblk = N / 32, kb = item / nblk, nb = item % nblk, k0 = 64 * kb, n0 = 32 * nb;
    float v[32];
#pragma unroll
    for (int i = 0; i < 32; ++i) { const int kk = 2 * i + (lane >> 5); v[i] = W[(size_t)(k0 + kk) * N + n0 + (lane & 31)]; }
    const float g0 = g ? g[k0 + lane] : 1.f;
#pragma unroll
    for (int i = 0; i < 32; ++i) { const int kk = 2 * i + (lane >> 5); const float gg = __shfl(g0, kk); scr[kk * 33 + (lane & 31)] = v[i] * gg; }
    asm volatile("s_waitcnt lgkmcnt(0)" ::: "memory");
    const int c = lane & 7;
#pragma unroll
    for (int j = 0; j < 4; ++j) { const int n = (lane >> 3) + 8 * j; const LAS float* s = scr + (8 * c) * 33 + n;
        u32x4 o; o.x = pkb(s[0 * 33], s[1 * 33]); o.y = pkb(s[2 * 33], s[3 * 33]); o.z = pkb(s[4 * 33], s[5 * 33]); o.w = pkb(s[6 * 33], s[7 * 33]);
        int nn = n0 + n;
        if (MODE == 1) { const int half = nn / FF, j2 = nn % FF; nn = (j2 >> 7) * 256 + half * 128 + (j2 & 127); }
        *(u32x4*)(WT + (size_t)nn * K + k0 + 8 * c) = o; }
    asm volatile("s_waitcnt lgkmcnt(0)" ::: "memory");
}
__device__ __forceinline__ void p0_prologue(Frame& F, const MArgs& args) {
    LAS float* scr = (LAS float*)(F.lds + F.wave * 16384);
    const int gw = F.vcu * MK_WAVES + F.wave, NGW = F.G * MK_WAVES, lane = F.lane;
    unsigned char* ws = F.ws;
    {
        const float* x = args.in[0]; bf16_t* HB = (bf16_t*)(ws + WS_HB); float* SS = (float*)(ws + WS_SS);
        for (int row = gw; row < NTOK; row += NGW) {
            const f32x4* p = (const f32x4*)(x + (size_t)row * DM) + lane; f32x4 v[4]; float s = 0.f;
#pragma unroll
            for (int j = 0; j < 4; ++j) { v[j] = p[64 * j]; s += v[j].x * v[j].x + v[j].y * v[j].y + v[j].z * v[j].z + v[j].w * v[j].w; }
            s = wave_sum(s);
            if (lane < 16) SS[(size_t)row * 16 + lane] = (lane == 0) ? s : 0.f;
            u32x2* o = (u32x2*)(HB + (size_t)row * DM) + lane;
#pragma unroll
            for (int j = 0; j < 4; ++j) { u32x2 w; w.x = pkb(v[j].x, v[j].y); w.y = pkb(v[j].z, v[j].w); o[64 * j] = w; }
        }
        const float* pp = args.in[1]; bf16_t* PB = (bf16_t*)(ws + WS_PB);
        const size_t n4 = (size_t)DEPTH * NTOK * PLE / 4;
        for (size_t i = (size_t)gw * 64 + lane; i < n4; i += (size_t)NGW * 64) { const f32x4 v = ((const f32x4*)pp)[i]; u32x2 w; w.x = pkb(v.x, v.y); w.y = pkb(v.z, v.w); ((u32x2*)PB)[i] = w; }
    }
    constexpr int I_QKV = (DM / 64) * (3 * DM / 32), I_SQ = (DM / 64) * (DM / 32), I_WP = (PLE / 64) * (DM / 32), I_GU = (DM / 64) * (2 * FF / 32), I_WD = (FF / 64) * (DM / 32), I_WR = (DM / 64) * (NE / 32);
    constexpr int PER_LAYER = I_QKV + 2 * I_SQ + I_WP + NE * I_GU + NE * I_WD + I_WR;
    const float* g_mix = args.in[2]; const float* w_qkv = args.in[3]; const float* w_fgate = args.in[4]; const float* w_o = args.in[6]; const float* g_moe = args.in[7]; const float* w_router = args.in[8];
    const float* w_gu = args.in[10]; const float* w_down = args.in[12]; const float* g_ple = args.in[14]; const float* w_ple_gate = args.in[15]; const float* w_ple_proj = args.in[16];
    for (int it = gw; it < DEPTH * PER_LAYER; it += NGW) {
        const int L = it / PER_LAYER; int r = it - L * PER_LAYER;
        if (r < I_QKV) { p0_transpose_item<0>(w_qkv + (size_t)L * DM * 3 * DM, g_mix + L * DM, DM, 3 * DM, (bf16_t*)(ws + WS_WQKV) + (size_t)L * 3 * DM * DM, scr, r, lane); continue; } r -= I_QKV;
        if (r < I_SQ) { p0_transpose_item<0>(w_o + (size_t)L * DM * DM, nullptr, DM, DM, (bf16_t*)(ws + WS_WO) + (size_t)L * DM * DM, scr, r, lane); continue; } r -= I_SQ;
        if (r < I_SQ) { p0_transpose_item<0>(w_ple_gate + (size_t)L * DM * DM, g_ple + L * DM, DM, DM, (bf16_t*)(ws + WS_WG) + (size_t)L * DM * DM, scr, r, lane); continue; } r -= I_SQ;
        if (r < I_WP) { p0_transpose_item<0>(w_ple_proj + (size_t)L * PLE * DM, nullptr, PLE, DM, (bf16_t*)(ws + WS_WP) + (size_t)L * DM * PLE, scr, r, lane); continue; } r -= I_WP;
        if (r < I_WR) { p0_transpose_item<0>(w_router + (size_t)L * DM * NE, g_moe + L * DM, DM, NE, (bf16_t*)(ws + WS_WR) + (size_t)L * NE * DM, scr, r, lane); continue; } r -= I_WR;
        if (r < NE * I_GU) { const int e = r / I_GU; p0_transpose_item<1>(w_gu + ((size_t)L * NE + e) * DM * 2 * FF, g_moe + L * DM, DM, 2 * FF, (bf16_t*)(ws + WS_WGU) + ((size_t)L * NE + e) * 2 * FF * DM, scr, r - e * I_GU, lane); continue; } r -= NE * I_GU;
        { const int e = r / I_WD; p0_transpose_item<0>(w_down + ((size_t)L * NE + e) * FF * DM, nullptr, FF, DM, (bf16_t*)(ws + WS_WD) + ((size_t)L * NE + e) * DM * FF, scr, r - e * I_WD, lane); }
    }
    if (gw < 256) { bf16_t* WF = (bf16_t*)(ws + WS_WF); const int idx = gw * 64 + lane; const int n = idx >> 10, k = idx & 1023; WF[idx] = (bf16_t)f2bf(w_fgate[(size_t)k * NH + n] * g_mix[DM + k]); }
}

__device__ __forceinline__ void moe_tables(Frame& F, const unsigned* cnt) {
    LAS int* tstartL = (LAS int*)(F.lds + TBL_OFF); LAS int* cntL = tstartL + 64;
    if (F.wave == 0) {
        const int lane = F.lane; const int c = (lane < NE) ? (int)__hip_atomic_load(cnt + (lane & 31), __ATOMIC_RELAXED, __HIP_MEMORY_SCOPE_AGENT) : 0; const int nt = (c + 255) >> 8; int incl = nt;
#pragma unroll
        for (int o = 1; o < 32; o <<= 1) { const int t = __shfl_up(incl, o); if ((lane & 31) >= o) incl += t; }
        if (lane < NE) { tstartL[lane] = incl - nt; cntL[lane] = c; if (lane == NE - 1) tstartL[NE] = incl; }
    }
    __syncthreads();
}
__device__ __forceinline__ void router_phase(Frame& F, const bf16_t* HB, const bf16_t* WR, const float* br, float* rstd, unsigned* cnt, int* tok_of, float* gate_of, unsigned* pair) {
    const int gw = F.vcu * MK_WAVES + F.wave, NGW = F.G * MK_WAVES, lane = F.lane, r = lane & 15, quad = lane >> 4;
    for (int blk = gw; blk < NTOK / 16; blk += NGW) {
        const int t0 = blk * 16;
        const bf16_t* ap = HB + (size_t)(t0 + r) * DM + quad * 8; const bf16_t* bp0 = WR + (size_t)r * DM + quad * 8; const bf16_t* bp1 = bp0 + (size_t)16 * DM;
        f32x4 acc0 = {0.f, 0.f, 0.f, 0.f}, acc1 = {0.f, 0.f, 0.f, 0.f}; float ssq = 0.f;
#pragma unroll 8
        for (int ks = 0; ks < 32; ++ks) { const bf16x8 a = *(const bf16x8*)(ap + 32 * ks), b0 = *(const bf16x8*)(bp0 + 32 * ks), b1 = *(const bf16x8*)(bp1 + 32 * ks);
            acc0 = __builtin_amdgcn_mfma_f32_16x16x32_bf16(a, b0, acc0, 0, 0, 0); acc1 = __builtin_amdgcn_mfma_f32_16x16x32_bf16(a, b1, acc1, 0, 0, 0);
#pragma unroll
            for (int j = 0; j < 8; ++j) { const float f = __uint_as_float(((unsigned)(unsigned short)a[j]) << 16); ssq += f * f; } }
        ssq += __shfl_xor(ssq, 16); ssq += __shfl_xor(ssq, 32);
        const float rs_r = rsqrtf(ssq * (1.f / DM) + EPS);
        const float b_lo = br[r], b_hi = br[16 + r];
#pragma unroll
        for (int j = 0; j < 4; ++j) {
            const float rsj = __shfl(rs_r, quad * 4 + j); const int t = t0 + quad * 4 + j;
            float v0 = acc0[j] * rsj + b_lo, v1 = acc1[j] * rsj + b_hi; float tv[4]; int ti[4];
#pragma unroll
            for (int k = 0; k < 4; ++k) {
                float bv = (v0 >= v1) ? v0 : v1; int bi = (v0 >= v1) ? r : 16 + r;
#pragma unroll
                for (int o = 1; o < 16; o <<= 1) { const float ov = __shfl_xor(bv, o); const int oi = __shfl_xor(bi, o); if (ov > bv || (ov == bv && oi < bi)) { bv = ov; bi = oi; } }
                tv[k] = bv; ti[k] = bi; if (bi == r) v0 = -INFINITY; if (bi == 16 + r) v1 = -INFINITY;
            }
            float w[4], sw = 0.f;
#pragma unroll
            for (int k = 0; k < 4; ++k) { w[k] = __expf(tv[k] - tv[0]); sw += w[k]; }
            if (r < 4) { const int ee = (r == 0) ? ti[0] : (r == 1) ? ti[1] : (r == 2) ? ti[2] : ti[3]; const float ww = (r == 0) ? w[0] : (r == 1) ? w[1] : (r == 2) ? w[2] : w[3];
                const unsigned rk = __hip_atomic_fetch_add(&cnt[ee], 1u, __ATOMIC_RELAXED, __HIP_MEMORY_SCOPE_AGENT);
                tok_of[(size_t)ee * CAP + rk] = t; gate_of[(size_t)ee * CAP + rk] = ww / sw; pair[(size_t)t * 4 + r] = ((unsigned)ee << 16) | rk; }
            if (r == 4) rstd[t] = rsj;
        }
    }
}
__device__ __forceinline__ void fgate_phase(Frame& F, const bf16_t* HB, const bf16_t* WF, const float* bfg, const float* SS, float* FL) {
    const int gw = F.vcu * MK_WAVES + F.wave, NGW = F.G * MK_WAVES, lane = F.lane, r = lane & 15, quad = lane >> 4;
    for (int blk = gw; blk < NTOK / 16; blk += NGW) {
        const int t0 = blk * 16;
        const bf16_t* ap = HB + (size_t)(t0 + r) * DM + quad * 8; const bf16_t* bp0 = WF + (size_t)r * DM + quad * 8;
        f32x4 acc0 = {0.f, 0.f, 0.f, 0.f};
#pragma unroll 8
        for (int ks = 0; ks < 32; ++ks) { const bf16x8 a = *(const bf16x8*)(ap + 32 * ks), b0 = *(const bf16x8*)(bp0 + 32 * ks); acc0 = __builtin_amdgcn_mfma_f32_16x16x32_bf16(a, b0, acc0, 0, 0, 0); }
        const f32x4 sp = *(const f32x4*)(SS + (size_t)(t0 + r) * 16 + quad * 4); float ss = (sp.x + sp.y) + (sp.z + sp.w); ss += __shfl_xor(ss, 16); ss += __shfl_xor(ss, 32);
        const float rs_r = rsqrtf(ss * (1.f / DM) + EPS); const float bb = bfg[r];
#pragma unroll
        for (int j = 0; j < 4; ++j) { const float rsj = __shfl(rs_r, quad * 4 + j); FL[(size_t)(t0 + quad * 4 + j) * NH + r] = acc0[j] * rsj + bb; }
    }
}
__device__ __forceinline__ void combine_phase(Frame& F, float* h, bf16_t* hb, float* rstd, const unsigned* pair, const bf16_t* Y) {
    const int gw = F.vcu * MK_WAVES + F.wave, NGW = F.G * MK_WAVES, lane = F.lane; const LAS int* tstartL = (const LAS int*)(F.lds + TBL_OFF);
    for (int t = gw; t < NTOK; t += NGW) {
        f32x4 v[4]; f32x4* hr = (f32x4*)(h + (size_t)t * DM) + lane;
        const u32x4 pr4 = *(const u32x4*)(pair + (size_t)t * 4);
#pragma unroll
        for (int j = 0; j < 4; ++j) v[j] = hr[64 * j];
#pragma unroll
        for (int k = 0; k < 4; ++k) {
            const unsigned pr = (k == 0) ? pr4.x : (k == 1) ? pr4.y : (k == 2) ? pr4.z : pr4.w; const int e = __builtin_amdgcn_readfirstlane((int)(pr >> 16)), rk = __builtin_amdgcn_readfirstlane((int)(pr & 0xffffu));
            const size_t slot = (size_t)tstartL[e] * 256 + rk; const u32x2* yr = (const u32x2*)(Y + slot * DM) + lane;
#pragma unroll
            for (int j = 0; j < 4; ++j) { const u32x2 w = yr[64 * j]; v[j].x += __uint_as_float(w.x << 16); v[j].y += __uint_as_float(w.x & 0xffff0000u); v[j].z += __uint_as_float(w.y << 16); v[j].w += __uint_as_float(w.y & 0xffff0000u); }
        }
        float s = 0.f;
#pragma unroll
        for (int j = 0; j < 4; ++j) { hr[64 * j] = v[j]; s += v[j].x * v[j].x + v[j].y * v[j].y + v[j].z * v[j].z + v[j].w * v[j].w; }
        s = wave_sum(s); if (lane == 0) rstd[t] = rsqrtf(s * (1.f / DM) + EPS);
        u32x2* o = (u32x2*)(hb + (size_t)t * DM) + lane;
#pragma unroll
        for (int j = 0; j < 4; ++j) { u32x2 w; w.x = pkb(v[j].x, v[j].y); w.y = pkb(v[j].z, v[j].w); o[64 * j] = w; }
    }
}
__device__ __forceinline__ void final_phase(Frame& F, const float* h, const float* SS, const float* g, float* out) {
    const int gw = F.vcu * MK_WAVES + F.wave, NGW = F.G * MK_WAVES, lane = F.lane;
    f32x4 gg[4];
#pragma unroll
    for (int j = 0; j < 4; ++j) gg[j] = ((const f32x4*)g)[lane + 64 * j];
    for (int row = gw; row < NTOK; row += NGW) {
        const f32x4* p = (const f32x4*)(h + (size_t)row * DM) + lane; f32x4 v[4];
#pragma unroll
        for (int j = 0; j < 4; ++j) v[j] = p[64 * j];
        float ss = (lane < 16) ? SS[(size_t)row * 16 + lane] : 0.f; ss = wave_sum(ss);
        const float rs = rsqrtf(ss * (1.f / DM) + EPS);
        f32x4* o = (f32x4*)(out + (size_t)row * DM) + lane;
#pragma unroll
        for (int j = 0; j < 4; ++j) o[64 * j] = v[j] * rs * gg[j];
    }
}
__device__ __forceinline__ void attn_sb_head(Frame& F, int bh, const bf16_t* Q, const bf16_t* K, const bf16_t* V, bf16_t* O) {
    const int lane = F.lane, b = bh / NH, hh = bh % NH; const size_t rowb = (size_t)b * SEQ;
    for (int t = F.wave; t < SEQ; t += MK_WAVES) {
        float q[64]; loadq(q, Q + (rowb + t) * DM + hh * HD);
        float o = 0.f, carry = 1.f;
        for (int jt = (t - 1) >> 6; jt >= 0 && t > 0; --jt) {
            const int s = 64 * jt + lane; const bool valid = s < t;
            float x = dot64(q, K + (rowb + s) * DM + hh * HD); x = fminf(x, 64.f);
            const float ex = exp2f(x), r = 1.f / (1.f + ex);
            const float beta = valid ? ex * r : 0.f, nb = valid ? r : 1.f;
            float P = nb;
#pragma unroll
            for (int off = 1; off < 64; off <<= 1) { const float t2 = __shfl_down(P, off); if (lane + off < 64) P *= t2; }
            float Pex = __shfl_down(P, 1); if (lane == 63) Pex = 1.f;
            const float a = beta * carry * Pex;
            carry *= __shfl(P, 0);
            const bf16_t* vb = V + (rowb + 64 * jt) * DM + hh * HD + lane;
            for (int l = 0; l < 64; ++l) { const float al = __shfl(a, l); o += al * bf2f(vb[(size_t)l * DM]); }
            if (carry < 1e-30f) break;
        }
        O[(rowb + t) * DM + hh * HD + lane] = (bf16_t)f2bf(o);
    }
}
__device__ __forceinline__ void attn_fox_head(Frame& F, int bh, const bf16_t* Q, const bf16_t* K, const bf16_t* V, const float* FL, bf16_t* O) {
    const int lane = F.lane, b = bh / NH, hh = bh % NH; const size_t rowb = (size_t)b * SEQ;
    LAS float* cbL = (LAS float*)(F.lds); LAS float* wtot = (LAS float*)(F.lds + 8192);
    {
        float loc[4]; float run = 0.f;
#pragma unroll
        for (int i = 0; i < 4; ++i) { run += log_sigmoid(FL[(size_t)(rowb + F.tid * 4 + i) * NH + hh]); loc[i] = run; }
        float incl = run;
#pragma unroll
        for (int o = 1; o < 64; o <<= 1) { const float t = __shfl_up(incl, o); if (lane >= o) incl += t; }
        if (lane == 63) wtot[F.wave] = incl;
        __syncthreads();
        float base = incl - run;
        for (int w = 0; w < F.wave; ++w) base += wtot[w];
#pragma unroll
        for (int i = 0; i < 4; ++i) cbL[F.tid * 4 + i] = (base + loc[i]) * LOG2E;
        __syncthreads();
    }
    for (int t = F.wave; t < SEQ; t += MK_WAVES) {
        float q[64]; loadq(q, Q + (rowb + t) * DM + hh * HD);
        float o = 0.f, m = -INFINITY, l = 0.f;
        for (int jt = 0; jt <= (t >> 6); ++jt) {
            const int s = 64 * jt + lane; const bool valid = s <= t;
            float x = dot64(q, K + (rowb + s) * DM + hh * HD) - cbL[s];
            x = valid ? x : -INFINITY;
            const float mn = fmaxf(m, wave_max(x)); const float alpha = exp2f(m - mn); const float p = exp2f(x - mn);
            l = l * alpha + wave_sum(p); o *= alpha; m = mn;
            const bf16_t* vb = V + (rowb + 64 * jt) * DM + hh * HD + lane;
            const int nl = min(64, t - 64 * jt + 1);
            for (int i = 0; i < nl; ++i) { const float pi = __shfl(p, i); o += pi * bf2f(vb[(size_t)i * DM]); }
        }
        O[(rowb + t) * DM + hh * HD + lane] = (bf16_t)f2bf(o / l);
    }
    __syncthreads();
}

__device__ __forceinline__ void fox_head(Frame& F, unsigned char* lds_generic, int bh, const bf16_t* Q, const bf16_t* K, const bf16_t* V, const float* FL, bf16_t* O) {
    int tid_ = threadIdx.x; asm volatile("" : "+v"(tid_));
    const int lane = tid_ & 63, b = bh / NH, hh = bh % NH; const size_t rowb = (size_t)b * SEQ;
    LAS float* cbL = (LAS float*)(F.lds + attn_body::ATTN_LDS_BYTES); LAS float* wtot = cbL + SEQ;
    {
        float loc[4]; float run = 0.f;
#pragma unroll
        for (int i = 0; i < 4; ++i) { run += log_sigmoid(FL[(size_t)(rowb + tid_ * 4 + i) * NH + hh]); loc[i] = run; }
        float incl = run;
#pragma unroll
        for (int o = 1; o < 64; o <<= 1) { const float t = __shfl_up(incl, o); if (lane >= o) incl += t; }
        if (lane == 63) wtot[F.wave] = incl;
        __syncthreads();
        float base = incl - run;
        for (int w = 0; w < F.wave; ++w) base += wtot[w];
#pragma unroll
        for (int i = 0; i < 4; ++i) cbL[tid_ * 4 + i] = (base + loc[i]) * LOG2E;
        __syncthreads();
    }
    for (int qb = 0; qb < SEQ / 256; ++qb)
        attn_body::attn_unit<8>(b, hh, qb, (const attn_body::bf16*)Q, (const attn_body::bf16*)K, (const attn_body::bf16*)V, (attn_body::bf16*)O, (char*)lds_generic, cbL);
}
constexpr int N_PHASES = 18;
__global__ void __launch_bounds__(MK_WAVES * 64, 2) mega_fwd(MArgs args) {
    extern __shared__ __attribute__((aligned(16))) unsigned char lds_raw[];
    Frame F;
    F.lds = (LAS unsigned char*)lds_raw;
    F.tid = threadIdx.x; F.lane = F.tid & 63; F.wave = __builtin_amdgcn_readfirstlane(F.tid >> 6);
    F.G = gridDim.x; { const int bx = blockIdx.x; F.vcu = (F.G % 8 == 0) ? (bx % 8) * (F.G / 8) + bx / 8 : bx; }
    F.ws = args.ws; F.ctl = (unsigned*)(args.ws + WS_CTL);
    unsigned char* ws = args.ws;
    for (int u = F.tid; u < (MK_LDS_BYTES - LDSCTL_OFF) / 4; u += MK_WAVES * 64) ((LAS unsigned*)(F.lds + LDSCTL_OFF))[u] = 0u;
    __syncthreads();
    const int lo = args.ph_lo, hi = args.ph_hi;
    const bool use_bar = (hi - lo) > 1;
    XcdBarrier bar; bar.bar = F.ctl + CW_BAR; bar.x = 0; bar.st = nullptr;
    if (use_bar) bar = xcd_barrier_post(F.ctl + CW_BAR, (volatile LAS unsigned*)(F.lds + LDSCTL_OFF + 32));
#ifndef MK_ATTSUB
#define MK_ATTSUB 3
#endif
#ifndef MK_P0SUB
#define MK_P0SUB 7
#endif
#ifndef MK_PHMASK
#define MK_PHMASK 0x3ff
#endif
#define IN(k) (lo <= (k) && (k) < hi)
#define EN(j) ((MK_PHMASK >> (j)) & 1)
#define PHASE_BEGIN() do { int t_ = threadIdx.x; asm volatile("" : "+v"(t_)); F.tid = t_; F.lane = t_ & 63; } while (0)
#define SEAM(k) do { if (IN(k) && IN((k) + 1)) xcd_barrier(bar); } while (0)
    bf16_t* const HB0 = (bf16_t*)(ws + WS_HB); bf16_t* const HB1 = (bf16_t*)(ws + WS_HB2); float* const H = (float*)(ws + WS_H); float* const SS = (float*)(ws + WS_SS);
    bf16_t* const Qb = (bf16_t*)(ws + WS_Q); bf16_t* const Kb = (bf16_t*)(ws + WS_K); bf16_t* const Vb = (bf16_t*)(ws + WS_V); bf16_t* const Ob = (bf16_t*)(ws + WS_O);
    float* const rstd_moe = (float*)(ws + WS_RSTD) + NTOK; float* const rstd_ple = rstd_moe + NTOK;
    int* const tok_of = (int*)(ws + WS_TOK); float* const gate_of = (float*)(ws + WS_GATE); unsigned* const pair = (unsigned*)(ws + WS_PAIR);
    bf16_t* const ACT = (bf16_t*)(ws + WS_ACT); bf16_t* const Yb = (bf16_t*)(ws + WS_Y); float* const FL = (float*)(ws + WS_FL);
    LAS int* const tstartL = (LAS int*)(F.lds + TBL_OFF); LAS int* const cntL = tstartL + 64; LAS unsigned short* const tokL = (LAS unsigned short*)(F.lds + TOK_OFF); LAS float* const rowL = (LAS float*)(F.lds + ROW_OFF);

    if (EN(8) && IN(0)) { p0_prologue(F, args); }
    SEAM(0);
    for (int L = 0; L < DEPTH; ++L) {
        const int pb = 1 + 8 * L;
        unsigned* const cnt = F.ctl + CW_CNT + 64 * L;
        bf16_t* const HBa = (L & 1) ? HB1 : HB0; bf16_t* const HBb = (L & 1) ? HB0 : HB1;
        if (EN(0) && IN(pb + 0)) { PHASE_BEGIN();
            if (MK_P0SUB & 1) if (L == 1) fgate_phase(F, HBa, (const bf16_t*)(ws + WS_WF), args.in[5], SS, FL);
            if (MK_P0SUB & 2) { pg8::DenseOrder S; S.init(NTOK, 3 * DM, F.G, (int)blockIdx.x); pg8::EpiQKV E{Qb, rowL};
              _Pragma("clang loop unroll(disable)") for (int i0 = 0; i0 < TOK_UNITS; i0 += 2) { const int i = i0 + (F.wave >> 2); pg8::Unit u; if (S.next(i, u)) { const int lr = F.tid & 255; const f32x4* sp = (const f32x4*)(SS + (size_t)(u.arow0 + lr) * 16);
                  const f32x4 s0 = sp[0], s1 = sp[1], s2 = sp[2], s3 = sp[3]; const float ss = ((s0.x + s0.y) + (s0.z + s0.w)) + ((s1.x + s1.y) + (s1.z + s1.w)) + ((s2.x + s2.y) + (s2.z + s2.w)) + ((s3.x + s3.y) + (s3.z + s3.w));
                  rowL[i * 256 + lr] = rsqrtf(ss * (1.f / DM) + EPS); } }
              __syncthreads();
              pg8::gemm_phase(F.lds, HBa, (const bf16_t*)(ws + WS_WQKV) + (size_t)L * 3 * DM * DM, DM, S, E); }
            if (MK_P0SUB & 4) if (L == 0) { pg8::PJOrder S; S.init(F.G, (int)blockIdx.x); pg8::EpiPJ E{(bf16_t*)(ws + WS_PJ)};
                pg8::gemm_phase(F.lds, (const bf16_t*)(ws + WS_PB), (const bf16_t*)(ws + WS_WP), PLE, S, E); }
        }
        SEAM(pb + 0);
        if (EN(1) && IN(pb + 1)) { PHASE_BEGIN();
#if defined(MK_SIMPLE_ATTN)
            for (int bh = blockIdx.x; bh < NB * NH; bh += F.G) { if (L == 0) attn_sb_head(F, bh, Qb, Kb, Vb, Ob); else attn_fox_head(F, bh, Qb, Kb, Vb, FL, Ob); }
#else
            if (L == 0) { if (MK_ATTSUB & 1) for (int bh = blockIdx.x; bh < NB * NH; bh += F.G) sb_body::sb_head(F.lds, F.lane, F.wave, bh, Qb, Kb, Vb, Ob); }
            else { if (MK_ATTSUB & 2) for (int bh = blockIdx.x; bh < NB * NH; bh += F.G) { fox_head(F, lds_raw, bh, Qb, Kb, Vb, FL, Ob); __syncthreads(); } }
#endif
        }
        SEAM(pb + 1);
        if (EN(2) && IN(pb + 2)) { PHASE_BEGIN();
            pg8::DenseOrder S; S.init(NTOK, DM, F.G, (int)blockIdx.x); pg8::EpiWo E{(L == 0) ? args.in[0] : (const float*)H, H, HBb};
            pg8::gemm_phase(F.lds, Ob, (const bf16_t*)(ws + WS_WO) + (size_t)L * DM * DM, DM, S, E);
        }
        SEAM(pb + 2);
        if (EN(3) && IN(pb + 3)) { PHASE_BEGIN(); router_phase(F, HBb, (const bf16_t*)(ws + WS_WR) + (size_t)L * NE * DM, args.in[9] + L * NE, rstd_moe, cnt, tok_of, gate_of, pair); }
        SEAM(pb + 3);
        if (EN(4) && IN(pb + 4)) { PHASE_BEGIN();
            moe_tables(F, cnt);
            pg8::MoeOrder S; S.NN = 8; S.nwg = tstartL[NE] * 8; S.G = F.G; S.c = (int)blockIdx.x; S.tstartL = tstartL; S.cntL = cntL; S.tokL = tokL; S.gather = true;
            _Pragma("clang loop unroll(disable)") for (int i0 = 0; i0 < TOK_UNITS; i0 += 2) { const int i = i0 + (F.wave >> 2); pg8::Unit u;
                if (S.next(i, u)) { const int lr = F.tid & 255; const int rk = u.rank0 + lr; const int tok = tok_of[(size_t)u.e * CAP + (rk < u.cnt ? rk : u.rank0)]; tokL[i * 256 + lr] = (unsigned short)tok; rowL[i * 256 + lr] = rstd_moe[tok]; } }
            __syncthreads();
            pg8::EpiGU E{ACT, args.in[11] + (size_t)L * NE * 2 * FF, rowL};
            pg8::gemm_phase(F.lds, HBb, (const bf16_t*)(ws + WS_WGU) + (size_t)L * NE * 2 * FF * DM, DM, S, E);
        }
        SEAM(pb + 4);
        if (EN(5) && IN(pb + 5)) { PHASE_BEGIN();
            moe_tables(F, cnt);
            pg8::MoeOrder S; S.NN = 4; S.nwg = tstartL[NE] * 4; S.G = F.G; S.c = (int)blockIdx.x; S.tstartL = tstartL; S.cntL = cntL; S.tokL = tokL; S.gather = false;
            _Pragma("clang loop unroll(disable)") for (int i0 = 0; i0 < TOK_UNITS; i0 += 2) { const int i = i0 + (F.wave >> 2); pg8::Unit u;
                if (S.next(i, u)) { const int lr = F.tid & 255; const int rk = u.rank0 + lr; rowL[i * 256 + lr] = (rk < u.cnt) ? gate_of[(size_t)u.e * CAP + rk] : 0.f; } }
            __syncthreads();
            pg8::EpiDown E{Yb, args.in[13] + (size_t)L * NE * DM, rowL};
            pg8::gemm_phase(F.lds, ACT, (const bf16_t*)(ws + WS_WD) + (size_t)L * NE * DM * FF, FF, S, E);
        }
        SEAM(pb + 5);
        if (EN(6) && IN(pb + 6)) { PHASE_BEGIN(); moe_tables(F, cnt); combine_phase(F, H, HBa, rstd_ple, pair, Yb); }
        SEAM(pb + 6);
        if (EN(7) && IN(pb + 7)) { PHASE_BEGIN();
            pg8::DenseOrder S; S.init(NTOK, DM, F.G, (int)blockIdx.x); pg8::EpiPLE E{H, HBb, (const bf16_t*)(ws + WS_PJ) + (size_t)L * NTOK * DM, rowL, SS};
            _Pragma("clang loop unroll(disable)") for (int i0 = 0; i0 < TOK_UNITS; i0 += 2) { const int i = i0 + (F.wave >> 2); pg8::Unit u; if (S.next(i, u)) { const int lr = F.tid & 255; rowL[i * 256 + lr] = rstd_ple[u.arow0 + lr]; } }
            __syncthreads();
            pg8::gemm_phase(F.lds, HBa, (const bf16_t*)(ws + WS_WG) + (size_t)L * DM * DM, DM, S, E);
        }
        SEAM(pb + 7);
    }
    if (EN(9) && IN(17)) { PHASE_BEGIN(); final_phase(F, H, SS, args.in[17], args.out); }
#undef IN
#undef SEAM
}
#define MK_MODE 2

#ifndef MK_MODE
#define MK_MODE 2
#endif
extern "C" void kernel_launch(void* const* d_in, const int* in_sizes, int n_in, void* d_out, int out_size, void* d_ws, size_t ws_size, hipStream_t stream) {
    if (n_in != 18 || in_sizes[0] != NTOK * DM || out_size != NTOK * DM || ws_size < WS_END2) { fprintf(stderr, "kernel_launch: unexpected shapes / workspace (%d inputs, ws %zu, need %zu)\n", n_in, ws_size, (size_t)WS_END2); return; }
    unsigned char* ws = (unsigned char*)d_ws;
    (void)hipMemsetAsync(ws + WS_CTL, 0, 1 * MiB, stream);
#if MK_MODE != 0
    static int grid = 0;
    if (grid == 0) {
        int dev = 0, cus = 0, per_cu = 0;
        if (hipGetDevice(&dev) != hipSuccess || hipDeviceGetAttribute(&cus, hipDeviceAttributeMultiprocessorCount, dev) != hipSuccess) { fprintf(stderr, "kernel_launch: device query failed\n"); grid = -1; return; }
        if (hipFuncSetAttribute((const void*)mega_fwd, hipFuncAttributeMaxDynamicSharedMemorySize, MK_LDS_BYTES) != hipSuccess) { fprintf(stderr, "kernel_launch: hipFuncSetAttribute failed\n"); grid = -1; return; }
        if (hipOccupancyMaxActiveBlocksPerMultiprocessor(&per_cu, (const void*)mega_fwd, MK_WAVES * 64, MK_LDS_BYTES) != hipSuccess || per_cu < 1) fprintf(stderr, "kernel_launch: occupancy query reports %d\n", per_cu);
        (void)hipGetLastError();
        grid = cus;
        grid -= grid % 8;
    }
    if (grid <= 0) return;
    MArgs a{};
    for (int i = 0; i < 18; ++i) a.in[i] = (const float*)d_in[i];
    a.out = (float*)d_out; a.ws = ws;
#if MK_MODE == 2
    a.ph_lo = 0; a.ph_hi = N_PHASES;
    hipLaunchKernelGGL(mega_fwd, dim3(grid), dim3(MK_WAVES * 64), MK_LDS_BYTES, stream, a);
#else
    for (int ph = 0; ph < N_PHASES; ++ph) { a.ph_lo = ph; a.ph_hi = ph + 1; hipLaunchKernelGGL(mega_fwd, dim3(grid), dim3(MK_WAVES * 64), MK_LDS_BYTES, stream, a); }
#endif
    { const hipError_t le = hipPeekAtLastError(); if (le != hipSuccess) fprintf(stderr, "kernel_launch: launch failed: %s\n", hipGetErrorName(le)); }
#else
    const float* x = (const float*)d_in[0]; const float* p = (const float*)d_in[1]; const float* g_mix = (const float*)d_in[2]; const float* w_qkv = (const float*)d_in[3];
    const float* w_fgate = (const float*)d_in[4]; const float* b_fgate = (const float*)d_in[5]; const float* w_o = (const float*)d_in[6]; const float* g_moe = (const float*)d_in[7];
    const float* w_router = (const float*)d_in[8]; const float* b_router = (const float*)d_in[9]; const float* w_gu = (const float*)d_in[10]; const float* b_gu = (const float*)d_in[11];
    const float* w_down = (const float*)d_in[12]; const float* b_down = (const float*)d_in[13]; const float* g_ple = (const float*)d_in[14]; const float* w_ple_gate = (const float*)d_in[15];
    const float* w_ple_proj = (const float*)d_in[16]; const float* g_final = (const float*)d_in[17];
    unsigned* ctl = (unsigned*)(ws + WS_CTL);
    bf16_t *Wqkv = (bf16_t*)(ws + WS_WQKV), *Wo = (bf16_t*)(ws + WS_WO), *Wg = (bf16_t*)(ws + WS_WG), *Wp = (bf16_t*)(ws + WS_WP), *Wgu = (bf16_t*)(ws + WS_WGU), *Wd = (bf16_t*)(ws + WS_WD);
    float* H = (float*)(ws + WS_H); bf16_t *HB = (bf16_t*)(ws + WS_HB), *Q = (bf16_t*)(ws + WS_Q), *Kb = (bf16_t*)(ws + WS_K), *Vb = (bf16_t*)(ws + WS_V), *O = (bf16_t*)(ws + WS_O);
    bf16_t *PB = (bf16_t*)(ws + WS_PB), *PJ = (bf16_t*)(ws + WS_PJ), *ACT = (bf16_t*)(ws + WS_ACT), *Y = (bf16_t*)(ws + WS_Y);
    int* tok_of = (int*)(ws + WS_TOK); float* gate_of = (float*)(ws + WS_GATE); unsigned* pair = (unsigned*)(ws + WS_PAIR);
    float* rstd_mix = (float*)(ws + WS_RSTD); float* rstd_moe = rstd_mix + NTOK; float* rstd_ple = rstd_moe + NTOK;
    float* FL = (float*)(ws + WS_FL); float* CB = (float*)(ws + WS_CB);
    for (int i = 0; i < DEPTH; ++i) {
        k_cvt_t<0><<<dim3(3 * DM / 64, DM / 64, 1), 256, 0, stream>>>(w_qkv + (size_t)i * DM * 3 * DM, g_mix + i * DM, Wqkv + (size_t)i * 3 * DM * DM, DM, 3 * DM);
        k_cvt_t<0><<<dim3(DM / 64, DM / 64, 1), 256, 0, stream>>>(w_o + (size_t)i * DM * DM, nullptr, Wo + (size_t)i * DM * DM, DM, DM);
        k_cvt_t<0><<<dim3(DM / 64, DM / 64, 1), 256, 0, stream>>>(w_ple_gate + (size_t)i * DM * DM, g_ple + i * DM, Wg + (size_t)i * DM * DM, DM, DM);
        k_cvt_t<0><<<dim3(DM / 64, PLE / 64, 1), 256, 0, stream>>>(w_ple_proj + (size_t)i * PLE * DM, nullptr, Wp + (size_t)i * DM * PLE, PLE, DM);
        k_cvt_t<1><<<dim3(2 * FF / 64, DM / 64, NE), 256, 0, stream>>>(w_gu + (size_t)i * NE * DM * 2 * FF, g_moe + i * DM, Wgu + (size_t)i * NE * 2 * FF * DM, DM, 2 * FF);
        k_cvt_t<0><<<dim3(DM / 64, FF / 64, NE), 256, 0, stream>>>(w_down + (size_t)i * NE * FF * DM, nullptr, Wd + (size_t)i * NE * DM * FF, FF, DM);
    }
    k_cvt<<<(unsigned)((size_t)DEPTH * NTOK * PLE / 4 / 256), 256, 0, stream>>>(p, PB, (size_t)DEPTH * NTOK * PLE / 4);
    for (int i = 0; i < DEPTH; ++i)
        k_gemm_pj<<<dim3(DM / 64, NTOK / 64), 64, 0, stream>>>(PB + (size_t)i * NTOK * PLE, Wp + (size_t)i * DM * PLE, PJ + (size_t)i * NTOK * DM);
    k_rowstat<<<NTOK / 4, 256, 0, stream>>>(x, HB, rstd_mix);
    for (int i = 0; i < DEPTH; ++i) {
        const float* hin = (i == 0) ? x : H;
        k_gemm_qkv<<<dim3(3 * DM / 64, NTOK / 64), 64, 0, stream>>>(HB, Wqkv + (size_t)i * 3 * DM * DM, rstd_mix, Q);
        if (i == 0) k_attn_sb<<<NB * NH * SEQ / 4, 256, 0, stream>>>(Q, Kb, Vb, O);
        else {
            k_fgate<<<NTOK / 4, 256, 0, stream>>>(hin, g_mix + i * DM, w_fgate, b_fgate, rstd_mix, FL);
            k_scan<<<NB * NH, 64, 0, stream>>>(FL, CB);
            k_attn_fox<<<NB * NH * SEQ / 4, 256, 0, stream>>>(Q, Kb, Vb, CB, O);
        }
        k_gemm_wo<<<dim3(DM / 64, NTOK / 64), 64, 0, stream>>>(O, Wo + (size_t)i * DM * DM, hin, H, HB);
        unsigned* cnt = ctl + CW_CNT + 64 * i;
        k_router<<<NTOK / 4, 256, 0, stream>>>(H, g_moe + i * DM, w_router + (size_t)i * DM * NE, b_router + i * NE, rstd_moe, cnt, tok_of, gate_of, pair);
        k_gemm_gu<<<dim3(FF / 64, MAXT * 4), 64, 0, stream>>>(HB, Wgu + (size_t)i * NE * 2 * FF * DM, b_gu + (size_t)i * NE * 2 * FF, rstd_moe, cnt, tok_of, ACT);
        k_gemm_down<<<dim3(DM / 64, MAXT * 4), 64, 0, stream>>>(ACT, Wd + (size_t)i * NE * DM * FF, b_down + (size_t)i * NE * DM, cnt, gate_of, Y);
        k_combine<<<NTOK / 4, 256, 0, stream>>>(H, HB, rstd_ple, cnt, pair, Y);
        k_gemm_ple<<<dim3(DM / 64, NTOK / 64), 64, 0, stream>>>(HB, Wg + (size_t)i * DM * DM, rstd_ple, PJ + (size_t)i * NTOK * DM, H, HB);
        if (i + 1 < DEPTH) k_rowstat<<<NTOK / 4, 256, 0, stream>>>(H, HB, rstd_mix);
    }
    k_final<<<NTOK / 4, 256, 0, stream>>>(H, g_final, (float*)d_out);
#endif
}
```

```cpp
#define MK_DUP 0
#define MK_FP8_MASK 3
#include <hip/hip_runtime.h>
#include <cstdio>
#include <cstdint>

typedef unsigned short bf16_t;
typedef short bf16x8 __attribute__((ext_vector_type(8)));
typedef float f32x4 __attribute__((ext_vector_type(4)));
typedef float f32x16 __attribute__((ext_vector_type(16)));
typedef unsigned u32x4 __attribute__((ext_vector_type(4)));
typedef unsigned u32x2 __attribute__((ext_vector_type(2)));

constexpr int NTOK = 32768, DM = 1024, SEQ = 2048, NB = 16, NH = 16, HD = 64, NE = 32, TOPK = 4, FF = 1024, PLE = 256, DEPTH = 2;
constexpr int CAP = NTOK;
constexpr int MAXT = 544;
constexpr int NSLOT = MAXT * 256;
constexpr float EPS = 1e-6f;
constexpr float LOG2E = 1.4426950408889634f;
constexpr float C2 = 0.125f * LOG2E;

constexpr size_t MiB = 1u << 20;
constexpr size_t WS_CTL = 0;
constexpr size_t WS_WQKV = 2 * MiB;
constexpr size_t WS_WO = WS_WQKV + 12 * MiB;
constexpr size_t WS_WG = WS_WO + 4 * MiB;
constexpr size_t WS_WP = WS_WG + 4 * MiB;
constexpr size_t WS_WGU = WS_WP + 2 * MiB;
constexpr size_t WS_WD = WS_WGU + 256 * MiB;
constexpr size_t WS_H = WS_WD + 128 * MiB;
constexpr size_t WS_HB = WS_H + 128 * MiB;
constexpr size_t WS_Q = WS_HB + 64 * MiB;
constexpr size_t WS_K = WS_Q + 64 * MiB;
constexpr size_t WS_V = WS_K + 64 * MiB;
constexpr size_t WS_O = WS_V + 64 * MiB;
constexpr size_t WS_PB = WS_O + 64 * MiB;
constexpr size_t WS_PJ = WS_PB + 32 * MiB;
constexpr size_t WS_ACT = WS_PJ + 128 * MiB;
constexpr size_t WS_Y = WS_ACT + 272 * MiB;
constexpr size_t WS_TOK = WS_Y + 272 * MiB;
constexpr size_t WS_GATE = WS_TOK + 4 * MiB;
constexpr size_t WS_PAIR = WS_GATE + 4 * MiB;
constexpr size_t WS_RSTD = WS_PAIR + 1 * MiB;
constexpr size_t WS_FL = WS_RSTD + 1 * MiB;
constexpr size_t WS_CB = WS_FL + 2 * MiB;
constexpr size_t WS_END = WS_CB + 2 * MiB;
constexpr int CW_CNT = 64;

__device__ __forceinline__ float bf2f(bf16_t v) { return __uint_as_float((unsigned)v << 16); }
__device__ __forceinline__ unsigned f2bf(float f) { unsigned u = __float_as_uint(f); return (u + 0x7fffu + ((u >> 16) & 1u)) >> 16; }
__device__ __forceinline__ unsigned pk2(float lo, float hi) { return f2bf(lo) | (f2bf(hi) << 16); }
__device__ __forceinline__ float wave_sum(float v) {
#pragma unroll
    for (int o = 1; o < 64; o <<= 1) v += __shfl_xor(v, o);
    return v;
}
__device__ __forceinline__ float wave_max(float v) {
#pragma unroll
    for (int o = 1; o < 64; o <<= 1) v = fmaxf(v, __shfl_xor(v, o));
    return v;
}
__device__ __forceinline__ int crow(int r, int hi) { return (r & 3) + 8 * (r >> 2) + 4 * hi; }
__device__ __forceinline__ float sigmoidf_(float x) { return 1.f / (1.f + __expf(-x)); }
__device__ __forceinline__ float log_sigmoid(float x) { return fminf(x, 0.f) - log1pf(__expf(-fabsf(x))); }

struct MoeTile { int e, rank0, cnt, tstart; bool ok; };
__device__ __forceinline__ MoeTile moe_tile(const unsigned* cnt, int T) {
    const int lane = threadIdx.x & 63;
    const int c = (lane < NE) ? (int)cnt[lane] : 0;
    const int nt = (c + 255) >> 8;
    int incl = nt;
#pragma unroll
    for (int o = 1; o < 32; o <<= 1) { int t = __shfl_up(incl, o); if ((lane & 31) >= o) incl += t; }
    const int excl = incl - nt;
    const unsigned long long m = __ballot(lane < NE && excl <= T && nt > 0 && T < incl);
    MoeTile r; r.ok = (m != 0ull);
    const int e = r.ok ? (int)__builtin_ctzll(m) : 0;
    r.e = e; r.tstart = __shfl(excl, e); r.cnt = __shfl(c, e); r.rank0 = (T - r.tstart) * 256;
    return r;
}
__device__ __forceinline__ int moe_tstart(const unsigned* cnt, int e) {
    const int lane = threadIdx.x & 63;
    const int c = (lane < NE) ? (int)cnt[lane] : 0;
    const int nt = (c + 255) >> 8;
    int incl = nt;
#pragma unroll
    for (int o = 1; o < 32; o <<= 1) { int t = __shfl_up(incl, o); if ((lane & 31) >= o) incl += t; }
    return __shfl(incl - nt, e);
}

__global__ void __launch_bounds__(256) k_rowstat(const float* __restrict__ h, bf16_t* __restrict__ hb, float* __restrict__ rstd) {
    const int lane = threadIdx.x & 63, row = blockIdx.x * 4 + (threadIdx.x >> 6);
    const f32x4* p = (const f32x4*)(h + (size_t)row * DM) + lane;
    f32x4 v[4]; float s = 0.f;
#pragma unroll
    for (int j = 0; j < 4; ++j) { v[j] = p[64 * j]; s += v[j].x * v[j].x + v[j].y * v[j].y + v[j].z * v[j].z + v[j].w * v[j].w; }
    s = wave_sum(s);
    if (lane == 0) rstd[row] = rsqrtf(s * (1.f / DM) + EPS);
    u32x2* o = (u32x2*)(hb + (size_t)row * DM) + lane;
#pragma unroll
    for (int j = 0; j < 4; ++j) { u32x2 w; w.x = pk2(v[j].x, v[j].y); w.y = pk2(v[j].z, v[j].w); o[64 * j] = w; }
}
__global__ void __launch_bounds__(256) k_cvt(const float* __restrict__ s, bf16_t* __restrict__ d, size_t n4) {
    size_t i = (size_t)blockIdx.x * 256 + threadIdx.x;
    if (i < n4) { f32x4 v = ((const f32x4*)s)[i]; u32x2 w; w.x = pk2(v.x, v.y); w.y = pk2(v.z, v.w); ((u32x2*)d)[i] = w; }
}
template <int MODE>
__global__ void __launch_bounds__(256) k_cvt_t(const float* __restrict__ src, const float* __restrict__ g, bf16_t* __restrict__ dst, int K, int N) {
    __shared__ float tile[64][65];
    const int n0 = blockIdx.x * 64, k0 = blockIdx.y * 64, b = blockIdx.z, tid = threadIdx.x;
    const float* s = src + (size_t)b * K * N; bf16_t* d = dst + (size_t)b * K * N;
#pragma unroll
    for (int i = 0; i < 16; ++i) { const int kk = i * 4 + (tid >> 6), nn = tid & 63; const float gg = g ? g[k0 + kk] : 1.f; tile[kk][nn] = s[(size_t)(k0 + kk) * N + n0 + nn] * gg; }
    __syncthreads();
#pragma unroll
    for (int j = 0; j < 2; ++j) {
        const int c = tid + 256 * j, n = c >> 3, kc = c & 7;
        u32x4 w; w.x = pk2(tile[kc * 8 + 0][n], tile[kc * 8 + 1][n]); w.y = pk2(tile[kc * 8 + 2][n], tile[kc * 8 + 3][n]);
        w.z = pk2(tile[kc * 8 + 4][n], tile[kc * 8 + 5][n]); w.w = pk2(tile[kc * 8 + 6][n], tile[kc * 8 + 7][n]);
        int nn = n0 + n;
        if (MODE == 1) { const int half = nn / FF, j2 = nn % FF; nn = (j2 >> 7) * 256 + half * 128 + (j2 & 127); }
        *(u32x4*)(d + (size_t)nn * K + k0 + kc * 8) = w;
    }
}

template <bool DUAL>
__device__ __forceinline__ void gemm_tile64(const bf16_t* a0, const bf16_t* a1, const bf16_t* B1, const bf16_t* B2, int K, f32x16 (&acc)[2][2], f32x16 (&acc2)[2][2]) {
    const int lane = threadIdx.x & 63, r32 = lane & 31, hi = lane >> 5;
    const bf16_t* b0 = B1 + (size_t)r32 * K + 8 * hi; const bf16_t* b1 = B1 + (size_t)(32 + r32) * K + 8 * hi;
    const bf16_t* c0 = DUAL ? B2 + (size_t)r32 * K + 8 * hi : nullptr; const bf16_t* c1 = DUAL ? B2 + (size_t)(32 + r32) * K + 8 * hi : nullptr;
    a0 += 8 * hi; a1 += 8 * hi;
#pragma unroll
    for (int i = 0; i < 2; ++i)
#pragma unroll
        for (int j = 0; j < 2; ++j) { acc[i][j] = f32x16{}; acc2[i][j] = f32x16{}; }
    for (int k = 0; k < K; k += 16) {
        const bf16x8 fa0 = *(const bf16x8*)(a0 + k), fa1 = *(const bf16x8*)(a1 + k), fb0 = *(const bf16x8*)(b0 + k), fb1 = *(const bf16x8*)(b1 + k);
        acc[0][0] = __builtin_amdgcn_mfma_f32_32x32x16_bf16(fa0, fb0, acc[0][0], 0, 0, 0);
        acc[0][1] = __builtin_amdgcn_mfma_f32_32x32x16_bf16(fa0, fb1, acc[0][1], 0, 0, 0);
        acc[1][0] = __builtin_amdgcn_mfma_f32_32x32x16_bf16(fa1, fb0, acc[1][0], 0, 0, 0);
        acc[1][1] = __builtin_amdgcn_mfma_f32_32x32x16_bf16(fa1, fb1, acc[1][1], 0, 0, 0);
        if (DUAL) {
            const bf16x8 fc0 = *(const bf16x8*)(c0 + k), fc1 = *(const bf16x8*)(c1 + k);
            acc2[0][0] = __builtin_amdgcn_mfma_f32_32x32x16_bf16(fa0, fc0, acc2[0][0], 0, 0, 0);
            acc2[0][1] = __builtin_amdgcn_mfma_f32_32x32x16_bf16(fa0, fc1, acc2[0][1], 0, 0, 0);
            acc2[1][0] = __builtin_amdgcn_mfma_f32_32x32x16_bf16(fa1, fc0, acc2[1][0], 0, 0, 0);
            acc2[1][1] = __builtin_amdgcn_mfma_f32_32x32x16_bf16(fa1, fc1, acc2[1][1], 0, 0, 0);
        }
    }
}
#define TILE_FOREACH(...) _Pragma("unroll") for (int mi = 0; mi < 2; ++mi) _Pragma("unroll") for (int ni = 0; ni < 2; ++ni) _Pragma("unroll") for (int r = 0; r < 16; ++r) { \
        const int lrow = 32 * mi + crow(r, hi), lcol = 32 * ni + r32; const float v = acc[mi][ni][r]; const float v2 = acc2[mi][ni][r]; (void)v2; __VA_ARGS__ }

__global__ void __launch_bounds__(64) k_gemm_qkv(const bf16_t* __restrict__ A, const bf16_t* __restrict__ Bt, const float* __restrict__ rstd, bf16_t* __restrict__ Q) {
    const int lane = threadIdx.x, r32 = lane & 31, hi = lane >> 5; const int m0 = blockIdx.y * 64, n0 = blockIdx.x * 64;
    f32x16 acc[2][2], acc2[2][2];
    gemm_tile64<false>(A + (size_t)(m0 + r32) * DM, A + (size_t)(m0 + 32 + r32) * DM, Bt + (size_t)n0 * DM, nullptr, DM, acc, acc2);
    const int t = n0 / DM; bf16_t* out = Q + (size_t)t * ((WS_K - WS_Q) / 2); const float sc = (t == 0) ? C2 : 1.f;
    TILE_FOREACH({ const int row = m0 + lrow, col = n0 - t * DM + lcol; out[(size_t)row * DM + col] = (bf16_t)f2bf(v * rstd[row] * sc); })
}
__global__ void __launch_bounds__(64) k_gemm_wo(const bf16_t* __restrict__ A, const bf16_t* __restrict__ Bt, const float* hin, float* hout, bf16_t* __restrict__ hb) {
    const int lane = threadIdx.x, r32 = lane & 31, hi = lane >> 5; const int m0 = blockIdx.y * 64, n0 = blockIdx.x * 64;
    f32x16 acc[2][2], acc2[2][2];
    gemm_tile64<false>(A + (size_t)(m0 + r32) * DM, A + (size_t)(m0 + 32 + r32) * DM, Bt + (size_t)n0 * DM, nullptr, DM, acc, acc2);
    TILE_FOREACH({ const size_t o = (size_t)(m0 + lrow) * DM + n0 + lcol; const float x = hin[o] + v; hout[o] = x; hb[o] = (bf16_t)f2bf(x); })
}
__global__ void __launch_bounds__(64) k_gemm_pj(const bf16_t* __restrict__ A, const bf16_t* __restrict__ Bt, bf16_t* __restrict__ PJ) {
    const int lane = threadIdx.x, r32 = lane & 31, hi = lane >> 5; const int m0 = blockIdx.y * 64, n0 = blockIdx.x * 64;
    f32x16 acc[2][2], acc2[2][2];
    gemm_tile64<false>(A + (size_t)(m0 + r32) * PLE, A + (size_t)(m0 + 32 + r32) * PLE, Bt + (size_t)n0 * PLE, nullptr, PLE, acc, acc2);
    TILE_FOREACH({ PJ[(size_t)(m0 + lrow) * DM + n0 + lcol] = (bf16_t)f2bf(v); })
}
__global__ void __launch_bounds__(64) k_gemm_ple(const bf16_t* __restrict__ A, const bf16_t* __restrict__ Bt, const float* __restrict__ rstd, const bf16_t* __restrict__ PJ, float* h, bf16_t* hb) {
    const int lane = threadIdx.x, r32 = lane & 31, hi = lane >> 5; const int m0 = blockIdx.y * 64, n0 = blockIdx.x * 64;
    f32x16 acc[2][2], acc2[2][2];
    gemm_tile64<false>(A + (size_t)(m0 + r32) * DM, A + (size_t)(m0 + 32 + r32) * DM, Bt + (size_t)n0 * DM, nullptr, DM, acc, acc2);
    TILE_FOREACH({ const int row = m0 + lrow; const size_t o = (size_t)row * DM + n0 + lcol; const float x = h[o] + sigmoidf_(v * rstd[row]) * bf2f(PJ[o]); h[o] = x; })
}
__global__ void __launch_bounds__(64) k_gemm_gu(const bf16_t* __restrict__ HB, const bf16_t* __restrict__ Wgu, const float* __restrict__ bgu, const float* __restrict__ rstd,
                                                const unsigned* __restrict__ cnt, const int* __restrict__ tok_of, bf16_t* __restrict__ ACT) {
    const int lane = threadIdx.x, r32 = lane & 31, hi = lane >> 5; const int rt = blockIdx.y, T = rt >> 2, j0 = blockIdx.x * 64;
    const MoeTile mt = moe_tile(cnt, T); if (!mt.ok) return;
    const int lr0 = (rt & 3) * 64; const int rk0 = mt.rank0 + lr0 + r32, rk1 = rk0 + 32;
    const int t0 = rk0 < mt.cnt ? tok_of[(size_t)mt.e * CAP + rk0] : 0, t1 = rk1 < mt.cnt ? tok_of[(size_t)mt.e * CAP + rk1] : 0;
    const bf16_t* Be = Wgu + (size_t)mt.e * 2048 * DM + (size_t)((j0 >> 7) * 256 + (j0 & 127)) * DM;
    f32x16 acc[2][2], acc2[2][2];
    gemm_tile64<true>(HB + (size_t)t0 * DM, HB + (size_t)t1 * DM, Be, Be + (size_t)128 * DM, DM, acc, acc2);
    const size_t slot0 = (size_t)T * 256 + lr0;
    TILE_FOREACH({ const int rk = mt.rank0 + lr0 + lrow; if (rk < mt.cnt) { const int tk = tok_of[(size_t)mt.e * CAP + rk]; const float rs = rstd[tk]; const int j = j0 + lcol;
        float gl = v * rs + bgu[(size_t)mt.e * 2048 + j], ln = v2 * rs + bgu[(size_t)mt.e * 2048 + FF + j];
        gl = fminf(gl, 7.f); ln = fminf(fmaxf(ln, -7.f), 7.f);
        const float a = gl * sigmoidf_(1.702f * gl) * (ln + 1.f);
        ACT[(slot0 + lrow) * FF + j] = (bf16_t)f2bf(a); } })
}
__global__ void __launch_bounds__(64) k_gemm_down(const bf16_t* __restrict__ ACT, const bf16_t* __restrict__ Wd, const float* __restrict__ bd, const unsigned* __restrict__ cnt,
                                                  const float* __restrict__ gate_of, bf16_t* __restrict__ Y) {
    const int lane = threadIdx.x, r32 = lane & 31, hi = lane >> 5; const int rt = blockIdx.y, T = rt >> 2, n0 = blockIdx.x * 64;
    const MoeTile mt = moe_tile(cnt, T); if (!mt.ok) return;
    const int lr0 = (rt & 3) * 64; const size_t slot0 = (size_t)T * 256 + lr0;
    const int rk0 = mt.rank0 + lr0 + r32, rk1 = rk0 + 32;
    const size_t s0 = rk0 < mt.cnt ? slot0 + r32 : (size_t)T * 256, s1 = rk1 < mt.cnt ? slot0 + 32 + r32 : (size_t)T * 256;
    f32x16 acc[2][2], acc2[2][2];
    gemm_tile64<false>(ACT + s0 * FF, ACT + s1 * FF, Wd + (size_t)mt.e * DM * FF + (size_t)n0 * FF, nullptr, FF, acc, acc2);
    TILE_FOREACH({ const int rk = mt.rank0 + lr0 + lrow; if (rk < mt.cnt) { const float gt = gate_of[(size_t)mt.e * CAP + rk]; const int n = n0 + lcol;
        Y[(slot0 + lrow) * DM + n] = (bf16_t)f2bf((v + bd[(size_t)mt.e * DM + n]) * gt); } })
}

__global__ void __launch_bounds__(256) k_router(const float* __restrict__ h, const float* __restrict__ g, const float* __restrict__ wr, const float* __restrict__ br,
                                                float* __restrict__ rstd, unsigned* cnt, int* __restrict__ tok_of, float* __restrict__ gate_of, unsigned* __restrict__ pair) {
    const int lane = threadIdx.x & 63, t = blockIdx.x * 4 + (threadIdx.x >> 6); const int e = lane & 31, half = lane >> 5;
    const float* hr = h + (size_t)t * DM;
    float ss = 0.f;
#pragma unroll
    for (int j = 0; j < 4; ++j) { const f32x4 v = ((const f32x4*)hr)[lane + 64 * j]; ss += v.x * v.x + v.y * v.y + v.z * v.z + v.w * v.w; }
    const float rs = rsqrtf(wave_sum(ss) * (1.f / DM) + EPS);
    float a = 0.f;
    for (int d = half * 512; d < half * 512 + 512; ++d) a += hr[d] * g[d] * wr[(size_t)d * NE + e];
    a += __shfl_xor(a, 32);
    float lg = a * rs + br[e];
    float tv[4]; int ti[4];
#pragma unroll
    for (int k = 0; k < 4; ++k) {
        float bv = lg; int bi = e;
#pragma unroll
        for (int o = 1; o < 32; o <<= 1) { const float ov = __shfl_xor(bv, o); const int oi = __shfl_xor(bi, o); if (ov > bv || (ov == bv && oi < bi)) { bv = ov; bi = oi; } }
        tv[k] = bv; ti[k] = bi; if (e == bi) lg = -INFINITY;
    }
    float w[4], sw = 0.f;
#pragma unroll
    for (int k = 0; k < 4; ++k) { w[k] = __expf(tv[k] - tv[0]); sw += w[k]; }
    if (lane == 0) rstd[t] = rs;
    if (lane < 4) {
        const int k = lane; const int ee = (k == 0) ? ti[0] : (k == 1) ? ti[1] : (k == 2) ? ti[2] : ti[3]; const float ww = (k == 0) ? w[0] : (k == 1) ? w[1] : (k == 2) ? w[2] : w[3];
        const unsigned rk = atomicAdd(&cnt[ee], 1u);
        tok_of[(size_t)ee * CAP + rk] = t; gate_of[(size_t)ee * CAP + rk] = ww / sw; pair[(size_t)t * 4 + k] = ((unsigned)ee << 16) | rk;
    }
}
__global__ void __launch_bounds__(256) k_combine(float* h, bf16_t* __restrict__ hb, float* __restrict__ rstd, const unsigned* __restrict__ cnt, const unsigned* __restrict__ pair, const bf16_t* __restrict__ Y) {
    const int lane = threadIdx.x & 63, t = blockIdx.x * 4 + (threadIdx.x >> 6);
    f32x4 v[4]; f32x4* hr = (f32x4*)(h + (size_t)t * DM) + lane;
#pragma unroll
    for (int j = 0; j < 4; ++j) v[j] = hr[64 * j];
    for (int k = 0; k < 4; ++k) {
        const unsigned pr = pair[(size_t)t * 4 + k]; const int e = pr >> 16, rk = pr & 0xffff;
        const size_t slot = (size_t)moe_tstart(cnt, e) * 256 + rk;
        const u32x2* yr = (const u32x2*)(Y + slot * DM) + lane;
#pragma unroll
        for (int j = 0; j < 4; ++j) { const u32x2 w = yr[64 * j]; v[j].x += __uint_as_float(w.x << 16); v[j].y += __uint_as_float(w.x & 0xffff0000u); v[j].z += __uint_as_float(w.y << 16); v[j].w += __uint_as_float(w.y & 0xffff0000u); }
    }
    float s = 0.f;
#pragma unroll
    for (int j = 0; j < 4; ++j) { hr[64 * j] = v[j]; s += v[j].x * v[j].x + v[j].y * v[j].y + v[j].z * v[j].z + v[j].w * v[j].w; }
    s = wave_sum(s); if (lane == 0) rstd[t] = rsqrtf(s * (1.f / DM) + EPS);
    u32x2* o = (u32x2*)(hb + (size_t)t * DM) + lane;
#pragma unroll
    for (int j = 0; j < 4; ++j) { u32x2 w; w.x = pk2(v[j].x, v[j].y); w.y = pk2(v[j].z, v[j].w); o[64 * j] = w; }
}
__global__ void __launch_bounds__(256) k_final(const float* __restrict__ h, const float* __restrict__ g, float* __restrict__ out) {
    const int lane = threadIdx.x & 63, row = blockIdx.x * 4 + (threadIdx.x >> 6);
    const f32x4* p = (const f32x4*)(h + (size_t)row * DM) + lane; f32x4 v[4]; float s = 0.f;
#pragma unroll
    for (int j = 0; j < 4; ++j) { v[j] = p[64 * j]; s += v[j].x * v[j].x + v[j].y * v[j].y + v[j].z * v[j].z + v[j].w * v[j].w; }
    const float rs = rsqrtf(wave_sum(s) * (1.f / DM) + EPS);
    f32x4* o = (f32x4*)(out + (size_t)row * DM) + lane;
#pragma unroll
    for (int j = 0; j < 4; ++j) { const f32x4 gg = ((const f32x4*)g)[lane + 64 * j]; o[64 * j] = v[j] * rs * gg; }
}
__global__ void __launch_bounds__(256) k_fgate(const float* __restrict__ h, const float* __restrict__ g, const float* __restrict__ wf, const float* __restrict__ bfg, const float* __restrict__ rstd, float* __restrict__ fl) {
    const int lane = threadIdx.x & 63, t = blockIdx.x * 4 + (threadIdx.x >> 6); const int hh = lane & 15, q = lane >> 4;
    const float* hr = h + (size_t)t * DM; float a = 0.f;
    for (int d = q * 256; d < q * 256 + 256; ++d) a += hr[d] * g[d] * wf[(size_t)d * NH + hh];
    a += __shfl_xor(a, 16); a += __shfl_xor(a, 32);
    if (lane < 16) fl[(size_t)t * NH + hh] = a * rstd[t] + bfg[hh];
}
__global__ void __launch_bounds__(64) k_scan(const float* __restrict__ fl, float* __restrict__ cb) {
    const int lane = threadIdx.x, bh = blockIdx.x, b = bh / NH, hh = bh % NH;
    float loc[32]; float run = 0.f;
#pragma unroll
    for (int i = 0; i < 32; ++i) { run += log_sigmoid(fl[(size_t)(b * SEQ + lane * 32 + i) * NH + hh]); loc[i] = run; }
    float incl = run;
#pragma unroll
    for (int o = 1; o < 64; o <<= 1) { const float t = __shfl_up(incl, o); if (lane >= o) incl += t; }
    const float base = incl - run;
#pragma unroll
    for (int i = 0; i < 32; ++i) cb[(size_t)bh * SEQ + lane * 32 + i] = (base + loc[i]) * LOG2E;
}

__device__ __forceinline__ float dot64(const float (&q)[64], const bf16_t* kr) {
    float a = 0.f;
#pragma unroll
    for (int c = 0; c < 8; ++c) { const u32x4 w = ((const u32x4*)kr)[c];
        a += q[8 * c + 0] * __uint_as_float(w.x << 16) + q[8 * c + 1] * __uint_as_float(w.x & 0xffff0000u) + q[8 * c + 2] * __uint_as_float(w.y << 16) + q[8 * c + 3] * __uint_as_float(w.y & 0xffff0000u)
           + q[8 * c + 4] * __uint_as_float(w.z << 16) + q[8 * c + 5] * __uint_as_float(w.z & 0xffff0000u) + q[8 * c + 6] * __uint_as_float(w.w << 16) + q[8 * c + 7] * __uint_as_float(w.w & 0xffff0000u); }
    return a;
}
__device__ __forceinline__ void loadq(float (&q)[64], const bf16_t* qr) {
#pragma unroll
    for (int c = 0; c < 8; ++c) { const u32x4 w = ((const u32x4*)qr)[c];
        q[8 * c + 0] = __uint_as_float(w.x << 16); q[8 * c + 1] = __uint_as_float(w.x & 0xffff0000u); q[8 * c + 2] = __uint_as_float(w.y << 16); q[8 * c + 3] = __uint_as_float(w.y & 0xffff0000u);
        q[8 * c + 4] = __uint_as_float(w.z << 16); q[8 * c + 5] = __uint_as_float(w.z & 0xffff0000u); q[8 * c + 6] = __uint_as_float(w.w << 16); q[8 * c + 7] = __uint_as_float(w.w & 0xffff0000u); }
}
__global__ void __launch_bounds__(256) k_attn_sb(const bf16_t* __restrict__ Q, const bf16_t* __restrict__ K, const bf16_t* __restrict__ V, bf16_t* __restrict__ O) {
    const int lane = threadIdx.x & 63; const int gw = blockIdx.x * 4 + (threadIdx.x >> 6); const int t = gw % SEQ, bh = gw / SEQ, b = bh / NH, hh = bh % NH;
    const size_t rowb = (size_t)b * SEQ; float q[64]; loadq(q, Q + (rowb + t) * DM + hh * HD);
    float o = 0.f, carry = 1.f;
    for (int jt = (t - 1) >> 6; jt >= 0 && t > 0; --jt) {
        const int s = 64 * jt + lane; const bool valid = s < t;
        float x = dot64(q, K + (rowb + s) * DM + hh * HD); x = fminf(x, 64.f);
        const float ex = exp2f(x), r = 1.f / (1.f + ex);
        const float beta = valid ? ex * r : 0.f, nb = valid ? r : 1.f;
        float P = nb;
#pragma unroll
        for (int off = 1; off < 64; off <<= 1) { const float t2 = __shfl_down(P, off); if (lane + off < 64) P *= t2; }
        float Pex = __shfl_down(P, 1); if (lane == 63) Pex = 1.f;
        const float a = beta * carry * Pex;
        carry *= __shfl(P, 0);
        const bf16_t* vb = V + (rowb + 64 * jt) * DM + hh * HD + lane;
        for (int l = 0; l < 64; ++l) { const float al = __shfl(a, l); o += al * bf2f(vb[(size_t)l * DM]); }
        if (carry < 1e-30f) break;
    }
    O[(rowb + t) * DM + hh * HD + lane] = (bf16_t)f2bf(o);
}
__global__ void __launch_bounds__(256) k_attn_fox(const bf16_t* __restrict__ Q, const bf16_t* __restrict__ K, const bf16_t* __restrict__ V, const float* __restrict__ cb, bf16_t* __restrict__ O) {
    const int lane = threadIdx.x & 63; const int gw = blockIdx.x * 4 + (threadIdx.x >> 6); const int t = gw % SEQ, bh = gw / SEQ, b = bh / NH, hh = bh % NH;
    const size_t rowb = (size_t)b * SEQ; float q[64]; loadq(q, Q + (rowb + t) * DM + hh * HD);
    float o = 0.f, m = -INFINITY, l = 0.f;
    for (int jt = 0; jt <= (t >> 6); ++jt) {
        const int s = 64 * jt + lane; const bool valid = s <= t;
        float x = dot64(q, K + (rowb + s) * DM + hh * HD) - cb[(size_t)bh * SEQ + s];
        x = valid ? x : -INFINITY;
        const float mn = fmaxf(m, wave_max(x)); const float alpha = exp2f(m - mn); const float p = exp2f(x - mn);
        l = l * alpha + wave_sum(p); o *= alpha; m = mn;
        const bf16_t* vb = V + (rowb + 64 * jt) * DM + hh * HD + lane;
        const int nl = min(64, t - 64 * jt + 1);
        for (int i = 0; i < nl; ++i) { const float pi = __shfl(p, i); o += pi * bf2f(vb[(size_t)i * DM]); }
    }
    O[(rowb + t) * DM + hh * HD + lane] = (bf16_t)f2bf(o / l);
}


#include <hip/hip_bf16.h>
#include <cmath>
namespace attn_body {
using bf16=__hip_bfloat16;
using bf16x8=__attribute__((ext_vector_type(8)))short;
using s16x4=__attribute__((ext_vector_type(4)))short;
using f32x16=__attribute__((ext_vector_type(16)))float;
using u32x4=__attribute__((ext_vector_type(4)))unsigned;
constexpr int BATCH=16,NHEAD=16,SEQ=2048,D=64,DM=NHEAD*D;
constexpr int NW=8,QBLK=32,QB=QBLK*NW,KVBLK=64,NQB=SEQ/QB;
constexpr int ATTN_PITCH=DM, ATTN_UNIT_ROWS=QB;
__device__ __forceinline__ int crow(int r,int hi){return (r&3)+8*(r>>2)+4*hi;}
#define SBAR() __builtin_amdgcn_sched_barrier(0)
__device__ __forceinline__ void cmask(f32x16&p0,f32x16&p1,int jb,int qrel,int hi){
  const float NEG=-INFINITY; int kb=64*jb+4*hi;
  #pragma unroll
  for(int r=0;r<16;++r){int kv=kb+(r&3)+8*(r>>2); if(kv>qrel)p0[r]=NEG; if(kv+32>qrel)p1[r]=NEG;}
}

constexpr int NSLOT=3, SLOTB=8192;
constexpr int LDS_K=0, LDS_V=NSLOT*SLOTB, LDS_WS=2*NSLOT*SLOTB, LDS_OST=LDS_WS+NW*64*4, LDS_BYTES=LDS_OST+NW*4096;
constexpr float C2=0.125f*1.4426950408889634f;
__device__ __forceinline__ void glds16(const void*gsrc,unsigned lds_dst){unsigned keep;
  asm volatile("s_mov_b32 %0, m0\n\ts_mov_b32 m0, %2\n\ts_nop 0\n\tglobal_load_lds_dwordx4 %1, off\n\ts_mov_b32 m0, %0":"=&s"(keep):"v"(gsrc),"s"(lds_dst):"memory");}
__device__ __forceinline__ float max3f(float a,float b,float c){float r;asm("v_max3_f32 %0, %1, %2, %3":"=v"(r):"v"(a),"v"(b),"v"(c));return r;}
__device__ __forceinline__ float max2f(float a,float b){float r;asm("v_max_f32_e32 %0, %1, %2":"=v"(r):"v"(a),"v"(b));return r;}
__device__ __forceinline__ float fadd_s(float a,float b){float r;asm("v_add_f32_e32 %0, %1, %2":"=v"(r):"v"(a),"v"(b));return r;}
__device__ __forceinline__ float fsub_s(float a,float b){float r;asm("v_sub_f32_e32 %0, %1, %2":"=v"(r):"v"(a),"v"(b));return r;}
typedef float f32x2_t __attribute__((ext_vector_type(2))); typedef __bf16 bf16x2_t __attribute__((ext_vector_type(2)));
__device__ __forceinline__ unsigned cvtpk_s(float lo,float hi){f32x2_t v={lo,hi};bf16x2_t b=__builtin_convertvector(v,bf16x2_t);return __builtin_bit_cast(unsigned,b);}
#define WAIT_BAR(N) asm volatile("s_waitcnt vmcnt(" #N ") lgkmcnt(0)\n\ts_barrier":::"memory")

__device__ __forceinline__ void qkt(f32x16&p0,f32x16&p1,const char*Kslot,const bf16x8*qr,const f32x16&negm,int r32,int hi){
  const char*kb=Kslot+hi*1024+r32*16;
  #pragma unroll
  for(int d0=0;d0<4;++d0){
    const bf16x8 b0=*reinterpret_cast<const bf16x8*>(kb+d0*2048);
    const bf16x8 b1=*reinterpret_cast<const bf16x8*>(kb+d0*2048+512);
    if(d0==0){p0=__builtin_amdgcn_mfma_f32_32x32x16_bf16(b0,qr[0],negm,0,0,0);p1=__builtin_amdgcn_mfma_f32_32x32x16_bf16(b1,qr[0],negm,0,0,0);}
    else{p0=__builtin_amdgcn_mfma_f32_32x32x16_bf16(b0,qr[d0],p0,0,0,0);p1=__builtin_amdgcn_mfma_f32_32x32x16_bf16(b1,qr[d0],p1,0,0,0);}}
}
typedef __attribute__((address_space(3))) const char* lds_cptr;
typedef short v4i16_t __attribute__((ext_vector_type(4)));
__device__ __forceinline__ void kload8(bf16x8*kf,lds_cptr kp){
  kf[0]=*(const __attribute__((address_space(3))) bf16x8*)(kp);      kf[1]=*(const __attribute__((address_space(3))) bf16x8*)(kp+512);
  kf[2]=*(const __attribute__((address_space(3))) bf16x8*)(kp+2048); kf[3]=*(const __attribute__((address_space(3))) bf16x8*)(kp+2560);
  kf[4]=*(const __attribute__((address_space(3))) bf16x8*)(kp+4096); kf[5]=*(const __attribute__((address_space(3))) bf16x8*)(kp+4608);
  kf[6]=*(const __attribute__((address_space(3))) bf16x8*)(kp+6144); kf[7]=*(const __attribute__((address_space(3))) bf16x8*)(kp+6656);
}
__device__ __forceinline__ void kload2(bf16x8*kf,lds_cptr kp,int j){ kf[2*j]=*(const __attribute__((address_space(3))) bf16x8*)(kp+j*2048); kf[2*j+1]=*(const __attribute__((address_space(3))) bf16x8*)(kp+j*2048+512); }
__device__ __forceinline__ s16x4 vtr(lds_cptr p){ return __builtin_bit_cast(s16x4,__builtin_amdgcn_ds_read_tr16_b64_v4i16((__attribute__((address_space(3))) v4i16_t*)p)); }
__device__ __forceinline__ float rowmax(const f32x16&p0,const f32x16&p1){
  float a=max3f(p0[0],p0[1],p1[0]),b=max3f(p0[2],p0[3],p1[1]);a=max3f(a,p1[2],p1[3]);
  #pragma unroll
  for(int r=4;r<16;r+=4){a=max3f(a,p0[r],p0[r+1]);b=max3f(b,p0[r+2],p0[r+3]);a=max3f(a,p1[r],p1[r+1]);b=max3f(b,p1[r+2],p1[r+3]);}
  const float m=max2f(a,b);
  auto rr=__builtin_amdgcn_permlane32_swap(__float_as_uint(m),__float_as_uint(m),false,false);
  return max2f(__uint_as_float(rr[0]),__uint_as_float(rr[1]));
}
__device__ __forceinline__ void pv(f32x16*o,int vb,bf16x8 pa0,bf16x8 pa1,bf16x8 pa2,bf16x8 pa3){
  #pragma unroll
  for(int d0=0;d0<2;++d0){s16x4 lo[4],hi[4];
    #pragma unroll
    for(int ks=0;ks<4;++ks){
      asm volatile("ds_read_b64_tr_b16 %0,%1 offset:%c2":"=&v"(lo[ks]):"v"(vb),"i"(d0*4096+ks*1024):"memory");
      asm volatile("ds_read_b64_tr_b16 %0,%1 offset:%c2":"=&v"(hi[ks]):"v"(vb),"i"(d0*4096+ks*1024+512):"memory");}
    asm volatile("s_waitcnt lgkmcnt(0)":::"memory");SBAR();
    #define PK(k) (bf16x8){lo[k][0],lo[k][1],lo[k][2],lo[k][3],hi[k][0],hi[k][1],hi[k][2],hi[k][3]}
    o[d0]=__builtin_amdgcn_mfma_f32_32x32x16_bf16(pa0,PK(0),o[d0],0,0,0);
    o[d0]=__builtin_amdgcn_mfma_f32_32x32x16_bf16(pa1,PK(1),o[d0],0,0,0);
    o[d0]=__builtin_amdgcn_mfma_f32_32x32x16_bf16(pa2,PK(2),o[d0],0,0,0);
    o[d0]=__builtin_amdgcn_mfma_f32_32x32x16_bf16(pa3,PK(3),o[d0],0,0,0);
    #undef PK
  }
}

#ifndef ATTN_STORE16
#define ATTN_STORE16(p,v) (*(u32x4*)(p)=(v))
#endif
typedef float f32x4b __attribute__((ext_vector_type(4)));
template<int THRL> __device__ __forceinline__ void attn_unit(int b,int h,int qb,const bf16*Q,const bf16*__restrict__ K,const bf16*__restrict__ V,bf16*O,char*shm,const __attribute__((address_space(3))) float*cb){
  int tid_=threadIdx.x; asm volatile("":"+v"(tid_));
  const int tid=tid_,lane=tid&63,r32=lane&31,hi=lane>>5; const int wid=__builtin_amdgcn_readfirstlane(tid>>6);
  const long rowbase=(long)b*SEQ; const int q0=qb*QB;
  const bf16*Qw=Q+(rowbase+q0+wid*QBLK)*DM+h*D;
  const bf16*Kh=K+rowbase*DM+h*D,*Vh=V+rowbase*DM+h*D;
  const unsigned lds0=(unsigned)(uintptr_t)shm;
  float*wsf=(float*)(shm+LDS_WS)+wid*64;
  const bf16*ksrc=Kh+(long)lane*DM+wid*8;
  const bf16*vsrc=Vh+(long)(16*(wid&3)+(lane>>2))*DM+(wid>>2)*32+(lane&3)*8;
  const unsigned kdst=lds0+LDS_K+wid*1024, vdst=lds0+LDS_V+wid*1024;
  #define DMA_K(t,slot) glds16(ksrc+(long)(t)*KVBLK*DM,(unsigned)__builtin_amdgcn_readfirstlane(kdst+(slot)))
  #define DMA_V(t,slot) glds16(vsrc+(long)(t)*KVBLK*DM,(unsigned)__builtin_amdgcn_readfirstlane(vdst+(slot)))
  const int vb0=(int)(lds0+LDS_V)+((lane>>4)&1)*32+(lane&3)*8+(4*hi+((lane&15)>>2))*64;
  const char*Kbase=shm+LDS_K; bf16x8 kf[8];
  const lds_cptr shm3=(lds_cptr)shm; const lds_cptr kp0=shm3+LDS_K+hi*1024+r32*16; const lds_cptr vp0=shm3+LDS_V+((lane>>4)&1)*32+(lane&3)*8+(4*hi+((lane&15)>>2))*64;
  const int NT=(q0+QB)/KVBLK;
  DMA_K(0,0);DMA_V(0,0);DMA_K(1,SLOTB);
  bf16x8 qr[4];
  #pragma unroll
  for(int d0=0;d0<4;++d0)qr[d0]=*reinterpret_cast<const bf16x8*>(&Qw[(long)r32*DM+d0*16+hi*8]);
  float mhat=0.f,l_reg=0.f;f32x16 o[2];o[0]=f32x16{};o[1]=f32x16{};const f32x16 negm=f32x16{};
  const int qrel=wid*QBLK+r32;
  #define CMASK(P0,P1,t) do{int jb_=(t)-(NT-4); if(jb_>=0)cmask(P0,P1,jb_,qrel,hi);}while(0)
  #define ABIAS(P0,P1,t) do{ const __attribute__((address_space(3))) f32x4b*cbp_=(const __attribute__((address_space(3))) f32x4b*)(cb+64*(t)+4*hi); const float mh_=mhat; \
    _Pragma("unroll") for(int g_=0;g_<4;++g_){ const f32x4b b0_=cbp_[2*g_]+mh_; \
      P0[4*g_+0]-=b0_[0];P0[4*g_+1]-=b0_[1];P0[4*g_+2]-=b0_[2];P0[4*g_+3]-=b0_[3]; SBAR(); const f32x4b b1_=cbp_[8+2*g_]+mh_; P1[4*g_+0]-=b1_[0];P1[4*g_+1]-=b1_[1];P1[4*g_+2]-=b1_[2];P1[4*g_+3]-=b1_[3]; SBAR(); } }while(0)
  bool resc=false;
  #define START(P0,P1) do{ const float rm=rowmax(P0,P1); resc=false; \
    { const float dl=rm; mhat=fadd_s(mhat,dl); \
      _Pragma("unroll") for(int r=0;r<16;++r){P0[r]=fsub_s(P0[r],dl);P1[r]=fsub_s(P1[r],dl);} \
      } \
    _Pragma("unroll") for(int r=0;r<16;++r)P0[r]=__builtin_amdgcn_exp2f(P0[r]); }while(0)
  #define RESC() do{ if(resc){ asm volatile("s_waitcnt lgkmcnt(0)":::"memory"); \
      _Pragma("unroll") for(int d_=0;d_<2;++d_) _Pragma("unroll") for(int r=0;r<16;++r)o[d_][r]*=wsf[crow(r,hi)]; } }while(0)
  f32x16 pA0,pA1,pB0,pB1;
  int sl_prev=0,sl_cur=0,sl_next=SLOTB;
  #define ROT() do{sl_prev=sl_cur;sl_cur=sl_next;sl_next=(sl_next==(NSLOT-1)*SLOTB)?0:sl_next+SLOTB;}while(0)
  DMA_K(2,2*SLOTB);
  WAIT_BAR(3);
  qkt(pA0,pA1,Kbase,qr,negm,r32,hi);asm volatile("s_nop 15\n\ts_nop 7":"+v"(pA0),"+v"(pA1));ABIAS(pA0,pA1,0);CMASK(pA0,pA1,0);
  START(pA0,pA1);
  _Pragma("unroll") for(int r=0;r<16;++r)pA1[r]=__builtin_amdgcn_exp2f(pA1[r]);
  WAIT_BAR(0);
  DMA_K(3,0);DMA_V(1,SLOTB);
  ROT();
  kload8(kf,kp0+sl_cur);
  WAIT_BAR(2);
  s16x4 vlo[8],vhi[8]; u32x4 pw0,pw1,pw2,pw3;
  #define PKW(P,B) cvtpk_s(P[B],P[B+1])
  #define PAF(k) __builtin_bit_cast(bf16x8,pw##k)
  #define VFR(i) (bf16x8){vlo[i][0],vlo[i][1],vlo[i][2],vlo[i][3],vhi[i][0],vhi[i][1],vhi[i][2],vhi[i][3]}
  #define PIN(x) asm volatile("":"+v"(x))
  #define MX3(a,b,c) __builtin_fmaxf(__builtin_fmaxf((a),(b)),(c))
  #define GAPA(MF,A0,A1,A2,A3,W0,W1,PW) do{ MF; sacc+=A0; sacc+=A1; sacc+=A2; sacc+=A3; PIN(sacc); W0; W1; PIN(PW); SBAR(); }while(0)
  #define EX(v) __builtin_amdgcn_exp2f(v)
  #define GAPB(MF,X,B) do{ MF; X[B]=EX(X[B]); X[B+1]=EX(X[B+1]); X[B+2]=EX(X[B+2]); X[B+3]=EX(X[B+3]); PIN(X); SBAR(); }while(0)
  #define VRD(i) do{ vlo[i]=vtr(vp_+(((i)>>2)*4096+((i)&3)*1024)); vhi[i]=vtr(vp_+(((i)>>2)*4096+((i)&3)*1024+512)); }while(0)
  #define KRD(G,j) do{ if(G){ kload2(kf,kp0+sl_next,j); SBAR(); } }while(0)
  #define STEP(C0,C1,P0,P1,t,GK,GV,GL) do{ SBAR(); \
    const lds_cptr vp_=vp0+sl_prev; \
    VRD(0); SBAR(); float sacc=(P0[0]+P0[1]); \
    GAPA(C0=__builtin_amdgcn_mfma_f32_32x32x16_bf16(kf[0],qr[0],negm,0,0,0), P0[2],P0[3],P0[4],P0[5],     pw0[0]=PKW(P0,0), pw0[1]=PKW(P0,2), pw0); \
    VRD(4); SBAR(); GAPA(C1=__builtin_amdgcn_mfma_f32_32x32x16_bf16(kf[1],qr[0],negm,0,0,0), P0[6],P0[7],P0[8],P0[9],     pw0[2]=PKW(P0,4), pw0[3]=PKW(P0,6), pw0); \
    VRD(1); SBAR(); GAPA(C0=__builtin_amdgcn_mfma_f32_32x32x16_bf16(kf[2],qr[1],C0,0,0,0),   P0[10],P0[11],P0[12],P0[13], pw1[0]=PKW(P0,8), pw1[1]=PKW(P0,10), pw1); \
    VRD(5); SBAR(); GAPA(C1=__builtin_amdgcn_mfma_f32_32x32x16_bf16(kf[3],qr[1],C1,0,0,0),   P0[14],P0[15],P1[0],P1[1],   pw1[2]=PKW(P0,12),pw1[3]=PKW(P0,14), pw1); \
    VRD(2); SBAR(); GAPA(C0=__builtin_amdgcn_mfma_f32_32x32x16_bf16(kf[4],qr[2],C0,0,0,0),   P1[2],P1[3],P1[4],P1[5],     pw2[0]=PKW(P1,0), pw2[1]=PKW(P1,2), pw2); \
    VRD(6); SBAR(); GAPA(C1=__builtin_amdgcn_mfma_f32_32x32x16_bf16(kf[5],qr[2],C1,0,0,0),   P1[6],P1[7],P1[8],P1[9],     pw2[2]=PKW(P1,4), pw2[3]=PKW(P1,6), pw2); \
    VRD(3); SBAR(); GAPA(C0=__builtin_amdgcn_mfma_f32_32x32x16_bf16(kf[6],qr[3],C0,0,0,0),   P1[10],P1[11],P1[12],P1[13], pw3[0]=PKW(P1,8), pw3[1]=PKW(P1,10), pw3); \
    VRD(7); SBAR(); GAPA(C1=__builtin_amdgcn_mfma_f32_32x32x16_bf16(kf[7],qr[3],C1,0,0,0),   P1[14],P1[15],0.f,0.f,       pw3[2]=PKW(P1,12),pw3[3]=PKW(P1,14), pw3); \
    l_reg+=sacc; \
    if(GK){DMA_K((t)+3,sl_cur);} if(GV){DMA_V((t)+1,sl_next);} \
    ABIAS(C0,C1,t); CMASK(C0,C1,t); \
    { float a=MX3(C0[0],C0[1],C1[0]),b=MX3(C0[2],C0[3],C1[1]); a=MX3(a,C1[2],C1[3]); \
      _Pragma("unroll") for(int r=4;r<16;r+=4){a=MX3(a,C0[r],C0[r+1]);b=MX3(b,C0[r+2],C0[r+3]);a=MX3(a,C1[r],C1[r+1]);b=MX3(b,C1[r+2],C1[r+3]);} \
      float rm=__builtin_fmaxf(a,b); { auto rr=__builtin_amdgcn_permlane32_swap(__float_as_uint(rm),__float_as_uint(rm),false,false); rm=__builtin_fmaxf(__uint_as_float(rr[0]),__uint_as_float(rr[1])); } \
      resc=false; \
      if(__builtin_expect(__any(rm>(float)THRL),0)){ const float dl=__builtin_fmaxf(rm,0.f); mhat+=dl; \
        _Pragma("unroll") for(int r=0;r<16;++r){C0[r]-=dl;C1[r]-=dl;} \
        const float f=__builtin_amdgcn_exp2f(-dl); l_reg*=f; if(hi==0)wsf[r32]=f; resc=true; } } \
    SBAR(); \
    GAPB(o[0]=__builtin_amdgcn_mfma_f32_32x32x16_bf16(PAF(0),VFR(0),o[0],0,0,0), C0,0); \
    GAPB(o[1]=__builtin_amdgcn_mfma_f32_32x32x16_bf16(PAF(0),VFR(4),o[1],0,0,0), C0,4); \
    KRD(GL,0); GAPB(o[0]=__builtin_amdgcn_mfma_f32_32x32x16_bf16(PAF(1),VFR(1),o[0],0,0,0), C0,8); \
    KRD(GL,1); GAPB(o[1]=__builtin_amdgcn_mfma_f32_32x32x16_bf16(PAF(1),VFR(5),o[1],0,0,0), C0,12); \
    KRD(GL,2); GAPB(o[0]=__builtin_amdgcn_mfma_f32_32x32x16_bf16(PAF(2),VFR(2),o[0],0,0,0), C1,0); \
    KRD(GL,3); GAPB(o[1]=__builtin_amdgcn_mfma_f32_32x32x16_bf16(PAF(2),VFR(6),o[1],0,0,0), C1,4); \
    GAPB(o[0]=__builtin_amdgcn_mfma_f32_32x32x16_bf16(PAF(3),VFR(3),o[0],0,0,0), C1,8); \
    GAPB(o[1]=__builtin_amdgcn_mfma_f32_32x32x16_bf16(PAF(3),VFR(7),o[1],0,0,0), C1,12); \
    }while(0)
  int t=1;
  #undef CMASK
  #define CMASK(P0,P1,t) do{}while(0)
  for(;t+5<NT;t+=2){
    STEP(pB0,pB1,pA0,pA1,t,true,true,true);     WAIT_BAR(2); RESC(); ROT();
    STEP(pA0,pA1,pB0,pB1,t+1,true,true,true);   WAIT_BAR(2); RESC(); ROT();
  }
  #undef CMASK
  #define CMASK(P0,P1,t) do{int jb_=(t)-(NT-4); if(jb_>=0)cmask(P0,P1,jb_,qrel,hi);}while(0)
  #define ENDW(tt) do{ if((tt)+3<NT){WAIT_BAR(2);} else if((tt)+2<NT){WAIT_BAR(1);} else {WAIT_BAR(0);} }while(0)
  for(;t+1<NT;t+=2){
    STEP(pB0,pB1,pA0,pA1,t,(t+3<NT),(t+1<NT),(t+1<NT));       ENDW(t);   RESC(); ROT();
    STEP(pA0,pA1,pB0,pB1,t+1,(t+4<NT),(t+2<NT),(t+2<NT));     ENDW(t+1); RESC(); ROT();
  }
  STEP(pB0,pB1,pA0,pA1,NT-1,false,false,false); RESC();
  { float sacc=pB0[0]+pB0[1]; _Pragma("unroll") for(int r=2;r<16;++r)sacc+=pB0[r]; _Pragma("unroll") for(int r=0;r<16;++r)sacc+=pB1[r]; l_reg+=sacc;
    pw0=(u32x4){PKW(pB0,0),PKW(pB0,2),PKW(pB0,4),PKW(pB0,6)};pw1=(u32x4){PKW(pB0,8),PKW(pB0,10),PKW(pB0,12),PKW(pB0,14)};pw2=(u32x4){PKW(pB1,0),PKW(pB1,2),PKW(pB1,4),PKW(pB1,6)};pw3=(u32x4){PKW(pB1,8),PKW(pB1,10),PKW(pB1,12),PKW(pB1,14)};
    SBAR(); pv(o,vb0+sl_cur,PAF(0),PAF(1),PAF(2),PAF(3)); }
  #undef PKW
  #undef PAF
  #undef VFR
  #undef PIN
  #undef MX3
  #undef GAPA
  #undef GAPB
  #undef EX
  #undef VRD
  #undef KRD
  #undef STEP
  #undef ENDW
  {auto rr=__builtin_amdgcn_permlane32_swap(__float_as_uint(l_reg),__float_as_uint(l_reg),false,false);l_reg=__uint_as_float(rr[0])+__uint_as_float(rr[1]);}
  if(hi==0)wsf[32+r32]=l_reg;asm volatile("s_waitcnt lgkmcnt(0)":::"memory");
  float rli[16];
  #pragma unroll
  for(int r=0;r<16;++r)rli[r]=__builtin_amdgcn_rcpf(wsf[32+crow(r,hi)]);
  bf16*Ow=O+(rowbase+q0+wid*QBLK)*DM+h*D;
  { bf16*stg=(bf16*)(shm+LDS_OST)+wid*2048;
    #pragma unroll
    for(int r=0;r<16;++r){const int orow=crow(r,hi);
      #pragma unroll
      for(int d0=0;d0<2;++d0)stg[orow*64+d0*32+r32]=__float2bfloat16(o[d0][r]*rli[r]);}
    asm volatile("s_waitcnt lgkmcnt(0)":::"memory");
    #pragma unroll
    for(int i=0;i<4;++i){const int row=i*8+(lane>>3),ch=lane&7; const u32x4 v=*(const u32x4*)(stg+row*64+ch*8); ATTN_STORE16(Ow+(long)row*DM+ch*8,v);} }
  asm volatile("s_waitcnt lgkmcnt(0)\n\ts_barrier":::"memory");
  #undef DMA_K
  #undef DMA_V
  #undef CMASK
  #undef ABIAS
  #undef START
  #undef RESC
  #undef ROT
}
constexpr int ATTN_LDS_BYTES=LDS_BYTES;
#undef SBAR
#undef WAIT_BAR
}

#ifndef LAS
#define LAS __attribute__((address_space(3)))
#endif
constexpr int MK_WAVES = 8;
namespace pg8 { __device__ __forceinline__ unsigned cvt_pk_bf16(float lo, float hi); }

namespace sb_body {
typedef short bf16x8 __attribute__((ext_vector_type(8)));
typedef float f32x16 __attribute__((ext_vector_type(16)));
__device__ __forceinline__ void sb_head(LAS unsigned char* lds, int lane, int wid, int bh, const bf16_t* Q, const bf16_t* K, const bf16_t* V, bf16_t* O) {
    const int r32 = lane & 31, hi = lane >> 5;
    const int b = bh / NH, hh = bh % NH; const size_t rowb = (size_t)b * SEQ;
    const bf16_t* Qh = Q + rowb * DM + hh * HD; const bf16_t* Kh = K + rowb * DM + hh * HD; const bf16_t* Vh = V + rowb * DM + hh * HD; bf16_t* Oh = O + rowb * DM + hh * HD;
    LAS unsigned char* slot0 = lds + wid * 16384;
    const int vb0 = (int)(unsigned)(size_t)slot0 + ((lane >> 4) & 1) * 32 + (lane & 3) * 8 + (4 * hi + ((lane & 15) >> 2)) * 64;
    const bf16_t* vsrc0 = Vh + (size_t)(lane >> 2) * DM + (lane & 3) * 8;
#define SB_DMAV(t, sc) do { _Pragma("unroll") for (int p_ = 0; p_ < 8; ++p_) \
        __builtin_amdgcn_global_load_lds((const unsigned*)(vsrc0 + (size_t)(64 * (t) + 16 * (p_ & 3)) * DM + 32 * (p_ >> 2)), (LAS unsigned*)(slot0 + (sc) * 8192 + p_ * 1024), 16, 0, 0); } while (0)
#define SB_LOADK(kf, t) do { const bf16_t* kp_ = Kh + (size_t)(64 * (t) + r32) * DM + 8 * hi; _Pragma("unroll") for (int d0_ = 0; d0_ < 4; ++d0_) { \
        kf[2 * d0_] = *(const bf16x8*)(kp_ + 16 * d0_); kf[2 * d0_ + 1] = *(const bf16x8*)(kp_ + (size_t)32 * DM + 16 * d0_); } } while (0)
    for (int uu = wid; uu < SEQ / 32; uu += MK_WAVES) {
        const int q0w = uu * 32, qabs = q0w + r32;
        bf16x8 qr[4];
#pragma unroll
        for (int d0 = 0; d0 < 4; ++d0) qr[d0] = *(const bf16x8*)(Qh + (size_t)qabs * DM + d0 * 16 + hi * 8);
        f32x16 o[2]; o[0] = f32x16{}; o[1] = f32x16{};
        float carry = 1.f; int jt = (q0w + 30) >> 6, sc = 0; bool first = true;
        bf16x8 kf[8], kfn[8];
        SB_DMAV(jt, 0); asm volatile("" ::: "memory"); SB_LOADK(kf, jt);
        for (;;) {
            f32x16 p0 = f32x16{}, p1 = f32x16{};
#pragma unroll
            for (int d0 = 0; d0 < 4; ++d0) { p0 = __builtin_amdgcn_mfma_f32_32x32x16_bf16(kf[2 * d0], qr[d0], p0, 0, 0, 0); p1 = __builtin_amdgcn_mfma_f32_32x32x16_bf16(kf[2 * d0 + 1], qr[d0], p1, 0, 0, 0); }
            const bool more = jt > 0;
            asm volatile("" ::: "memory");
            if (more) { SB_DMAV(jt - 1, sc ^ 1); asm volatile("" ::: "memory"); SB_LOADK(kfn, jt - 1); }
            asm volatile("" ::: "memory");
            float nb[8][4], be[8][4];
#pragma unroll
            for (int w = 0; w < 8; ++w)
#pragma unroll
                for (int i = 0; i < 4; ++i) { const int r = (w & 3) * 4 + i; float x = (w < 4) ? p0[r] : p1[r]; x = fminf(x, 64.f);
                    const float e = __builtin_amdgcn_exp2f(x), rr = __builtin_amdgcn_rcpf(1.f + e);
                    const int kv = 64 * jt + 32 * (w >> 2) + 8 * (w & 3) + 4 * hi + i; const bool valid = !first || (kv < qabs);
                    be[w][i] = valid ? e * rr : 0.f; nb[w][i] = valid ? rr : 1.f; }
            float Xs[8];
            float Te[8], To[8];
#pragma unroll
            for (int w = 0; w < 8; ++w) { const float s2 = nb[w][3], s1 = s2 * nb[w][2], s0 = s1 * nb[w][1], T = s0 * nb[w][0];
                be[w][2] *= s2; be[w][1] *= s1; be[w][0] *= s0;
                auto rr2 = __builtin_amdgcn_permlane32_swap(__float_as_uint(T), __float_as_uint(T), false, false); Te[w] = __uint_as_float(rr2[0]); To[w] = __uint_as_float(rr2[1]); }
            float W = 1.f;
#pragma unroll
            for (int w = 7; w >= 0; --w) { const float xe = W * To[w]; Xs[w] = hi ? W : xe; W = xe * Te[w]; }
            unsigned pw[16];
#pragma unroll
            for (int w = 0; w < 8; ++w) { const float sc2 = Xs[w] * carry; pw[2 * w] = pg8::cvt_pk_bf16(be[w][0] * sc2, be[w][1] * sc2); pw[2 * w + 1] = pg8::cvt_pk_bf16(be[w][2] * sc2, be[w][3] * sc2); }
            carry *= W;
            const bf16x8 pa0 = __builtin_bit_cast(bf16x8, (u32x4){pw[0], pw[1], pw[2], pw[3]}), pa1 = __builtin_bit_cast(bf16x8, (u32x4){pw[4], pw[5], pw[6], pw[7]});
            const bf16x8 pa2 = __builtin_bit_cast(bf16x8, (u32x4){pw[8], pw[9], pw[10], pw[11]}), pa3 = __builtin_bit_cast(bf16x8, (u32x4){pw[12], pw[13], pw[14], pw[15]});
            if (more) asm volatile("s_waitcnt vmcnt(16)" ::: "memory"); else asm volatile("s_waitcnt vmcnt(0)" ::: "memory");
            attn_body::pv(o, vb0 + sc * 8192, pa0, pa1, pa2, pa3);
            if (!more || __all(carry < 1e-30f)) break;
#pragma unroll
            for (int i = 0; i < 8; ++i) kf[i] = kfn[i];
            sc ^= 1; --jt; first = false;
        }
        asm volatile("s_waitcnt vmcnt(0)" ::: "memory");
#pragma unroll
        for (int d0 = 0; d0 < 2; ++d0)
#pragma unroll
            for (int r = 0; r < 16; ++r) Oh[(size_t)(q0w + crow(r, hi)) * DM + d0 * 32 + r32] = (bf16_t)f2bf(o[d0][r]);
    }
#undef SB_DMAV
#undef SB_LOADK
}
}

#ifndef LAS
#define LAS __attribute__((address_space(3)))
#endif
#define GAS __attribute__((address_space(1)))
constexpr size_t WS_SS = WS_END;
constexpr size_t WS_WR = WS_SS + 2 * MiB;
constexpr size_t WS_WF = WS_WR + 1 * MiB;
constexpr size_t WS_HB2 = WS_WF + 1 * MiB;
constexpr size_t WS_WGU8 = WS_HB2 + 64 * MiB;
constexpr size_t WS_WD8 = WS_WGU8 + 128 * MiB;
constexpr size_t WS_HB8 = WS_WD8 + 64 * MiB;
constexpr size_t WS_ACT8 = WS_HB8 + 32 * MiB;
constexpr size_t WS_END2 = WS_ACT8 + 136 * MiB;
#ifndef MK_FP8_MASK
#define MK_FP8_MASK 0
#endif
constexpr float W8SCALE = 256.f, W8INV = 1.f / 256.f;
constexpr int CW_BAR = 4096;
constexpr int CW_CNT2 = 16384, CNT_STRIDE = 64;

namespace pg8 {
constexpr int BM = 256, BK = 64, HALF = 128, HTB = HALF * BK * 2, STAGE_BYTES = 8 * HTB, NXCD = 8, WGM = 8;
__device__ __forceinline__ int lds_byte(int r, int c) { const int st = (r >> 4) * 2 + (c >> 5), rr = r & 15, cc = c & 31, ob = rr * 64 + cc * 2; return st * 1024 + (ob ^ (((ob >> 9) & 1) << 5)); }
__device__ __forceinline__ void stage_rc(int b, int& R, int& C) { const int st = b / 1024, sb = b % 1024, swz = sb ^ (((sb >> 9) & 1) << 5); R = (st >> 1) * 16 + swz / 64; C = (st & 1) * 32 + (swz % 64) / 2; }
__device__ __forceinline__ int perm32(int rho) { const int n = rho >> 4, i = rho & 15; return 8 * (i >> 2) + 4 * n + (i & 3); }
__device__ __forceinline__ unsigned cvt_pk_bf16(float lo, float hi) { unsigned r; asm volatile("v_cvt_pk_bf16_f32 %0, %1, %2" : "=v"(r) : "v"(lo), "v"(hi)); return r; }

struct Unit { int arow0, brow0, pn, e, rank0, cnt, ui; };

__device__ __forceinline__ int xcd_remap(int L, int nwg) { const int q = nwg / NXCD, r = nwg % NXCD, xcd = L % NXCD, off = L / NXCD; return (xcd < r ? xcd * (q + 1) : r * (q + 1) + (xcd - r) * q) + off; }

struct DenseOrder {
    int nM, nN, nwg, G, c;
    __device__ __forceinline__ void init(int M, int N, int G_, int c_) { nM = M / BM; nN = N / BM; nwg = nM * nN; G = G_; c = c_; }
    __device__ __forceinline__ bool next(int i, Unit& u) const {
        const long L = (long)i * G + c; if (L >= nwg) return false;
        const int wgid = xcd_remap((int)L, nwg);
        const int nig = WGM * nN, gid = wgid / nig, fm = gid * WGM, gsz = (nM - fm) < WGM ? (nM - fm) : WGM;
        const int pm = fm + ((wgid % nig) % gsz), pn = (wgid % nig) / gsz;
        u.arow0 = pm * BM; u.brow0 = pn * BM; u.pn = pn; u.e = 0; u.rank0 = 0; u.cnt = 0; u.ui = i; return true;
    }
    __device__ __forceinline__ int arow(const Unit& u, int lr) const { return u.arow0 + lr; }
};
struct PJOrder {
    DenseOrder d; int G, c;
    __device__ __forceinline__ void init(int G_, int c_) { d.init(NTOK, DM, G_, 0); G = G_; c = c_; }
    __device__ __forceinline__ bool next(int i, Unit& u) const {
        const long L = (long)i * G + c; if (L >= 2 * d.nwg) return false;
        const int l2 = (L >= d.nwg) ? 1 : 0; const int wgid = xcd_remap((int)L - l2 * d.nwg, d.nwg);
        const int nig = WGM * d.nN, gid = wgid / nig, fm = gid * WGM, gsz = (d.nM - fm) < WGM ? (d.nM - fm) : WGM;
        const int pm = fm + ((wgid % nig) % gsz), pn = (wgid % nig) / gsz;
        u.arow0 = l2 * NTOK + pm * BM; u.brow0 = l2 * DM + pn * BM; u.pn = pn; u.e = 0; u.rank0 = 0; u.cnt = 0; u.ui = i; return true;
    }
    __device__ __forceinline__ int arow(const Unit& u, int lr) const { return u.arow0 + lr; }
};
struct MoeOrder {
    int NN, nwg, G, c; const LAS int* tstartL; const LAS int* cntL; const LAS unsigned short* tokL; bool gather;
    __device__ __forceinline__ bool next(int i, Unit& u) const {
        const long L = (long)i * G + c; if (L >= nwg) return false;
        const int wgid = xcd_remap((int)L, nwg);
        const int T = wgid / NN, pn = wgid - T * NN;
        const int lane = threadIdx.x & 63;
        const int lo = (lane < NE) ? tstartL[lane] : 0x7fffffff, hi = (lane < NE) ? tstartL[lane + 1] : 0x7fffffff;
        const unsigned long long m = __ballot(lo <= T && T < hi);
        const int e = __builtin_amdgcn_readfirstlane((int)__builtin_ctzll(m | (1ull << 63)));
        u.e = e; u.rank0 = (T - tstartL[e]) * 256; u.cnt = cntL[e]; u.arow0 = T * 256; u.brow0 = (e * NN + pn) * 256; u.pn = pn; u.ui = i; return true;
    }
    __device__ __forceinline__ int arow(const Unit& u, int lr) const { return gather ? (int)tokL[u.ui * 256 + lr] : u.arow0 + lr; }
};

typedef const f32x4 (&AccRef)[2][2][4][2];
struct EpiQKV {
    bf16_t* Q; const LAS float* rowL;
    __device__ __forceinline__ void operator()(AccRef acc, const Unit& u, int wr, int wc, int fr, int fq) const {
        const int t = u.brow0 >> 10, colt = u.brow0 & 1023; bf16_t* base = Q + (size_t)t * ((size_t)NTOK * DM); const float sc = (t == 0) ? C2 : 1.f;
        const int col0 = colt + wc * 32 + 8 * fq;
#pragma unroll
        for (int ai = 0; ai < 2; ++ai)
#pragma unroll
            for (int m = 0; m < 4; ++m) { const int lr = ai * HALF + wr * 64 + m * 16 + fr; const int row = u.arow0 + lr;
                const float rs = rowL[u.ui * 256 + lr] * sc; bf16_t* rowp = base + (size_t)row * DM + col0;
#pragma unroll
                for (int bj = 0; bj < 2; ++bj) { const f32x4 v0 = acc[ai][bj][m][0] * rs, v1 = acc[ai][bj][m][1] * rs; u32x4 w;
                    w.x = cvt_pk_bf16(v0[0], v0[1]); w.y = cvt_pk_bf16(v0[2], v0[3]); w.z = cvt_pk_bf16(v1[0], v1[1]); w.w = cvt_pk_bf16(v1[2], v1[3]); *(u32x4*)(rowp + bj * HALF) = w; } }
    }
};
struct EpiPJ {
    bf16_t* O;
    __device__ __forceinline__ void operator()(AccRef acc, const Unit& u, int wr, int wc, int fr, int fq) const {
        const int col0 = u.pn * BM + wc * 32 + 8 * fq;
#pragma unroll
        for (int ai = 0; ai < 2; ++ai)
#pragma unroll
            for (int m = 0; m < 4; ++m) { const int row = u.arow0 + ai * HALF + wr * 64 + m * 16 + fr; bf16_t* rowp = O + (size_t)row * DM + col0;
#pragma unroll
                for (int bj = 0; bj < 2; ++bj) { const f32x4 v0 = acc[ai][bj][m][0], v1 = acc[ai][bj][m][1]; u32x4 w;
                    w.x = cvt_pk_bf16(v0[0], v0[1]); w.y = cvt_pk_bf16(v0[2], v0[3]); w.z = cvt_pk_bf16(v1[0], v1[1]); w.w = cvt_pk_bf16(v1[2], v1[3]); *(u32x4*)(rowp + bj * HALF) = w; } }
    }
};
struct EpiWo {
    const bf16_t* hin; bf16_t* hb; unsigned char* hb8;
    __device__ __forceinline__ void operator()(AccRef acc, const Unit& u, int wr, int wc, int fr, int fq) const {
        const int col0 = u.brow0 + wc * 32 + 8 * fq;
#pragma unroll
        for (int ai = 0; ai < 2; ++ai)
#pragma unroll
            for (int m = 0; m < 4; ++m) { const int row = u.arow0 + ai * HALF + wr * 64 + m * 16 + fr; const size_t off = (size_t)row * DM + col0;
#pragma unroll
                for (int bj = 0; bj < 2; ++bj) { const size_t o = off + bj * HALF; const u32x4 hv = *(const u32x4*)(hin + o); const f32x4 a0 = acc[ai][bj][m][0], a1 = acc[ai][bj][m][1]; u32x4 w;
                    if (hb8) { unsigned p0 = 0u, p1 = 0u; p0 = __builtin_amdgcn_cvt_pk_fp8_f32(__uint_as_float(hv.x << 16) + a0[0], __uint_as_float(hv.x & 0xffff0000u) + a0[1], p0, false); p0 = __builtin_amdgcn_cvt_pk_fp8_f32(__uint_as_float(hv.y << 16) + a0[2], __uint_as_float(hv.y & 0xffff0000u) + a0[3], p0, true);
                        p1 = __builtin_amdgcn_cvt_pk_fp8_f32(__uint_as_float(hv.z << 16) + a1[0], __uint_as_float(hv.z & 0xffff0000u) + a1[1], p1, false); p1 = __builtin_amdgcn_cvt_pk_fp8_f32(__uint_as_float(hv.w << 16) + a1[2], __uint_as_float(hv.w & 0xffff0000u) + a1[3], p1, true);
                        *(u32x2*)(hb8 + o) = (u32x2){p0, p1}; }
                    w.x = cvt_pk_bf16(__uint_as_float(hv.x << 16) + a0[0], __uint_as_float(hv.x & 0xffff0000u) + a0[1]); w.y = cvt_pk_bf16(__uint_as_float(hv.y << 16) + a0[2], __uint_as_float(hv.y & 0xffff0000u) + a0[3]);
                    w.z = cvt_pk_bf16(__uint_as_float(hv.z << 16) + a1[0], __uint_as_float(hv.z & 0xffff0000u) + a1[1]); w.w = cvt_pk_bf16(__uint_as_float(hv.w << 16) + a1[2], __uint_as_float(hv.w & 0xffff0000u) + a1[3]);
                    *(u32x4*)(hb + o) = w; }
                if (m & 1) asm volatile("" ::: "memory"); }
    }
};
__device__ __forceinline__ float fast_sigmoid(float x) { return __builtin_amdgcn_rcpf(1.f + __builtin_amdgcn_exp2f(-LOG2E * x)); }
struct EpiPLE {
    const bf16_t* hin; bf16_t* hb; const bf16_t* PJ; const LAS float* rowL; float* SS;
    __device__ __forceinline__ void operator()(AccRef acc, const Unit& u, int wr, int wc, int fr, int fq) const {
        const int col0 = u.brow0 + wc * 32 + 8 * fq;
#pragma unroll
        for (int ai = 0; ai < 2; ++ai)
#pragma unroll
            for (int m = 0; m < 4; ++m) { const int lr = ai * HALF + wr * 64 + m * 16 + fr; const int row = u.arow0 + lr; const size_t off = (size_t)row * DM + col0; const float rs = rowL[u.ui * 256 + lr]; float ssq = 0.f;
#pragma unroll
                for (int bj = 0; bj < 2; ++bj) { const size_t o = off + bj * HALF; const u32x4 pj = *(const u32x4*)(PJ + o); const u32x4 hv = *(const u32x4*)(hin + o);
                    const f32x4 a0 = acc[ai][bj][m][0] * rs, a1 = acc[ai][bj][m][1] * rs; float x[8];
                    x[0] = __uint_as_float(hv.x << 16) + fast_sigmoid(a0[0]) * __uint_as_float(pj.x << 16); x[1] = __uint_as_float(hv.x & 0xffff0000u) + fast_sigmoid(a0[1]) * __uint_as_float(pj.x & 0xffff0000u);
                    x[2] = __uint_as_float(hv.y << 16) + fast_sigmoid(a0[2]) * __uint_as_float(pj.y << 16); x[3] = __uint_as_float(hv.y & 0xffff0000u) + fast_sigmoid(a0[3]) * __uint_as_float(pj.y & 0xffff0000u);
                    x[4] = __uint_as_float(hv.z << 16) + fast_sigmoid(a1[0]) * __uint_as_float(pj.z << 16); x[5] = __uint_as_float(hv.z & 0xffff0000u) + fast_sigmoid(a1[1]) * __uint_as_float(pj.z & 0xffff0000u);
                    x[6] = __uint_as_float(hv.w << 16) + fast_sigmoid(a1[2]) * __uint_as_float(pj.w << 16); x[7] = __uint_as_float(hv.w & 0xffff0000u) + fast_sigmoid(a1[3]) * __uint_as_float(pj.w & 0xffff0000u);
                    u32x4 w; w.x = cvt_pk_bf16(x[0], x[1]); w.y = cvt_pk_bf16(x[2], x[3]); w.z = cvt_pk_bf16(x[4], x[5]); w.w = cvt_pk_bf16(x[6], x[7]); *(u32x4*)(hb + o) = w;
                    float q0 = __uint_as_float(w.x << 16), q1 = __uint_as_float(w.x & 0xffff0000u), q2 = __uint_as_float(w.y << 16), q3 = __uint_as_float(w.y & 0xffff0000u);
                    float q4 = __uint_as_float(w.z << 16), q5 = __uint_as_float(w.z & 0xffff0000u), q6 = __uint_as_float(w.w << 16), q7 = __uint_as_float(w.w & 0xffff0000u);
                    ssq += (q0 * q0 + q1 * q1) + (q2 * q2 + q3 * q3) + (q4 * q4 + q5 * q5) + (q6 * q6 + q7 * q7); }
                ssq += __shfl_xor(ssq, 16); ssq += __shfl_xor(ssq, 32);
                if (fq == 0) SS[(size_t)row * 16 + u.pn * 4 + wc] = ssq;
                asm volatile("" ::: "memory"); }
    }
};
template <bool OUT8> struct EpiGU {
    void* ACT; const float* bgu; const LAS float* rowL;
    __device__ __forceinline__ void operator()(AccRef acc, const Unit& u, int wr, int wc, int fr, int fq) const {
        const int jc = u.pn * 128 + wc * 32 + 8 * fq; const float* bp = bgu + (size_t)u.e * (2 * FF) + jc;
        const f32x4 bg0 = *(const f32x4*)(bp), bg1 = *(const f32x4*)(bp + 4), bl0 = *(const f32x4*)(bp + FF), bl1 = *(const f32x4*)(bp + FF + 4);
#pragma unroll
        for (int ai = 0; ai < 2; ++ai)
#pragma unroll
            for (int m = 0; m < 4; ++m) { const int lr = ai * HALF + wr * 64 + m * 16 + fr; const float rs = rowL[u.ui * 256 + lr];
                f32x4 g0 = acc[ai][0][m][0] * rs + bg0, g1 = acc[ai][0][m][1] * rs + bg1, l0 = acc[ai][1][m][0] * rs + bl0, l1 = acc[ai][1][m][1] * rs + bl1; float a[8];
#pragma unroll
                for (int c = 0; c < 4; ++c) { const float gl = fminf(g0[c], 7.f), ln = fminf(fmaxf(l0[c], -7.f), 7.f); a[c] = gl * fast_sigmoid(1.702f * gl) * (ln + 1.f);
                    const float gl2 = fminf(g1[c], 7.f), ln2 = fminf(fmaxf(l1[c], -7.f), 7.f); a[4 + c] = gl2 * fast_sigmoid(1.702f * gl2) * (ln2 + 1.f); }
                if constexpr (OUT8) { unsigned p0 = 0u, p1 = 0u; p0 = __builtin_amdgcn_cvt_pk_fp8_f32(a[0], a[1], p0, false); p0 = __builtin_amdgcn_cvt_pk_fp8_f32(a[2], a[3], p0, true); p1 = __builtin_amdgcn_cvt_pk_fp8_f32(a[4], a[5], p1, false); p1 = __builtin_amdgcn_cvt_pk_fp8_f32(a[6], a[7], p1, true);
                    *(u32x2*)((unsigned char*)ACT + (size_t)(u.arow0 + lr) * FF + jc) = (u32x2){p0, p1}; }
                else { u32x4 w; w.x = cvt_pk_bf16(a[0], a[1]); w.y = cvt_pk_bf16(a[2], a[3]); w.z = cvt_pk_bf16(a[4], a[5]); w.w = cvt_pk_bf16(a[6], a[7]);
                    *(u32x4*)((bf16_t*)ACT + (size_t)(u.arow0 + lr) * FF + jc) = w; } }
    }
};
struct EpiDown {
    bf16_t* Y; const float* bd; const LAS float* rowL; float bscale;
    __device__ __forceinline__ void operator()(AccRef acc, const Unit& u, int wr, int wc, int fr, int fq) const {
        const int col0 = u.pn * 256 + wc * 32 + 8 * fq; const float* bp = bd + (size_t)u.e * DM + col0;
        f32x4 bv[2][2];
#pragma unroll
        for (int bj = 0; bj < 2; ++bj) { bv[bj][0] = *(const f32x4*)(bp + bj * HALF) * bscale; bv[bj][1] = *(const f32x4*)(bp + bj * HALF + 4) * bscale; }
#pragma unroll
        for (int ai = 0; ai < 2; ++ai)
#pragma unroll
            for (int m = 0; m < 4; ++m) { const int lr = ai * HALF + wr * 64 + m * 16 + fr; const float gt = rowL[u.ui * 256 + lr];
                bf16_t* rowp = Y + (size_t)(u.arow0 + lr) * DM + col0;
#pragma unroll
                for (int bj = 0; bj < 2; ++bj) { const f32x4 v0 = (acc[ai][bj][m][0] + bv[bj][0]) * gt, v1 = (acc[ai][bj][m][1] + bv[bj][1]) * gt; u32x4 w;
                    w.x = cvt_pk_bf16(v0[0], v0[1]); w.y = cvt_pk_bf16(v0[2], v0[3]); w.z = cvt_pk_bf16(v1[0], v1[1]); w.w = cvt_pk_bf16(v1[2], v1[3]); *(u32x4*)(rowp + bj * HALF) = w; } }
    }
};

typedef int v8i_t __attribute__((ext_vector_type(8))); typedef int v4i_t __attribute__((ext_vector_type(4)));
template <class Epi, class Sched, bool FP8 = false>
__device__ __forceinline__ void gemm_phase(LAS unsigned char* lds, const void* gA, const void* gBt, const int KB, const Sched& S, const Epi& E) {
    int tid_ = threadIdx.x; asm volatile("" : "+v"(tid_));
    const int tid = tid_, wid = __builtin_amdgcn_readfirstlane(tid >> 6), lane = tid & 63, wr = wid >> 2, wc = wid & 3, fr = lane & 15, fq = lane >> 4;
    const int nt = KB / (BK * 2);
    unsigned voffB[2];
#pragma unroll
    for (int i = 0; i < 2; ++i) { int R, C; stage_rc(tid * 16 + i * 8192, R, C); const int Rb = (R & ~31) + perm32(R & 31); voffB[i] = (unsigned)(Rb * KB + C * 2); }
#define PG8_AOFF(u, o0, o1) do { int t2_ = threadIdx.x; asm volatile("" : "+v"(t2_)); _Pragma("unroll") for (int i = 0; i < 2; ++i) { int R, C; stage_rc(t2_ * 16 + i * 8192, R, C); \
        o0[i] = (unsigned)S.arow(u, R) * (unsigned)KB + (unsigned)C * 2u; o1[i] = (unsigned)S.arow(u, HALF + R) * (unsigned)KB + (unsigned)C * 2u; } } while (0)
    const unsigned kstep = (unsigned)(BK * 2);
    const unsigned hstep = (unsigned)HALF * (unsigned)KB;
    const unsigned ldsw = (unsigned)wid * 1024u;
    unsigned rdA_ = (unsigned)(size_t)lds + (unsigned)lds_byte(wr * 64 + fr, fq * 8), rdB_ = (unsigned)(size_t)lds + 4u * HTB + (unsigned)lds_byte(wc * 32 + fr, fq * 8);
    asm volatile("" : "+v"(rdA_), "+v"(rdB_));
    const LAS unsigned char* const rdA = (const LAS unsigned char*)(size_t)rdA_; const LAS unsigned char* const rdB = (const LAS unsigned char*)(size_t)rdB_;
#define PG8_SA(b, h) (((b) * 2 + (h)) * HTB)
#define PG8_SB(b, h) ((4 + (b) * 2 + (h)) * HTB)
#define PG8_STAGE(bufoff, rs, voff, soff) do { _Pragma("unroll") for (int _i = 0; _i < 2; ++_i) \
        __builtin_amdgcn_raw_ptr_buffer_load_lds(rs, (LAS void*)(lds + (bufoff) + ldsw + _i * 8192), 16, (voff)[_i], (unsigned)(soff), 0, 0); } while (0)
#define PG8_RA(b, h) (((b) * 2 + (h)) * HTB)
#define PG8_LD16A(off) __builtin_bit_cast(v4i_t, *(const LAS bf16x8*)(rdA + (off)))
#define PG8_LD16B(off) __builtin_bit_cast(v4i_t, *(const LAS bf16x8*)(rdB + (off)))
#define PG8_LDA(dst, b, h) do { if constexpr (FP8) { _Pragma("unroll") for (int m = 0; m < 4; ++m) dst##8[m] = __builtin_shufflevector(PG8_LD16A(PG8_RA(b, h) + m * 2048), PG8_LD16A(PG8_RA(b, h) + m * 2048 + 1024), 0, 1, 2, 3, 4, 5, 6, 7); } \
        else { _Pragma("unroll") for (int m = 0; m < 4; ++m) _Pragma("unroll") for (int k = 0; k < 2; ++k) dst[m][k] = *(const LAS bf16x8*)(rdA + PG8_RA(b, h) + m * 2048 + k * 1024); } } while (0)
#define PG8_LDB(dst, b, h) do { if constexpr (FP8) { _Pragma("unroll") for (int n = 0; n < 2; ++n) dst##8[n] = __builtin_shufflevector(PG8_LD16B(PG8_RA(b, h) + n * 2048), PG8_LD16B(PG8_RA(b, h) + n * 2048 + 1024), 0, 1, 2, 3, 4, 5, 6, 7); } \
        else { _Pragma("unroll") for (int n = 0; n < 2; ++n) _Pragma("unroll") for (int k = 0; k < 2; ++k) dst[n][k] = *(const LAS bf16x8*)(rdB + PG8_RA(b, h) + n * 2048 + k * 1024); } } while (0)
#define PG8_MMA(ai, bj, At, Bt) do { __builtin_amdgcn_s_setprio(1); _Pragma("unroll") for (int m = 0; m < 4; ++m) _Pragma("unroll") for (int n = 0; n < 2; ++n) { \
            if constexpr (FP8) acc[ai][bj][m][n] = __builtin_amdgcn_mfma_scale_f32_16x16x128_f8f6f4(Bt##8[n], At##8[m], acc[ai][bj][m][n], 0, 0, 0, 0, 0, 0); \
            else { _Pragma("unroll") for (int k = 0; k < 2; ++k) acc[ai][bj][m][n] = __builtin_amdgcn_mfma_f32_16x16x32_bf16(Bt[n][k], At[m][k], acc[ai][bj][m][n], 0, 0, 0); } } __builtin_amdgcn_s_setprio(0); } while (0)
#define PG8_WAIT_V(n) asm volatile("s_waitcnt vmcnt(" #n ")" ::: "memory")
#define PG8_WAIT_L(n) asm volatile("s_waitcnt lgkmcnt(" #n ")" ::: "memory")
#define PG8_BAR __builtin_amdgcn_s_barrier()
#define PG8_SCHED __builtin_amdgcn_sched_barrier(0)
    Unit cur, nxt; int ui = 0;
    if (!S.next(0, cur)) return;
    f32x4 acc[2][2][4][2];
#pragma unroll
    for (int a = 0; a < 2; ++a)
#pragma unroll
        for (int b = 0; b < 2; ++b)
#pragma unroll
            for (int m = 0; m < 4; ++m)
#pragma unroll
                for (int n = 0; n < 2; ++n) acc[a][b][m][n] = (f32x4){0.f, 0.f, 0.f, 0.f};
    bf16x8 At[4][2], B0[2][2], B1[2][2];
    v8i_t At8[4], B08[2], B18[2];
    unsigned ao0[2], ao1[2];
    PG8_AOFF(cur, ao0, ao1);
    const __amdgpu_buffer_rsrc_t rsA = __builtin_amdgcn_make_buffer_rsrc((void*)gA, 0, 0x7fffffff, 0x00020000), rsB = __builtin_amdgcn_make_buffer_rsrc((void*)gBt, 0, 0x7fffffff, 0x00020000);
    unsigned cB = (unsigned)cur.brow0 * (unsigned)KB;
    PG8_STAGE(PG8_SB(0, 0), rsB, voffB, cB); PG8_STAGE(PG8_SB(0, 1), rsB, voffB, cB + hstep); PG8_STAGE(PG8_SA(0, 0), rsA, ao0, 0u); PG8_STAGE(PG8_SA(0, 1), rsA, ao1, 0u);
    if (wr == 1) PG8_BAR;
    PG8_WAIT_V(2); PG8_BAR;
    PG8_STAGE(PG8_SB(1, 0), rsB, voffB, cB + kstep); PG8_STAGE(PG8_SA(1, 0), rsA, ao0, kstep); PG8_STAGE(PG8_SB(1, 1), rsB, voffB, cB + hstep + kstep);
    PG8_WAIT_V(6); PG8_BAR;
    for (;;) {
        const bool has_next = S.next(ui + 1, nxt);
        const unsigned nB = has_next ? (unsigned)nxt.brow0 * (unsigned)KB : cB;
        _Pragma("clang loop unroll(disable)") for (int t = 0; t < nt; t += 2) {
            const bool last = (t == nt - 2);
            const unsigned a1 = (unsigned)(t + 1) * kstep;
            const unsigned a2 = last ? 0u : (unsigned)(t + 2) * kstep; const unsigned b2 = last ? nB : cB + (unsigned)(t + 2) * kstep;
            const unsigned a3 = a2 + kstep; const unsigned b3 = b2 + kstep;
            PG8_LDB(B0, 0, 0); PG8_LDB(B1, 0, 1); PG8_SCHED; PG8_LDA(At, 0, 0); PG8_STAGE(PG8_SA(1, 1), rsA, ao1, a1);
            if (last && has_next) { PG8_AOFF(nxt, ao0, ao1); }
            PG8_WAIT_V(8); PG8_WAIT_L(0); PG8_BAR; PG8_MMA(0, 0, At, B0); PG8_MMA(0, 1, At, B1); PG8_BAR; PG8_SCHED;
            PG8_LDA(At, 0, 1); PG8_STAGE(PG8_SB(0, 0), rsB, voffB, b2); PG8_STAGE(PG8_SB(0, 1), rsB, voffB, b2 + hstep); PG8_STAGE(PG8_SA(0, 0), rsA, ao0, a2);
            PG8_WAIT_V(8); PG8_WAIT_L(0); PG8_BAR; PG8_MMA(1, 0, At, B0); PG8_MMA(1, 1, At, B1); PG8_BAR; PG8_SCHED;
            PG8_LDB(B0, 1, 0); PG8_LDB(B1, 1, 1); PG8_SCHED; PG8_LDA(At, 1, 0); PG8_STAGE(PG8_SA(0, 1), rsA, ao1, a2);
            PG8_WAIT_V(8); PG8_WAIT_L(0); PG8_BAR; PG8_MMA(0, 0, At, B0); PG8_MMA(0, 1, At, B1); PG8_BAR; PG8_SCHED;
            PG8_LDA(At, 1, 1); PG8_STAGE(PG8_SB(1, 0), rsB, voffB, b3); PG8_STAGE(PG8_SB(1, 1), rsB, voffB, b3 + hstep); PG8_STAGE(PG8_SA(1, 0), rsA, ao0, a3);
            PG8_WAIT_V(8); PG8_WAIT_L(0); PG8_BAR; PG8_MMA(1, 0, At, B0); PG8_MMA(1, 1, At, B1); PG8_BAR; PG8_SCHED;
        }
        if (wr == 0) PG8_BAR;
        E(acc, cur, wr, wc, fr, fq);
        if (!has_next) break;
#pragma unroll
        for (int a = 0; a < 2; ++a)
#pragma unroll
            for (int b = 0; b < 2; ++b)
#pragma unroll
                for (int m = 0; m < 4; ++m)
#pragma unroll
                    for (int n = 0; n < 2; ++n) acc[a][b][m][n] = (f32x4){0.f, 0.f, 0.f, 0.f};
        cur = nxt; cB = nB; ++ui;
        if (wr == 1) PG8_BAR;
    }
    PG8_WAIT_V(0);
    PG8_BAR;
#undef PG8_AOFF
#undef PG8_SA
#undef PG8_SB
#undef PG8_STAGE
#undef PG8_LDA
#undef PG8_LD16A
#undef PG8_LD16B
#undef PG8_RA
#undef PG8_LDB
#undef PG8_MMA
#undef PG8_WAIT_V
#undef PG8_WAIT_L
#undef PG8_BAR
#undef PG8_SCHED
}
}

#define XB_TMO      128
#define XB_XCNT(j)  (256  + 64 * (j))
#define XB_XSUB(j)  (1280 + 64 * (j))
#define XB_XGEN(j)  (2304 + 64 * (j))
#define XB_TOP      3328
#define XB_TOPGEN   3392
#define XCD_BAR_WORDS 3456
#define XB_SPIN_CAP (1u << 18)
__device__ __forceinline__ unsigned xb_ld(unsigned* p)              { return __hip_atomic_load(p, __ATOMIC_RELAXED, __HIP_MEMORY_SCOPE_AGENT); }
__device__ __forceinline__ unsigned xb_add(unsigned* p, unsigned v) { return __hip_atomic_fetch_add(p, v, __ATOMIC_RELAXED, __HIP_MEMORY_SCOPE_AGENT); }
__device__ __forceinline__ unsigned xb_xcc_id() { return (unsigned)__builtin_amdgcn_s_getreg((3 << 11) | 20) & 0xFu; }
#define XB_SPIN(cond, bar) do { unsigned _sp = 0; while (cond) { __builtin_amdgcn_s_sleep(1); \
    if ((++_sp & 255u) == 0u) { if (xb_ld(&(bar)[XB_TMO])) break; if (_sp > XB_SPIN_CAP) { atomicAdd(&(bar)[XB_TMO], 1u); break; } } } } while (0)
struct XcdBarrier { unsigned* bar; unsigned x; volatile LAS unsigned* st; };
__device__ __forceinline__ XcdBarrier xcd_barrier_post(unsigned* bar, volatile LAS unsigned* st) {
    XcdBarrier b; b.bar = bar; b.x = xb_xcc_id(); b.st = st;
    if (threadIdx.x == 0) (void)xb_add(&bar[XB_XCNT(b.x)], 1u);
    return b;
}
__device__ __forceinline__ void xcd_barrier_complete(unsigned* bar, unsigned x, unsigned& nloc, unsigned& nx) {
    const unsigned G = gridDim.x * gridDim.y * gridDim.z;
    unsigned sum, cnt, mine, sp = 0u;
    for (;;) {
        sum = 0u; cnt = 0u; mine = 0u;
#pragma unroll
        for (unsigned j = 0; j < 16; ++j) { const unsigned c = xb_ld(&bar[XB_XCNT(j)]); sum += c; cnt += (c > 0u) ? 1u : 0u; mine = (j == x) ? c : mine; }
        if (sum == G) break;
        __builtin_amdgcn_s_sleep(1);
        if ((++sp & 255u) == 0u) { if (xb_ld(&bar[XB_TMO])) break; if (sp > XB_SPIN_CAP) { atomicAdd(&bar[XB_TMO], 1u); break; } }
    }
    nloc = mine > 0u ? mine : 1u; nx = cnt > 0u ? cnt : 1u;
}
__device__ __forceinline__ void xcd_barrier(const XcdBarrier& b) {
    asm volatile("s_waitcnt vmcnt(0)" ::: "memory");
    __syncthreads();
    if (threadIdx.x == 0) {
        unsigned* bar = b.bar;
        __builtin_amdgcn_s_waitcnt(0);
        unsigned nloc = b.st[0], nx = b.st[1];
        if (nloc == 0u) { xcd_barrier_complete(bar, b.x, nloc, nx); b.st[0] = nloc; b.st[1] = nx; }
        const unsigned old = xb_add(&bar[XB_XSUB(b.x)], 1u);
        const unsigned gen = old / nloc;
        if (old + 1u == (gen + 1u) * nloc) {
            __builtin_amdgcn_fence(__ATOMIC_RELEASE, "agent");
            asm volatile("s_waitcnt vmcnt(0)" ::: "memory");
            const unsigned og = xb_add(&bar[XB_TOP], 1u);
            const unsigned tg = og / nx;
            if (og + 1u == (tg + 1u) * nx) xb_add(&bar[XB_TOPGEN], 1u);
            else XB_SPIN(xb_ld(&bar[XB_TOPGEN]) == tg, bar);
            __builtin_amdgcn_fence(__ATOMIC_ACQUIRE, "agent");
            xb_add(&bar[XB_XGEN(b.x)], 1u);
            asm volatile("s_waitcnt vmcnt(0)" ::: "memory");
        } else {
            XB_SPIN(xb_ld(&bar[XB_XGEN(b.x)]) == gen, bar);
            __builtin_amdgcn_fence(__ATOMIC_ACQUIRE, "agent");
            asm volatile("s_waitcnt vmcnt(0)" ::: "memory");
        }
    }
    __syncthreads();
}

constexpr int RING_BYTES = 131072;
constexpr int ROW_OFF = RING_BYTES, TOK_UNITS = 18;
constexpr int TOK_OFF = ROW_OFF + TOK_UNITS * 1024;
constexpr int TBL_OFF = TOK_OFF + TOK_UNITS * 512;
constexpr int LDSCTL_OFF = TBL_OFF + 512;
constexpr int MK_LDS_BYTES = LDSCTL_OFF + 256;
static_assert(MK_LDS_BYTES <= 160 * 1024, "LDS map");

struct MArgs { const float* in[18]; float* out; unsigned char* ws; int ph_lo, ph_hi; };
struct Frame {
    LAS unsigned char* lds; int tid, lane, wave, vcu, G;
    unsigned char* ws; unsigned* ctl;
};
__device__ __forceinline__ unsigned pkb(float lo, float hi) { return pg8::cvt_pk_bf16(lo, hi); }

template <int MODE>
__device__ __forceinline__ void p0_transpose_item(const float* W, const float* g, int K, int N, bf16_t* WT, LAS float* scr, int item, int lane) {
    const int nblk = N / 32, kb = item / nblk, nb = item % nblk, k0 = 64 * kb, n0 = 32 * nb;
    float v[32];
#pragma unroll
    for (int i = 0; i < 32; ++i) { const int kk = 2 * i + (lane >> 5); v[i] = W[(size_t)(k0 + kk) * N + n0 + (lane & 31)]; }
    const float g0 = g ? g[k0 + lane] : 1.f;
#pragma unroll
    for (int i = 0; i < 32; ++i) { const int kk = 2 * i + (lane >> 5); const float gg = __shfl(g0, kk); scr[kk * 33 + (lane & 31)] = v[i] * gg; }
    asm volatile("s_waitcnt lgkmcnt(0)" ::: "memory");
    const int c = lane & 7;
#pragma unroll
    for (int j = 0; j < 4; ++j) { const int n = (lane >> 3) + 8 * j; const LAS float* s = scr + (8 * c) * 33 + n;
        u32x4 o; o.x = pkb(s[0 * 33], s[1 * 33]); o.y = pkb(s[2 * 33], s[3 * 33]); o.z = pkb(s[4 * 33], s[5 * 33]); o.w = pkb(s[6 * 33], s[7 * 33]);
        int nn = n0 + n;
        if (MODE == 1) { const int half = nn / FF, j2 = nn % FF; nn = (j2 >> 7) * 256 + half * 128 + (j2 & 127); }
        *(u32x4*)(WT + (size_t)nn * K + k0 + 8 * c) = o; }
    asm volatile("s_waitcnt lgkmcnt(0)" ::: "memory");
}
template <int MODE>
__device__ __forceinline__ void p0_transpose_item8(const float* W, const float* g, int K, int N, unsigned char* WT, LAS float* scr, int item, int lane, float scale) {
    const int nblk = N / 32, kb = item / nblk, nb = item % nblk, k0 = 64 * kb, n0 = 32 * nb;
    float v[32];
#pragma unroll
    for (int i = 0; i < 32; ++i) { const int kk = 2 * i + (lane >> 5); v[i] = W[(size_t)(k0 + kk) * N + n0 + (lane & 31)]; }
    const float g0 = (g ? g[k0 + lane] : 1.f) * scale;
#pragma unroll
    for (int i = 0; i < 32; ++i) { const int kk = 2 * i + (lane >> 5); const float gg = __shfl(g0, kk); scr[kk * 33 + (lane & 31)] = v[i] * gg; }
    asm volatile("s_waitcnt lgkmcnt(0)" ::: "memory");
#pragma unroll
    for (int j = 0; j < 2; ++j) { const int id = lane + 64 * j, n = id >> 2, c = id & 3; const LAS float* s = scr + (16 * c) * 33 + n; unsigned p[4];
#pragma unroll
        for (int q = 0; q < 4; ++q) { unsigned w = 0u; w = __builtin_amdgcn_cvt_pk_fp8_f32(s[(4 * q + 0) * 33], s[(4 * q + 1) * 33], w, false); w = __builtin_amdgcn_cvt_pk_fp8_f32(s[(4 * q + 2) * 33], s[(4 * q + 3) * 33], w, true); p[q] = w; }
        int nn = n0 + n;
        if (MODE == 1) { const int half = nn / FF, j2 = nn % FF; nn = (j2 >> 7) * 256 + half * 128 + (j2 & 127); }
        *(u32x4*)(WT + (size_t)nn * K + k0 + 16 * c) = (u32x4){p[0], p[1], p[2], p[3]}; }
    asm volatile("s_waitcnt lgkmcnt(0)" ::: "memory");
}
__device__ __forceinline__ void p0_prologue(Frame& F, const MArgs& args) {
    LAS float* scr = (LAS float*)(F.lds + F.wave * 16384);
    const int gw = F.vcu * MK_WAVES + F.wave, NGW = F.G * MK_WAVES, lane = F.lane;
    unsigned char* ws = F.ws;
    {
        const float* x = args.in[0]; bf16_t* HB = (bf16_t*)(ws + WS_HB); float* SS = (float*)(ws + WS_SS);
        for (int row = gw; row < NTOK; row += NGW) {
            const f32x4* p = (const f32x4*)(x + (size_t)row * DM) + lane; f32x4 v[4]; float s = 0.f;
#pragma unroll
            for (int j = 0; j < 4; ++j) { v[j] = p[64 * j]; s += v[j].x * v[j].x + v[j].y * v[j].y + v[j].z * v[j].z + v[j].w * v[j].w; }
            s = wave_sum(s);
            if (lane < 16) SS[(size_t)row * 16 + lane] = (lane == 0) ? s : 0.f;
            u32x2* o = (u32x2*)(HB + (size_t)row * DM) + lane;
#pragma unroll
            for (int j = 0; j < 4; ++j) { u32x2 w; w.x = pkb(v[j].x, v[j].y); w.y = pkb(v[j].z, v[j].w); o[64 * j] = w; }
        }
        const float* pp = args.in[1]; bf16_t* PB = (bf16_t*)(ws + WS_PB);
        const size_t n4 = (size_t)DEPTH * NTOK * PLE / 4;
        for (size_t i = (size_t)gw * 64 + lane; i < n4; i += (size_t)NGW * 64) { const f32x4 v = ((const f32x4*)pp)[i]; u32x2 w; w.x = pkb(v.x, v.y); w.y = pkb(v.z, v.w); ((u32x2*)PB)[i] = w; }
    }
    constexpr int I_QKV = (DM / 64) * (3 * DM / 32), I_SQ = (DM / 64) * (DM / 32), I_WP = (PLE / 64) * (DM / 32), I_GU = (DM / 64) * (2 * FF / 32), I_WD = (FF / 64) * (DM / 32), I_WR = (DM / 64) * (NE / 32);
    constexpr int PER_LAYER = I_QKV + 2 * I_SQ + I_WP + NE * I_GU + NE * I_WD + I_WR;
    const float* g_mix = args.in[2]; const float* w_qkv = args.in[3]; const float* w_fgate = args.in[4]; const float* w_o = args.in[6]; const float* g_moe = args.in[7]; const float* w_router = args.in[8];
    const float* w_gu = args.in[10]; const float* w_down = args.in[12]; const float* g_ple = args.in[14]; const float* w_ple_gate = args.in[15]; const float* w_ple_proj = args.in[16];
    for (int it = gw; it < DEPTH * PER_LAYER; it += NGW) {
        const int L = it / PER_LAYER; int r = it - L * PER_LAYER;
        if (r < I_QKV) { p0_transpose_item<0>(w_qkv + (size_t)L * DM * 3 * DM, g_mix + L * DM, DM, 3 * DM, (bf16_t*)(ws + WS_WQKV) + (size_t)L * 3 * DM * DM, scr, r, lane); continue; } r -= I_QKV;
        if (r < I_SQ) { p0_transpose_item<0>(w_o + (size_t)L * DM * DM, nullptr, DM, DM, (bf16_t*)(ws + WS_WO) + (size_t)L * DM * DM, scr, r, lane); continue; } r -= I_SQ;
        if (r < I_SQ) { p0_transpose_item<0>(w_ple_gate + (size_t)L * DM * DM, g_ple + L * DM, DM, DM, (bf16_t*)(ws + WS_WG) + (size_t)L * DM * DM, scr, r, lane); continue; } r -= I_SQ;
        if (r < I_WP) { p0_transpose_item<0>(w_ple_proj + (size_t)L * PLE * DM, nullptr, PLE, DM, (bf16_t*)(ws + WS_WP) + (size_t)L * DM * PLE, scr, r, lane); continue; } r -= I_WP;
        if (r < I_WR) { p0_transpose_item<0>(w_router + (size_t)L * DM * NE, g_moe + L * DM, DM, NE, (bf16_t*)(ws + WS_WR) + (size_t)L * NE * DM, scr, r, lane); continue; } r -= I_WR;
        const bool f8 = (MK_FP8_MASK >> L) & 1;
        if (r < NE * I_GU) { const int e = r / I_GU;
            if (f8) p0_transpose_item8<1>(w_gu + ((size_t)L * NE + e) * DM * 2 * FF, g_moe + L * DM, DM, 2 * FF, ws + WS_WGU8 + ((size_t)L * NE + e) * 2 * FF * DM, scr, r - e * I_GU, lane, W8SCALE);
            else p0_transpose_item<1>(w_gu + ((size_t)L * NE + e) * DM * 2 * FF, g_moe + L * DM, DM, 2 * FF, (bf16_t*)(ws + WS_WGU) + ((size_t)L * NE + e) * 2 * FF * DM, scr, r - e * I_GU, lane); continue; } r -= NE * I_GU;
        { const int e = r / I_WD;
            if (f8) p0_transpose_item8<0>(w_down + ((size_t)L * NE + e) * FF * DM, nullptr, FF, DM, ws + WS_WD8 + ((size_t)L * NE + e) * DM * FF, scr, r - e * I_WD, lane, W8SCALE);
            else p0_transpose_item<0>(w_down + ((size_t)L * NE + e) * FF * DM, nullptr, FF, DM, (bf16_t*)(ws + WS_WD) + ((size_t)L * NE + e) * DM * FF, scr, r - e * I_WD, lane); }
    }
    if (gw < 256) { bf16_t* WF = (bf16_t*)(ws + WS_WF); const int idx = gw * 64 + lane; const int n = idx >> 10, k = idx & 1023; WF[idx] = (bf16_t)f2bf(w_fgate[(size_t)k * NH + n] * g_mix[DM + k]); }
}

__device__ __forceinline__ void moe_tables(Frame& F, const unsigned* cnt) {
    LAS int* tstartL = (LAS int*)(F.lds + TBL_OFF); LAS int* cntL = tstartL + 64;
    if (F.wave == 0) {
        const int lane = F.lane; const int c = (lane < NE) ? (int)__hip_atomic_load(cnt + CNT_STRIDE * (lane & 31), __ATOMIC_RELAXED, __HIP_MEMORY_SCOPE_AGENT) : 0; const int nt = (c + 255) >> 8; int incl = nt;
#pragma unroll
        for (int o = 1; o < 32; o <<= 1) { const int t = __shfl_up(incl, o); if ((lane & 31) >= o) incl += t; }
        if (lane < NE) { tstartL[lane] = incl - nt; cntL[lane] = c; if (lane == NE - 1) tstartL[NE] = incl; }
    }
    __syncthreads();
}
__device__ __forceinline__ void router_phase(Frame& F, const bf16_t* HB, const bf16_t* WR, const float* br, float* rstd, unsigned* cnt, int* tok_of, float* gate_of, unsigned* pair) {
    const int gw = F.vcu * MK_WAVES + F.wave, NGW = F.G * MK_WAVES, lane = F.lane, r = lane & 15, quad = lane >> 4;
    LAS unsigned* hist = (LAS unsigned*)(F.lds); LAS unsigned* gbase = hist + 32;
    for (int it = 0; it * NGW < NTOK / 16; ++it) {
        const int blk = it * NGW + gw; const bool valid = blk < NTOK / 16;
        if (F.tid < 32) hist[F.tid] = 0u;
        __syncthreads();
        int see[4]; unsigned slr[4]; float sgt[4];
        const int t0 = blk * 16;
        if (valid) {
            const bf16_t* ap = HB + (size_t)(t0 + r) * DM + quad * 8; const bf16_t* bp0 = WR + (size_t)r * DM + quad * 8; const bf16_t* bp1 = bp0 + (size_t)16 * DM;
            f32x4 acc0 = {0.f, 0.f, 0.f, 0.f}, acc1 = {0.f, 0.f, 0.f, 0.f}; float ssq = 0.f;
#pragma unroll 8
            for (int ks = 0; ks < 32; ++ks) { const bf16x8 a = *(const bf16x8*)(ap + 32 * ks), b0 = *(const bf16x8*)(bp0 + 32 * ks), b1 = *(const bf16x8*)(bp1 + 32 * ks);
                acc0 = __builtin_amdgcn_mfma_f32_16x16x32_bf16(a, b0, acc0, 0, 0, 0); acc1 = __builtin_amdgcn_mfma_f32_16x16x32_bf16(a, b1, acc1, 0, 0, 0);
#pragma unroll
                for (int j = 0; j < 8; ++j) { const float f = __uint_as_float(((unsigned)(unsigned short)a[j]) << 16); ssq += f * f; } }
            ssq += __shfl_xor(ssq, 16); ssq += __shfl_xor(ssq, 32);
            const float rs_r = rsqrtf(ssq * (1.f / DM) + EPS);
            const float b_lo = br[r], b_hi = br[16 + r];
#pragma unroll
            for (int j = 0; j < 4; ++j) {
                const float rsj = __shfl(rs_r, quad * 4 + j); const int t = t0 + quad * 4 + j;
                float v0 = acc0[j] * rsj + b_lo, v1 = acc1[j] * rsj + b_hi; float tv[4]; int ti[4];
#pragma unroll
                for (int k = 0; k < 4; ++k) {
                    float bv = (v0 >= v1) ? v0 : v1; int bi = (v0 >= v1) ? r : 16 + r;
#pragma unroll
                    for (int o = 1; o < 16; o <<= 1) { const float ov = __shfl_xor(bv, o); const int oi = __shfl_xor(bi, o); if (ov > bv || (ov == bv && oi < bi)) { bv = ov; bi = oi; } }
                    tv[k] = bv; ti[k] = bi; if (bi == r) v0 = -INFINITY; if (bi == 16 + r) v1 = -INFINITY;
                }
                float w[4], sw = 0.f;
#pragma unroll
                for (int k = 0; k < 4; ++k) { w[k] = __expf(tv[k] - tv[0]); sw += w[k]; }
                const int ee = (r == 0) ? ti[0] : (r == 1) ? ti[1] : (r == 2) ? ti[2] : ti[3]; const float ww = (r == 0) ? w[0] : (r == 1) ? w[1] : (r == 2) ? w[2] : w[3];
                see[j] = ee; sgt[j] = ww / sw; slr[j] = 0u;
                if (r < 4) slr[j] = __hip_atomic_fetch_add(hist + ee, 1u, __ATOMIC_RELAXED, __HIP_MEMORY_SCOPE_WORKGROUP);
                if (r == 4) rstd[t] = rsj;
            }
        }
        __syncthreads();
        if (F.tid < 32) { const unsigned n = hist[F.tid]; gbase[F.tid] = n ? __hip_atomic_fetch_add(cnt + CNT_STRIDE * F.tid, n, __ATOMIC_RELAXED, __HIP_MEMORY_SCOPE_AGENT) : 0u; }
        __syncthreads();
        if (valid && r < 4) {
#pragma unroll
            for (int j = 0; j < 4; ++j) { const int t = t0 + quad * 4 + j; const int ee = see[j]; const unsigned rk = gbase[ee] + slr[j];
                tok_of[(size_t)ee * CAP + rk] = t; gate_of[(size_t)ee * CAP + rk] = sgt[j]; pair[(size_t)t * 4 + r] = ((unsigned)ee << 16) | rk; }
        }
        __syncthreads();
    }
}
__device__ __forceinline__ void fgate_phase(Frame& F, const bf16_t* HB, const bf16_t* WF, const float* bfg, const float* SS, float* FL) {
    const int gw = F.vcu * MK_WAVES + F.wave, NGW = F.G * MK_WAVES, lane = F.lane, r = lane & 15, quad = lane >> 4;
    for (int blk = gw; blk < NTOK / 16; blk += NGW) {
        const int t0 = blk * 16;
        const bf16_t* ap = HB + (size_t)(t0 + r) * DM + quad * 8; const bf16_t* bp0 = WF + (size_t)r * DM + quad * 8;
        f32x4 acc0 = {0.f, 0.f, 0.f, 0.f};
#pragma unroll 8
        for (int ks = 0; ks < 32; ++ks) { const bf16x8 a = *(const bf16x8*)(ap + 32 * ks), b0 = *(const bf16x8*)(bp0 + 32 * ks); acc0 = __builtin_amdgcn_mfma_f32_16x16x32_bf16(a, b0, acc0, 0, 0, 0); }
        const f32x4 sp = *(const f32x4*)(SS + (size_t)(t0 + r) * 16 + quad * 4); float ss = (sp.x + sp.y) + (sp.z + sp.w); ss += __shfl_xor(ss, 16); ss += __shfl_xor(ss, 32);
        const float rs_r = rsqrtf(ss * (1.f / DM) + EPS); const float bb = bfg[r];
#pragma unroll
        for (int j = 0; j < 4; ++j) { const float rsj = __shfl(rs_r, quad * 4 + j); FL[(size_t)(t0 + quad * 4 + j) * NH + r] = acc0[j] * rsj + bb; }
    }
}
__device__ __forceinline__ void combine_phase(Frame& F, const bf16_t* hin, bf16_t* hout, float* rstd, const unsigned* pair, const bf16_t* Y) {
    const int gw = F.vcu * MK_WAVES + F.wave, NGW = F.G * MK_WAVES, lane = F.lane; const LAS int* tstartL = (const LAS int*)(F.lds + TBL_OFF);
    for (int t = gw; t < NTOK; t += NGW) {
        f32x4 v[4]; const u32x2* hr = (const u32x2*)(hin + (size_t)t * DM) + lane;
        const u32x4 pr4 = *(const u32x4*)(pair + (size_t)t * 4);
#pragma unroll
        for (int j = 0; j < 4; ++j) { const u32x2 w = hr[64 * j]; v[j].x = __uint_as_float(w.x << 16); v[j].y = __uint_as_float(w.x & 0xffff0000u); v[j].z = __uint_as_float(w.y << 16); v[j].w = __uint_as_float(w.y & 0xffff0000u); }
#pragma unroll
        for (int k = 0; k < 4; ++k) {
            const unsigned pr = (k == 0) ? pr4.x : (k == 1) ? pr4.y : (k == 2) ? pr4.z : pr4.w; const int e = __builtin_amdgcn_readfirstlane((int)(pr >> 16)), rk = __builtin_amdgcn_readfirstlane((int)(pr & 0xffffu));
            const size_t slot = (size_t)tstartL[e] * 256 + rk; const u32x2* yr = (const u32x2*)(Y + slot * DM) + lane;
#pragma unroll
            for (int j = 0; j < 4; ++j) { const u32x2 w = yr[64 * j]; v[j].x += __uint_as_float(w.x << 16); v[j].y += __uint_as_float(w.x & 0xffff0000u); v[j].z += __uint_as_float(w.y << 16); v[j].w += __uint_as_float(w.y & 0xffff0000u); }
        }
        float s = 0.f; u32x2* o = (u32x2*)(hout + (size_t)t * DM) + lane;
#pragma unroll
        for (int j = 0; j < 4; ++j) { u32x2 w; w.x = pkb(v[j].x, v[j].y); w.y = pkb(v[j].z, v[j].w); o[64 * j] = w;
            const float q0 = __uint_as_float(w.x << 16), q1 = __uint_as_float(w.x & 0xffff0000u), q2 = __uint_as_float(w.y << 16), q3 = __uint_as_float(w.y & 0xffff0000u); s += (q0 * q0 + q1 * q1) + (q2 * q2 + q3 * q3); }
        s = wave_sum(s); if (lane == 0) rstd[t] = rsqrtf(s * (1.f / DM) + EPS);
    }
}
__device__ __forceinline__ void final_phase(Frame& F, const bf16_t* hb, const float* SS, const float* g, float* out) {
    const int gw = F.vcu * MK_WAVES + F.wave, NGW = F.G * MK_WAVES, lane = F.lane;
    f32x4 gg[4];
#pragma unroll
    for (int j = 0; j < 4; ++j) gg[j] = ((const f32x4*)g)[lane + 64 * j];
    for (int row = gw; row < NTOK; row += NGW) {
        const u32x2* p = (const u32x2*)(hb + (size_t)row * DM) + lane; u32x2 w[4];
#pragma unroll
        for (int j = 0; j < 4; ++j) w[j] = p[64 * j];
        float ss = (lane < 16) ? SS[(size_t)row * 16 + lane] : 0.f; ss = wave_sum(ss);
        const float rs = rsqrtf(ss * (1.f / DM) + EPS);
        f32x4* o = (f32x4*)(out + (size_t)row * DM) + lane;
#pragma unroll
        for (int j = 0; j < 4; ++j) { f32x4 v; v.x = __uint_as_float(w[j].x << 16); v.y = __uint_as_float(w[j].x & 0xffff0000u); v.z = __uint_as_float(w[j].y << 16); v.w = __uint_as_float(w[j].y & 0xffff0000u); o[64 * j] = v * rs * gg[j]; }
    }
}
__device__ __forceinline__ void attn_sb_head(Frame& F, int bh, const bf16_t* Q, const bf16_t* K, const bf16_t* V, bf16_t* O) {
    const int lane = F.lane, b = bh / NH, hh = bh % NH; const size_t rowb = (size_t)b * SEQ;
    for (int t = F.wave; t < SEQ; t += MK_WAVES) {
        float q[64]; loadq(q, Q + (rowb + t) * DM + hh * HD);
        float o = 0.f, carry = 1.f;
        for (int jt = (t - 1) >> 6; jt >= 0 && t > 0; --jt) {
            const int s = 64 * jt + lane; const bool valid = s < t;
            float x = dot64(q, K + (rowb + s) * DM + hh * HD); x = fminf(x, 64.f);
            const float ex = exp2f(x), r = 1.f / (1.f + ex);
            const float beta = valid ? ex * r : 0.f, nb = valid ? r : 1.f;
            float P = nb;
#pragma unroll
            for (int off = 1; off < 64; off <<= 1) { const float t2 = __shfl_down(P, off); if (lane + off < 64) P *= t2; }
            float Pex = __shfl_down(P, 1); if (lane == 63) Pex = 1.f;
            const float a = beta * carry * Pex;
            carry *= __shfl(P, 0);
            const bf16_t* vb = V + (rowb + 64 * jt) * DM + hh * HD + lane;
            for (int l = 0; l < 64; ++l) { const float al = __shfl(a, l); o += al * bf2f(vb[(size_t)l * DM]); }
            if (carry < 1e-30f) break;
        }
        O[(rowb + t) * DM + hh * HD + lane] = (bf16_t)f2bf(o);
    }
}
__device__ __forceinline__ void attn_fox_head(Frame& F, int bh, const bf16_t* Q, const bf16_t* K, const bf16_t* V, const float* FL, bf16_t* O) {
    const int lane = F.lane, b = bh / NH, hh = bh % NH; const size_t rowb = (size_t)b * SEQ;
    LAS float* cbL = (LAS float*)(F.lds); LAS float* wtot = (LAS float*)(F.lds + 8192);
    {
        float loc[4]; float run = 0.f;
#pragma unroll
        for (int i = 0; i < 4; ++i) { run += log_sigmoid(FL[(size_t)(rowb + F.tid * 4 + i) * NH + hh]); loc[i] = run; }
        float incl = run;
#pragma unroll
        for (int o = 1; o < 64; o <<= 1) { const float t = __shfl_up(incl, o); if (lane >= o) incl += t; }
        if (lane == 63) wtot[F.wave] = incl;
        __syncthreads();
        float base = incl - run;
        for (int w = 0; w < F.wave; ++w) base += wtot[w];
#pragma unroll
        for (int i = 0; i < 4; ++i) cbL[F.tid * 4 + i] = (base + loc[i]) * LOG2E;
        __syncthreads();
    }
    for (int t = F.wave; t < SEQ; t += MK_WAVES) {
        float q[64]; loadq(q, Q + (rowb + t) * DM + hh * HD);
        float o = 0.f, m = -INFINITY, l = 0.f;
        for (int jt = 0; jt <= (t >> 6); ++jt) {
            const int s = 64 * jt + lane; const bool valid = s <= t;
            float x = dot64(q, K + (rowb + s) * DM + hh * HD) - cbL[s];
            x = valid ? x : -INFINITY;
            const float mn = fmaxf(m, wave_max(x)); const float alpha = exp2f(m - mn); const float p = exp2f(x - mn);
            l = l * alpha + wave_sum(p); o *= alpha; m = mn;
            const bf16_t* vb = V + (rowb + 64 * jt) * DM + hh * HD + lane;
            const int nl = min(64, t - 64 * jt + 1);
            for (int i = 0; i < nl; ++i) { const float pi = __shfl(p, i); o += pi * bf2f(vb[(size_t)i * DM]); }
        }
        O[(rowb + t) * DM + hh * HD + lane] = (bf16_t)f2bf(o / l);
    }
    __syncthreads();
}

__device__ __forceinline__ void fox_head(Frame& F, unsigned char* lds_generic, int bh, const bf16_t* Q, const bf16_t* K, const bf16_t* V, const float* FL, bf16_t* O) {
    int tid_ = threadIdx.x; asm volatile("" : "+v"(tid_));
    const int lane = tid_ & 63, b = bh / NH, hh = bh % NH; const size_t rowb = (size_t)b * SEQ;
    LAS float* cbL = (LAS float*)(F.lds + attn_body::ATTN_LDS_BYTES); LAS float* wtot = cbL + SEQ;
    {
        float loc[4]; float run = 0.f;
#pragma unroll
        for (int i = 0; i < 4; ++i) { run += log_sigmoid(FL[(size_t)(rowb + tid_ * 4 + i) * NH + hh]); loc[i] = run; }
        float incl = run;
#pragma unroll
        for (int o = 1; o < 64; o <<= 1) { const float t = __shfl_up(incl, o); if (lane >= o) incl += t; }
        if (lane == 63) wtot[F.wave] = incl;
        __syncthreads();
        float base = incl - run;
        for (int w = 0; w < F.wave; ++w) base += wtot[w];
#pragma unroll
        for (int i = 0; i < 4; ++i) cbL[tid_ * 4 + i] = (base + loc[i]) * LOG2E;
        __syncthreads();
    }
    for (int qb = 0; qb < SEQ / 256; ++qb)
        attn_body::attn_unit<8>(b, hh, qb, (const attn_body::bf16*)Q, (const attn_body::bf16*)K, (const attn_body::bf16*)V, (attn_body::bf16*)O, (char*)lds_generic, cbL);
}
constexpr int N_PHASES = 18;
__global__ void __launch_bounds__(MK_WAVES * 64, 2) mega_fwd(MArgs args) {
    extern __shared__ __attribute__((aligned(16))) unsigned char lds_raw[];
    Frame F;
    F.lds = (LAS unsigned char*)lds_raw;
    F.tid = threadIdx.x; F.lane = F.tid & 63; F.wave = __builtin_amdgcn_readfirstlane(F.tid >> 6);
    F.G = gridDim.x; { const int bx = blockIdx.x; F.vcu = (F.G % 8 == 0) ? (bx % 8) * (F.G / 8) + bx / 8 : bx; }
    F.ws = args.ws; F.ctl = (unsigned*)(args.ws + WS_CTL);
    unsigned char* ws = args.ws;
    for (int u = F.tid; u < (MK_LDS_BYTES - LDSCTL_OFF) / 4; u += MK_WAVES * 64) ((LAS unsigned*)(F.lds + LDSCTL_OFF))[u] = 0u;
    __syncthreads();
    const int lo = args.ph_lo, hi = args.ph_hi;
    const bool use_bar = (hi - lo) > 1;
    XcdBarrier bar; bar.bar = F.ctl + CW_BAR; bar.x = 0; bar.st = nullptr;
    if (use_bar) bar = xcd_barrier_post(F.ctl + CW_BAR, (volatile LAS unsigned*)(F.lds + LDSCTL_OFF + 32));
#ifndef MK_DUP
#define MK_DUP 0
#endif
#define NREP(j) (((MK_DUP >> (j)) & 1) ? 2 : 1)
#ifndef MK_ATTSUB
#define MK_ATTSUB 3
#endif
#ifndef MK_P0SUB
#define MK_P0SUB 7
#endif
#ifndef MK_PHMASK
#define MK_PHMASK 0x3ff
#endif
#define IN(k) (lo <= (k) && (k) < hi)
#define EN(j) ((MK_PHMASK >> (j)) & 1)
#define PHASE_BEGIN() do { int t_ = threadIdx.x; asm volatile("" : "+v"(t_)); F.tid = t_; F.lane = t_ & 63; } while (0)
#define SEAM(k) do { if (IN(k) && IN((k) + 1)) xcd_barrier(bar); } while (0)
    bf16_t* const HB0 = (bf16_t*)(ws + WS_HB); bf16_t* const HB1 = (bf16_t*)(ws + WS_HB2); float* const SS = (float*)(ws + WS_SS);
    bf16_t* const Qb = (bf16_t*)(ws + WS_Q); bf16_t* const Kb = (bf16_t*)(ws + WS_K); bf16_t* const Vb = (bf16_t*)(ws + WS_V); bf16_t* const Ob = (bf16_t*)(ws + WS_O);
    float* const rstd_moe = (float*)(ws + WS_RSTD) + NTOK; float* const rstd_ple = rstd_moe + NTOK;
    int* const tok_of = (int*)(ws + WS_TOK); float* const gate_of = (float*)(ws + WS_GATE); unsigned* const pair = (unsigned*)(ws + WS_PAIR);
    bf16_t* const ACT = (bf16_t*)(ws + WS_ACT); bf16_t* const Yb = (bf16_t*)(ws + WS_Y); float* const FL = (float*)(ws + WS_FL);
    LAS int* const tstartL = (LAS int*)(F.lds + TBL_OFF); LAS int* const cntL = tstartL + 64; LAS unsigned short* const tokL = (LAS unsigned short*)(F.lds + TOK_OFF); LAS float* const rowL = (LAS float*)(F.lds + ROW_OFF);

    if (EN(8) && IN(0)) { for (int rep_ = 0; rep_ < NREP(8); ++rep_) p0_prologue(F, args); }
    SEAM(0);
    for (int L = 0; L < DEPTH; ++L) {
        const int pb = 1 + 8 * L;
        unsigned* const cnt = F.ctl + CW_CNT2 + 2048 * L;
        const bool f8 = (L == 0) ? bool(MK_FP8_MASK & 1) : bool(MK_FP8_MASK & 2);
        bf16_t* const HBa = (L & 1) ? HB1 : HB0; bf16_t* const HBb = (L & 1) ? HB0 : HB1;
        if (EN(0) && IN(pb + 0)) for (int rep_ = 0; rep_ < NREP(0); ++rep_) { PHASE_BEGIN();
            if (MK_P0SUB & 1) if (L == 1) fgate_phase(F, HBa, (const bf16_t*)(ws + WS_WF), args.in[5], SS, FL);
            if (MK_P0SUB & 2) { pg8::DenseOrder S; S.init(NTOK, 3 * DM, F.G, (int)blockIdx.x); pg8::EpiQKV E{Qb, rowL};
              _Pragma("clang loop unroll(disable)") for (int i0 = 0; i0 < TOK_UNITS; i0 += 2) { const int i = i0 + (F.wave >> 2); pg8::Unit u; if (S.next(i, u)) { const int lr = F.tid & 255; const f32x4* sp = (const f32x4*)(SS + (size_t)(u.arow0 + lr) * 16);
                  const f32x4 s0 = sp[0], s1 = sp[1], s2 = sp[2], s3 = sp[3]; const float ss = ((s0.x + s0.y) + (s0.z + s0.w)) + ((s1.x + s1.y) + (s1.z + s1.w)) + ((s2.x + s2.y) + (s2.z + s2.w)) + ((s3.x + s3.y) + (s3.z + s3.w));
                  rowL[i * 256 + lr] = rsqrtf(ss * (1.f / DM) + EPS); } }
              __syncthreads();
              pg8::gemm_phase(F.lds, HBa, (const bf16_t*)(ws + WS_WQKV) + (size_t)L * 3 * DM * DM, 2 * DM, S, E); }
            if (MK_P0SUB & 4) if (L == 0) { pg8::PJOrder S; S.init(F.G, (int)blockIdx.x); pg8::EpiPJ E{(bf16_t*)(ws + WS_PJ)};
                pg8::gemm_phase(F.lds, (const bf16_t*)(ws + WS_PB), (const bf16_t*)(ws + WS_WP), 2 * PLE, S, E); }
        }
        SEAM(pb + 0);
        if (EN(1) && IN(pb + 1)) for (int rep_ = 0; rep_ < (NREP(1) > 1 ? 2 : (L == 0 ? NREP(10) : NREP(11))); ++rep_) { PHASE_BEGIN();
#if defined(MK_SIMPLE_ATTN)
            for (int bh = blockIdx.x; bh < NB * NH; bh += F.G) { if (L == 0) attn_sb_head(F, bh, Qb, Kb, Vb, Ob); else attn_fox_head(F, bh, Qb, Kb, Vb, FL, Ob); }
#else
            if (L == 0) { if (MK_ATTSUB & 1) for (int bh = blockIdx.x; bh < NB * NH; bh += F.G) sb_body::sb_head(F.lds, F.lane, F.wave, bh, Qb, Kb, Vb, Ob); }
            else { if (MK_ATTSUB & 2) for (int bh = blockIdx.x; bh < NB * NH; bh += F.G) { fox_head(F, lds_raw, bh, Qb, Kb, Vb, FL, Ob); __syncthreads(); } }
#endif
        }
        SEAM(pb + 1);
        if (EN(2) && IN(pb + 2)) for (int rep_ = NREP(2) - 1; rep_ >= 0; --rep_) { PHASE_BEGIN();
            pg8::DenseOrder S; S.init(NTOK, DM, F.G, (int)blockIdx.x); pg8::EpiWo E{HBa, rep_ ? (bf16_t*)(ws + WS_ACT + 128 * MiB) : HBb, f8 ? (rep_ ? ws + WS_ACT + 210 * MiB : ws + WS_HB8) : nullptr};
            pg8::gemm_phase(F.lds, Ob, (const bf16_t*)(ws + WS_WO) + (size_t)L * DM * DM, 2 * DM, S, E);
        }
        SEAM(pb + 2);
        if (EN(3) && IN(pb + 3)) for (int rep_ = NREP(3) - 1; rep_ >= 0; --rep_) { PHASE_BEGIN(); unsigned char* dd = ws + WS_ACT + 192 * MiB;
            if (rep_) router_phase(F, HBb, (const bf16_t*)(ws + WS_WR) + (size_t)L * NE * DM, args.in[9] + L * NE, (float*)(dd + 9 * MiB), F.ctl + CW_CNT2 + 4096 + 2048 * L, (int*)dd, (float*)(dd + 4 * MiB), (unsigned*)(dd + 8 * MiB));
            else router_phase(F, HBb, (const bf16_t*)(ws + WS_WR) + (size_t)L * NE * DM, args.in[9] + L * NE, rstd_moe, cnt, tok_of, gate_of, pair); }
        SEAM(pb + 3);
        if (EN(4) && IN(pb + 4)) for (int rep_ = 0; rep_ < NREP(4); ++rep_) { PHASE_BEGIN();
            moe_tables(F, cnt);
            pg8::MoeOrder S; S.NN = 8; S.nwg = tstartL[NE] * 8; S.G = F.G; S.c = (int)blockIdx.x; S.tstartL = tstartL; S.cntL = cntL; S.tokL = tokL; S.gather = true;
            _Pragma("clang loop unroll(disable)") for (int i0 = 0; i0 < TOK_UNITS; i0 += 2) { const int i = i0 + (F.wave >> 2); pg8::Unit u;
                if (S.next(i, u)) { const int lr = F.tid & 255; const int rk = u.rank0 + lr; const int tok = tok_of[(size_t)u.e * CAP + (rk < u.cnt ? rk : u.rank0)]; tokL[i * 256 + lr] = (unsigned short)tok; rowL[i * 256 + lr] = rstd_moe[tok] * (f8 ? W8INV : 1.f); } }
            __syncthreads();
            if (f8) { pg8::EpiGU<true> E{ws + WS_ACT8, args.in[11] + (size_t)L * NE * 2 * FF, rowL};
                pg8::gemm_phase<pg8::EpiGU<true>, pg8::MoeOrder, true>(F.lds, ws + WS_HB8, ws + WS_WGU8 + (size_t)L * NE * 2 * FF * DM, DM, S, E); }
            else { pg8::EpiGU<false> E{ACT, args.in[11] + (size_t)L * NE * 2 * FF, rowL};
                pg8::gemm_phase(F.lds, HBb, (const bf16_t*)(ws + WS_WGU) + (size_t)L * NE * 2 * FF * DM, 2 * DM, S, E); }
        }
        SEAM(pb + 4);
        if (EN(5) && IN(pb + 5)) for (int rep_ = 0; rep_ < NREP(5); ++rep_) { PHASE_BEGIN();
            moe_tables(F, cnt);
            pg8::MoeOrder S; S.NN = 4; S.nwg = tstartL[NE] * 4; S.G = F.G; S.c = (int)blockIdx.x; S.tstartL = tstartL; S.cntL = cntL; S.tokL = tokL; S.gather = false;
            _Pragma("clang loop unroll(disable)") for (int i0 = 0; i0 < TOK_UNITS; i0 += 2) { const int i = i0 + (F.wave >> 2); pg8::Unit u;
                if (S.next(i, u)) { const int lr = F.tid & 255; const int rk = u.rank0 + lr; rowL[i * 256 + lr] = (rk < u.cnt) ? gate_of[(size_t)u.e * CAP + rk] * (f8 ? W8INV : 1.f) : 0.f; } }
            __syncthreads();
            pg8::EpiDown E{Yb, args.in[13] + (size_t)L * NE * DM, rowL, f8 ? W8SCALE : 1.f};
            if (f8) pg8::gemm_phase<pg8::EpiDown, pg8::MoeOrder, true>(F.lds, ws + WS_ACT8, ws + WS_WD8 + (size_t)L * NE * DM * FF, FF, S, E);
            else pg8::gemm_phase(F.lds, ACT, (const bf16_t*)(ws + WS_WD) + (size_t)L * NE * DM * FF, 2 * FF, S, E);
        }
        SEAM(pb + 5);
        if (EN(6) && IN(pb + 6)) for (int rep_ = NREP(6) - 1; rep_ >= 0; --rep_) { PHASE_BEGIN(); moe_tables(F, cnt);
            if (rep_) combine_phase(F, HBb, (bf16_t*)(ws + WS_ACT + 128 * MiB), (float*)(ws + WS_ACT + 201 * MiB), pair, Yb);
            else combine_phase(F, HBb, HBa, rstd_ple, pair, Yb); }
        SEAM(pb + 6);
        if (EN(7) && IN(pb + 7)) for (int rep_ = NREP(7) - 1; rep_ >= 0; --rep_) { PHASE_BEGIN();
            pg8::DenseOrder S; S.init(NTOK, DM, F.G, (int)blockIdx.x);
            pg8::EpiPLE E{HBa, rep_ ? (bf16_t*)(ws + WS_ACT + 128 * MiB) : HBb, (const bf16_t*)(ws + WS_PJ) + (size_t)L * NTOK * DM, rowL, rep_ ? (float*)(ws + WS_ACT + 202 * MiB) : SS};
            _Pragma("clang loop unroll(disable)") for (int i0 = 0; i0 < TOK_UNITS; i0 += 2) { const int i = i0 + (F.wave >> 2); pg8::Unit u; if (S.next(i, u)) { const int lr = F.tid & 255; rowL[i * 256 + lr] = rstd_ple[u.arow0 + lr]; } }
            __syncthreads();
            pg8::gemm_phase(F.lds, HBa, (const bf16_t*)(ws + WS_WG) + (size_t)L * DM * DM, 2 * DM, S, E);
        }
        SEAM(pb + 7);
    }
    if (EN(9) && IN(17)) for (int rep_ = 0; rep_ < NREP(9); ++rep_) { PHASE_BEGIN(); final_phase(F, HB0, SS, args.in[17], args.out); }
#undef IN
#undef SEAM
}
#define MK_MODE 2

#ifndef MK_MODE
#define MK_MODE 2
#endif
extern "C" void kernel_launch(void* const* d_in, const int* in_sizes, int n_in, void* d_out, int out_size, void* d_ws, size_t ws_size, hipStream_t stream) {
    if (n_in != 18 || in_sizes[0] != NTOK * DM || out_size != NTOK * DM || ws_size < WS_END2) { fprintf(stderr, "kernel_launch: unexpected shapes / workspace (%d inputs, ws %zu, need %zu)\n", n_in, ws_size, (size_t)WS_END2); return; }
    unsigned char* ws = (unsigned char*)d_ws;
    (void)hipMemsetAsync(ws + WS_CTL, 0, 1 * MiB, stream);
#if MK_MODE != 0
    static int grid = 0;
    if (grid == 0) {
        int dev = 0, cus = 0, per_cu = 0;
        if (hipGetDevice(&dev) != hipSuccess || hipDeviceGetAttribute(&cus, hipDeviceAttributeMultiprocessorCount, dev) != hipSuccess) { fprintf(stderr, "kernel_launch: device query failed\n"); grid = -1; return; }
        if (hipFuncSetAttribute((const void*)mega_fwd, hipFuncAttributeMaxDynamicSharedMemorySize, MK_LDS_BYTES) != hipSuccess) { fprintf(stderr, "kernel_launch: hipFuncSetAttribute failed\n"); grid = -1; return; }
        if (hipOccupancyMaxActiveBlocksPerMultiprocessor(&per_cu, (const void*)mega_fwd, MK_WAVES * 64, MK_LDS_BYTES) != hipSuccess || per_cu < 1) fprintf(stderr, "kernel_launch: occupancy query reports %d\n", per_cu);
        (void)hipGetLastError();
        grid = cus;
        grid -= grid % 8;
    }
    if (grid <= 0) return;
    MArgs a{};
    for (int i = 0; i < 18; ++i) a.in[i] = (const float*)d_in[i];
    a.out = (float*)d_out; a.ws = ws;
#if MK_MODE == 2
    a.ph_lo = 0; a.ph_hi = N_PHASES;
    hipLaunchKernelGGL(mega_fwd, dim3(grid), dim3(MK_WAVES * 64), MK_LDS_BYTES, stream, a);
#else
    for (int ph = 0; ph < N_PHASES; ++ph) { a.ph_lo = ph; a.ph_hi = ph + 1; hipLaunchKernelGGL(mega_fwd, dim3(grid), dim3(MK_WAVES * 64), MK_LDS_BYTES, stream, a); }
#endif
    { const hipError_t le = hipPeekAtLastError(); if (le != hipSuccess) fprintf(stderr, "kernel_launch: launch failed: %s\n", hipGetErrorName(le)); }
#else
    const float* x = (const float*)d_in[0]; const float* p = (const float*)d_in[1]; const float* g_mix = (const float*)d_in[2]; const float* w_qkv = (const float*)d_in[3];
    const float* w_fgate = (const float*)d_in[4]; const float* b_fgate = (const float*)d_in[5]; const float* w_o = (const float*)d_in[6]; const float* g_moe = (const float*)d_in[7];
    const float* w_router = (const float*)d_in[8]; const float* b_router = (const float*)d_in[9]; const float* w_gu = (const float*)d_in[10]; const float* b_gu = (const float*)d_in[11];
    const float* w_down = (const float*)d_in[12]; const float* b_down = (const float*)d_in[13]; const float* g_ple = (const float*)d_in[14]; const float* w_ple_gate = (const float*)d_in[15];
    const float* w_ple_proj = (const float*)d_in[16]; const float* g_final = (const float*)d_in[17];
    unsigned* ctl = (unsigned*)(ws + WS_CTL);
    bf16_t *Wqkv = (bf16_t*)(ws + WS_WQKV), *Wo = (bf16_t*)(ws + WS_WO), *Wg = (bf16_t*)(ws + WS_WG), *Wp = (bf16_t*)(ws + WS_WP), *Wgu = (bf16_t*)(ws + WS_WGU), *Wd = (bf16_t*)(ws + WS_WD);
    float* H = (float*)(ws + WS_H); bf16_t *HB = (bf16_t*)(ws + WS_HB), *Q = (bf16_t*)(ws + WS_Q), *Kb = (bf16_t*)(ws + WS_K), *Vb = (bf16_t*)(ws + WS_V), *O = (bf16_t*)(ws + WS_O);
    bf16_t *PB = (bf16_t*)(ws + WS_PB), *PJ = (bf16_t*)(ws + WS_PJ), *ACT = (bf16_t*)(ws + WS_ACT), *Y = (bf16_t*)(ws + WS_Y);
    int* tok_of = (int*)(ws + WS_TOK); float* gate_of = (float*)(ws + WS_GATE); unsigned* pair = (unsigned*)(ws + WS_PAIR);
    float* rstd_mix = (float*)(ws + WS_RSTD); float* rstd_moe = rstd_mix + NTOK; float* rstd_ple = rstd_moe + NTOK;
    float* FL = (float*)(ws + WS_FL); float* CB = (float*)(ws + WS_CB);
    for (int i = 0; i < DEPTH; ++i) {
        k_cvt_t<0><<<dim3(3 * DM / 64, DM / 64, 1), 256, 0, stream>>>(w_qkv + (size_t)i * DM * 3 * DM, g_mix + i * DM, Wqkv + (size_t)i * 3 * DM * DM, DM, 3 * DM);
        k_cvt_t<0><<<dim3(DM / 64, DM / 64, 1), 256, 0, stream>>>(w_o + (size_t)i * DM * DM, nullptr, Wo + (size_t)i * DM * DM, DM, DM);
        k_cvt_t<0><<<dim3(DM / 64, DM / 64, 1), 256, 0, stream>>>(w_ple_gate + (size_t)i * DM * DM, g_ple + i * DM, Wg + (size_t)i * DM * DM, DM, DM);
        k_cvt_t<0><<<dim3(DM / 64, PLE / 64, 1), 256, 0, stream>>>(w_ple_proj + (size_t)i * PLE * DM, nullptr, Wp + (size_t)i * DM * PLE, PLE, DM);
        k_cvt_t<1><<<dim3(2 * FF / 64, DM / 64, NE), 256, 0, stream>>>(w_gu + (size_t)i * NE * DM * 2 * FF, g_moe + i * DM, Wgu + (size_t)i * NE * 2 * FF * DM, DM, 2 * FF);
        k_cvt_t<0><<<dim3(DM / 64, FF / 64, NE), 256, 0, stream>>>(w_down + (size_t)i * NE * FF * DM, nullptr, Wd + (size_t)i * NE * DM * FF, FF, DM);
    }
    k_cvt<<<(unsigned)((size_t)DEPTH * NTOK * PLE / 4 / 256), 256, 0, stream>>>(p, PB, (size_t)DEPTH * NTOK * PLE / 4);
    for (int i = 0; i < DEPTH; ++i)
        k_gemm_pj<<<dim3(DM / 64, NTOK / 64), 64, 0, stream>>>(PB + (size_t)i * NTOK * PLE, Wp + (size_t)i * DM * PLE, PJ + (size_t)i * NTOK * DM);
    k_rowstat<<<NTOK / 4, 256, 0, stream>>>(x, HB, rstd_mix);
    for (int i = 0; i < DEPTH; ++i) {
        const float* hin = (i == 0) ? x : H;
        k_gemm_qkv<<<dim3(3 * DM / 64, NTOK / 64), 64, 0, stream>>>(HB, Wqkv + (size_t)i * 3 * DM * DM, rstd_mix, Q);
        if (i == 0) k_attn_sb<<<NB * NH * SEQ / 4, 256, 0, stream>>>(Q, Kb, Vb, O);
        else {
            k_fgate<<<NTOK / 4, 256, 0, stream>>>(hin, g_mix + i * DM, w_fgate, b_fgate, rstd_mix, FL);
            k_scan<<<NB * NH, 64, 0, stream>>>(FL, CB);
            k_attn_fox<<<NB * NH * SEQ / 4, 256, 0, stream>>>(Q, Kb, Vb, CB, O);
        }
        k_gemm_wo<<<dim3(DM / 64, NTOK / 64), 64, 0, stream>>>(O, Wo + (size_t)i * DM * DM, hin, H, HB);
        unsigned* cnt = ctl + CW_CNT + 64 * i;
        k_router<<<NTOK / 4, 256, 0, stream>>>(H, g_moe + i * DM, w_router + (size_t)i * DM * NE, b_router + i * NE, rstd_moe, cnt, tok_of, gate_of, pair);
        k_gemm_gu<<<dim3(FF / 64, MAXT * 4), 64, 0, stream>>>(HB, Wgu + (size_t)i * NE * 2 * FF * DM, b_gu + (size_t)i * NE * 2 * FF, rstd_moe, cnt, tok_of, ACT);
        k_gemm_down<<<dim3(DM / 64, MAXT * 4), 64, 0, stream>>>(ACT, Wd + (size_t)i * NE * DM * FF, b_down + (size_t)i * NE * DM, cnt, gate_of, Y);
        k_combine<<<NTOK / 4, 256, 0, stream>>>(H, HB, rstd_ple, cnt, pair, Y);
        k_gemm_ple<<<dim3(DM / 64, NTOK / 64), 64, 0, stream>>>(HB, Wg + (size_t)i * DM * DM, rstd_ple, PJ + (size_t)i * NTOK * DM, H, HB);
        if (i + 1 < DEPTH) k_rowstat<<<NTOK / 4, 256, 0, stream>>>(H, HB, rstd_mix);
    }
    k_final<<<NTOK / 4, 256, 0, stream>>>(H, g_final, (float*)d_out);
#endif
}
```

```cpp
#define MK_DUP 0
#define MK_FP8_MASK 3
#include <hip/hip_runtime.h>
#include <cstdio>
#include <cstdint>

typedef unsigned short bf16_t;
typedef short bf16x8 __attribute__((ext_vector_type(8)));
typedef float f32x4 __attribute__((ext_vector_type(4)));
typedef float f32x16 __attribute__((ext_vector_type(16)));
typedef unsigned u32x4 __attribute__((ext_vector_type(4)));
typedef unsigned u32x2 __attribute__((ext_vector_type(2)));

constexpr int NTOK = 32768, DM = 1024, SEQ = 2048, NB = 16, NH = 16, HD = 64, NE = 32, TOPK = 4, FF = 1024, PLE = 256, DEPTH = 2;
constexpr int CAP = NTOK;
constexpr int MAXT = 544;
constexpr int NSLOT = MAXT * 256;
constexpr float EPS = 1e-6f;
constexpr float LOG2E = 1.4426950408889634f;
constexpr float C2 = 0.125f * LOG2E;

constexpr size_t MiB = 1u << 20;
constexpr size_t WS_CTL = 0;
constexpr size_t WS_WQKV = 2 * MiB;
constexpr size_t WS_WO = WS_WQKV + 12 * MiB;
constexpr size_t WS_WG = WS_WO + 4 * MiB;
constexpr size_t WS_WP = WS_WG + 4 * MiB;
constexpr size_t WS_WGU = WS_WP + 2 * MiB;
constexpr size_t WS_WD = WS_WGU + 256 * MiB;
constexpr size_t WS_H = WS_WD + 128 * MiB;
constexpr size_t WS_HB = WS_H + 128 * MiB;
constexpr size_t WS_Q = WS_HB + 64 * MiB;
constexpr size_t WS_K = WS_Q + 64 * MiB;
constexpr size_t WS_V = WS_K + 64 * MiB;
constexpr size_t WS_O = WS_V + 64 * MiB;
constexpr size_t WS_PB = WS_O + 64 * MiB;
constexpr size_t WS_PJ = WS_PB + 32 * MiB;
constexpr size_t WS_ACT = WS_PJ + 128 * MiB;
constexpr size_t WS_Y = WS_ACT + 272 * MiB;
constexpr size_t WS_TOK = WS_Y + 272 * MiB;
constexpr size_t WS_GATE = WS_TOK + 4 * MiB;
constexpr size_t WS_PAIR = WS_GATE + 4 * MiB;
constexpr size_t WS_RSTD = WS_PAIR + 1 * MiB;
constexpr size_t WS_FL = WS_RSTD + 1 * MiB;
constexpr size_t WS_CB = WS_FL + 2 * MiB;
constexpr size_t WS_END = WS_CB + 2 * MiB;
constexpr int CW_CNT = 64;

__device__ __forceinline__ float bf2f(bf16_t v) { return __uint_as_float((unsigned)v << 16); }
__device__ __forceinline__ unsigned f2bf(float f) { unsigned u = __float_as_uint(f); return (u + 0x7fffu + ((u >> 16) & 1u)) >> 16; }
__device__ __forceinline__ unsigned pk2(float lo, float hi) { return f2bf(lo) | (f2bf(hi) << 16); }
__device__ __forceinline__ float wave_sum(float v) {
#pragma unroll
    for (int o = 1; o < 64; o <<= 1) v += __shfl_xor(v, o);
    return v;
}
__device__ __forceinline__ float wave_max(float v) {
#pragma unroll
    for (int o = 1; o < 64; o <<= 1) v = fmaxf(v, __shfl_xor(v, o));
    return v;
}
__device__ __forceinline__ int crow(int r, int hi) { return (r & 3) + 8 * (r >> 2) + 4 * hi; }
__device__ __forceinline__ float sigmoidf_(float x) { return 1.f / (1.f + __expf(-x)); }
__device__ __forceinline__ float log_sigmoid(float x) { return fminf(x, 0.f) - log1pf(__expf(-fabsf(x))); }

struct MoeTile { int e, rank0, cnt, tstart; bool ok; };
__device__ __forceinline__ MoeTile moe_tile(const unsigned* cnt, int T) {
    const int lane = threadIdx.x & 63;
    const int c = (lane < NE) ? (int)cnt[lane] : 0;
    const int nt = (c + 255) >> 8;
    int incl = nt;
#pragma unroll
    for (int o = 1; o < 32; o <<= 1) { int t = __shfl_up(incl, o); if ((lane & 31) >= o) incl += t; }
    const int excl = incl - nt;
    const unsigned long long m = __ballot(lane < NE && excl <= T && nt > 0 && T < incl);
    MoeTile r; r.ok = (m != 0ull);
    const int e = r.ok ? (int)__builtin_ctzll(m) : 0;
    r.e = e; r.tstart = __shfl(excl, e); r.cnt = __shfl(c, e); r.rank0 = (T - r.tstart) * 256;
    return r;
}
__device__ __forceinline__ int moe_tstart(const unsigned* cnt, int e) {
    const int lane = threadIdx.x & 63;
    const int c = (lane < NE) ? (int)cnt[lane] : 0;
    const int nt = (c + 255) >> 8;
    int incl = nt;
#pragma unroll
    for (int o = 1; o < 32; o <<= 1) { int t = __shfl_up(incl, o); if ((lane & 31) >= o) incl += t; }
    return __shfl(incl - nt, e);
}

__global__ void __launch_bounds__(256) k_rowstat(const float* __restrict__ h, bf16_t* __restrict__ hb, float* __restrict__ rstd) {
    const int lane = threadIdx.x & 63, row = blockIdx.x * 4 + (threadIdx.x >> 6);
    const f32x4* p = (const f32x4*)(h + (size_t)row * DM) + lane;
    f32x4 v[4]; float s = 0.f;
#pragma unroll
    for (int j = 0; j < 4; ++j) { v[j] = p[64 * j]; s += v[j].x * v[j].x + v[j].y * v[j].y + v[j].z * v[j].z + v[j].w * v[j].w; }
    s = wave_sum(s);
    if (lane == 0) rstd[row] = rsqrtf(s * (1.f / DM) + EPS);
    u32x2* o = (u32x2*)(hb + (size_t)row * DM) + lane;
#pragma unroll
    for (int j = 0; j < 4; ++j) { u32x2 w; w.x = pk2(v[j].x, v[j].y); w.y = pk2(v[j].z, v[j].w); o[64 * j] = w; }
}
__global__ void __launch_bounds__(256) k_cvt(const float* __restrict__ s, bf16_t* __restrict__ d, size_t n4) {
    size_t i = (size_t)blockIdx.x * 256 + threadIdx.x;
    if (i < n4) { f32x4 v = ((const f32x4*)s)[i]; u32x2 w; w.x = pk2(v.x, v.y); w.y = pk2(v.z, v.w); ((u32x2*)d)[i] = w; }
}
template <int MODE>
__global__ void __launch_bounds__(256) k_cvt_t(const float* __restrict__ src, const float* __restrict__ g, bf16_t* __restrict__ dst, int K, int N) {
    __shared__ float tile[64][65];
    const int n0 = blockIdx.x * 64, k0 = blockIdx.y * 64, b = blockIdx.z, tid = threadIdx.x;
    const float* s = src + (size_t)b * K * N; bf16_t* d = dst + (size_t)b * K * N;
#pragma unroll
    for (int i = 0; i < 16; ++i) { const int kk = i * 4 + (tid >> 6), nn = tid & 63; const float gg = g ? g[k0 + kk] : 1.f; tile[kk][nn] = s[(size_t)(k0 + kk) * N + n0 + nn] * gg; }
    __syncthreads();
#pragma unroll
    for (int j = 0; j < 2; ++j) {
        const int c = tid + 256 * j, n = c >> 3, kc = c & 7;
        u32x4 w; w.x = pk2(tile[kc * 8 + 0][n], tile[kc * 8 + 1][n]); w.y = pk2(tile[kc * 8 + 2][n], tile[kc * 8 + 3][n]);
        w.z = pk2(tile[kc * 8 + 4][n], tile[kc * 8 + 5][n]); w.w = pk2(tile[kc * 8 + 6][n], tile[kc * 8 + 7][n]);
        int nn = n0 + n;
        if (MODE == 1) { const int half = nn / FF, j2 = nn % FF; nn = (j2 >> 7) * 256 + half * 128 + (j2 & 127); }
        *(u32x4*)(d + (size_t)nn * K + k0 + kc * 8) = w;
    }
}

template <bool DUAL>
__device__ __forceinline__ void gemm_tile64(const bf16_t* a0, const bf16_t* a1, const bf16_t* B1, const bf16_t* B2, int K, f32x16 (&acc)[2][2], f32x16 (&acc2)[2][2]) {
    const int lane = threadIdx.x & 63, r32 = lane & 31, hi = lane >> 5;
    const bf16_t* b0 = B1 + (size_t)r32 * K + 8 * hi; const bf16_t* b1 = B1 + (size_t)(32 + r32) * K + 8 * hi;
    const bf16_t* c0 = DUAL ? B2 + (size_t)r32 * K + 8 * hi : nullptr; const bf16_t* c1 = DUAL ? B2 + (size_t)(32 + r32) * K + 8 * hi : nullptr;
    a0 += 8 * hi; a1 += 8 * hi;
#pragma unroll
    for (int i = 0; i < 2; ++i)
#pragma unroll
        for (int j = 0; j < 2; ++j) { acc[i][j] = f32x16{}; acc2[i][j] = f32x16{}; }
    for (int k = 0; k < K; k += 16) {
        const bf16x8 fa0 = *(const bf16x8*)(a0 + k), fa1 = *(const bf16x8*)(a1 + k), fb0 = *(const bf16x8*)(b0 + k), fb1 = *(const bf16x8*)(b1 + k);
        acc[0][0] = __builtin_amdgcn_mfma_f32_32x32x16_bf16(fa0, fb0, acc[0][0], 0, 0, 0);
        acc[0][1] = __builtin_amdgcn_mfma_f32_32x32x16_bf16(fa0, fb1, acc[0][1], 0, 0, 0);
        acc[1][0] = __builtin_amdgcn_mfma_f32_32x32x16_bf16(fa1, fb0, acc[1][0], 0, 0, 0);
        acc[1][1] = __builtin_amdgcn_mfma_f32_32x32x16_bf16(fa1, fb1, acc[1][1], 0, 0, 0);
        if (DUAL) {
            const bf16x8 fc0 = *(const bf16x8*)(c0 + k), fc1 = *(const bf16x8*)(c1 + k);
            acc2[0][0] = __builtin_amdgcn_mfma_f32_32x32x16_bf16(fa0, fc0, acc2[0][0], 0, 0, 0);
            acc2[0][1] = __builtin_amdgcn_mfma_f32_32x32x16_bf16(fa0, fc1, acc2[0][1], 0, 0, 0);
            acc2[1][0] = __builtin_amdgcn_mfma_f32_32x32x16_bf16(fa1, fc0, acc2[1][0], 0, 0, 0);
            acc2[1][1] = __builtin_amdgcn_mfma_f32_32x32x16_bf16(fa1, fc1, acc2[1][1], 0, 0, 0);
        }
    }
}
#define TILE_FOREACH(...) _Pragma("unroll") for (int mi = 0; mi < 2; ++mi) _Pragma("unroll") for (int ni = 0; ni < 2; ++ni) _Pragma("unroll") for (int r = 0; r < 16; ++r) { \
        const int lrow = 32 * mi + crow(r, hi), lcol = 32 * ni + r32; const float v = acc[mi][ni][r]; const float v2 = acc2[mi][ni][r]; (void)v2; __VA_ARGS__ }

__global__ void __launch_bounds__(64) k_gemm_qkv(const bf16_t* __restrict__ A, const bf16_t* __restrict__ Bt, const float* __restrict__ rstd, bf16_t* __restrict__ Q) {
    const int lane = threadIdx.x, r32 = lane & 31, hi = lane >> 5; const int m0 = blockIdx.y * 64, n0 = blockIdx.x * 64;
    f32x16 acc[2][2], acc2[2][2];
    gemm_tile64<false>(A + (size_t)(m0 + r32) * DM, A + (size_t)(m0 + 32 + r32) * DM, Bt + (size_t)n0 * DM, nullptr, DM, acc, acc2);
    const int t = n0 / DM; bf16_t* out = Q + (size_t)t * ((WS_K - WS_Q) / 2); const float sc = (t == 0) ? C2 : 1.f;
    TILE_FOREACH({ const int row = m0 + lrow, col = n0 - t * DM + lcol; out[(size_t)row * DM + col] = (bf16_t)f2bf(v * rstd[row] * sc); })
}
__global__ void __launch_bounds__(64) k_gemm_wo(const bf16_t* __restrict__ A, const bf16_t* __restrict__ Bt, const float* hin, float* hout, bf16_t* __restrict__ hb) {
    const int lane = threadIdx.x, r32 = lane & 31, hi = lane >> 5; const int m0 = blockIdx.y * 64, n0 = blockIdx.x * 64;
    f32x16 acc[2][2], acc2[2][2];
    gemm_tile64<false>(A + (size_t)(m0 + r32) * DM, A + (size_t)(m0 + 32 + r32) * DM, Bt + (size_t)n0 * DM, nullptr, DM, acc, acc2);
    TILE_FOREACH({ const size_t o = (size_t)(m0 + lrow) * DM + n0 + lcol; const float x = hin[o] + v; hout[o] = x; hb[o] = (bf16_t)f2bf(x); })
}
__global__ void __launch_bounds__(64) k_gemm_pj(const bf16_t* __restrict__ A, const bf16_t* __restrict__ Bt, bf16_t* __restrict__ PJ) {
    const int lane = threadIdx.x, r32 = lane & 31, hi = lane >> 5; const int m0 = blockIdx.y * 64, n0 = blockIdx.x * 64;
    f32x16 acc[2][2], acc2[2][2];
    gemm_tile64<false>(A + (size_t)(m0 + r32) * PLE, A + (size_t)(m0 + 32 + r32) * PLE, Bt + (size_t)n0 * PLE, nullptr, PLE, acc, acc2);
    TILE_FOREACH({ PJ[(size_t)(m0 + lrow) * DM + n0 + lcol] = (bf16_t)f2bf(v); })
}
__global__ void __launch_bounds__(64) k_gemm_ple(const bf16_t* __restrict__ A, const bf16_t* __restrict__ Bt, const float* __restrict__ rstd, const bf16_t* __restrict__ PJ, float* h, bf16_t* hb) {
    const int lane = threadIdx.x, r32 = lane & 31, hi = lane >> 5; const int m0 = blockIdx.y * 64, n0 = blockIdx.x * 64;
    f32x16 acc[2][2], acc2[2][2];
    gemm_tile64<false>(A + (size_t)(m0 + r32) * DM, A + (size_t)(m0 + 32 + r32) * DM, Bt + (size_t)n0 * DM, nullptr, DM, acc, acc2);
    TILE_FOREACH({ const int row = m0 + lrow; const size_t o = (size_t)row * DM + n0 + lcol; const float x = h[o] + sigmoidf_(v * rstd[row]) * bf2f(PJ[o]); h[o] = x; })
}
__global__ void __launch_bounds__(64) k_gemm_gu(const bf16_t* __restrict__ HB, const bf16_t* __restrict__ Wgu, const float* __restrict__ bgu, const float* __restrict__ rstd,
                                                const unsigned* __restrict__ cnt, const int* __restrict__ tok_of, bf16_t* __restrict__ ACT) {
    const int lane = threadIdx.x, r32 = lane & 31, hi = lane >> 5; const int rt = blockIdx.y, T = rt >> 2, j0 = blockIdx.x * 64;
    const MoeTile mt = moe_tile(cnt, T); if (!mt.ok) return;
    const int lr0 = (rt & 3) * 64; const int rk0 = mt.rank0 + lr0 + r32, rk1 = rk0 + 32;
    const int t0 = rk0 < mt.cnt ? tok_of[(size_t)mt.e * CAP + rk0] : 0, t1 = rk1 < mt.cnt ? tok_of[(size_t)mt.e * CAP + rk1] : 0;
    const bf16_t* Be = Wgu + (size_t)mt.e * 2048 * DM + (size_t)((j0 >> 7) * 256 + (j0 & 127)) * DM;
    f32x16 acc[2][2], acc2[2][2];
    gemm_tile64<true>(HB + (size_t)t0 * DM, HB + (size_t)t1 * DM, Be, Be + (size_t)128 * DM, DM, acc, acc2);
    const size_t slot0 = (size_t)T * 256 + lr0;
    TILE_FOREACH({ const int rk = mt.rank0 + lr0 + lrow; if (rk < mt.cnt) { const int tk = tok_of[(size_t)mt.e * CAP + rk]; const float rs = rstd[tk]; const int j = j0 + lcol;
        float gl = v * rs + bgu[(size_t)mt.e * 2048 + j], ln = v2 * rs + bgu[(size_t)mt.e * 2048 + FF + j];
        gl = fminf(gl, 7.f); ln = fminf(fmaxf(ln, -7.f), 7.f);
        const float a = gl * sigmoidf_(1.702f * gl) * (ln + 1.f);
        ACT[(slot0 + lrow) * FF + j] = (bf16_t)f2bf(a); } })
}
__global__ void __launch_bounds__(64) k_gemm_down(const bf16_t* __restrict__ ACT, const bf16_t* __restrict__ Wd, const float* __restrict__ bd, const unsigned* __restrict__ cnt,
                                                  const float* __restrict__ gate_of, bf16_t* __restrict__ Y) {
    const int lane = threadIdx.x, r32 = lane & 31, hi = lane >> 5; const int rt = blockIdx.y, T = rt >> 2, n0 = blockIdx.x * 64;
    const MoeTile mt = moe_tile(cnt, T); if (!mt.ok) return;
    const int lr0 = (rt & 3) * 64; const size_t slot0 = (size_t)T * 256 + lr0;
    const int rk0 = mt.rank0 + lr0 + r32, rk1 = rk0 + 32;
    const size_t s0 = rk0 < mt.cnt ? slot0 + r32 : (size_t)T * 256, s1 = rk1 < mt.cnt ? slot0 + 32 + r32 : (size_t)T * 256;
    f32x16 acc[2][2], acc2[2][2];
    gemm_tile64<false>(ACT + s0 * FF, ACT + s1 * FF, Wd + (size_t)mt.e * DM * FF + (size_t)n0 * FF, nullptr, FF, acc, acc2);
    TILE_FOREACH({ const int rk = mt.rank0 + lr0 + lrow; if (rk < mt.cnt) { const float gt = gate_of[(size_t)mt.e * CAP + rk]; const int n = n0 + lcol;
        Y[(slot0 + lrow) * DM + n] = (bf16_t)f2bf((v + bd[(size_t)mt.e * DM + n]) * gt); } })
}

__global__ void __launch_bounds__(256) k_router(const float* __restrict__ h, const float* __restrict__ g, const float* __restrict__ wr, const float* __restrict__ br,
                                                float* __restrict__ rstd, unsigned* cnt, int* __restrict__ tok_of, float* __restrict__ gate_of, unsigned* __restrict__ pair) {
    const int lane = threadIdx.x & 63, t = blockIdx.x * 4 + (threadIdx.x >> 6); const int e = lane & 31, half = lane >> 5;
    const float* hr = h + (size_t)t * DM;
    float ss = 0.f;
#pragma unroll
    for (int j = 0; j < 4; ++j) { const f32x4 v = ((const f32x4*)hr)[lane + 64 * j]; ss += v.x * v.x + v.y * v.y + v.z * v.z + v.w * v.w; }
    const float rs = rsqrtf(wave_sum(ss) * (1.f / DM) + EPS);
    float a = 0.f;
    for (int d = half * 512; d < half * 512 + 512; ++d) a += hr[d] * g[d] * wr[(size_t)d * NE + e];
    a += __shfl_xor(a, 32);
    float lg = a * rs + br[e];
    float tv[4]; int ti[4];
#pragma unroll
    for (int k = 0; k < 4; ++k) {
        float bv = lg; int bi = e;
#pragma unroll
        for (int o = 1; o < 32; o <<= 1) { const float ov = __shfl_xor(bv, o); const int oi = __shfl_xor(bi, o); if (ov > bv || (ov == bv && oi < bi)) { bv = ov; bi = oi; } }
        tv[k] = bv; ti[k] = bi; if (e == bi) lg = -INFINITY;
    }
    float w[4], sw = 0.f;
#pragma unroll
    for (int k = 0; k < 4; ++k) { w[k] = __expf(tv[k] - tv[0]); sw += w[k]; }
    if (lane == 0) rstd[t] = rs;
    if (lane < 4) {
        const int k = lane; const int ee = (k == 0) ? ti[0] : (k == 1) ? ti[1] : (k == 2) ? ti[2] : ti[3]; const float ww = (k == 0) ? w[0] : (k == 1) ? w[1] : (k == 2) ? w[2] : w[3];
        const unsigned rk = atomicAdd(&cnt[ee], 1u);
        tok_of[(size_t)ee * CAP + rk] = t; gate_of[(size_t)ee * CAP + rk] = ww / sw; pair[(size_t)t * 4 + k] = ((unsigned)ee << 16) | rk;
    }
}
__global__ void __launch_bounds__(256) k_combine(float* h, bf16_t* __restrict__ hb, float* __restrict__ rstd, const unsigned* __restrict__ cnt, const unsigned* __restrict__ pair, const bf16_t* __restrict__ Y) {
    const int lane = threadIdx.x & 63, t = blockIdx.x * 4 + (threadIdx.x >> 6);
    f32x4 v[4]; f32x4* hr = (f32x4*)(h + (size_t)t * DM) + lane;
#pragma unroll
    for (int j = 0; j < 4; ++j) v[j] = hr[64 * j];
    for (int k = 0; k < 4; ++k) {
        const unsigned pr = pair[(size_t)t * 4 + k]; const int e = pr >> 16, rk = pr & 0xffff;
        const size_t slot = (size_t)moe_tstart(cnt, e) * 256 + rk;
        const u32x2* yr = (const u32x2*)(Y + slot * DM) + lane;
#pragma unroll
        for (int j = 0; j < 4; ++j) { const u32x2 w = yr[64 * j]; v[j].x += __uint_as_float(w.x << 16); v[j].y += __uint_as_float(w.x & 0xffff0000u); v[j].z += __uint_as_float(w.y << 16); v[j].w += __uint_as_float(w.y & 0xffff0000u); }
    }
    float s = 0.f;
#pragma unroll
    for (int j = 0; j < 4; ++j) { hr[64 * j] = v[j]; s += v[j].x * v[j].x + v[j].y * v[j].y + v[j].z * v[j].z + v[j].w * v[j].w; }
    s = wave_sum(s); if (lane == 0) rstd[t] = rsqrtf(s * (1.f / DM) + EPS);
    u32x2* o = (u32x2*)(hb + (size_t)t * DM) + lane;
#pragma unroll
    for (int j = 0; j < 4; ++j) { u32x2 w; w.x = pk2(v[j].x, v[j].y); w.y = pk2(v[j].z, v[j].w); o[64 * j] = w; }
}
__global__ void __launch_bounds__(256) k_final(const float* __restrict__ h, const float* __restrict__ g, float* __restrict__ out) {
    const int lane = threadIdx.x & 63, row = blockIdx.x * 4 + (threadIdx.x >> 6);
    const f32x4* p = (const f32x4*)(h + (size_t)row * DM) + lane; f32x4 v[4]; float s = 0.f;
#pragma unroll
    for (int j = 0; j < 4; ++j) { v[j] = p[64 * j]; s += v[j].x * v[j].x + v[j].y * v[j].y + v[j].z * v[j].z + v[j].w * v[j].w; }
    const float rs = rsqrtf(wave_sum(s) * (1.f / DM) + EPS);
    f32x4* o = (f32x4*)(out + (size_t)row * DM) + lane;
#pragma unroll
    for (int j = 0; j < 4; ++j) { const f32x4 gg = ((const f32x4*)g)[lane + 64 * j]; o[64 * j] = v[j] * rs * gg; }
}
__global__ void __launch_bounds__(256) k_fgate(const float* __restrict__ h, const float* __restrict__ g, const float* __restrict__ wf, const float* __restrict__ bfg, const float* __restrict__ rstd, float* __restrict__ fl) {
    const int lane = threadIdx.x & 63, t = blockIdx.x * 4 + (threadIdx.x >> 6); const int hh = lane & 15, q = lane >> 4;
    const float* hr = h + (size_t)t * DM; float a = 0.f;
    for (int d = q * 256; d < q * 256 + 256; ++d) a += hr[d] * g[d] * wf[(size_t)d * NH + hh];
    a += __shfl_xor(a, 16); a += __shfl_xor(a, 32);
    if (lane < 16) fl[(size_t)t * NH + hh] = a * rstd[t] + bfg[hh];
}
__global__ void __launch_bounds__(64) k_scan(const float* __restrict__ fl, float* __restrict__ cb) {
    const int lane = threadIdx.x, bh = blockIdx.x, b = bh / NH, hh = bh % NH;
    float loc[32]; float run = 0.f;
#pragma unroll
    for (int i = 0; i < 32; ++i) { run += log_sigmoid(fl[(size_t)(b * SEQ + lane * 32 + i) * NH + hh]); loc[i] = run; }
    float incl = run;
#pragma unroll
    for (int o = 1; o < 64; o <<= 1) { const float t = __shfl_up(incl, o); if (lane >= o) incl += t; }
    const float base = incl - run;
#pragma unroll
    for (int i = 0; i < 32; ++i) cb[(size_t)bh * SEQ + lane * 32 + i] = (base + loc[i]) * LOG2E;
}

__device__ __forceinline__ float dot64(const float (&q)[64], const bf16_t* kr) {
    float a = 0.f;
#pragma unroll
    for (int c = 0; c < 8; ++c) { const u32x4 w = ((const u32x4*)kr)[c];
        a += q[8 * c + 0] * __uint_as_float(w.x << 16) + q[8 * c + 1] * __uint_as_float(w.x & 0xffff0000u) + q[8 * c + 2] * __uint_as_float(w.y << 16) + q[8 * c + 3] * __uint_as_float(w.y & 0xffff0000u)
           + q[8 * c + 4] * __uint_as_float(w.z << 16) + q[8 * c + 5] * __uint_as_float(w.z & 0xffff0000u) + q[8 * c + 6] * __uint_as_float(w.w << 16) + q[8 * c + 7] * __uint_as_float(w.w & 0xffff0000u); }
    return a;
}
__device__ __forceinline__ void loadq(float (&q)[64], const bf16_t* qr) {
#pragma unroll
    for (int c = 0; c < 8; ++c) { const u32x4 w = ((const u32x4*)qr)[c];
        q[8 * c + 0] = __uint_as_float(w.x << 16); q[8 * c + 1] = __uint_as_float(w.x & 0xffff0000u); q[8 * c + 2] = __uint_as_float(w.y << 16); q[8 * c + 3] = __uint_as_float(w.y & 0xffff0000u);
        q[8 * c + 4] = __uint_as_float(w.z << 16); q[8 * c + 5] = __uint_as_float(w.z & 0xffff0000u); q[8 * c + 6] = __uint_as_float(w.w << 16); q[8 * c + 7] = __uint_as_float(w.w & 0xffff0000u); }
}
__global__ void __launch_bounds__(256) k_attn_sb(const bf16_t* __restrict__ Q, const bf16_t* __restrict__ K, const bf16_t* __restrict__ V, bf16_t* __restrict__ O) {
    const int lane = threadIdx.x & 63; const int gw = blockIdx.x * 4 + (threadIdx.x >> 6); const int t = gw % SEQ, bh = gw / SEQ, b = bh / NH, hh = bh % NH;
    const size_t rowb = (size_t)b * SEQ; float q[64]; loadq(q, Q + (rowb + t) * DM + hh * HD);
    float o = 0.f, carry = 1.f;
    for (int jt = (t - 1) >> 6; jt >= 0 && t > 0; --jt) {
        const int s = 64 * jt + lane; const bool valid = s < t;
        float x = dot64(q, K + (rowb + s) * DM + hh * HD); x = fminf(x, 64.f);
        const float ex = exp2f(x), r = 1.f / (1.f + ex);
        const float beta = valid ? ex * r : 0.f, nb = valid ? r : 1.f;
        float P = nb;
#pragma unroll
        for (int off = 1; off < 64; off <<= 1) { const float t2 = __shfl_down(P, off); if (lane + off < 64) P *= t2; }
        float Pex = __shfl_down(P, 1); if (lane == 63) Pex = 1.f;
        const float a = beta * carry * Pex;
        carry *= __shfl(P, 0);
        const bf16_t* vb = V + (rowb + 64 * jt) * DM + hh * HD + lane;
        for (int l = 0; l < 64; ++l) { const float al = __shfl(a, l); o += al * bf2f(vb[(size_t)l * DM]); }
        if (carry < 1e-30f) break;
    }
    O[(rowb + t) * DM + hh * HD + lane] = (bf16_t)f2bf(o);
}
__global__ void __launch_bounds__(256) k_attn_fox(const bf16_t* __restrict__ Q, const bf16_t* __restrict__ K, const bf16_t* __restrict__ V, const float* __restrict__ cb, bf16_t* __restrict__ O) {
    const int lane = threadIdx.x & 63; const int gw = blockIdx.x * 4 + (threadIdx.x >> 6); const int t = gw % SEQ, bh = gw / SEQ, b = bh / NH, hh = bh % NH;
    const size_t rowb = (size_t)b * SEQ; float q[64]; loadq(q, Q + (rowb + t) * DM + hh * HD);
    float o = 0.f, m = -INFINITY, l = 0.f;
    for (int jt = 0; jt <= (t >> 6); ++jt) {
        const int s = 64 * jt + lane; const bool valid = s <= t;
        float x = dot64(q, K + (rowb + s) * DM + hh * HD) - cb[(size_t)bh * SEQ + s];
        x = valid ? x : -INFINITY;
        const float mn = fmaxf(m, wave_max(x)); const float alpha = exp2f(m - mn); const float p = exp2f(x - mn);
        l = l * alpha + wave_sum(p); o *= alpha; m = mn;
        const bf16_t* vb = V + (rowb + 64 * jt) * DM + hh * HD + lane;
        const int nl = min(64, t - 64 * jt + 1);
        for (int i = 0; i < nl; ++i) { const float pi = __shfl(p, i); o += pi * bf2f(vb[(size_t)i * DM]); }
    }
    O[(rowb + t) * DM + hh * HD + lane] = (bf16_t)f2bf(o / l);
}


#include <hip/hip_bf16.h>
#include <cmath>
namespace attn_body {
using bf16=__hip_bfloat16;
using bf16x8=__attribute__((ext_vector_type(8)))short;
using s16x4=__attribute__((ext_vector_type(4)))short;
using f32x16=__attribute__((ext_vector_type(16)))float;
using u32x4=__attribute__((ext_vector_type(4)))unsigned;
constexpr int BATCH=16,NHEAD=16,SEQ=2048,D=64,DM=NHEAD*D;
constexpr int NW=8,QBLK=32,QB=QBLK*NW,KVBLK=64,NQB=SEQ/QB;
constexpr int ATTN_PITCH=DM, ATTN_UNIT_ROWS=QB;
__device__ __forceinline__ int crow(int r,int hi){return (r&3)+8*(r>>2)+4*hi;}
#define SBAR() __builtin_amdgcn_sched_barrier(0)
__device__ __forceinline__ void cmask(f32x16&p0,f32x16&p1,int jb,int qrel,int hi){
  const float NEG=-INFINITY; int kb=64*jb+4*hi;
  #pragma unroll
  for(int r=0;r<16;++r){int kv=kb+(r&3)+8*(r>>2); if(kv>qrel)p0[r]=NEG; if(kv+32>qrel)p1[r]=NEG;}
}

constexpr int NSLOT=3, SLOTB=8192;
constexpr int LDS_K=0, LDS_V=NSLOT*SLOTB, LDS_WS=2*NSLOT*SLOTB, LDS_OST=LDS_WS+NW*64*4, LDS_BYTES=LDS_OST+NW*4096;
constexpr float C2=0.125f*1.4426950408889634f;
__device__ __forceinline__ void glds16(const void*gsrc,unsigned lds_dst){unsigned keep;
  asm volatile("s_mov_b32 %0, m0\n\ts_mov_b32 m0, %2\n\ts_nop 0\n\tglobal_load_lds_dwordx4 %1, off\n\ts_mov_b32 m0, %0":"=&s"(keep):"v"(gsrc),"s"(lds_dst):"memory");}
__device__ __forceinline__ float max3f(float a,float b,float c){float r;asm("v_max3_f32 %0, %1, %2, %3":"=v"(r):"v"(a),"v"(b),"v"(c));return r;}
__device__ __forceinline__ float max2f(float a,float b){float r;asm("v_max_f32_e32 %0, %1, %2":"=v"(r):"v"(a),"v"(b));return r;}
__device__ __forceinline__ float fadd_s(float a,float b){float r;asm("v_add_f32_e32 %0, %1, %2":"=v"(r):"v"(a),"v"(b));return r;}
__device__ __forceinline__ float fsub_s(float a,float b){float r;asm("v_sub_f32_e32 %0, %1, %2":"=v"(r):"v"(a),"v"(b));return r;}
typedef float f32x2_t __attribute__((ext_vector_type(2))); typedef __bf16 bf16x2_t __attribute__((ext_vector_type(2)));
__device__ __forceinline__ unsigned cvtpk_s(float lo,float hi){f32x2_t v={lo,hi};bf16x2_t b=__builtin_convertvector(v,bf16x2_t);return __builtin_bit_cast(unsigned,b);}
#define WAIT_BAR(N) asm volatile("s_waitcnt vmcnt(" #N ") lgkmcnt(0)\n\ts_barrier":::"memory")

__device__ __forceinline__ void qkt(f32x16&p0,f32x16&p1,const char*Kslot,const bf16x8*qr,const f32x16&negm,int r32,int hi){
  const char*kb=Kslot+hi*1024+r32*16;
  #pragma unroll
  for(int d0=0;d0<4;++d0){
    const bf16x8 b0=*reinterpret_cast<const bf16x8*>(kb+d0*2048);
    const bf16x8 b1=*reinterpret_cast<const bf16x8*>(kb+d0*2048+512);
    if(d0==0){p0=__builtin_amdgcn_mfma_f32_32x32x16_bf16(b0,qr[0],negm,0,0,0);p1=__builtin_amdgcn_mfma_f32_32x32x16_bf16(b1,qr[0],negm,0,0,0);}
    else{p0=__builtin_amdgcn_mfma_f32_32x32x16_bf16(b0,qr[d0],p0,0,0,0);p1=__builtin_amdgcn_mfma_f32_32x32x16_bf16(b1,qr[d0],p1,0,0,0);}}
}
typedef __attribute__((address_space(3))) const char* lds_cptr;
typedef short v4i16_t __attribute__((ext_vector_type(4)));
__device__ __forceinline__ void kload8(bf16x8*kf,lds_cptr kp){
  kf[0]=*(const __attribute__((address_space(3))) bf16x8*)(kp);      kf[1]=*(const __attribute__((address_space(3))) bf16x8*)(kp+512);
  kf[2]=*(const __attribute__((address_space(3))) bf16x8*)(kp+2048); kf[3]=*(const __attribute__((address_space(3))) bf16x8*)(kp+2560);
  kf[4]=*(const __attribute__((address_space(3))) bf16x8*)(kp+4096); kf[5]=*(const __attribute__((address_space(3))) bf16x8*)(kp+4608);
  kf[6]=*(const __attribute__((address_space(3))) bf16x8*)(kp+6144); kf[7]=*(const __attribute__((address_space(3))) bf16x8*)(kp+6656);
}
__device__ __forceinline__ void kload2(bf16x8*kf,lds_cptr kp,int j){ kf[2*j]=*(const __attribute__((address_space(3))) bf16x8*)(kp+j*2048); kf[2*j+1]=*(const __attribute__((address_space(3))) bf16x8*)(kp+j*2048+512); }
__device__ __forceinline__ s16x4 vtr(lds_cptr p){ return __builtin_bit_cast(s16x4,__builtin_amdgcn_ds_read_tr16_b64_v4i16((__attribute__((address_space(3))) v4i16_t*)p)); }
__device__ __forceinline__ float rowmax(const f32x16&p0,const f32x16&p1){
  float a=max3f(p0[0],p0[1],p1[0]),b=max3f(p0[2],p0[3],p1[1]);a=max3f(a,p1[2],p1[3]);
  #pragma unroll
  for(int r=4;r<16;r+=4){a=max3f(a,p0[r],p0[r+1]);b=max3f(b,p0[r+2],p0[r+3]);a=max3f(a,p1[r],p1[r+1]);b=max3f(b,p1[r+2],p1[r+3]);}
  const float m=max2f(a,b);
  auto rr=__builtin_amdgcn_permlane32_swap(__float_as_uint(m),__float_as_uint(m),false,false);
  return max2f(__uint_as_float(rr[0]),__uint_as_float(rr[1]));
}
__device__ __forceinline__ void pv(f32x16*o,int vb,bf16x8 pa0,bf16x8 pa1,bf16x8 pa2,bf16x8 pa3){
  #pragma unroll
  for(int d0=0;d0<2;++d0){s16x4 lo[4],hi[4];
    #pragma unroll
    for(int ks=0;ks<4;++ks){
      asm volatile("ds_read_b64_tr_b16 %0,%1 offset:%c2":"=&v"(lo[ks]):"v"(vb),"i"(d0*4096+ks*1024):"memory");
      asm volatile("ds_read_b64_tr_b16 %0,%1 offset:%c2":"=&v"(hi[ks]):"v"(vb),"i"(d0*4096+ks*1024+512):"memory");}
    asm volatile("s_waitcnt lgkmcnt(0)":::"memory");SBAR();
    #define PK(k) (bf16x8){lo[k][0],lo[k][1],lo[k][2],lo[k][3],hi[k][0],hi[k][1],hi[k][2],hi[k][3]}
    o[d0]=__builtin_amdgcn_mfma_f32_32x32x16_bf16(pa0,PK(0),o[d0],0,0,0);
    o[d0]=__builtin_amdgcn_mfma_f32_32x32x16_bf16(pa1,PK(1),o[d0],0,0,0);
    o[d0]=__builtin_amdgcn_mfma_f32_32x32x16_bf16(pa2,PK(2),o[d0],0,0,0);
    o[d0]=__builtin_amdgcn_mfma_f32_32x32x16_bf16(pa3,PK(3),o[d0],0,0,0);
    #undef PK
  }
}

#ifndef ATTN_STORE16
#define ATTN_STORE16(p,v) (*(u32x4*)(p)=(v))
#endif
typedef float f32x4b __attribute__((ext_vector_type(4)));
template<int THRL> __device__ __forceinline__ void attn_unit(int b,int h,int qb,const bf16*Q,const bf16*__restrict__ K,const bf16*__restrict__ V,bf16*O,char*shm,const __attribute__((address_space(3))) float*cb){
  int tid_=threadIdx.x; asm volatile("":"+v"(tid_));
  const int tid=tid_,lane=tid&63,r32=lane&31,hi=lane>>5; const int wid=__builtin_amdgcn_readfirstlane(tid>>6);
  const long rowbase=(long)b*SEQ; const int q0=qb*QB;
  const bf16*Qw=Q+(rowbase+q0+wid*QBLK)*DM+h*D;
  const bf16*Kh=K+rowbase*DM+h*D,*Vh=V+rowbase*DM+h*D;
  const unsigned lds0=(unsigned)(uintptr_t)shm;
  float*wsf=(float*)(shm+LDS_WS)+wid*64;
  const bf16*ksrc=Kh+(long)lane*DM+wid*8;
  const bf16*vsrc=Vh+(long)(16*(wid&3)+(lane>>2))*DM+(wid>>2)*32+(lane&3)*8;
  const unsigned kdst=lds0+LDS_K+wid*1024, vdst=lds0+LDS_V+wid*1024;
  #define TIDX(u) (NT-1-(u))
  #define DMA_K(t,slot) glds16(ksrc+(long)TIDX(t)*KVBLK*DM,(unsigned)__builtin_amdgcn_readfirstlane(kdst+(slot)))
  #define DMA_V(t,slot) glds16(vsrc+(long)TIDX(t)*KVBLK*DM,(unsigned)__builtin_amdgcn_readfirstlane(vdst+(slot)))
  const int vb0=(int)(lds0+LDS_V)+((lane>>4)&1)*32+(lane&3)*8+(4*hi+((lane&15)>>2))*64;
  const char*Kbase=shm+LDS_K; bf16x8 kf[8];
  const lds_cptr shm3=(lds_cptr)shm; const lds_cptr kp0=shm3+LDS_K+hi*1024+r32*16; const lds_cptr vp0=shm3+LDS_V+((lane>>4)&1)*32+(lane&3)*8+(4*hi+((lane&15)>>2))*64;
  const int NT=(q0+QB)/KVBLK;
  DMA_K(0,0);DMA_V(0,0);DMA_K(1,SLOTB);
  bf16x8 qr[4];
  #pragma unroll
  for(int d0=0;d0<4;++d0)qr[d0]=*reinterpret_cast<const bf16x8*>(&Qw[(long)r32*DM+d0*16+hi*8]);
  float mhat=0.f,l_reg=0.f;f32x16 o[2];o[0]=f32x16{};o[1]=f32x16{};const f32x16 negm=f32x16{};
  const int qrel=wid*QBLK+r32;
  #define CMASK(P0,P1,t) do{int jb_=3-(t); if(jb_>=0)cmask(P0,P1,jb_,qrel,hi);}while(0)
  #define ABIAS(P0,P1,t) do{ const __attribute__((address_space(3))) f32x4b*cbp_=(const __attribute__((address_space(3))) f32x4b*)(cb+64*TIDX(t)+4*hi); \
    _Pragma("unroll") for(int g_=0;g_<4;++g_){ const f32x4b b0_=cbp_[2*g_], b1_=cbp_[8+2*g_]; \
      P0[4*g_+0]+=b0_[0];P0[4*g_+1]+=b0_[1];P0[4*g_+2]+=b0_[2];P0[4*g_+3]+=b0_[3]; P1[4*g_+0]+=b1_[0];P1[4*g_+1]+=b1_[1];P1[4*g_+2]+=b1_[2];P1[4*g_+3]+=b1_[3]; } }while(0)
  #define BLD(G,t,h) f32x4b nb##h##_[4]; { const __attribute__((address_space(3))) f32x4b*cbp_=(const __attribute__((address_space(3))) f32x4b*)(cb+64*TIDX(t)+4*hi+32*(h)); \
      _Pragma("unroll") for(int g_=0;g_<4;++g_) nb##h##_[g_]=cbp_[2*g_]; }
  #define BSUB(G,P,h) if(G){ const float mh_=mhat; _Pragma("unroll") for(int g_=0;g_<4;++g_){ \
      P[4*g_+0]=nb##h##_[g_][0]-mh_;P[4*g_+1]=nb##h##_[g_][1]-mh_;P[4*g_+2]=nb##h##_[g_][2]-mh_;P[4*g_+3]=nb##h##_[g_][3]-mh_; } }
  bool resc=false;
  #define START(P0,P1) do{ const float rm=rowmax(P0,P1); resc=false; \
    { const float dl=(rm>-INFINITY)?rm:0.f; mhat=fadd_s(mhat,dl);     \
      _Pragma("unroll") for(int r=0;r<16;++r){P0[r]=fsub_s(P0[r],dl);P1[r]=fsub_s(P1[r],dl);} \
      } \
    _Pragma("unroll") for(int r=0;r<16;++r)P0[r]=__builtin_amdgcn_exp2f(P0[r]); }while(0)
  #define RESC() do{ if(resc){ asm volatile("s_waitcnt lgkmcnt(0)":::"memory"); \
      _Pragma("unroll") for(int d_=0;d_<2;++d_) _Pragma("unroll") for(int r=0;r<16;++r)o[d_][r]*=wsf[crow(r,hi)]; } }while(0)
  f32x16 pA0,pA1,pB0,pB1;
  int sl_prev=0,sl_cur=0,sl_next=SLOTB;
  #define ROT() do{sl_prev=sl_cur;sl_cur=sl_next;sl_next=(sl_next==(NSLOT-1)*SLOTB)?0:sl_next+SLOTB;}while(0)
  DMA_K(2,2*SLOTB);
  WAIT_BAR(3);
  qkt(pA0,pA1,Kbase,qr,negm,r32,hi);asm volatile("s_nop 15\n\ts_nop 7":"+v"(pA0),"+v"(pA1));ABIAS(pA0,pA1,0);CMASK(pA0,pA1,0);
  START(pA0,pA1);
  _Pragma("unroll") for(int r=0;r<16;++r)pA1[r]=__builtin_amdgcn_exp2f(pA1[r]);
  { BLD(true,1,0) BLD(true,1,1) BSUB(true,pB0,0) BSUB(true,pB1,1) }
  WAIT_BAR(0);
  DMA_K(3,0);DMA_V(1,SLOTB);
  ROT();
  kload8(kf,kp0+sl_cur);
  WAIT_BAR(2);
  s16x4 vlo[8],vhi[8]; u32x4 pw0,pw1,pw2,pw3;
  #define PKW(P,B) cvtpk_s(P[B],P[B+1])
  #define PAF(k) __builtin_bit_cast(bf16x8,pw##k)
  #define VFR(i) (bf16x8){vlo[i][0],vlo[i][1],vlo[i][2],vlo[i][3],vhi[i][0],vhi[i][1],vhi[i][2],vhi[i][3]}
  #define PIN(x) asm volatile("":"+v"(x))
  #define MX3(a,b,c) __builtin_fmaxf(__builtin_fmaxf((a),(b)),(c))
  #define GAPA(MF,A0,A1,A2,A3,W0,W1,PW) do{ MF; sacc+=A0; sacc+=A1; sacc+=A2; sacc+=A3; PIN(sacc); W0; W1; PIN(PW); SBAR(); }while(0)
  #define EX(v) __builtin_amdgcn_exp2f(v)
  #define GAPB(MF,X,B) do{ MF; X[B]=EX(X[B]); X[B+1]=EX(X[B+1]); X[B+2]=EX(X[B+2]); X[B+3]=EX(X[B+3]); PIN(X); SBAR(); }while(0)
  #define VRD(i) do{ vlo[i]=vtr(vp_+(((i)>>2)*4096+((i)&3)*1024)); vhi[i]=vtr(vp_+(((i)>>2)*4096+((i)&3)*1024+512)); }while(0)
  #define KRD(G,j) do{ if(G){ kload2(kf,kp0+sl_next,j); SBAR(); } }while(0)
  #define STEP(C0,C1,P0,P1,t,GK,GV,GL,GB) do{ SBAR(); \
    const lds_cptr vp_=vp0+sl_prev; \
    VRD(0); SBAR(); float sacc=(P0[0]+P0[1]); \
    GAPA(C0=__builtin_amdgcn_mfma_f32_32x32x16_bf16(kf[0],qr[0],C0,0,0,0), P0[2],P0[3],P0[4],P0[5],     pw0[0]=PKW(P0,0), pw0[1]=PKW(P0,2), pw0); \
    VRD(4); SBAR(); GAPA(C1=__builtin_amdgcn_mfma_f32_32x32x16_bf16(kf[1],qr[0],C1,0,0,0), P0[6],P0[7],P0[8],P0[9],     pw0[2]=PKW(P0,4), pw0[3]=PKW(P0,6), pw0); \
    VRD(1); SBAR(); GAPA(C0=__builtin_amdgcn_mfma_f32_32x32x16_bf16(kf[2],qr[1],C0,0,0,0),   P0[10],P0[11],P0[12],P0[13], pw1[0]=PKW(P0,8), pw1[1]=PKW(P0,10), pw1); \
    VRD(5); SBAR(); GAPA(C1=__builtin_amdgcn_mfma_f32_32x32x16_bf16(kf[3],qr[1],C1,0,0,0),   P0[14],P0[15],P1[0],P1[1],   pw1[2]=PKW(P0,12),pw1[3]=PKW(P0,14), pw1); \
    VRD(2); SBAR(); GAPA(C0=__builtin_amdgcn_mfma_f32_32x32x16_bf16(kf[4],qr[2],C0,0,0,0),   P1[2],P1[3],P1[4],P1[5],     pw2[0]=PKW(P1,0), pw2[1]=PKW(P1,2), pw2); \
    VRD(6); SBAR(); GAPA(C1=__builtin_amdgcn_mfma_f32_32x32x16_bf16(kf[5],qr[2],C1,0,0,0),   P1[6],P1[7],P1[8],P1[9],     pw2[2]=PKW(P1,4), pw2[3]=PKW(P1,6), pw2); \
    VRD(3); SBAR(); GAPA(C0=__builtin_amdgcn_mfma_f32_32x32x16_bf16(kf[6],qr[3],C0,0,0,0),   P1[10],P1[11],P1[12],P1[13], pw3[0]=PKW(P1,8), pw3[1]=PKW(P1,10), pw3); \
    VRD(7); SBAR(); GAPA(C1=__builtin_amdgcn_mfma_f32_32x32x16_bf16(kf[7],qr[3],C1,0,0,0),   P1[14],P1[15],0.f,0.f,       pw3[2]=PKW(P1,12),pw3[3]=PKW(P1,14), pw3); \
    l_reg+=sacc; \
    if(GK){DMA_K((t)+3,sl_cur);} if(GV){DMA_V((t)+1,sl_next);} \
    CMASK(C0,C1,t); \
    { float a=MX3(C0[0],C0[1],C1[0]),b=MX3(C0[2],C0[3],C1[1]); a=MX3(a,C1[2],C1[3]); \
      _Pragma("unroll") for(int r=4;r<16;r+=4){a=MX3(a,C0[r],C0[r+1]);b=MX3(b,C0[r+2],C0[r+3]);a=MX3(a,C1[r],C1[r+1]);b=MX3(b,C1[r+2],C1[r+3]);} \
      float rm=__builtin_fmaxf(a,b); { auto rr=__builtin_amdgcn_permlane32_swap(__float_as_uint(rm),__float_as_uint(rm),false,false); rm=__builtin_fmaxf(__uint_as_float(rr[0]),__uint_as_float(rr[1])); } \
      resc=false; \
      if(__builtin_expect(__any(rm>(float)THRL),0)){ const float dl=__builtin_fmaxf(rm,0.f); mhat+=dl; \
        _Pragma("unroll") for(int r=0;r<16;++r){C0[r]-=dl;C1[r]-=dl;} \
        const float f=__builtin_amdgcn_exp2f(-dl); l_reg*=f; if(hi==0)wsf[r32]=f; resc=true; } } \
    SBAR(); \
    BLD(GB,(t)+1,0) SBAR(); \
    GAPB(o[0]=__builtin_amdgcn_mfma_f32_32x32x16_bf16(PAF(0),VFR(0),o[0],0,0,0), C0,0); \
    GAPB(o[1]=__builtin_amdgcn_mfma_f32_32x32x16_bf16(PAF(0),VFR(4),o[1],0,0,0), C0,4); \
    KRD(GL,0); GAPB(o[0]=__builtin_amdgcn_mfma_f32_32x32x16_bf16(PAF(1),VFR(1),o[0],0,0,0), C0,8); \
    KRD(GL,1); GAPB(o[1]=__builtin_amdgcn_mfma_f32_32x32x16_bf16(PAF(1),VFR(5),o[1],0,0,0), C0,12); \
    BSUB(GB,P0,0) BLD(GB,(t)+1,1) SBAR(); \
    KRD(GL,2); GAPB(o[0]=__builtin_amdgcn_mfma_f32_32x32x16_bf16(PAF(2),VFR(2),o[0],0,0,0), C1,0); \
    KRD(GL,3); GAPB(o[1]=__builtin_amdgcn_mfma_f32_32x32x16_bf16(PAF(2),VFR(6),o[1],0,0,0), C1,4); \
    GAPB(o[0]=__builtin_amdgcn_mfma_f32_32x32x16_bf16(PAF(3),VFR(3),o[0],0,0,0), C1,8); \
    GAPB(o[1]=__builtin_amdgcn_mfma_f32_32x32x16_bf16(PAF(3),VFR(7),o[1],0,0,0), C1,12); \
    BSUB(GB,P1,1) \
    }while(0)
  int t=1;
  #define ENDW(tt) do{ if((tt)+3<NT){WAIT_BAR(2);} else if((tt)+2<NT){WAIT_BAR(1);} else {WAIT_BAR(0);} }while(0)
  for(;t+1<NT&&t<5;t+=2){
    STEP(pB0,pB1,pA0,pA1,t,(t+3<NT),(t+1<NT),(t+1<NT),(t+1<NT));       ENDW(t);   RESC(); ROT();
    STEP(pA0,pA1,pB0,pB1,t+1,(t+4<NT),(t+2<NT),(t+2<NT),(t+2<NT));     ENDW(t+1); RESC(); ROT();
  }
  #undef CMASK
  #define CMASK(P0,P1,t) do{}while(0)
  for(;t+5<NT;t+=2){
    STEP(pB0,pB1,pA0,pA1,t,true,true,true,true);     WAIT_BAR(2); RESC(); ROT();
    STEP(pA0,pA1,pB0,pB1,t+1,true,true,true,true);   WAIT_BAR(2); RESC(); ROT();
  }
  for(;t+1<NT;t+=2){
    STEP(pB0,pB1,pA0,pA1,t,(t+3<NT),(t+1<NT),(t+1<NT),(t+1<NT));       ENDW(t);   RESC(); ROT();
    STEP(pA0,pA1,pB0,pB1,t+1,(t+4<NT),(t+2<NT),(t+2<NT),(t+2<NT));     ENDW(t+1); RESC(); ROT();
  }
  #undef CMASK
  #define CMASK(P0,P1,t) do{int jb_=3-(t); if(jb_>=0)cmask(P0,P1,jb_,qrel,hi);}while(0)
  STEP(pB0,pB1,pA0,pA1,NT-1,false,false,false,false); RESC();
  { float sacc=pB0[0]+pB0[1]; _Pragma("unroll") for(int r=2;r<16;++r)sacc+=pB0[r]; _Pragma("unroll") for(int r=0;r<16;++r)sacc+=pB1[r]; l_reg+=sacc;
    pw0=(u32x4){PKW(pB0,0),PKW(pB0,2),PKW(pB0,4),PKW(pB0,6)};pw1=(u32x4){PKW(pB0,8),PKW(pB0,10),PKW(pB0,12),PKW(pB0,14)};pw2=(u32x4){PKW(pB1,0),PKW(pB1,2),PKW(pB1,4),PKW(pB1,6)};pw3=(u32x4){PKW(pB1,8),PKW(pB1,10),PKW(pB1,12),PKW(pB1,14)};
    SBAR(); pv(o,vb0+sl_cur,PAF(0),PAF(1),PAF(2),PAF(3)); }
  #undef PKW
  #undef PAF
  #undef VFR
  #undef PIN
  #undef MX3
  #undef GAPA
  #undef GAPB
  #undef EX
  #undef VRD
  #undef KRD
  #undef STEP
  #undef ENDW
  {auto rr=__builtin_amdgcn_permlane32_swap(__float_as_uint(l_reg),__float_as_uint(l_reg),false,false);l_reg=__uint_as_float(rr[0])+__uint_as_float(rr[1]);}
  if(hi==0)wsf[32+r32]=l_reg;asm volatile("s_waitcnt lgkmcnt(0)":::"memory");
  float rli[16];
  #pragma unroll
  for(int r=0;r<16;++r)rli[r]=__builtin_amdgcn_rcpf(wsf[32+crow(r,hi)]);
  bf16*Ow=O+(rowbase+q0+wid*QBLK)*DM+h*D;
  { bf16*stg=(bf16*)(shm+LDS_OST)+wid*2048;
    #pragma unroll
    for(int r=0;r<16;++r){const int orow=crow(r,hi);
      #pragma unroll
      for(int d0=0;d0<2;++d0)stg[orow*64+d0*32+r32]=__float2bfloat16(o[d0][r]*rli[r]);}
    asm volatile("s_waitcnt lgkmcnt(0)":::"memory");
    #pragma unroll
    for(int i=0;i<4;++i){const int row=i*8+(lane>>3),ch=lane&7; const u32x4 v=*(const u32x4*)(stg+row*64+ch*8); ATTN_STORE16(Ow+(long)row*DM+ch*8,v);} }
  asm volatile("s_waitcnt lgkmcnt(0)\n\ts_barrier":::"memory");
  #undef DMA_K
  #undef TIDX
  #undef DMA_V
  #undef CMASK
  #undef ABIAS
  #undef BLD
  #undef BSUB
  #undef START
  #undef RESC
  #undef ROT
}
constexpr int ATTN_LDS_BYTES=LDS_BYTES;
#undef SBAR
#undef WAIT_BAR
}

#ifndef LAS
#define LAS __attribute__((address_space(3)))
#endif
constexpr int MK_WAVES = 8;
namespace pg8 { __device__ __forceinline__ unsigned cvt_pk_bf16(float lo, float hi); }

namespace sb_body {
typedef short bf16x8 __attribute__((ext_vector_type(8)));
typedef float f32x16 __attribute__((ext_vector_type(16)));
__device__ __forceinline__ void sb_head(LAS unsigned char* lds, int bh, const bf16_t* Q, const bf16_t* K, const bf16_t* V, bf16_t* O) {
    int tid_ = threadIdx.x; asm volatile("" : "+v"(tid_));
    const int lane = tid_ & 63, wid = __builtin_amdgcn_readfirstlane(tid_ >> 6), r32 = lane & 31, hi = lane >> 5;
    const int b = bh / NH, hh = bh % NH; const size_t rowb = (size_t)b * SEQ;
    const bf16_t* Qh = Q + rowb * DM + hh * HD; const bf16_t* Kh = K + rowb * DM + hh * HD; const bf16_t* Vh = V + rowb * DM + hh * HD; bf16_t* Oh = O + rowb * DM + hh * HD;
    LAS unsigned char* slot0 = lds + wid * 16384;
    const int vb0 = (int)(unsigned)(size_t)slot0 + ((lane >> 4) & 1) * 32 + (lane & 3) * 8 + (4 * hi + ((lane & 15) >> 2)) * 64;
    const bf16_t* vsrc0 = Vh + (size_t)(lane >> 2) * DM + (lane & 3) * 8;
#define SB_DMAV(t, sc) do { _Pragma("unroll") for (int p_ = 0; p_ < 8; ++p_) \
        __builtin_amdgcn_global_load_lds((const unsigned*)(vsrc0 + (size_t)(64 * (t) + 16 * (p_ & 3)) * DM + 32 * (p_ >> 2)), (LAS unsigned*)(slot0 + (sc) * 8192 + p_ * 1024), 16, 0, 0); } while (0)
#define SB_LOADK(kf, t) do { const bf16_t* kp_ = Kh + (size_t)(64 * (t) + r32) * DM + 8 * hi; _Pragma("unroll") for (int d0_ = 0; d0_ < 4; ++d0_) { \
        kf[2 * d0_] = *(const bf16x8*)(kp_ + 16 * d0_); kf[2 * d0_ + 1] = *(const bf16x8*)(kp_ + (size_t)32 * DM + 16 * d0_); } } while (0)
    for (int uu = wid; uu < SEQ / 32; uu += MK_WAVES) {
        const int q0w = uu * 32, qabs = q0w + r32;
        bf16x8 qr[4];
#pragma unroll
        for (int d0 = 0; d0 < 4; ++d0) qr[d0] = *(const bf16x8*)(Qh + (size_t)qabs * DM + d0 * 16 + hi * 8);
        f32x16 o[2]; o[0] = f32x16{}; o[1] = f32x16{};
        float carry = 1.f; int jt = (q0w + 30) >> 6, sc = 0; bool first = true;
        bf16x8 kf[8], kfn[8];
        SB_DMAV(jt, 0); asm volatile("" ::: "memory"); SB_LOADK(kf, jt);
        for (;;) {
            f32x16 p0 = f32x16{}, p1 = f32x16{};
#pragma unroll
            for (int d0 = 0; d0 < 4; ++d0) { p0 = __builtin_amdgcn_mfma_f32_32x32x16_bf16(kf[2 * d0], qr[d0], p0, 0, 0, 0); p1 = __builtin_amdgcn_mfma_f32_32x32x16_bf16(kf[2 * d0 + 1], qr[d0], p1, 0, 0, 0); }
            const bool more = jt > 0;
            asm volatile("" ::: "memory");
            if (more) { SB_DMAV(jt - 1, sc ^ 1); asm volatile("" ::: "memory"); SB_LOADK(kfn, jt - 1); }
            asm volatile("" ::: "memory");
            float nb[8][4], be[8][4];
#pragma unroll
            for (int w = 0; w < 8; ++w)
#pragma unroll
                for (int i = 0; i < 4; ++i) { const int r = (w & 3) * 4 + i; float x = (w < 4) ? p0[r] : p1[r]; x = fminf(x, 64.f);
                    const float e = __builtin_amdgcn_exp2f(x), rr = __builtin_amdgcn_rcpf(1.f + e);
                    const int kv = 64 * jt + 32 * (w >> 2) + 8 * (w & 3) + 4 * hi + i; const bool valid = !first || (kv < qabs);
                    be[w][i] = valid ? e * rr : 0.f; nb[w][i] = valid ? rr : 1.f; }
            float Xs[8];
            float Te[8], To[8];
#pragma unroll
            for (int w = 0; w < 8; ++w) { const float s2 = nb[w][3], s1 = s2 * nb[w][2], s0 = s1 * nb[w][1], T = s0 * nb[w][0];
                be[w][2] *= s2; be[w][1] *= s1; be[w][0] *= s0;
                auto rr2 = __builtin_amdgcn_permlane32_swap(__float_as_uint(T), __float_as_uint(T), false, false); Te[w] = __uint_as_float(rr2[0]); To[w] = __uint_as_float(rr2[1]); }
            float W = 1.f;
#pragma unroll
            for (int w = 7; w >= 0; --w) { const float xe = W * To[w]; Xs[w] = hi ? W : xe; W = xe * Te[w]; }
            unsigned pw[16];
#pragma unroll
            for (int w = 0; w < 8; ++w) { const float sc2 = Xs[w] * carry; pw[2 * w] = pg8::cvt_pk_bf16(be[w][0] * sc2, be[w][1] * sc2); pw[2 * w + 1] = pg8::cvt_pk_bf16(be[w][2] * sc2, be[w][3] * sc2); }
            carry *= W;
            const bf16x8 pa0 = __builtin_bit_cast(bf16x8, (u32x4){pw[0], pw[1], pw[2], pw[3]}), pa1 = __builtin_bit_cast(bf16x8, (u32x4){pw[4], pw[5], pw[6], pw[7]});
            const bf16x8 pa2 = __builtin_bit_cast(bf16x8, (u32x4){pw[8], pw[9], pw[10], pw[11]}), pa3 = __builtin_bit_cast(bf16x8, (u32x4){pw[12], pw[13], pw[14], pw[15]});
            if (more) asm volatile("s_waitcnt vmcnt(16)" ::: "memory"); else asm volatile("s_waitcnt vmcnt(0)" ::: "memory");
            attn_body::pv(o, vb0 + sc * 8192, pa0, pa1, pa2, pa3);
            if (!more || __all(carry < 1e-12f)) break;
#pragma unroll
            for (int i = 0; i < 8; ++i) kf[i] = kfn[i];
            sc ^= 1; --jt; first = false;
        }
#pragma unroll
        for (int d0 = 0; d0 < 2; ++d0)
#pragma unroll
            for (int r = 0; r < 16; ++r) Oh[(size_t)(q0w + crow(r, hi)) * DM + d0 * 32 + r32] = (bf16_t)f2bf(o[d0][r]);
    }
#undef SB_DMAV
#undef SB_LOADK
}
}

#ifndef LAS
#define LAS __attribute__((address_space(3)))
#endif
#define GAS __attribute__((address_space(1)))
constexpr size_t WS_SS = WS_END;
constexpr size_t WS_WR = WS_SS + 2 * MiB;
constexpr size_t WS_WF = WS_WR + 1 * MiB;
constexpr size_t WS_HB2 = WS_WF + 1 * MiB;
constexpr size_t WS_WGU8 = WS_HB2 + 64 * MiB;
constexpr size_t WS_WD8 = WS_WGU8 + 128 * MiB;
constexpr size_t WS_HB8 = WS_WD8 + 64 * MiB;
constexpr size_t WS_ACT8 = WS_HB8 + 32 * MiB;
constexpr size_t WS_WG8 = WS_ACT8 + 136 * MiB;
constexpr size_t WS_END2 = WS_WG8 + 2 * MiB;
#ifndef MK_PLE8
#define MK_PLE8 1
#endif
#ifndef MK_FP8_MASK
#define MK_FP8_MASK 0
#endif
constexpr float W8SCALE = 256.f, W8INV = 1.f / 256.f;
constexpr int CW_BAR = 4096;
constexpr int CW_CNT2 = 16384, CNT_STRIDE = 64;


__device__ __forceinline__ float lperm(float v, int src) { return __builtin_bit_cast(float, __builtin_amdgcn_ds_bpermute(src << 2, __builtin_bit_cast(int, v))); }
__device__ __forceinline__ int lpermi(int v, int src) { return __builtin_amdgcn_ds_bpermute(src << 2, v); }
__device__ __forceinline__ float lwave_sum(float v, int lane) {
#pragma unroll
    for (int o = 1; o < 64; o <<= 1) v += lperm(v, lane ^ o);
    return v;
}
namespace pg8 {
constexpr int BM = 256, BK = 64, HALF = 128, HTB = HALF * BK * 2, STAGE_BYTES = 8 * HTB, NXCD = 8, WGM = 8;
__device__ __forceinline__ int lds_byte(int r, int c) { const int st = (r >> 4) * 2 + (c >> 5), rr = r & 15, cc = c & 31, ob = rr * 64 + cc * 2; return st * 1024 + (ob ^ (((ob >> 9) & 1) << 5)); }
__device__ __forceinline__ void stage_rc(int b, int& R, int& C) { const int st = b / 1024, sb = b % 1024, swz = sb ^ (((sb >> 9) & 1) << 5); R = (st >> 1) * 16 + swz / 64; C = (st & 1) * 32 + (swz % 64) / 2; }
__device__ __forceinline__ int perm32(int rho) { const int n = rho >> 4, i = rho & 15; return 8 * (i >> 2) + 4 * n + (i & 3); }
__device__ __forceinline__ unsigned cvt_pk_bf16(float lo, float hi) { unsigned r; asm volatile("v_cvt_pk_bf16_f32 %0, %1, %2" : "=v"(r) : "v"(lo), "v"(hi)); return r; }

struct Unit { int arow0, brow0, pn, e, rank0, cnt, ui; };

__device__ __forceinline__ int xcd_remap(int L, int nwg) { const int q = nwg / NXCD, r = nwg % NXCD, xcd = L % NXCD, off = L / NXCD; return (xcd < r ? xcd * (q + 1) : r * (q + 1) + (xcd - r) * q) + off; }

struct DenseOrder {
    int nM, nN, nwg, G, c;
    __device__ __forceinline__ void init(int M, int N, int G_, int c_) { nM = M / BM; nN = N / BM; nwg = nM * nN; G = G_; c = c_; }
    __device__ __forceinline__ bool next(int i, Unit& u) const {
        const long L = (long)i * G + c; if (L >= nwg) return false;
        const int wgid = xcd_remap((int)L, nwg);
        const int nig = WGM * nN, gid = wgid / nig, fm = gid * WGM, gsz = (nM - fm) < WGM ? (nM - fm) : WGM;
        const int pm = fm + ((wgid % nig) % gsz), pn = (wgid % nig) / gsz;
        u.arow0 = pm * BM; u.brow0 = pn * BM; u.pn = pn; u.e = 0; u.rank0 = 0; u.cnt = 0; u.ui = i; return true;
    }
    __device__ __forceinline__ int arow(const Unit& u, int lr) const { return u.arow0 + lr; }
};
struct HotOrder {
    DenseOrder d;
    __device__ __forceinline__ bool next(int i, Unit& u) const { const bool ok = d.next(i, u); u.arow0 = 0; u.brow0 = 0; u.pn = 0; return ok; }
    __device__ __forceinline__ int arow(const Unit& u, int lr) const { return lr; }
};
struct PJOrder {
    DenseOrder d; int G, c;
    __device__ __forceinline__ void init(int G_, int c_) { d.init(NTOK, DM, G_, 0); G = G_; c = c_; }
    __device__ __forceinline__ bool next(int i, Unit& u) const {
        const long L = (long)i * G + c; if (L >= 2 * d.nwg) return false;
        const int l2 = (L >= d.nwg) ? 1 : 0; const int wgid = xcd_remap((int)L - l2 * d.nwg, d.nwg);
        const int nig = WGM * d.nN, gid = wgid / nig, fm = gid * WGM, gsz = (d.nM - fm) < WGM ? (d.nM - fm) : WGM;
        const int pm = fm + ((wgid % nig) % gsz), pn = (wgid % nig) / gsz;
        u.arow0 = l2 * NTOK + pm * BM; u.brow0 = l2 * DM + pn * BM; u.pn = pn; u.e = 0; u.rank0 = 0; u.cnt = 0; u.ui = i; return true;
    }
    __device__ __forceinline__ int arow(const Unit& u, int lr) const { return u.arow0 + lr; }
};
struct MoeOrder {
    int NN, nwg, G, c, lane; const LAS int* tstartL; const LAS int* cntL; const LAS unsigned short* tokL; bool gather;
    __device__ __forceinline__ bool next(int i, Unit& u) const {
        const long L = (long)i * G + c; if (L >= nwg) return false;
        const int wgid = xcd_remap((int)L, nwg);
        const int T = wgid / NN, pn = wgid - T * NN;
        const int lo = (lane < NE) ? tstartL[lane] : 0x7fffffff, hi = (lane < NE) ? tstartL[lane + 1] : 0x7fffffff;
        const unsigned long long m = __ballot(lo <= T && T < hi);
        const int e = __builtin_amdgcn_readfirstlane((int)__builtin_ctzll(m | (1ull << 63)));
        u.e = e; u.rank0 = (T - tstartL[e]) * 256; u.cnt = cntL[e]; u.arow0 = T * 256; u.brow0 = (e * NN + pn) * 256; u.pn = pn; u.ui = i; return true;
    }
    __device__ __forceinline__ int arow(const Unit& u, int lr) const { return gather ? (int)tokL[u.ui * 256 + lr] : u.arow0 + lr; }
};

typedef const f32x4 (&AccRef)[2][2][4][2];
struct EpiQKV {
    bf16_t* Q; const LAS float* rowL; int probe;
    __device__ __forceinline__ void operator()(AccRef acc, const Unit& u, int wr, int wc, int fr, int fq) const {
        const int t = u.brow0 >> 10, colt = u.brow0 & 1023; bf16_t* base = Q + (size_t)t * ((size_t)NTOK * DM); const float sc = (t == 0) ? C2 : 1.f;
        const int col0 = colt + wc * 32 + 8 * fq;
#pragma unroll
        for (int ai = 0; ai < 2; ++ai)
#pragma unroll
            for (int m = 0; m < 4; ++m) { const int lr = ai * HALF + wr * 64 + m * 16 + fr; const int row = u.arow0 + lr;
                const float rs = rowL[u.ui * 256 + lr] * sc; bf16_t* rowp = base + (size_t)row * DM + col0;
#pragma unroll
                for (int bj = 0; bj < 2; ++bj) { const f32x4 v0 = acc[ai][bj][m][0] * rs, v1 = acc[ai][bj][m][1] * rs; u32x4 w;
                    w.x = cvt_pk_bf16(v0[0], v0[1]); w.y = cvt_pk_bf16(v0[2], v0[3]); w.z = cvt_pk_bf16(v1[0], v1[1]); w.w = cvt_pk_bf16(v1[2], v1[3]);
                    if (probe == 1) asm volatile("" :: "v"(w)); else if (probe == 2) __builtin_nontemporal_store(w, (u32x4*)(rowp + bj * HALF)); else *(u32x4*)(rowp + bj * HALF) = w; } }
    }
};
struct EpiPJ {
    bf16_t* O;
    __device__ __forceinline__ void operator()(AccRef acc, const Unit& u, int wr, int wc, int fr, int fq) const {
        const int col0 = u.pn * BM + wc * 32 + 8 * fq;
#pragma unroll
        for (int ai = 0; ai < 2; ++ai)
#pragma unroll
            for (int m = 0; m < 4; ++m) { const int row = u.arow0 + ai * HALF + wr * 64 + m * 16 + fr; bf16_t* rowp = O + (size_t)row * DM + col0;
#pragma unroll
                for (int bj = 0; bj < 2; ++bj) { const f32x4 v0 = acc[ai][bj][m][0], v1 = acc[ai][bj][m][1]; u32x4 w;
                    w.x = cvt_pk_bf16(v0[0], v0[1]); w.y = cvt_pk_bf16(v0[2], v0[3]); w.z = cvt_pk_bf16(v1[0], v1[1]); w.w = cvt_pk_bf16(v1[2], v1[3]); *(u32x4*)(rowp + bj * HALF) = w; } }
    }
};
struct EpiWo {
    const bf16_t* hin; bf16_t* hb; unsigned char* hb8;
    __device__ __forceinline__ void operator()(AccRef acc, const Unit& u, int wr, int wc, int fr, int fq) const {
        const int col0 = u.brow0 + wc * 32 + 8 * fq;
#pragma unroll
        for (int ai = 0; ai < 2; ++ai)
#pragma unroll
            for (int m = 0; m < 4; ++m) { const int row = u.arow0 + ai * HALF + wr * 64 + m * 16 + fr; const size_t off = (size_t)row * DM + col0;
#pragma unroll
                for (int bj = 0; bj < 2; ++bj) { const size_t o = off + bj * HALF; const u32x4 hv = *(const u32x4*)(hin + o); const f32x4 a0 = acc[ai][bj][m][0], a1 = acc[ai][bj][m][1]; u32x4 w;
                    if (hb8) { unsigned p0 = 0u, p1 = 0u; p0 = __builtin_amdgcn_cvt_pk_fp8_f32(__uint_as_float(hv.x << 16) + a0[0], __uint_as_float(hv.x & 0xffff0000u) + a0[1], p0, false); p0 = __builtin_amdgcn_cvt_pk_fp8_f32(__uint_as_float(hv.y << 16) + a0[2], __uint_as_float(hv.y & 0xffff0000u) + a0[3], p0, true);
                        p1 = __builtin_amdgcn_cvt_pk_fp8_f32(__uint_as_float(hv.z << 16) + a1[0], __uint_as_float(hv.z & 0xffff0000u) + a1[1], p1, false); p1 = __builtin_amdgcn_cvt_pk_fp8_f32(__uint_as_float(hv.w << 16) + a1[2], __uint_as_float(hv.w & 0xffff0000u) + a1[3], p1, true);
                        *(u32x2*)(hb8 + o) = (u32x2){p0, p1}; }
                    w.x = cvt_pk_bf16(__uint_as_float(hv.x << 16) + a0[0], __uint_as_float(hv.x & 0xffff0000u) + a0[1]); w.y = cvt_pk_bf16(__uint_as_float(hv.y << 16) + a0[2], __uint_as_float(hv.y & 0xffff0000u) + a0[3]);
                    w.z = cvt_pk_bf16(__uint_as_float(hv.z << 16) + a1[0], __uint_as_float(hv.z & 0xffff0000u) + a1[1]); w.w = cvt_pk_bf16(__uint_as_float(hv.w << 16) + a1[2], __uint_as_float(hv.w & 0xffff0000u) + a1[3]);
                    *(u32x4*)(hb + o) = w; }
                if (m & 1) asm volatile("" ::: "memory"); }
    }
};
__device__ __forceinline__ float fast_sigmoid(float x) { return __builtin_amdgcn_rcpf(1.f + __builtin_amdgcn_exp2f(-LOG2E * x)); }
struct EpiPLE {
    const bf16_t* hin; bf16_t* hb; const bf16_t* PJ; const LAS float* rowL; float* SS;
    __device__ __forceinline__ void operator()(AccRef acc, const Unit& u, int wr, int wc, int fr, int fq) const {
        const int col0 = u.brow0 + wc * 32 + 8 * fq;
#pragma unroll
        for (int ai = 0; ai < 2; ++ai)
#pragma unroll
            for (int m = 0; m < 4; ++m) { const int lr = ai * HALF + wr * 64 + m * 16 + fr; const int row = u.arow0 + lr; const size_t off = (size_t)row * DM + col0; const float rs = rowL[u.ui * 256 + lr]; float ssq = 0.f;
#pragma unroll
                for (int bj = 0; bj < 2; ++bj) { const size_t o = off + bj * HALF; const u32x4 pj = *(const u32x4*)(PJ + o); const u32x4 hv = *(const u32x4*)(hin + o);
                    const f32x4 a0 = acc[ai][bj][m][0] * rs, a1 = acc[ai][bj][m][1] * rs; float x[8];
                    x[0] = __uint_as_float(hv.x << 16) + fast_sigmoid(a0[0]) * __uint_as_float(pj.x << 16); x[1] = __uint_as_float(hv.x & 0xffff0000u) + fast_sigmoid(a0[1]) * __uint_as_float(pj.x & 0xffff0000u);
                    x[2] = __uint_as_float(hv.y << 16) + fast_sigmoid(a0[2]) * __uint_as_float(pj.y << 16); x[3] = __uint_as_float(hv.y & 0xffff0000u) + fast_sigmoid(a0[3]) * __uint_as_float(pj.y & 0xffff0000u);
                    x[4] = __uint_as_float(hv.z << 16) + fast_sigmoid(a1[0]) * __uint_as_float(pj.z << 16); x[5] = __uint_as_float(hv.z & 0xffff0000u) + fast_sigmoid(a1[1]) * __uint_as_float(pj.z & 0xffff0000u);
                    x[6] = __uint_as_float(hv.w << 16) + fast_sigmoid(a1[2]) * __uint_as_float(pj.w << 16); x[7] = __uint_as_float(hv.w & 0xffff0000u) + fast_sigmoid(a1[3]) * __uint_as_float(pj.w & 0xffff0000u);
                    u32x4 w; w.x = cvt_pk_bf16(x[0], x[1]); w.y = cvt_pk_bf16(x[2], x[3]); w.z = cvt_pk_bf16(x[4], x[5]); w.w = cvt_pk_bf16(x[6], x[7]); *(u32x4*)(hb + o) = w;
                    float q0 = __uint_as_float(w.x << 16), q1 = __uint_as_float(w.x & 0xffff0000u), q2 = __uint_as_float(w.y << 16), q3 = __uint_as_float(w.y & 0xffff0000u);
                    float q4 = __uint_as_float(w.z << 16), q5 = __uint_as_float(w.z & 0xffff0000u), q6 = __uint_as_float(w.w << 16), q7 = __uint_as_float(w.w & 0xffff0000u);
                    ssq += (q0 * q0 + q1 * q1) + (q2 * q2 + q3 * q3) + (q4 * q4 + q5 * q5) + (q6 * q6 + q7 * q7); }
                { const int ln_ = fr + 16 * fq; ssq += lperm(ssq, ln_ ^ 16); ssq += lperm(ssq, ln_ ^ 32); }
                if (fq == 0) SS[(size_t)row * 16 + u.pn * 4 + wc] = ssq;
                asm volatile("" ::: "memory"); }
    }
};
template <bool OUT8> struct EpiGU {
    void* ACT; const float* bgu; const LAS float* rowL;
    __device__ __forceinline__ void operator()(AccRef acc, const Unit& u, int wr, int wc, int fr, int fq) const {
        const int jc = u.pn * 128 + wc * 32 + 8 * fq; const float* bp = bgu + (size_t)u.e * (2 * FF) + jc;
        const f32x4 bg0 = *(const f32x4*)(bp), bg1 = *(const f32x4*)(bp + 4), bl0 = *(const f32x4*)(bp + FF), bl1 = *(const f32x4*)(bp + FF + 4);
#pragma unroll
        for (int ai = 0; ai < 2; ++ai)
#pragma unroll
            for (int m = 0; m < 4; ++m) { const int lr = ai * HALF + wr * 64 + m * 16 + fr; const float rs = rowL[u.ui * 256 + lr];
                const f32x4 g0 = __builtin_elementwise_min(acc[ai][0][m][0] * rs + bg0, (f32x4){7.f, 7.f, 7.f, 7.f}), g1 = __builtin_elementwise_min(acc[ai][0][m][1] * rs + bg1, (f32x4){7.f, 7.f, 7.f, 7.f});
                const f32x4 l0 = __builtin_elementwise_min(__builtin_elementwise_max(acc[ai][1][m][0] * rs + bl0, (f32x4){-7.f, -7.f, -7.f, -7.f}), (f32x4){7.f, 7.f, 7.f, 7.f}) + 1.f;
                const f32x4 l1 = __builtin_elementwise_min(__builtin_elementwise_max(acc[ai][1][m][1] * rs + bl1, (f32x4){-7.f, -7.f, -7.f, -7.f}), (f32x4){7.f, 7.f, 7.f, 7.f}) + 1.f;
                const f32x4 x0 = g0 * (-1.702f * LOG2E), x1 = g1 * (-1.702f * LOG2E); f32x4 e0, e1;
#pragma unroll
                for (int c = 0; c < 4; ++c) { e0[c] = __builtin_amdgcn_exp2f(x0[c]); e1[c] = __builtin_amdgcn_exp2f(x1[c]); }
                const f32x4 d0 = e0 + 1.f, d1 = e1 + 1.f; f32x4 s0, s1;
#pragma unroll
                for (int c = 0; c < 4; ++c) { s0[c] = __builtin_amdgcn_rcpf(d0[c]); s1[c] = __builtin_amdgcn_rcpf(d1[c]); }
                const f32x4 a0 = (g0 * l0) * s0, a1 = (g1 * l1) * s1; const float a[8] = {a0[0], a0[1], a0[2], a0[3], a1[0], a1[1], a1[2], a1[3]};
                if constexpr (OUT8) { unsigned p0 = 0u, p1 = 0u; p0 = __builtin_amdgcn_cvt_pk_fp8_f32(a[0], a[1], p0, false); p0 = __builtin_amdgcn_cvt_pk_fp8_f32(a[2], a[3], p0, true); p1 = __builtin_amdgcn_cvt_pk_fp8_f32(a[4], a[5], p1, false); p1 = __builtin_amdgcn_cvt_pk_fp8_f32(a[6], a[7], p1, true);
                    *(u32x2*)((unsigned char*)ACT + (size_t)(u.arow0 + lr) * FF + jc) = (u32x2){p0, p1}; }
                else { u32x4 w; w.x = cvt_pk_bf16(a[0], a[1]); w.y = cvt_pk_bf16(a[2], a[3]); w.z = cvt_pk_bf16(a[4], a[5]); w.w = cvt_pk_bf16(a[6], a[7]);
                    *(u32x4*)((bf16_t*)ACT + (size_t)(u.arow0 + lr) * FF + jc) = w; } }
    }
};
struct EpiDown {
    bf16_t* Y; const float* bd; const LAS float* rowL; float bscale;
    __device__ __forceinline__ void operator()(AccRef acc, const Unit& u, int wr, int wc, int fr, int fq) const {
        const int col0 = u.pn * 256 + wc * 32 + 8 * fq; const float* bp = bd + (size_t)u.e * DM + col0;
        f32x4 bv[2][2];
#pragma unroll
        for (int bj = 0; bj < 2; ++bj) { bv[bj][0] = *(const f32x4*)(bp + bj * HALF) * bscale; bv[bj][1] = *(const f32x4*)(bp + bj * HALF + 4) * bscale; }
#pragma unroll
        for (int ai = 0; ai < 2; ++ai)
#pragma unroll
            for (int m = 0; m < 4; ++m) { const int lr = ai * HALF + wr * 64 + m * 16 + fr; const float gt = rowL[u.ui * 256 + lr];
                bf16_t* rowp = Y + (size_t)(u.arow0 + lr) * DM + col0;
#pragma unroll
                for (int bj = 0; bj < 2; ++bj) { const f32x4 v0 = (acc[ai][bj][m][0] + bv[bj][0]) * gt, v1 = (acc[ai][bj][m][1] + bv[bj][1]) * gt; u32x4 w;
                    w.x = cvt_pk_bf16(v0[0], v0[1]); w.y = cvt_pk_bf16(v0[2], v0[3]); w.z = cvt_pk_bf16(v1[0], v1[1]); w.w = cvt_pk_bf16(v1[2], v1[3]); *(u32x4*)(rowp + bj * HALF) = w; } }
    }
};

typedef int v8i_t __attribute__((ext_vector_type(8))); typedef int v4i_t __attribute__((ext_vector_type(4)));
template <class Epi, class Sched, bool FP8 = false>
__device__ __forceinline__ void gemm_phase(LAS unsigned char* lds, const void* gA, const void* gBt, const int KB, const Sched& S, const Epi& E, const bool skip_epi = false) {
    int tid_ = threadIdx.x; asm volatile("" : "+v"(tid_));
    const int tid = tid_, wid = __builtin_amdgcn_readfirstlane(tid >> 6), lane = tid & 63, wr = wid >> 2, wc = wid & 3, fr = lane & 15, fq = lane >> 4;
    const int nt = KB / (BK * 2);
    unsigned voffB[2];
#pragma unroll
    for (int i = 0; i < 2; ++i) { int R, C; stage_rc(tid * 16 + i * 8192, R, C); const int Rb = (R & ~31) + perm32(R & 31); voffB[i] = (unsigned)(Rb * KB + C * 2); }
#define PG8_AOFF(u, o0, o1) do { int t2_ = threadIdx.x; asm volatile("" : "+v"(t2_)); _Pragma("unroll") for (int i = 0; i < 2; ++i) { int R, C; stage_rc(t2_ * 16 + i * 8192, R, C); \
        o0[i] = (unsigned)S.arow(u, R) * (unsigned)KB + (unsigned)C * 2u; o1[i] = (unsigned)S.arow(u, HALF + R) * (unsigned)KB + (unsigned)C * 2u; } } while (0)
    const unsigned kstep = (unsigned)(BK * 2);
    const unsigned hstep = (unsigned)HALF * (unsigned)KB;
    const unsigned ldsw = (unsigned)wid * 1024u;
    unsigned rdA_ = (unsigned)(size_t)lds + (unsigned)lds_byte(wr * 64 + fr, fq * 8), rdB_ = (unsigned)(size_t)lds + 4u * HTB + (unsigned)lds_byte(wc * 32 + fr, fq * 8);
    asm volatile("" : "+v"(rdA_), "+v"(rdB_));
    const LAS unsigned char* const rdA = (const LAS unsigned char*)(size_t)rdA_; const LAS unsigned char* const rdB = (const LAS unsigned char*)(size_t)rdB_;
#define PG8_SA(b, h) (((b) * 2 + (h)) * HTB)
#define PG8_SB(b, h) ((4 + (b) * 2 + (h)) * HTB)
#define PG8_STAGE(bufoff, rs, voff, soff) do { _Pragma("unroll") for (int _i = 0; _i < 2; ++_i) \
        __builtin_amdgcn_raw_ptr_buffer_load_lds(rs, (LAS void*)(lds + (bufoff) + ldsw + _i * 8192), 16, (voff)[_i], (unsigned)(soff), 0, 0); } while (0)
#define PG8_RA(b, h) (((b) * 2 + (h)) * HTB)
#define PG8_LD16A(off) __builtin_bit_cast(v4i_t, *(const LAS bf16x8*)(rdA + (off)))
#define PG8_LD16B(off) __builtin_bit_cast(v4i_t, *(const LAS bf16x8*)(rdB + (off)))
#define PG8_LDA(dst, b, h) do { if constexpr (FP8) { _Pragma("unroll") for (int m = 0; m < 4; ++m) dst##8[m] = __builtin_shufflevector(PG8_LD16A(PG8_RA(b, h) + m * 2048), PG8_LD16A(PG8_RA(b, h) + m * 2048 + 1024), 0, 1, 2, 3, 4, 5, 6, 7); } \
        else { _Pragma("unroll") for (int m = 0; m < 4; ++m) _Pragma("unroll") for (int k = 0; k < 2; ++k) dst[m][k] = *(const LAS bf16x8*)(rdA + PG8_RA(b, h) + m * 2048 + k * 1024); } } while (0)
#define PG8_LDB(dst, b, h) do { if constexpr (FP8) { _Pragma("unroll") for (int n = 0; n < 2; ++n) dst##8[n] = __builtin_shufflevector(PG8_LD16B(PG8_RA(b, h) + n * 2048), PG8_LD16B(PG8_RA(b, h) + n * 2048 + 1024), 0, 1, 2, 3, 4, 5, 6, 7); } \
        else { _Pragma("unroll") for (int n = 0; n < 2; ++n) _Pragma("unroll") for (int k = 0; k < 2; ++k) dst[n][k] = *(const LAS bf16x8*)(rdB + PG8_RA(b, h) + n * 2048 + k * 1024); } } while (0)
#define PG8_MMA(ai, bj, At, Bt) do { __builtin_amdgcn_s_setprio(1); _Pragma("unroll") for (int m = 0; m < 4; ++m) _Pragma("unroll") for (int n = 0; n < 2; ++n) { \
            if constexpr (FP8) acc[ai][bj][m][n] = __builtin_amdgcn_mfma_scale_f32_16x16x128_f8f6f4(Bt##8[n], At##8[m], acc[ai][bj][m][n], 0, 0, 0, 0, 0, 0); \
            else { _Pragma("unroll") for (int k = 0; k < 2; ++k) acc[ai][bj][m][n] = __builtin_amdgcn_mfma_f32_16x16x32_bf16(Bt[n][k], At[m][k], acc[ai][bj][m][n], 0, 0, 0); } } __builtin_amdgcn_s_setprio(0); } while (0)
#define PG8_WAIT_V(n) asm volatile("s_waitcnt vmcnt(" #n ")" ::: "memory")
#define PG8_WAIT_L(n) asm volatile("s_waitcnt lgkmcnt(" #n ")" ::: "memory")
#define PG8_BAR __builtin_amdgcn_s_barrier()
#define PG8_SCHED __builtin_amdgcn_sched_barrier(0)
    Unit cur, nxt; int ui = 0;
    if (!S.next(0, cur)) return;
    f32x4 acc[2][2][4][2];
#pragma unroll
    for (int a = 0; a < 2; ++a)
#pragma unroll
        for (int b = 0; b < 2; ++b)
#pragma unroll
            for (int m = 0; m < 4; ++m)
#pragma unroll
                for (int n = 0; n < 2; ++n) acc[a][b][m][n] = (f32x4){0.f, 0.f, 0.f, 0.f};
    bf16x8 At[4][2], B0[2][2], B1[2][2];
    v8i_t At8[4], B08[2], B18[2];
    unsigned ao0[2], ao1[2];
    PG8_AOFF(cur, ao0, ao1);
    const __amdgpu_buffer_rsrc_t rsA = __builtin_amdgcn_make_buffer_rsrc((void*)gA, 0, 0x7fffffff, 0x00020000), rsB = __builtin_amdgcn_make_buffer_rsrc((void*)gBt, 0, 0x7fffffff, 0x00020000);
    unsigned cB = (unsigned)cur.brow0 * (unsigned)KB;
    PG8_STAGE(PG8_SB(0, 0), rsB, voffB, cB); PG8_STAGE(PG8_SB(0, 1), rsB, voffB, cB + hstep); PG8_STAGE(PG8_SA(0, 0), rsA, ao0, 0u); PG8_STAGE(PG8_SA(0, 1), rsA, ao1, 0u);
    if (wr == 1) PG8_BAR;
    PG8_WAIT_V(2); PG8_BAR;
    PG8_STAGE(PG8_SB(1, 0), rsB, voffB, cB + kstep); PG8_STAGE(PG8_SA(1, 0), rsA, ao0, kstep); PG8_STAGE(PG8_SB(1, 1), rsB, voffB, cB + hstep + kstep);
    PG8_WAIT_V(6); PG8_BAR;
    for (;;) {
        const bool has_next = S.next(ui + 1, nxt);
        const unsigned nB = has_next ? (unsigned)nxt.brow0 * (unsigned)KB : cB;
        _Pragma("clang loop unroll(disable)") for (int t = 0; t < nt; t += 2) {
            const bool last = (t == nt - 2);
            const unsigned a1 = (unsigned)(t + 1) * kstep;
            const unsigned a2 = last ? 0u : (unsigned)(t + 2) * kstep; const unsigned b2 = last ? nB : cB + (unsigned)(t + 2) * kstep;
            const unsigned a3 = a2 + kstep; const unsigned b3 = b2 + kstep;
            PG8_LDB(B0, 0, 0); PG8_LDB(B1, 0, 1); PG8_SCHED; PG8_LDA(At, 0, 0); PG8_STAGE(PG8_SA(1, 1), rsA, ao1, a1);
            if (last && has_next) { PG8_AOFF(nxt, ao0, ao1); }
            PG8_WAIT_V(8); PG8_WAIT_L(0); PG8_BAR; PG8_MMA(0, 0, At, B0); PG8_MMA(0, 1, At, B1); PG8_BAR; PG8_SCHED;
            PG8_LDA(At, 0, 1); PG8_STAGE(PG8_SB(0, 0), rsB, voffB, b2); PG8_STAGE(PG8_SB(0, 1), rsB, voffB, b2 + hstep); PG8_STAGE(PG8_SA(0, 0), rsA, ao0, a2);
            PG8_WAIT_V(8); PG8_WAIT_L(0); PG8_BAR; PG8_MMA(1, 0, At, B0); PG8_MMA(1, 1, At, B1); PG8_BAR; PG8_SCHED;
            PG8_LDB(B0, 1, 0); PG8_LDB(B1, 1, 1); PG8_SCHED; PG8_LDA(At, 1, 0); PG8_STAGE(PG8_SA(0, 1), rsA, ao1, a2);
            PG8_WAIT_V(8); PG8_WAIT_L(0); PG8_BAR; PG8_MMA(0, 0, At, B0); PG8_MMA(0, 1, At, B1); PG8_BAR; PG8_SCHED;
            PG8_LDA(At, 1, 1); PG8_STAGE(PG8_SB(1, 0), rsB, voffB, b3); PG8_STAGE(PG8_SB(1, 1), rsB, voffB, b3 + hstep); PG8_STAGE(PG8_SA(1, 0), rsA, ao0, a3);
            PG8_WAIT_V(8); PG8_WAIT_L(0); PG8_BAR; PG8_MMA(1, 0, At, B0); PG8_MMA(1, 1, At, B1); PG8_BAR; PG8_SCHED;
        }
        if (wr == 0) PG8_BAR;
        if (!skip_epi) E(acc, cur, wr, wc, fr, fq);
        if (!has_next) break;
#pragma unroll
        for (int a = 0; a < 2; ++a)
#pragma unroll
            for (int b = 0; b < 2; ++b)
#pragma unroll
                for (int m = 0; m < 4; ++m)
#pragma unroll
                    for (int n = 0; n < 2; ++n) acc[a][b][m][n] = (f32x4){0.f, 0.f, 0.f, 0.f};
        cur = nxt; cB = nB; ++ui;
        if (wr == 1) PG8_BAR;
    }
    PG8_WAIT_V(0);
    PG8_BAR;
#undef PG8_AOFF
#undef PG8_SA
#undef PG8_SB
#undef PG8_STAGE
#undef PG8_LDA
#undef PG8_LD16A
#undef PG8_LD16B
#undef PG8_RA
#undef PG8_LDB
#undef PG8_MMA
#undef PG8_WAIT_V
#undef PG8_WAIT_L
#undef PG8_BAR
#undef PG8_SCHED
}
}

#define XB_TMO      128
#define XB_XCNT(j)  (256  + 64 * (j))
#define XB_XSUB(j)  (1280 + 64 * (j))
#define XB_XGEN(j)  (2304 + 64 * (j))
#define XB_TOP      3328
#define XB_TOPGEN   3392
#define XCD_BAR_WORDS 3456
#define XB_SPIN_CAP (1u << 18)
__device__ __forceinline__ unsigned xb_ld(unsigned* p)              { return __hip_atomic_load(p, __ATOMIC_RELAXED, __HIP_MEMORY_SCOPE_AGENT); }
__device__ __forceinline__ unsigned xb_add(unsigned* p, unsigned v) { return __hip_atomic_fetch_add(p, v, __ATOMIC_RELAXED, __HIP_MEMORY_SCOPE_AGENT); }
__device__ __forceinline__ unsigned xb_xcc_id() { return (unsigned)__builtin_amdgcn_s_getreg((3 << 11) | 20) & 0xFu; }
#define XB_SPIN(cond, bar) do { unsigned _sp = 0; while (cond) { __builtin_amdgcn_s_sleep(1); \
    if ((++_sp & 255u) == 0u) { if (xb_ld(&(bar)[XB_TMO])) break; if (_sp > XB_SPIN_CAP) { atomicAdd(&(bar)[XB_TMO], 1u); break; } } } } while (0)
struct XcdBarrier { unsigned* bar; unsigned x; volatile LAS unsigned* st; };
__device__ __forceinline__ XcdBarrier xcd_barrier_post(unsigned* bar, volatile LAS unsigned* st) {
    XcdBarrier b; b.bar = bar; b.x = xb_xcc_id(); b.st = st;
    if (threadIdx.x == 0) (void)xb_add(&bar[XB_XCNT(b.x)], 1u);
    return b;
}
__device__ __forceinline__ void xcd_barrier_complete(unsigned* bar, unsigned x, unsigned& nloc, unsigned& nx) {
    const unsigned G = gridDim.x * gridDim.y * gridDim.z;
    unsigned sum, cnt, mine, sp = 0u;
    for (;;) {
        sum = 0u; cnt = 0u; mine = 0u;
#pragma unroll
        for (unsigned j = 0; j < 16; ++j) { const unsigned c = xb_ld(&bar[XB_XCNT(j)]); sum += c; cnt += (c > 0u) ? 1u : 0u; mine = (j == x) ? c : mine; }
        if (sum == G) break;
        __builtin_amdgcn_s_sleep(1);
        if ((++sp & 255u) == 0u) { if (xb_ld(&bar[XB_TMO])) break; if (sp > XB_SPIN_CAP) { atomicAdd(&bar[XB_TMO], 1u); break; } }
    }
    nloc = mine > 0u ? mine : 1u; nx = cnt > 0u ? cnt : 1u;
}
__device__ __forceinline__ void xcd_barrier(const XcdBarrier& b) {
    asm volatile("s_waitcnt vmcnt(0)" ::: "memory");
    __syncthreads();
    if (threadIdx.x == 0) {
        unsigned* bar = b.bar;
        __builtin_amdgcn_s_waitcnt(0);
        unsigned nloc = b.st[0], nx = b.st[1];
        if (nloc == 0u) { xcd_barrier_complete(bar, b.x, nloc, nx); b.st[0] = nloc; b.st[1] = nx; }
        const unsigned old = xb_add(&bar[XB_XSUB(b.x)], 1u);
        const unsigned gen = old / nloc;
        if (old + 1u == (gen + 1u) * nloc) {
            __builtin_amdgcn_fence(__ATOMIC_RELEASE, "agent");
            asm volatile("s_waitcnt vmcnt(0)" ::: "memory");
            const unsigned og = xb_add(&bar[XB_TOP], 1u);
            const unsigned tg = og / nx;
            if (og + 1u == (tg + 1u) * nx) xb_add(&bar[XB_TOPGEN], 1u);
            else XB_SPIN(xb_ld(&bar[XB_TOPGEN]) == tg, bar);
            __builtin_amdgcn_fence(__ATOMIC_ACQUIRE, "agent");
            xb_add(&bar[XB_XGEN(b.x)], 1u);
            asm volatile("s_waitcnt vmcnt(0)" ::: "memory");
        } else {
            XB_SPIN(xb_ld(&bar[XB_XGEN(b.x)]) == gen, bar);
            __builtin_amdgcn_fence(__ATOMIC_ACQUIRE, "agent");
            asm volatile("s_waitcnt vmcnt(0)" ::: "memory");
        }
    }
    __syncthreads();
}

constexpr int RING_BYTES = 131072;
constexpr int ROW_OFF = RING_BYTES, TOK_UNITS = 18;
constexpr int TOK_OFF = ROW_OFF + TOK_UNITS * 1024;
constexpr int TBL_OFF = TOK_OFF + TOK_UNITS * 512;
constexpr int LDSCTL_OFF = TBL_OFF + 512;
constexpr int MK_LDS_BYTES = LDSCTL_OFF + 256;
static_assert(MK_LDS_BYTES <= 160 * 1024, "LDS map");

struct MArgs { const float* in[18]; float* out; unsigned char* ws; int ph_lo, ph_hi; };
struct Frame {
    LAS unsigned char* lds; int tid, lane, wave, vcu, G;
    unsigned char* ws; unsigned* ctl;
};
__device__ __forceinline__ unsigned pkb(float lo, float hi) { return pg8::cvt_pk_bf16(lo, hi); }

struct P0Item { const float* W; const float* g; unsigned char* dst; int K, N, item, mode, f8; };
__device__ __forceinline__ void p0_load(const P0Item& d, int lane, float (&v)[32], float& g0) {
    const int nblk = d.N / 32, kb = d.item / nblk, nb = d.item - kb * nblk, k0 = 64 * kb, n0 = 32 * nb;
    const float* p = d.W + (size_t)(k0 + (lane >> 5)) * d.N + n0 + (lane & 31);
#pragma unroll
    for (int i = 0; i < 32; ++i) v[i] = p[(size_t)(2 * i) * d.N];
    g0 = d.g ? d.g[k0 + lane] : 1.f;
}
__device__ __forceinline__ void p0_store(const P0Item& d, int lane, const float (&v)[32], float g0, LAS float* scr) {
    const int nblk = d.N / 32, kb = d.item / nblk, nb = d.item - kb * nblk, k0 = 64 * kb, n0 = 32 * nb;
    if (d.f8) g0 *= W8SCALE;
#pragma unroll
    for (int i = 0; i < 32; ++i) { const int kk = 2 * i + (lane >> 5); scr[kk * 33 + (lane & 31)] = v[i] * lperm(g0, kk); }
    asm volatile("s_waitcnt lgkmcnt(0)" ::: "memory");
    if (d.f8) {
#pragma unroll
        for (int j = 0; j < 2; ++j) { const int id = lane + 64 * j, n = id >> 2, c = id & 3; const LAS float* s = scr + (16 * c) * 33 + n; unsigned p[4];
#pragma unroll
            for (int q = 0; q < 4; ++q) { unsigned w = 0u; w = __builtin_amdgcn_cvt_pk_fp8_f32(s[(4 * q + 0) * 33], s[(4 * q + 1) * 33], w, false); w = __builtin_amdgcn_cvt_pk_fp8_f32(s[(4 * q + 2) * 33], s[(4 * q + 3) * 33], w, true); p[q] = w; }
            int nn = n0 + n; if (d.mode == 1) { const int half = nn / FF, j2 = nn % FF; nn = (j2 >> 7) * 256 + half * 128 + (j2 & 127); }
            *(u32x4*)(d.dst + (size_t)nn * d.K + k0 + 16 * c) = (u32x4){p[0], p[1], p[2], p[3]}; }
    } else {
        const int c = lane & 7;
#pragma unroll
        for (int j = 0; j < 4; ++j) { const int n = (lane >> 3) + 8 * j; const LAS float* s = scr + (8 * c) * 33 + n;
            u32x4 o; o.x = pkb(s[0 * 33], s[1 * 33]); o.y = pkb(s[2 * 33], s[3 * 33]); o.z = pkb(s[4 * 33], s[5 * 33]); o.w = pkb(s[6 * 33], s[7 * 33]);
            int nn = n0 + n; if (d.mode == 1) { const int half = nn / FF, j2 = nn % FF; nn = (j2 >> 7) * 256 + half * 128 + (j2 & 127); }
            *(u32x4*)((bf16_t*)d.dst + (size_t)nn * d.K + k0 + 8 * c) = o; }
    }
    asm volatile("s_waitcnt lgkmcnt(0)" ::: "memory");
}
__device__ __forceinline__ void p0_prologue(Frame& F, const MArgs& args) {
    LAS float* scr = (LAS float*)(F.lds + F.wave * 16384);
    const int gw = F.vcu * MK_WAVES + F.wave, NGW = F.G * MK_WAVES, lane = F.lane;
    unsigned char* ws = F.ws;
    constexpr int I_QKV = (DM / 64) * (3 * DM / 32), I_SQ = (DM / 64) * (DM / 32), I_WP = (PLE / 64) * (DM / 32), I_GU = (DM / 64) * (2 * FF / 32), I_WD = (FF / 64) * (DM / 32), I_WR = (DM / 64) * (NE / 32);
    constexpr int PER_LAYER = I_QKV + 2 * I_SQ + I_WP + NE * I_GU + NE * I_WD + I_WR;
    const float* g_mix = args.in[2]; const float* w_qkv = args.in[3]; const float* w_fgate = args.in[4]; const float* w_o = args.in[6]; const float* g_moe = args.in[7]; const float* w_router = args.in[8];
    const float* w_gu = args.in[10]; const float* w_down = args.in[12]; const float* g_ple = args.in[14]; const float* w_ple_gate = args.in[15]; const float* w_ple_proj = args.in[16];
    auto decode = [&](int it) -> P0Item {
        const int L = it / PER_LAYER; int r = it - L * PER_LAYER; const int f8 = (MK_FP8_MASK >> L) & 1;
        if (r < I_QKV) return P0Item{w_qkv + (size_t)L * DM * 3 * DM, g_mix + L * DM, ws + WS_WQKV + (size_t)L * 3 * DM * DM * 2, DM, 3 * DM, r, 0, 0}; r -= I_QKV;
        if (r < I_SQ) return P0Item{w_o + (size_t)L * DM * DM, nullptr, ws + WS_WO + (size_t)L * DM * DM * 2, DM, DM, r, 0, 0}; r -= I_SQ;
        if (r < I_SQ) return P0Item{w_ple_gate + (size_t)L * DM * DM, g_ple + L * DM, MK_PLE8 ? ws + WS_WG8 + (size_t)L * DM * DM : ws + WS_WG + (size_t)L * DM * DM * 2, DM, DM, r, 0, MK_PLE8}; r -= I_SQ;
        if (r < I_WP) return P0Item{w_ple_proj + (size_t)L * PLE * DM, nullptr, ws + WS_WP + (size_t)L * DM * PLE * 2, PLE, DM, r, 0, 0}; r -= I_WP;
        if (r < I_WR) return P0Item{w_router + (size_t)L * DM * NE, g_moe + L * DM, ws + WS_WR + (size_t)L * NE * DM * 2, DM, NE, r, 0, 0}; r -= I_WR;
        if (r < NE * I_GU) { const int e = r / I_GU; const size_t m = (size_t)L * NE + e;
            return P0Item{w_gu + m * DM * 2 * FF, g_moe + L * DM, f8 ? ws + WS_WGU8 + m * 2 * FF * DM : ws + WS_WGU + m * 2 * FF * DM * 2, DM, 2 * FF, r - e * I_GU, 1, f8}; } r -= NE * I_GU;
        { const int e = r / I_WD; const size_t m = (size_t)L * NE + e;
            return P0Item{w_down + m * FF * DM, nullptr, f8 ? ws + WS_WD8 + m * DM * FF : ws + WS_WD + m * DM * FF * 2, FF, DM, r - e * I_WD, 0, f8}; }
    };
    {
        float va[32], vb[32]; float ga = 1.f, gb = 1.f; P0Item da{}, db{};
        int it = gw; const int NIT = DEPTH * PER_LAYER;
        if (it < NIT) { da = decode(it); p0_load(da, lane, va, ga); }
        while (it < NIT) {
            const int itb = it + NGW; const bool hb = itb < NIT;
            if (hb) { db = decode(itb); p0_load(db, lane, vb, gb); }
            p0_store(da, lane, va, ga, scr);
            const int itc = itb + NGW; const bool hc = itc < NIT;
            if (hc) { da = decode(itc); p0_load(da, lane, va, ga); }
            if (hb) p0_store(db, lane, vb, gb, scr);
            it = itc;
        }
    }
    if (gw < 256) { bf16_t* WF = (bf16_t*)(ws + WS_WF); const int idx = gw * 64 + lane; const int n = idx >> 10, k = idx & 1023; WF[idx] = (bf16_t)f2bf(w_fgate[(size_t)k * NH + n] * g_mix[DM + k]); }
    {
        const float* x = args.in[0]; bf16_t* HB = (bf16_t*)(ws + WS_HB); float* SS = (float*)(ws + WS_SS);
        for (int row0 = gw * 4; row0 < NTOK; row0 += NGW * 4) {
            f32x4 v[4][4];
#pragma unroll
            for (int q = 0; q < 4; ++q) { const f32x4* p = (const f32x4*)(x + (size_t)(row0 + q) * DM) + lane;
#pragma unroll
                for (int j = 0; j < 4; ++j) v[q][j] = p[64 * j]; }
#pragma unroll
            for (int q = 0; q < 4; ++q) { float s = 0.f;
#pragma unroll
                for (int j = 0; j < 4; ++j) s += v[q][j].x * v[q][j].x + v[q][j].y * v[q][j].y + v[q][j].z * v[q][j].z + v[q][j].w * v[q][j].w;
                s = lwave_sum(s, lane);
                if (lane < 16) SS[(size_t)(row0 + q) * 16 + lane] = (lane == 0) ? s : 0.f;
                u32x2* o = (u32x2*)(HB + (size_t)(row0 + q) * DM) + lane;
#pragma unroll
                for (int j = 0; j < 4; ++j) { u32x2 w; w.x = pkb(v[q][j].x, v[q][j].y); w.y = pkb(v[q][j].z, v[q][j].w); o[64 * j] = w; } }
        }
        const float* pp = args.in[1]; bf16_t* PB = (bf16_t*)(ws + WS_PB);
        const size_t n4 = (size_t)DEPTH * NTOK * PLE / 4;
        for (size_t i = (size_t)gw * 64 + lane; i < n4; i += (size_t)NGW * 64 * 4) {
            f32x4 v[4];
#pragma unroll
            for (int q = 0; q < 4; ++q) { const size_t ii = i + (size_t)q * NGW * 64; if (ii < n4) v[q] = ((const f32x4*)pp)[ii]; }
#pragma unroll
            for (int q = 0; q < 4; ++q) { const size_t ii = i + (size_t)q * NGW * 64; if (ii < n4) { u32x2 w; w.x = pkb(v[q].x, v[q].y); w.y = pkb(v[q].z, v[q].w); ((u32x2*)PB)[ii] = w; } }
        }
    }
}

__device__ __forceinline__ void moe_tables(Frame& F, const unsigned* cnt) {
    LAS int* tstartL = (LAS int*)(F.lds + TBL_OFF); LAS int* cntL = tstartL + 64;
    if (F.wave == 0) {
        const int lane = F.lane; const int c = (lane < NE) ? (int)__hip_atomic_load(cnt + CNT_STRIDE * (lane & 31), __ATOMIC_RELAXED, __HIP_MEMORY_SCOPE_AGENT) : 0; const int nt = (c + 255) >> 8; int incl = nt;
#pragma unroll
        for (int o = 1; o < 32; o <<= 1) { const int t = lpermi(incl, lane - o); if ((lane & 31) >= o) incl += t; }
        if (lane < NE) { tstartL[lane] = incl - nt; cntL[lane] = c; if (lane == NE - 1) tstartL[NE] = incl; }
    }
    __syncthreads();
}
__device__ __forceinline__ void router_phase(Frame& F, const bf16_t* HB, const bf16_t* WR, const float* br, float* rstd, unsigned* cnt, int* tok_of, float* gate_of, unsigned* pair) {
    const int gw = F.vcu * MK_WAVES + F.wave, NGW = F.G * MK_WAVES, lane = F.lane, r = lane & 15, quad = lane >> 4;
    LAS unsigned* hist = (LAS unsigned*)(F.lds); LAS unsigned* gbase = hist + 32;
    for (int it = 0; it * NGW < NTOK / 16; ++it) {
        const int blk = it * NGW + gw; const bool valid = blk < NTOK / 16;
        if (F.tid < 32) hist[F.tid] = 0u;
        __syncthreads();
        int see[4]; unsigned slr[4]; float sgt[4];
        const int t0 = blk * 16;
        if (valid) {
            const bf16_t* ap = HB + (size_t)(t0 + r) * DM + quad * 8; const bf16_t* bp0 = WR + (size_t)r * DM + quad * 8; const bf16_t* bp1 = bp0 + (size_t)16 * DM;
            f32x4 acc0 = {0.f, 0.f, 0.f, 0.f}, acc1 = {0.f, 0.f, 0.f, 0.f}; float ssq = 0.f;
#pragma unroll 8
            for (int ks = 0; ks < 32; ++ks) { const bf16x8 a = *(const bf16x8*)(ap + 32 * ks), b0 = *(const bf16x8*)(bp0 + 32 * ks), b1 = *(const bf16x8*)(bp1 + 32 * ks);
                acc0 = __builtin_amdgcn_mfma_f32_16x16x32_bf16(a, b0, acc0, 0, 0, 0); acc1 = __builtin_amdgcn_mfma_f32_16x16x32_bf16(a, b1, acc1, 0, 0, 0);
#pragma unroll
                for (int j = 0; j < 8; ++j) { const float f = __uint_as_float(((unsigned)(unsigned short)a[j]) << 16); ssq += f * f; } }
            ssq += lperm(ssq, lane ^ 16); ssq += lperm(ssq, lane ^ 32);
            const float rs_r = rsqrtf(ssq * (1.f / DM) + EPS);
            const float b_lo = br[r], b_hi = br[16 + r];
#pragma unroll
            for (int j = 0; j < 4; ++j) {
                const float rsj = lperm(rs_r, quad * 4 + j); const int t = t0 + quad * 4 + j;
                float v0 = acc0[j] * rsj + b_lo, v1 = acc1[j] * rsj + b_hi; float tv[4]; int ti[4];
#pragma unroll
                for (int k = 0; k < 4; ++k) {
                    float bv = (v0 >= v1) ? v0 : v1; int bi = (v0 >= v1) ? r : 16 + r;
#pragma unroll
                    for (int o = 1; o < 16; o <<= 1) { const float ov = lperm(bv, lane ^ o); const int oi = lpermi(bi, lane ^ o); if (ov > bv || (ov == bv && oi < bi)) { bv = ov; bi = oi; } }
                    tv[k] = bv; ti[k] = bi; if (bi == r) v0 = -INFINITY; if (bi == 16 + r) v1 = -INFINITY;
                }
                float w[4], sw = 0.f;
#pragma unroll
                for (int k = 0; k < 4; ++k) { w[k] = __expf(tv[k] - tv[0]); sw += w[k]; }
                const int ee = (r == 0) ? ti[0] : (r == 1) ? ti[1] : (r == 2) ? ti[2] : ti[3]; const float ww = (r == 0) ? w[0] : (r == 1) ? w[1] : (r == 2) ? w[2] : w[3];
                see[j] = ee; sgt[j] = ww / sw; slr[j] = 0u;
                if (r < 4) slr[j] = __hip_atomic_fetch_add(hist + ee, 1u, __ATOMIC_RELAXED, __HIP_MEMORY_SCOPE_WORKGROUP);
                if (r == 4) rstd[t] = rsj;
            }
        }
        __syncthreads();
        if (F.tid < 32) { const unsigned n = hist[F.tid]; gbase[F.tid] = n ? __hip_atomic_fetch_add(cnt + CNT_STRIDE * F.tid, n, __ATOMIC_RELAXED, __HIP_MEMORY_SCOPE_AGENT) : 0u; }
        __syncthreads();
        if (valid && r < 4) {
#pragma unroll
            for (int j = 0; j < 4; ++j) { const int t = t0 + quad * 4 + j; const int ee = see[j]; const unsigned rk = gbase[ee] + slr[j];
                tok_of[(size_t)ee * CAP + rk] = t; gate_of[(size_t)ee * CAP + rk] = sgt[j]; pair[(size_t)t * 4 + r] = ((unsigned)ee << 16) | rk; }
        }
        __syncthreads();
    }
}
__device__ __forceinline__ void fgate_phase(Frame& F, const bf16_t* HB, const bf16_t* WF, const float* bfg, const float* SS, float* FL) {
    const int gw = F.vcu * MK_WAVES + F.wave, NGW = F.G * MK_WAVES, lane = F.lane, r = lane & 15, quad = lane >> 4;
    for (int blk = gw; blk < NTOK / 16; blk += NGW) {
        const int t0 = blk * 16;
        const bf16_t* ap = HB + (size_t)(t0 + r) * DM + quad * 8; const bf16_t* bp0 = WF + (size_t)r * DM + quad * 8;
        f32x4 acc0 = {0.f, 0.f, 0.f, 0.f};
#pragma unroll 8
        for (int ks = 0; ks < 32; ++ks) { const bf16x8 a = *(const bf16x8*)(ap + 32 * ks), b0 = *(const bf16x8*)(bp0 + 32 * ks); acc0 = __builtin_amdgcn_mfma_f32_16x16x32_bf16(a, b0, acc0, 0, 0, 0); }
        const f32x4 sp = *(const f32x4*)(SS + (size_t)(t0 + r) * 16 + quad * 4); float ss = (sp.x + sp.y) + (sp.z + sp.w); ss += lperm(ss, lane ^ 16); ss += lperm(ss, lane ^ 32);
        const float rs_r = rsqrtf(ss * (1.f / DM) + EPS); const float bb = bfg[r];
#pragma unroll
        for (int j = 0; j < 4; ++j) { const float rsj = lperm(rs_r, quad * 4 + j); FL[(size_t)(t0 + quad * 4 + j) * NH + r] = acc0[j] * rsj + bb; }
    }
}
__device__ __forceinline__ void combine_phase(Frame& F, const bf16_t* hin, bf16_t* hout, unsigned char* hout8, float* rstd, const unsigned* pair, const bf16_t* Y) {
    const int gw = F.vcu * MK_WAVES + F.wave, NGW = F.G * MK_WAVES, lane = F.lane; const LAS int* tstartL = (const LAS int*)(F.lds + TBL_OFF);
    for (int t = gw; t < NTOK; t += NGW) {
        f32x4 v[4]; const u32x2* hr = (const u32x2*)(hin + (size_t)t * DM) + lane;
        const u32x4 pr4 = *(const u32x4*)(pair + (size_t)t * 4);
#pragma unroll
        for (int j = 0; j < 4; ++j) { const u32x2 w = hr[64 * j]; v[j].x = __uint_as_float(w.x << 16); v[j].y = __uint_as_float(w.x & 0xffff0000u); v[j].z = __uint_as_float(w.y << 16); v[j].w = __uint_as_float(w.y & 0xffff0000u); }
#pragma unroll
        for (int k = 0; k < 4; ++k) {
            const unsigned pr = (k == 0) ? pr4.x : (k == 1) ? pr4.y : (k == 2) ? pr4.z : pr4.w; const int e = __builtin_amdgcn_readfirstlane((int)(pr >> 16)), rk = __builtin_amdgcn_readfirstlane((int)(pr & 0xffffu));
            const size_t slot = (size_t)tstartL[e] * 256 + rk; const u32x2* yr = (const u32x2*)(Y + slot * DM) + lane;
#pragma unroll
            for (int j = 0; j < 4; ++j) { const u32x2 w = yr[64 * j]; v[j].x += __uint_as_float(w.x << 16); v[j].y += __uint_as_float(w.x & 0xffff0000u); v[j].z += __uint_as_float(w.y << 16); v[j].w += __uint_as_float(w.y & 0xffff0000u); }
        }
        float s = 0.f; u32x2* o = (u32x2*)(hout + (size_t)t * DM) + lane;
#pragma unroll
        for (int j = 0; j < 4; ++j) { u32x2 w; w.x = pkb(v[j].x, v[j].y); w.y = pkb(v[j].z, v[j].w); o[64 * j] = w;
            if (hout8) { unsigned p = 0u; p = __builtin_amdgcn_cvt_pk_fp8_f32(v[j].x, v[j].y, p, false); p = __builtin_amdgcn_cvt_pk_fp8_f32(v[j].z, v[j].w, p, true); ((unsigned*)(hout8 + (size_t)t * DM))[lane + 64 * j] = p; }
            const float q0 = __uint_as_float(w.x << 16), q1 = __uint_as_float(w.x & 0xffff0000u), q2 = __uint_as_float(w.y << 16), q3 = __uint_as_float(w.y & 0xffff0000u); s += (q0 * q0 + q1 * q1) + (q2 * q2 + q3 * q3); }
        s = lwave_sum(s, lane); if (lane == 0) rstd[t] = rsqrtf(s * (1.f / DM) + EPS);
    }
}
__device__ __forceinline__ void final_phase(Frame& F, const bf16_t* hb, const float* SS, const float* g, float* out) {
    const int gw = F.vcu * MK_WAVES + F.wave, NGW = F.G * MK_WAVES, lane = F.lane;
    f32x4 gg[4];
#pragma unroll
    for (int j = 0; j < 4; ++j) gg[j] = ((const f32x4*)g)[lane + 64 * j];
    for (int row = gw; row < NTOK; row += NGW) {
        const u32x2* p = (const u32x2*)(hb + (size_t)row * DM) + lane; u32x2 w[4];
#pragma unroll
        for (int j = 0; j < 4; ++j) w[j] = p[64 * j];
        float ss = (lane < 16) ? SS[(size_t)row * 16 + lane] : 0.f; ss = lwave_sum(ss, lane);
        const float rs = rsqrtf(ss * (1.f / DM) + EPS);
        f32x4* o = (f32x4*)(out + (size_t)row * DM) + lane;
#pragma unroll
        for (int j = 0; j < 4; ++j) { f32x4 v; v.x = __uint_as_float(w[j].x << 16); v.y = __uint_as_float(w[j].x & 0xffff0000u); v.z = __uint_as_float(w[j].y << 16); v.w = __uint_as_float(w[j].y & 0xffff0000u); o[64 * j] = v * rs * gg[j]; }
    }
}
__device__ __forceinline__ void fox_head(Frame& F, unsigned char* lds_generic, int bh, const bf16_t* Q, const bf16_t* K, const bf16_t* V, const float* FL, bf16_t* O) {
    int tid_ = threadIdx.x; asm volatile("" : "+v"(tid_));
    const int lane = tid_ & 63, b = bh / NH, hh = bh % NH; const size_t rowb = (size_t)b * SEQ;
    LAS float* cbL = (LAS float*)(F.lds + attn_body::ATTN_LDS_BYTES); LAS float* wtot = cbL + SEQ;
    {
        float loc[4]; float run = 0.f;
#pragma unroll
        for (int i = 0; i < 4; ++i) { run += log_sigmoid(FL[(size_t)(rowb + tid_ * 4 + i) * NH + hh]); loc[i] = run; }
        float incl = run;
#pragma unroll
        for (int o = 1; o < 64; o <<= 1) { const float t = lperm(incl, lane - o); if (lane >= o) incl += t; }
        if (lane == 63) wtot[F.wave] = incl;
        __syncthreads();
        float base = incl - run;
        for (int w = 0; w < F.wave; ++w) base += wtot[w];
#pragma unroll
        for (int i = 0; i < 4; ++i) cbL[tid_ * 4 + i] = -(base + loc[i]) * LOG2E;
        __syncthreads();
    }
    for (int qb = 0; qb < SEQ / 256; ++qb)
        attn_body::attn_unit<8>(b, hh, qb, (const attn_body::bf16*)Q, (const attn_body::bf16*)K, (const attn_body::bf16*)V, (attn_body::bf16*)O, (char*)lds_generic, cbL);
}
constexpr int N_PHASES = 18;
__global__ void __launch_bounds__(MK_WAVES * 64, 2) mega_fwd(MArgs args) {
    extern __shared__ __attribute__((aligned(16))) unsigned char lds_raw[];
    Frame F;
    F.lds = (LAS unsigned char*)lds_raw;
    F.tid = threadIdx.x; F.lane = F.tid & 63; F.wave = __builtin_amdgcn_readfirstlane(F.tid >> 6);
    F.G = gridDim.x; { const int bx = blockIdx.x; F.vcu = (F.G % 8 == 0) ? (bx % 8) * (F.G / 8) + bx / 8 : bx; }
    F.ws = args.ws; F.ctl = (unsigned*)(args.ws + WS_CTL);
    unsigned char* ws = args.ws;
    for (int u = F.tid; u < (MK_LDS_BYTES - LDSCTL_OFF) / 4; u += MK_WAVES * 64) ((LAS unsigned*)(F.lds + LDSCTL_OFF))[u] = 0u;
    __syncthreads();
    const int lo = args.ph_lo, hi = args.ph_hi;
    const bool use_bar = (hi - lo) > 1;
    XcdBarrier bar; bar.bar = F.ctl + CW_BAR; bar.x = 0; bar.st = nullptr;
    if (use_bar) bar = xcd_barrier_post(F.ctl + CW_BAR, (volatile LAS unsigned*)(F.lds + LDSCTL_OFF + 32));
#ifndef MK_DUP
#define MK_DUP 0
#endif
#define NREP(j) (((MK_DUP >> (j)) & 1) ? 2 : 1)
#ifndef MK_QKVPROBE
#define MK_QKVPROBE 0
#endif
#ifndef MK_ATTSUB
#define MK_ATTSUB 3
#endif
#ifndef MK_P0SUB
#define MK_P0SUB 7
#endif
#ifndef MK_PHMASK
#define MK_PHMASK 0x3ff
#endif
#define IN(k) (lo <= (k) && (k) < hi)
#define EN(j) ((MK_PHMASK >> (j)) & 1)
#define PHASE_BEGIN() do { int t_ = threadIdx.x; asm volatile("" : "+v"(t_)); F.tid = t_; F.lane = t_ & 63; } while (0)
#define SEAM(k) do { if (IN(k) && IN((k) + 1)) xcd_barrier(bar); } while (0)
    bf16_t* const HB0 = (bf16_t*)(ws + WS_HB); bf16_t* const HB1 = (bf16_t*)(ws + WS_HB2); float* const SS = (float*)(ws + WS_SS);
    bf16_t* const Qb = (bf16_t*)(ws + WS_Q); bf16_t* const Kb = (bf16_t*)(ws + WS_K); bf16_t* const Vb = (bf16_t*)(ws + WS_V); bf16_t* const Ob = (bf16_t*)(ws + WS_O);
    float* const rstd_moe = (float*)(ws + WS_RSTD) + NTOK; float* const rstd_ple = rstd_moe + NTOK;
    int* const tok_of = (int*)(ws + WS_TOK); float* const gate_of = (float*)(ws + WS_GATE); unsigned* const pair = (unsigned*)(ws + WS_PAIR);
    bf16_t* const ACT = (bf16_t*)(ws + WS_ACT); bf16_t* const Yb = (bf16_t*)(ws + WS_Y); float* const FL = (float*)(ws + WS_FL);
    LAS int* const tstartL = (LAS int*)(F.lds + TBL_OFF); LAS int* const cntL = tstartL + 64; LAS unsigned short* const tokL = (LAS unsigned short*)(F.lds + TOK_OFF); LAS float* const rowL = (LAS float*)(F.lds + ROW_OFF);

    if (EN(8) && IN(0)) { for (int rep_ = 0; rep_ < NREP(8); ++rep_) p0_prologue(F, args); }
    SEAM(0);
    for (int L = 0; L < DEPTH; ++L) {
        const int pb = 1 + 8 * L;
        unsigned* const cnt = F.ctl + CW_CNT2 + 2048 * L;
        const bool f8 = (L == 0) ? bool(MK_FP8_MASK & 1) : bool(MK_FP8_MASK & 2);
        bf16_t* const HBa = (L & 1) ? HB1 : HB0; bf16_t* const HBb = (L & 1) ? HB0 : HB1;
        if (EN(0) && IN(pb + 0)) for (int rep_ = 0; rep_ < NREP(0); ++rep_) { PHASE_BEGIN();
            if (MK_P0SUB & 1) if (L == 1) fgate_phase(F, HBa, (const bf16_t*)(ws + WS_WF), args.in[5], SS, FL);
            if (MK_P0SUB & 2) { pg8::DenseOrder S; S.init(NTOK, 3 * DM, F.G, (int)blockIdx.x); pg8::EpiQKV E{Qb, rowL, 0}; pg8::EpiQKV Ep{Qb, rowL, MK_QKVPROBE};
              _Pragma("clang loop unroll(disable)") for (int i0 = 0; i0 < TOK_UNITS; i0 += 2) { const int i = i0 + (F.wave >> 2); pg8::Unit u; if (S.next(i, u)) { const int lr = F.tid & 255; const f32x4* sp = (const f32x4*)(SS + (size_t)(u.arow0 + lr) * 16);
                  const f32x4 s0 = sp[0], s1 = sp[1], s2 = sp[2], s3 = sp[3]; const float ss = ((s0.x + s0.y) + (s0.z + s0.w)) + ((s1.x + s1.y) + (s1.z + s1.w)) + ((s2.x + s2.y) + (s2.z + s2.w)) + ((s3.x + s3.y) + (s3.z + s3.w));
                  rowL[i * 256 + lr] = rsqrtf(ss * (1.f / DM) + EPS); } }
              __syncthreads();
              if (NREP(13) > 1) pg8::gemm_phase(F.lds, HBa, (const bf16_t*)(ws + WS_WQKV) + (size_t)L * 3 * DM * DM, 2 * DM, S, E, true);
              if (NREP(14) > 1) pg8::gemm_phase(F.lds, HBa, (const bf16_t*)(ws + WS_WQKV) + (size_t)L * 3 * DM * DM, 2 * DM, S, Ep, false);
              if (NREP(15) > 1) { pg8::HotOrder Sh; Sh.d = S; pg8::gemm_phase(F.lds, HBa, (const bf16_t*)(ws + WS_WQKV) + (size_t)L * 3 * DM * DM, 2 * DM, Sh, Ep, false); }
              pg8::gemm_phase(F.lds, HBa, (const bf16_t*)(ws + WS_WQKV) + (size_t)L * 3 * DM * DM, 2 * DM, S, E); }
            if (MK_P0SUB & 4) if (L == 0) { pg8::PJOrder S; S.init(F.G, (int)blockIdx.x); pg8::EpiPJ E{(bf16_t*)(ws + WS_PJ)};
                pg8::gemm_phase(F.lds, (const bf16_t*)(ws + WS_PB), (const bf16_t*)(ws + WS_WP), 2 * PLE, S, E); }
        }
        SEAM(pb + 0);
        if (EN(1) && IN(pb + 1)) for (int rep_ = 0; rep_ < (NREP(1) > 1 ? 2 : (L == 0 ? NREP(10) : NREP(11))); ++rep_) { PHASE_BEGIN();
            if (L == 0) { if (MK_ATTSUB & 1) for (int bh = blockIdx.x; bh < NB * NH; bh += F.G) sb_body::sb_head(F.lds, bh, Qb, Kb, Vb, Ob); }
            else { if (MK_ATTSUB & 2) for (int bh = blockIdx.x; bh < NB * NH; bh += F.G) { fox_head(F, lds_raw, bh, Qb, Kb, Vb, FL, Ob); __syncthreads(); } }
        }
        SEAM(pb + 1);
        if (EN(2) && IN(pb + 2)) for (int rep_ = NREP(2) - 1; rep_ >= 0; --rep_) { PHASE_BEGIN();
            pg8::DenseOrder S; S.init(NTOK, DM, F.G, (int)blockIdx.x); pg8::EpiWo E{HBa, rep_ ? (bf16_t*)(ws + WS_ACT + 128 * MiB) : HBb, f8 ? (rep_ ? ws + WS_ACT + 210 * MiB : ws + WS_HB8) : nullptr};
            pg8::gemm_phase(F.lds, Ob, (const bf16_t*)(ws + WS_WO) + (size_t)L * DM * DM, 2 * DM, S, E);
        }
        SEAM(pb + 2);
        if (EN(3) && IN(pb + 3)) for (int rep_ = NREP(3) - 1; rep_ >= 0; --rep_) { PHASE_BEGIN(); unsigned char* dd = ws + WS_ACT + 192 * MiB;
            if (rep_) router_phase(F, HBb, (const bf16_t*)(ws + WS_WR) + (size_t)L * NE * DM, args.in[9] + L * NE, (float*)(dd + 9 * MiB), F.ctl + CW_CNT2 + 4096 + 2048 * L, (int*)dd, (float*)(dd + 4 * MiB), (unsigned*)(dd + 8 * MiB));
            else router_phase(F, HBb, (const bf16_t*)(ws + WS_WR) + (size_t)L * NE * DM, args.in[9] + L * NE, rstd_moe, cnt, tok_of, gate_of, pair); }
        SEAM(pb + 3);
        if (EN(4) && IN(pb + 4)) for (int rep_ = (NREP(4) > 1 || NREP(12) > 1) ? 1 : 0; rep_ >= 0; --rep_) { PHASE_BEGIN(); const bool skip_ = rep_ && NREP(12) > 1;
            moe_tables(F, cnt);
            pg8::MoeOrder S; S.NN = 8; S.nwg = tstartL[NE] * 8; S.G = F.G; S.c = (int)blockIdx.x; S.lane = F.lane; S.tstartL = tstartL; S.cntL = cntL; S.tokL = tokL; S.gather = true;
            _Pragma("clang loop unroll(disable)") for (int i0 = 0; i0 < TOK_UNITS; i0 += 2) { const int i = i0 + (F.wave >> 2); pg8::Unit u;
                if (S.next(i, u)) { const int lr = F.tid & 255; const int rk = u.rank0 + lr; const int tok = tok_of[(size_t)u.e * CAP + (rk < u.cnt ? rk : u.rank0)]; tokL[i * 256 + lr] = (unsigned short)tok; rowL[i * 256 + lr] = rstd_moe[tok] * (f8 ? W8INV : 1.f); } }
            __syncthreads();
            if (f8) { pg8::EpiGU<true> E{ws + WS_ACT8, args.in[11] + (size_t)L * NE * 2 * FF, rowL};
                pg8::gemm_phase<pg8::EpiGU<true>, pg8::MoeOrder, true>(F.lds, ws + WS_HB8, ws + WS_WGU8 + (size_t)L * NE * 2 * FF * DM, DM, S, E, skip_); }
            else { pg8::EpiGU<false> E{ACT, args.in[11] + (size_t)L * NE * 2 * FF, rowL};
                pg8::gemm_phase(F.lds, HBb, (const bf16_t*)(ws + WS_WGU) + (size_t)L * NE * 2 * FF * DM, 2 * DM, S, E); }
        }
        SEAM(pb + 4);
        if (EN(5) && IN(pb + 5)) for (int rep_ = 0; rep_ < NREP(5); ++rep_) { PHASE_BEGIN();
            moe_tables(F, cnt);
            pg8::MoeOrder S; S.NN = 4; S.nwg = tstartL[NE] * 4; S.G = F.G; S.c = (int)blockIdx.x; S.lane = F.lane; S.tstartL = tstartL; S.cntL = cntL; S.tokL = tokL; S.gather = false;
            _Pragma("clang loop unroll(disable)") for (int i0 = 0; i0 < TOK_UNITS; i0 += 2) { const int i = i0 + (F.wave >> 2); pg8::Unit u;
                if (S.next(i, u)) { const int lr = F.tid & 255; const int rk = u.rank0 + lr; rowL[i * 256 + lr] = (rk < u.cnt) ? gate_of[(size_t)u.e * CAP + rk] * (f8 ? W8INV : 1.f) : 0.f; } }
            __syncthreads();
            pg8::EpiDown E{Yb, args.in[13] + (size_t)L * NE * DM, rowL, f8 ? W8SCALE : 1.f};
            if (f8) pg8::gemm_phase<pg8::EpiDown, pg8::MoeOrder, true>(F.lds, ws + WS_ACT8, ws + WS_WD8 + (size_t)L * NE * DM * FF, FF, S, E);
            else pg8::gemm_phase(F.lds, ACT, (const bf16_t*)(ws + WS_WD) + (size_t)L * NE * DM * FF, 2 * FF, S, E);
        }
        SEAM(pb + 5);
        if (EN(6) && IN(pb + 6)) for (int rep_ = NREP(6) - 1; rep_ >= 0; --rep_) { PHASE_BEGIN(); moe_tables(F, cnt);
            if (rep_) combine_phase(F, HBb, (bf16_t*)(ws + WS_ACT + 128 * MiB), nullptr, (float*)(ws + WS_ACT + 201 * MiB), pair, Yb);
            else combine_phase(F, HBb, HBa, MK_PLE8 ? ws + WS_HB8 : nullptr, rstd_ple, pair, Yb); }
        SEAM(pb + 6);
        if (EN(7) && IN(pb + 7)) for (int rep_ = NREP(7) - 1; rep_ >= 0; --rep_) { PHASE_BEGIN();
            pg8::DenseOrder S; S.init(NTOK, DM, F.G, (int)blockIdx.x);
            pg8::EpiPLE E{HBa, rep_ ? (bf16_t*)(ws + WS_ACT + 128 * MiB) : HBb, (const bf16_t*)(ws + WS_PJ) + (size_t)L * NTOK * DM, rowL, rep_ ? (float*)(ws + WS_ACT + 202 * MiB) : SS};
            _Pragma("clang loop unroll(disable)") for (int i0 = 0; i0 < TOK_UNITS; i0 += 2) { const int i = i0 + (F.wave >> 2); pg8::Unit u; if (S.next(i, u)) { const int lr = F.tid & 255; rowL[i * 256 + lr] = rstd_ple[u.arow0 + lr] * (MK_PLE8 ? W8INV : 1.f); } }
            __syncthreads();
            if (MK_PLE8) pg8::gemm_phase<pg8::EpiPLE, pg8::DenseOrder, true>(F.lds, ws + WS_HB8, ws + WS_WG8 + (size_t)L * DM * DM, DM, S, E);
            else pg8::gemm_phase(F.lds, HBa, (const bf16_t*)(ws + WS_WG) + (size_t)L * DM * DM, 2 * DM, S, E);
        }
        SEAM(pb + 7);
    }
    if (EN(9) && IN(17)) for (int rep_ = 0; rep_ < NREP(9); ++rep_) { PHASE_BEGIN(); final_phase(F, HB0, SS, args.in[17], args.out); }
#undef IN
#undef SEAM
}
#define MK_MODE 2

#ifndef MK_MODE
#define MK_MODE 2
#endif
extern "C" void kernel_launch(void* const* d_in, const int* in_sizes, int n_in, void* d_out, int out_size, void* d_ws, size_t ws_size, hipStream_t stream) {
    if (n_in != 18 || in_sizes[0] != NTOK * DM || out_size != NTOK * DM || ws_size < WS_END2) { fprintf(stderr, "kernel_launch: unexpected shapes / workspace (%d inputs, ws %zu, need %zu)\n", n_in, ws_size, (size_t)WS_END2); return; }
    unsigned char* ws = (unsigned char*)d_ws;
    (void)hipMemsetAsync(ws + WS_CTL, 0, 1 * MiB, stream);
#if MK_MODE != 0
    static int grid = 0;
    if (grid == 0) {
        int dev = 0, cus = 0, per_cu = 0;
        if (hipGetDevice(&dev) != hipSuccess || hipDeviceGetAttribute(&cus, hipDeviceAttributeMultiprocessorCount, dev) != hipSuccess) { fprintf(stderr, "kernel_launch: device query failed\n"); grid = -1; return; }
        if (hipFuncSetAttribute((const void*)mega_fwd, hipFuncAttributeMaxDynamicSharedMemorySize, MK_LDS_BYTES) != hipSuccess) { fprintf(stderr, "kernel_launch: hipFuncSetAttribute failed\n"); grid = -1; return; }
        if (hipOccupancyMaxActiveBlocksPerMultiprocessor(&per_cu, (const void*)mega_fwd, MK_WAVES * 64, MK_LDS_BYTES) != hipSuccess || per_cu < 1) fprintf(stderr, "kernel_launch: occupancy query reports %d\n", per_cu);
        (void)hipGetLastError();
        grid = cus;
        grid -= grid % 8;
    }
    if (grid <= 0) return;
    MArgs a{};
    for (int i = 0; i < 18; ++i) a.in[i] = (const float*)d_in[i];
    a.out = (float*)d_out; a.ws = ws;
#if MK_MODE == 2
    a.ph_lo = 0; a.ph_hi = N_PHASES;
    hipLaunchKernelGGL(mega_fwd, dim3(grid), dim3(MK_WAVES * 64), MK_LDS_BYTES, stream, a);
#else
    for (int ph = 0; ph < N_PHASES; ++ph) { a.ph_lo = ph; a.ph_hi = ph + 1; hipLaunchKernelGGL(mega_fwd, dim3(grid), dim3(MK_WAVES * 64), MK_LDS_BYTES, stream, a); }
#endif
    { const hipError_t le = hipPeekAtLastError(); if (le != hipSuccess) fprintf(stderr, "kernel_launch: launch failed: %s\n", hipGetErrorName(le)); }
#else
    const float* x = (const float*)d_in[0]; const float* p = (const float*)d_in[1]; const float* g_mix = (const float*)d_in[2]; const float* w_qkv = (const float*)d_in[3];
    const float* w_fgate = (const float*)d_in[4]; const float* b_fgate = (const float*)d_in[5]; const float* w_o = (const float*)d_in[6]; const float* g_moe = (const float*)d_in[7];
    const float* w_router = (const float*)d_in[8]; const float* b_router = (const float*)d_in[9]; const float* w_gu = (const float*)d_in[10]; const float* b_gu = (const float*)d_in[11];
    const float* w_down = (const float*)d_in[12]; const float* b_down = (const float*)d_in[13]; const float* g_ple = (const float*)d_in[14]; const float* w_ple_gate = (const float*)d_in[15];
    const float* w_ple_proj = (const float*)d_in[16]; const float* g_final = (const float*)d_in[17];
    unsigned* ctl = (unsigned*)(ws + WS_CTL);
    bf16_t *Wqkv = (bf16_t*)(ws + WS_WQKV), *Wo = (bf16_t*)(ws + WS_WO), *Wg = (bf16_t*)(ws + WS_WG), *Wp = (bf16_t*)(ws + WS_WP), *Wgu = (bf16_t*)(ws + WS_WGU), *Wd = (bf16_t*)(ws + WS_WD);
    float* H = (float*)(ws + WS_H); bf16_t *HB = (bf16_t*)(ws + WS_HB), *Q = (bf16_t*)(ws + WS_Q), *Kb = (bf16_t*)(ws + WS_K), *Vb = (bf16_t*)(ws + WS_V), *O = (bf16_t*)(ws + WS_O);
    bf16_t *PB = (bf16_t*)(ws + WS_PB), *PJ = (bf16_t*)(ws + WS_PJ), *ACT = (bf16_t*)(ws + WS_ACT), *Y = (bf16_t*)(ws + WS_Y);
    int* tok_of = (int*)(ws + WS_TOK); float* gate_of = (float*)(ws + WS_GATE); unsigned* pair = (unsigned*)(ws + WS_PAIR);
    float* rstd_mix = (float*)(ws + WS_RSTD); float* rstd_moe = rstd_mix + NTOK; float* rstd_ple = rstd_moe + NTOK;
    float* FL = (float*)(ws + WS_FL); float* CB = (float*)(ws + WS_CB);
    for (int i = 0; i < DEPTH; ++i) {
        k_cvt_t<0><<<dim3(3 * DM / 64, DM / 64, 1), 256, 0, stream>>>(w_qkv + (size_t)i * DM * 3 * DM, g_mix + i * DM, Wqkv + (size_t)i * 3 * DM * DM, DM, 3 * DM);
        k_cvt_t<0><<<dim3(DM / 64, DM / 64, 1), 256, 0, stream>>>(w_o + (size_t)i * DM * DM, nullptr, Wo + (size_t)i * DM * DM, DM, DM);
        k_cvt_t<0><<<dim3(DM / 64, DM / 64, 1), 256, 0, stream>>>(w_ple_gate + (size_t)i * DM * DM, g_ple + i * DM, Wg + (size_t)i * DM * DM, DM, DM);
        k_cvt_t<0><<<dim3(DM / 64, PLE / 64, 1), 256, 0, stream>>>(w_ple_proj + (size_t)i * PLE * DM, nullptr, Wp + (size_t)i * DM * PLE, PLE, DM);
        k_cvt_t<1><<<dim3(2 * FF / 64, DM / 64, NE), 256, 0, stream>>>(w_gu + (size_t)i * NE * DM * 2 * FF, g_moe + i * DM, Wgu + (size_t)i * NE * 2 * FF * DM, DM, 2 * FF);
        k_cvt_t<0><<<dim3(DM / 64, FF / 64, NE), 256, 0, stream>>>(w_down + (size_t)i * NE * FF * DM, nullptr, Wd + (size_t)i * NE * DM * FF, FF, DM);
    }
    k_cvt<<<(unsigned)((size_t)DEPTH * NTOK * PLE / 4 / 256), 256, 0, stream>>>(p, PB, (size_t)DEPTH * NTOK * PLE / 4);
    for (int i = 0; i < DEPTH; ++i)
        k_gemm_pj<<<dim3(DM / 64, NTOK / 64), 64, 0, stream>>>(PB + (size_t)i * NTOK * PLE, Wp + (size_t)i * DM * PLE, PJ + (size_t)i * NTOK * DM);
    k_rowstat<<<NTOK / 4, 256, 0, stream>>>(x, HB, rstd_mix);
    for (int i = 0; i < DEPTH; ++i) {
        const float* hin = (i == 0) ? x : H;
        k_gemm_qkv<<<dim3(3 * DM / 64, NTOK / 64), 64, 0, stream>>>(HB, Wqkv + (size_t)i * 3 * DM * DM, rstd_mix, Q);
        if (i == 0) k_attn_sb<<<NB * NH * SEQ / 4, 256, 0, stream>>>(Q, Kb, Vb, O);
        else {
            k_fgate<<<NTOK / 4, 256, 0, stream>>>(hin, g_mix + i * DM, w_fgate, b_fgate, rstd_mix, FL);
            k_scan<<<NB * NH, 64, 0, stream>>>(FL, CB);
            k_attn_fox<<<NB * NH * SEQ / 4, 256, 0, stream>>>(Q, Kb, Vb, CB, O);
        }
        k_gemm_wo<<<dim3(DM / 64, NTOK / 64), 64, 0, stream>>>(O, Wo + (size_t)i * DM * DM, hin, H, HB);
        unsigned* cnt = ctl + CW_CNT + 64 * i;
        k_router<<<NTOK / 4, 256, 0, stream>>>(H, g_moe + i * DM, w_router + (size_t)i * DM * NE, b_router + i * NE, rstd_moe, cnt, tok_of, gate_of, pair);
        k_gemm_gu<<<dim3(FF / 64, MAXT * 4), 64, 0, stream>>>(HB, Wgu + (size_t)i * NE * 2 * FF * DM, b_gu + (size_t)i * NE * 2 * FF, rstd_moe, cnt, tok_of, ACT);
        k_gemm_down<<<dim3(DM / 64, MAXT * 4), 64, 0, stream>>>(ACT, Wd + (size_t)i * NE * DM * FF, b_down + (size_t)i * NE * DM, cnt, gate_of, Y);
        k_combine<<<NTOK / 4, 256, 0, stream>>>(H, HB, rstd_ple, cnt, pair, Y);
        k_gemm_ple<<<dim3(DM / 64, NTOK / 64), 64, 0, stream>>>(HB, Wg + (size_t)i * DM * DM, rstd_ple, PJ + (size_t)i * NTOK * DM, H, HB);
        if (i + 1 < DEPTH) k_rowstat<<<NTOK / 4, 256, 0, stream>>>(H, HB, rstd_mix);
    }
    k_final<<<NTOK / 4, 256, 0, stream>>>(H, g_final, (float*)d_out);
#endif
}
```

```cpp
#define MK_DUP 0
#define MK_FP8_MASK 3
#include <hip/hip_runtime.h>
#include <cstdio>
#include <cstdint>

typedef unsigned short bf16_t;
typedef short bf16x8 __attribute__((ext_vector_type(8)));
typedef float f32x4 __attribute__((ext_vector_type(4)));
typedef float f32x16 __attribute__((ext_vector_type(16)));
typedef unsigned u32x4 __attribute__((ext_vector_type(4)));
typedef unsigned u32x2 __attribute__((ext_vector_type(2)));

constexpr int NTOK = 32768, DM = 1024, SEQ = 2048, NB = 16, NH = 16, HD = 64, NE = 32, TOPK = 4, FF = 1024, PLE = 256, DEPTH = 2;
constexpr int CAP = NTOK;
constexpr int MAXT = 544;
constexpr int NSLOT = MAXT * 256;
constexpr float EPS = 1e-6f;
constexpr float LOG2E = 1.4426950408889634f;
constexpr float C2 = 0.125f * LOG2E;

constexpr size_t MiB = 1u << 20;
constexpr size_t WS_CTL = 0;
constexpr size_t WS_WQKV = 2 * MiB;
constexpr size_t WS_WO = WS_WQKV + 12 * MiB;
constexpr size_t WS_WG = WS_WO + 4 * MiB;
constexpr size_t WS_WP = WS_WG + 4 * MiB;
constexpr size_t WS_WGU = WS_WP + 2 * MiB;
constexpr size_t WS_WD = WS_WGU + 256 * MiB;
constexpr size_t WS_H = WS_WD + 128 * MiB;
constexpr size_t WS_HB = WS_H + 128 * MiB;
constexpr size_t WS_Q = WS_HB + 64 * MiB;
constexpr size_t WS_K = WS_Q + 64 * MiB;
constexpr size_t WS_V = WS_K + 64 * MiB;
constexpr size_t WS_O = WS_V + 64 * MiB;
constexpr size_t WS_PB = WS_O + 64 * MiB;
constexpr size_t WS_PJ = WS_PB + 32 * MiB;
constexpr size_t WS_ACT = WS_PJ + 128 * MiB;
constexpr size_t WS_Y = WS_ACT + 272 * MiB;
constexpr size_t WS_TOK = WS_Y + 272 * MiB;
constexpr size_t WS_GATE = WS_TOK + 4 * MiB;
constexpr size_t WS_PAIR = WS_GATE + 4 * MiB;
constexpr size_t WS_RSTD = WS_PAIR + 1 * MiB;
constexpr size_t WS_FL = WS_RSTD + 1 * MiB;
constexpr size_t WS_CB = WS_FL + 2 * MiB;
constexpr size_t WS_END = WS_CB + 2 * MiB;
constexpr int CW_CNT = 64;

__device__ __forceinline__ float bf2f(bf16_t v) { return __uint_as_float((unsigned)v << 16); }
__device__ __forceinline__ unsigned f2bf(float f) { unsigned u = __float_as_uint(f); return (u + 0x7fffu + ((u >> 16) & 1u)) >> 16; }
__device__ __forceinline__ unsigned pk2(float lo, float hi) { return f2bf(lo) | (f2bf(hi) << 16); }
__device__ __forceinline__ float wave_sum(float v) {
#pragma unroll
    for (int o = 1; o < 64; o <<= 1) v += __shfl_xor(v, o);
    return v;
}
__device__ __forceinline__ float wave_max(float v) {
#pragma unroll
    for (int o = 1; o < 64; o <<= 1) v = fmaxf(v, __shfl_xor(v, o));
    return v;
}
__device__ __forceinline__ int crow(int r, int hi) { return (r & 3) + 8 * (r >> 2) + 4 * hi; }
__device__ __forceinline__ float sigmoidf_(float x) { return 1.f / (1.f + __expf(-x)); }
__device__ __forceinline__ float log_sigmoid(float x) { return fminf(x, 0.f) - log1pf(__expf(-fabsf(x))); }

struct MoeTile { int e, rank0, cnt, tstart; bool ok; };
__device__ __forceinline__ MoeTile moe_tile(const unsigned* cnt, int T) {
    const int lane = threadIdx.x & 63;
    const int c = (lane < NE) ? (int)cnt[lane] : 0;
    const int nt = (c + 255) >> 8;
    int incl = nt;
#pragma unroll
    for (int o = 1; o < 32; o <<= 1) { int t = __shfl_up(incl, o); if ((lane & 31) >= o) incl += t; }
    const int excl = incl - nt;
    const unsigned long long m = __ballot(lane < NE && excl <= T && nt > 0 && T < incl);
    MoeTile r; r.ok = (m != 0ull);
    const int e = r.ok ? (int)__builtin_ctzll(m) : 0;
    r.e = e; r.tstart = __shfl(excl, e); r.cnt = __shfl(c, e); r.rank0 = (T - r.tstart) * 256;
    return r;
}
__device__ __forceinline__ int moe_tstart(const unsigned* cnt, int e) {
    const int lane = threadIdx.x & 63;
    const int c = (lane < NE) ? (int)cnt[lane] : 0;
    const int nt = (c + 255) >> 8;
    int incl = nt;
#pragma unroll
    for (int o = 1; o < 32; o <<= 1) { int t = __shfl_up(incl, o); if ((lane & 31) >= o) incl += t; }
    return __shfl(incl - nt, e);
}

__global__ void __launch_bounds__(256) k_rowstat(const float* __restrict__ h, bf16_t* __restrict__ hb, float* __restrict__ rstd) {
    const int lane = threadIdx.x & 63, row = blockIdx.x * 4 + (threadIdx.x >> 6);
    const f32x4* p = (const f32x4*)(h + (size_t)row * DM) + lane;
    f32x4 v[4]; float s = 0.f;
#pragma unroll
    for (int j = 0; j < 4; ++j) { v[j] = p[64 * j]; s += v[j].x * v[j].x + v[j].y * v[j].y + v[j].z * v[j].z + v[j].w * v[j].w; }
    s = wave_sum(s);
    if (lane == 0) rstd[row] = rsqrtf(s * (1.f / DM) + EPS);
    u32x2* o = (u32x2*)(hb + (size_t)row * DM) + lane;
#pragma unroll
    for (int j = 0; j < 4; ++j) { u32x2 w; w.x = pk2(v[j].x, v[j].y); w.y = pk2(v[j].z, v[j].w); o[64 * j] = w; }
}
__global__ void __launch_bounds__(256) k_cvt(const float* __restrict__ s, bf16_t* __restrict__ d, size_t n4) {
    size_t i = (size_t)blockIdx.x * 256 + threadIdx.x;
    if (i < n4) { f32x4 v = ((const f32x4*)s)[i]; u32x2 w; w.x = pk2(v.x, v.y); w.y = pk2(v.z, v.w); ((u32x2*)d)[i] = w; }
}
template <int MODE>
__global__ void __launch_bounds__(256) k_cvt_t(const float* __restrict__ src, const float* __restrict__ g, bf16_t* __restrict__ dst, int K, int N) {
    __shared__ float tile[64][65];
    const int n0 = blockIdx.x * 64, k0 = blockIdx.y * 64, b = blockIdx.z, tid = threadIdx.x;
    const float* s = src + (size_t)b * K * N; bf16_t* d = dst + (size_t)b * K * N;
#pragma unroll
    for (int i = 0; i < 16; ++i) { const int kk = i * 4 + (tid >> 6), nn = tid & 63; const float gg = g ? g[k0 + kk] : 1.f; tile[kk][nn] = s[(size_t)(k0 + kk) * N + n0 + nn] * gg; }
    __syncthreads();
#pragma unroll
    for (int j = 0; j < 2; ++j) {
        const int c = tid + 256 * j, n = c >> 3, kc = c & 7;
        u32x4 w; w.x = pk2(tile[kc * 8 + 0][n], tile[kc * 8 + 1][n]); w.y = pk2(tile[kc * 8 + 2][n], tile[kc * 8 + 3][n]);
        w.z = pk2(tile[kc * 8 + 4][n], tile[kc * 8 + 5][n]); w.w = pk2(tile[kc * 8 + 6][n], tile[kc * 8 + 7][n]);
        int nn = n0 + n;
        if (MODE == 1) { const int half = nn / FF, j2 = nn % FF; nn = (j2 >> 7) * 256 + half * 128 + (j2 & 127); }
        *(u32x4*)(d + (size_t)nn * K + k0 + kc * 8) = w;
    }
}

template <bool DUAL>
__device__ __forceinline__ void gemm_tile64(const bf16_t* a0, const bf16_t* a1, const bf16_t* B1, const bf16_t* B2, int K, f32x16 (&acc)[2][2], f32x16 (&acc2)[2][2]) {
    const int lane = threadIdx.x & 63, r32 = lane & 31, hi = lane >> 5;
    const bf16_t* b0 = B1 + (size_t)r32 * K + 8 * hi; const bf16_t* b1 = B1 + (size_t)(32 + r32) * K + 8 * hi;
    const bf16_t* c0 = DUAL ? B2 + (size_t)r32 * K + 8 * hi : nullptr; const bf16_t* c1 = DUAL ? B2 + (size_t)(32 + r32) * K + 8 * hi : nullptr;
    a0 += 8 * hi; a1 += 8 * hi;
#pragma unroll
    for (int i = 0; i < 2; ++i)
#pragma unroll
        for (int j = 0; j < 2; ++j) { acc[i][j] = f32x16{}; acc2[i][j] = f32x16{}; }
    for (int k = 0; k < K; k += 16) {
        const bf16x8 fa0 = *(const bf16x8*)(a0 + k), fa1 = *(const bf16x8*)(a1 + k), fb0 = *(const bf16x8*)(b0 + k), fb1 = *(const bf16x8*)(b1 + k);
        acc[0][0] = __builtin_amdgcn_mfma_f32_32x32x16_bf16(fa0, fb0, acc[0][0], 0, 0, 0);
        acc[0][1] = __builtin_amdgcn_mfma_f32_32x32x16_bf16(fa0, fb1, acc[0][1], 0, 0, 0);
        acc[1][0] = __builtin_amdgcn_mfma_f32_32x32x16_bf16(fa1, fb0, acc[1][0], 0, 0, 0);
        acc[1][1] = __builtin_amdgcn_mfma_f32_32x32x16_bf16(fa1, fb1, acc[1][1], 0, 0, 0);
        if (DUAL) {
            const bf16x8 fc0 = *(const bf16x8*)(c0 + k), fc1 = *(const bf16x8*)(c1 + k);
            acc2[0][0] = __builtin_amdgcn_mfma_f32_32x32x16_bf16(fa0, fc0, acc2[0][0], 0, 0, 0);
            acc2[0][1] = __builtin_amdgcn_mfma_f32_32x32x16_bf16(fa0, fc1, acc2[0][1], 0, 0, 0);
            acc2[1][0] = __builtin_amdgcn_mfma_f32_32x32x16_bf16(fa1, fc0, acc2[1][0], 0, 0, 0);
            acc2[1][1] = __builtin_amdgcn_mfma_f32_32x32x16_bf16(fa1, fc1, acc2[1][1], 0, 0, 0);
        }
    }
}
#define TILE_FOREACH(...) _Pragma("unroll") for (int mi = 0; mi < 2; ++mi) _Pragma("unroll") for (int ni = 0; ni < 2; ++ni) _Pragma("unroll") for (int r = 0; r < 16; ++r) { \
        const int lrow = 32 * mi + crow(r, hi), lcol = 32 * ni + r32; const float v = acc[mi][ni][r]; const float v2 = acc2[mi][ni][r]; (void)v2; __VA_ARGS__ }

__global__ void __launch_bounds__(64) k_gemm_qkv(const bf16_t* __restrict__ A, const bf16_t* __restrict__ Bt, const float* __restrict__ rstd, bf16_t* __restrict__ Q) {
    const int lane = threadIdx.x, r32 = lane & 31, hi = lane >> 5; const int m0 = blockIdx.y * 64, n0 = blockIdx.x * 64;
    f32x16 acc[2][2], acc2[2][2];
    gemm_tile64<false>(A + (size_t)(m0 + r32) * DM, A + (size_t)(m0 + 32 + r32) * DM, Bt + (size_t)n0 * DM, nullptr, DM, acc, acc2);
    const int t = n0 / DM; bf16_t* out = Q + (size_t)t * ((WS_K - WS_Q) / 2); const float sc = (t == 0) ? C2 : 1.f;
    TILE_FOREACH({ const int row = m0 + lrow, col = n0 - t * DM + lcol; out[(size_t)row * DM + col] = (bf16_t)f2bf(v * rstd[row] * sc); })
}
__global__ void __launch_bounds__(64) k_gemm_wo(const bf16_t* __restrict__ A, const bf16_t* __restrict__ Bt, const float* hin, float* hout, bf16_t* __restrict__ hb) {
    const int lane = threadIdx.x, r32 = lane & 31, hi = lane >> 5; const int m0 = blockIdx.y * 64, n0 = blockIdx.x * 64;
    f32x16 acc[2][2], acc2[2][2];
    gemm_tile64<false>(A + (size_t)(m0 + r32) * DM, A + (size_t)(m0 + 32 + r32) * DM, Bt + (size_t)n0 * DM, nullptr, DM, acc, acc2);
    TILE_FOREACH({ const size_t o = (size_t)(m0 + lrow) * DM + n0 + lcol; const float x = hin[o] + v; hout[o] = x; hb[o] = (bf16_t)f2bf(x); })
}
__global__ void __launch_bounds__(64) k_gemm_pj(const bf16_t* __restrict__ A, const bf16_t* __restrict__ Bt, bf16_t* __restrict__ PJ) {
    const int lane = threadIdx.x, r32 = lane & 31, hi = lane >> 5; const int m0 = blockIdx.y * 64, n0 = blockIdx.x * 64;
    f32x16 acc[2][2], acc2[2][2];
    gemm_tile64<false>(A + (size_t)(m0 + r32) * PLE, A + (size_t)(m0 + 32 + r32) * PLE, Bt + (size_t)n0 * PLE, nullptr, PLE, acc, acc2);
    TILE_FOREACH({ PJ[(size_t)(m0 + lrow) * DM + n0 + lcol] = (bf16_t)f2bf(v); })
}
__global__ void __launch_bounds__(64) k_gemm_ple(const bf16_t* __restrict__ A, const bf16_t* __restrict__ Bt, const float* __restrict__ rstd, const bf16_t* __restrict__ PJ, float* h, bf16_t* hb) {
    const int lane = threadIdx.x, r32 = lane & 31, hi = lane >> 5; const int m0 = blockIdx.y * 64, n0 = blockIdx.x * 64;
    f32x16 acc[2][2], acc2[2][2];
    gemm_tile64<false>(A + (size_t)(m0 + r32) * DM, A + (size_t)(m0 + 32 + r32) * DM, Bt + (size_t)n0 * DM, nullptr, DM, acc, acc2);
    TILE_FOREACH({ const int row = m0 + lrow; const size_t o = (size_t)row * DM + n0 + lcol; const float x = h[o] + sigmoidf_(v * rstd[row]) * bf2f(PJ[o]); h[o] = x; })
}
__global__ void __launch_bounds__(64) k_gemm_gu(const bf16_t* __restrict__ HB, const bf16_t* __restrict__ Wgu, const float* __restrict__ bgu, const float* __restrict__ rstd,
                                                const unsigned* __restrict__ cnt, const int* __restrict__ tok_of, bf16_t* __restrict__ ACT) {
    const int lane = threadIdx.x, r32 = lane & 31, hi = lane >> 5; const int rt = blockIdx.y, T = rt >> 2, j0 = blockIdx.x * 64;
    const MoeTile mt = moe_tile(cnt, T); if (!mt.ok) return;
    const int lr0 = (rt & 3) * 64; const int rk0 = mt.rank0 + lr0 + r32, rk1 = rk0 + 32;
    const int t0 = rk0 < mt.cnt ? tok_of[(size_t)mt.e * CAP + rk0] : 0, t1 = rk1 < mt.cnt ? tok_of[(size_t)mt.e * CAP + rk1] : 0;
    const bf16_t* Be = Wgu + (size_t)mt.e * 2048 * DM + (size_t)((j0 >> 7) * 256 + (j0 & 127)) * DM;
    f32x16 acc[2][2], acc2[2][2];
    gemm_tile64<true>(HB + (size_t)t0 * DM, HB + (size_t)t1 * DM, Be, Be + (size_t)128 * DM, DM, acc, acc2);
    const size_t slot0 = (size_t)T * 256 + lr0;
    TILE_FOREACH({ const int rk = mt.rank0 + lr0 + lrow; if (rk < mt.cnt) { const int tk = tok_of[(size_t)mt.e * CAP + rk]; const float rs = rstd[tk]; const int j = j0 + lcol;
        float gl = v * rs + bgu[(size_t)mt.e * 2048 + j], ln = v2 * rs + bgu[(size_t)mt.e * 2048 + FF + j];
        gl = fminf(gl, 7.f); ln = fminf(fmaxf(ln, -7.f), 7.f);
        const float a = gl * sigmoidf_(1.702f * gl) * (ln + 1.f);
        ACT[(slot0 + lrow) * FF + j] = (bf16_t)f2bf(a); } })
}
__global__ void __launch_bounds__(64) k_gemm_down(const bf16_t* __restrict__ ACT, const bf16_t* __restrict__ Wd, const float* __restrict__ bd, const unsigned* __restrict__ cnt,
                                                  const float* __restrict__ gate_of, bf16_t* __restrict__ Y) {
    const int lane = threadIdx.x, r32 = lane & 31, hi = lane >> 5; const int rt = blockIdx.y, T = rt >> 2, n0 = blockIdx.x * 64;
    const MoeTile mt = moe_tile(cnt, T); if (!mt.ok) return;
    const int lr0 = (rt & 3) * 64; const size_t slot0 = (size_t)T * 256 + lr0;
    const int rk0 = mt.rank0 + lr0 + r32, rk1 = rk0 + 32;
    const size_t s0 = rk0 < mt.cnt ? slot0 + r32 : (size_t)T * 256, s1 = rk1 < mt.cnt ? slot0 + 32 + r32 : (size_t)T * 256;
    f32x16 acc[2][2], acc2[2][2];
    gemm_tile64<false>(ACT + s0 * FF, ACT + s1 * FF, Wd + (size_t)mt.e * DM * FF + (size_t)n0 * FF, nullptr, FF, acc, acc2);
    TILE_FOREACH({ const int rk = mt.rank0 + lr0 + lrow; if (rk < mt.cnt) { const float gt = gate_of[(size_t)mt.e * CAP + rk]; const int n = n0 + lcol;
        Y[(slot0 + lrow) * DM + n] = (bf16_t)f2bf((v + bd[(size_t)mt.e * DM + n]) * gt); } })
}

__global__ void __launch_bounds__(256) k_router(const float* __restrict__ h, const float* __restrict__ g, const float* __restrict__ wr, const float* __restrict__ br,
                                                float* __restrict__ rstd, unsigned* cnt, int* __restrict__ tok_of, float* __restrict__ gate_of, unsigned* __restrict__ pair) {
    const int lane = threadIdx.x & 63, t = blockIdx.x * 4 + (threadIdx.x >> 6); const int e = lane & 31, half = lane >> 5;
    const float* hr = h + (size_t)t * DM;
    float ss = 0.f;
#pragma unroll
    for (int j = 0; j < 4; ++j) { const f32x4 v = ((const f32x4*)hr)[lane + 64 * j]; ss += v.x * v.x + v.y * v.y + v.z * v.z + v.w * v.w; }
    const float rs = rsqrtf(wave_sum(ss) * (1.f / DM) + EPS);
    float a = 0.f;
    for (int d = half * 512; d < half * 512 + 512; ++d) a += hr[d] * g[d] * wr[(size_t)d * NE + e];
    a += __shfl_xor(a, 32);
    float lg = a * rs + br[e];
    float tv[4]; int ti[4];
#pragma unroll
    for (int k = 0; k < 4; ++k) {
        float bv = lg; int bi = e;
#pragma unroll
        for (int o = 1; o < 32; o <<= 1) { const float ov = __shfl_xor(bv, o); const int oi = __shfl_xor(bi, o); if (ov > bv || (ov == bv && oi < bi)) { bv = ov; bi = oi; } }
        tv[k] = bv; ti[k] = bi; if (e == bi) lg = -INFINITY;
    }
    float w[4], sw = 0.f;
#pragma unroll
    for (int k = 0; k < 4; ++k) { w[k] = __expf(tv[k] - tv[0]); sw += w[k]; }
    if (lane == 0) rstd[t] = rs;
    if (lane < 4) {
        const int k = lane; const int ee = (k == 0) ? ti[0] : (k == 1) ? ti[1] : (k == 2) ? ti[2] : ti[3]; const float ww = (k == 0) ? w[0] : (k == 1) ? w[1] : (k == 2) ? w[2] : w[3];
        const unsigned rk = atomicAdd(&cnt[ee], 1u);
        tok_of[(size_t)ee * CAP + rk] = t; gate_of[(size_t)ee * CAP + rk] = ww / sw; pair[(size_t)t * 4 + k] = ((unsigned)ee << 16) | rk;
    }
}
__global__ void __launch_bounds__(256) k_combine(float* h, bf16_t* __restrict__ hb, float* __restrict__ rstd, const unsigned* __restrict__ cnt, const unsigned* __restrict__ pair, const bf16_t* __restrict__ Y) {
    const int lane = threadIdx.x & 63, t = blockIdx.x * 4 + (threadIdx.x >> 6);
    f32x4 v[4]; f32x4* hr = (f32x4*)(h + (size_t)t * DM) + lane;
#pragma unroll
    for (int j = 0; j < 4; ++j) v[j] = hr[64 * j];
    for (int k = 0; k < 4; ++k) {
        const unsigned pr = pair[(size_t)t * 4 + k]; const int e = pr >> 16, rk = pr & 0xffff;
        const size_t slot = (size_t)moe_tstart(cnt, e) * 256 + rk;
        const u32x2* yr = (const u32x2*)(Y + slot * DM) + lane;
#pragma unroll
        for (int j = 0; j < 4; ++j) { const u32x2 w = yr[64 * j]; v[j].x += __uint_as_float(w.x << 16); v[j].y += __uint_as_float(w.x & 0xffff0000u); v[j].z += __uint_as_float(w.y << 16); v[j].w += __uint_as_float(w.y & 0xffff0000u); }
    }
    float s = 0.f;
#pragma unroll
    for (int j = 0; j < 4; ++j) { hr[64 * j] = v[j]; s += v[j].x * v[j].x + v[j].y * v[j].y + v[j].z * v[j].z + v[j].w * v[j].w; }
    s = wave_sum(s); if (lane == 0) rstd[t] = rsqrtf(s * (1.f / DM) + EPS);
    u32x2* o = (u32x2*)(hb + (size_t)t * DM) + lane;
#pragma unroll
    for (int j = 0; j < 4; ++j) { u32x2 w; w.x = pk2(v[j].x, v[j].y); w.y = pk2(v[j].z, v[j].w); o[64 * j] = w; }
}
__global__ void __launch_bounds__(256) k_final(const float* __restrict__ h, const float* __restrict__ g, float* __restrict__ out) {
    const int lane = threadIdx.x & 63, row = blockIdx.x * 4 + (threadIdx.x >> 6);
    const f32x4* p = (const f32x4*)(h + (size_t)row * DM) + lane; f32x4 v[4]; float s = 0.f;
#pragma unroll
    for (int j = 0; j < 4; ++j) { v[j] = p[64 * j]; s += v[j].x * v[j].x + v[j].y * v[j].y + v[j].z * v[j].z + v[j].w * v[j].w; }
    const float rs = rsqrtf(wave_sum(s) * (1.f / DM) + EPS);
    f32x4* o = (f32x4*)(out + (size_t)row * DM) + lane;
#pragma unroll
    for (int j = 0; j < 4; ++j) { const f32x4 gg = ((const f32x4*)g)[lane + 64 * j]; o[64 * j] = v[j] * rs * gg; }
}
__global__ void __launch_bounds__(256) k_fgate(const float* __restrict__ h, const float* __restrict__ g, const float* __restrict__ wf, const float* __restrict__ bfg, const float* __restrict__ rstd, float* __restrict__ fl) {
    const int lane = threadIdx.x & 63, t = blockIdx.x * 4 + (threadIdx.x >> 6); const int hh = lane & 15, q = lane >> 4;
    const float* hr = h + (size_t)t * DM; float a = 0.f;
    for (int d = q * 256; d < q * 256 + 256; ++d) a += hr[d] * g[d] * wf[(size_t)d * NH + hh];
    a += __shfl_xor(a, 16); a += __shfl_xor(a, 32);
    if (lane < 16) fl[(size_t)t * NH + hh] = a * rstd[t] + bfg[hh];
}
__global__ void __launch_bounds__(64) k_scan(const float* __restrict__ fl, float* __restrict__ cb) {
    const int lane = threadIdx.x, bh = blockIdx.x, b = bh / NH, hh = bh % NH;
    float loc[32]; float run = 0.f;
#pragma unroll
    for (int i = 0; i < 32; ++i) { run += log_sigmoid(fl[(size_t)(b * SEQ + lane * 32 + i) * NH + hh]); loc[i] = run; }
    float incl = run;
#pragma unroll
    for (int o = 1; o < 64; o <<= 1) { const float t = __shfl_up(incl, o); if (lane >= o) incl += t; }
    const float base = incl - run;
#pragma unroll
    for (int i = 0; i < 32; ++i) cb[(size_t)bh * SEQ + lane * 32 + i] = (base + loc[i]) * LOG2E;
}

__device__ __forceinline__ float dot64(const float (&q)[64], const bf16_t* kr) {
    float a = 0.f;
#pragma unroll
    for (int c = 0; c < 8; ++c) { const u32x4 w = ((const u32x4*)kr)[c];
        a += q[8 * c + 0] * __uint_as_float(w.x << 16) + q[8 * c + 1] * __uint_as_float(w.x & 0xffff0000u) + q[8 * c + 2] * __uint_as_float(w.y << 16) + q[8 * c + 3] * __uint_as_float(w.y & 0xffff0000u)
           + q[8 * c + 4] * __uint_as_float(w.z << 16) + q[8 * c + 5] * __uint_as_float(w.z & 0xffff0000u) + q[8 * c + 6] * __uint_as_float(w.w << 16) + q[8 * c + 7] * __uint_as_float(w.w & 0xffff0000u); }
    return a;
}
__device__ __forceinline__ void loadq(float (&q)[64], const bf16_t* qr) {
#pragma unroll
    for (int c = 0; c < 8; ++c) { const u32x4 w = ((const u32x4*)qr)[c];
        q[8 * c + 0] = __uint_as_float(w.x << 16); q[8 * c + 1] = __uint_as_float(w.x & 0xffff0000u); q[8 * c + 2] = __uint_as_float(w.y << 16); q[8 * c + 3] = __uint_as_float(w.y & 0xffff0000u);
        q[8 * c + 4] = __uint_as_float(w.z << 16); q[8 * c + 5] = __uint_as_float(w.z & 0xffff0000u); q[8 * c + 6] = __uint_as_float(w.w << 16); q[8 * c + 7] = __uint_as_float(w.w & 0xffff0000u); }
}
__global__ void __launch_bounds__(256) k_attn_sb(const bf16_t* __restrict__ Q, const bf16_t* __restrict__ K, const bf16_t* __restrict__ V, bf16_t* __restrict__ O) {
    const int lane = threadIdx.x & 63; const int gw = blockIdx.x * 4 + (threadIdx.x >> 6); const int t = gw % SEQ, bh = gw / SEQ, b = bh / NH, hh = bh % NH;
    const size_t rowb = (size_t)b * SEQ; float q[64]; loadq(q, Q + (rowb + t) * DM + hh * HD);
    float o = 0.f, carry = 1.f;
    for (int jt = (t - 1) >> 6; jt >= 0 && t > 0; --jt) {
        const int s = 64 * jt + lane; const bool valid = s < t;
        float x = dot64(q, K + (rowb + s) * DM + hh * HD); x = fminf(x, 64.f);
        const float ex = exp2f(x), r = 1.f / (1.f + ex);
        const float beta = valid ? ex * r : 0.f, nb = valid ? r : 1.f;
        float P = nb;
#pragma unroll
        for (int off = 1; off < 64; off <<= 1) { const float t2 = __shfl_down(P, off); if (lane + off < 64) P *= t2; }
        float Pex = __shfl_down(P, 1); if (lane == 63) Pex = 1.f;
        const float a = beta * carry * Pex;
        carry *= __shfl(P, 0);
        const bf16_t* vb = V + (rowb + 64 * jt) * DM + hh * HD + lane;
        for (int l = 0; l < 64; ++l) { const float al = __shfl(a, l); o += al * bf2f(vb[(size_t)l * DM]); }
        if (carry < 1e-30f) break;
    }
    O[(rowb + t) * DM + hh * HD + lane] = (bf16_t)f2bf(o);
}
__global__ void __launch_bounds__(256) k_attn_fox(const bf16_t* __restrict__ Q, const bf16_t* __restrict__ K, const bf16_t* __restrict__ V, const float* __restrict__ cb, bf16_t* __restrict__ O) {
    const int lane = threadIdx.x & 63; const int gw = blockIdx.x * 4 + (threadIdx.x >> 6); const int t = gw % SEQ, bh = gw / SEQ, b = bh / NH, hh = bh % NH;
    const size_t rowb = (size_t)b * SEQ; float q[64]; loadq(q, Q + (rowb + t) * DM + hh * HD);
    float o = 0.f, m = -INFINITY, l = 0.f;
    for (int jt = 0; jt <= (t >> 6); ++jt) {
        const int s = 64 * jt + lane; const bool valid = s <= t;
        float x = dot64(q, K + (rowb + s) * DM + hh * HD) - cb[(size_t)bh * SEQ + s];
        x = valid ? x : -INFINITY;
        const float mn = fmaxf(m, wave_max(x)); const float alpha = exp2f(m - mn); const float p = exp2f(x - mn);
        l = l * alpha + wave_sum(p); o *= alpha; m = mn;
        const bf16_t* vb = V + (rowb + 64 * jt) * DM + hh * HD + lane;
        const int nl = min(64, t - 64 * jt + 1);
        for (int i = 0; i < nl; ++i) { const float pi = __shfl(p, i); o += pi * bf2f(vb[(size_t)i * DM]); }
    }
    O[(rowb + t) * DM + hh * HD + lane] = (bf16_t)f2bf(o / l);
}


#include <hip/hip_bf16.h>
#include <cmath>
namespace attn_body {
using bf16=__hip_bfloat16;
using bf16x8=__attribute__((ext_vector_type(8)))short;
using s16x4=__attribute__((ext_vector_type(4)))short;
using f32x16=__attribute__((ext_vector_type(16)))float;
using u32x4=__attribute__((ext_vector_type(4)))unsigned;
constexpr int BATCH=16,NHEAD=16,SEQ=2048,D=64,DM=NHEAD*D;
constexpr int NW=8,QBLK=32,QB=QBLK*NW,KVBLK=64,NQB=SEQ/QB;
constexpr int ATTN_PITCH=DM, ATTN_UNIT_ROWS=QB;
__device__ __forceinline__ int crow(int r,int hi){return (r&3)+8*(r>>2)+4*hi;}
#define SBAR() __builtin_amdgcn_sched_barrier(0)
__device__ __forceinline__ void cmask(f32x16&p0,f32x16&p1,int jb,int qrel,int hi){
  const float NEG=-INFINITY; int kb=64*jb+4*hi;
  #pragma unroll
  for(int r=0;r<16;++r){int kv=kb+(r&3)+8*(r>>2); if(kv>qrel)p0[r]=NEG; if(kv+32>qrel)p1[r]=NEG;}
}

constexpr int NSLOT=3, SLOTB=8192;
constexpr int LDS_K=0, LDS_V=NSLOT*SLOTB, LDS_WS=2*NSLOT*SLOTB, LDS_OST=LDS_WS+NW*64*4, LDS_BYTES=LDS_OST+NW*4096;
constexpr float C2=0.125f*1.4426950408889634f;
__device__ __forceinline__ void glds16(const void*gsrc,unsigned lds_dst){unsigned keep;
  asm volatile("s_mov_b32 %0, m0\n\ts_mov_b32 m0, %2\n\ts_nop 0\n\tglobal_load_lds_dwordx4 %1, off\n\ts_mov_b32 m0, %0":"=&s"(keep):"v"(gsrc),"s"(lds_dst):"memory");}
__device__ __forceinline__ float max3f(float a,float b,float c){float r;asm("v_max3_f32 %0, %1, %2, %3":"=v"(r):"v"(a),"v"(b),"v"(c));return r;}
__device__ __forceinline__ float max2f(float a,float b){float r;asm("v_max_f32_e32 %0, %1, %2":"=v"(r):"v"(a),"v"(b));return r;}
__device__ __forceinline__ float fadd_s(float a,float b){float r;asm("v_add_f32_e32 %0, %1, %2":"=v"(r):"v"(a),"v"(b));return r;}
__device__ __forceinline__ float fsub_s(float a,float b){float r;asm("v_sub_f32_e32 %0, %1, %2":"=v"(r):"v"(a),"v"(b));return r;}
typedef float f32x2_t __attribute__((ext_vector_type(2))); typedef __bf16 bf16x2_t __attribute__((ext_vector_type(2)));
__device__ __forceinline__ unsigned cvtpk_s(float lo,float hi){f32x2_t v={lo,hi};bf16x2_t b=__builtin_convertvector(v,bf16x2_t);return __builtin_bit_cast(unsigned,b);}
#define WAIT_BAR(N) asm volatile("s_waitcnt vmcnt(" #N ") lgkmcnt(0)\n\ts_barrier":::"memory")

__device__ __forceinline__ void qkt(f32x16&p0,f32x16&p1,const char*Kslot,const bf16x8*qr,const f32x16&negm,int r32,int hi){
  const char*kb=Kslot+hi*1024+r32*16;
  #pragma unroll
  for(int d0=0;d0<4;++d0){
    const bf16x8 b0=*reinterpret_cast<const bf16x8*>(kb+d0*2048);
    const bf16x8 b1=*reinterpret_cast<const bf16x8*>(kb+d0*2048+512);
    if(d0==0){p0=__builtin_amdgcn_mfma_f32_32x32x16_bf16(b0,qr[0],negm,0,0,0);p1=__builtin_amdgcn_mfma_f32_32x32x16_bf16(b1,qr[0],negm,0,0,0);}
    else{p0=__builtin_amdgcn_mfma_f32_32x32x16_bf16(b0,qr[d0],p0,0,0,0);p1=__builtin_amdgcn_mfma_f32_32x32x16_bf16(b1,qr[d0],p1,0,0,0);}}
}
typedef __attribute__((address_space(3))) const char* lds_cptr;
typedef short v4i16_t __attribute__((ext_vector_type(4)));
__device__ __forceinline__ void kload8(bf16x8*kf,lds_cptr kp){
  kf[0]=*(const __attribute__((address_space(3))) bf16x8*)(kp);      kf[1]=*(const __attribute__((address_space(3))) bf16x8*)(kp+512);
  kf[2]=*(const __attribute__((address_space(3))) bf16x8*)(kp+2048); kf[3]=*(const __attribute__((address_space(3))) bf16x8*)(kp+2560);
  kf[4]=*(const __attribute__((address_space(3))) bf16x8*)(kp+4096); kf[5]=*(const __attribute__((address_space(3))) bf16x8*)(kp+4608);
  kf[6]=*(const __attribute__((address_space(3))) bf16x8*)(kp+6144); kf[7]=*(const __attribute__((address_space(3))) bf16x8*)(kp+6656);
}
__device__ __forceinline__ void kload2(bf16x8*kf,lds_cptr kp,int j){ kf[2*j]=*(const __attribute__((address_space(3))) bf16x8*)(kp+j*2048); kf[2*j+1]=*(const __attribute__((address_space(3))) bf16x8*)(kp+j*2048+512); }
__device__ __forceinline__ s16x4 vtr(lds_cptr p){ return __builtin_bit_cast(s16x4,__builtin_amdgcn_ds_read_tr16_b64_v4i16((__attribute__((address_space(3))) v4i16_t*)p)); }
__device__ __forceinline__ float rowmax(const f32x16&p0,const f32x16&p1){
  float a=max3f(p0[0],p0[1],p1[0]),b=max3f(p0[2],p0[3],p1[1]);a=max3f(a,p1[2],p1[3]);
  #pragma unroll
  for(int r=4;r<16;r+=4){a=max3f(a,p0[r],p0[r+1]);b=max3f(b,p0[r+2],p0[r+3]);a=max3f(a,p1[r],p1[r+1]);b=max3f(b,p1[r+2],p1[r+3]);}
  const float m=max2f(a,b);
  auto rr=__builtin_amdgcn_permlane32_swap(__float_as_uint(m),__float_as_uint(m),false,false);
  return max2f(__uint_as_float(rr[0]),__uint_as_float(rr[1]));
}
__device__ __forceinline__ void pv(f32x16*o,int vb,bf16x8 pa0,bf16x8 pa1,bf16x8 pa2,bf16x8 pa3){
  #pragma unroll
  for(int d0=0;d0<2;++d0){s16x4 lo[4],hi[4];
    #pragma unroll
    for(int ks=0;ks<4;++ks){
      asm volatile("ds_read_b64_tr_b16 %0,%1 offset:%c2":"=&v"(lo[ks]):"v"(vb),"i"(d0*4096+ks*1024):"memory");
      asm volatile("ds_read_b64_tr_b16 %0,%1 offset:%c2":"=&v"(hi[ks]):"v"(vb),"i"(d0*4096+ks*1024+512):"memory");}
    asm volatile("s_waitcnt lgkmcnt(0)":::"memory");SBAR();
    #define PK(k) (bf16x8){lo[k][0],lo[k][1],lo[k][2],lo[k][3],hi[k][0],hi[k][1],hi[k][2],hi[k][3]}
    o[d0]=__builtin_amdgcn_mfma_f32_32x32x16_bf16(pa0,PK(0),o[d0],0,0,0);
    o[d0]=__builtin_amdgcn_mfma_f32_32x32x16_bf16(pa1,PK(1),o[d0],0,0,0);
    o[d0]=__builtin_amdgcn_mfma_f32_32x32x16_bf16(pa2,PK(2),o[d0],0,0,0);
    o[d0]=__builtin_amdgcn_mfma_f32_32x32x16_bf16(pa3,PK(3),o[d0],0,0,0);
    #undef PK
  }
}

#ifndef ATTN_STORE16
#define ATTN_STORE16(p,v) (*(u32x4*)(p)=(v))
#endif
typedef float f32x4b __attribute__((ext_vector_type(4)));
template<int THRL> __device__ __forceinline__ void attn_unit(int b,int h,int qb,const bf16*Q,const bf16*__restrict__ K,const bf16*__restrict__ V,bf16*O,char*shm,const __attribute__((address_space(3))) float*cb){
  int tid_=threadIdx.x; asm volatile("":"+v"(tid_));
  const int tid=tid_,lane=tid&63,r32=lane&31,hi=lane>>5; const int wid=__builtin_amdgcn_readfirstlane(tid>>6);
  const long rowbase=(long)b*SEQ; const int q0=qb*QB;
  const bf16*Qw=Q+(rowbase+q0+wid*QBLK)*DM+h*D;
  const bf16*Kh=K+rowbase*DM+h*D,*Vh=V+rowbase*DM+h*D;
  const unsigned lds0=(unsigned)(uintptr_t)shm;
  float*wsf=(float*)(shm+LDS_WS)+wid*64;
  const bf16*ksrc=Kh+(long)lane*DM+wid*8;
  const bf16*vsrc=Vh+(long)(16*(wid&3)+(lane>>2))*DM+(wid>>2)*32+(lane&3)*8;
  const unsigned kdst=lds0+LDS_K+wid*1024, vdst=lds0+LDS_V+wid*1024;
  #define TIDX(u) (NT-1-(u))
  #define DMA_K(t,slot) glds16(ksrc+(long)TIDX(t)*KVBLK*DM,(unsigned)__builtin_amdgcn_readfirstlane(kdst+(slot)))
  #define DMA_V(t,slot) glds16(vsrc+(long)TIDX(t)*KVBLK*DM,(unsigned)__builtin_amdgcn_readfirstlane(vdst+(slot)))
  const int vb0=(int)(lds0+LDS_V)+((lane>>4)&1)*32+(lane&3)*8+(4*hi+((lane&15)>>2))*64;
  const char*Kbase=shm+LDS_K; bf16x8 kf[8];
  const lds_cptr shm3=(lds_cptr)shm; const lds_cptr kp0=shm3+LDS_K+hi*1024+r32*16; const lds_cptr vp0=shm3+LDS_V+((lane>>4)&1)*32+(lane&3)*8+(4*hi+((lane&15)>>2))*64;
  const int NT=(q0+QB)/KVBLK;
  DMA_K(0,0);DMA_V(0,0);DMA_K(1,SLOTB);
  bf16x8 qr[4];
  #pragma unroll
  for(int d0=0;d0<4;++d0)qr[d0]=*reinterpret_cast<const bf16x8*>(&Qw[(long)r32*DM+d0*16+hi*8]);
  float mhat=0.f,l_reg=0.f;f32x16 o[2];o[0]=f32x16{};o[1]=f32x16{};const f32x16 negm=f32x16{};
  const int qrel=wid*QBLK+r32;
  #define CMASK(P0,P1,t) do{int jb_=3-(t); if(jb_>=0)cmask(P0,P1,jb_,qrel,hi);}while(0)
  #define ABIAS(P0,P1,t) do{ const __attribute__((address_space(3))) f32x4b*cbp_=(const __attribute__((address_space(3))) f32x4b*)(cb+64*TIDX(t)+4*hi); \
    _Pragma("unroll") for(int g_=0;g_<4;++g_){ const f32x4b b0_=cbp_[2*g_], b1_=cbp_[8+2*g_]; \
      P0[4*g_+0]+=b0_[0];P0[4*g_+1]+=b0_[1];P0[4*g_+2]+=b0_[2];P0[4*g_+3]+=b0_[3]; P1[4*g_+0]+=b1_[0];P1[4*g_+1]+=b1_[1];P1[4*g_+2]+=b1_[2];P1[4*g_+3]+=b1_[3]; } }while(0)
  #define BLD(G,t,h) f32x4b nb##h##_[4]; { const __attribute__((address_space(3))) f32x4b*cbp_=(const __attribute__((address_space(3))) f32x4b*)(cb+64*TIDX(t)+4*hi+32*(h)); \
      _Pragma("unroll") for(int g_=0;g_<4;++g_) nb##h##_[g_]=cbp_[2*g_]; }
  #define BSUB(G,P,h) if(G){ const float mh_=mhat; _Pragma("unroll") for(int g_=0;g_<4;++g_){ \
      P[4*g_+0]=nb##h##_[g_][0]-mh_;P[4*g_+1]=nb##h##_[g_][1]-mh_;P[4*g_+2]=nb##h##_[g_][2]-mh_;P[4*g_+3]=nb##h##_[g_][3]-mh_; } }
  bool resc=false;
  #define START(P0,P1) do{ const float rm=rowmax(P0,P1); resc=false; \
    { const float dl=(rm>-INFINITY)?rm:0.f; mhat=fadd_s(mhat,dl);     \
      _Pragma("unroll") for(int r=0;r<16;++r){P0[r]=fsub_s(P0[r],dl);P1[r]=fsub_s(P1[r],dl);} \
      } \
    _Pragma("unroll") for(int r=0;r<16;++r)P0[r]=__builtin_amdgcn_exp2f(P0[r]); }while(0)
  #define RESC() do{ if(resc){ asm volatile("s_waitcnt lgkmcnt(0)":::"memory"); \
      _Pragma("unroll") for(int d_=0;d_<2;++d_) _Pragma("unroll") for(int r=0;r<16;++r)o[d_][r]*=wsf[crow(r,hi)]; } }while(0)
  f32x16 pA0,pA1,pB0,pB1;
  int sl_prev=0,sl_cur=0,sl_next=SLOTB;
  #define ROT() do{sl_prev=sl_cur;sl_cur=sl_next;sl_next=(sl_next==(NSLOT-1)*SLOTB)?0:sl_next+SLOTB;}while(0)
  DMA_K(2,2*SLOTB);
  WAIT_BAR(3);
  qkt(pA0,pA1,Kbase,qr,negm,r32,hi);asm volatile("s_nop 15\n\ts_nop 7":"+v"(pA0),"+v"(pA1));ABIAS(pA0,pA1,0);CMASK(pA0,pA1,0);
  START(pA0,pA1);
  _Pragma("unroll") for(int r=0;r<16;++r)pA1[r]=__builtin_amdgcn_exp2f(pA1[r]);
  { BLD(true,1,0) BLD(true,1,1) BSUB(true,pB0,0) BSUB(true,pB1,1) }
  WAIT_BAR(0);
  DMA_K(3,0);DMA_V(1,SLOTB);
  ROT();
  kload8(kf,kp0+sl_cur);
  WAIT_BAR(2);
  s16x4 vlo[8],vhi[8]; u32x4 pw0,pw1,pw2,pw3;
  #define PKW(P,B) cvtpk_s(P[B],P[B+1])
  #define PAF(k) __builtin_bit_cast(bf16x8,pw##k)
  #define VFR(i) (bf16x8){vlo[i][0],vlo[i][1],vlo[i][2],vlo[i][3],vhi[i][0],vhi[i][1],vhi[i][2],vhi[i][3]}
  #define PIN(x) asm volatile("":"+v"(x))
  #define MX3(a,b,c) __builtin_fmaxf(__builtin_fmaxf((a),(b)),(c))
  #define GAPA(MF,A0,A1,A2,A3,W0,W1,PW) do{ MF; sacc+=A0; sacc+=A1; sacc+=A2; sacc+=A3; PIN(sacc); W0; W1; PIN(PW); SBAR(); }while(0)
  #define EX(v) __builtin_amdgcn_exp2f(v)
  #define GAPB(MF,X,B) do{ MF; X[B]=EX(X[B]); X[B+1]=EX(X[B+1]); X[B+2]=EX(X[B+2]); X[B+3]=EX(X[B+3]); PIN(X); SBAR(); }while(0)
  #define VRD(i) do{ vlo[i]=vtr(vp_+(((i)>>2)*4096+((i)&3)*1024)); vhi[i]=vtr(vp_+(((i)>>2)*4096+((i)&3)*1024+512)); }while(0)
  #define KRD(G,j) do{ if(G){ kload2(kf,kp0+sl_next,j); SBAR(); } }while(0)
  #define STEP(C0,C1,P0,P1,t,GK,GV,GL,GB) do{ SBAR(); \
    const lds_cptr vp_=vp0+sl_prev; \
    VRD(0); SBAR(); float sacc=(P0[0]+P0[1]); \
    GAPA(C0=__builtin_amdgcn_mfma_f32_32x32x16_bf16(kf[0],qr[0],C0,0,0,0), P0[2],P0[3],P0[4],P0[5],     pw0[0]=PKW(P0,0), pw0[1]=PKW(P0,2), pw0); \
    VRD(4); SBAR(); GAPA(C1=__builtin_amdgcn_mfma_f32_32x32x16_bf16(kf[1],qr[0],C1,0,0,0), P0[6],P0[7],P0[8],P0[9],     pw0[2]=PKW(P0,4), pw0[3]=PKW(P0,6), pw0); \
    VRD(1); SBAR(); GAPA(C0=__builtin_amdgcn_mfma_f32_32x32x16_bf16(kf[2],qr[1],C0,0,0,0),   P0[10],P0[11],P0[12],P0[13], pw1[0]=PKW(P0,8), pw1[1]=PKW(P0,10), pw1); \
    VRD(5); SBAR(); GAPA(C1=__builtin_amdgcn_mfma_f32_32x32x16_bf16(kf[3],qr[1],C1,0,0,0),   P0[14],P0[15],P1[0],P1[1],   pw1[2]=PKW(P0,12),pw1[3]=PKW(P0,14), pw1); \
    VRD(2); SBAR(); GAPA(C0=__builtin_amdgcn_mfma_f32_32x32x16_bf16(kf[4],qr[2],C0,0,0,0),   P1[2],P1[3],P1[4],P1[5],     pw2[0]=PKW(P1,0), pw2[1]=PKW(P1,2), pw2); \
    VRD(6); SBAR(); GAPA(C1=__builtin_amdgcn_mfma_f32_32x32x16_bf16(kf[5],qr[2],C1,0,0,0),   P1[6],P1[7],P1[8],P1[9],     pw2[2]=PKW(P1,4), pw2[3]=PKW(P1,6), pw2); \
    VRD(3); SBAR(); GAPA(C0=__builtin_amdgcn_mfma_f32_32x32x16_bf16(kf[6],qr[3],C0,0,0,0),   P1[10],P1[11],P1[12],P1[13], pw3[0]=PKW(P1,8), pw3[1]=PKW(P1,10), pw3); \
    VRD(7); SBAR(); GAPA(C1=__builtin_amdgcn_mfma_f32_32x32x16_bf16(kf[7],qr[3],C1,0,0,0),   P1[14],P1[15],0.f,0.f,       pw3[2]=PKW(P1,12),pw3[3]=PKW(P1,14), pw3); \
    l_reg+=sacc; \
    if(GK){DMA_K((t)+3,sl_cur);} if(GV){DMA_V((t)+1,sl_next);} \
    CMASK(C0,C1,t); \
    { float a=MX3(C0[0],C0[1],C1[0]),b=MX3(C0[2],C0[3],C1[1]); a=MX3(a,C1[2],C1[3]); \
      _Pragma("unroll") for(int r=4;r<16;r+=4){a=MX3(a,C0[r],C0[r+1]);b=MX3(b,C0[r+2],C0[r+3]);a=MX3(a,C1[r],C1[r+1]);b=MX3(b,C1[r+2],C1[r+3]);} \
      float rm=__builtin_fmaxf(a,b); { auto rr=__builtin_amdgcn_permlane32_swap(__float_as_uint(rm),__float_as_uint(rm),false,false); rm=__builtin_fmaxf(__uint_as_float(rr[0]),__uint_as_float(rr[1])); } \
      resc=false; \
      if(__builtin_expect(__any(rm>(float)THRL),0)){ const float dl=__builtin_fmaxf(rm,0.f); mhat+=dl; \
        _Pragma("unroll") for(int r=0;r<16;++r){C0[r]-=dl;C1[r]-=dl;} \
        const float f=__builtin_amdgcn_exp2f(-dl); l_reg*=f; if(hi==0)wsf[r32]=f; resc=true; } } \
    SBAR(); \
    BLD(GB,(t)+1,0) SBAR(); \
    GAPB(o[0]=__builtin_amdgcn_mfma_f32_32x32x16_bf16(PAF(0),VFR(0),o[0],0,0,0), C0,0); \
    GAPB(o[1]=__builtin_amdgcn_mfma_f32_32x32x16_bf16(PAF(0),VFR(4),o[1],0,0,0), C0,4); \
    KRD(GL,0); GAPB(o[0]=__builtin_amdgcn_mfma_f32_32x32x16_bf16(PAF(1),VFR(1),o[0],0,0,0), C0,8); \
    KRD(GL,1); GAPB(o[1]=__builtin_amdgcn_mfma_f32_32x32x16_bf16(PAF(1),VFR(5),o[1],0,0,0), C0,12); \
    BSUB(GB,P0,0) BLD(GB,(t)+1,1) SBAR(); \
    KRD(GL,2); GAPB(o[0]=__builtin_amdgcn_mfma_f32_32x32x16_bf16(PAF(2),VFR(2),o[0],0,0,0), C1,0); \
    KRD(GL,3); GAPB(o[1]=__builtin_amdgcn_mfma_f32_32x32x16_bf16(PAF(2),VFR(6),o[1],0,0,0), C1,4); \
    GAPB(o[0]=__builtin_amdgcn_mfma_f32_32x32x16_bf16(PAF(3),VFR(3),o[0],0,0,0), C1,8); \
    GAPB(o[1]=__builtin_amdgcn_mfma_f32_32x32x16_bf16(PAF(3),VFR(7),o[1],0,0,0), C1,12); \
    BSUB(GB,P1,1) \
    }while(0)
  int t=1;
  #define ENDW(tt) do{ if((tt)+3<NT){WAIT_BAR(2);} else if((tt)+2<NT){WAIT_BAR(1);} else {WAIT_BAR(0);} }while(0)
  for(;t+1<NT&&t<5;t+=2){
    STEP(pB0,pB1,pA0,pA1,t,(t+3<NT),(t+1<NT),(t+1<NT),(t+1<NT));       ENDW(t);   RESC(); ROT();
    STEP(pA0,pA1,pB0,pB1,t+1,(t+4<NT),(t+2<NT),(t+2<NT),(t+2<NT));     ENDW(t+1); RESC(); ROT();
  }
  #undef CMASK
  #define CMASK(P0,P1,t) do{}while(0)
  for(;t+5<NT;t+=2){
    STEP(pB0,pB1,pA0,pA1,t,true,true,true,true);     WAIT_BAR(2); RESC(); ROT();
    STEP(pA0,pA1,pB0,pB1,t+1,true,true,true,true);   WAIT_BAR(2); RESC(); ROT();
  }
  for(;t+1<NT;t+=2){
    STEP(pB0,pB1,pA0,pA1,t,(t+3<NT),(t+1<NT),(t+1<NT),(t+1<NT));       ENDW(t);   RESC(); ROT();
    STEP(pA0,pA1,pB0,pB1,t+1,(t+4<NT),(t+2<NT),(t+2<NT),(t+2<NT));     ENDW(t+1); RESC(); ROT();
  }
  #undef CMASK
  #define CMASK(P0,P1,t) do{int jb_=3-(t); if(jb_>=0)cmask(P0,P1,jb_,qrel,hi);}while(0)
  STEP(pB0,pB1,pA0,pA1,NT-1,false,false,false,false); RESC();
  { float sacc=pB0[0]+pB0[1]; _Pragma("unroll") for(int r=2;r<16;++r)sacc+=pB0[r]; _Pragma("unroll") for(int r=0;r<16;++r)sacc+=pB1[r]; l_reg+=sacc;
    pw0=(u32x4){PKW(pB0,0),PKW(pB0,2),PKW(pB0,4),PKW(pB0,6)};pw1=(u32x4){PKW(pB0,8),PKW(pB0,10),PKW(pB0,12),PKW(pB0,14)};pw2=(u32x4){PKW(pB1,0),PKW(pB1,2),PKW(pB1,4),PKW(pB1,6)};pw3=(u32x4){PKW(pB1,8),PKW(pB1,10),PKW(pB1,12),PKW(pB1,14)};
    SBAR(); pv(o,vb0+sl_cur,PAF(0),PAF(1),PAF(2),PAF(3)); }
  #undef PKW
  #undef PAF
  #undef VFR
  #undef PIN
  #undef MX3
  #undef GAPA
  #undef GAPB
  #undef EX
  #undef VRD
  #undef KRD
  #undef STEP
  #undef ENDW
  {auto rr=__builtin_amdgcn_permlane32_swap(__float_as_uint(l_reg),__float_as_uint(l_reg),false,false);l_reg=__uint_as_float(rr[0])+__uint_as_float(rr[1]);}
  if(hi==0)wsf[32+r32]=l_reg;asm volatile("s_waitcnt lgkmcnt(0)":::"memory");
  float rli[16];
  #pragma unroll
  for(int r=0;r<16;++r)rli[r]=__builtin_amdgcn_rcpf(wsf[32+crow(r,hi)]);
  bf16*Ow=O+(rowbase+q0+wid*QBLK)*DM+h*D;
  { bf16*stg=(bf16*)(shm+LDS_OST)+wid*2048;
    #pragma unroll
    for(int r=0;r<16;++r){const int orow=crow(r,hi);
      #pragma unroll
      for(int d0=0;d0<2;++d0)stg[orow*64+d0*32+r32]=__float2bfloat16(o[d0][r]*rli[r]);}
    asm volatile("s_waitcnt lgkmcnt(0)":::"memory");
    #pragma unroll
    for(int i=0;i<4;++i){const int row=i*8+(lane>>3),ch=lane&7; const u32x4 v=*(const u32x4*)(stg+row*64+ch*8); ATTN_STORE16(Ow+(long)row*DM+ch*8,v);} }
  asm volatile("s_waitcnt lgkmcnt(0)\n\ts_barrier":::"memory");
  #undef DMA_K
  #undef TIDX
  #undef DMA_V
  #undef CMASK
  #undef ABIAS
  #undef BLD
  #undef BSUB
  #undef START
  #undef RESC
  #undef ROT
}
constexpr int ATTN_LDS_BYTES=LDS_BYTES;
#undef SBAR
#undef WAIT_BAR
}

#ifndef LAS
#define LAS __attribute__((address_space(3)))
#endif
constexpr int MK_WAVES = 8;
#ifndef MK_NSB
#define MK_NSB 5
#endif
namespace pg8 { __device__ __forceinline__ unsigned cvt_pk_bf16(float lo, float hi); }

namespace sb_body {
typedef short bf16x8 __attribute__((ext_vector_type(8)));
typedef float f32x16 __attribute__((ext_vector_type(16)));
__device__ __forceinline__ void sb_head(LAS unsigned char* lds, int bh, const bf16_t* Q, const bf16_t* K, const bf16_t* V, bf16_t* O) {
    int tid_ = threadIdx.x; asm volatile("" : "+v"(tid_));
    const int lane = tid_ & 63, wid = __builtin_amdgcn_readfirstlane(tid_ >> 6), r32 = lane & 31, hi = lane >> 5;
    const int b = bh / NH, hh = bh % NH; const size_t rowb = (size_t)b * SEQ;
    const bf16_t* Qh = Q + rowb * DM + hh * HD; const bf16_t* Kh = K + rowb * DM + hh * HD; const bf16_t* Vh = V + rowb * DM + hh * HD; bf16_t* Oh = O + rowb * DM + hh * HD;
    LAS unsigned char* slot0 = lds + wid * 16384;
    const int vb0 = (int)(unsigned)(size_t)slot0 + ((lane >> 4) & 1) * 32 + (lane & 3) * 8 + (4 * hi + ((lane & 15) >> 2)) * 64;
    const bf16_t* vsrc0 = Vh + (size_t)(lane >> 2) * DM + (lane & 3) * 8;
#define SB_DMAV(t, sc) do { _Pragma("unroll") for (int p_ = 0; p_ < 8; ++p_) \
        __builtin_amdgcn_global_load_lds((const unsigned*)(vsrc0 + (size_t)(64 * (t) + 16 * (p_ & 3)) * DM + 32 * (p_ >> 2)), (LAS unsigned*)(slot0 + (sc) * 8192 + p_ * 1024), 16, 0, 0); } while (0)
#define SB_LOADK(kf, t) do { const bf16_t* kp_ = Kh + (size_t)(64 * (t) + r32) * DM + 8 * hi; _Pragma("unroll") for (int d0_ = 0; d0_ < 4; ++d0_) { \
        kf[2 * d0_] = *(const bf16x8*)(kp_ + 16 * d0_); kf[2 * d0_ + 1] = *(const bf16x8*)(kp_ + (size_t)32 * DM + 16 * d0_); } } while (0)
    for (int uu = wid; uu < SEQ / 32; uu += MK_NSB) {
        const int q0w = uu * 32, qabs = q0w + r32;
        bf16x8 qr[4];
#pragma unroll
        for (int d0 = 0; d0 < 4; ++d0) qr[d0] = *(const bf16x8*)(Qh + (size_t)qabs * DM + d0 * 16 + hi * 8);
        f32x16 o[2]; o[0] = f32x16{}; o[1] = f32x16{};
        float carry = 1.f; int jt = (q0w + 30) >> 6, sc = 0; bool first = true;
        bf16x8 kf[8], kfn[8];
        SB_DMAV(jt, 0); asm volatile("" ::: "memory"); SB_LOADK(kf, jt);
        for (;;) {
            f32x16 p0 = f32x16{}, p1 = f32x16{};
#pragma unroll
            for (int d0 = 0; d0 < 4; ++d0) { p0 = __builtin_amdgcn_mfma_f32_32x32x16_bf16(kf[2 * d0], qr[d0], p0, 0, 0, 0); p1 = __builtin_amdgcn_mfma_f32_32x32x16_bf16(kf[2 * d0 + 1], qr[d0], p1, 0, 0, 0); }
            const bool more = jt > 0;
            asm volatile("" ::: "memory");
            if (more) { SB_DMAV(jt - 1, sc ^ 1); asm volatile("" ::: "memory"); SB_LOADK(kfn, jt - 1); }
            asm volatile("" ::: "memory");
            float nb[8][4], be[8][4];
#pragma unroll
            for (int w = 0; w < 8; ++w)
#pragma unroll
                for (int i = 0; i < 4; ++i) { const int r = (w & 3) * 4 + i; float x = (w < 4) ? p0[r] : p1[r]; x = fminf(x, 64.f);
                    const float e = __builtin_amdgcn_exp2f(x), rr = __builtin_amdgcn_rcpf(1.f + e);
                    const int kv = 64 * jt + 32 * (w >> 2) + 8 * (w & 3) + 4 * hi + i; const bool valid = !first || (kv < qabs);
                    be[w][i] = valid ? e * rr : 0.f; nb[w][i] = valid ? rr : 1.f; }
            float Xs[8];
            float Te[8], To[8];
#pragma unroll
            for (int w = 0; w < 8; ++w) { const float s2 = nb[w][3], s1 = s2 * nb[w][2], s0 = s1 * nb[w][1], T = s0 * nb[w][0];
                be[w][2] *= s2; be[w][1] *= s1; be[w][0] *= s0;
                auto rr2 = __builtin_amdgcn_permlane32_swap(__float_as_uint(T), __float_as_uint(T), false, false); Te[w] = __uint_as_float(rr2[0]); To[w] = __uint_as_float(rr2[1]); }
            float W = 1.f;
#pragma unroll
            for (int w = 7; w >= 0; --w) { const float xe = W * To[w]; Xs[w] = hi ? W : xe; W = xe * Te[w]; }
            unsigned pw[16];
#pragma unroll
            for (int w = 0; w < 8; ++w) { const float sc2 = Xs[w] * carry; pw[2 * w] = pg8::cvt_pk_bf16(be[w][0] * sc2, be[w][1] * sc2); pw[2 * w + 1] = pg8::cvt_pk_bf16(be[w][2] * sc2, be[w][3] * sc2); }
            carry *= W;
            const bf16x8 pa0 = __builtin_bit_cast(bf16x8, (u32x4){pw[0], pw[1], pw[2], pw[3]}), pa1 = __builtin_bit_cast(bf16x8, (u32x4){pw[4], pw[5], pw[6], pw[7]});
            const bf16x8 pa2 = __builtin_bit_cast(bf16x8, (u32x4){pw[8], pw[9], pw[10], pw[11]}), pa3 = __builtin_bit_cast(bf16x8, (u32x4){pw[12], pw[13], pw[14], pw[15]});
            if (more) asm volatile("s_waitcnt vmcnt(16)" ::: "memory"); else asm volatile("s_waitcnt vmcnt(0)" ::: "memory");
            attn_body::pv(o, vb0 + sc * 8192, pa0, pa1, pa2, pa3);
            if (!more || __all(carry < 1e-12f)) break;
#pragma unroll
            for (int i = 0; i < 8; ++i) kf[i] = kfn[i];
            sc ^= 1; --jt; first = false;
        }
#pragma unroll
        for (int d0 = 0; d0 < 2; ++d0)
#pragma unroll
            for (int r = 0; r < 16; ++r) Oh[(size_t)(q0w + crow(r, hi)) * DM + d0 * 32 + r32] = (bf16_t)f2bf(o[d0][r]);
    }
#undef SB_DMAV
#undef SB_LOADK
}
}

#ifndef LAS
#define LAS __attribute__((address_space(3)))
#endif
#define GAS __attribute__((address_space(1)))
constexpr size_t WS_SS = WS_END;
constexpr size_t WS_WR = WS_SS + 2 * MiB;
constexpr size_t WS_WF = WS_WR + 1 * MiB;
constexpr size_t WS_HB2 = WS_WF + 1 * MiB;
constexpr size_t WS_WGU8 = WS_HB2 + 64 * MiB;
constexpr size_t WS_WD8 = WS_WGU8 + 128 * MiB;
constexpr size_t WS_HB8 = WS_WD8 + 64 * MiB;
constexpr size_t WS_ACT8 = WS_HB8 + 32 * MiB;
constexpr size_t WS_WG8 = WS_ACT8 + 136 * MiB;
constexpr size_t WS_END2 = WS_WG8 + 2 * MiB;
#ifndef MK_PLE8
#define MK_PLE8 1
#endif
#ifndef MK_FP8_MASK
#define MK_FP8_MASK 0
#endif
constexpr float W8SCALE = 256.f, W8INV = 1.f / 256.f;
constexpr int CW_BAR = 4096;
constexpr int CW_CNT2 = 16384, CNT_STRIDE = 64;


__device__ __forceinline__ float lperm(float v, int src) { return __builtin_bit_cast(float, __builtin_amdgcn_ds_bpermute(src << 2, __builtin_bit_cast(int, v))); }
__device__ __forceinline__ int lpermi(int v, int src) { return __builtin_amdgcn_ds_bpermute(src << 2, v); }
__device__ __forceinline__ float lwave_sum(float v, int lane) {
#pragma unroll
    for (int o = 1; o < 64; o <<= 1) v += lperm(v, lane ^ o);
    return v;
}
namespace pg8 {
constexpr int BM = 256, BK = 64, HALF = 128, HTB = HALF * BK * 2, STAGE_BYTES = 8 * HTB, NXCD = 8, WGM = 8;
__device__ __forceinline__ int lds_byte(int r, int c) { const int st = (r >> 4) * 2 + (c >> 5), rr = r & 15, cc = c & 31, ob = rr * 64 + cc * 2; return st * 1024 + (ob ^ (((ob >> 9) & 1) << 5)); }
__device__ __forceinline__ void stage_rc(int b, int& R, int& C) { const int st = b / 1024, sb = b % 1024, swz = sb ^ (((sb >> 9) & 1) << 5); R = (st >> 1) * 16 + swz / 64; C = (st & 1) * 32 + (swz % 64) / 2; }
__device__ __forceinline__ int perm32(int rho) { const int n = rho >> 4, i = rho & 15; return 8 * (i >> 2) + 4 * n + (i & 3); }
__device__ __forceinline__ unsigned cvt_pk_bf16(float lo, float hi) { unsigned r; asm volatile("v_cvt_pk_bf16_f32 %0, %1, %2" : "=v"(r) : "v"(lo), "v"(hi)); return r; }

struct Unit { int arow0, brow0, pn, e, rank0, cnt, ui; };

__device__ __forceinline__ int xcd_remap(int L, int nwg) { const int q = nwg / NXCD, r = nwg % NXCD, xcd = L % NXCD, off = L / NXCD; return (xcd < r ? xcd * (q + 1) : r * (q + 1) + (xcd - r) * q) + off; }

struct DenseOrder {
    int nM, nN, nwg, G, c;
    __device__ __forceinline__ void init(int M, int N, int G_, int c_) { nM = M / BM; nN = N / BM; nwg = nM * nN; G = G_; c = c_; }
    __device__ __forceinline__ bool next(int i, Unit& u) const {
        const long L = (long)i * G + c; if (L >= nwg) return false;
        const int wgid = xcd_remap((int)L, nwg);
        const int nig = WGM * nN, gid = wgid / nig, fm = gid * WGM, gsz = (nM - fm) < WGM ? (nM - fm) : WGM;
        const int pm = fm + ((wgid % nig) % gsz), pn = (wgid % nig) / gsz;
        u.arow0 = pm * BM; u.brow0 = pn * BM; u.pn = pn; u.e = 0; u.rank0 = 0; u.cnt = 0; u.ui = i; return true;
    }
    __device__ __forceinline__ int arow(const Unit& u, int lr) const { return u.arow0 + lr; }
};
struct HotOrder {
    DenseOrder d;
    __device__ __forceinline__ bool next(int i, Unit& u) const { const bool ok = d.next(i, u); u.arow0 = 0; u.brow0 = 0; u.pn = 0; return ok; }
    __device__ __forceinline__ int arow(const Unit& u, int lr) const { return lr; }
};
struct PJOrder {
    DenseOrder d; int G, c;
    __device__ __forceinline__ void init(int G_, int c_) { d.init(NTOK, DM, G_, 0); G = G_; c = c_; }
    __device__ __forceinline__ bool next(int i, Unit& u) const {
        const long L = (long)i * G + c; if (L >= 2 * d.nwg) return false;
        const int l2 = (L >= d.nwg) ? 1 : 0; const int wgid = xcd_remap((int)L - l2 * d.nwg, d.nwg);
        const int nig = WGM * d.nN, gid = wgid / nig, fm = gid * WGM, gsz = (d.nM - fm) < WGM ? (d.nM - fm) : WGM;
        const int pm = fm + ((wgid % nig) % gsz), pn = (wgid % nig) / gsz;
        u.arow0 = l2 * NTOK + pm * BM; u.brow0 = l2 * DM + pn * BM; u.pn = pn; u.e = 0; u.rank0 = 0; u.cnt = 0; u.ui = i; return true;
    }
    __device__ __forceinline__ int arow(const Unit& u, int lr) const { return u.arow0 + lr; }
};
struct MoeOrder {
    int NN, nwg, G, c, lane; const LAS int* tstartL; const LAS int* cntL; const LAS unsigned short* tokL; bool gather;
    __device__ __forceinline__ bool next(int i, Unit& u) const {
        const long L = (long)i * G + c; if (L >= nwg) return false;
        const int wgid = xcd_remap((int)L, nwg);
        const int T = wgid / NN, pn = wgid - T * NN;
        const int lo = (lane < NE) ? tstartL[lane] : 0x7fffffff, hi = (lane < NE) ? tstartL[lane + 1] : 0x7fffffff;
        const unsigned long long m = __ballot(lo <= T && T < hi);
        const int e = __builtin_amdgcn_readfirstlane((int)__builtin_ctzll(m | (1ull << 63)));
        u.e = e; u.rank0 = (T - __builtin_amdgcn_readfirstlane(tstartL[e])) * 256; u.cnt = __builtin_amdgcn_readfirstlane(cntL[e]); u.arow0 = T * 256; u.brow0 = (e * NN + pn) * 256; u.pn = pn; u.ui = i; return true;
    }
    __device__ __forceinline__ int arow(const Unit& u, int lr) const { return gather ? (int)tokL[u.ui * 256 + lr] : u.arow0 + lr; }
};

typedef const f32x4 (&AccRef)[2][2][4][2];
struct EpiQKV {
    bf16_t* Q; const LAS float* rowL; int probe;
    __device__ __forceinline__ void operator()(AccRef acc, const Unit& u, int wr, int wc, int fr, int fq) const {
        const int t = u.brow0 >> 10, colt = u.brow0 & 1023; bf16_t* base = Q + (size_t)t * ((size_t)NTOK * DM); const float sc = (t == 0) ? C2 : 1.f;
        const int col0 = colt + wc * 32 + 8 * fq;
#pragma unroll
        for (int ai = 0; ai < 2; ++ai)
#pragma unroll
            for (int m = 0; m < 4; ++m) { const int lr = ai * HALF + wr * 64 + m * 16 + fr; const int row = u.arow0 + lr;
                const float rs = rowL[u.ui * 256 + lr] * sc; bf16_t* rowp = base + (size_t)row * DM + col0;
#pragma unroll
                for (int bj = 0; bj < 2; ++bj) { const f32x4 v0 = acc[ai][bj][m][0] * rs, v1 = acc[ai][bj][m][1] * rs; u32x4 w;
                    w.x = cvt_pk_bf16(v0[0], v0[1]); w.y = cvt_pk_bf16(v0[2], v0[3]); w.z = cvt_pk_bf16(v1[0], v1[1]); w.w = cvt_pk_bf16(v1[2], v1[3]);
                    if (probe == 1) asm volatile("" :: "v"(w)); else if (probe == 2) __builtin_nontemporal_store(w, (u32x4*)(rowp + bj * HALF)); else *(u32x4*)(rowp + bj * HALF) = w; } }
    }
};
struct EpiPJ {
    bf16_t* O;
    __device__ __forceinline__ void operator()(AccRef acc, const Unit& u, int wr, int wc, int fr, int fq) const {
        const int col0 = u.pn * BM + wc * 32 + 8 * fq;
#pragma unroll
        for (int ai = 0; ai < 2; ++ai)
#pragma unroll
            for (int m = 0; m < 4; ++m) { const int row = u.arow0 + ai * HALF + wr * 64 + m * 16 + fr; bf16_t* rowp = O + (size_t)row * DM + col0;
#pragma unroll
                for (int bj = 0; bj < 2; ++bj) { const f32x4 v0 = acc[ai][bj][m][0], v1 = acc[ai][bj][m][1]; u32x4 w;
                    w.x = cvt_pk_bf16(v0[0], v0[1]); w.y = cvt_pk_bf16(v0[2], v0[3]); w.z = cvt_pk_bf16(v1[0], v1[1]); w.w = cvt_pk_bf16(v1[2], v1[3]); *(u32x4*)(rowp + bj * HALF) = w; } }
    }
};
struct EpiWo {
    const bf16_t* hin; bf16_t* hb; unsigned char* hb8;
    __device__ __forceinline__ void operator()(AccRef acc, const Unit& u, int wr, int wc, int fr, int fq) const {
        const int col0 = u.brow0 + wc * 32 + 8 * fq;
        u32x4 hv[2][4][2];
#pragma unroll
        for (int ai = 0; ai < 2; ++ai)
#pragma unroll
            for (int m = 0; m < 4; ++m) { const size_t off = (size_t)(u.arow0 + ai * HALF + wr * 64 + m * 16 + fr) * DM + col0;
#pragma unroll
                for (int bj = 0; bj < 2; ++bj) hv[ai][m][bj] = *(const u32x4*)(hin + off + bj * HALF); }
#pragma unroll
        for (int ai = 0; ai < 2; ++ai)
#pragma unroll
            for (int m = 0; m < 4; ++m) { const size_t off = (size_t)(u.arow0 + ai * HALF + wr * 64 + m * 16 + fr) * DM + col0;
#pragma unroll
                for (int bj = 0; bj < 2; ++bj) { const size_t o = off + bj * HALF; const u32x4 h4 = hv[ai][m][bj]; const f32x4 a0 = acc[ai][bj][m][0], a1 = acc[ai][bj][m][1];
                    const float x0 = __uint_as_float(h4.x << 16) + a0[0], x1 = __uint_as_float(h4.x & 0xffff0000u) + a0[1], x2 = __uint_as_float(h4.y << 16) + a0[2], x3 = __uint_as_float(h4.y & 0xffff0000u) + a0[3];
                    const float x4 = __uint_as_float(h4.z << 16) + a1[0], x5 = __uint_as_float(h4.z & 0xffff0000u) + a1[1], x6 = __uint_as_float(h4.w << 16) + a1[2], x7 = __uint_as_float(h4.w & 0xffff0000u) + a1[3];
                    if (hb8) { unsigned p0 = 0u, p1 = 0u; p0 = __builtin_amdgcn_cvt_pk_fp8_f32(x0, x1, p0, false); p0 = __builtin_amdgcn_cvt_pk_fp8_f32(x2, x3, p0, true); p1 = __builtin_amdgcn_cvt_pk_fp8_f32(x4, x5, p1, false); p1 = __builtin_amdgcn_cvt_pk_fp8_f32(x6, x7, p1, true);
                        *(u32x2*)(hb8 + o) = (u32x2){p0, p1}; }
                    u32x4 w; w.x = cvt_pk_bf16(x0, x1); w.y = cvt_pk_bf16(x2, x3); w.z = cvt_pk_bf16(x4, x5); w.w = cvt_pk_bf16(x6, x7);
                    *(u32x4*)(hb + o) = w; } }
    }
};
__device__ __forceinline__ float fast_sigmoid(float x) { return __builtin_amdgcn_rcpf(1.f + __builtin_amdgcn_exp2f(-LOG2E * x)); }
struct EpiPLE {
    const bf16_t* hin; bf16_t* hb; const bf16_t* PJ; const LAS float* rowL; float* SS;
    __device__ __forceinline__ void operator()(AccRef acc, const Unit& u, int wr, int wc, int fr, int fq) const {
        const int col0 = u.brow0 + wc * 32 + 8 * fq;
#pragma unroll
        for (int ai = 0; ai < 2; ++ai) {
            u32x4 hv[4][2], pv[4][2];
#pragma unroll
            for (int m = 0; m < 4; ++m) { const size_t off = (size_t)(u.arow0 + ai * HALF + wr * 64 + m * 16 + fr) * DM + col0;
#pragma unroll
                for (int bj = 0; bj < 2; ++bj) { hv[m][bj] = *(const u32x4*)(hin + off + bj * HALF); pv[m][bj] = *(const u32x4*)(PJ + off + bj * HALF); } }
#pragma unroll
            for (int m = 0; m < 4; ++m) { const int lr = ai * HALF + wr * 64 + m * 16 + fr; const int row = u.arow0 + lr; const size_t off = (size_t)row * DM + col0; const float rs = rowL[u.ui * 256 + lr]; float ssq = 0.f;
#pragma unroll
                for (int bj = 0; bj < 2; ++bj) { const size_t o = off + bj * HALF; const u32x4 pj = pv[m][bj]; const u32x4 h4 = hv[m][bj];
                    const f32x4 a0 = acc[ai][bj][m][0] * rs, a1 = acc[ai][bj][m][1] * rs; float x[8];
                    x[0] = __uint_as_float(h4.x << 16) + fast_sigmoid(a0[0]) * __uint_as_float(pj.x << 16); x[1] = __uint_as_float(h4.x & 0xffff0000u) + fast_sigmoid(a0[1]) * __uint_as_float(pj.x & 0xffff0000u);
                    x[2] = __uint_as_float(h4.y << 16) + fast_sigmoid(a0[2]) * __uint_as_float(pj.y << 16); x[3] = __uint_as_float(h4.y & 0xffff0000u) + fast_sigmoid(a0[3]) * __uint_as_float(pj.y & 0xffff0000u);
                    x[4] = __uint_as_float(h4.z << 16) + fast_sigmoid(a1[0]) * __uint_as_float(pj.z << 16); x[5] = __uint_as_float(h4.z & 0xffff0000u) + fast_sigmoid(a1[1]) * __uint_as_float(pj.z & 0xffff0000u);
                    x[6] = __uint_as_float(h4.w << 16) + fast_sigmoid(a1[2]) * __uint_as_float(pj.w << 16); x[7] = __uint_as_float(h4.w & 0xffff0000u) + fast_sigmoid(a1[3]) * __uint_as_float(pj.w & 0xffff0000u);
                    u32x4 w; w.x = cvt_pk_bf16(x[0], x[1]); w.y = cvt_pk_bf16(x[2], x[3]); w.z = cvt_pk_bf16(x[4], x[5]); w.w = cvt_pk_bf16(x[6], x[7]); *(u32x4*)(hb + o) = w;
                    float q0 = __uint_as_float(w.x << 16), q1 = __uint_as_float(w.x & 0xffff0000u), q2 = __uint_as_float(w.y << 16), q3 = __uint_as_float(w.y & 0xffff0000u);
                    float q4 = __uint_as_float(w.z << 16), q5 = __uint_as_float(w.z & 0xffff0000u), q6 = __uint_as_float(w.w << 16), q7 = __uint_as_float(w.w & 0xffff0000u);
                    ssq += (q0 * q0 + q1 * q1) + (q2 * q2 + q3 * q3) + (q4 * q4 + q5 * q5) + (q6 * q6 + q7 * q7); }
                { const int ln_ = fr + 16 * fq; ssq += lperm(ssq, ln_ ^ 16); ssq += lperm(ssq, ln_ ^ 32); }
                if (fq == 0) SS[(size_t)row * 16 + u.pn * 4 + wc] = ssq; }
            asm volatile("" ::: "memory");
        }
    }
};
template <bool OUT8> struct EpiGU {
    void* ACT; const float* bgu; const LAS float* rowL;
    __device__ __forceinline__ void operator()(AccRef acc, const Unit& u, int wr, int wc, int fr, int fq) const {
        const int jc = u.pn * 128 + wc * 32 + 8 * fq; const float* bp = bgu + (size_t)u.e * (2 * FF) + jc;
        const f32x4 bg0 = *(const f32x4*)(bp), bg1 = *(const f32x4*)(bp + 4), bl0 = *(const f32x4*)(bp + FF), bl1 = *(const f32x4*)(bp + FF + 4);
#pragma unroll
        for (int ai = 0; ai < 2; ++ai)
#pragma unroll
            for (int m = 0; m < 4; ++m) { const int lr = ai * HALF + wr * 64 + m * 16 + fr; const float rs = rowL[u.ui * 256 + lr];
                const f32x4 g0 = __builtin_elementwise_min(acc[ai][0][m][0] * rs + bg0, (f32x4){7.f, 7.f, 7.f, 7.f}), g1 = __builtin_elementwise_min(acc[ai][0][m][1] * rs + bg1, (f32x4){7.f, 7.f, 7.f, 7.f});
                const f32x4 l0 = __builtin_elementwise_min(__builtin_elementwise_max(acc[ai][1][m][0] * rs + bl0, (f32x4){-7.f, -7.f, -7.f, -7.f}), (f32x4){7.f, 7.f, 7.f, 7.f}) + 1.f;
                const f32x4 l1 = __builtin_elementwise_min(__builtin_elementwise_max(acc[ai][1][m][1] * rs + bl1, (f32x4){-7.f, -7.f, -7.f, -7.f}), (f32x4){7.f, 7.f, 7.f, 7.f}) + 1.f;
                const f32x4 x0 = g0 * (-1.702f * LOG2E), x1 = g1 * (-1.702f * LOG2E); f32x4 e0, e1;
#pragma unroll
                for (int c = 0; c < 4; ++c) { e0[c] = __builtin_amdgcn_exp2f(x0[c]); e1[c] = __builtin_amdgcn_exp2f(x1[c]); }
                const f32x4 d0 = e0 + 1.f, d1 = e1 + 1.f; f32x4 s0, s1;
#pragma unroll
                for (int c = 0; c < 4; ++c) { s0[c] = __builtin_amdgcn_rcpf(d0[c]); s1[c] = __builtin_amdgcn_rcpf(d1[c]); }
                const f32x4 a0 = (g0 * l0) * s0, a1 = (g1 * l1) * s1; const float a[8] = {a0[0], a0[1], a0[2], a0[3], a1[0], a1[1], a1[2], a1[3]};
                if constexpr (OUT8) { unsigned p0 = 0u, p1 = 0u; p0 = __builtin_amdgcn_cvt_pk_fp8_f32(a[0], a[1], p0, false); p0 = __builtin_amdgcn_cvt_pk_fp8_f32(a[2], a[3], p0, true); p1 = __builtin_amdgcn_cvt_pk_fp8_f32(a[4], a[5], p1, false); p1 = __builtin_amdgcn_cvt_pk_fp8_f32(a[6], a[7], p1, true);
                    *(u32x2*)((unsigned char*)ACT + (size_t)(u.arow0 + lr) * FF + jc) = (u32x2){p0, p1}; }
                else { u32x4 w; w.x = cvt_pk_bf16(a[0], a[1]); w.y = cvt_pk_bf16(a[2], a[3]); w.z = cvt_pk_bf16(a[4], a[5]); w.w = cvt_pk_bf16(a[6], a[7]);
                    *(u32x4*)((bf16_t*)ACT + (size_t)(u.arow0 + lr) * FF + jc) = w; } }
    }
};
struct EpiDown {
    bf16_t* Y; const float* bd; const LAS float* rowL; float bscale;
    __device__ __forceinline__ void operator()(AccRef acc, const Unit& u, int wr, int wc, int fr, int fq) const {
        const int col0 = u.pn * 256 + wc * 32 + 8 * fq; const float* bp = bd + (size_t)u.e * DM + col0;
        f32x4 bv[2][2];
#pragma unroll
        for (int bj = 0; bj < 2; ++bj) { bv[bj][0] = *(const f32x4*)(bp + bj * HALF) * bscale; bv[bj][1] = *(const f32x4*)(bp + bj * HALF + 4) * bscale; }
#pragma unroll
        for (int ai = 0; ai < 2; ++ai)
#pragma unroll
            for (int m = 0; m < 4; ++m) { const int lr = ai * HALF + wr * 64 + m * 16 + fr; const float gt = rowL[u.ui * 256 + lr];
                bf16_t* rowp = Y + (size_t)(u.arow0 + lr) * DM + col0;
#pragma unroll
                for (int bj = 0; bj < 2; ++bj) { const f32x4 v0 = (acc[ai][bj][m][0] + bv[bj][0]) * gt, v1 = (acc[ai][bj][m][1] + bv[bj][1]) * gt; u32x4 w;
                    w.x = cvt_pk_bf16(v0[0], v0[1]); w.y = cvt_pk_bf16(v0[2], v0[3]); w.z = cvt_pk_bf16(v1[0], v1[1]); w.w = cvt_pk_bf16(v1[2], v1[3]); *(u32x4*)(rowp + bj * HALF) = w; } }
    }
};

typedef int v8i_t __attribute__((ext_vector_type(8))); typedef int v4i_t __attribute__((ext_vector_type(4)));
template <class Epi, class Sched, bool FP8 = false>
__device__ __forceinline__ void gemm_phase(LAS unsigned char* lds, const void* gA, const void* gBt, const int KB, const Sched& S, const Epi& E, const bool skip_epi = false) {
    int tid_ = threadIdx.x; asm volatile("" : "+v"(tid_));
    const int tid = tid_, wid = __builtin_amdgcn_readfirstlane(tid >> 6), lane = tid & 63, wr = wid >> 2, wc = wid & 3, fr = lane & 15, fq = lane >> 4;
    const int nt = KB / (BK * 2);
    unsigned voffB[2];
#pragma unroll
    for (int i = 0; i < 2; ++i) { int R, C; stage_rc(tid * 16 + i * 8192, R, C); const int Rb = (R & ~31) + perm32(R & 31); voffB[i] = (unsigned)(Rb * KB + C * 2); }
#define PG8_AOFF(u, o0, o1) do { int t2_ = threadIdx.x; asm volatile("" : "+v"(t2_)); _Pragma("unroll") for (int i = 0; i < 2; ++i) { int R, C; stage_rc(t2_ * 16 + i * 8192, R, C); \
        o0[i] = (unsigned)S.arow(u, R) * (unsigned)KB + (unsigned)C * 2u; o1[i] = (unsigned)S.arow(u, HALF + R) * (unsigned)KB + (unsigned)C * 2u; } } while (0)
    const unsigned kstep = (unsigned)(BK * 2);
    const unsigned hstep = (unsigned)HALF * (unsigned)KB;
    const unsigned ldsw = (unsigned)wid * 1024u;
    unsigned rdA_ = (unsigned)(size_t)lds + (unsigned)lds_byte(wr * 64 + fr, fq * 8), rdB_ = (unsigned)(size_t)lds + 4u * HTB + (unsigned)lds_byte(wc * 32 + fr, fq * 8);
    asm volatile("" : "+v"(rdA_), "+v"(rdB_));
    const LAS unsigned char* const rdA = (const LAS unsigned char*)(size_t)rdA_; const LAS unsigned char* const rdB = (const LAS unsigned char*)(size_t)rdB_;
#define PG8_SA(b, h) (((b) * 2 + (h)) * HTB)
#define PG8_SB(b, h) ((4 + (b) * 2 + (h)) * HTB)
#define PG8_STAGE(bufoff, rs, voff, soff) do { _Pragma("unroll") for (int _i = 0; _i < 2; ++_i) \
        __builtin_amdgcn_raw_ptr_buffer_load_lds(rs, (LAS void*)(lds + (bufoff) + ldsw + _i * 8192), 16, (voff)[_i], (unsigned)(soff), 0, 0); } while (0)
#define PG8_RA(b, h) (((b) * 2 + (h)) * HTB)
#define PG8_LD16A(off) __builtin_bit_cast(v4i_t, *(const LAS bf16x8*)(rdA + (off)))
#define PG8_LD16B(off) __builtin_bit_cast(v4i_t, *(const LAS bf16x8*)(rdB + (off)))
#define PG8_LDA(dst, b, h) do { if constexpr (FP8) { _Pragma("unroll") for (int m = 0; m < 4; ++m) dst##8[m] = __builtin_shufflevector(PG8_LD16A(PG8_RA(b, h) + m * 2048), PG8_LD16A(PG8_RA(b, h) + m * 2048 + 1024), 0, 1, 2, 3, 4, 5, 6, 7); } \
        else { _Pragma("unroll") for (int m = 0; m < 4; ++m) _Pragma("unroll") for (int k = 0; k < 2; ++k) dst[m][k] = *(const LAS bf16x8*)(rdA + PG8_RA(b, h) + m * 2048 + k * 1024); } } while (0)
#define PG8_LDB(dst, b, h) do { if constexpr (FP8) { _Pragma("unroll") for (int n = 0; n < 2; ++n) dst##8[n] = __builtin_shufflevector(PG8_LD16B(PG8_RA(b, h) + n * 2048), PG8_LD16B(PG8_RA(b, h) + n * 2048 + 1024), 0, 1, 2, 3, 4, 5, 6, 7); } \
        else { _Pragma("unroll") for (int n = 0; n < 2; ++n) _Pragma("unroll") for (int k = 0; k < 2; ++k) dst[n][k] = *(const LAS bf16x8*)(rdB + PG8_RA(b, h) + n * 2048 + k * 1024); } } while (0)
#define PG8_MMA(ai, bj, At, Bt) do { __builtin_amdgcn_s_setprio(1); _Pragma("unroll") for (int m = 0; m < 4; ++m) _Pragma("unroll") for (int n = 0; n < 2; ++n) { \
            if constexpr (FP8) acc[ai][bj][m][n] = __builtin_amdgcn_mfma_scale_f32_16x16x128_f8f6f4(Bt##8[n], At##8[m], acc[ai][bj][m][n], 0, 0, 0, 0, 0, 0); \
            else { _Pragma("unroll") for (int k = 0; k < 2; ++k) acc[ai][bj][m][n] = __builtin_amdgcn_mfma_f32_16x16x32_bf16(Bt[n][k], At[m][k], acc[ai][bj][m][n], 0, 0, 0); } } __builtin_amdgcn_s_setprio(0); } while (0)
#define PG8_WAIT_V(n) asm volatile("s_waitcnt vmcnt(" #n ")" ::: "memory")
#define PG8_WAIT_L(n) asm volatile("s_waitcnt lgkmcnt(" #n ")" ::: "memory")
#define PG8_BAR __builtin_amdgcn_s_barrier()
#define PG8_SCHED __builtin_amdgcn_sched_barrier(0)
    Unit cur, nxt; int ui = 0;
    if (!S.next(0, cur)) return;
    f32x4 acc[2][2][4][2];
#pragma unroll
    for (int a = 0; a < 2; ++a)
#pragma unroll
        for (int b = 0; b < 2; ++b)
#pragma unroll
            for (int m = 0; m < 4; ++m)
#pragma unroll
                for (int n = 0; n < 2; ++n) acc[a][b][m][n] = (f32x4){0.f, 0.f, 0.f, 0.f};
    bf16x8 At[4][2], B0[2][2], B1[2][2];
    v8i_t At8[4], B08[2], B18[2];
    unsigned ao0[2], ao1[2];
    PG8_AOFF(cur, ao0, ao1);
    const __amdgpu_buffer_rsrc_t rsA = __builtin_amdgcn_make_buffer_rsrc((void*)gA, 0, 0x7fffffff, 0x00020000), rsB = __builtin_amdgcn_make_buffer_rsrc((void*)gBt, 0, 0x7fffffff, 0x00020000);
    unsigned cB = (unsigned)cur.brow0 * (unsigned)KB;
    PG8_STAGE(PG8_SB(0, 0), rsB, voffB, cB); PG8_STAGE(PG8_SB(0, 1), rsB, voffB, cB + hstep); PG8_STAGE(PG8_SA(0, 0), rsA, ao0, 0u); PG8_STAGE(PG8_SA(0, 1), rsA, ao1, 0u);
    if (wr == 1) PG8_BAR;
    PG8_WAIT_V(2); PG8_BAR;
    PG8_STAGE(PG8_SB(1, 0), rsB, voffB, cB + kstep); PG8_STAGE(PG8_SA(1, 0), rsA, ao0, kstep); PG8_STAGE(PG8_SB(1, 1), rsB, voffB, cB + hstep + kstep);
    PG8_WAIT_V(6); PG8_BAR;
    for (;;) {
        const bool has_next = S.next(ui + 1, nxt);
        const unsigned nB = has_next ? (unsigned)nxt.brow0 * (unsigned)KB : cB;
        _Pragma("clang loop unroll(disable)") for (int t = 0; t < nt; t += 2) {
            const bool last = (t == nt - 2);
            const unsigned a1 = (unsigned)(t + 1) * kstep;
            const unsigned a2 = last ? 0u : (unsigned)(t + 2) * kstep; const unsigned b2 = last ? nB : cB + (unsigned)(t + 2) * kstep;
            const unsigned a3 = a2 + kstep; const unsigned b3 = b2 + kstep;
            PG8_LDB(B0, 0, 0); PG8_LDB(B1, 0, 1); PG8_SCHED; PG8_LDA(At, 0, 0); PG8_STAGE(PG8_SA(1, 1), rsA, ao1, a1);
            if (last && has_next) { PG8_AOFF(nxt, ao0, ao1); }
            PG8_WAIT_V(8); PG8_WAIT_L(0); PG8_BAR; PG8_MMA(0, 0, At, B0); PG8_MMA(0, 1, At, B1); PG8_BAR; PG8_SCHED;
            PG8_LDA(At, 0, 1); PG8_STAGE(PG8_SB(0, 0), rsB, voffB, b2); PG8_STAGE(PG8_SB(0, 1), rsB, voffB, b2 + hstep); PG8_STAGE(PG8_SA(0, 0), rsA, ao0, a2);
            PG8_WAIT_V(8); PG8_WAIT_L(0); PG8_BAR; PG8_MMA(1, 0, At, B0); PG8_MMA(1, 1, At, B1); PG8_BAR; PG8_SCHED;
            PG8_LDB(B0, 1, 0); PG8_LDB(B1, 1, 1); PG8_SCHED; PG8_LDA(At, 1, 0); PG8_STAGE(PG8_SA(0, 1), rsA, ao1, a2);
            PG8_WAIT_V(8); PG8_WAIT_L(0); PG8_BAR; PG8_MMA(0, 0, At, B0); PG8_MMA(0, 1, At, B1); PG8_BAR; PG8_SCHED;
            PG8_LDA(At, 1, 1); PG8_STAGE(PG8_SB(1, 0), rsB, voffB, b3); PG8_STAGE(PG8_SB(1, 1), rsB, voffB, b3 + hstep); PG8_STAGE(PG8_SA(1, 0), rsA, ao0, a3);
            PG8_WAIT_V(8); PG8_WAIT_L(0); PG8_BAR; PG8_MMA(1, 0, At, B0); PG8_MMA(1, 1, At, B1); PG8_BAR; PG8_SCHED;
        }
        if (wr == 0) PG8_BAR;
        if (!skip_epi) E(acc, cur, wr, wc, fr, fq);
        if (!has_next) break;
#pragma unroll
        for (int a = 0; a < 2; ++a)
#pragma unroll
            for (int b = 0; b < 2; ++b)
#pragma unroll
                for (int m = 0; m < 4; ++m)
#pragma unroll
                    for (int n = 0; n < 2; ++n) acc[a][b][m][n] = (f32x4){0.f, 0.f, 0.f, 0.f};
        cur = nxt; cB = nB; ++ui;
        if (wr == 1) PG8_BAR;
    }
    PG8_WAIT_V(0);
    PG8_BAR;
#undef PG8_AOFF
#undef PG8_SA
#undef PG8_SB
#undef PG8_STAGE
#undef PG8_LDA
#undef PG8_LD16A
#undef PG8_LD16B
#undef PG8_RA
#undef PG8_LDB
#undef PG8_MMA
#undef PG8_WAIT_V
#undef PG8_WAIT_L
#undef PG8_BAR
#undef PG8_SCHED
}
}

#define XB_TMO      128
#define XB_XCNT(j)  (256  + 64 * (j))
#define XB_XSUB(j)  (1280 + 64 * (j))
#define XB_XGEN(j)  (2304 + 64 * (j))
#define XB_TOP      3328
#define XB_TOPGEN   3392
#define XCD_BAR_WORDS 3456
#define XB_SPIN_CAP (1u << 18)
__device__ __forceinline__ unsigned xb_ld(unsigned* p)              { return __hip_atomic_load(p, __ATOMIC_RELAXED, __HIP_MEMORY_SCOPE_AGENT); }
__device__ __forceinline__ unsigned xb_add(unsigned* p, unsigned v) { return __hip_atomic_fetch_add(p, v, __ATOMIC_RELAXED, __HIP_MEMORY_SCOPE_AGENT); }
__device__ __forceinline__ unsigned xb_xcc_id() { return (unsigned)__builtin_amdgcn_s_getreg((3 << 11) | 20) & 0xFu; }
#define XB_SPIN(cond, bar) do { unsigned _sp = 0; while (cond) { __builtin_amdgcn_s_sleep(1); \
    if ((++_sp & 255u) == 0u) { if (xb_ld(&(bar)[XB_TMO])) break; if (_sp > XB_SPIN_CAP) { atomicAdd(&(bar)[XB_TMO], 1u); break; } } } } while (0)
struct XcdBarrier { unsigned* bar; unsigned x; volatile LAS unsigned* st; };
__device__ __forceinline__ XcdBarrier xcd_barrier_post(unsigned* bar, volatile LAS unsigned* st) {
    XcdBarrier b; b.bar = bar; b.x = xb_xcc_id(); b.st = st;
    if (threadIdx.x == 0) (void)xb_add(&bar[XB_XCNT(b.x)], 1u);
    return b;
}
__device__ __forceinline__ void xcd_barrier_complete(unsigned* bar, unsigned x, unsigned& nloc, unsigned& nx) {
    const unsigned G = gridDim.x * gridDim.y * gridDim.z;
    unsigned sum, cnt, mine, sp = 0u;
    for (;;) {
        sum = 0u; cnt = 0u; mine = 0u;
#pragma unroll
        for (unsigned j = 0; j < 16; ++j) { const unsigned c = xb_ld(&bar[XB_XCNT(j)]); sum += c; cnt += (c > 0u) ? 1u : 0u; mine = (j == x) ? c : mine; }
        if (sum == G) break;
        __builtin_amdgcn_s_sleep(1);
        if ((++sp & 255u) == 0u) { if (xb_ld(&bar[XB_TMO])) break; if (sp > XB_SPIN_CAP) { atomicAdd(&bar[XB_TMO], 1u); break; } }
    }
    nloc = mine > 0u ? mine : 1u; nx = cnt > 0u ? cnt : 1u;
}
__device__ __forceinline__ void xcd_barrier(const XcdBarrier& b) {
    asm volatile("s_waitcnt vmcnt(0)" ::: "memory");
    __syncthreads();
    if (threadIdx.x == 0) {
        unsigned* bar = b.bar;
        __builtin_amdgcn_s_waitcnt(0);
        unsigned nloc = b.st[0], nx = b.st[1];
        if (nloc == 0u) { xcd_barrier_complete(bar, b.x, nloc, nx); b.st[0] = nloc; b.st[1] = nx; }
        const unsigned old = xb_add(&bar[XB_XSUB(b.x)], 1u);
        const unsigned gen = old / nloc;
        if (old + 1u == (gen + 1u) * nloc) {
            __builtin_amdgcn_fence(__ATOMIC_RELEASE, "agent");
            asm volatile("s_waitcnt vmcnt(0)" ::: "memory");
            const unsigned og = xb_add(&bar[XB_TOP], 1u);
            const unsigned tg = og / nx;
            if (og + 1u == (tg + 1u) * nx) xb_add(&bar[XB_TOPGEN], 1u);
            else XB_SPIN(xb_ld(&bar[XB_TOPGEN]) == tg, bar);
            __builtin_amdgcn_fence(__ATOMIC_ACQUIRE, "agent");
            xb_add(&bar[XB_XGEN(b.x)], 1u);
            asm volatile("s_waitcnt vmcnt(0)" ::: "memory");
        } else {
            XB_SPIN(xb_ld(&bar[XB_XGEN(b.x)]) == gen, bar);
            __builtin_amdgcn_fence(__ATOMIC_ACQUIRE, "agent");
            asm volatile("s_waitcnt vmcnt(0)" ::: "memory");
        }
    }
    __syncthreads();
}

constexpr int RING_BYTES = 131072;
constexpr int ROW_OFF = RING_BYTES, TOK_UNITS = 18;
constexpr int TOK_OFF = ROW_OFF + TOK_UNITS * 1024;
constexpr int TBL_OFF = TOK_OFF + TOK_UNITS * 512;
constexpr int LDSCTL_OFF = TBL_OFF + 512;
constexpr int MK_LDS_BYTES = LDSCTL_OFF + 256;
static_assert(MK_LDS_BYTES <= 160 * 1024, "LDS map");

struct MArgs { const float* in[18]; float* out; unsigned char* ws; int ph_lo, ph_hi; };
struct Frame {
    LAS unsigned char* lds; int tid, lane, wave, vcu, G;
    unsigned char* ws; unsigned* ctl;
};
__device__ __forceinline__ unsigned pkb(float lo, float hi) { return pg8::cvt_pk_bf16(lo, hi); }

struct P0Item { const float* W; const float* g; unsigned char* dst; int K, N, item, mode; };
__device__ __forceinline__ void p0_load32(const P0Item& d, int lane, float (&v)[32], float& g0) {
    const int nblk = d.N / 32, kb = d.item / nblk, nb = d.item - kb * nblk, k0 = 64 * kb, n0 = 32 * nb;
    const float* p = d.W + (size_t)(k0 + (lane >> 5)) * d.N + n0 + (lane & 31);
#pragma unroll
    for (int i = 0; i < 32; ++i) v[i] = p[(size_t)(2 * i) * d.N];
    g0 = d.g ? d.g[k0 + lane] : 1.f;
}
__device__ __forceinline__ void p0_store32(const P0Item& d, int lane, const float (&v)[32], float g0, LAS float* scr) {
    const int nblk = d.N / 32, kb = d.item / nblk, nb = d.item - kb * nblk, k0 = 64 * kb, n0 = 32 * nb;
#pragma unroll
    for (int i = 0; i < 32; ++i) { const int kk = 2 * i + (lane >> 5); scr[kk * 33 + (lane & 31)] = v[i] * lperm(g0, kk); }
    asm volatile("s_waitcnt lgkmcnt(0)" ::: "memory");
    const int c = lane & 7;
#pragma unroll
    for (int j = 0; j < 4; ++j) { const int n = (lane >> 3) + 8 * j; const LAS float* s = scr + (8 * c) * 33 + n;
        u32x4 o; o.x = pkb(s[0 * 33], s[1 * 33]); o.y = pkb(s[2 * 33], s[3 * 33]); o.z = pkb(s[4 * 33], s[5 * 33]); o.w = pkb(s[6 * 33], s[7 * 33]);
        *(u32x4*)((bf16_t*)d.dst + (size_t)(n0 + n) * d.K + k0 + 8 * c) = o; }
    asm volatile("s_waitcnt lgkmcnt(0)" ::: "memory");
}
__device__ __forceinline__ void p0_load64(const P0Item& d, int lane, f32x4 (&v)[16], float& g0) {
    const int nblk = d.N / 64, kb = d.item / nblk, nb = d.item - kb * nblk, k0 = 64 * kb, n0 = 64 * nb;
    const float* p = d.W + (size_t)(k0 + (lane >> 4)) * d.N + n0 + 4 * (lane & 15);
#pragma unroll
    for (int i = 0; i < 16; ++i) v[i] = __builtin_nontemporal_load((const f32x4*)(p + (size_t)(4 * i) * d.N));
    g0 = (d.g ? d.g[k0 + lane] : 1.f) * W8SCALE;
}
__device__ __forceinline__ void p0_store64(const P0Item& d, int lane, const f32x4 (&v)[16], float g0, LAS float* scr) {
    const int nblk = d.N / 64, kb = d.item / nblk, nb = d.item - kb * nblk, k0 = 64 * kb, n0 = 64 * nb;
#pragma unroll
    for (int i = 0; i < 16; ++i) { const int kk = 4 * i + (lane >> 4); const float gg = lperm(g0, kk); LAS float* w = scr + kk * 65 + 4 * (lane & 15); w[0] = v[i].x * gg; w[1] = v[i].y * gg; w[2] = v[i].z * gg; w[3] = v[i].w * gg; }
    asm volatile("s_waitcnt lgkmcnt(0)" ::: "memory");
#pragma unroll
    for (int j = 0; j < 4; ++j) { const int id = lane + 64 * j, n = id >> 2, c = id & 3; const LAS float* s = scr + (16 * c) * 65 + n; unsigned p[4];
#pragma unroll
        for (int q = 0; q < 4; ++q) { unsigned w = 0u; w = __builtin_amdgcn_cvt_pk_fp8_f32(s[(4 * q + 0) * 65], s[(4 * q + 1) * 65], w, false); w = __builtin_amdgcn_cvt_pk_fp8_f32(s[(4 * q + 2) * 65], s[(4 * q + 3) * 65], w, true); p[q] = w; }
        int nn = n0 + n; if (d.mode == 1) { const int half = nn / FF, j2 = nn % FF; nn = (j2 >> 7) * 256 + half * 128 + (j2 & 127); }
        *(u32x4*)(d.dst + (size_t)nn * d.K + k0 + 16 * c) = (u32x4){p[0], p[1], p[2], p[3]}; }
    asm volatile("s_waitcnt lgkmcnt(0)" ::: "memory");
}
__device__ __forceinline__ void p0_big(Frame& F, const MArgs& args, int cw, int ncw, LAS float* scr) {
    const int gw = F.vcu * ncw + cw, NGW = F.G * ncw, lane = F.lane;
    unsigned char* ws = F.ws;
    const float* g_moe = args.in[7]; const float* w_gu = args.in[10]; const float* w_down = args.in[12]; const float* g_ple = args.in[14]; const float* w_ple_gate = args.in[15];
    {
        constexpr int J_GU = (DM / 64) * (2 * FF / 64), J_WD = (FF / 64) * (DM / 64), J_WG = (DM / 64) * (DM / 64);
        constexpr int PER_LAYER8 = NE * J_GU + NE * J_WD + J_WG, NIT = DEPTH * PER_LAYER8;
        auto decode = [&](int it) -> P0Item {
            const int L = it / PER_LAYER8; int r = it - L * PER_LAYER8;
            if (r < NE * J_GU) { const int e = r / J_GU; const size_t m = (size_t)L * NE + e; return P0Item{w_gu + m * DM * 2 * FF, g_moe + L * DM, ws + WS_WGU8 + m * 2 * FF * DM, DM, 2 * FF, r - e * J_GU, 1}; } r -= NE * J_GU;
            if (r < NE * J_WD) { const int e = r / J_WD; const size_t m = (size_t)L * NE + e; return P0Item{w_down + m * FF * DM, nullptr, ws + WS_WD8 + m * DM * FF, FF, DM, r - e * J_WD, 0}; } r -= NE * J_WD;
            return P0Item{w_ple_gate + (size_t)L * DM * DM, g_ple + L * DM, ws + WS_WG8 + (size_t)L * DM * DM, DM, DM, r, 0};
        };
        f32x4 va[16], vb[16]; float ga = 1.f, gb = 1.f; P0Item da{}, db{};
        int it = gw;
        if (it < NIT) { da = decode(it); p0_load64(da, lane, va, ga); }
        while (it < NIT) {
            const int itb = it + NGW; const bool hb = itb < NIT;
            if (hb) { db = decode(itb); p0_load64(db, lane, vb, gb); }
            p0_store64(da, lane, va, ga, scr);
            const int itc = itb + NGW; const bool hc = itc < NIT;
            if (hc) { da = decode(itc); p0_load64(da, lane, va, ga); }
            if (hb) p0_store64(db, lane, vb, gb, scr);
            it = itc;
        }
    }
}
__device__ __forceinline__ void p0_prologue(Frame& F, const MArgs& args) {
    static_assert(MK_FP8_MASK == 3 && MK_PLE8 == 1, "this prologue converts the expert and PLE gate matrices to fp8 only");
    LAS float* scr = (LAS float*)(F.lds + F.wave * 16896);
    const int gw = F.vcu * MK_WAVES + F.wave, NGW = F.G * MK_WAVES, lane = F.lane;
    unsigned char* ws = F.ws;
    const float* g_mix = args.in[2]; const float* w_qkv = args.in[3]; const float* w_fgate = args.in[4]; const float* w_o = args.in[6]; const float* g_moe = args.in[7]; const float* w_router = args.in[8];
    const float* w_gu = args.in[10]; const float* w_down = args.in[12]; const float* g_ple = args.in[14]; const float* w_ple_gate = args.in[15]; const float* w_ple_proj = args.in[16];
    {
        constexpr int I_QKV = (DM / 64) * (3 * DM / 32), I_SQ = (DM / 64) * (DM / 32), I_WP = (PLE / 64) * (DM / 32), I_WR = (DM / 64) * (NE / 32);
        constexpr int PER_LAYER = I_QKV + I_SQ + I_WP + I_WR, NIT = DEPTH * PER_LAYER;
        auto decode = [&](int it) -> P0Item {
            const int L = it / PER_LAYER; int r = it - L * PER_LAYER;
            if (r < I_QKV) return P0Item{w_qkv + (size_t)L * DM * 3 * DM, g_mix + L * DM, ws + WS_WQKV + (size_t)L * 3 * DM * DM * 2, DM, 3 * DM, r, 0}; r -= I_QKV;
            if (r < I_SQ) return P0Item{w_o + (size_t)L * DM * DM, nullptr, ws + WS_WO + (size_t)L * DM * DM * 2, DM, DM, r, 0}; r -= I_SQ;
            if (r < I_WP) return P0Item{w_ple_proj + (size_t)L * PLE * DM, nullptr, ws + WS_WP + (size_t)L * DM * PLE * 2, PLE, DM, r, 0}; r -= I_WP;
            return P0Item{w_router + (size_t)L * DM * NE, g_moe + L * DM, ws + WS_WR + (size_t)L * NE * DM * 2, DM, NE, r, 0};
        };
        float va[32]; float ga = 1.f;
        for (int it = gw; it < NIT; it += NGW) { const P0Item d = decode(it); p0_load32(d, lane, va, ga); p0_store32(d, lane, va, ga, scr); }
    }
    if (gw < 256) { bf16_t* WF = (bf16_t*)(ws + WS_WF); const int idx = gw * 64 + lane; const int n = idx >> 10, k = idx & 1023; WF[idx] = (bf16_t)f2bf(w_fgate[(size_t)k * NH + n] * g_mix[DM + k]); }
    {
        const float* x = args.in[0]; bf16_t* HB = (bf16_t*)(ws + WS_HB); float* SS = (float*)(ws + WS_SS);
        for (int row0 = gw * 4; row0 < NTOK; row0 += NGW * 4) {
            f32x4 v[4][4];
#pragma unroll
            for (int q = 0; q < 4; ++q) { const f32x4* p = (const f32x4*)(x + (size_t)(row0 + q) * DM) + lane;
#pragma unroll
                for (int j = 0; j < 4; ++j) v[q][j] = p[64 * j]; }
#pragma unroll
            for (int q = 0; q < 4; ++q) { float s = 0.f;
#pragma unroll
                for (int j = 0; j < 4; ++j) s += v[q][j].x * v[q][j].x + v[q][j].y * v[q][j].y + v[q][j].z * v[q][j].z + v[q][j].w * v[q][j].w;
                s = lwave_sum(s, lane);
                if (lane < 16) SS[(size_t)(row0 + q) * 16 + lane] = (lane == 0) ? s : 0.f;
                u32x2* o = (u32x2*)(HB + (size_t)(row0 + q) * DM) + lane;
#pragma unroll
                for (int j = 0; j < 4; ++j) { u32x2 w; w.x = pkb(v[q][j].x, v[q][j].y); w.y = pkb(v[q][j].z, v[q][j].w); o[64 * j] = w; } }
        }
        const float* pp = args.in[1]; bf16_t* PB = (bf16_t*)(ws + WS_PB);
        const size_t n4 = (size_t)DEPTH * NTOK * PLE / 4;
        for (size_t i = (size_t)gw * 64 + lane; i < n4; i += (size_t)NGW * 64 * 4) {
            f32x4 v[4];
#pragma unroll
            for (int q = 0; q < 4; ++q) { const size_t ii = i + (size_t)q * NGW * 64; if (ii < n4) v[q] = ((const f32x4*)pp)[ii]; }
#pragma unroll
            for (int q = 0; q < 4; ++q) { const size_t ii = i + (size_t)q * NGW * 64; if (ii < n4) { u32x2 w; w.x = pkb(v[q].x, v[q].y); w.y = pkb(v[q].z, v[q].w); ((u32x2*)PB)[ii] = w; } }
        }
    }
}

__device__ __forceinline__ void moe_tables(Frame& F, const unsigned* cnt) {
    LAS int* tstartL = (LAS int*)(F.lds + TBL_OFF); LAS int* cntL = tstartL + 64;
    if (F.wave == 0) {
        const int lane = F.lane; const int c = (lane < NE) ? (int)__hip_atomic_load(cnt + CNT_STRIDE * (lane & 31), __ATOMIC_RELAXED, __HIP_MEMORY_SCOPE_AGENT) : 0; const int nt = (c + 255) >> 8; int incl = nt;
#pragma unroll
        for (int o = 1; o < 32; o <<= 1) { const int t = lpermi(incl, lane - o); if ((lane & 31) >= o) incl += t; }
        if (lane < NE) { tstartL[lane] = incl - nt; cntL[lane] = c; if (lane == NE - 1) tstartL[NE] = incl; }
    }
    __syncthreads();
}
__device__ __forceinline__ void router_phase(Frame& F, const bf16_t* HB, const bf16_t* WR, const float* br, float* rstd, unsigned* cnt, int* tok_of, float* gate_of, unsigned* pair) {
    const int gw = F.vcu * MK_WAVES + F.wave, NGW = F.G * MK_WAVES, lane = F.lane, r = lane & 15, quad = lane >> 4;
    LAS unsigned* hist = (LAS unsigned*)(F.lds); LAS unsigned* gbase = hist + 32;
    LAS unsigned char* wl = F.lds + 1024; constexpr int WLS = 2064;
    for (int i = F.tid; i < NE * 128; i += MK_WAVES * 64) { const int row = i >> 7, ch = i & 127; *(LAS u32x4*)(wl + row * WLS + ch * 16) = *(const u32x4*)(WR + (size_t)row * DM + ch * 8); }
    __syncthreads();
    for (int it = 0; it * NGW < NTOK / 16; ++it) {
        const int blk = it * NGW + gw; const bool valid = blk < NTOK / 16;
        if (F.tid < 32) hist[F.tid] = 0u;
        __syncthreads();
        int see[4]; unsigned slr[4]; float sgt[4];
        const int t0 = blk * 16;
        if (valid) {
            const bf16_t* ap = HB + (size_t)(t0 + r) * DM + quad * 8; const LAS unsigned char* bl0 = wl + r * WLS + quad * 16; const LAS unsigned char* bl1 = bl0 + 16 * WLS;
            f32x4 acc0 = {0.f, 0.f, 0.f, 0.f}, acc1 = {0.f, 0.f, 0.f, 0.f}; float ssq = 0.f;
#pragma unroll 16
            for (int ks = 0; ks < 32; ++ks) { const bf16x8 a = *(const bf16x8*)(ap + 32 * ks), b0 = *(const LAS bf16x8*)(bl0 + 64 * ks), b1 = *(const LAS bf16x8*)(bl1 + 64 * ks);
                acc0 = __builtin_amdgcn_mfma_f32_16x16x32_bf16(a, b0, acc0, 0, 0, 0); acc1 = __builtin_amdgcn_mfma_f32_16x16x32_bf16(a, b1, acc1, 0, 0, 0);
#pragma unroll
                for (int j = 0; j < 8; ++j) { const float f = __uint_as_float(((unsigned)(unsigned short)a[j]) << 16); ssq += f * f; } }
            ssq += lperm(ssq, lane ^ 16); ssq += lperm(ssq, lane ^ 32);
            const float rs_r = rsqrtf(ssq * (1.f / DM) + EPS);
            const float b_lo = br[r], b_hi = br[16 + r];
#pragma unroll
            for (int j = 0; j < 4; ++j) {
                const float rsj = lperm(rs_r, quad * 4 + j); const int t = t0 + quad * 4 + j;
                float v0 = acc0[j] * rsj + b_lo, v1 = acc1[j] * rsj + b_hi; float tv[4]; int ti[4];
#pragma unroll
                for (int k = 0; k < 4; ++k) {
                    float bv = (v0 >= v1) ? v0 : v1; int bi = (v0 >= v1) ? r : 16 + r;
#pragma unroll
                    for (int o = 1; o < 16; o <<= 1) { const float ov = lperm(bv, lane ^ o); const int oi = lpermi(bi, lane ^ o); if (ov > bv || (ov == bv && oi < bi)) { bv = ov; bi = oi; } }
                    tv[k] = bv; ti[k] = bi; if (bi == r) v0 = -INFINITY; if (bi == 16 + r) v1 = -INFINITY;
                }
                float w[4], sw = 0.f;
#pragma unroll
                for (int k = 0; k < 4; ++k) { w[k] = __expf(tv[k] - tv[0]); sw += w[k]; }
                const int ee = (r == 0) ? ti[0] : (r == 1) ? ti[1] : (r == 2) ? ti[2] : ti[3]; const float ww = (r == 0) ? w[0] : (r == 1) ? w[1] : (r == 2) ? w[2] : w[3];
                see[j] = ee; sgt[j] = ww / sw; slr[j] = 0u;
                if (r < 4) slr[j] = __hip_atomic_fetch_add(hist + ee, 1u, __ATOMIC_RELAXED, __HIP_MEMORY_SCOPE_WORKGROUP);
                if (r == 4) rstd[t] = rsj;
            }
        }
        __syncthreads();
        if (F.tid < 32) { const unsigned n = hist[F.tid]; gbase[F.tid] = n ? __hip_atomic_fetch_add(cnt + CNT_STRIDE * F.tid, n, __ATOMIC_RELAXED, __HIP_MEMORY_SCOPE_AGENT) : 0u; }
        __syncthreads();
        if (valid && r < 4) {
#pragma unroll
            for (int j = 0; j < 4; ++j) { const int t = t0 + quad * 4 + j; const int ee = see[j]; const unsigned rk = gbase[ee] + slr[j];
                tok_of[(size_t)ee * CAP + rk] = t; gate_of[(size_t)ee * CAP + rk] = sgt[j]; pair[(size_t)t * 4 + r] = ((unsigned)ee << 16) | rk; }
        }
        __syncthreads();
    }
}
__device__ __forceinline__ void fgate_phase(Frame& F, const bf16_t* HB, const bf16_t* WF, const float* bfg, const float* SS, float* FL) {
    const int gw = F.vcu * MK_WAVES + F.wave, NGW = F.G * MK_WAVES, lane = F.lane, r = lane & 15, quad = lane >> 4;
    for (int blk = gw; blk < NTOK / 16; blk += NGW) {
        const int t0 = blk * 16;
        const bf16_t* ap = HB + (size_t)(t0 + r) * DM + quad * 8; const bf16_t* bp0 = WF + (size_t)r * DM + quad * 8;
        f32x4 acc0 = {0.f, 0.f, 0.f, 0.f};
#pragma unroll 8
        for (int ks = 0; ks < 32; ++ks) { const bf16x8 a = *(const bf16x8*)(ap + 32 * ks), b0 = *(const bf16x8*)(bp0 + 32 * ks); acc0 = __builtin_amdgcn_mfma_f32_16x16x32_bf16(a, b0, acc0, 0, 0, 0); }
        const f32x4 sp = *(const f32x4*)(SS + (size_t)(t0 + r) * 16 + quad * 4); float ss = (sp.x + sp.y) + (sp.z + sp.w); ss += lperm(ss, lane ^ 16); ss += lperm(ss, lane ^ 32);
        const float rs_r = rsqrtf(ss * (1.f / DM) + EPS); const float bb = bfg[r];
#pragma unroll
        for (int j = 0; j < 4; ++j) { const float rsj = lperm(rs_r, quad * 4 + j); FL[(size_t)(t0 + quad * 4 + j) * NH + r] = acc0[j] * rsj + bb; }
    }
}
__device__ __forceinline__ void combine_phase(Frame& F, const bf16_t* hin, bf16_t* hout, unsigned char* hout8, float* rstd, const unsigned* pair, const bf16_t* Y) {
    const int gw = F.vcu * MK_WAVES + F.wave, NGW = F.G * MK_WAVES, lane = F.lane; const LAS int* tstartL = (const LAS int*)(F.lds + TBL_OFF);
    constexpr int CMB_Q = 2;
    for (int t0 = gw; t0 < NTOK; t0 += CMB_Q * NGW) {
        int tt[CMB_Q];
#pragma unroll
        for (int q = 0; q < CMB_Q; ++q) tt[q] = (t0 + q * NGW < NTOK) ? t0 + q * NGW : t0;
        u32x4 pr4[CMB_Q]; u32x2 hw[CMB_Q][4]; u32x2 yw[CMB_Q][4][4];
#pragma unroll
        for (int q = 0; q < CMB_Q; ++q) pr4[q] = *(const u32x4*)(pair + (size_t)tt[q] * 4);
#pragma unroll
        for (int q = 0; q < CMB_Q; ++q) { const u32x2* hr = (const u32x2*)(hin + (size_t)tt[q] * DM) + lane;
#pragma unroll
            for (int j = 0; j < 4; ++j) hw[q][j] = hr[64 * j]; }
#pragma unroll
        for (int q = 0; q < CMB_Q; ++q)
#pragma unroll
            for (int k = 0; k < 4; ++k) { const unsigned pr = (k == 0) ? pr4[q].x : (k == 1) ? pr4[q].y : (k == 2) ? pr4[q].z : pr4[q].w; const int e = __builtin_amdgcn_readfirstlane((int)(pr >> 16)), rk = __builtin_amdgcn_readfirstlane((int)(pr & 0xffffu));
                const size_t slot = (size_t)tstartL[e] * 256 + rk; const u32x2* yr = (const u32x2*)(Y + slot * DM) + lane;
#pragma unroll
                for (int j = 0; j < 4; ++j) yw[q][k][j] = yr[64 * j]; }
#pragma unroll
        for (int q = 0; q < CMB_Q; ++q) { const int t = tt[q]; f32x4 v[4];
#pragma unroll
            for (int j = 0; j < 4; ++j) { v[j].x = __uint_as_float(hw[q][j].x << 16); v[j].y = __uint_as_float(hw[q][j].x & 0xffff0000u); v[j].z = __uint_as_float(hw[q][j].y << 16); v[j].w = __uint_as_float(hw[q][j].y & 0xffff0000u);
#pragma unroll
                for (int k = 0; k < 4; ++k) { const u32x2 w = yw[q][k][j]; v[j].x += __uint_as_float(w.x << 16); v[j].y += __uint_as_float(w.x & 0xffff0000u); v[j].z += __uint_as_float(w.y << 16); v[j].w += __uint_as_float(w.y & 0xffff0000u); } }
            float s = 0.f; u32x2* o = (u32x2*)(hout + (size_t)t * DM) + lane;
#pragma unroll
            for (int j = 0; j < 4; ++j) { u32x2 w; w.x = pkb(v[j].x, v[j].y); w.y = pkb(v[j].z, v[j].w); o[64 * j] = w;
                if (hout8) { unsigned p = 0u; p = __builtin_amdgcn_cvt_pk_fp8_f32(v[j].x, v[j].y, p, false); p = __builtin_amdgcn_cvt_pk_fp8_f32(v[j].z, v[j].w, p, true); ((unsigned*)(hout8 + (size_t)t * DM))[lane + 64 * j] = p; }
                const float q0 = __uint_as_float(w.x << 16), q1 = __uint_as_float(w.x & 0xffff0000u), q2 = __uint_as_float(w.y << 16), q3 = __uint_as_float(w.y & 0xffff0000u); s += (q0 * q0 + q1 * q1) + (q2 * q2 + q3 * q3); }
            s = lwave_sum(s, lane); if (lane == 0) rstd[t] = rsqrtf(s * (1.f / DM) + EPS); }
    }
}
__device__ __forceinline__ void final_phase(Frame& F, const bf16_t* hb, const float* SS, const float* g, float* out) {
    const int gw = F.vcu * MK_WAVES + F.wave, NGW = F.G * MK_WAVES, lane = F.lane;
    f32x4 gg[4];
#pragma unroll
    for (int j = 0; j < 4; ++j) gg[j] = ((const f32x4*)g)[lane + 64 * j];
    for (int row0 = gw; row0 < NTOK; row0 += 4 * NGW) {
        u32x2 w[4][4]; float ss[4]; int rr[4];
#pragma unroll
        for (int q = 0; q < 4; ++q) { rr[q] = (row0 + q * NGW < NTOK) ? row0 + q * NGW : row0; const u32x2* p = (const u32x2*)(hb + (size_t)rr[q] * DM) + lane;
#pragma unroll
            for (int j = 0; j < 4; ++j) w[q][j] = p[64 * j];
            ss[q] = (lane < 16) ? SS[(size_t)rr[q] * 16 + lane] : 0.f; }
#pragma unroll
        for (int q = 0; q < 4; ++q) { const float rs = rsqrtf(lwave_sum(ss[q], lane) * (1.f / DM) + EPS); f32x4* o = (f32x4*)(out + (size_t)rr[q] * DM) + lane;
#pragma unroll
            for (int j = 0; j < 4; ++j) { f32x4 v; v.x = __uint_as_float(w[q][j].x << 16); v.y = __uint_as_float(w[q][j].x & 0xffff0000u); v.z = __uint_as_float(w[q][j].y << 16); v.w = __uint_as_float(w[q][j].y & 0xffff0000u); o[64 * j] = v * rs * gg[j]; } }
    }
}
__device__ __forceinline__ void fox_head(Frame& F, unsigned char* lds_generic, int bh, const bf16_t* Q, const bf16_t* K, const bf16_t* V, const float* FL, bf16_t* O) {
    int tid_ = threadIdx.x; asm volatile("" : "+v"(tid_));
    const int lane = tid_ & 63, b = bh / NH, hh = bh % NH; const size_t rowb = (size_t)b * SEQ;
    LAS float* cbL = (LAS float*)(F.lds + attn_body::ATTN_LDS_BYTES); LAS float* wtot = cbL + SEQ;
    {
        float loc[4]; float run = 0.f;
#pragma unroll
        for (int i = 0; i < 4; ++i) { run += log_sigmoid(FL[(size_t)(rowb + tid_ * 4 + i) * NH + hh]); loc[i] = run; }
        float incl = run;
#pragma unroll
        for (int o = 1; o < 64; o <<= 1) { const float t = lperm(incl, lane - o); if (lane >= o) incl += t; }
        if (lane == 63) wtot[F.wave] = incl;
        __syncthreads();
        float base = incl - run;
        for (int w = 0; w < F.wave; ++w) base += wtot[w];
#pragma unroll
        for (int i = 0; i < 4; ++i) cbL[tid_ * 4 + i] = -(base + loc[i]) * LOG2E;
        __syncthreads();
    }
    for (int qb = 0; qb < SEQ / 256; ++qb)
        attn_body::attn_unit<8>(b, hh, qb, (const attn_body::bf16*)Q, (const attn_body::bf16*)K, (const attn_body::bf16*)V, (attn_body::bf16*)O, (char*)lds_generic, cbL);
}
constexpr int N_PHASES = 18;
__global__ void __launch_bounds__(MK_WAVES * 64, 2) mega_fwd(MArgs args) {
    extern __shared__ __attribute__((aligned(16))) unsigned char lds_raw[];
    Frame F;
    F.lds = (LAS unsigned char*)lds_raw;
    F.tid = threadIdx.x; F.lane = F.tid & 63; F.wave = __builtin_amdgcn_readfirstlane(F.tid >> 6);
    F.G = gridDim.x; { const int bx = blockIdx.x; F.vcu = (F.G % 8 == 0) ? (bx % 8) * (F.G / 8) + bx / 8 : bx; }
    F.ws = args.ws; F.ctl = (unsigned*)(args.ws + WS_CTL);
    unsigned char* ws = args.ws;
    for (int u = F.tid; u < (MK_LDS_BYTES - LDSCTL_OFF) / 4; u += MK_WAVES * 64) ((LAS unsigned*)(F.lds + LDSCTL_OFF))[u] = 0u;
    __syncthreads();
    const int lo = args.ph_lo, hi = args.ph_hi;
    const bool use_bar = (hi - lo) > 1;
    XcdBarrier bar; bar.bar = F.ctl + CW_BAR; bar.x = 0; bar.st = nullptr;
    if (use_bar) bar = xcd_barrier_post(F.ctl + CW_BAR, (volatile LAS unsigned*)(F.lds + LDSCTL_OFF + 32));
#ifndef MK_DUP
#define MK_DUP 0
#endif
#define NREP(j) (((MK_DUP >> (j)) & 1) ? 2 : 1)
#ifndef MK_QKVPROBE
#define MK_QKVPROBE 0
#endif
#ifndef MK_NSB
#define MK_NSB 5
#endif
#ifndef MK_ATTSUB
#define MK_ATTSUB 3
#endif
#ifndef MK_P0SUB
#define MK_P0SUB 7
#endif
#ifndef MK_PHMASK
#define MK_PHMASK 0x3ff
#endif
#define IN(k) (lo <= (k) && (k) < hi)
#define EN(j) ((MK_PHMASK >> (j)) & 1)
#define PHASE_BEGIN() do { int t_ = threadIdx.x; asm volatile("" : "+v"(t_)); F.tid = t_; F.lane = t_ & 63; } while (0)
#define SEAM(k) do { if (IN(k) && IN((k) + 1)) xcd_barrier(bar); } while (0)
    bf16_t* const HB0 = (bf16_t*)(ws + WS_HB); bf16_t* const HB1 = (bf16_t*)(ws + WS_HB2); float* const SS = (float*)(ws + WS_SS);
    bf16_t* const Qb = (bf16_t*)(ws + WS_Q); bf16_t* const Kb = (bf16_t*)(ws + WS_K); bf16_t* const Vb = (bf16_t*)(ws + WS_V); bf16_t* const Ob = (bf16_t*)(ws + WS_O);
    float* const rstd_moe = (float*)(ws + WS_RSTD) + NTOK; float* const rstd_ple = rstd_moe + NTOK;
    int* const tok_of = (int*)(ws + WS_TOK); float* const gate_of = (float*)(ws + WS_GATE); unsigned* const pair = (unsigned*)(ws + WS_PAIR);
    bf16_t* const ACT = (bf16_t*)(ws + WS_ACT); bf16_t* const Yb = (bf16_t*)(ws + WS_Y); float* const FL = (float*)(ws + WS_FL);
    LAS int* const tstartL = (LAS int*)(F.lds + TBL_OFF); LAS int* const cntL = tstartL + 64; LAS unsigned short* const tokL = (LAS unsigned short*)(F.lds + TOK_OFF); LAS float* const rowL = (LAS float*)(F.lds + ROW_OFF);

    if (EN(8) && IN(0)) { for (int rep_ = 0; rep_ < NREP(8); ++rep_) p0_prologue(F, args); }
    SEAM(0);
    for (int L = 0; L < DEPTH; ++L) {
        const int pb = 1 + 8 * L;
        unsigned* const cnt = F.ctl + CW_CNT2 + 2048 * L;
        const bool f8 = (L == 0) ? bool(MK_FP8_MASK & 1) : bool(MK_FP8_MASK & 2);
        bf16_t* const HBa = (L & 1) ? HB1 : HB0; bf16_t* const HBb = (L & 1) ? HB0 : HB1;
        if (EN(0) && IN(pb + 0)) for (int rep_ = 0; rep_ < NREP(0); ++rep_) { PHASE_BEGIN();
            if (MK_P0SUB & 1) if (L == 1) fgate_phase(F, HBa, (const bf16_t*)(ws + WS_WF), args.in[5], SS, FL);
            if (MK_P0SUB & 2) { pg8::DenseOrder S; S.init(NTOK, 3 * DM, F.G, (int)blockIdx.x); pg8::EpiQKV E{Qb, rowL, 0}; pg8::EpiQKV Ep{Qb, rowL, MK_QKVPROBE};
              _Pragma("clang loop unroll(disable)") for (int i0 = 0; i0 < TOK_UNITS; i0 += 2) { const int i = i0 + (F.wave >> 2); pg8::Unit u; if (S.next(i, u)) { const int lr = F.tid & 255; const f32x4* sp = (const f32x4*)(SS + (size_t)(u.arow0 + lr) * 16);
                  const f32x4 s0 = sp[0], s1 = sp[1], s2 = sp[2], s3 = sp[3]; const float ss = ((s0.x + s0.y) + (s0.z + s0.w)) + ((s1.x + s1.y) + (s1.z + s1.w)) + ((s2.x + s2.y) + (s2.z + s2.w)) + ((s3.x + s3.y) + (s3.z + s3.w));
                  rowL[i * 256 + lr] = rsqrtf(ss * (1.f / DM) + EPS); } }
              __syncthreads();
              if (NREP(13) > 1) pg8::gemm_phase(F.lds, HBa, (const bf16_t*)(ws + WS_WQKV) + (size_t)L * 3 * DM * DM, 2 * DM, S, E, true);
              if (NREP(14) > 1) pg8::gemm_phase(F.lds, HBa, (const bf16_t*)(ws + WS_WQKV) + (size_t)L * 3 * DM * DM, 2 * DM, S, Ep, false);
              if (NREP(15) > 1) { pg8::HotOrder Sh; Sh.d = S; pg8::gemm_phase(F.lds, HBa, (const bf16_t*)(ws + WS_WQKV) + (size_t)L * 3 * DM * DM, 2 * DM, Sh, Ep, false); }
              pg8::gemm_phase(F.lds, HBa, (const bf16_t*)(ws + WS_WQKV) + (size_t)L * 3 * DM * DM, 2 * DM, S, E); }
            if (MK_P0SUB & 4) if (L == 0) { pg8::PJOrder S; S.init(F.G, (int)blockIdx.x); pg8::EpiPJ E{(bf16_t*)(ws + WS_PJ)};
                pg8::gemm_phase(F.lds, (const bf16_t*)(ws + WS_PB), (const bf16_t*)(ws + WS_WP), 2 * PLE, S, E); }
        }
        SEAM(pb + 0);
        if (EN(1) && IN(pb + 1)) for (int rep_ = 0; rep_ < (NREP(1) > 1 ? 2 : (L == 0 ? NREP(10) : NREP(11))); ++rep_) { PHASE_BEGIN();
            if (L == 0) {
                if (F.wave < MK_NSB) { if (MK_ATTSUB & 1) for (int bh = blockIdx.x; bh < NB * NH; bh += F.G) sb_body::sb_head(F.lds, bh, Qb, Kb, Vb, Ob); }
                else p0_big(F, args, F.wave - MK_NSB, MK_WAVES - MK_NSB, (LAS float*)(F.lds + MK_NSB * 16384 + (F.wave - MK_NSB) * 16896));
            }
            else { if (MK_ATTSUB & 2) for (int bh = blockIdx.x; bh < NB * NH; bh += F.G) { fox_head(F, lds_raw, bh, Qb, Kb, Vb, FL, Ob); __syncthreads(); } }
        }
        SEAM(pb + 1);
        if (EN(2) && IN(pb + 2)) for (int rep_ = NREP(2) - 1; rep_ >= 0; --rep_) { PHASE_BEGIN();
            pg8::DenseOrder S; S.init(NTOK, DM, F.G, (int)blockIdx.x); pg8::EpiWo E{HBa, rep_ ? (bf16_t*)(ws + WS_ACT + 128 * MiB) : HBb, f8 ? (rep_ ? ws + WS_ACT + 210 * MiB : ws + WS_HB8) : nullptr};
            pg8::gemm_phase(F.lds, Ob, (const bf16_t*)(ws + WS_WO) + (size_t)L * DM * DM, 2 * DM, S, E);
        }
        SEAM(pb + 2);
        if (EN(3) && IN(pb + 3)) for (int rep_ = NREP(3) - 1; rep_ >= 0; --rep_) { PHASE_BEGIN(); unsigned char* dd = ws + WS_ACT + 192 * MiB;
            if (rep_) router_phase(F, HBb, (const bf16_t*)(ws + WS_WR) + (size_t)L * NE * DM, args.in[9] + L * NE, (float*)(dd + 9 * MiB), F.ctl + CW_CNT2 + 4096 + 2048 * L, (int*)dd, (float*)(dd + 4 * MiB), (unsigned*)(dd + 8 * MiB));
            else router_phase(F, HBb, (const bf16_t*)(ws + WS_WR) + (size_t)L * NE * DM, args.in[9] + L * NE, rstd_moe, cnt, tok_of, gate_of, pair); }
        SEAM(pb + 3);
        if (EN(4) && IN(pb + 4)) for (int rep_ = (NREP(4) > 1 || NREP(12) > 1) ? 1 : 0; rep_ >= 0; --rep_) { PHASE_BEGIN(); const bool skip_ = rep_ && NREP(12) > 1;
            moe_tables(F, cnt);
            pg8::MoeOrder S; S.NN = 8; S.nwg = tstartL[NE] * 8; S.G = F.G; S.c = (int)blockIdx.x; S.lane = F.lane; S.tstartL = tstartL; S.cntL = cntL; S.tokL = tokL; S.gather = true;
            _Pragma("clang loop unroll(disable)") for (int k0 = 0; k0 < TOK_UNITS / 2; k0 += 3) {
                int tokv[3]; float rsv[3]; bool okv[3]; const int lr = F.tid & 255;
#pragma unroll
                for (int k = 0; k < 3; ++k) { pg8::Unit u; okv[k] = S.next(2 * (k0 + k) + (F.wave >> 2), u); const int rk = u.rank0 + lr; tokv[k] = okv[k] ? tok_of[(size_t)u.e * CAP + (rk < u.cnt ? rk : u.rank0)] : 0; }
#pragma unroll
                for (int k = 0; k < 3; ++k) rsv[k] = okv[k] ? rstd_moe[tokv[k]] : 0.f;
#pragma unroll
                for (int k = 0; k < 3; ++k) if (okv[k]) { const int i = 2 * (k0 + k) + (F.wave >> 2); tokL[i * 256 + lr] = (unsigned short)tokv[k]; rowL[i * 256 + lr] = rsv[k] * (f8 ? W8INV : 1.f); }
            }
            __syncthreads();
            if (f8) { pg8::EpiGU<true> E{ws + WS_ACT8, args.in[11] + (size_t)L * NE * 2 * FF, rowL};
                pg8::gemm_phase<pg8::EpiGU<true>, pg8::MoeOrder, true>(F.lds, ws + WS_HB8, ws + WS_WGU8 + (size_t)L * NE * 2 * FF * DM, DM, S, E, skip_); }
            else { pg8::EpiGU<false> E{ACT, args.in[11] + (size_t)L * NE * 2 * FF, rowL};
                pg8::gemm_phase(F.lds, HBb, (const bf16_t*)(ws + WS_WGU) + (size_t)L * NE * 2 * FF * DM, 2 * DM, S, E); }
        }
        SEAM(pb + 4);
        if (EN(5) && IN(pb + 5)) for (int rep_ = 0; rep_ < NREP(5); ++rep_) { PHASE_BEGIN();
            moe_tables(F, cnt);
            pg8::MoeOrder S; S.NN = 4; S.nwg = tstartL[NE] * 4; S.G = F.G; S.c = (int)blockIdx.x; S.lane = F.lane; S.tstartL = tstartL; S.cntL = cntL; S.tokL = tokL; S.gather = false;
            _Pragma("clang loop unroll(disable)") for (int k0 = 0; k0 < 6; k0 += 3) {
                float gv[3]; bool okv[3]; const int lr = F.tid & 255;
#pragma unroll
                for (int k = 0; k < 3; ++k) { pg8::Unit u; okv[k] = S.next(2 * (k0 + k) + (F.wave >> 2), u); const int rk = u.rank0 + lr; gv[k] = (okv[k] && rk < u.cnt) ? gate_of[(size_t)u.e * CAP + rk] : 0.f; }
#pragma unroll
                for (int k = 0; k < 3; ++k) if (okv[k]) rowL[(2 * (k0 + k) + (F.wave >> 2)) * 256 + lr] = gv[k] * (f8 ? W8INV : 1.f);
            }
            __syncthreads();
            pg8::EpiDown E{Yb, args.in[13] + (size_t)L * NE * DM, rowL, f8 ? W8SCALE : 1.f};
            if (f8) pg8::gemm_phase<pg8::EpiDown, pg8::MoeOrder, true>(F.lds, ws + WS_ACT8, ws + WS_WD8 + (size_t)L * NE * DM * FF, FF, S, E);
            else pg8::gemm_phase(F.lds, ACT, (const bf16_t*)(ws + WS_WD) + (size_t)L * NE * DM * FF, 2 * FF, S, E);
        }
        SEAM(pb + 5);
        if (EN(6) && IN(pb + 6)) for (int rep_ = NREP(6) - 1; rep_ >= 0; --rep_) { PHASE_BEGIN(); moe_tables(F, cnt);
            if (rep_) combine_phase(F, HBb, (bf16_t*)(ws + WS_ACT + 128 * MiB), nullptr, (float*)(ws + WS_ACT + 201 * MiB), pair, Yb);
            else combine_phase(F, HBb, HBa, MK_PLE8 ? ws + WS_HB8 : nullptr, rstd_ple, pair, Yb); }
        SEAM(pb + 6);
        if (EN(7) && IN(pb + 7)) for (int rep_ = NREP(7) - 1; rep_ >= 0; --rep_) { PHASE_BEGIN();
            pg8::DenseOrder S; S.init(NTOK, DM, F.G, (int)blockIdx.x);
            pg8::EpiPLE E{HBa, rep_ ? (bf16_t*)(ws + WS_ACT + 128 * MiB) : HBb, (const bf16_t*)(ws + WS_PJ) + (size_t)L * NTOK * DM, rowL, rep_ ? (float*)(ws + WS_ACT + 202 * MiB) : SS};
            _Pragma("clang loop unroll(disable)") for (int i0 = 0; i0 < TOK_UNITS; i0 += 2) { const int i = i0 + (F.wave >> 2); pg8::Unit u; if (S.next(i, u)) { const int lr = F.tid & 255; rowL[i * 256 + lr] = rstd_ple[u.arow0 + lr] * (MK_PLE8 ? W8INV : 1.f); } }
            __syncthreads();
            if (MK_PLE8) pg8::gemm_phase<pg8::EpiPLE, pg8::DenseOrder, true>(F.lds, ws + WS_HB8, ws + WS_WG8 + (size_t)L * DM * DM, DM, S, E);
            else pg8::gemm_phase(F.lds, HBa, (const bf16_t*)(ws + WS_WG) + (size_t)L * DM * DM, 2 * DM, S, E);
        }
        SEAM(pb + 7);
    }
    if (EN(9) && IN(17)) for (int rep_ = 0; rep_ < NREP(9); ++rep_) { PHASE_BEGIN(); final_phase(F, HB0, SS, args.in[17], args.out); }
#undef IN
#undef SEAM
}
#define MK_MODE 2

#ifndef MK_MODE
#define MK_MODE 2
#endif
extern "C" void kernel_launch(void* const* d_in, const int* in_sizes, int n_in, void* d_out, int out_size, void* d_ws, size_t ws_size, hipStream_t stream) {
    if (n_in != 18 || in_sizes[0] != NTOK * DM || out_size != NTOK * DM || ws_size < WS_END2) { fprintf(stderr, "kernel_launch: unexpected shapes / workspace (%d inputs, ws %zu, need %zu)\n", n_in, ws_size, (size_t)WS_END2); return; }
    unsigned char* ws = (unsigned char*)d_ws;
    (void)hipMemsetAsync(ws + WS_CTL, 0, 1 * MiB, stream);
#if MK_MODE != 0
    static int grid = 0;
    if (grid == 0) {
        int dev = 0, cus = 0, per_cu = 0;
        if (hipGetDevice(&dev) != hipSuccess || hipDeviceGetAttribute(&cus, hipDeviceAttributeMultiprocessorCount, dev) != hipSuccess) { fprintf(stderr, "kernel_launch: device query failed\n"); grid = -1; return; }
        if (hipFuncSetAttribute((const void*)mega_fwd, hipFuncAttributeMaxDynamicSharedMemorySize, MK_LDS_BYTES) != hipSuccess) { fprintf(stderr, "kernel_launch: hipFuncSetAttribute failed\n"); grid = -1; return; }
        if (hipOccupancyMaxActiveBlocksPerMultiprocessor(&per_cu, (const void*)mega_fwd, MK_WAVES * 64, MK_LDS_BYTES) != hipSuccess || per_cu < 1) fprintf(stderr, "kernel_launch: occupancy query reports %d\n", per_cu);
        (void)hipGetLastError();
        grid = cus;
        grid -= grid % 8;
    }
    if (grid <= 0) return;
    MArgs a{};
    for (int i = 0; i < 18; ++i) a.in[i] = (const float*)d_in[i];
    a.out = (float*)d_out; a.ws = ws;
#if MK_MODE == 2
    a.ph_lo = 0; a.ph_hi = N_PHASES;
    hipLaunchKernelGGL(mega_fwd, dim3(grid), dim3(MK_WAVES * 64), MK_LDS_BYTES, stream, a);
#else
    for (int ph = 0; ph < N_PHASES; ++ph) { a.ph_lo = ph; a.ph_hi = ph + 1; hipLaunchKernelGGL(mega_fwd, dim3(grid), dim3(MK_WAVES * 64), MK_LDS_BYTES, stream, a); }
#endif
    { const hipError_t le = hipPeekAtLastError(); if (le != hipSuccess) fprintf(stderr, "kernel_launch: launch failed: %s\n", hipGetErrorName(le)); }
#else
    const float* x = (const float*)d_in[0]; const float* p = (const float*)d_in[1]; const float* g_mix = (const float*)d_in[2]; const float* w_qkv = (const float*)d_in[3];
    const float* w_fgate = (const float*)d_in[4]; const float* b_fgate = (const float*)d_in[5]; const float* w_o = (const float*)d_in[6]; const float* g_moe = (const float*)d_in[7];
    const float* w_router = (const float*)d_in[8]; const float* b_router = (const float*)d_in[9]; const float* w_gu = (const float*)d_in[10]; const float* b_gu = (const float*)d_in[11];
    const float* w_down = (const float*)d_in[12]; const float* b_down = (const float*)d_in[13]; const float* g_ple = (const float*)d_in[14]; const float* w_ple_gate = (const float*)d_in[15];
    const float* w_ple_proj = (const float*)d_in[16]; const float* g_final = (const float*)d_in[17];
    unsigned* ctl = (unsigned*)(ws + WS_CTL);
    bf16_t *Wqkv = (bf16_t*)(ws + WS_WQKV), *Wo = (bf16_t*)(ws + WS_WO), *Wg = (bf16_t*)(ws + WS_WG), *Wp = (bf16_t*)(ws + WS_WP), *Wgu = (bf16_t*)(ws + WS_WGU), *Wd = (bf16_t*)(ws + WS_WD);
    float* H = (float*)(ws + WS_H); bf16_t *HB = (bf16_t*)(ws + WS_HB), *Q = (bf16_t*)(ws + WS_Q), *Kb = (bf16_t*)(ws + WS_K), *Vb = (bf16_t*)(ws + WS_V), *O = (bf16_t*)(ws + WS_O);
    bf16_t *PB = (bf16_t*)(ws + WS_PB), *PJ = (bf16_t*)(ws + WS_PJ), *ACT = (bf16_t*)(ws + WS_ACT), *Y = (bf16_t*)(ws + WS_Y);
    int* tok_of = (int*)(ws + WS_TOK); float* gate_of = (float*)(ws + WS_GATE); unsigned* pair = (unsigned*)(ws + WS_PAIR);
    float* rstd_mix = (float*)(ws + WS_RSTD); float* rstd_moe = rstd_mix + NTOK; float* rstd_ple = rstd_moe + NTOK;
    float* FL = (float*)(ws + WS_FL); float* CB = (float*)(ws + WS_CB);
    for (int i = 0; i < DEPTH; ++i) {
        k_cvt_t<0><<<dim3(3 * DM / 64, DM / 64, 1), 256, 0, stream>>>(w_qkv + (size_t)i * DM * 3 * DM, g_mix + i * DM, Wqkv + (size_t)i * 3 * DM * DM, DM, 3 * DM);
        k_cvt_t<0><<<dim3(DM / 64, DM / 64, 1), 256, 0, stream>>>(w_o + (size_t)i * DM * DM, nullptr, Wo + (size_t)i * DM * DM, DM, DM);
        k_cvt_t<0><<<dim3(DM / 64, DM / 64, 1), 256, 0, stream>>>(w_ple_gate + (size_t)i * DM * DM, g_ple + i * DM, Wg + (size_t)i * DM * DM, DM, DM);
        k_cvt_t<0><<<dim3(DM / 64, PLE / 64, 1), 256, 0, stream>>>(w_ple_proj + (size_t)i * PLE * DM, nullptr, Wp + (size_t)i * DM * PLE, PLE, DM);
        k_cvt_t<1><<<dim3(2 * FF / 64, DM / 64, NE), 256, 0, stream>>>(w_gu + (size_t)i * NE * DM * 2 * FF, g_moe + i * DM, Wgu + (size_t)i * NE * 2 * FF * DM, DM, 2 * FF);
        k_cvt_t<0><<<dim3(DM / 64, FF / 64, NE), 256, 0, stream>>>(w_down + (size_t)i * NE * FF * DM, nullptr, Wd + (size_t)i * NE * DM * FF, FF, DM);
    }
    k_cvt<<<(unsigned)((size_t)DEPTH * NTOK * PLE / 4 / 256), 256, 0, stream>>>(p, PB, (size_t)DEPTH * NTOK * PLE / 4);
    for (int i = 0; i < DEPTH; ++i)
        k_gemm_pj<<<dim3(DM / 64, NTOK / 64), 64, 0, stream>>>(PB + (size_t)i * NTOK * PLE, Wp + (size_t)i * DM * PLE, PJ + (size_t)i * NTOK * DM);
    k_rowstat<<<NTOK / 4, 256, 0, stream>>>(x, HB, rstd_mix);
    for (int i = 0; i < DEPTH; ++i) {
        const float* hin = (i == 0) ? x : H;
        k_gemm_qkv<<<dim3(3 * DM / 64, NTOK / 64), 64, 0, stream>>>(HB, Wqkv + (size_t)i * 3 * DM * DM, rstd_mix, Q);
        if (i == 0) k_attn_sb<<<NB * NH * SEQ / 4, 256, 0, stream>>>(Q, Kb, Vb, O);
        else {
            k_fgate<<<NTOK / 4, 256, 0, stream>>>(hin, g_mix + i * DM, w_fgate, b_fgate, rstd_mix, FL);
            k_scan<<<NB * NH, 64, 0, stream>>>(FL, CB);
            k_attn_fox<<<NB * NH * SEQ / 4, 256, 0, stream>>>(Q, Kb, Vb, CB, O);
        }
        k_gemm_wo<<<dim3(DM / 64, NTOK / 64), 64, 0, stream>>>(O, Wo + (size_t)i * DM * DM, hin, H, HB);
        unsigned* cnt = ctl + CW_CNT + 64 * i;
        k_router<<<NTOK / 4, 256, 0, stream>>>(H, g_moe + i * DM, w_router + (size_t)i * DM * NE, b_router + i * NE, rstd_moe, cnt, tok_of, gate_of, pair);
        k_gemm_gu<<<dim3(FF / 64, MAXT * 4), 64, 0, stream>>>(HB, Wgu + (size_t)i * NE * 2 * FF * DM, b_gu + (size_t)i * NE * 2 * FF, rstd_moe, cnt, tok_of, ACT);
        k_gemm_down<<<dim3(DM / 64, MAXT * 4), 64, 0, stream>>>(ACT, Wd + (size_t)i * NE * DM * FF, b_down + (size_t)i * NE * DM, cnt, gate_of, Y);
        k_combine<<<NTOK / 4, 256, 0, stream>>>(H, HB, rstd_ple, cnt, pair, Y);
        k_gemm_ple<<<dim3(DM / 64, NTOK / 64), 64, 0, stream>>>(HB, Wg + (size_t)i * DM * DM, rstd_ple, PJ + (size_t)i * NTOK * DM, H, HB);
        if (i + 1 < DEPTH) k_rowstat<<<NTOK / 4, 256, 0, stream>>>(H, HB, rstd_mix);
    }
    k_final<<<NTOK / 4, 256, 0, stream>>>(H, g_final, (float*)d_out);
#endif
}
```

```cpp
#define MK_DUP 0
#define MK_FP8_MASK 3
#include <hip/hip_runtime.h>
#include <cstdio>
#include <cstdint>

typedef unsigned short bf16_t;
typedef short bf16x8 __attribute__((ext_vector_type(8)));
typedef float f32x4 __attribute__((ext_vector_type(4)));
typedef float f32x16 __attribute__((ext_vector_type(16)));
typedef unsigned u32x4 __attribute__((ext_vector_type(4)));
typedef unsigned u32x2 __attribute__((ext_vector_type(2)));

constexpr int NTOK = 32768, DM = 1024, SEQ = 2048, NB = 16, NH = 16, HD = 64, NE = 32, TOPK = 4, FF = 1024, PLE = 256, DEPTH = 2;
constexpr int CAP = NTOK;
constexpr int MAXT = 544;
constexpr int NSLOT = MAXT * 256;
constexpr float EPS = 1e-6f;
constexpr float LOG2E = 1.4426950408889634f;
constexpr float C2 = 0.125f * LOG2E;

constexpr size_t MiB = 1u << 20;
constexpr size_t WS_CTL = 0;
constexpr size_t WS_WQKV = 2 * MiB;
constexpr size_t WS_WO = WS_WQKV + 12 * MiB;
constexpr size_t WS_WG = WS_WO + 4 * MiB;
constexpr size_t WS_WP = WS_WG + 4 * MiB;
constexpr size_t WS_WGU = WS_WP + 2 * MiB;
constexpr size_t WS_WD = WS_WGU + 256 * MiB;
constexpr size_t WS_H = WS_WD + 128 * MiB;
constexpr size_t WS_HB = WS_H + 128 * MiB;
constexpr size_t WS_Q = WS_HB + 64 * MiB;
constexpr size_t WS_K = WS_Q + 64 * MiB;
constexpr size_t WS_V = WS_K + 64 * MiB;
constexpr size_t WS_O = WS_V + 64 * MiB;
constexpr size_t WS_PB = WS_O + 64 * MiB;
constexpr size_t WS_PJ = WS_PB + 32 * MiB;
constexpr size_t WS_ACT = WS_PJ + 128 * MiB;
constexpr size_t WS_Y = WS_ACT + 272 * MiB;
constexpr size_t WS_TOK = WS_Y + 272 * MiB;
constexpr size_t WS_GATE = WS_TOK + 4 * MiB;
constexpr size_t WS_PAIR = WS_GATE + 4 * MiB;
constexpr size_t WS_RSTD = WS_PAIR + 1 * MiB;
constexpr size_t WS_FL = WS_RSTD + 1 * MiB;
constexpr size_t WS_CB = WS_FL + 2 * MiB;
constexpr size_t WS_END = WS_CB + 2 * MiB;
constexpr int CW_CNT = 64;

__device__ __forceinline__ float bf2f(bf16_t v) { return __uint_as_float((unsigned)v << 16); }
__device__ __forceinline__ unsigned f2bf(float f) { unsigned u = __float_as_uint(f); return (u + 0x7fffu + ((u >> 16) & 1u)) >> 16; }
__device__ __forceinline__ unsigned pk2(float lo, float hi) { return f2bf(lo) | (f2bf(hi) << 16); }
__device__ __forceinline__ float wave_sum(float v) {
#pragma unroll
    for (int o = 1; o < 64; o <<= 1) v += __shfl_xor(v, o);
    return v;
}
__device__ __forceinline__ float wave_max(float v) {
#pragma unroll
    for (int o = 1; o < 64; o <<= 1) v = fmaxf(v, __shfl_xor(v, o));
    return v;
}
__device__ __forceinline__ int crow(int r, int hi) { return (r & 3) + 8 * (r >> 2) + 4 * hi; }
__device__ __forceinline__ float sigmoidf_(float x) { return 1.f / (1.f + __expf(-x)); }
__device__ __forceinline__ float log_sigmoid(float x) { return fminf(x, 0.f) - log1pf(__expf(-fabsf(x))); }

struct MoeTile { int e, rank0, cnt, tstart; bool ok; };
__device__ __forceinline__ MoeTile moe_tile(const unsigned* cnt, int T) {
    const int lane = threadIdx.x & 63;
    const int c = (lane < NE) ? (int)cnt[lane] : 0;
    const int nt = (c + 255) >> 8;
    int incl = nt;
#pragma unroll
    for (int o = 1; o < 32; o <<= 1) { int t = __shfl_up(incl, o); if ((lane & 31) >= o) incl += t; }
    const int excl = incl - nt;
    const unsigned long long m = __ballot(lane < NE && excl <= T && nt > 0 && T < incl);
    MoeTile r; r.ok = (m != 0ull);
    const int e = r.ok ? (int)__builtin_ctzll(m) : 0;
    r.e = e; r.tstart = __shfl(excl, e); r.cnt = __shfl(c, e); r.rank0 = (T - r.tstart) * 256;
    return r;
}
__device__ __forceinline__ int moe_tstart(const unsigned* cnt, int e) {
    const int lane = threadIdx.x & 63;
    const int c = (lane < NE) ? (int)cnt[lane] : 0;
    const int nt = (c + 255) >> 8;
    int incl = nt;
#pragma unroll
    for (int o = 1; o < 32; o <<= 1) { int t = __shfl_up(incl, o); if ((lane & 31) >= o) incl += t; }
    return __shfl(incl - nt, e);
}

__global__ void __launch_bounds__(256) k_rowstat(const float* __restrict__ h, bf16_t* __restrict__ hb, float* __restrict__ rstd) {
    const int lane = threadIdx.x & 63, row = blockIdx.x * 4 + (threadIdx.x >> 6);
    const f32x4* p = (const f32x4*)(h + (size_t)row * DM) + lane;
    f32x4 v[4]; float s = 0.f;
#pragma unroll
    for (int j = 0; j < 4; ++j) { v[j] = p[64 * j]; s += v[j].x * v[j].x + v[j].y * v[j].y + v[j].z * v[j].z + v[j].w * v[j].w; }
    s = wave_sum(s);
    if (lane == 0) rstd[row] = rsqrtf(s * (1.f / DM) + EPS);
    u32x2* o = (u32x2*)(hb + (size_t)row * DM) + lane;
#pragma unroll
    for (int j = 0; j < 4; ++j) { u32x2 w; w.x = pk2(v[j].x, v[j].y); w.y = pk2(v[j].z, v[j].w); o[64 * j] = w; }
}
__global__ void __launch_bounds__(256) k_cvt(const float* __restrict__ s, bf16_t* __restrict__ d, size_t n4) {
    size_t i = (size_t)blockIdx.x * 256 + threadIdx.x;
    if (i < n4) { f32x4 v = ((const f32x4*)s)[i]; u32x2 w; w.x = pk2(v.x, v.y); w.y = pk2(v.z, v.w); ((u32x2*)d)[i] = w; }
}
template <int MODE>
__global__ void __launch_bounds__(256) k_cvt_t(const float* __restrict__ src, const float* __restrict__ g, bf16_t* __restrict__ dst, int K, int N) {
    __shared__ float tile[64][65];
    const int n0 = blockIdx.x * 64, k0 = blockIdx.y * 64, b = blockIdx.z, tid = threadIdx.x;
    const float* s = src + (size_t)b * K * N; bf16_t* d = dst + (size_t)b * K * N;
#pragma unroll
    for (int i = 0; i < 16; ++i) { const int kk = i * 4 + (tid >> 6), nn = tid & 63; const float gg = g ? g[k0 + kk] : 1.f; tile[kk][nn] = s[(size_t)(k0 + kk) * N + n0 + nn] * gg; }
    __syncthreads();
#pragma unroll
    for (int j = 0; j < 2; ++j) {
        const int c = tid + 256 * j, n = c >> 3, kc = c & 7;
        u32x4 w; w.x = pk2(tile[kc * 8 + 0][n], tile[kc * 8 + 1][n]); w.y = pk2(tile[kc * 8 + 2][n], tile[kc * 8 + 3][n]);
        w.z = pk2(tile[kc * 8 + 4][n], tile[kc * 8 + 5][n]); w.w = pk2(tile[kc * 8 + 6][n], tile[kc * 8 + 7][n]);
        int nn = n0 + n;
        if (MODE == 1) { const int half = nn / FF, j2 = nn % FF; nn = (j2 >> 7) * 256 + half * 128 + (j2 & 127); }
        *(u32x4*)(d + (size_t)nn * K + k0 + kc * 8) = w;
    }
}

template <bool DUAL>
__device__ __forceinline__ void gemm_tile64(const bf16_t* a0, const bf16_t* a1, const bf16_t* B1, const bf16_t* B2, int K, f32x16 (&acc)[2][2], f32x16 (&acc2)[2][2]) {
    const int lane = threadIdx.x & 63, r32 = lane & 31, hi = lane >> 5;
    const bf16_t* b0 = B1 + (size_t)r32 * K + 8 * hi; const bf16_t* b1 = B1 + (size_t)(32 + r32) * K + 8 * hi;
    const bf16_t* c0 = DUAL ? B2 + (size_t)r32 * K + 8 * hi : nullptr; const bf16_t* c1 = DUAL ? B2 + (size_t)(32 + r32) * K + 8 * hi : nullptr;
    a0 += 8 * hi; a1 += 8 * hi;
#pragma unroll
    for (int i = 0; i < 2; ++i)
#pragma unroll
        for (int j = 0; j < 2; ++j) { acc[i][j] = f32x16{}; acc2[i][j] = f32x16{}; }
    for (int k = 0; k < K; k += 16) {
        const bf16x8 fa0 = *(const bf16x8*)(a0 + k), fa1 = *(const bf16x8*)(a1 + k), fb0 = *(const bf16x8*)(b0 + k), fb1 = *(const bf16x8*)(b1 + k);
        acc[0][0] = __builtin_amdgcn_mfma_f32_32x32x16_bf16(fa0, fb0, acc[0][0], 0, 0, 0);
        acc[0][1] = __builtin_amdgcn_mfma_f32_32x32x16_bf16(fa0, fb1, acc[0][1], 0, 0, 0);
        acc[1][0] = __builtin_amdgcn_mfma_f32_32x32x16_bf16(fa1, fb0, acc[1][0], 0, 0, 0);
        acc[1][1] = __builtin_amdgcn_mfma_f32_32x32x16_bf16(fa1, fb1, acc[1][1], 0, 0, 0);
        if (DUAL) {
            const bf16x8 fc0 = *(const bf16x8*)(c0 + k), fc1 = *(const bf16x8*)(c1 + k);
            acc2[0][0] = __builtin_amdgcn_mfma_f32_32x32x16_bf16(fa0, fc0, acc2[0][0], 0, 0, 0);
            acc2[0][1] = __builtin_amdgcn_mfma_f32_32x32x16_bf16(fa0, fc1, acc2[0][1], 0, 0, 0);
            acc2[1][0] = __builtin_amdgcn_mfma_f32_32x32x16_bf16(fa1, fc0, acc2[1][0], 0, 0, 0);
            acc2[1][1] = __builtin_amdgcn_mfma_f32_32x32x16_bf16(fa1, fc1, acc2[1][1], 0, 0, 0);
        }
    }
}
#define TILE_FOREACH(...) _Pragma("unroll") for (int mi = 0; mi < 2; ++mi) _Pragma("unroll") for (int ni = 0; ni < 2; ++ni) _Pragma("unroll") for (int r = 0; r < 16; ++r) { \
        const int lrow = 32 * mi + crow(r, hi), lcol = 32 * ni + r32; const float v = acc[mi][ni][r]; const float v2 = acc2[mi][ni][r]; (void)v2; __VA_ARGS__ }

__global__ void __launch_bounds__(64) k_gemm_qkv(const bf16_t* __restrict__ A, const bf16_t* __restrict__ Bt, const float* __restrict__ rstd, bf16_t* __restrict__ Q) {
    const int lane = threadIdx.x, r32 = lane & 31, hi = lane >> 5; const int m0 = blockIdx.y * 64, n0 = blockIdx.x * 64;
    f32x16 acc[2][2], acc2[2][2];
    gemm_tile64<false>(A + (size_t)(m0 + r32) * DM, A + (size_t)(m0 + 32 + r32) * DM, Bt + (size_t)n0 * DM, nullptr, DM, acc, acc2);
    const int t = n0 / DM; bf16_t* out = Q + (size_t)t * ((WS_K - WS_Q) / 2); const float sc = (t == 0) ? C2 : 1.f;
    TILE_FOREACH({ const int row = m0 + lrow, col = n0 - t * DM + lcol; out[(size_t)row * DM + col] = (bf16_t)f2bf(v * rstd[row] * sc); })
}
__global__ void __launch_bounds__(64) k_gemm_wo(const bf16_t* __restrict__ A, const bf16_t* __restrict__ Bt, const float* hin, float* hout, bf16_t* __restrict__ hb) {
    const int lane = threadIdx.x, r32 = lane & 31, hi = lane >> 5; const int m0 = blockIdx.y * 64, n0 = blockIdx.x * 64;
    f32x16 acc[2][2], acc2[2][2];
    gemm_tile64<false>(A + (size_t)(m0 + r32) * DM, A + (size_t)(m0 + 32 + r32) * DM, Bt + (size_t)n0 * DM, nullptr, DM, acc, acc2);
    TILE_FOREACH({ const size_t o = (size_t)(m0 + lrow) * DM + n0 + lcol; const float x = hin[o] + v; hout[o] = x; hb[o] = (bf16_t)f2bf(x); })
}
__global__ void __launch_bounds__(64) k_gemm_pj(const bf16_t* __restrict__ A, const bf16_t* __restrict__ Bt, bf16_t* __restrict__ PJ) {
    const int lane = threadIdx.x, r32 = lane & 31, hi = lane >> 5; const int m0 = blockIdx.y * 64, n0 = blockIdx.x * 64;
    f32x16 acc[2][2], acc2[2][2];
    gemm_tile64<false>(A + (size_t)(m0 + r32) * PLE, A + (size_t)(m0 + 32 + r32) * PLE, Bt + (size_t)n0 * PLE, nullptr, PLE, acc, acc2);
    TILE_FOREACH({ PJ[(size_t)(m0 + lrow) * DM + n0 + lcol] = (bf16_t)f2bf(v); })
}
__global__ void __launch_bounds__(64) k_gemm_ple(const bf16_t* __restrict__ A, const bf16_t* __restrict__ Bt, const float* __restrict__ rstd, const bf16_t* __restrict__ PJ, float* h, bf16_t* hb) {
    const int lane = threadIdx.x, r32 = lane & 31, hi = lane >> 5; const int m0 = blockIdx.y * 64, n0 = blockIdx.x * 64;
    f32x16 acc[2][2], acc2[2][2];
    gemm_tile64<false>(A + (size_t)(m0 + r32) * DM, A + (size_t)(m0 + 32 + r32) * DM, Bt + (size_t)n0 * DM, nullptr, DM, acc, acc2);
    TILE_FOREACH({ const int row = m0 + lrow; const size_t o = (size_t)row * DM + n0 + lcol; const float x = h[o] + sigmoidf_(v * rstd[row]) * bf2f(PJ[o]); h[o] = x; })
}
__global__ void __launch_bounds__(64) k_gemm_gu(const bf16_t* __restrict__ HB, const bf16_t* __restrict__ Wgu, const float* __restrict__ bgu, const float* __restrict__ rstd,
                                                const unsigned* __restrict__ cnt, const int* __restrict__ tok_of, bf16_t* __restrict__ ACT) {
    const int lane = threadIdx.x, r32 = lane & 31, hi = lane >> 5; const int rt = blockIdx.y, T = rt >> 2, j0 = blockIdx.x * 64;
    const MoeTile mt = moe_tile(cnt, T); if (!mt.ok) return;
    const int lr0 = (rt & 3) * 64; const int rk0 = mt.rank0 + lr0 + r32, rk1 = rk0 + 32;
    const int t0 = rk0 < mt.cnt ? tok_of[(size_t)mt.e * CAP + rk0] : 0, t1 = rk1 < mt.cnt ? tok_of[(size_t)mt.e * CAP + rk1] : 0;
    const bf16_t* Be = Wgu + (size_t)mt.e * 2048 * DM + (size_t)((j0 >> 7) * 256 + (j0 & 127)) * DM;
    f32x16 acc[2][2], acc2[2][2];
    gemm_tile64<true>(HB + (size_t)t0 * DM, HB + (size_t)t1 * DM, Be, Be + (size_t)128 * DM, DM, acc, acc2);
    const size_t slot0 = (size_t)T * 256 + lr0;
    TILE_FOREACH({ const int rk = mt.rank0 + lr0 + lrow; if (rk < mt.cnt) { const int tk = tok_of[(size_t)mt.e * CAP + rk]; const float rs = rstd[tk]; const int j = j0 + lcol;
        float gl = v * rs + bgu[(size_t)mt.e * 2048 + j], ln = v2 * rs + bgu[(size_t)mt.e * 2048 + FF + j];
        gl = fminf(gl, 7.f); ln = fminf(fmaxf(ln, -7.f), 7.f);
        const float a = gl * sigmoidf_(1.702f * gl) * (ln + 1.f);
        ACT[(slot0 + lrow) * FF + j] = (bf16_t)f2bf(a); } })
}
__global__ void __launch_bounds__(64) k_gemm_down(const bf16_t* __restrict__ ACT, const bf16_t* __restrict__ Wd, const float* __restrict__ bd, const unsigned* __restrict__ cnt,
                                                  const float* __restrict__ gate_of, bf16_t* __restrict__ Y) {
    const int lane = threadIdx.x, r32 = lane & 31, hi = lane >> 5; const int rt = blockIdx.y, T = rt >> 2, n0 = blockIdx.x * 64;
    const MoeTile mt = moe_tile(cnt, T); if (!mt.ok) return;
    const int lr0 = (rt & 3) * 64; const size_t slot0 = (size_t)T * 256 + lr0;
    const int rk0 = mt.rank0 + lr0 + r32, rk1 = rk0 + 32;
    const size_t s0 = rk0 < mt.cnt ? slot0 + r32 : (size_t)T * 256, s1 = rk1 < mt.cnt ? slot0 + 32 + r32 : (size_t)T * 256;
    f32x16 acc[2][2], acc2[2][2];
    gemm_tile64<false>(ACT + s0 * FF, ACT + s1 * FF, Wd + (size_t)mt.e * DM * FF + (size_t)n0 * FF, nullptr, FF, acc, acc2);
    TILE_FOREACH({ const int rk = mt.rank0 + lr0 + lrow; if (rk < mt.cnt) { const float gt = gate_of[(size_t)mt.e * CAP + rk]; const int n = n0 + lcol;
        Y[(slot0 + lrow) * DM + n] = (bf16_t)f2bf((v + bd[(size_t)mt.e * DM + n]) * gt); } })
}

__global__ void __launch_bounds__(256) k_router(const float* __restrict__ h, const float* __restrict__ g, const float* __restrict__ wr, const float* __restrict__ br,
                                                float* __restrict__ rstd, unsigned* cnt, int* __restrict__ tok_of, float* __restrict__ gate_of, unsigned* __restrict__ pair) {
    const int lane = threadIdx.x & 63, t = blockIdx.x * 4 + (threadIdx.x >> 6); const int e = lane & 31, half = lane >> 5;
    const float* hr = h + (size_t)t * DM;
    float ss = 0.f;
#pragma unroll
    for (int j = 0; j < 4; ++j) { const f32x4 v = ((const f32x4*)hr)[lane + 64 * j]; ss += v.x * v.x + v.y * v.y + v.z * v.z + v.w * v.w; }
    const float rs = rsqrtf(wave_sum(ss) * (1.f / DM) + EPS);
    float a = 0.f;
    for (int d = half * 512; d < half * 512 + 512; ++d) a += hr[d] * g[d] * wr[(size_t)d * NE + e];
    a += __shfl_xor(a, 32);
    float lg = a * rs + br[e];
    float tv[4]; int ti[4];
#pragma unroll
    for (int k = 0; k < 4; ++k) {
        float bv = lg; int bi = e;
#pragma unroll
        for (int o = 1; o < 32; o <<= 1) { const float ov = __shfl_xor(bv, o); const int oi = __shfl_xor(bi, o); if (ov > bv || (ov == bv && oi < bi)) { bv = ov; bi = oi; } }
        tv[k] = bv; ti[k] = bi; if (e == bi) lg = -INFINITY;
    }
    float w[4], sw = 0.f;
#pragma unroll
    for (int k = 0; k < 4; ++k) { w[k] = __expf(tv[k] - tv[0]); sw += w[k]; }
    if (lane == 0) rstd[t] = rs;
    if (lane < 4) {
        const int k = lane; const int ee = (k == 0) ? ti[0] : (k == 1) ? ti[1] : (k == 2) ? ti[2] : ti[3]; const float ww = (k == 0) ? w[0] : (k == 1) ? w[1] : (k == 2) ? w[2] : w[3];
        const unsigned rk = atomicAdd(&cnt[ee], 1u);
        tok_of[(size_t)ee * CAP + rk] = t; gate_of[(size_t)ee * CAP + rk] = ww / sw; pair[(size_t)t * 4 + k] = ((unsigned)ee << 16) | rk;
    }
}
__global__ void __launch_bounds__(256) k_combine(float* h, bf16_t* __restrict__ hb, float* __restrict__ rstd, const unsigned* __restrict__ cnt, const unsigned* __restrict__ pair, const bf16_t* __restrict__ Y) {
    const int lane = threadIdx.x & 63, t = blockIdx.x * 4 + (threadIdx.x >> 6);
    f32x4 v[4]; f32x4* hr = (f32x4*)(h + (size_t)t * DM) + lane;
#pragma unroll
    for (int j = 0; j < 4; ++j) v[j] = hr[64 * j];
    for (int k = 0; k < 4; ++k) {
        const unsigned pr = pair[(size_t)t * 4 + k]; const int e = pr >> 16, rk = pr & 0xffff;
        const size_t slot = (size_t)moe_tstart(cnt, e) * 256 + rk;
        const u32x2* yr = (const u32x2*)(Y + slot * DM) + lane;
#pragma unroll
        for (int j = 0; j < 4; ++j) { const u32x2 w = yr[64 * j]; v[j].x += __uint_as_float(w.x << 16); v[j].y += __uint_as_float(w.x & 0xffff0000u); v[j].z += __uint_as_float(w.y << 16); v[j].w += __uint_as_float(w.y & 0xffff0000u); }
    }
    float s = 0.f;
#pragma unroll
    for (int j = 0; j < 4; ++j) { hr[64 * j] = v[j]; s += v[j].x * v[j].x + v[j].y * v[j].y + v[j].z * v[j].z + v[j].w * v[j].w; }
    s = wave_sum(s); if (lane == 0) rstd[t] = rsqrtf(s * (1.f / DM) + EPS);
    u32x2* o = (u32x2*)(hb + (size_t)t * DM) + lane;
#pragma unroll
    for (int j = 0; j < 4; ++j) { u32x2 w; w.x = pk2(v[j].x, v[j].y); w.y = pk2(v[j].z, v[j].w); o[64 * j] = w; }
}
__global__ void __launch_bounds__(256) k_final(const float* __restrict__ h, const float* __restrict__ g, float* __restrict__ out) {
    const int lane = threadIdx.x & 63, row = blockIdx.x * 4 + (threadIdx.x >> 6);
    const f32x4* p = (const f32x4*)(h + (size_t)row * DM) + lane; f32x4 v[4]; float s = 0.f;
#pragma unroll
    for (int j = 0; j < 4; ++j) { v[j] = p[64 * j]; s += v[j].x * v[j].x + v[j].y * v[j].y + v[j].z * v[j].z + v[j].w * v[j].w; }
    const float rs = rsqrtf(wave_sum(s) * (1.f / DM) + EPS);
    f32x4* o = (f32x4*)(out + (size_t)row * DM) + lane;
#pragma unroll
    for (int j = 0; j < 4; ++j) { const f32x4 gg = ((const f32x4*)g)[lane + 64 * j]; o[64 * j] = v[j] * rs * gg; }
}
__global__ void __launch_bounds__(256) k_fgate(const float* __restrict__ h, const float* __restrict__ g, const float* __restrict__ wf, const float* __restrict__ bfg, const float* __restrict__ rstd, float* __restrict__ fl) {
    const int lane = threadIdx.x & 63, t = blockIdx.x * 4 + (threadIdx.x >> 6); const int hh = lane & 15, q = lane >> 4;
    const float* hr = h + (size_t)t * DM; float a = 0.f;
    for (int d = q * 256; d < q * 256 + 256; ++d) a += hr[d] * g[d] * wf[(size_t)d * NH + hh];
    a += __shfl_xor(a, 16); a += __shfl_xor(a, 32);
    if (lane < 16) fl[(size_t)t * NH + hh] = a * rstd[t] + bfg[hh];
}
__global__ void __launch_bounds__(64) k_scan(const float* __restrict__ fl, float* __restrict__ cb) {
    const int lane = threadIdx.x, bh = blockIdx.x, b = bh / NH, hh = bh % NH;
    float loc[32]; float run = 0.f;
#pragma unroll
    for (int i = 0; i < 32; ++i) { run += log_sigmoid(fl[(size_t)(b * SEQ + lane * 32 + i) * NH + hh]); loc[i] = run; }
    float incl = run;
#pragma unroll
    for (int o = 1; o < 64; o <<= 1) { const float t = __shfl_up(incl, o); if (lane >= o) incl += t; }
    const float base = incl - run;
#pragma unroll
    for (int i = 0; i < 32; ++i) cb[(size_t)bh * SEQ + lane * 32 + i] = (base + loc[i]) * LOG2E;
}

__device__ __forceinline__ float dot64(const float (&q)[64], const bf16_t* kr) {
    float a = 0.f;
#pragma unroll
    for (int c = 0; c < 8; ++c) { const u32x4 w = ((const u32x4*)kr)[c];
        a += q[8 * c + 0] * __uint_as_float(w.x << 16) + q[8 * c + 1] * __uint_as_float(w.x & 0xffff0000u) + q[8 * c + 2] * __uint_as_float(w.y << 16) + q[8 * c + 3] * __uint_as_float(w.y & 0xffff0000u)
           + q[8 * c + 4] * __uint_as_float(w.z << 16) + q[8 * c + 5] * __uint_as_float(w.z & 0xffff0000u) + q[8 * c + 6] * __uint_as_float(w.w << 16) + q[8 * c + 7] * __uint_as_float(w.w & 0xffff0000u); }
    return a;
}
__device__ __forceinline__ void loadq(float (&q)[64], const bf16_t* qr) {
#pragma unroll
    for (int c = 0; c < 8; ++c) { const u32x4 w = ((const u32x4*)qr)[c];
        q[8 * c + 0] = __uint_as_float(w.x << 16); q[8 * c + 1] = __uint_as_float(w.x & 0xffff0000u); q[8 * c + 2] = __uint_as_float(w.y << 16); q[8 * c + 3] = __uint_as_float(w.y & 0xffff0000u);
        q[8 * c + 4] = __uint_as_float(w.z << 16); q[8 * c + 5] = __uint_as_float(w.z & 0xffff0000u); q[8 * c + 6] = __uint_as_float(w.w << 16); q[8 * c + 7] = __uint_as_float(w.w & 0xffff0000u); }
}
__global__ void __launch_bounds__(256) k_attn_sb(const bf16_t* __restrict__ Q, const bf16_t* __restrict__ K, const bf16_t* __restrict__ V, bf16_t* __restrict__ O) {
    const int lane = threadIdx.x & 63; const int gw = blockIdx.x * 4 + (threadIdx.x >> 6); const int t = gw % SEQ, bh = gw / SEQ, b = bh / NH, hh = bh % NH;
    const size_t rowb = (size_t)b * SEQ; float q[64]; loadq(q, Q + (rowb + t) * DM + hh * HD);
    float o = 0.f, carry = 1.f;
    for (int jt = (t - 1) >> 6; jt >= 0 && t > 0; --jt) {
        const int s = 64 * jt + lane; const bool valid = s < t;
        float x = dot64(q, K + (rowb + s) * DM + hh * HD); x = fminf(x, 64.f);
        const float ex = exp2f(x), r = 1.f / (1.f + ex);
        const float beta = valid ? ex * r : 0.f, nb = valid ? r : 1.f;
        float P = nb;
#pragma unroll
        for (int off = 1; off < 64; off <<= 1) { const float t2 = __shfl_down(P, off); if (lane + off < 64) P *= t2; }
        float Pex = __shfl_down(P, 1); if (lane == 63) Pex = 1.f;
        const float a = beta * carry * Pex;
        carry *= __shfl(P, 0);
        const bf16_t* vb = V + (rowb + 64 * jt) * DM + hh * HD + lane;
        for (int l = 0; l < 64; ++l) { const float al = __shfl(a, l); o += al * bf2f(vb[(size_t)l * DM]); }
        if (carry < 1e-30f) break;
    }
    O[(rowb + t) * DM + hh * HD + lane] = (bf16_t)f2bf(o);
}
__global__ void __launch_bounds__(256) k_attn_fox(const bf16_t* __restrict__ Q, const bf16_t* __restrict__ K, const bf16_t* __restrict__ V, const float* __restrict__ cb, bf16_t* __restrict__ O) {
    const int lane = threadIdx.x & 63; const int gw = blockIdx.x * 4 + (threadIdx.x >> 6); const int t = gw % SEQ, bh = gw / SEQ, b = bh / NH, hh = bh % NH;
    const size_t rowb = (size_t)b * SEQ; float q[64]; loadq(q, Q + (rowb + t) * DM + hh * HD);
    float o = 0.f, m = -INFINITY, l = 0.f;
    for (int jt = 0; jt <= (t >> 6); ++jt) {
        const int s = 64 * jt + lane; const bool valid = s <= t;
        float x = dot64(q, K + (rowb + s) * DM + hh * HD) - cb[(size_t)bh * SEQ + s];
        x = valid ? x : -INFINITY;
        const float mn = fmaxf(m, wave_max(x)); const float alpha = exp2f(m - mn); const float p = exp2f(x - mn);
        l = l * alpha + wave_sum(p); o *= alpha; m = mn;
        const bf16_t* vb = V + (rowb + 64 * jt) * DM + hh * HD + lane;
        const int nl = min(64, t - 64 * jt + 1);
        for (int i = 0; i < nl; ++i) { const float pi = __shfl(p, i); o += pi * bf2f(vb[(size_t)i * DM]); }
    }
    O[(rowb + t) * DM + hh * HD + lane] = (bf16_t)f2bf(o / l);
}


#include <hip/hip_bf16.h>
#include <cmath>
namespace attn_body {
using bf16=__hip_bfloat16;
using bf16x8=__attribute__((ext_vector_type(8)))short;
using s16x4=__attribute__((ext_vector_type(4)))short;
using f32x16=__attribute__((ext_vector_type(16)))float;
using u32x4=__attribute__((ext_vector_type(4)))unsigned;
constexpr int BATCH=16,NHEAD=16,SEQ=2048,D=64,DM=NHEAD*D;
constexpr int NW=8,QBLK=32,QB=QBLK*NW,KVBLK=64,NQB=SEQ/QB;
constexpr int ATTN_PITCH=DM, ATTN_UNIT_ROWS=QB;
__device__ __forceinline__ int crow(int r,int hi){return (r&3)+8*(r>>2)+4*hi;}
#define SBAR() __builtin_amdgcn_sched_barrier(0)
__device__ __forceinline__ void cmask(f32x16&p0,f32x16&p1,int jb,int qrel,int hi){
  const float NEG=-INFINITY; int kb=64*jb+4*hi;
  #pragma unroll
  for(int r=0;r<16;++r){int kv=kb+(r&3)+8*(r>>2); if(kv>qrel)p0[r]=NEG; if(kv+32>qrel)p1[r]=NEG;}
}

constexpr int NSLOT=3, SLOTB=8192;
constexpr int LDS_K=0, LDS_V=NSLOT*SLOTB, LDS_WS=2*NSLOT*SLOTB, LDS_OST=LDS_WS+NW*64*4, LDS_BYTES=LDS_OST+NW*4096;
constexpr float C2=0.125f*1.4426950408889634f;
__device__ __forceinline__ void glds16(const void*gsrc,unsigned lds_dst){unsigned keep;
  asm volatile("s_mov_b32 %0, m0\n\ts_mov_b32 m0, %2\n\ts_nop 0\n\tglobal_load_lds_dwordx4 %1, off\n\ts_mov_b32 m0, %0":"=&s"(keep):"v"(gsrc),"s"(lds_dst):"memory");}
__device__ __forceinline__ float max3f(float a,float b,float c){float r;asm("v_max3_f32 %0, %1, %2, %3":"=v"(r):"v"(a),"v"(b),"v"(c));return r;}
__device__ __forceinline__ float max2f(float a,float b){float r;asm("v_max_f32_e32 %0, %1, %2":"=v"(r):"v"(a),"v"(b));return r;}
__device__ __forceinline__ float fadd_s(float a,float b){float r;asm("v_add_f32_e32 %0, %1, %2":"=v"(r):"v"(a),"v"(b));return r;}
__device__ __forceinline__ float fsub_s(float a,float b){float r;asm("v_sub_f32_e32 %0, %1, %2":"=v"(r):"v"(a),"v"(b));return r;}
typedef float f32x2_t __attribute__((ext_vector_type(2))); typedef __bf16 bf16x2_t __attribute__((ext_vector_type(2)));
__device__ __forceinline__ unsigned cvtpk_s(float lo,float hi){f32x2_t v={lo,hi};bf16x2_t b=__builtin_convertvector(v,bf16x2_t);return __builtin_bit_cast(unsigned,b);}
#define WAIT_BAR(N) asm volatile("s_waitcnt vmcnt(" #N ") lgkmcnt(0)\n\ts_barrier":::"memory")

__device__ __forceinline__ void qkt(f32x16&p0,f32x16&p1,const char*Kslot,const bf16x8*qr,const f32x16&negm,int r32,int hi){
  const char*kb=Kslot+hi*1024+r32*16;
  #pragma unroll
  for(int d0=0;d0<4;++d0){
    const bf16x8 b0=*reinterpret_cast<const bf16x8*>(kb+d0*2048);
    const bf16x8 b1=*reinterpret_cast<const bf16x8*>(kb+d0*2048+512);
    if(d0==0){p0=__builtin_amdgcn_mfma_f32_32x32x16_bf16(b0,qr[0],negm,0,0,0);p1=__builtin_amdgcn_mfma_f32_32x32x16_bf16(b1,qr[0],negm,0,0,0);}
    else{p0=__builtin_amdgcn_mfma_f32_32x32x16_bf16(b0,qr[d0],p0,0,0,0);p1=__builtin_amdgcn_mfma_f32_32x32x16_bf16(b1,qr[d0],p1,0,0,0);}}
}
typedef __attribute__((address_space(3))) const char* lds_cptr;
typedef short v4i16_t __attribute__((ext_vector_type(4)));
__device__ __forceinline__ void kload8(bf16x8*kf,lds_cptr kp){
  kf[0]=*(const __attribute__((address_space(3))) bf16x8*)(kp);      kf[1]=*(const __attribute__((address_space(3))) bf16x8*)(kp+512);
  kf[2]=*(const __attribute__((address_space(3))) bf16x8*)(kp+2048); kf[3]=*(const __attribute__((address_space(3))) bf16x8*)(kp+2560);
  kf[4]=*(const __attribute__((address_space(3))) bf16x8*)(kp+4096); kf[5]=*(const __attribute__((address_space(3))) bf16x8*)(kp+4608);
  kf[6]=*(const __attribute__((address_space(3))) bf16x8*)(kp+6144); kf[7]=*(const __attribute__((address_space(3))) bf16x8*)(kp+6656);
}
__device__ __forceinline__ void kload2(bf16x8*kf,lds_cptr kp,int j){ kf[2*j]=*(const __attribute__((address_space(3))) bf16x8*)(kp+j*2048); kf[2*j+1]=*(const __attribute__((address_space(3))) bf16x8*)(kp+j*2048+512); }
__device__ __forceinline__ s16x4 vtr(lds_cptr p){ return __builtin_bit_cast(s16x4,__builtin_amdgcn_ds_read_tr16_b64_v4i16((__attribute__((address_space(3))) v4i16_t*)p)); }
__device__ __forceinline__ float rowmax(const f32x16&p0,const f32x16&p1){
  float a=max3f(p0[0],p0[1],p1[0]),b=max3f(p0[2],p0[3],p1[1]);a=max3f(a,p1[2],p1[3]);
  #pragma unroll
  for(int r=4;r<16;r+=4){a=max3f(a,p0[r],p0[r+1]);b=max3f(b,p0[r+2],p0[r+3]);a=max3f(a,p1[r],p1[r+1]);b=max3f(b,p1[r+2],p1[r+3]);}
  const float m=max2f(a,b);
  auto rr=__builtin_amdgcn_permlane32_swap(__float_as_uint(m),__float_as_uint(m),false,false);
  return max2f(__uint_as_float(rr[0]),__uint_as_float(rr[1]));
}
__device__ __forceinline__ void pv(f32x16*o,int vb,bf16x8 pa0,bf16x8 pa1,bf16x8 pa2,bf16x8 pa3){
  #pragma unroll
  for(int d0=0;d0<2;++d0){s16x4 lo[4],hi[4];
    #pragma unroll
    for(int ks=0;ks<4;++ks){
      asm volatile("ds_read_b64_tr_b16 %0,%1 offset:%c2":"=&v"(lo[ks]):"v"(vb),"i"(d0*4096+ks*1024):"memory");
      asm volatile("ds_read_b64_tr_b16 %0,%1 offset:%c2":"=&v"(hi[ks]):"v"(vb),"i"(d0*4096+ks*1024+512):"memory");}
    asm volatile("s_waitcnt lgkmcnt(0)":::"memory");SBAR();
    #define PK(k) (bf16x8){lo[k][0],lo[k][1],lo[k][2],lo[k][3],hi[k][0],hi[k][1],hi[k][2],hi[k][3]}
    o[d0]=__builtin_amdgcn_mfma_f32_32x32x16_bf16(pa0,PK(0),o[d0],0,0,0);
    o[d0]=__builtin_amdgcn_mfma_f32_32x32x16_bf16(pa1,PK(1),o[d0],0,0,0);
    o[d0]=__builtin_amdgcn_mfma_f32_32x32x16_bf16(pa2,PK(2),o[d0],0,0,0);
    o[d0]=__builtin_amdgcn_mfma_f32_32x32x16_bf16(pa3,PK(3),o[d0],0,0,0);
    #undef PK
  }
}

#ifndef ATTN_STORE16
#define ATTN_STORE16(p,v) (*(u32x4*)(p)=(v))
#endif
typedef float f32x4b __attribute__((ext_vector_type(4)));
template<int THRL> __device__ __forceinline__ void attn_unit(int b,int h,int qb,const bf16*Q,const bf16*__restrict__ K,const bf16*__restrict__ V,bf16*O,char*shm,const __attribute__((address_space(3))) float*cb){
  int tid_=threadIdx.x; asm volatile("":"+v"(tid_));
  const int tid=tid_,lane=tid&63,r32=lane&31,hi=lane>>5; const int wid=__builtin_amdgcn_readfirstlane(tid>>6);
  const long rowbase=(long)b*SEQ; const int q0=qb*QB;
  const bf16*Qw=Q+(rowbase+q0+wid*QBLK)*DM+h*D;
  const bf16*Kh=K+rowbase*DM+h*D,*Vh=V+rowbase*DM+h*D;
  const unsigned lds0=(unsigned)(uintptr_t)shm;
  float*wsf=(float*)(shm+LDS_WS)+wid*64;
  const bf16*ksrc=Kh+(long)lane*DM+wid*8;
  const bf16*vsrc=Vh+(long)(16*(wid&3)+(lane>>2))*DM+(wid>>2)*32+(lane&3)*8;
  const unsigned kdst=lds0+LDS_K+wid*1024, vdst=lds0+LDS_V+wid*1024;
  #define TIDX(u) (NT-1-(u))
  #define DMA_K(t,slot) glds16(ksrc+(long)TIDX(t)*KVBLK*DM,(unsigned)__builtin_amdgcn_readfirstlane(kdst+(slot)))
  #define DMA_V(t,slot) glds16(vsrc+(long)TIDX(t)*KVBLK*DM,(unsigned)__builtin_amdgcn_readfirstlane(vdst+(slot)))
  const int vb0=(int)(lds0+LDS_V)+((lane>>4)&1)*32+(lane&3)*8+(4*hi+((lane&15)>>2))*64;
  const char*Kbase=shm+LDS_K; bf16x8 kf[8];
  const lds_cptr shm3=(lds_cptr)shm; const lds_cptr kp0=shm3+LDS_K+hi*1024+r32*16; const lds_cptr vp0=shm3+LDS_V+((lane>>4)&1)*32+(lane&3)*8+(4*hi+((lane&15)>>2))*64;
  const int NT=(q0+QB)/KVBLK;
  DMA_K(0,0);DMA_V(0,0);DMA_K(1,SLOTB);
  bf16x8 qr[4];
  #pragma unroll
  for(int d0=0;d0<4;++d0)qr[d0]=*reinterpret_cast<const bf16x8*>(&Qw[(long)r32*DM+d0*16+hi*8]);
  float mhat=0.f,l_reg=0.f;f32x16 o[2];o[0]=f32x16{};o[1]=f32x16{};const f32x16 negm=f32x16{};
  const int qrel=wid*QBLK+r32;
  #define CMASK(P0,P1,t) do{int jb_=3-(t); if(jb_>=0)cmask(P0,P1,jb_,qrel,hi);}while(0)
  #define ABIAS(P0,P1,t) do{ const __attribute__((address_space(3))) f32x4b*cbp_=(const __attribute__((address_space(3))) f32x4b*)(cb+64*TIDX(t)+4*hi); \
    _Pragma("unroll") for(int g_=0;g_<4;++g_){ const f32x4b b0_=cbp_[2*g_], b1_=cbp_[8+2*g_]; \
      P0[4*g_+0]+=b0_[0];P0[4*g_+1]+=b0_[1];P0[4*g_+2]+=b0_[2];P0[4*g_+3]+=b0_[3]; P1[4*g_+0]+=b1_[0];P1[4*g_+1]+=b1_[1];P1[4*g_+2]+=b1_[2];P1[4*g_+3]+=b1_[3]; } }while(0)
  #define BLD(G,t,h) f32x4b nb##h##_[4]; { const __attribute__((address_space(3))) f32x4b*cbp_=(const __attribute__((address_space(3))) f32x4b*)(cb+64*TIDX(t)+4*hi+32*(h)); \
      _Pragma("unroll") for(int g_=0;g_<4;++g_) nb##h##_[g_]=cbp_[2*g_]; }
  #define BSUB(G,P,h) if(G){ const float mh_=mhat; _Pragma("unroll") for(int g_=0;g_<4;++g_){ \
      P[4*g_+0]=nb##h##_[g_][0]-mh_;P[4*g_+1]=nb##h##_[g_][1]-mh_;P[4*g_+2]=nb##h##_[g_][2]-mh_;P[4*g_+3]=nb##h##_[g_][3]-mh_; } }
  bool resc=false;
  #define START(P0,P1) do{ const float rm=rowmax(P0,P1); resc=false; \
    { const float dl=(rm>-INFINITY)?rm:0.f; mhat=fadd_s(mhat,dl);     \
      _Pragma("unroll") for(int r=0;r<16;++r){P0[r]=fsub_s(P0[r],dl);P1[r]=fsub_s(P1[r],dl);} \
      } \
    _Pragma("unroll") for(int r=0;r<16;++r)P0[r]=__builtin_amdgcn_exp2f(P0[r]); }while(0)
  #define RESC() do{ if(resc){ asm volatile("s_waitcnt lgkmcnt(0)":::"memory"); \
      _Pragma("unroll") for(int d_=0;d_<2;++d_) _Pragma("unroll") for(int r=0;r<16;++r)o[d_][r]*=wsf[crow(r,hi)]; } }while(0)
  f32x16 pA0,pA1,pB0,pB1;
  int sl_prev=0,sl_cur=0,sl_next=SLOTB;
  #define ROT() do{sl_prev=sl_cur;sl_cur=sl_next;sl_next=(sl_next==(NSLOT-1)*SLOTB)?0:sl_next+SLOTB;}while(0)
  DMA_K(2,2*SLOTB);
  WAIT_BAR(3);
  qkt(pA0,pA1,Kbase,qr,negm,r32,hi);asm volatile("s_nop 15\n\ts_nop 7":"+v"(pA0),"+v"(pA1));ABIAS(pA0,pA1,0);CMASK(pA0,pA1,0);
  START(pA0,pA1);
  _Pragma("unroll") for(int r=0;r<16;++r)pA1[r]=__builtin_amdgcn_exp2f(pA1[r]);
  { BLD(true,1,0) BLD(true,1,1) BSUB(true,pB0,0) BSUB(true,pB1,1) }
  WAIT_BAR(0);
  DMA_K(3,0);DMA_V(1,SLOTB);
  ROT();
  kload8(kf,kp0+sl_cur);
  WAIT_BAR(2);
  s16x4 vlo[8],vhi[8]; u32x4 pw0,pw1,pw2,pw3;
  #define PKW(P,B) cvtpk_s(P[B],P[B+1])
  #define PAF(k) __builtin_bit_cast(bf16x8,pw##k)
  #define VFR(i) (bf16x8){vlo[i][0],vlo[i][1],vlo[i][2],vlo[i][3],vhi[i][0],vhi[i][1],vhi[i][2],vhi[i][3]}
  #define PIN(x) asm volatile("":"+v"(x))
  #define MX3(a,b,c) __builtin_fmaxf(__builtin_fmaxf((a),(b)),(c))
  #define GAPA(MF,A0,A1,A2,A3,W0,W1,PW) do{ MF; sacc+=A0; sacc+=A1; sacc+=A2; sacc+=A3; PIN(sacc); W0; W1; PIN(PW); SBAR(); }while(0)
  #define EX(v) __builtin_amdgcn_exp2f(v)
  #define GAPB(MF,X,B) do{ MF; X[B]=EX(X[B]); X[B+1]=EX(X[B+1]); X[B+2]=EX(X[B+2]); X[B+3]=EX(X[B+3]); PIN(X); SBAR(); }while(0)
  #define VRD(i) do{ vlo[i]=vtr(vp_+(((i)>>2)*4096+((i)&3)*1024)); vhi[i]=vtr(vp_+(((i)>>2)*4096+((i)&3)*1024+512)); }while(0)
  #define KRD(G,j) do{ if(G){ kload2(kf,kp0+sl_next,j); SBAR(); } }while(0)
  #define STEP(C0,C1,P0,P1,t,GK,GV,GL,GB) do{ SBAR(); \
    const lds_cptr vp_=vp0+sl_prev; \
    VRD(0); SBAR(); float sacc=(P0[0]+P0[1]); \
    GAPA(C0=__builtin_amdgcn_mfma_f32_32x32x16_bf16(kf[0],qr[0],C0,0,0,0), P0[2],P0[3],P0[4],P0[5],     pw0[0]=PKW(P0,0), pw0[1]=PKW(P0,2), pw0); \
    VRD(4); SBAR(); GAPA(C1=__builtin_amdgcn_mfma_f32_32x32x16_bf16(kf[1],qr[0],C1,0,0,0), P0[6],P0[7],P0[8],P0[9],     pw0[2]=PKW(P0,4), pw0[3]=PKW(P0,6), pw0); \
    VRD(1); SBAR(); GAPA(C0=__builtin_amdgcn_mfma_f32_32x32x16_bf16(kf[2],qr[1],C0,0,0,0),   P0[10],P0[11],P0[12],P0[13], pw1[0]=PKW(P0,8), pw1[1]=PKW(P0,10), pw1); \
    VRD(5); SBAR(); GAPA(C1=__builtin_amdgcn_mfma_f32_32x32x16_bf16(kf[3],qr[1],C1,0,0,0),   P0[14],P0[15],P1[0],P1[1],   pw1[2]=PKW(P0,12),pw1[3]=PKW(P0,14), pw1); \
    VRD(2); SBAR(); GAPA(C0=__builtin_amdgcn_mfma_f32_32x32x16_bf16(kf[4],qr[2],C0,0,0,0),   P1[2],P1[3],P1[4],P1[5],     pw2[0]=PKW(P1,0), pw2[1]=PKW(P1,2), pw2); \
    VRD(6); SBAR(); GAPA(C1=__builtin_amdgcn_mfma_f32_32x32x16_bf16(kf[5],qr[2],C1,0,0,0),   P1[6],P1[7],P1[8],P1[9],     pw2[2]=PKW(P1,4), pw2[3]=PKW(P1,6), pw2); \
    VRD(3); SBAR(); GAPA(C0=__builtin_amdgcn_mfma_f32_32x32x16_bf16(kf[6],qr[3],C0,0,0,0),   P1[10],P1[11],P1[12],P1[13], pw3[0]=PKW(P1,8), pw3[1]=PKW(P1,10), pw3); \
    VRD(7); SBAR(); GAPA(C1=__builtin_amdgcn_mfma_f32_32x32x16_bf16(kf[7],qr[3],C1,0,0,0),   P1[14],P1[15],0.f,0.f,       pw3[2]=PKW(P1,12),pw3[3]=PKW(P1,14), pw3); \
    l_reg+=sacc; \
    if(GK){DMA_K((t)+3,sl_cur);} if(GV){DMA_V((t)+1,sl_next);} \
    CMASK(C0,C1,t); \
    { float a=MX3(C0[0],C0[1],C1[0]),b=MX3(C0[2],C0[3],C1[1]); a=MX3(a,C1[2],C1[3]); \
      _Pragma("unroll") for(int r=4;r<16;r+=4){a=MX3(a,C0[r],C0[r+1]);b=MX3(b,C0[r+2],C0[r+3]);a=MX3(a,C1[r],C1[r+1]);b=MX3(b,C1[r+2],C1[r+3]);} \
      float rm=__builtin_fmaxf(a,b); { auto rr=__builtin_amdgcn_permlane32_swap(__float_as_uint(rm),__float_as_uint(rm),false,false); rm=__builtin_fmaxf(__uint_as_float(rr[0]),__uint_as_float(rr[1])); } \
      resc=false; \
      if(__builtin_expect(__any(rm>(float)THRL),0)){ const float dl=__builtin_fmaxf(rm,0.f); mhat+=dl; \
        _Pragma("unroll") for(int r=0;r<16;++r){C0[r]-=dl;C1[r]-=dl;} \
        const float f=__builtin_amdgcn_exp2f(-dl); l_reg*=f; if(hi==0)wsf[r32]=f; resc=true; } } \
    SBAR(); \
    BLD(GB,(t)+1,0) SBAR(); \
    GAPB(o[0]=__builtin_amdgcn_mfma_f32_32x32x16_bf16(PAF(0),VFR(0),o[0],0,0,0), C0,0); \
    GAPB(o[1]=__builtin_amdgcn_mfma_f32_32x32x16_bf16(PAF(0),VFR(4),o[1],0,0,0), C0,4); \
    KRD(GL,0); GAPB(o[0]=__builtin_amdgcn_mfma_f32_32x32x16_bf16(PAF(1),VFR(1),o[0],0,0,0), C0,8); \
    KRD(GL,1); GAPB(o[1]=__builtin_amdgcn_mfma_f32_32x32x16_bf16(PAF(1),VFR(5),o[1],0,0,0), C0,12); \
    BSUB(GB,P0,0) BLD(GB,(t)+1,1) SBAR(); \
    KRD(GL,2); GAPB(o[0]=__builtin_amdgcn_mfma_f32_32x32x16_bf16(PAF(2),VFR(2),o[0],0,0,0), C1,0); \
    KRD(GL,3); GAPB(o[1]=__builtin_amdgcn_mfma_f32_32x32x16_bf16(PAF(2),VFR(6),o[1],0,0,0), C1,4); \
    GAPB(o[0]=__builtin_amdgcn_mfma_f32_32x32x16_bf16(PAF(3),VFR(3),o[0],0,0,0), C1,8); \
    GAPB(o[1]=__builtin_amdgcn_mfma_f32_32x32x16_bf16(PAF(3),VFR(7),o[1],0,0,0), C1,12); \
    BSUB(GB,P1,1) \
    }while(0)
  int t=1;
  #define ENDW(tt) do{ if((tt)+3<NT){WAIT_BAR(2);} else if((tt)+2<NT){WAIT_BAR(1);} else {WAIT_BAR(0);} }while(0)
  for(;t+1<NT&&t<5;t+=2){
    STEP(pB0,pB1,pA0,pA1,t,(t+3<NT),(t+1<NT),(t+1<NT),(t+1<NT));       ENDW(t);   RESC(); ROT();
    STEP(pA0,pA1,pB0,pB1,t+1,(t+4<NT),(t+2<NT),(t+2<NT),(t+2<NT));     ENDW(t+1); RESC(); ROT();
  }
  #undef CMASK
  #define CMASK(P0,P1,t) do{}while(0)
  for(;t+5<NT;t+=2){
    STEP(pB0,pB1,pA0,pA1,t,true,true,true,true);     WAIT_BAR(2); RESC(); ROT();
    STEP(pA0,pA1,pB0,pB1,t+1,true,true,true,true);   WAIT_BAR(2); RESC(); ROT();
  }
  for(;t+1<NT;t+=2){
    STEP(pB0,pB1,pA0,pA1,t,(t+3<NT),(t+1<NT),(t+1<NT),(t+1<NT));       ENDW(t);   RESC(); ROT();
    STEP(pA0,pA1,pB0,pB1,t+1,(t+4<NT),(t+2<NT),(t+2<NT),(t+2<NT));     ENDW(t+1); RESC(); ROT();
  }
  #undef CMASK
  #define CMASK(P0,P1,t) do{int jb_=3-(t); if(jb_>=0)cmask(P0,P1,jb_,qrel,hi);}while(0)
  STEP(pB0,pB1,pA0,pA1,NT-1,false,false,false,false); RESC();
  { float sacc=pB0[0]+pB0[1]; _Pragma("unroll") for(int r=2;r<16;++r)sacc+=pB0[r]; _Pragma("unroll") for(int r=0;r<16;++r)sacc+=pB1[r]; l_reg+=sacc;
    pw0=(u32x4){PKW(pB0,0),PKW(pB0,2),PKW(pB0,4),PKW(pB0,6)};pw1=(u32x4){PKW(pB0,8),PKW(pB0,10),PKW(pB0,12),PKW(pB0,14)};pw2=(u32x4){PKW(pB1,0),PKW(pB1,2),PKW(pB1,4),PKW(pB1,6)};pw3=(u32x4){PKW(pB1,8),PKW(pB1,10),PKW(pB1,12),PKW(pB1,14)};
    SBAR(); pv(o,vb0+sl_cur,PAF(0),PAF(1),PAF(2),PAF(3)); }
  #undef PKW
  #undef PAF
  #undef VFR
  #undef PIN
  #undef MX3
  #undef GAPA
  #undef GAPB
  #undef EX
  #undef VRD
  #undef KRD
  #undef STEP
  #undef ENDW
  {auto rr=__builtin_amdgcn_permlane32_swap(__float_as_uint(l_reg),__float_as_uint(l_reg),false,false);l_reg=__uint_as_float(rr[0])+__uint_as_float(rr[1]);}
  if(hi==0)wsf[32+r32]=l_reg;asm volatile("s_waitcnt lgkmcnt(0)":::"memory");
  float rli[16];
  #pragma unroll
  for(int r=0;r<16;++r)rli[r]=__builtin_amdgcn_rcpf(wsf[32+crow(r,hi)]);
  bf16*Ow=O+(rowbase+q0+wid*QBLK)*DM+h*D;
  { bf16*stg=(bf16*)(shm+LDS_OST)+wid*2048;
    #pragma unroll
    for(int r=0;r<16;++r){const int orow=crow(r,hi);
      #pragma unroll
      for(int d0=0;d0<2;++d0)stg[orow*64+d0*32+r32]=__float2bfloat16(o[d0][r]*rli[r]);}
    asm volatile("s_waitcnt lgkmcnt(0)":::"memory");
    #pragma unroll
    for(int i=0;i<4;++i){const int row=i*8+(lane>>3),ch=lane&7; const u32x4 v=*(const u32x4*)(stg+row*64+ch*8); ATTN_STORE16(Ow+(long)row*DM+ch*8,v);} }
  asm volatile("s_waitcnt lgkmcnt(0)\n\ts_barrier":::"memory");
  #undef DMA_K
  #undef TIDX
  #undef DMA_V
  #undef CMASK
  #undef ABIAS
  #undef BLD
  #undef BSUB
  #undef START
  #undef RESC
  #undef ROT
}
constexpr int ATTN_LDS_BYTES=LDS_BYTES;
#undef SBAR
#undef WAIT_BAR
}

#ifndef LAS
#define LAS __attribute__((address_space(3)))
#endif
constexpr int MK_WAVES = 8;
#ifndef MK_NSB
#define MK_NSB 5
#endif
namespace pg8 { __device__ __forceinline__ unsigned cvt_pk_bf16(float lo, float hi); }

namespace sb_body {
typedef short bf16x8 __attribute__((ext_vector_type(8)));
typedef float f32x16 __attribute__((ext_vector_type(16)));
__device__ __forceinline__ void sb_head(LAS unsigned char* lds, int bh, const bf16_t* Q, const bf16_t* K, const bf16_t* V, bf16_t* O) {
    int tid_ = threadIdx.x; asm volatile("" : "+v"(tid_));
    const int lane = tid_ & 63, wid = __builtin_amdgcn_readfirstlane(tid_ >> 6), r32 = lane & 31, hi = lane >> 5;
    const int b = bh / NH, hh = bh % NH; const size_t rowb = (size_t)b * SEQ;
    const bf16_t* Qh = Q + rowb * DM + hh * HD; const bf16_t* Kh = K + rowb * DM + hh * HD; const bf16_t* Vh = V + rowb * DM + hh * HD; bf16_t* Oh = O + rowb * DM + hh * HD;
    LAS unsigned char* slot0 = lds + wid * 16384;
    const int vb0 = (int)(unsigned)(size_t)slot0 + ((lane >> 4) & 1) * 32 + (lane & 3) * 8 + (4 * hi + ((lane & 15) >> 2)) * 64;
    const bf16_t* vsrc0 = Vh + (size_t)(lane >> 2) * DM + (lane & 3) * 8;
#define SB_DMAV(t, sc) do { _Pragma("unroll") for (int p_ = 0; p_ < 8; ++p_) \
        __builtin_amdgcn_global_load_lds((const unsigned*)(vsrc0 + (size_t)(64 * (t) + 16 * (p_ & 3)) * DM + 32 * (p_ >> 2)), (LAS unsigned*)(slot0 + (sc) * 8192 + p_ * 1024), 16, 0, 0); } while (0)
#define SB_LOADK(kf, t) do { const bf16_t* kp_ = Kh + (size_t)(64 * (t) + r32) * DM + 8 * hi; _Pragma("unroll") for (int d0_ = 0; d0_ < 4; ++d0_) { \
        kf[2 * d0_] = *(const bf16x8*)(kp_ + 16 * d0_); kf[2 * d0_ + 1] = *(const bf16x8*)(kp_ + (size_t)32 * DM + 16 * d0_); } } while (0)
    for (int uu = wid; uu < SEQ / 32; uu += MK_NSB) {
        const int q0w = uu * 32, qabs = q0w + r32;
        bf16x8 qr[4];
#pragma unroll
        for (int d0 = 0; d0 < 4; ++d0) qr[d0] = *(const bf16x8*)(Qh + (size_t)qabs * DM + d0 * 16 + hi * 8);
        f32x16 o[2]; o[0] = f32x16{}; o[1] = f32x16{};
        float carry = 1.f; int jt = (q0w + 30) >> 6, sc = 0; bool first = true;
        bf16x8 kf[8], kfn[8];
        SB_DMAV(jt, 0); asm volatile("" ::: "memory"); SB_LOADK(kf, jt);
        for (;;) {
            f32x16 p0 = f32x16{}, p1 = f32x16{};
#pragma unroll
            for (int d0 = 0; d0 < 4; ++d0) { p0 = __builtin_amdgcn_mfma_f32_32x32x16_bf16(kf[2 * d0], qr[d0], p0, 0, 0, 0); p1 = __builtin_amdgcn_mfma_f32_32x32x16_bf16(kf[2 * d0 + 1], qr[d0], p1, 0, 0, 0); }
            const bool more = jt > 0;
            asm volatile("" ::: "memory");
            if (more) { SB_DMAV(jt - 1, sc ^ 1); asm volatile("" ::: "memory"); SB_LOADK(kfn, jt - 1); }
            asm volatile("" ::: "memory");
            float nb[8][4], be[8][4];
#pragma unroll
            for (int w = 0; w < 8; ++w)
#pragma unroll
                for (int i = 0; i < 4; ++i) { const int r = (w & 3) * 4 + i; float x = (w < 4) ? p0[r] : p1[r]; x = fminf(x, 64.f);
                    const float e = __builtin_amdgcn_exp2f(x), rr = __builtin_amdgcn_rcpf(1.f + e);
                    const int kv = 64 * jt + 32 * (w >> 2) + 8 * (w & 3) + 4 * hi + i; const bool valid = !first || (kv < qabs);
                    be[w][i] = valid ? e * rr : 0.f; nb[w][i] = valid ? rr : 1.f; }
            float Xs[8];
            float Te[8], To[8];
#pragma unroll
            for (int w = 0; w < 8; ++w) { const float s2 = nb[w][3], s1 = s2 * nb[w][2], s0 = s1 * nb[w][1], T = s0 * nb[w][0];
                be[w][2] *= s2; be[w][1] *= s1; be[w][0] *= s0;
                auto rr2 = __builtin_amdgcn_permlane32_swap(__float_as_uint(T), __float_as_uint(T), false, false); Te[w] = __uint_as_float(rr2[0]); To[w] = __uint_as_float(rr2[1]); }
            float W = 1.f;
#pragma unroll
            for (int w = 7; w >= 0; --w) { const float xe = W * To[w]; Xs[w] = hi ? W : xe; W = xe * Te[w]; }
            unsigned pw[16];
#pragma unroll
            for (int w = 0; w < 8; ++w) { const float sc2 = Xs[w] * carry; pw[2 * w] = pg8::cvt_pk_bf16(be[w][0] * sc2, be[w][1] * sc2); pw[2 * w + 1] = pg8::cvt_pk_bf16(be[w][2] * sc2, be[w][3] * sc2); }
            carry *= W;
            const bf16x8 pa0 = __builtin_bit_cast(bf16x8, (u32x4){pw[0], pw[1], pw[2], pw[3]}), pa1 = __builtin_bit_cast(bf16x8, (u32x4){pw[4], pw[5], pw[6], pw[7]});
            const bf16x8 pa2 = __builtin_bit_cast(bf16x8, (u32x4){pw[8], pw[9], pw[10], pw[11]}), pa3 = __builtin_bit_cast(bf16x8, (u32x4){pw[12], pw[13], pw[14], pw[15]});
            if (more) asm volatile("s_waitcnt vmcnt(16)" ::: "memory"); else asm volatile("s_waitcnt vmcnt(0)" ::: "memory");
            attn_body::pv(o, vb0 + sc * 8192, pa0, pa1, pa2, pa3);
            if (!more || __all(carry < 1e-12f)) break;
#pragma unroll
            for (int i = 0; i < 8; ++i) kf[i] = kfn[i];
            sc ^= 1; --jt; first = false;
        }
#pragma unroll
        for (int d0 = 0; d0 < 2; ++d0)
#pragma unroll
            for (int r = 0; r < 16; ++r) Oh[(size_t)(q0w + crow(r, hi)) * DM + d0 * 32 + r32] = (bf16_t)f2bf(o[d0][r]);
    }
#undef SB_DMAV
#undef SB_LOADK
}
}

#ifndef LAS
#define LAS __attribute__((address_space(3)))
#endif
#define GAS __attribute__((address_space(1)))
constexpr size_t WS_SS = WS_END;
constexpr size_t WS_WR = WS_SS + 2 * MiB;
constexpr size_t WS_WF = WS_WR + 1 * MiB;
constexpr size_t WS_HB2 = WS_WF + 1 * MiB;
constexpr size_t WS_WGU8 = WS_HB2 + 64 * MiB;
constexpr size_t WS_WD8 = WS_WGU8 + 128 * MiB;
constexpr size_t WS_HB8 = WS_WD8 + 64 * MiB;
constexpr size_t WS_ACT8 = WS_HB8 + 32 * MiB;
constexpr size_t WS_WG8 = WS_ACT8 + 136 * MiB;
constexpr size_t WS_END2 = WS_WG8 + 2 * MiB;
#ifndef MK_PLE8
#define MK_PLE8 1
#endif
#ifndef MK_FP8_MASK
#define MK_FP8_MASK 0
#endif
constexpr float W8SCALE = 256.f, W8INV = 1.f / 256.f;
constexpr int CW_BAR = 4096;
constexpr int CW_CNT2 = 16384, CNT_STRIDE = 64;


__device__ __forceinline__ float lperm(float v, int src) { return __builtin_bit_cast(float, __builtin_amdgcn_ds_bpermute(src << 2, __builtin_bit_cast(int, v))); }
__device__ __forceinline__ int lpermi(int v, int src) { return __builtin_amdgcn_ds_bpermute(src << 2, v); }
__device__ __forceinline__ float lwave_sum(float v, int lane) {
#pragma unroll
    for (int o = 1; o < 64; o <<= 1) v += lperm(v, lane ^ o);
    return v;
}
namespace pg8 {
constexpr int BM = 256, BK = 64, HALF = 128, HTB = HALF * BK * 2, STAGE_BYTES = 8 * HTB, NXCD = 8, WGM = 8;
__device__ __forceinline__ int lds_byte(int r, int c) { const int st = (r >> 4) * 2 + (c >> 5), rr = r & 15, cc = c & 31, ob = rr * 64 + cc * 2; return st * 1024 + (ob ^ (((ob >> 9) & 1) << 5)); }
__device__ __forceinline__ void stage_rc(int b, int& R, int& C) { const int st = b / 1024, sb = b % 1024, swz = sb ^ (((sb >> 9) & 1) << 5); R = (st >> 1) * 16 + swz / 64; C = (st & 1) * 32 + (swz % 64) / 2; }
__device__ __forceinline__ int perm32(int rho) { const int n = rho >> 4, i = rho & 15; return 8 * (i >> 2) + 4 * n + (i & 3); }
__device__ __forceinline__ unsigned cvt_pk_bf16(float lo, float hi) { unsigned r; asm volatile("v_cvt_pk_bf16_f32 %0, %1, %2" : "=v"(r) : "v"(lo), "v"(hi)); return r; }

struct Unit { int arow0, brow0, pn, e, rank0, cnt, ui; };

__device__ __forceinline__ int xcd_remap(int L, int nwg) { const int q = nwg / NXCD, r = nwg % NXCD, xcd = L % NXCD, off = L / NXCD; return (xcd < r ? xcd * (q + 1) : r * (q + 1) + (xcd - r) * q) + off; }

struct DenseOrder {
    int nM, nN, nwg, G, c;
    __device__ __forceinline__ void init(int M, int N, int G_, int c_) { nM = M / BM; nN = N / BM; nwg = nM * nN; G = G_; c = c_; }
    __device__ __forceinline__ bool next(int i, Unit& u) const {
        const long L = (long)i * G + c; if (L >= nwg) return false;
        const int wgid = xcd_remap((int)L, nwg);
        const int nig = WGM * nN, gid = wgid / nig, fm = gid * WGM, gsz = (nM - fm) < WGM ? (nM - fm) : WGM;
        const int pm = fm + ((wgid % nig) % gsz), pn = (wgid % nig) / gsz;
        u.arow0 = pm * BM; u.brow0 = pn * BM; u.pn = pn; u.e = 0; u.rank0 = 0; u.cnt = 0; u.ui = i; return true;
    }
    __device__ __forceinline__ int arow(const Unit& u, int lr) const { return u.arow0 + lr; }
};
struct HotOrder {
    DenseOrder d;
    __device__ __forceinline__ bool next(int i, Unit& u) const { const bool ok = d.next(i, u); u.arow0 = 0; u.brow0 = 0; u.pn = 0; return ok; }
    __device__ __forceinline__ int arow(const Unit& u, int lr) const { return lr; }
};
struct PJOrder {
    DenseOrder d; int G, c;
    __device__ __forceinline__ void init(int G_, int c_) { d.init(NTOK, DM, G_, 0); G = G_; c = c_; }
    __device__ __forceinline__ bool next(int i, Unit& u) const {
        const long L = (long)i * G + c; if (L >= 2 * d.nwg) return false;
        const int l2 = (L >= d.nwg) ? 1 : 0; const int wgid = xcd_remap((int)L - l2 * d.nwg, d.nwg);
        const int nig = WGM * d.nN, gid = wgid / nig, fm = gid * WGM, gsz = (d.nM - fm) < WGM ? (d.nM - fm) : WGM;
        const int pm = fm + ((wgid % nig) % gsz), pn = (wgid % nig) / gsz;
        u.arow0 = l2 * NTOK + pm * BM; u.brow0 = l2 * DM + pn * BM; u.pn = pn; u.e = 0; u.rank0 = 0; u.cnt = 0; u.ui = i; return true;
    }
    __device__ __forceinline__ int arow(const Unit& u, int lr) const { return u.arow0 + lr; }
};
struct MoeOrder {
    int NN, nwg, G, c, lane; const LAS int* tstartL; const LAS int* cntL; const LAS unsigned short* tokL; bool gather;
    __device__ __forceinline__ bool next(int i, Unit& u) const {
        const long L = (long)i * G + c; if (L >= nwg) return false;
        const int wgid = xcd_remap((int)L, nwg);
        const int T = wgid / NN, pn = wgid - T * NN;
        const int lo = (lane < NE) ? tstartL[lane] : 0x7fffffff, hi = (lane < NE) ? tstartL[lane + 1] : 0x7fffffff;
        const unsigned long long m = __ballot(lo <= T && T < hi);
        const int e = __builtin_amdgcn_readfirstlane((int)__builtin_ctzll(m | (1ull << 63)));
        u.e = e; u.rank0 = (T - __builtin_amdgcn_readfirstlane(tstartL[e])) * 256; u.cnt = __builtin_amdgcn_readfirstlane(cntL[e]); u.arow0 = T * 256; u.brow0 = (e * NN + pn) * 256; u.pn = pn; u.ui = i; return true;
    }
    __device__ __forceinline__ int arow(const Unit& u, int lr) const { return gather ? (int)tokL[u.ui * 256 + lr] : u.arow0 + lr; }
};

typedef const f32x4 (&AccRef)[2][2][4][2];
struct EpiQKV {
    bf16_t* Q; const LAS float* rowL; int probe;
    __device__ __forceinline__ void operator()(AccRef acc, const Unit& u, int wr, int wc, int fr, int fq) const {
        const int t = u.brow0 >> 10, colt = u.brow0 & 1023; bf16_t* base = Q + (size_t)t * ((size_t)NTOK * DM); const float sc = (t == 0) ? C2 : 1.f;
        const int col0 = colt + wc * 32 + 8 * fq;
#pragma unroll
        for (int ai = 0; ai < 2; ++ai)
#pragma unroll
            for (int m = 0; m < 4; ++m) { const int lr = ai * HALF + wr * 64 + m * 16 + fr; const int row = u.arow0 + lr;
                const float rs = rowL[u.ui * 256 + lr] * sc; bf16_t* rowp = base + (size_t)row * DM + col0;
#pragma unroll
                for (int bj = 0; bj < 2; ++bj) { const f32x4 v0 = acc[ai][bj][m][0] * rs, v1 = acc[ai][bj][m][1] * rs; u32x4 w;
                    w.x = cvt_pk_bf16(v0[0], v0[1]); w.y = cvt_pk_bf16(v0[2], v0[3]); w.z = cvt_pk_bf16(v1[0], v1[1]); w.w = cvt_pk_bf16(v1[2], v1[3]);
                    if (probe == 1) asm volatile("" :: "v"(w)); else if (probe == 2) __builtin_nontemporal_store(w, (u32x4*)(rowp + bj * HALF)); else *(u32x4*)(rowp + bj * HALF) = w; } }
    }
};
struct EpiPJ {
    bf16_t* O;
    __device__ __forceinline__ void operator()(AccRef acc, const Unit& u, int wr, int wc, int fr, int fq) const {
        const int col0 = u.pn * BM + wc * 32 + 8 * fq;
#pragma unroll
        for (int ai = 0; ai < 2; ++ai)
#pragma unroll
            for (int m = 0; m < 4; ++m) { const int row = u.arow0 + ai * HALF + wr * 64 + m * 16 + fr; bf16_t* rowp = O + (size_t)row * DM + col0;
#pragma unroll
                for (int bj = 0; bj < 2; ++bj) { const f32x4 v0 = acc[ai][bj][m][0], v1 = acc[ai][bj][m][1]; u32x4 w;
                    w.x = cvt_pk_bf16(v0[0], v0[1]); w.y = cvt_pk_bf16(v0[2], v0[3]); w.z = cvt_pk_bf16(v1[0], v1[1]); w.w = cvt_pk_bf16(v1[2], v1[3]); *(u32x4*)(rowp + bj * HALF) = w; } }
    }
};
struct EpiWo {
    const bf16_t* hin; bf16_t* hb; unsigned char* hb8;
    __device__ __forceinline__ void operator()(AccRef acc, const Unit& u, int wr, int wc, int fr, int fq) const {
        const int col0 = u.brow0 + wc * 32 + 8 * fq;
        u32x4 hv[2][4][2];
#pragma unroll
        for (int ai = 0; ai < 2; ++ai)
#pragma unroll
            for (int m = 0; m < 4; ++m) { const size_t off = (size_t)(u.arow0 + ai * HALF + wr * 64 + m * 16 + fr) * DM + col0;
#pragma unroll
                for (int bj = 0; bj < 2; ++bj) hv[ai][m][bj] = *(const u32x4*)(hin + off + bj * HALF); }
#pragma unroll
        for (int ai = 0; ai < 2; ++ai)
#pragma unroll
            for (int m = 0; m < 4; ++m) { const size_t off = (size_t)(u.arow0 + ai * HALF + wr * 64 + m * 16 + fr) * DM + col0;
#pragma unroll
                for (int bj = 0; bj < 2; ++bj) { const size_t o = off + bj * HALF; const u32x4 h4 = hv[ai][m][bj]; const f32x4 a0 = acc[ai][bj][m][0], a1 = acc[ai][bj][m][1];
                    const float x0 = __uint_as_float(h4.x << 16) + a0[0], x1 = __uint_as_float(h4.x & 0xffff0000u) + a0[1], x2 = __uint_as_float(h4.y << 16) + a0[2], x3 = __uint_as_float(h4.y & 0xffff0000u) + a0[3];
                    const float x4 = __uint_as_float(h4.z << 16) + a1[0], x5 = __uint_as_float(h4.z & 0xffff0000u) + a1[1], x6 = __uint_as_float(h4.w << 16) + a1[2], x7 = __uint_as_float(h4.w & 0xffff0000u) + a1[3];
                    if (hb8) { unsigned p0 = 0u, p1 = 0u; p0 = __builtin_amdgcn_cvt_pk_fp8_f32(x0, x1, p0, false); p0 = __builtin_amdgcn_cvt_pk_fp8_f32(x2, x3, p0, true); p1 = __builtin_amdgcn_cvt_pk_fp8_f32(x4, x5, p1, false); p1 = __builtin_amdgcn_cvt_pk_fp8_f32(x6, x7, p1, true);
                        *(u32x2*)(hb8 + o) = (u32x2){p0, p1}; }
                    u32x4 w; w.x = cvt_pk_bf16(x0, x1); w.y = cvt_pk_bf16(x2, x3); w.z = cvt_pk_bf16(x4, x5); w.w = cvt_pk_bf16(x6, x7);
                    *(u32x4*)(hb + o) = w; } }
    }
};
__device__ __forceinline__ float fast_sigmoid(float x) { return __builtin_amdgcn_rcpf(1.f + __builtin_amdgcn_exp2f(-LOG2E * x)); }
struct EpiPLE {
    const bf16_t* hin; bf16_t* hb; const bf16_t* PJ; const LAS float* rowL; float* SS;
    __device__ __forceinline__ void operator()(AccRef acc, const Unit& u, int wr, int wc, int fr, int fq) const {
        const int col0 = u.brow0 + wc * 32 + 8 * fq;
#pragma unroll
        for (int ai = 0; ai < 2; ++ai) {
            u32x4 hv[4][2], pv[4][2];
#pragma unroll
            for (int m = 0; m < 4; ++m) { const size_t off = (size_t)(u.arow0 + ai * HALF + wr * 64 + m * 16 + fr) * DM + col0;
#pragma unroll
                for (int bj = 0; bj < 2; ++bj) { hv[m][bj] = *(const u32x4*)(hin + off + bj * HALF); pv[m][bj] = *(const u32x4*)(PJ + off + bj * HALF); } }
#pragma unroll
            for (int m = 0; m < 4; ++m) { const int lr = ai * HALF + wr * 64 + m * 16 + fr; const int row = u.arow0 + lr; const size_t off = (size_t)row * DM + col0; const float rs = rowL[u.ui * 256 + lr]; float ssq = 0.f;
#pragma unroll
                for (int bj = 0; bj < 2; ++bj) { const size_t o = off + bj * HALF; const u32x4 pj = pv[m][bj]; const u32x4 h4 = hv[m][bj];
                    const f32x4 a0 = acc[ai][bj][m][0] * rs, a1 = acc[ai][bj][m][1] * rs; float x[8];
                    x[0] = __uint_as_float(h4.x << 16) + fast_sigmoid(a0[0]) * __uint_as_float(pj.x << 16); x[1] = __uint_as_float(h4.x & 0xffff0000u) + fast_sigmoid(a0[1]) * __uint_as_float(pj.x & 0xffff0000u);
                    x[2] = __uint_as_float(h4.y << 16) + fast_sigmoid(a0[2]) * __uint_as_float(pj.y << 16); x[3] = __uint_as_float(h4.y & 0xffff0000u) + fast_sigmoid(a0[3]) * __uint_as_float(pj.y & 0xffff0000u);
                    x[4] = __uint_as_float(h4.z << 16) + fast_sigmoid(a1[0]) * __uint_as_float(pj.z << 16); x[5] = __uint_as_float(h4.z & 0xffff0000u) + fast_sigmoid(a1[1]) * __uint_as_float(pj.z & 0xffff0000u);
                    x[6] = __uint_as_float(h4.w << 16) + fast_sigmoid(a1[2]) * __uint_as_float(pj.w << 16); x[7] = __uint_as_float(h4.w & 0xffff0000u) + fast_sigmoid(a1[3]) * __uint_as_float(pj.w & 0xffff0000u);
                    u32x4 w; w.x = cvt_pk_bf16(x[0], x[1]); w.y = cvt_pk_bf16(x[2], x[3]); w.z = cvt_pk_bf16(x[4], x[5]); w.w = cvt_pk_bf16(x[6], x[7]); *(u32x4*)(hb + o) = w;
                    float q0 = __uint_as_float(w.x << 16), q1 = __uint_as_float(w.x & 0xffff0000u), q2 = __uint_as_float(w.y << 16), q3 = __uint_as_float(w.y & 0xffff0000u);
                    float q4 = __uint_as_float(w.z << 16), q5 = __uint_as_float(w.z & 0xffff0000u), q6 = __uint_as_float(w.w << 16), q7 = __uint_as_float(w.w & 0xffff0000u);
                    ssq += (q0 * q0 + q1 * q1) + (q2 * q2 + q3 * q3) + (q4 * q4 + q5 * q5) + (q6 * q6 + q7 * q7); }
                { const int ln_ = fr + 16 * fq; ssq += lperm(ssq, ln_ ^ 16); ssq += lperm(ssq, ln_ ^ 32); }
                if (fq == 0) SS[(size_t)row * 16 + u.pn * 4 + wc] = ssq; }
            asm volatile("" ::: "memory");
        }
    }
};
template <bool OUT8> struct EpiGU {
    void* ACT; const float* bgu; const LAS float* rowL;
    __device__ __forceinline__ void operator()(AccRef acc, const Unit& u, int wr, int wc, int fr, int fq) const {
        const int jc = u.pn * 128 + wc * 32 + 8 * fq; const float* bp = bgu + (size_t)u.e * (2 * FF) + jc;
        const f32x4 bg0 = *(const f32x4*)(bp), bg1 = *(const f32x4*)(bp + 4), bl0 = *(const f32x4*)(bp + FF), bl1 = *(const f32x4*)(bp + FF + 4);
#pragma unroll
        for (int ai = 0; ai < 2; ++ai)
#pragma unroll
            for (int m = 0; m < 4; ++m) { const int lr = ai * HALF + wr * 64 + m * 16 + fr; const float rs = rowL[u.ui * 256 + lr];
                const f32x4 g0 = __builtin_elementwise_min(acc[ai][0][m][0] * rs + bg0, (f32x4){7.f, 7.f, 7.f, 7.f}), g1 = __builtin_elementwise_min(acc[ai][0][m][1] * rs + bg1, (f32x4){7.f, 7.f, 7.f, 7.f});
                const f32x4 l0 = __builtin_elementwise_min(__builtin_elementwise_max(acc[ai][1][m][0] * rs + bl0, (f32x4){-7.f, -7.f, -7.f, -7.f}), (f32x4){7.f, 7.f, 7.f, 7.f}) + 1.f;
                const f32x4 l1 = __builtin_elementwise_min(__builtin_elementwise_max(acc[ai][1][m][1] * rs + bl1, (f32x4){-7.f, -7.f, -7.f, -7.f}), (f32x4){7.f, 7.f, 7.f, 7.f}) + 1.f;
                const f32x4 x0 = g0 * (-1.702f * LOG2E), x1 = g1 * (-1.702f * LOG2E); f32x4 e0, e1;
#pragma unroll
                for (int c = 0; c < 4; ++c) { e0[c] = __builtin_amdgcn_exp2f(x0[c]); e1[c] = __builtin_amdgcn_exp2f(x1[c]); }
                const f32x4 d0 = e0 + 1.f, d1 = e1 + 1.f; f32x4 s0, s1;
#pragma unroll
                for (int c = 0; c < 4; ++c) { s0[c] = __builtin_amdgcn_rcpf(d0[c]); s1[c] = __builtin_amdgcn_rcpf(d1[c]); }
                const f32x4 a0 = (g0 * l0) * s0, a1 = (g1 * l1) * s1; const float a[8] = {a0[0], a0[1], a0[2], a0[3], a1[0], a1[1], a1[2], a1[3]};
                if constexpr (OUT8) { unsigned p0 = 0u, p1 = 0u; p0 = __builtin_amdgcn_cvt_pk_fp8_f32(a[0], a[1], p0, false); p0 = __builtin_amdgcn_cvt_pk_fp8_f32(a[2], a[3], p0, true); p1 = __builtin_amdgcn_cvt_pk_fp8_f32(a[4], a[5], p1, false); p1 = __builtin_amdgcn_cvt_pk_fp8_f32(a[6], a[7], p1, true);
                    *(u32x2*)((unsigned char*)ACT + (size_t)(u.arow0 + lr) * FF + jc) = (u32x2){p0, p1}; }
                else { u32x4 w; w.x = cvt_pk_bf16(a[0], a[1]); w.y = cvt_pk_bf16(a[2], a[3]); w.z = cvt_pk_bf16(a[4], a[5]); w.w = cvt_pk_bf16(a[6], a[7]);
                    *(u32x4*)((bf16_t*)ACT + (size_t)(u.arow0 + lr) * FF + jc) = w; } }
    }
};
struct EpiDown {
    bf16_t* Y; const float* bd; const LAS float* rowL; float bscale; bool y8;
    __device__ __forceinline__ void operator()(AccRef acc, const Unit& u, int wr, int wc, int fr, int fq) const {
        const int col0 = u.pn * 256 + wc * 32 + 8 * fq; const float* bp = bd + (size_t)u.e * DM + col0;
        f32x4 bv[2][2];
#pragma unroll
        for (int bj = 0; bj < 2; ++bj) { bv[bj][0] = *(const f32x4*)(bp + bj * HALF) * bscale; bv[bj][1] = *(const f32x4*)(bp + bj * HALF + 4) * bscale; }
#pragma unroll
        for (int ai = 0; ai < 2; ++ai)
#pragma unroll
            for (int m = 0; m < 4; ++m) { const int lr = ai * HALF + wr * 64 + m * 16 + fr; const float gt = rowL[u.ui * 256 + lr];
                bf16_t* rowp = Y + (size_t)(u.arow0 + lr) * DM + col0; unsigned char* rowp8 = (unsigned char*)Y + (size_t)(u.arow0 + lr) * DM + col0;
#pragma unroll
                for (int bj = 0; bj < 2; ++bj) { const f32x4 v0 = (acc[ai][bj][m][0] + bv[bj][0]) * gt, v1 = (acc[ai][bj][m][1] + bv[bj][1]) * gt;
                    if (y8) { unsigned p0 = 0u, p1 = 0u; p0 = __builtin_amdgcn_cvt_pk_fp8_f32(v0[0], v0[1], p0, false); p0 = __builtin_amdgcn_cvt_pk_fp8_f32(v0[2], v0[3], p0, true); p1 = __builtin_amdgcn_cvt_pk_fp8_f32(v1[0], v1[1], p1, false); p1 = __builtin_amdgcn_cvt_pk_fp8_f32(v1[2], v1[3], p1, true);
                        *(u32x2*)(rowp8 + bj * HALF) = (u32x2){p0, p1}; }
                    else { u32x4 w; w.x = cvt_pk_bf16(v0[0], v0[1]); w.y = cvt_pk_bf16(v0[2], v0[3]); w.z = cvt_pk_bf16(v1[0], v1[1]); w.w = cvt_pk_bf16(v1[2], v1[3]); *(u32x4*)(rowp + bj * HALF) = w; } } }
    }
};

typedef int v8i_t __attribute__((ext_vector_type(8))); typedef int v4i_t __attribute__((ext_vector_type(4)));
template <class Epi, class Sched, bool FP8 = false>
__device__ __forceinline__ void gemm_phase(LAS unsigned char* lds, const void* gA, const void* gBt, const int KB, const Sched& S, const Epi& E, const bool skip_epi = false) {
    int tid_ = threadIdx.x; asm volatile("" : "+v"(tid_));
    const int tid = tid_, wid = __builtin_amdgcn_readfirstlane(tid >> 6), lane = tid & 63, wr = wid >> 2, wc = wid & 3, fr = lane & 15, fq = lane >> 4;
    const int nt = KB / (BK * 2);
    unsigned voffB[2];
#pragma unroll
    for (int i = 0; i < 2; ++i) { int R, C; stage_rc(tid * 16 + i * 8192, R, C); const int Rb = (R & ~31) + perm32(R & 31); voffB[i] = (unsigned)(Rb * KB + C * 2); }
#define PG8_AOFF(u, o0, o1) do { int t2_ = threadIdx.x; asm volatile("" : "+v"(t2_)); _Pragma("unroll") for (int i = 0; i < 2; ++i) { int R, C; stage_rc(t2_ * 16 + i * 8192, R, C); \
        o0[i] = (unsigned)S.arow(u, R) * (unsigned)KB + (unsigned)C * 2u; o1[i] = (unsigned)S.arow(u, HALF + R) * (unsigned)KB + (unsigned)C * 2u; } } while (0)
    const unsigned kstep = (unsigned)(BK * 2);
    const unsigned hstep = (unsigned)HALF * (unsigned)KB;
    const unsigned ldsw = (unsigned)wid * 1024u;
    unsigned rdA_ = (unsigned)(size_t)lds + (unsigned)lds_byte(wr * 64 + fr, fq * 8), rdB_ = (unsigned)(size_t)lds + 4u * HTB + (unsigned)lds_byte(wc * 32 + fr, fq * 8);
    asm volatile("" : "+v"(rdA_), "+v"(rdB_));
    const LAS unsigned char* const rdA = (const LAS unsigned char*)(size_t)rdA_; const LAS unsigned char* const rdB = (const LAS unsigned char*)(size_t)rdB_;
#define PG8_SA(b, h) (((b) * 2 + (h)) * HTB)
#define PG8_SB(b, h) ((4 + (b) * 2 + (h)) * HTB)
#define PG8_STAGE(bufoff, rs, voff, soff) do { _Pragma("unroll") for (int _i = 0; _i < 2; ++_i) \
        __builtin_amdgcn_raw_ptr_buffer_load_lds(rs, (LAS void*)(lds + (bufoff) + ldsw + _i * 8192), 16, (voff)[_i], (unsigned)(soff), 0, 0); } while (0)
#define PG8_RA(b, h) (((b) * 2 + (h)) * HTB)
#define PG8_LD16A(off) __builtin_bit_cast(v4i_t, *(const LAS bf16x8*)(rdA + (off)))
#define PG8_LD16B(off) __builtin_bit_cast(v4i_t, *(const LAS bf16x8*)(rdB + (off)))
#define PG8_LDA(dst, b, h) do { if constexpr (FP8) { _Pragma("unroll") for (int m = 0; m < 4; ++m) dst##8[m] = __builtin_shufflevector(PG8_LD16A(PG8_RA(b, h) + m * 2048), PG8_LD16A(PG8_RA(b, h) + m * 2048 + 1024), 0, 1, 2, 3, 4, 5, 6, 7); } \
        else { _Pragma("unroll") for (int m = 0; m < 4; ++m) _Pragma("unroll") for (int k = 0; k < 2; ++k) dst[m][k] = *(const LAS bf16x8*)(rdA + PG8_RA(b, h) + m * 2048 + k * 1024); } } while (0)
#define PG8_LDB(dst, b, h) do { if constexpr (FP8) { _Pragma("unroll") for (int n = 0; n < 2; ++n) dst##8[n] = __builtin_shufflevector(PG8_LD16B(PG8_RA(b, h) + n * 2048), PG8_LD16B(PG8_RA(b, h) + n * 2048 + 1024), 0, 1, 2, 3, 4, 5, 6, 7); } \
        else { _Pragma("unroll") for (int n = 0; n < 2; ++n) _Pragma("unroll") for (int k = 0; k < 2; ++k) dst[n][k] = *(const LAS bf16x8*)(rdB + PG8_RA(b, h) + n * 2048 + k * 1024); } } while (0)
#define PG8_MMA(ai, bj, At, Bt) do { __builtin_amdgcn_s_setprio(1); _Pragma("unroll") for (int m = 0; m < 4; ++m) _Pragma("unroll") for (int n = 0; n < 2; ++n) { \
            if constexpr (FP8) acc[ai][bj][m][n] = __builtin_amdgcn_mfma_scale_f32_16x16x128_f8f6f4(Bt##8[n], At##8[m], acc[ai][bj][m][n], 0, 0, 0, 0, 0, 0); \
            else { _Pragma("unroll") for (int k = 0; k < 2; ++k) acc[ai][bj][m][n] = __builtin_amdgcn_mfma_f32_16x16x32_bf16(Bt[n][k], At[m][k], acc[ai][bj][m][n], 0, 0, 0); } } __builtin_amdgcn_s_setprio(0); } while (0)
#define PG8_WAIT_V(n) asm volatile("s_waitcnt vmcnt(" #n ")" ::: "memory")
#define PG8_WAIT_L(n) asm volatile("s_waitcnt lgkmcnt(" #n ")" ::: "memory")
#define PG8_BAR __builtin_amdgcn_s_barrier()
#define PG8_SCHED __builtin_amdgcn_sched_barrier(0)
    Unit cur, nxt; int ui = 0;
    if (!S.next(0, cur)) return;
    f32x4 acc[2][2][4][2];
#pragma unroll
    for (int a = 0; a < 2; ++a)
#pragma unroll
        for (int b = 0; b < 2; ++b)
#pragma unroll
            for (int m = 0; m < 4; ++m)
#pragma unroll
                for (int n = 0; n < 2; ++n) acc[a][b][m][n] = (f32x4){0.f, 0.f, 0.f, 0.f};
    bf16x8 At[4][2], B0[2][2], B1[2][2];
    v8i_t At8[4], B08[2], B18[2];
    unsigned ao0[2], ao1[2];
    PG8_AOFF(cur, ao0, ao1);
    const __amdgpu_buffer_rsrc_t rsA = __builtin_amdgcn_make_buffer_rsrc((void*)gA, 0, 0x7fffffff, 0x00020000), rsB = __builtin_amdgcn_make_buffer_rsrc((void*)gBt, 0, 0x7fffffff, 0x00020000);
    unsigned cB = (unsigned)cur.brow0 * (unsigned)KB;
    PG8_STAGE(PG8_SB(0, 0), rsB, voffB, cB); PG8_STAGE(PG8_SB(0, 1), rsB, voffB, cB + hstep); PG8_STAGE(PG8_SA(0, 0), rsA, ao0, 0u); PG8_STAGE(PG8_SA(0, 1), rsA, ao1, 0u);
    if (wr == 1) PG8_BAR;
    PG8_WAIT_V(2); PG8_BAR;
    PG8_STAGE(PG8_SB(1, 0), rsB, voffB, cB + kstep); PG8_STAGE(PG8_SA(1, 0), rsA, ao0, kstep); PG8_STAGE(PG8_SB(1, 1), rsB, voffB, cB + hstep + kstep);
    PG8_WAIT_V(6); PG8_BAR;
    for (;;) {
        const bool has_next = S.next(ui + 1, nxt);
        const unsigned nB = has_next ? (unsigned)nxt.brow0 * (unsigned)KB : cB;
        _Pragma("clang loop unroll(disable)") for (int t = 0; t < nt; t += 2) {
            const bool last = (t == nt - 2);
            const unsigned a1 = (unsigned)(t + 1) * kstep;
            const unsigned a2 = last ? 0u : (unsigned)(t + 2) * kstep; const unsigned b2 = last ? nB : cB + (unsigned)(t + 2) * kstep;
            const unsigned a3 = a2 + kstep; const unsigned b3 = b2 + kstep;
            PG8_LDB(B0, 0, 0); PG8_LDB(B1, 0, 1); PG8_SCHED; PG8_LDA(At, 0, 0); PG8_STAGE(PG8_SA(1, 1), rsA, ao1, a1);
            if (last && has_next) { PG8_AOFF(nxt, ao0, ao1); }
            PG8_WAIT_V(8); PG8_WAIT_L(0); PG8_BAR; PG8_MMA(0, 0, At, B0); PG8_MMA(0, 1, At, B1); PG8_BAR; PG8_SCHED;
            PG8_LDA(At, 0, 1); PG8_STAGE(PG8_SB(0, 0), rsB, voffB, b2); PG8_STAGE(PG8_SB(0, 1), rsB, voffB, b2 + hstep); PG8_STAGE(PG8_SA(0, 0), rsA, ao0, a2);
            PG8_WAIT_V(8); PG8_WAIT_L(0); PG8_BAR; PG8_MMA(1, 0, At, B0); PG8_MMA(1, 1, At, B1); PG8_BAR; PG8_SCHED;
            PG8_LDB(B0, 1, 0); PG8_LDB(B1, 1, 1); PG8_SCHED; PG8_LDA(At, 1, 0); PG8_STAGE(PG8_SA(0, 1), rsA, ao1, a2);
            PG8_WAIT_V(8); PG8_WAIT_L(0); PG8_BAR; PG8_MMA(0, 0, At, B0); PG8_MMA(0, 1, At, B1); PG8_BAR; PG8_SCHED;
            PG8_LDA(At, 1, 1); PG8_STAGE(PG8_SB(1, 0), rsB, voffB, b3); PG8_STAGE(PG8_SB(1, 1), rsB, voffB, b3 + hstep); PG8_STAGE(PG8_SA(1, 0), rsA, ao0, a3);
            PG8_WAIT_V(8); PG8_WAIT_L(0); PG8_BAR; PG8_MMA(1, 0, At, B0); PG8_MMA(1, 1, At, B1); PG8_BAR; PG8_SCHED;
        }
        if (wr == 0) PG8_BAR;
        if (!skip_epi) E(acc, cur, wr, wc, fr, fq);
        if (!has_next) break;
#pragma unroll
        for (int a = 0; a < 2; ++a)
#pragma unroll
            for (int b = 0; b < 2; ++b)
#pragma unroll
                for (int m = 0; m < 4; ++m)
#pragma unroll
                    for (int n = 0; n < 2; ++n) acc[a][b][m][n] = (f32x4){0.f, 0.f, 0.f, 0.f};
        cur = nxt; cB = nB; ++ui;
        if (wr == 1) PG8_BAR;
    }
    PG8_WAIT_V(0);
    PG8_BAR;
#undef PG8_AOFF
#undef PG8_SA
#undef PG8_SB
#undef PG8_STAGE
#undef PG8_LDA
#undef PG8_LD16A
#undef PG8_LD16B
#undef PG8_RA
#undef PG8_LDB
#undef PG8_MMA
#undef PG8_WAIT_V
#undef PG8_WAIT_L
#undef PG8_BAR
#undef PG8_SCHED
}
}

#define XB_TMO      128
#define XB_XCNT(j)  (256  + 64 * (j))
#define XB_XSUB(j)  (1280 + 64 * (j))
#define XB_XGEN(j)  (2304 + 64 * (j))
#define XB_TOP      3328
#define XB_TOPGEN   3392
#define XCD_BAR_WORDS 3456
#define XB_SPIN_CAP (1u << 18)
__device__ __forceinline__ unsigned xb_ld(unsigned* p)              { return __hip_atomic_load(p, __ATOMIC_RELAXED, __HIP_MEMORY_SCOPE_AGENT); }
__device__ __forceinline__ unsigned xb_add(unsigned* p, unsigned v) { return __hip_atomic_fetch_add(p, v, __ATOMIC_RELAXED, __HIP_MEMORY_SCOPE_AGENT); }
__device__ __forceinline__ unsigned xb_xcc_id() { return (unsigned)__builtin_amdgcn_s_getreg((3 << 11) | 20) & 0xFu; }
#define XB_SPIN(cond, bar) do { unsigned _sp = 0; while (cond) { __builtin_amdgcn_s_sleep(1); \
    if ((++_sp & 255u) == 0u) { if (xb_ld(&(bar)[XB_TMO])) break; if (_sp > XB_SPIN_CAP) { atomicAdd(&(bar)[XB_TMO], 1u); break; } } } } while (0)
struct XcdBarrier { unsigned* bar; unsigned x; volatile LAS unsigned* st; };
__device__ __forceinline__ XcdBarrier xcd_barrier_post(unsigned* bar, volatile LAS unsigned* st) {
    XcdBarrier b; b.bar = bar; b.x = xb_xcc_id(); b.st = st;
    if (threadIdx.x == 0) (void)xb_add(&bar[XB_XCNT(b.x)], 1u);
    return b;
}
__device__ __forceinline__ void xcd_barrier_complete(unsigned* bar, unsigned x, unsigned& nloc, unsigned& nx) {
    const unsigned G = gridDim.x * gridDim.y * gridDim.z;
    unsigned sum, cnt, mine, sp = 0u;
    for (;;) {
        sum = 0u; cnt = 0u; mine = 0u;
#pragma unroll
        for (unsigned j = 0; j < 16; ++j) { const unsigned c = xb_ld(&bar[XB_XCNT(j)]); sum += c; cnt += (c > 0u) ? 1u : 0u; mine = (j == x) ? c : mine; }
        if (sum == G) break;
        __builtin_amdgcn_s_sleep(1);
        if ((++sp & 255u) == 0u) { if (xb_ld(&bar[XB_TMO])) break; if (sp > XB_SPIN_CAP) { atomicAdd(&bar[XB_TMO], 1u); break; } }
    }
    nloc = mine > 0u ? mine : 1u; nx = cnt > 0u ? cnt : 1u;
}
__device__ __forceinline__ void xcd_barrier(const XcdBarrier& b) {
    asm volatile("s_waitcnt vmcnt(0)" ::: "memory");
    __syncthreads();
    if (threadIdx.x == 0) {
        unsigned* bar = b.bar;
        __builtin_amdgcn_s_waitcnt(0);
        unsigned nloc = b.st[0], nx = b.st[1];
        if (nloc == 0u) { xcd_barrier_complete(bar, b.x, nloc, nx); b.st[0] = nloc; b.st[1] = nx; }
        const unsigned old = xb_add(&bar[XB_XSUB(b.x)], 1u);
        const unsigned gen = old / nloc;
        if (old + 1u == (gen + 1u) * nloc) {
            __builtin_amdgcn_fence(__ATOMIC_RELEASE, "agent");
            asm volatile("s_waitcnt vmcnt(0)" ::: "memory");
            const unsigned og = xb_add(&bar[XB_TOP], 1u);
            const unsigned tg = og / nx;
            if (og + 1u == (tg + 1u) * nx) xb_add(&bar[XB_TOPGEN], 1u);
            else XB_SPIN(xb_ld(&bar[XB_TOPGEN]) == tg, bar);
            __builtin_amdgcn_fence(__ATOMIC_ACQUIRE, "agent");
            xb_add(&bar[XB_XGEN(b.x)], 1u);
            asm volatile("s_waitcnt vmcnt(0)" ::: "memory");
        } else {
            XB_SPIN(xb_ld(&bar[XB_XGEN(b.x)]) == gen, bar);
            __builtin_amdgcn_fence(__ATOMIC_ACQUIRE, "agent");
            asm volatile("s_waitcnt vmcnt(0)" ::: "memory");
        }
    }
    __syncthreads();
}

constexpr int RING_BYTES = 131072;
constexpr int ROW_OFF = RING_BYTES, TOK_UNITS = 18;
constexpr int TOK_OFF = ROW_OFF + TOK_UNITS * 1024;
constexpr int TBL_OFF = TOK_OFF + TOK_UNITS * 512;
constexpr int LDSCTL_OFF = TBL_OFF + 512;
constexpr int MK_LDS_BYTES = LDSCTL_OFF + 256;
static_assert(MK_LDS_BYTES <= 160 * 1024, "LDS map");

struct MArgs { const float* in[18]; float* out; unsigned char* ws; int ph_lo, ph_hi; };
struct Frame {
    LAS unsigned char* lds; int tid, lane, wave, vcu, G;
    unsigned char* ws; unsigned* ctl;
};
__device__ __forceinline__ unsigned pkb(float lo, float hi) { return pg8::cvt_pk_bf16(lo, hi); }

struct P0Item { const float* W; const float* g; unsigned char* dst; int K, N, item, mode; };
__device__ __forceinline__ void p0_load32(const P0Item& d, int lane, float (&v)[32], float& g0) {
    const int nblk = d.N / 32, kb = d.item / nblk, nb = d.item - kb * nblk, k0 = 64 * kb, n0 = 32 * nb;
    const float* p = d.W + (size_t)(k0 + (lane >> 5)) * d.N + n0 + (lane & 31);
#pragma unroll
    for (int i = 0; i < 32; ++i) v[i] = p[(size_t)(2 * i) * d.N];
    g0 = d.g ? d.g[k0 + lane] : 1.f;
}
__device__ __forceinline__ void p0_store32(const P0Item& d, int lane, const float (&v)[32], float g0, LAS float* scr) {
    const int nblk = d.N / 32, kb = d.item / nblk, nb = d.item - kb * nblk, k0 = 64 * kb, n0 = 32 * nb;
#pragma unroll
    for (int i = 0; i < 32; ++i) { const int kk = 2 * i + (lane >> 5); scr[kk * 33 + (lane & 31)] = v[i] * lperm(g0, kk); }
    asm volatile("s_waitcnt lgkmcnt(0)" ::: "memory");
    const int c = lane & 7;
#pragma unroll
    for (int j = 0; j < 4; ++j) { const int n = (lane >> 3) + 8 * j; const LAS float* s = scr + (8 * c) * 33 + n;
        u32x4 o; o.x = pkb(s[0 * 33], s[1 * 33]); o.y = pkb(s[2 * 33], s[3 * 33]); o.z = pkb(s[4 * 33], s[5 * 33]); o.w = pkb(s[6 * 33], s[7 * 33]);
        *(u32x4*)((bf16_t*)d.dst + (size_t)(n0 + n) * d.K + k0 + 8 * c) = o; }
    asm volatile("s_waitcnt lgkmcnt(0)" ::: "memory");
}
__device__ __forceinline__ void p0_load64(const P0Item& d, int lane, f32x4 (&v)[16], float& g0) {
    const int nblk = d.N / 64, kb = d.item / nblk, nb = d.item - kb * nblk, k0 = 64 * kb, n0 = 64 * nb;
    const float* p = d.W + (size_t)(k0 + (lane >> 4)) * d.N + n0 + 4 * (lane & 15);
#pragma unroll
    for (int i = 0; i < 16; ++i) v[i] = __builtin_nontemporal_load((const f32x4*)(p + (size_t)(4 * i) * d.N));
    g0 = (d.g ? d.g[k0 + lane] : 1.f) * W8SCALE;
}
__device__ __forceinline__ void p0_store64(const P0Item& d, int lane, const f32x4 (&v)[16], float g0, LAS float* scr) {
    const int nblk = d.N / 64, kb = d.item / nblk, nb = d.item - kb * nblk, k0 = 64 * kb, n0 = 64 * nb;
#pragma unroll
    for (int i = 0; i < 16; ++i) { const int kk = 4 * i + (lane >> 4); const float gg = lperm(g0, kk); LAS float* w = scr + kk * 65 + 4 * (lane & 15); w[0] = v[i].x * gg; w[1] = v[i].y * gg; w[2] = v[i].z * gg; w[3] = v[i].w * gg; }
    asm volatile("s_waitcnt lgkmcnt(0)" ::: "memory");
#pragma unroll
    for (int j = 0; j < 4; ++j) { const int id = lane + 64 * j, n = id >> 2, c = id & 3; const LAS float* s = scr + (16 * c) * 65 + n; unsigned p[4];
#pragma unroll
        for (int q = 0; q < 4; ++q) { unsigned w = 0u; w = __builtin_amdgcn_cvt_pk_fp8_f32(s[(4 * q + 0) * 65], s[(4 * q + 1) * 65], w, false); w = __builtin_amdgcn_cvt_pk_fp8_f32(s[(4 * q + 2) * 65], s[(4 * q + 3) * 65], w, true); p[q] = w; }
        int nn = n0 + n; if (d.mode == 1) { const int half = nn / FF, j2 = nn % FF; nn = (j2 >> 7) * 256 + half * 128 + (j2 & 127); }
        *(u32x4*)(d.dst + (size_t)nn * d.K + k0 + 16 * c) = (u32x4){p[0], p[1], p[2], p[3]}; }
    asm volatile("s_waitcnt lgkmcnt(0)" ::: "memory");
}
__device__ __forceinline__ void p0_big(Frame& F, const MArgs& args, int cw, int ncw, LAS float* scr) {
    const int gw = F.vcu * ncw + cw, NGW = F.G * ncw, lane = F.lane;
    unsigned char* ws = F.ws;
    const float* g_moe = args.in[7]; const float* w_gu = args.in[10]; const float* w_down = args.in[12]; const float* g_ple = args.in[14]; const float* w_ple_gate = args.in[15];
    {
        constexpr int J_GU = (DM / 64) * (2 * FF / 64), J_WD = (FF / 64) * (DM / 64), J_WG = (DM / 64) * (DM / 64);
        constexpr int PER_LAYER8 = NE * J_GU + NE * J_WD + J_WG, NIT = DEPTH * PER_LAYER8;
        auto decode = [&](int it) -> P0Item {
            const int L = it / PER_LAYER8; int r = it - L * PER_LAYER8;
            if (r < NE * J_GU) { const int e = r / J_GU; const size_t m = (size_t)L * NE + e; return P0Item{w_gu + m * DM * 2 * FF, g_moe + L * DM, ws + WS_WGU8 + m * 2 * FF * DM, DM, 2 * FF, r - e * J_GU, 1}; } r -= NE * J_GU;
            if (r < NE * J_WD) { const int e = r / J_WD; const size_t m = (size_t)L * NE + e; return P0Item{w_down + m * FF * DM, nullptr, ws + WS_WD8 + m * DM * FF, FF, DM, r - e * J_WD, 0}; } r -= NE * J_WD;
            return P0Item{w_ple_gate + (size_t)L * DM * DM, g_ple + L * DM, ws + WS_WG8 + (size_t)L * DM * DM, DM, DM, r, 0};
        };
        f32x4 va[16], vb[16]; float ga = 1.f, gb = 1.f; P0Item da{}, db{};
        int it = gw;
        if (it < NIT) { da = decode(it); p0_load64(da, lane, va, ga); }
        while (it < NIT) {
            const int itb = it + NGW; const bool hb = itb < NIT;
            if (hb) { db = decode(itb); p0_load64(db, lane, vb, gb); }
            p0_store64(da, lane, va, ga, scr);
            const int itc = itb + NGW; const bool hc = itc < NIT;
            if (hc) { da = decode(itc); p0_load64(da, lane, va, ga); }
            if (hb) p0_store64(db, lane, vb, gb, scr);
            it = itc;
        }
    }
}
__device__ __forceinline__ void p0_prologue(Frame& F, const MArgs& args) {
    static_assert(MK_FP8_MASK == 3 && MK_PLE8 == 1, "this prologue converts the expert and PLE gate matrices to fp8 only");
    LAS float* scr = (LAS float*)(F.lds + F.wave * 16896);
    const int gw = F.vcu * MK_WAVES + F.wave, NGW = F.G * MK_WAVES, lane = F.lane;
    unsigned char* ws = F.ws;
    const float* g_mix = args.in[2]; const float* w_qkv = args.in[3]; const float* w_fgate = args.in[4]; const float* w_o = args.in[6]; const float* g_moe = args.in[7]; const float* w_router = args.in[8];
    const float* w_gu = args.in[10]; const float* w_down = args.in[12]; const float* g_ple = args.in[14]; const float* w_ple_gate = args.in[15]; const float* w_ple_proj = args.in[16];
    {
        constexpr int I_QKV = (DM / 64) * (3 * DM / 32), I_SQ = (DM / 64) * (DM / 32), I_WP = (PLE / 64) * (DM / 32), I_WR = (DM / 64) * (NE / 32);
        constexpr int PER_LAYER = I_QKV + I_SQ + I_WP + I_WR, NIT = DEPTH * PER_LAYER;
        auto decode = [&](int it) -> P0Item {
            const int L = it / PER_LAYER; int r = it - L * PER_LAYER;
            if (r < I_QKV) return P0Item{w_qkv + (size_t)L * DM * 3 * DM, g_mix + L * DM, ws + WS_WQKV + (size_t)L * 3 * DM * DM * 2, DM, 3 * DM, r, 0}; r -= I_QKV;
            if (r < I_SQ) return P0Item{w_o + (size_t)L * DM * DM, nullptr, ws + WS_WO + (size_t)L * DM * DM * 2, DM, DM, r, 0}; r -= I_SQ;
            if (r < I_WP) return P0Item{w_ple_proj + (size_t)L * PLE * DM, nullptr, ws + WS_WP + (size_t)L * DM * PLE * 2, PLE, DM, r, 0}; r -= I_WP;
            return P0Item{w_router + (size_t)L * DM * NE, g_moe + L * DM, ws + WS_WR + (size_t)L * NE * DM * 2, DM, NE, r, 0};
        };
        float va[32]; float ga = 1.f;
        for (int it = gw; it < NIT; it += NGW) { const P0Item d = decode(it); p0_load32(d, lane, va, ga); p0_store32(d, lane, va, ga, scr); }
    }
    if (gw < 256) { bf16_t* WF = (bf16_t*)(ws + WS_WF); const int idx = gw * 64 + lane; const int n = idx >> 10, k = idx & 1023; WF[idx] = (bf16_t)f2bf(w_fgate[(size_t)k * NH + n] * g_mix[DM + k]); }
    {
        const float* x = args.in[0]; bf16_t* HB = (bf16_t*)(ws + WS_HB); float* SS = (float*)(ws + WS_SS);
        for (int row0 = gw * 4; row0 < NTOK; row0 += NGW * 4) {
            f32x4 v[4][4];
#pragma unroll
            for (int q = 0; q < 4; ++q) { const f32x4* p = (const f32x4*)(x + (size_t)(row0 + q) * DM) + lane;
#pragma unroll
                for (int j = 0; j < 4; ++j) v[q][j] = p[64 * j]; }
#pragma unroll
            for (int q = 0; q < 4; ++q) { float s = 0.f;
#pragma unroll
                for (int j = 0; j < 4; ++j) s += v[q][j].x * v[q][j].x + v[q][j].y * v[q][j].y + v[q][j].z * v[q][j].z + v[q][j].w * v[q][j].w;
                s = lwave_sum(s, lane);
                if (lane < 16) SS[(size_t)(row0 + q) * 16 + lane] = (lane == 0) ? s : 0.f;
                u32x2* o = (u32x2*)(HB + (size_t)(row0 + q) * DM) + lane;
#pragma unroll
                for (int j = 0; j < 4; ++j) { u32x2 w; w.x = pkb(v[q][j].x, v[q][j].y); w.y = pkb(v[q][j].z, v[q][j].w); o[64 * j] = w; } }
        }
        const float* pp = args.in[1]; bf16_t* PB = (bf16_t*)(ws + WS_PB);
        const size_t n4 = (size_t)DEPTH * NTOK * PLE / 4;
        for (size_t i = (size_t)gw * 64 + lane; i < n4; i += (size_t)NGW * 64 * 4) {
            f32x4 v[4];
#pragma unroll
            for (int q = 0; q < 4; ++q) { const size_t ii = i + (size_t)q * NGW * 64; if (ii < n4) v[q] = ((const f32x4*)pp)[ii]; }
#pragma unroll
            for (int q = 0; q < 4; ++q) { const size_t ii = i + (size_t)q * NGW * 64; if (ii < n4) { u32x2 w; w.x = pkb(v[q].x, v[q].y); w.y = pkb(v[q].z, v[q].w); ((u32x2*)PB)[ii] = w; } }
        }
    }
}

__device__ __forceinline__ void moe_tables(Frame& F, const unsigned* cnt) {
    LAS int* tstartL = (LAS int*)(F.lds + TBL_OFF); LAS int* cntL = tstartL + 64;
    if (F.wave == 0) {
        const int lane = F.lane; const int c = (lane < NE) ? (int)__hip_atomic_load(cnt + CNT_STRIDE * (lane & 31), __ATOMIC_RELAXED, __HIP_MEMORY_SCOPE_AGENT) : 0; const int nt = (c + 255) >> 8; int incl = nt;
#pragma unroll
        for (int o = 1; o < 32; o <<= 1) { const int t = lpermi(incl, lane - o); if ((lane & 31) >= o) incl += t; }
        if (lane < NE) { tstartL[lane] = incl - nt; cntL[lane] = c; if (lane == NE - 1) tstartL[NE] = incl; }
    }
    __syncthreads();
}
__device__ __forceinline__ void router_phase(Frame& F, const bf16_t* HB, const bf16_t* WR, const float* br, float* rstd, unsigned* cnt, int* tok_of, float* gate_of, unsigned* pair) {
    const int gw = F.vcu * MK_WAVES + F.wave, NGW = F.G * MK_WAVES, lane = F.lane, r = lane & 15, quad = lane >> 4;
    LAS unsigned* hist = (LAS unsigned*)(F.lds); LAS unsigned* gbase = hist + 32;
    LAS unsigned char* wl = F.lds + 1024; constexpr int WLS = 2064;
    for (int i = F.tid; i < NE * 128; i += MK_WAVES * 64) { const int row = i >> 7, ch = i & 127; *(LAS u32x4*)(wl + row * WLS + ch * 16) = *(const u32x4*)(WR + (size_t)row * DM + ch * 8); }
    __syncthreads();
    for (int it = 0; it * NGW < NTOK / 16; ++it) {
        const int blk = it * NGW + gw; const bool valid = blk < NTOK / 16;
        if (F.tid < 32) hist[F.tid] = 0u;
        __syncthreads();
        int see[4]; unsigned slr[4]; float sgt[4];
        const int t0 = blk * 16;
        if (valid) {
            const bf16_t* ap = HB + (size_t)(t0 + r) * DM + quad * 8; const LAS unsigned char* bl0 = wl + r * WLS + quad * 16; const LAS unsigned char* bl1 = bl0 + 16 * WLS;
            f32x4 acc0 = {0.f, 0.f, 0.f, 0.f}, acc1 = {0.f, 0.f, 0.f, 0.f}; float ssq = 0.f;
#pragma unroll 16
            for (int ks = 0; ks < 32; ++ks) { const bf16x8 a = *(const bf16x8*)(ap + 32 * ks), b0 = *(const LAS bf16x8*)(bl0 + 64 * ks), b1 = *(const LAS bf16x8*)(bl1 + 64 * ks);
                acc0 = __builtin_amdgcn_mfma_f32_16x16x32_bf16(a, b0, acc0, 0, 0, 0); acc1 = __builtin_amdgcn_mfma_f32_16x16x32_bf16(a, b1, acc1, 0, 0, 0);
#pragma unroll
                for (int j = 0; j < 8; ++j) { const float f = __uint_as_float(((unsigned)(unsigned short)a[j]) << 16); ssq += f * f; } }
            ssq += lperm(ssq, lane ^ 16); ssq += lperm(ssq, lane ^ 32);
            const float rs_r = rsqrtf(ssq * (1.f / DM) + EPS);
            const float b_lo = br[r], b_hi = br[16 + r];
#pragma unroll
            for (int j = 0; j < 4; ++j) {
                const float rsj = lperm(rs_r, quad * 4 + j); const int t = t0 + quad * 4 + j;
                float v0 = acc0[j] * rsj + b_lo, v1 = acc1[j] * rsj + b_hi; float tv[4]; int ti[4];
#pragma unroll
                for (int k = 0; k < 4; ++k) {
                    float bv = (v0 >= v1) ? v0 : v1; int bi = (v0 >= v1) ? r : 16 + r;
#pragma unroll
                    for (int o = 1; o < 16; o <<= 1) { const float ov = lperm(bv, lane ^ o); const int oi = lpermi(bi, lane ^ o); if (ov > bv || (ov == bv && oi < bi)) { bv = ov; bi = oi; } }
                    tv[k] = bv; ti[k] = bi; if (bi == r) v0 = -INFINITY; if (bi == 16 + r) v1 = -INFINITY;
                }
                float w[4], sw = 0.f;
#pragma unroll
                for (int k = 0; k < 4; ++k) { w[k] = __expf(tv[k] - tv[0]); sw += w[k]; }
                const int ee = (r == 0) ? ti[0] : (r == 1) ? ti[1] : (r == 2) ? ti[2] : ti[3]; const float ww = (r == 0) ? w[0] : (r == 1) ? w[1] : (r == 2) ? w[2] : w[3];
                see[j] = ee; sgt[j] = ww / sw; slr[j] = 0u;
                if (r < 4) slr[j] = __hip_atomic_fetch_add(hist + ee, 1u, __ATOMIC_RELAXED, __HIP_MEMORY_SCOPE_WORKGROUP);
                if (r == 4) rstd[t] = rsj;
            }
        }
        __syncthreads();
        if (F.tid < 32) { const unsigned n = hist[F.tid]; gbase[F.tid] = n ? __hip_atomic_fetch_add(cnt + CNT_STRIDE * F.tid, n, __ATOMIC_RELAXED, __HIP_MEMORY_SCOPE_AGENT) : 0u; }
        __syncthreads();
        if (valid && r < 4) {
#pragma unroll
            for (int j = 0; j < 4; ++j) { const int t = t0 + quad * 4 + j; const int ee = see[j]; const unsigned rk = gbase[ee] + slr[j];
                tok_of[(size_t)ee * CAP + rk] = t; gate_of[(size_t)ee * CAP + rk] = sgt[j]; pair[(size_t)t * 4 + r] = ((unsigned)ee << 16) | rk; }
        }
        __syncthreads();
    }
}
__device__ __forceinline__ void fgate_phase(Frame& F, const bf16_t* HB, const bf16_t* WF, const float* bfg, const float* SS, float* FL) {
    const int gw = F.vcu * MK_WAVES + F.wave, NGW = F.G * MK_WAVES, lane = F.lane, r = lane & 15, quad = lane >> 4;
    for (int blk = gw; blk < NTOK / 16; blk += NGW) {
        const int t0 = blk * 16;
        const bf16_t* ap = HB + (size_t)(t0 + r) * DM + quad * 8; const bf16_t* bp0 = WF + (size_t)r * DM + quad * 8;
        f32x4 acc0 = {0.f, 0.f, 0.f, 0.f};
#pragma unroll 8
        for (int ks = 0; ks < 32; ++ks) { const bf16x8 a = *(const bf16x8*)(ap + 32 * ks), b0 = *(const bf16x8*)(bp0 + 32 * ks); acc0 = __builtin_amdgcn_mfma_f32_16x16x32_bf16(a, b0, acc0, 0, 0, 0); }
        const f32x4 sp = *(const f32x4*)(SS + (size_t)(t0 + r) * 16 + quad * 4); float ss = (sp.x + sp.y) + (sp.z + sp.w); ss += lperm(ss, lane ^ 16); ss += lperm(ss, lane ^ 32);
        const float rs_r = rsqrtf(ss * (1.f / DM) + EPS); const float bb = bfg[r];
#pragma unroll
        for (int j = 0; j < 4; ++j) { const float rsj = lperm(rs_r, quad * 4 + j); FL[(size_t)(t0 + quad * 4 + j) * NH + r] = acc0[j] * rsj + bb; }
    }
}
__device__ __forceinline__ void combine_phase(Frame& F, const bf16_t* hin, bf16_t* hout, unsigned char* hout8, float* rstd, const unsigned* pair, const bf16_t* Y, const bool y8) {
    const int gw = F.vcu * MK_WAVES + F.wave, NGW = F.G * MK_WAVES, lane = F.lane; const LAS int* tstartL = (const LAS int*)(F.lds + TBL_OFF);
    constexpr int CMB_Q = 2;
    for (int t0 = gw; t0 < NTOK; t0 += CMB_Q * NGW) {
        int tt[CMB_Q];
#pragma unroll
        for (int q = 0; q < CMB_Q; ++q) tt[q] = (t0 + q * NGW < NTOK) ? t0 + q * NGW : t0;
        u32x4 pr4[CMB_Q]; u32x2 hw[CMB_Q][4]; u32x2 yw[CMB_Q][4][4];
#pragma unroll
        for (int q = 0; q < CMB_Q; ++q) pr4[q] = *(const u32x4*)(pair + (size_t)tt[q] * 4);
#pragma unroll
        for (int q = 0; q < CMB_Q; ++q) { const u32x2* hr = (const u32x2*)(hin + (size_t)tt[q] * DM) + lane;
#pragma unroll
            for (int j = 0; j < 4; ++j) hw[q][j] = hr[64 * j]; }
#pragma unroll
        for (int q = 0; q < CMB_Q; ++q)
#pragma unroll
            for (int k = 0; k < 4; ++k) { const unsigned pr = (k == 0) ? pr4[q].x : (k == 1) ? pr4[q].y : (k == 2) ? pr4[q].z : pr4[q].w; const int e = __builtin_amdgcn_readfirstlane((int)(pr >> 16)), rk = __builtin_amdgcn_readfirstlane((int)(pr & 0xffffu));
                const size_t slot = (size_t)tstartL[e] * 256 + rk;
                if (y8) { const unsigned* yr = (const unsigned*)((const unsigned char*)Y + slot * DM) + lane;
#pragma unroll
                    for (int j = 0; j < 4; ++j) { yw[q][k][j].x = yr[64 * j]; yw[q][k][j].y = 0u; } }
                else { const u32x2* yr = (const u32x2*)(Y + slot * DM) + lane;
#pragma unroll
                    for (int j = 0; j < 4; ++j) yw[q][k][j] = yr[64 * j]; } }
#pragma unroll
        for (int q = 0; q < CMB_Q; ++q) { const int t = tt[q]; f32x4 v[4];
#pragma unroll
            for (int j = 0; j < 4; ++j) { v[j].x = __uint_as_float(hw[q][j].x << 16); v[j].y = __uint_as_float(hw[q][j].x & 0xffff0000u); v[j].z = __uint_as_float(hw[q][j].y << 16); v[j].w = __uint_as_float(hw[q][j].y & 0xffff0000u);
#pragma unroll
                for (int k = 0; k < 4; ++k) { const u32x2 w = yw[q][k][j];
                    if (y8) { typedef float f32x2_ __attribute__((ext_vector_type(2))); const f32x2_ lo = __builtin_amdgcn_cvt_pk_f32_fp8((int)w.x, false), hi = __builtin_amdgcn_cvt_pk_f32_fp8((int)w.x, true); v[j].x += lo.x; v[j].y += lo.y; v[j].z += hi.x; v[j].w += hi.y; }
                    else { v[j].x += __uint_as_float(w.x << 16); v[j].y += __uint_as_float(w.x & 0xffff0000u); v[j].z += __uint_as_float(w.y << 16); v[j].w += __uint_as_float(w.y & 0xffff0000u); } } }
            float s = 0.f; u32x2* o = (u32x2*)(hout + (size_t)t * DM) + lane;
#pragma unroll
            for (int j = 0; j < 4; ++j) { u32x2 w; w.x = pkb(v[j].x, v[j].y); w.y = pkb(v[j].z, v[j].w); o[64 * j] = w;
                if (hout8) { unsigned p = 0u; p = __builtin_amdgcn_cvt_pk_fp8_f32(v[j].x, v[j].y, p, false); p = __builtin_amdgcn_cvt_pk_fp8_f32(v[j].z, v[j].w, p, true); ((unsigned*)(hout8 + (size_t)t * DM))[lane + 64 * j] = p; }
                const float q0 = __uint_as_float(w.x << 16), q1 = __uint_as_float(w.x & 0xffff0000u), q2 = __uint_as_float(w.y << 16), q3 = __uint_as_float(w.y & 0xffff0000u); s += (q0 * q0 + q1 * q1) + (q2 * q2 + q3 * q3); }
            s = lwave_sum(s, lane); if (lane == 0) rstd[t] = rsqrtf(s * (1.f / DM) + EPS); }
    }
}
__device__ __forceinline__ void final_phase(Frame& F, const bf16_t* hb, const float* SS, const float* g, float* out) {
    const int gw = F.vcu * MK_WAVES + F.wave, NGW = F.G * MK_WAVES, lane = F.lane;
    f32x4 gg[4];
#pragma unroll
    for (int j = 0; j < 4; ++j) gg[j] = ((const f32x4*)g)[lane + 64 * j];
    for (int row0 = gw; row0 < NTOK; row0 += 4 * NGW) {
        u32x2 w[4][4]; float ss[4]; int rr[4];
#pragma unroll
        for (int q = 0; q < 4; ++q) { rr[q] = (row0 + q * NGW < NTOK) ? row0 + q * NGW : row0; const u32x2* p = (const u32x2*)(hb + (size_t)rr[q] * DM) + lane;
#pragma unroll
            for (int j = 0; j < 4; ++j) w[q][j] = p[64 * j];
            ss[q] = (lane < 16) ? SS[(size_t)rr[q] * 16 + lane] : 0.f; }
#pragma unroll
        for (int q = 0; q < 4; ++q) { const float rs = rsqrtf(lwave_sum(ss[q], lane) * (1.f / DM) + EPS); f32x4* o = (f32x4*)(out + (size_t)rr[q] * DM) + lane;
#pragma unroll
            for (int j = 0; j < 4; ++j) { f32x4 v; v.x = __uint_as_float(w[q][j].x << 16); v.y = __uint_as_float(w[q][j].x & 0xffff0000u); v.z = __uint_as_float(w[q][j].y << 16); v.w = __uint_as_float(w[q][j].y & 0xffff0000u); o[64 * j] = v * rs * gg[j]; } }
    }
}
__device__ __forceinline__ void fox_head(Frame& F, unsigned char* lds_generic, int bh, const bf16_t* Q, const bf16_t* K, const bf16_t* V, const float* FL, bf16_t* O) {
    int tid_ = threadIdx.x; asm volatile("" : "+v"(tid_));
    const int lane = tid_ & 63, b = bh / NH, hh = bh % NH; const size_t rowb = (size_t)b * SEQ;
    LAS float* cbL = (LAS float*)(F.lds + attn_body::ATTN_LDS_BYTES); LAS float* wtot = cbL + SEQ;
    {
        float loc[4]; float run = 0.f;
#pragma unroll
        for (int i = 0; i < 4; ++i) { run += log_sigmoid(FL[(size_t)(rowb + tid_ * 4 + i) * NH + hh]); loc[i] = run; }
        float incl = run;
#pragma unroll
        for (int o = 1; o < 64; o <<= 1) { const float t = lperm(incl, lane - o); if (lane >= o) incl += t; }
        if (lane == 63) wtot[F.wave] = incl;
        __syncthreads();
        float base = incl - run;
        for (int w = 0; w < F.wave; ++w) base += wtot[w];
#pragma unroll
        for (int i = 0; i < 4; ++i) cbL[tid_ * 4 + i] = -(base + loc[i]) * LOG2E;
        __syncthreads();
    }
    for (int qb = 0; qb < SEQ / 256; ++qb)
        attn_body::attn_unit<8>(b, hh, qb, (const attn_body::bf16*)Q, (const attn_body::bf16*)K, (const attn_body::bf16*)V, (attn_body::bf16*)O, (char*)lds_generic, cbL);
}
constexpr int N_PHASES = 18;
__global__ void __launch_bounds__(MK_WAVES * 64, 2) mega_fwd(MArgs args) {
    extern __shared__ __attribute__((aligned(16))) unsigned char lds_raw[];
    Frame F;
    F.lds = (LAS unsigned char*)lds_raw;
    F.tid = threadIdx.x; F.lane = F.tid & 63; F.wave = __builtin_amdgcn_readfirstlane(F.tid >> 6);
    F.G = gridDim.x; { const int bx = blockIdx.x; F.vcu = (F.G % 8 == 0) ? (bx % 8) * (F.G / 8) + bx / 8 : bx; }
    F.ws = args.ws; F.ctl = (unsigned*)(args.ws + WS_CTL);
    unsigned char* ws = args.ws;
    for (int u = F.tid; u < (MK_LDS_BYTES - LDSCTL_OFF) / 4; u += MK_WAVES * 64) ((LAS unsigned*)(F.lds + LDSCTL_OFF))[u] = 0u;
    __syncthreads();
    const int lo = args.ph_lo, hi = args.ph_hi;
    const bool use_bar = (hi - lo) > 1;
    XcdBarrier bar; bar.bar = F.ctl + CW_BAR; bar.x = 0; bar.st = nullptr;
    if (use_bar) bar = xcd_barrier_post(F.ctl + CW_BAR, (volatile LAS unsigned*)(F.lds + LDSCTL_OFF + 32));
#ifndef MK_DUP
#define MK_DUP 0
#endif
#define NREP(j) (((MK_DUP >> (j)) & 1) ? 2 : 1)
#ifndef MK_QKVPROBE
#define MK_QKVPROBE 0
#endif
#ifndef MK_NSB
#define MK_NSB 5
#endif
#ifndef MK_Y8_MASK
#define MK_Y8_MASK 3
#endif
#ifndef MK_ATTSUB
#define MK_ATTSUB 3
#endif
#ifndef MK_P0SUB
#define MK_P0SUB 7
#endif
#ifndef MK_PHMASK
#define MK_PHMASK 0x3ff
#endif
#define IN(k) (lo <= (k) && (k) < hi)
#define EN(j) ((MK_PHMASK >> (j)) & 1)
#define PHASE_BEGIN() do { int t_ = threadIdx.x; asm volatile("" : "+v"(t_)); F.tid = t_; F.lane = t_ & 63; } while (0)
#define SEAM(k) do { if (IN(k) && IN((k) + 1)) xcd_barrier(bar); } while (0)
    bf16_t* const HB0 = (bf16_t*)(ws + WS_HB); bf16_t* const HB1 = (bf16_t*)(ws + WS_HB2); float* const SS = (float*)(ws + WS_SS);
    bf16_t* const Qb = (bf16_t*)(ws + WS_Q); bf16_t* const Kb = (bf16_t*)(ws + WS_K); bf16_t* const Vb = (bf16_t*)(ws + WS_V); bf16_t* const Ob = (bf16_t*)(ws + WS_O);
    float* const rstd_moe = (float*)(ws + WS_RSTD) + NTOK; float* const rstd_ple = rstd_moe + NTOK;
    int* const tok_of = (int*)(ws + WS_TOK); float* const gate_of = (float*)(ws + WS_GATE); unsigned* const pair = (unsigned*)(ws + WS_PAIR);
    bf16_t* const ACT = (bf16_t*)(ws + WS_ACT); bf16_t* const Yb = (bf16_t*)(ws + WS_Y); float* const FL = (float*)(ws + WS_FL);
    LAS int* const tstartL = (LAS int*)(F.lds + TBL_OFF); LAS int* const cntL = tstartL + 64; LAS unsigned short* const tokL = (LAS unsigned short*)(F.lds + TOK_OFF); LAS float* const rowL = (LAS float*)(F.lds + ROW_OFF);

    if (EN(8) && IN(0)) { for (int rep_ = 0; rep_ < NREP(8); ++rep_) p0_prologue(F, args); }
    SEAM(0);
    for (int L = 0; L < DEPTH; ++L) {
        const int pb = 1 + 8 * L;
        unsigned* const cnt = F.ctl + CW_CNT2 + 2048 * L;
        const bool f8 = (L == 0) ? bool(MK_FP8_MASK & 1) : bool(MK_FP8_MASK & 2);
        bf16_t* const HBa = (L & 1) ? HB1 : HB0; bf16_t* const HBb = (L & 1) ? HB0 : HB1;
        if (EN(0) && IN(pb + 0)) for (int rep_ = 0; rep_ < NREP(0); ++rep_) { PHASE_BEGIN();
            if (MK_P0SUB & 1) if (L == 1) fgate_phase(F, HBa, (const bf16_t*)(ws + WS_WF), args.in[5], SS, FL);
            if (MK_P0SUB & 2) { pg8::DenseOrder S; S.init(NTOK, 3 * DM, F.G, (int)blockIdx.x); pg8::EpiQKV E{Qb, rowL, 0}; pg8::EpiQKV Ep{Qb, rowL, MK_QKVPROBE};
              _Pragma("clang loop unroll(disable)") for (int i0 = 0; i0 < TOK_UNITS; i0 += 2) { const int i = i0 + (F.wave >> 2); pg8::Unit u; if (S.next(i, u)) { const int lr = F.tid & 255; const f32x4* sp = (const f32x4*)(SS + (size_t)(u.arow0 + lr) * 16);
                  const f32x4 s0 = sp[0], s1 = sp[1], s2 = sp[2], s3 = sp[3]; const float ss = ((s0.x + s0.y) + (s0.z + s0.w)) + ((s1.x + s1.y) + (s1.z + s1.w)) + ((s2.x + s2.y) + (s2.z + s2.w)) + ((s3.x + s3.y) + (s3.z + s3.w));
                  rowL[i * 256 + lr] = rsqrtf(ss * (1.f / DM) + EPS); } }
              __syncthreads();
              if (NREP(13) > 1) pg8::gemm_phase(F.lds, HBa, (const bf16_t*)(ws + WS_WQKV) + (size_t)L * 3 * DM * DM, 2 * DM, S, E, true);
              if (NREP(14) > 1) pg8::gemm_phase(F.lds, HBa, (const bf16_t*)(ws + WS_WQKV) + (size_t)L * 3 * DM * DM, 2 * DM, S, Ep, false);
              if (NREP(15) > 1) { pg8::HotOrder Sh; Sh.d = S; pg8::gemm_phase(F.lds, HBa, (const bf16_t*)(ws + WS_WQKV) + (size_t)L * 3 * DM * DM, 2 * DM, Sh, Ep, false); }
              pg8::gemm_phase(F.lds, HBa, (const bf16_t*)(ws + WS_WQKV) + (size_t)L * 3 * DM * DM, 2 * DM, S, E); }
            if (MK_P0SUB & 4) if (L == 0) { pg8::PJOrder S; S.init(F.G, (int)blockIdx.x); pg8::EpiPJ E{(bf16_t*)(ws + WS_PJ)};
                pg8::gemm_phase(F.lds, (const bf16_t*)(ws + WS_PB), (const bf16_t*)(ws + WS_WP), 2 * PLE, S, E); }
        }
        SEAM(pb + 0);
        if (EN(1) && IN(pb + 1)) for (int rep_ = 0; rep_ < (NREP(1) > 1 ? 2 : (L == 0 ? NREP(10) : NREP(11))); ++rep_) { PHASE_BEGIN();
            if (L == 0) {
                if (F.wave < MK_NSB) { if (MK_ATTSUB & 1) for (int bh = blockIdx.x; bh < NB * NH; bh += F.G) sb_body::sb_head(F.lds, bh, Qb, Kb, Vb, Ob); }
                else p0_big(F, args, F.wave - MK_NSB, MK_WAVES - MK_NSB, (LAS float*)(F.lds + MK_NSB * 16384 + (F.wave - MK_NSB) * 16896));
            }
            else { if (MK_ATTSUB & 2) for (int bh = blockIdx.x; bh < NB * NH; bh += F.G) { fox_head(F, lds_raw, bh, Qb, Kb, Vb, FL, Ob); __syncthreads(); } }
        }
        SEAM(pb + 1);
        if (EN(2) && IN(pb + 2)) for (int rep_ = NREP(2) - 1; rep_ >= 0; --rep_) { PHASE_BEGIN();
            pg8::DenseOrder S; S.init(NTOK, DM, F.G, (int)blockIdx.x); pg8::EpiWo E{HBa, rep_ ? (bf16_t*)(ws + WS_ACT + 128 * MiB) : HBb, f8 ? (rep_ ? ws + WS_ACT + 210 * MiB : ws + WS_HB8) : nullptr};
            pg8::gemm_phase(F.lds, Ob, (const bf16_t*)(ws + WS_WO) + (size_t)L * DM * DM, 2 * DM, S, E);
        }
        SEAM(pb + 2);
        if (EN(3) && IN(pb + 3)) for (int rep_ = NREP(3) - 1; rep_ >= 0; --rep_) { PHASE_BEGIN(); unsigned char* dd = ws + WS_ACT + 192 * MiB;
            if (rep_) router_phase(F, HBb, (const bf16_t*)(ws + WS_WR) + (size_t)L * NE * DM, args.in[9] + L * NE, (float*)(dd + 9 * MiB), F.ctl + CW_CNT2 + 4096 + 2048 * L, (int*)dd, (float*)(dd + 4 * MiB), (unsigned*)(dd + 8 * MiB));
            else router_phase(F, HBb, (const bf16_t*)(ws + WS_WR) + (size_t)L * NE * DM, args.in[9] + L * NE, rstd_moe, cnt, tok_of, gate_of, pair); }
        SEAM(pb + 3);
        if (EN(4) && IN(pb + 4)) for (int rep_ = (NREP(4) > 1 || NREP(12) > 1) ? 1 : 0; rep_ >= 0; --rep_) { PHASE_BEGIN(); const bool skip_ = rep_ && NREP(12) > 1;
            moe_tables(F, cnt);
            pg8::MoeOrder S; S.NN = 8; S.nwg = tstartL[NE] * 8; S.G = F.G; S.c = (int)blockIdx.x; S.lane = F.lane; S.tstartL = tstartL; S.cntL = cntL; S.tokL = tokL; S.gather = true;
            _Pragma("clang loop unroll(disable)") for (int k0 = 0; k0 < TOK_UNITS / 2; k0 += 3) {
                int tokv[3]; float rsv[3]; bool okv[3]; const int lr = F.tid & 255;
#pragma unroll
                for (int k = 0; k < 3; ++k) { pg8::Unit u; okv[k] = S.next(2 * (k0 + k) + (F.wave >> 2), u); const int rk = u.rank0 + lr; tokv[k] = okv[k] ? tok_of[(size_t)u.e * CAP + (rk < u.cnt ? rk : u.rank0)] : 0; }
#pragma unroll
                for (int k = 0; k < 3; ++k) rsv[k] = okv[k] ? rstd_moe[tokv[k]] : 0.f;
#pragma unroll
                for (int k = 0; k < 3; ++k) if (okv[k]) { const int i = 2 * (k0 + k) + (F.wave >> 2); tokL[i * 256 + lr] = (unsigned short)tokv[k]; rowL[i * 256 + lr] = rsv[k] * (f8 ? W8INV : 1.f); }
            }
            __syncthreads();
            if (f8) { pg8::EpiGU<true> E{ws + WS_ACT8, args.in[11] + (size_t)L * NE * 2 * FF, rowL};
                pg8::gemm_phase<pg8::EpiGU<true>, pg8::MoeOrder, true>(F.lds, ws + WS_HB8, ws + WS_WGU8 + (size_t)L * NE * 2 * FF * DM, DM, S, E, skip_); }
            else { pg8::EpiGU<false> E{ACT, args.in[11] + (size_t)L * NE * 2 * FF, rowL};
                pg8::gemm_phase(F.lds, HBb, (const bf16_t*)(ws + WS_WGU) + (size_t)L * NE * 2 * FF * DM, 2 * DM, S, E); }
        }
        SEAM(pb + 4);
        if (EN(5) && IN(pb + 5)) for (int rep_ = 0; rep_ < NREP(5); ++rep_) { PHASE_BEGIN();
            moe_tables(F, cnt);
            pg8::MoeOrder S; S.NN = 4; S.nwg = tstartL[NE] * 4; S.G = F.G; S.c = (int)blockIdx.x; S.lane = F.lane; S.tstartL = tstartL; S.cntL = cntL; S.tokL = tokL; S.gather = false;
            _Pragma("clang loop unroll(disable)") for (int k0 = 0; k0 < 6; k0 += 3) {
                float gv[3]; bool okv[3]; const int lr = F.tid & 255;
#pragma unroll
                for (int k = 0; k < 3; ++k) { pg8::Unit u; okv[k] = S.next(2 * (k0 + k) + (F.wave >> 2), u); const int rk = u.rank0 + lr; gv[k] = (okv[k] && rk < u.cnt) ? gate_of[(size_t)u.e * CAP + rk] : 0.f; }
#pragma unroll
                for (int k = 0; k < 3; ++k) if (okv[k]) rowL[(2 * (k0 + k) + (F.wave >> 2)) * 256 + lr] = gv[k] * (f8 ? W8INV : 1.f);
            }
            __syncthreads();
            const bool y8 = (MK_Y8_MASK >> L) & 1;
            pg8::EpiDown E{Yb, args.in[13] + (size_t)L * NE * DM, rowL, f8 ? W8SCALE : 1.f, y8};
            if (f8) pg8::gemm_phase<pg8::EpiDown, pg8::MoeOrder, true>(F.lds, ws + WS_ACT8, ws + WS_WD8 + (size_t)L * NE * DM * FF, FF, S, E);
            else pg8::gemm_phase(F.lds, ACT, (const bf16_t*)(ws + WS_WD) + (size_t)L * NE * DM * FF, 2 * FF, S, E);
        }
        SEAM(pb + 5);
        if (EN(6) && IN(pb + 6)) for (int rep_ = NREP(6) - 1; rep_ >= 0; --rep_) { PHASE_BEGIN(); moe_tables(F, cnt);
            if (rep_) combine_phase(F, HBb, (bf16_t*)(ws + WS_ACT + 128 * MiB), nullptr, (float*)(ws + WS_ACT + 201 * MiB), pair, Yb, (MK_Y8_MASK >> L) & 1);
            else combine_phase(F, HBb, HBa, MK_PLE8 ? ws + WS_HB8 : nullptr, rstd_ple, pair, Yb, (MK_Y8_MASK >> L) & 1); }
        SEAM(pb + 6);
        if (EN(7) && IN(pb + 7)) for (int rep_ = NREP(7) - 1; rep_ >= 0; --rep_) { PHASE_BEGIN();
            pg8::DenseOrder S; S.init(NTOK, DM, F.G, (int)blockIdx.x);
            pg8::EpiPLE E{HBa, rep_ ? (bf16_t*)(ws + WS_ACT + 128 * MiB) : HBb, (const bf16_t*)(ws + WS_PJ) + (size_t)L * NTOK * DM, rowL, rep_ ? (float*)(ws + WS_ACT + 202 * MiB) : SS};
            _Pragma("clang loop unroll(disable)") for (int i0 = 0; i0 < TOK_UNITS; i0 += 2) { const int i = i0 + (F.wave >> 2); pg8::Unit u; if (S.next(i, u)) { const int lr = F.tid & 255; rowL[i * 256 + lr] = rstd_ple[u.arow0 + lr] * (MK_PLE8 ? W8INV : 1.f); } }
            __syncthreads();
            if (MK_PLE8) pg8::gemm_phase<pg8::EpiPLE, pg8::DenseOrder, true>(F.lds, ws + WS_HB8, ws + WS_WG8 + (size_t)L * DM * DM, DM, S, E);
            else pg8::gemm_phase(F.lds, HBa, (const bf16_t*)(ws + WS_WG) + (size_t)L * DM * DM, 2 * DM, S, E);
        }
        SEAM(pb + 7);
    }
    if (EN(9) && IN(17)) for (int rep_ = 0; rep_ < NREP(9); ++rep_) { PHASE_BEGIN(); final_phase(F, HB0, SS, args.in[17], args.out); }
#undef IN
#undef SEAM
}
#define MK_MODE 2

#ifndef MK_MODE
#define MK_MODE 2
#endif
extern "C" void kernel_launch(void* const* d_in, const int* in_sizes, int n_in, void* d_out, int out_size, void* d_ws, size_t ws_size, hipStream_t stream) {
    if (n_in != 18 || in_sizes[0] != NTOK * DM || out_size != NTOK * DM || ws_size < WS_END2) { fprintf(stderr, "kernel_launch: unexpected shapes / workspace (%d inputs, ws %zu, need %zu)\n", n_in, ws_size, (size_t)WS_END2); return; }
    unsigned char* ws = (unsigned char*)d_ws;
    (void)hipMemsetAsync(ws + WS_CTL, 0, 1 * MiB, stream);
#if MK_MODE != 0
    static int grid = 0;
    if (grid == 0) {
        int dev = 0, cus = 0, per_cu = 0;
        if (hipGetDevice(&dev) != hipSuccess || hipDeviceGetAttribute(&cus, hipDeviceAttributeMultiprocessorCount, dev) != hipSuccess) { fprintf(stderr, "kernel_launch: device query failed\n"); grid = -1; return; }
        if (hipFuncSetAttribute((const void*)mega_fwd, hipFuncAttributeMaxDynamicSharedMemorySize, MK_LDS_BYTES) != hipSuccess) { fprintf(stderr, "kernel_launch: hipFuncSetAttribute failed\n"); grid = -1; return; }
        if (hipOccupancyMaxActiveBlocksPerMultiprocessor(&per_cu, (const void*)mega_fwd, MK_WAVES * 64, MK_LDS_BYTES) != hipSuccess || per_cu < 1) fprintf(stderr, "kernel_launch: occupancy query reports %d\n", per_cu);
        (void)hipGetLastError();
        grid = cus;
        grid -= grid % 8;
    }
    if (grid <= 0) return;
    MArgs a{};
    for (int i = 0; i < 18; ++i) a.in[i] = (const float*)d_in[i];
    a.out = (float*)d_out; a.ws = ws;
#if MK_MODE == 2
    a.ph_lo = 0; a.ph_hi = N_PHASES;
    hipLaunchKernelGGL(mega_fwd, dim3(grid), dim3(MK_WAVES * 64), MK_LDS_BYTES, stream, a);
#else
    for (int ph = 0; ph < N_PHASES; ++ph) { a.ph_lo = ph; a.ph_hi = ph + 1; hipLaunchKernelGGL(mega_fwd, dim3(grid), dim3(MK_WAVES * 64), MK_LDS_BYTES, stream, a); }
#endif
    { const hipError_t le = hipPeekAtLastError(); if (le != hipSuccess) fprintf(stderr, "kernel_launch: launch failed: %s\n", hipGetErrorName(le)); }
#else
    const float* x = (const float*)d_in[0]; const float* p = (const float*)d_in[1]; const float* g_mix = (const float*)d_in[2]; const float* w_qkv = (const float*)d_in[3];
    const float* w_fgate = (const float*)d_in[4]; const float* b_fgate = (const float*)d_in[5]; const float* w_o = (const float*)d_in[6]; const float* g_moe = (const float*)d_in[7];
    const float* w_router = (const float*)d_in[8]; const float* b_router = (const float*)d_in[9]; const float* w_gu = (const float*)d_in[10]; const float* b_gu = (const float*)d_in[11];
    const float* w_down = (const float*)d_in[12]; const float* b_down = (const float*)d_in[13]; const float* g_ple = (const float*)d_in[14]; const float* w_ple_gate = (const float*)d_in[15];
    const float* w_ple_proj = (const float*)d_in[16]; const float* g_final = (const float*)d_in[17];
    unsigned* ctl = (unsigned*)(ws + WS_CTL);
    bf16_t *Wqkv = (bf16_t*)(ws + WS_WQKV), *Wo = (bf16_t*)(ws + WS_WO), *Wg = (bf16_t*)(ws + WS_WG), *Wp = (bf16_t*)(ws + WS_WP), *Wgu = (bf16_t*)(ws + WS_WGU), *Wd = (bf16_t*)(ws + WS_WD);
    float* H = (float*)(ws + WS_H); bf16_t *HB = (bf16_t*)(ws + WS_HB), *Q = (bf16_t*)(ws + WS_Q), *Kb = (bf16_t*)(ws + WS_K), *Vb = (bf16_t*)(ws + WS_V), *O = (bf16_t*)(ws + WS_O);
    bf16_t *PB = (bf16_t*)(ws + WS_PB), *PJ = (bf16_t*)(ws + WS_PJ), *ACT = (bf16_t*)(ws + WS_ACT), *Y = (bf16_t*)(ws + WS_Y);
    int* tok_of = (int*)(ws + WS_TOK); float* gate_of = (float*)(ws + WS_GATE); unsigned* pair = (unsigned*)(ws + WS_PAIR);
    float* rstd_mix = (float*)(ws + WS_RSTD); float* rstd_moe = rstd_mix + NTOK; float* rstd_ple = rstd_moe + NTOK;
    float* FL = (float*)(ws + WS_FL); float* CB = (float*)(ws + WS_CB);
    for (int i = 0; i < DEPTH; ++i) {
        k_cvt_t<0><<<dim3(3 * DM / 64, DM / 64, 1), 256, 0, stream>>>(w_qkv + (size_t)i * DM * 3 * DM, g_mix + i * DM, Wqkv + (size_t)i * 3 * DM * DM, DM, 3 * DM);
        k_cvt_t<0><<<dim3(DM / 64, DM / 64, 1), 256, 0, stream>>>(w_o + (size_t)i * DM * DM, nullptr, Wo + (size_t)i * DM * DM, DM, DM);
        k_cvt_t<0><<<dim3(DM / 64, DM / 64, 1), 256, 0, stream>>>(w_ple_gate + (size_t)i * DM * DM, g_ple + i * DM, Wg + (size_t)i * DM * DM, DM, DM);
        k_cvt_t<0><<<dim3(DM / 64, PLE / 64, 1), 256, 0, stream>>>(w_ple_proj + (size_t)i * PLE * DM, nullptr, Wp + (size_t)i * DM * PLE, PLE, DM);
        k_cvt_t<1><<<dim3(2 * FF / 64, DM / 64, NE), 256, 0, stream>>>(w_gu + (size_t)i * NE * DM * 2 * FF, g_moe + i * DM, Wgu + (size_t)i * NE * 2 * FF * DM, DM, 2 * FF);
        k_cvt_t<0><<<dim3(DM / 64, FF / 64, NE), 256, 0, stream>>>(w_down + (size_t)i * NE * FF * DM, nullptr, Wd + (size_t)i * NE * DM * FF, FF, DM);
    }
    k_cvt<<<(unsigned)((size_t)DEPTH * NTOK * PLE / 4 / 256), 256, 0, stream>>>(p, PB, (size_t)DEPTH * NTOK * PLE / 4);
    for (int i = 0; i < DEPTH; ++i)
        k_gemm_pj<<<dim3(DM / 64, NTOK / 64), 64, 0, stream>>>(PB + (size_t)i * NTOK * PLE, Wp + (size_t)i * DM * PLE, PJ + (size_t)i * NTOK * DM);
    k_rowstat<<<NTOK / 4, 256, 0, stream>>>(x, HB, rstd_mix);
    for (int i = 0; i < DEPTH; ++i) {
        const float* hin = (i == 0) ? x : H;
        k_gemm_qkv<<<dim3(3 * DM / 64, NTOK / 64), 64, 0, stream>>>(HB, Wqkv + (size_t)i * 3 * DM * DM, rstd_mix, Q);
        if (i == 0) k_attn_sb<<<NB * NH * SEQ / 4, 256, 0, stream>>>(Q, Kb, Vb, O);
        else {
            k_fgate<<<NTOK / 4, 256, 0, stream>>>(hin, g_mix + i * DM, w_fgate, b_fgate, rstd_mix, FL);
            k_scan<<<NB * NH, 64, 0, stream>>>(FL, CB);
            k_attn_fox<<<NB * NH * SEQ / 4, 256, 0, stream>>>(Q, Kb, Vb, CB, O);
        }
        k_gemm_wo<<<dim3(DM / 64, NTOK / 64), 64, 0, stream>>>(O, Wo + (size_t)i * DM * DM, hin, H, HB);
        unsigned* cnt = ctl + CW_CNT + 64 * i;
        k_router<<<NTOK / 4, 256, 0, stream>>>(H, g_moe + i * DM, w_router + (size_t)i * DM * NE, b_router + i * NE, rstd_moe, cnt, tok_of, gate_of, pair);
        k_gemm_gu<<<dim3(FF / 64, MAXT * 4), 64, 0, stream>>>(HB, Wgu + (size_t)i * NE * 2 * FF * DM, b_gu + (size_t)i * NE * 2 * FF, rstd_moe, cnt, tok_of, ACT);
        k_gemm_down<<<dim3(DM / 64, MAXT * 4), 64, 0, stream>>>(ACT, Wd + (size_t)i * NE * DM * FF, b_down + (size_t)i * NE * DM, cnt, gate_of, Y);
        k_combine<<<NTOK / 4, 256, 0, stream>>>(H, HB, rstd_ple, cnt, pair, Y);
        k_gemm_ple<<<dim3(DM / 64, NTOK / 64), 64, 0, stream>>>(HB, Wg + (size_t)i * DM * DM, rstd_ple, PJ + (size_t)i * NTOK * DM, H, HB);
        if (i + 1 < DEPTH) k_rowstat<<<NTOK / 4, 256, 0, stream>>>(H, HB, rstd_mix);
    }
    k_final<<<NTOK / 4, 256, 0, stream>>>(H, g_final, (float*)d_out);
#endif
}
```

```cpp
#define MK_DUP 0
#define MK_FP8_MASK 3
#include <hip/hip_runtime.h>
#include <cstdio>
#include <cstdint>

typedef unsigned short bf16_t;
typedef short bf16x8 __attribute__((ext_vector_type(8)));
typedef float f32x4 __attribute__((ext_vector_type(4)));
typedef float f32x16 __attribute__((ext_vector_type(16)));
typedef unsigned u32x4 __attribute__((ext_vector_type(4)));
typedef unsigned u32x2 __attribute__((ext_vector_type(2)));

constexpr int NTOK = 32768, DM = 1024, SEQ = 2048, NB = 16, NH = 16, HD = 64, NE = 32, TOPK = 4, FF = 1024, PLE = 256, DEPTH = 2;
constexpr int CAP = NTOK;
constexpr int MAXT = 544;
constexpr int NSLOT = MAXT * 256;
constexpr float EPS = 1e-6f;
constexpr float LOG2E = 1.4426950408889634f;
constexpr float C2 = 0.125f * LOG2E;

constexpr size_t MiB = 1u << 20;
constexpr size_t WS_CTL = 0;
constexpr size_t WS_WQKV = 2 * MiB;
constexpr size_t WS_WO = WS_WQKV + 12 * MiB;
constexpr size_t WS_WG = WS_WO + 4 * MiB;
constexpr size_t WS_WP = WS_WG + 4 * MiB;
constexpr size_t WS_WGU = WS_WP + 2 * MiB;
constexpr size_t WS_WD = WS_WGU + 256 * MiB;
constexpr size_t WS_H = WS_WD + 128 * MiB;
constexpr size_t WS_HB = WS_H + 128 * MiB;
constexpr size_t WS_Q = WS_HB + 64 * MiB;
constexpr size_t WS_K = WS_Q + 64 * MiB;
constexpr size_t WS_V = WS_K + 64 * MiB;
constexpr size_t WS_O = WS_V + 64 * MiB;
constexpr size_t WS_PB = WS_O + 64 * MiB;
constexpr size_t WS_PJ = WS_PB + 32 * MiB;
constexpr size_t WS_ACT = WS_PJ + 128 * MiB;
constexpr size_t WS_Y = WS_ACT + 272 * MiB;
constexpr size_t WS_TOK = WS_Y + 272 * MiB;
constexpr size_t WS_GATE = WS_TOK + 4 * MiB;
constexpr size_t WS_PAIR = WS_GATE + 4 * MiB;
constexpr size_t WS_RSTD = WS_PAIR + 1 * MiB;
constexpr size_t WS_FL = WS_RSTD + 1 * MiB;
constexpr size_t WS_CB = WS_FL + 2 * MiB;
constexpr size_t WS_END = WS_CB + 2 * MiB;
constexpr int CW_CNT = 64;

__device__ __forceinline__ float bf2f(bf16_t v) { return __uint_as_float((unsigned)v << 16); }
__device__ __forceinline__ unsigned f2bf(float f) { unsigned u = __float_as_uint(f); return (u + 0x7fffu + ((u >> 16) & 1u)) >> 16; }
__device__ __forceinline__ unsigned pk2(float lo, float hi) { return f2bf(lo) | (f2bf(hi) << 16); }
__device__ __forceinline__ float wave_sum(float v) {
#pragma unroll
    for (int o = 1; o < 64; o <<= 1) v += __shfl_xor(v, o);
    return v;
}
__device__ __forceinline__ float wave_max(float v) {
#pragma unroll
    for (int o = 1; o < 64; o <<= 1) v = fmaxf(v, __shfl_xor(v, o));
    return v;
}
__device__ __forceinline__ int crow(int r, int hi) { return (r & 3) + 8 * (r >> 2) + 4 * hi; }
__device__ __forceinline__ float sigmoidf_(float x) { return 1.f / (1.f + __expf(-x)); }
__device__ __forceinline__ float log_sigmoid(float x) { return fminf(x, 0.f) - log1pf(__expf(-fabsf(x))); }

struct MoeTile { int e, rank0, cnt, tstart; bool ok; };
__device__ __forceinline__ MoeTile moe_tile(const unsigned* cnt, int T) {
    const int lane = threadIdx.x & 63;
    const int c = (lane < NE) ? (int)cnt[lane] : 0;
    const int nt = (c + 255) >> 8;
    int incl = nt;
#pragma unroll
    for (int o = 1; o < 32; o <<= 1) { int t = __shfl_up(incl, o); if ((lane & 31) >= o) incl += t; }
    const int excl = incl - nt;
    const unsigned long long m = __ballot(lane < NE && excl <= T && nt > 0 && T < incl);
    MoeTile r; r.ok = (m != 0ull);
    const int e = r.ok ? (int)__builtin_ctzll(m) : 0;
    r.e = e; r.tstart = __shfl(excl, e); r.cnt = __shfl(c, e); r.rank0 = (T - r.tstart) * 256;
    return r;
}
__device__ __forceinline__ int moe_tstart(const unsigned* cnt, int e) {
    const int lane = threadIdx.x & 63;
    const int c = (lane < NE) ? (int)cnt[lane] : 0;
    const int nt = (c + 255) >> 8;
    int incl = nt;
#pragma unroll
    for (int o = 1; o < 32; o <<= 1) { int t = __shfl_up(incl, o); if ((lane & 31) >= o) incl += t; }
    return __shfl(incl - nt, e);
}

__global__ void __launch_bounds__(256) k_rowstat(const float* __restrict__ h, bf16_t* __restrict__ hb, float* __restrict__ rstd) {
    const int lane = threadIdx.x & 63, row = blockIdx.x * 4 + (threadIdx.x >> 6);
    const f32x4* p = (const f32x4*)(h + (size_t)row * DM) + lane;
    f32x4 v[4]; float s = 0.f;
#pragma unroll
    for (int j = 0; j < 4; ++j) { v[j] = p[64 * j]; s += v[j].x * v[j].x + v[j].y * v[j].y + v[j].z * v[j].z + v[j].w * v[j].w; }
    s = wave_sum(s);
    if (lane == 0) rstd[row] = rsqrtf(s * (1.f / DM) + EPS);
    u32x2* o = (u32x2*)(hb + (size_t)row * DM) + lane;
#pragma unroll
    for (int j = 0; j < 4; ++j) { u32x2 w; w.x = pk2(v[j].x, v[j].y); w.y = pk2(v[j].z, v[j].w); o[64 * j] = w; }
}
__global__ void __launch_bounds__(256) k_cvt(const float* __restrict__ s, bf16_t* __restrict__ d, size_t n4) {
    size_t i = (size_t)blockIdx.x * 256 + threadIdx.x;
    if (i < n4) { f32x4 v = ((const f32x4*)s)[i]; u32x2 w; w.x = pk2(v.x, v.y); w.y = pk2(v.z, v.w); ((u32x2*)d)[i] = w; }
}
template <int MODE>
__global__ void __launch_bounds__(256) k_cvt_t(const float* __restrict__ src, const float* __restrict__ g, bf16_t* __restrict__ dst, int K, int N) {
    __shared__ float tile[64][65];
    const int n0 = blockIdx.x * 64, k0 = blockIdx.y * 64, b = blockIdx.z, tid = threadIdx.x;
    const float* s = src + (size_t)b * K * N; bf16_t* d = dst + (size_t)b * K * N;
#pragma unroll
    for (int i = 0; i < 16; ++i) { const int kk = i * 4 + (tid >> 6), nn = tid & 63; const float gg = g ? g[k0 + kk] : 1.f; tile[kk][nn] = s[(size_t)(k0 + kk) * N + n0 + nn] * gg; }
    __syncthreads();
#pragma unroll
    for (int j = 0; j < 2; ++j) {
        const int c = tid + 256 * j, n = c >> 3, kc = c & 7;
        u32x4 w; w.x = pk2(tile[kc * 8 + 0][n], tile[kc * 8 + 1][n]); w.y = pk2(tile[kc * 8 + 2][n], tile[kc * 8 + 3][n]);
        w.z = pk2(tile[kc * 8 + 4][n], tile[kc * 8 + 5][n]); w.w = pk2(tile[kc * 8 + 6][n], tile[kc * 8 + 7][n]);
        int nn = n0 + n;
        if (MODE == 1) { const int half = nn / FF, j2 = nn % FF; nn = (j2 >> 7) * 256 + half * 128 + (j2 & 127); }
        *(u32x4*)(d + (size_t)nn * K + k0 + kc * 8) = w;
    }
}

template <bool DUAL>
__device__ __forceinline__ void gemm_tile64(const bf16_t* a0, const bf16_t* a1, const bf16_t* B1, const bf16_t* B2, int K, f32x16 (&acc)[2][2], f32x16 (&acc2)[2][2]) {
    const int lane = threadIdx.x & 63, r32 = lane & 31, hi = lane >> 5;
    const bf16_t* b0 = B1 + (size_t)r32 * K + 8 * hi; const bf16_t* b1 = B1 + (size_t)(32 + r32) * K + 8 * hi;
    const bf16_t* c0 = DUAL ? B2 + (size_t)r32 * K + 8 * hi : nullptr; const bf16_t* c1 = DUAL ? B2 + (size_t)(32 + r32) * K + 8 * hi : nullptr;
    a0 += 8 * hi; a1 += 8 * hi;
#pragma unroll
    for (int i = 0; i < 2; ++i)
#pragma unroll
        for (int j = 0; j < 2; ++j) { acc[i][j] = f32x16{}; acc2[i][j] = f32x16{}; }
    for (int k = 0; k < K; k += 16) {
        const bf16x8 fa0 = *(const bf16x8*)(a0 + k), fa1 = *(const bf16x8*)(a1 + k), fb0 = *(const bf16x8*)(b0 + k), fb1 = *(const bf16x8*)(b1 + k);
        acc[0][0] = __builtin_amdgcn_mfma_f32_32x32x16_bf16(fa0, fb0, acc[0][0], 0, 0, 0);
        acc[0][1] = __builtin_amdgcn_mfma_f32_32x32x16_bf16(fa0, fb1, acc[0][1], 0, 0, 0);
        acc[1][0] = __builtin_amdgcn_mfma_f32_32x32x16_bf16(fa1, fb0, acc[1][0], 0, 0, 0);
        acc[1][1] = __builtin_amdgcn_mfma_f32_32x32x16_bf16(fa1, fb1, acc[1][1], 0, 0, 0);
        if (DUAL) {
            const bf16x8 fc0 = *(const bf16x8*)(c0 + k), fc1 = *(const bf16x8*)(c1 + k);
            acc2[0][0] = __builtin_amdgcn_mfma_f32_32x32x16_bf16(fa0, fc0, acc2[0][0], 0, 0, 0);
            acc2[0][1] = __builtin_amdgcn_mfma_f32_32x32x16_bf16(fa0, fc1, acc2[0][1], 0, 0, 0);
            acc2[1][0] = __builtin_amdgcn_mfma_f32_32x32x16_bf16(fa1, fc0, acc2[1][0], 0, 0, 0);
            acc2[1][1] = __builtin_amdgcn_mfma_f32_32x32x16_bf16(fa1, fc1, acc2[1][1], 0, 0, 0);
        }
    }
}
#define TILE_FOREACH(...) _Pragma("unroll") for (int mi = 0; mi < 2; ++mi) _Pragma("unroll") for (int ni = 0; ni < 2; ++ni) _Pragma("unroll") for (int r = 0; r < 16; ++r) { \
        const int lrow = 32 * mi + crow(r, hi), lcol = 32 * ni + r32; const float v = acc[mi][ni][r]; const float v2 = acc2[mi][ni][r]; (void)v2; __VA_ARGS__ }

__global__ void __launch_bounds__(64) k_gemm_qkv(const bf16_t* __restrict__ A, const bf16_t* __restrict__ Bt, const float* __restrict__ rstd, bf16_t* __restrict__ Q) {
    const int lane = threadIdx.x, r32 = lane & 31, hi = lane >> 5; const int m0 = blockIdx.y * 64, n0 = blockIdx.x * 64;
    f32x16 acc[2][2], acc2[2][2];
    gemm_tile64<false>(A + (size_t)(m0 + r32) * DM, A + (size_t)(m0 + 32 + r32) * DM, Bt + (size_t)n0 * DM, nullptr, DM, acc, acc2);
    const int t = n0 / DM; bf16_t* out = Q + (size_t)t * ((WS_K - WS_Q) / 2); const float sc = (t == 0) ? C2 : 1.f;
    TILE_FOREACH({ const int row = m0 + lrow, col = n0 - t * DM + lcol; out[(size_t)row * DM + col] = (bf16_t)f2bf(v * rstd[row] * sc); })
}
__global__ void __launch_bounds__(64) k_gemm_wo(const bf16_t* __restrict__ A, const bf16_t* __restrict__ Bt, const float* hin, float* hout, bf16_t* __restrict__ hb) {
    const int lane = threadIdx.x, r32 = lane & 31, hi = lane >> 5; const int m0 = blockIdx.y * 64, n0 = blockIdx.x * 64;
    f32x16 acc[2][2], acc2[2][2];
    gemm_tile64<false>(A + (size_t)(m0 + r32) * DM, A + (size_t)(m0 + 32 + r32) * DM, Bt + (size_t)n0 * DM, nullptr, DM, acc, acc2);
    TILE_FOREACH({ const size_t o = (size_t)(m0 + lrow) * DM + n0 + lcol; const float x = hin[o] + v; hout[o] = x; hb[o] = (bf16_t)f2bf(x); })
}
__global__ void __launch_bounds__(64) k_gemm_pj(const bf16_t* __restrict__ A, const bf16_t* __restrict__ Bt, bf16_t* __restrict__ PJ) {
    const int lane = threadIdx.x, r32 = lane & 31, hi = lane >> 5; const int m0 = blockIdx.y * 64, n0 = blockIdx.x * 64;
    f32x16 acc[2][2], acc2[2][2];
    gemm_tile64<false>(A + (size_t)(m0 + r32) * PLE, A + (size_t)(m0 + 32 + r32) * PLE, Bt + (size_t)n0 * PLE, nullptr, PLE, acc, acc2);
    TILE_FOREACH({ PJ[(size_t)(m0 + lrow) * DM + n0 + lcol] = (bf16_t)f2bf(v); })
}
__global__ void __launch_bounds__(64) k_gemm_ple(const bf16_t* __restrict__ A, const bf16_t* __restrict__ Bt, const float* __restrict__ rstd, const bf16_t* __restrict__ PJ, float* h, bf16_t* hb) {
    const int lane = threadIdx.x, r32 = lane & 31, hi = lane >> 5; const int m0 = blockIdx.y * 64, n0 = blockIdx.x * 64;
    f32x16 acc[2][2], acc2[2][2];
    gemm_tile64<false>(A + (size_t)(m0 + r32) * DM, A + (size_t)(m0 + 32 + r32) * DM, Bt + (size_t)n0 * DM, nullptr, DM, acc, acc2);
    TILE_FOREACH({ const int row = m0 + lrow; const size_t o = (size_t)row * DM + n0 + lcol; const float x = h[o] + sigmoidf_(v * rstd[row]) * bf2f(PJ[o]); h[o] = x; })
}
__global__ void __launch_bounds__(64) k_gemm_gu(const bf16_t* __restrict__ HB, const bf16_t* __restrict__ Wgu, const float* __restrict__ bgu, const float* __restrict__ rstd,
                                                const unsigned* __restrict__ cnt, const int* __restrict__ tok_of, bf16_t* __restrict__ ACT) {
    const int lane = threadIdx.x, r32 = lane & 31, hi = lane >> 5; const int rt = blockIdx.y, T = rt >> 2, j0 = blockIdx.x * 64;
    const MoeTile mt = moe_tile(cnt, T); if (!mt.ok) return;
    const int lr0 = (rt & 3) * 64; const int rk0 = mt.rank0 + lr0 + r32, rk1 = rk0 + 32;
    const int t0 = rk0 < mt.cnt ? tok_of[(size_t)mt.e * CAP + rk0] : 0, t1 = rk1 < mt.cnt ? tok_of[(size_t)mt.e * CAP + rk1] : 0;
    const bf16_t* Be = Wgu + (size_t)mt.e * 2048 * DM + (size_t)((j0 >> 7) * 256 + (j0 & 127)) * DM;
    f32x16 acc[2][2], acc2[2][2];
    gemm_tile64<true>(HB + (size_t)t0 * DM, HB + (size_t)t1 * DM, Be, Be + (size_t)128 * DM, DM, acc, acc2);
    const size_t slot0 = (size_t)T * 256 + lr0;
    TILE_FOREACH({ const int rk = mt.rank0 + lr0 + lrow; if (rk < mt.cnt) { const int tk = tok_of[(size_t)mt.e * CAP + rk]; const float rs = rstd[tk]; const int j = j0 + lcol;
        float gl = v * rs + bgu[(size_t)mt.e * 2048 + j], ln = v2 * rs + bgu[(size_t)mt.e * 2048 + FF + j];
        gl = fminf(gl, 7.f); ln = fminf(fmaxf(ln, -7.f), 7.f);
        const float a = gl * sigmoidf_(1.702f * gl) * (ln + 1.f);
        ACT[(slot0 + lrow) * FF + j] = (bf16_t)f2bf(a); } })
}
__global__ void __launch_bounds__(64) k_gemm_down(const bf16_t* __restrict__ ACT, const bf16_t* __restrict__ Wd, const float* __restrict__ bd, const unsigned* __restrict__ cnt,
                                                  const float* __restrict__ gate_of, bf16_t* __restrict__ Y) {
    const int lane = threadIdx.x, r32 = lane & 31, hi = lane >> 5; const int rt = blockIdx.y, T = rt >> 2, n0 = blockIdx.x * 64;
    const MoeTile mt = moe_tile(cnt, T); if (!mt.ok) return;
    const int lr0 = (rt & 3) * 64; const size_t slot0 = (size_t)T * 256 + lr0;
    const int rk0 = mt.rank0 + lr0 + r32, rk1 = rk0 + 32;
    const size_t s0 = rk0 < mt.cnt ? slot0 + r32 : (size_t)T * 256, s1 = rk1 < mt.cnt ? slot0 + 32 + r32 : (size_t)T * 256;
    f32x16 acc[2][2], acc2[2][2];
    gemm_tile64<false>(ACT + s0 * FF, ACT + s1 * FF, Wd + (size_t)mt.e * DM * FF + (size_t)n0 * FF, nullptr, FF, acc, acc2);
    TILE_FOREACH({ const int rk = mt.rank0 + lr0 + lrow; if (rk < mt.cnt) { const float gt = gate_of[(size_t)mt.e * CAP + rk]; const int n = n0 + lcol;
        Y[(slot0 + lrow) * DM + n] = (bf16_t)f2bf((v + bd[(size_t)mt.e * DM + n]) * gt); } })
}

__global__ void __launch_bounds__(256) k_router(const float* __restrict__ h, const float* __restrict__ g, const float* __restrict__ wr, const float* __restrict__ br,
                                                float* __restrict__ rstd, unsigned* cnt, int* __restrict__ tok_of, float* __restrict__ gate_of, unsigned* __restrict__ pair) {
    const int lane = threadIdx.x & 63, t = blockIdx.x * 4 + (threadIdx.x >> 6); const int e = lane & 31, half = lane >> 5;
    const float* hr = h + (size_t)t * DM;
    float ss = 0.f;
#pragma unroll
    for (int j = 0; j < 4; ++j) { const f32x4 v = ((const f32x4*)hr)[lane + 64 * j]; ss += v.x * v.x + v.y * v.y + v.z * v.z + v.w * v.w; }
    const float rs = rsqrtf(wave_sum(ss) * (1.f / DM) + EPS);
    float a = 0.f;
    for (int d = half * 512; d < half * 512 + 512; ++d) a += hr[d] * g[d] * wr[(size_t)d * NE + e];
    a += __shfl_xor(a, 32);
    float lg = a * rs + br[e];
    float tv[4]; int ti[4];
#pragma unroll
    for (int k = 0; k < 4; ++k) {
        float bv = lg; int bi = e;
#pragma unroll
        for (int o = 1; o < 32; o <<= 1) { const float ov = __shfl_xor(bv, o); const int oi = __shfl_xor(bi, o); if (ov > bv || (ov == bv && oi < bi)) { bv = ov; bi = oi; } }
        tv[k] = bv; ti[k] = bi; if (e == bi) lg = -INFINITY;
    }
    float w[4], sw = 0.f;
#pragma unroll
    for (int k = 0; k < 4; ++k) { w[k] = __expf(tv[k] - tv[0]); sw += w[k]; }
    if (lane == 0) rstd[t] = rs;
    if (lane < 4) {
        const int k = lane; const int ee = (k == 0) ? ti[0] : (k == 1) ? ti[1] : (k == 2) ? ti[2] : ti[3]; const float ww = (k == 0) ? w[0] : (k == 1) ? w[1] : (k == 2) ? w[2] : w[3];
        const unsigned rk = atomicAdd(&cnt[ee], 1u);
        tok_of[(size_t)ee * CAP + rk] = t; gate_of[(size_t)ee * CAP + rk] = ww / sw; pair[(size_t)t * 4 + k] = ((unsigned)ee << 16) | rk;
    }
}
__global__ void __launch_bounds__(256) k_combine(float* h, bf16_t* __restrict__ hb, float* __restrict__ rstd, const unsigned* __restrict__ cnt, const unsigned* __restrict__ pair, const bf16_t* __restrict__ Y) {
    const int lane = threadIdx.x & 63, t = blockIdx.x * 4 + (threadIdx.x >> 6);
    f32x4 v[4]; f32x4* hr = (f32x4*)(h + (size_t)t * DM) + lane;
#pragma unroll
    for (int j = 0; j < 4; ++j) v[j] = hr[64 * j];
    for (int k = 0; k < 4; ++k) {
        const unsigned pr = pair[(size_t)t * 4 + k]; const int e = pr >> 16, rk = pr & 0xffff;
        const size_t slot = (size_t)moe_tstart(cnt, e) * 256 + rk;
        const u32x2* yr = (const u32x2*)(Y + slot * DM) + lane;
#pragma unroll
        for (int j = 0; j < 4; ++j) { const u32x2 w = yr[64 * j]; v[j].x += __uint_as_float(w.x << 16); v[j].y += __uint_as_float(w.x & 0xffff0000u); v[j].z += __uint_as_float(w.y << 16); v[j].w += __uint_as_float(w.y & 0xffff0000u); }
    }
    float s = 0.f;
#pragma unroll
    for (int j = 0; j < 4; ++j) { hr[64 * j] = v[j]; s += v[j].x * v[j].x + v[j].y * v[j].y + v[j].z * v[j].z + v[j].w * v[j].w; }
    s = wave_sum(s); if (lane == 0) rstd[t] = rsqrtf(s * (1.f / DM) + EPS);
    u32x2* o = (u32x2*)(hb + (size_t)t * DM) + lane;
#pragma unroll
    for (int j = 0; j < 4; ++j) { u32x2 w; w.x = pk2(v[j].x, v[j].y); w.y = pk2(v[j].z, v[j].w); o[64 * j] = w; }
}
__global__ void __launch_bounds__(256) k_final(const float* __restrict__ h, const float* __restrict__ g, float* __restrict__ out) {
    const int lane = threadIdx.x & 63, row = blockIdx.x * 4 + (threadIdx.x >> 6);
    const f32x4* p = (const f32x4*)(h + (size_t)row * DM) + lane; f32x4 v[4]; float s = 0.f;
#pragma unroll
    for (int j = 0; j < 4; ++j) { v[j] = p[64 * j]; s += v[j].x * v[j].x + v[j].y * v[j].y + v[j].z * v[j].z + v[j].w * v[j].w; }
    const float rs = rsqrtf(wave_sum(s) * (1.f / DM) + EPS);
    f32x4* o = (f32x4*)(out + (size_t)row * DM) + lane;
#pragma unroll
    for (int j = 0; j < 4; ++j) { const f32x4 gg = ((const f32x4*)g)[lane + 64 * j]; o[64 * j] = v[j] * rs * gg; }
}
__global__ void __launch_bounds__(256) k_fgate(const float* __restrict__ h, const float* __restrict__ g, const float* __restrict__ wf, const float* __restrict__ bfg, const float* __restrict__ rstd, float* __restrict__ fl) {
    const int lane = threadIdx.x & 63, t = blockIdx.x * 4 + (threadIdx.x >> 6); const int hh = lane & 15, q = lane >> 4;
    const float* hr = h + (size_t)t * DM; float a = 0.f;
    for (int d = q * 256; d < q * 256 + 256; ++d) a += hr[d] * g[d] * wf[(size_t)d * NH + hh];
    a += __shfl_xor(a, 16); a += __shfl_xor(a, 32);
    if (lane < 16) fl[(size_t)t * NH + hh] = a * rstd[t] + bfg[hh];
}
__global__ void __launch_bounds__(64) k_scan(const float* __restrict__ fl, float* __restrict__ cb) {
    const int lane = threadIdx.x, bh = blockIdx.x, b = bh / NH, hh = bh % NH;
    float loc[32]; float run = 0.f;
#pragma unroll
    for (int i = 0; i < 32; ++i) { run += log_sigmoid(fl[(size_t)(b * SEQ + lane * 32 + i) * NH + hh]); loc[i] = run; }
    float incl = run;
#pragma unroll
    for (int o = 1; o < 64; o <<= 1) { const float t = __shfl_up(incl, o); if (lane >= o) incl += t; }
    const float base = incl - run;
#pragma unroll
    for (int i = 0; i < 32; ++i) cb[(size_t)bh * SEQ + lane * 32 + i] = (base + loc[i]) * LOG2E;
}

__device__ __forceinline__ float dot64(const float (&q)[64], const bf16_t* kr) {
    float a = 0.f;
#pragma unroll
    for (int c = 0; c < 8; ++c) { const u32x4 w = ((const u32x4*)kr)[c];
        a += q[8 * c + 0] * __uint_as_float(w.x << 16) + q[8 * c + 1] * __uint_as_float(w.x & 0xffff0000u) + q[8 * c + 2] * __uint_as_float(w.y << 16) + q[8 * c + 3] * __uint_as_float(w.y & 0xffff0000u)
           + q[8 * c + 4] * __uint_as_float(w.z << 16) + q[8 * c + 5] * __uint_as_float(w.z & 0xffff0000u) + q[8 * c + 6] * __uint_as_float(w.w << 16) + q[8 * c + 7] * __uint_as_float(w.w & 0xffff0000u); }
    return a;
}
__device__ __forceinline__ void loadq(float (&q)[64], const bf16_t* qr) {
#pragma unroll
    for (int c = 0; c < 8; ++c) { const u32x4 w = ((const u32x4*)qr)[c];
        q[8 * c + 0] = __uint_as_float(w.x << 16); q[8 * c + 1] = __uint_as_float(w.x & 0xffff0000u); q[8 * c + 2] = __uint_as_float(w.y << 16); q[8 * c + 3] = __uint_as_float(w.y & 0xffff0000u);
        q[8 * c + 4] = __uint_as_float(w.z << 16); q[8 * c + 5] = __uint_as_float(w.z & 0xffff0000u); q[8 * c + 6] = __uint_as_float(w.w << 16); q[8 * c + 7] = __uint_as_float(w.w & 0xffff0000u); }
}
__global__ void __launch_bounds__(256) k_attn_sb(const bf16_t* __restrict__ Q, const bf16_t* __restrict__ K, const bf16_t* __restrict__ V, bf16_t* __restrict__ O) {
    const int lane = threadIdx.x & 63; const int gw = blockIdx.x * 4 + (threadIdx.x >> 6); const int t = gw % SEQ, bh = gw / SEQ, b = bh / NH, hh = bh % NH;
    const size_t rowb = (size_t)b * SEQ; float q[64]; loadq(q, Q + (rowb + t) * DM + hh * HD);
    float o = 0.f, carry = 1.f;
    for (int jt = (t - 1) >> 6; jt >= 0 && t > 0; --jt) {
        const int s = 64 * jt + lane; const bool valid = s < t;
        float x = dot64(q, K + (rowb + s) * DM + hh * HD); x = fminf(x, 64.f);
        const float ex = exp2f(x), r = 1.f / (1.f + ex);
        const float beta = valid ? ex * r : 0.f, nb = valid ? r : 1.f;
        float P = nb;
#pragma unroll
        for (int off = 1; off < 64; off <<= 1) { const float t2 = __shfl_down(P, off); if (lane + off < 64) P *= t2; }
        float Pex = __shfl_down(P, 1); if (lane == 63) Pex = 1.f;
        const float a = beta * carry * Pex;
        carry *= __shfl(P, 0);
        const bf16_t* vb = V + (rowb + 64 * jt) * DM + hh * HD + lane;
        for (int l = 0; l < 64; ++l) { const float al = __shfl(a, l); o += al * bf2f(vb[(size_t)l * DM]); }
        if (carry < 1e-30f) break;
    }
    O[(rowb + t) * DM + hh * HD + lane] = (bf16_t)f2bf(o);
}
__global__ void __launch_bounds__(256) k_attn_fox(const bf16_t* __restrict__ Q, const bf16_t* __restrict__ K, const bf16_t* __restrict__ V, const float* __restrict__ cb, bf16_t* __restrict__ O) {
    const int lane = threadIdx.x & 63; const int gw = blockIdx.x * 4 + (threadIdx.x >> 6); const int t = gw % SEQ, bh = gw / SEQ, b = bh / NH, hh = bh % NH;
    const size_t rowb = (size_t)b * SEQ; float q[64]; loadq(q, Q + (rowb + t) * DM + hh * HD);
    float o = 0.f, m = -INFINITY, l = 0.f;
    for (int jt = 0; jt <= (t >> 6); ++jt) {
        const int s = 64 * jt + lane; const bool valid = s <= t;
        float x = dot64(q, K + (rowb + s) * DM + hh * HD) - cb[(size_t)bh * SEQ + s];
        x = valid ? x : -INFINITY;
        const float mn = fmaxf(m, wave_max(x)); const float alpha = exp2f(m - mn); const float p = exp2f(x - mn);
        l = l * alpha + wave_sum(p); o *= alpha; m = mn;
        const bf16_t* vb = V + (rowb + 64 * jt) * DM + hh * HD + lane;
        const int nl = min(64, t - 64 * jt + 1);
        for (int i = 0; i < nl; ++i) { const float pi = __shfl(p, i); o += pi * bf2f(vb[(size_t)i * DM]); }
    }
    O[(rowb + t) * DM + hh * HD + lane] = (bf16_t)f2bf(o / l);
}


#include <hip/hip_bf16.h>
#include <cmath>
namespace attn_body {
using bf16=__hip_bfloat16;
using bf16x8=__attribute__((ext_vector_type(8)))short;
using s16x4=__attribute__((ext_vector_type(4)))short;
using f32x16=__attribute__((ext_vector_type(16)))float;
using u32x4=__attribute__((ext_vector_type(4)))unsigned;
constexpr int BATCH=16,NHEAD=16,SEQ=2048,D=64,DM=NHEAD*D;
constexpr int NW=8,QBLK=32,QB=QBLK*NW,KVBLK=64,NQB=SEQ/QB;
constexpr int ATTN_PITCH=DM, ATTN_UNIT_ROWS=QB;
__device__ __forceinline__ int crow(int r,int hi){return (r&3)+8*(r>>2)+4*hi;}
#define SBAR() __builtin_amdgcn_sched_barrier(0)
__device__ __forceinline__ void cmask(f32x16&p0,f32x16&p1,int jb,int qrel,int hi){
  const float NEG=-INFINITY; int kb=64*jb+4*hi;
  #pragma unroll
  for(int r=0;r<16;++r){int kv=kb+(r&3)+8*(r>>2); if(kv>qrel)p0[r]=NEG; if(kv+32>qrel)p1[r]=NEG;}
}

constexpr int NSLOT=3, SLOTB=8192;
constexpr int LDS_K=0, LDS_V=NSLOT*SLOTB, LDS_WS=2*NSLOT*SLOTB, LDS_OST=LDS_WS+NW*64*4, LDS_BYTES=LDS_OST+NW*4096;
constexpr float C2=0.125f*1.4426950408889634f;
__device__ __forceinline__ void glds16(const void*gsrc,unsigned lds_dst){unsigned keep;
  asm volatile("s_mov_b32 %0, m0\n\ts_mov_b32 m0, %2\n\ts_nop 0\n\tglobal_load_lds_dwordx4 %1, off\n\ts_mov_b32 m0, %0":"=&s"(keep):"v"(gsrc),"s"(lds_dst):"memory");}
__device__ __forceinline__ float max3f(float a,float b,float c){float r;asm("v_max3_f32 %0, %1, %2, %3":"=v"(r):"v"(a),"v"(b),"v"(c));return r;}
__device__ __forceinline__ float max2f(float a,float b){float r;asm("v_max_f32_e32 %0, %1, %2":"=v"(r):"v"(a),"v"(b));return r;}
__device__ __forceinline__ float fadd_s(float a,float b){float r;asm("v_add_f32_e32 %0, %1, %2":"=v"(r):"v"(a),"v"(b));return r;}
__device__ __forceinline__ float fsub_s(float a,float b){float r;asm("v_sub_f32_e32 %0, %1, %2":"=v"(r):"v"(a),"v"(b));return r;}
typedef float f32x2_t __attribute__((ext_vector_type(2))); typedef __bf16 bf16x2_t __attribute__((ext_vector_type(2)));
__device__ __forceinline__ unsigned cvtpk_s(float lo,float hi){f32x2_t v={lo,hi};bf16x2_t b=__builtin_convertvector(v,bf16x2_t);return __builtin_bit_cast(unsigned,b);}
#define WAIT_BAR(N) asm volatile("s_waitcnt vmcnt(" #N ") lgkmcnt(0)\n\ts_barrier":::"memory")

__device__ __forceinline__ void qkt(f32x16&p0,f32x16&p1,const char*Kslot,const bf16x8*qr,const f32x16&negm,int r32,int hi){
  const char*kb=Kslot+hi*1024+r32*16;
  #pragma unroll
  for(int d0=0;d0<4;++d0){
    const bf16x8 b0=*reinterpret_cast<const bf16x8*>(kb+d0*2048);
    const bf16x8 b1=*reinterpret_cast<const bf16x8*>(kb+d0*2048+512);
    if(d0==0){p0=__builtin_amdgcn_mfma_f32_32x32x16_bf16(b0,qr[0],negm,0,0,0);p1=__builtin_amdgcn_mfma_f32_32x32x16_bf16(b1,qr[0],negm,0,0,0);}
    else{p0=__builtin_amdgcn_mfma_f32_32x32x16_bf16(b0,qr[d0],p0,0,0,0);p1=__builtin_amdgcn_mfma_f32_32x32x16_bf16(b1,qr[d0],p1,0,0,0);}}
}
typedef __attribute__((address_space(3))) const char* lds_cptr;
typedef short v4i16_t __attribute__((ext_vector_type(4)));
__device__ __forceinline__ void kload8(bf16x8*kf,lds_cptr kp){
  kf[0]=*(const __attribute__((address_space(3))) bf16x8*)(kp);      kf[1]=*(const __attribute__((address_space(3))) bf16x8*)(kp+512);
  kf[2]=*(const __attribute__((address_space(3))) bf16x8*)(kp+2048); kf[3]=*(const __attribute__((address_space(3))) bf16x8*)(kp+2560);
  kf[4]=*(const __attribute__((address_space(3))) bf16x8*)(kp+4096); kf[5]=*(const __attribute__((address_space(3))) bf16x8*)(kp+4608);
  kf[6]=*(const __attribute__((address_space(3))) bf16x8*)(kp+6144); kf[7]=*(const __attribute__((address_space(3))) bf16x8*)(kp+6656);
}
__device__ __forceinline__ void kload2(bf16x8*kf,lds_cptr kp,int j){ kf[2*j]=*(const __attribute__((address_space(3))) bf16x8*)(kp+j*2048); kf[2*j+1]=*(const __attribute__((address_space(3))) bf16x8*)(kp+j*2048+512); }
__device__ __forceinline__ s16x4 vtr(lds_cptr p){ return __builtin_bit_cast(s16x4,__builtin_amdgcn_ds_read_tr16_b64_v4i16((__attribute__((address_space(3))) v4i16_t*)p)); }
__device__ __forceinline__ float rowmax(const f32x16&p0,const f32x16&p1){
  float a=max3f(p0[0],p0[1],p1[0]),b=max3f(p0[2],p0[3],p1[1]);a=max3f(a,p1[2],p1[3]);
  #pragma unroll
  for(int r=4;r<16;r+=4){a=max3f(a,p0[r],p0[r+1]);b=max3f(b,p0[r+2],p0[r+3]);a=max3f(a,p1[r],p1[r+1]);b=max3f(b,p1[r+2],p1[r+3]);}
  const float m=max2f(a,b);
  auto rr=__builtin_amdgcn_permlane32_swap(__float_as_uint(m),__float_as_uint(m),false,false);
  return max2f(__uint_as_float(rr[0]),__uint_as_float(rr[1]));
}
__device__ __forceinline__ void pv(f32x16*o,int vb,bf16x8 pa0,bf16x8 pa1,bf16x8 pa2,bf16x8 pa3){
  #pragma unroll
  for(int d0=0;d0<2;++d0){s16x4 lo[4],hi[4];
    #pragma unroll
    for(int ks=0;ks<4;++ks){
      asm volatile("ds_read_b64_tr_b16 %0,%1 offset:%c2":"=&v"(lo[ks]):"v"(vb),"i"(d0*4096+ks*1024):"memory");
      asm volatile("ds_read_b64_tr_b16 %0,%1 offset:%c2":"=&v"(hi[ks]):"v"(vb),"i"(d0*4096+ks*1024+512):"memory");}
    asm volatile("s_waitcnt lgkmcnt(0)":::"memory");SBAR();
    #define PK(k) (bf16x8){lo[k][0],lo[k][1],lo[k][2],lo[k][3],hi[k][0],hi[k][1],hi[k][2],hi[k][3]}
    o[d0]=__builtin_amdgcn_mfma_f32_32x32x16_bf16(pa0,PK(0),o[d0],0,0,0);
    o[d0]=__builtin_amdgcn_mfma_f32_32x32x16_bf16(pa1,PK(1),o[d0],0,0,0);
    o[d0]=__builtin_amdgcn_mfma_f32_32x32x16_bf16(pa2,PK(2),o[d0],0,0,0);
    o[d0]=__builtin_amdgcn_mfma_f32_32x32x16_bf16(pa3,PK(3),o[d0],0,0,0);
    #undef PK
  }
}

#ifndef ATTN_STORE16
#define ATTN_STORE16(p,v) (*(u32x4*)(p)=(v))
#endif
typedef float f32x4b __attribute__((ext_vector_type(4)));
template<int THRL> __device__ __forceinline__ void attn_unit(int b,int h,int qb,const bf16*Q,const bf16*__restrict__ K,const bf16*__restrict__ V,bf16*O,char*shm,const __attribute__((address_space(3))) float*cb){
  int tid_=threadIdx.x; asm volatile("":"+v"(tid_));
  const int tid=tid_,lane=tid&63,r32=lane&31,hi=lane>>5; const int wid=__builtin_amdgcn_readfirstlane(tid>>6);
  const long rowbase=(long)b*SEQ; const int q0=qb*QB;
  const long hbase=((long)b*NHEAD+h)*SEQ;
  constexpr int PQ=D;
  const bf16*Qw=Q+(hbase+q0+wid*QBLK)*PQ;
  const bf16*Kh=K+hbase*PQ,*Vh=V+hbase*PQ;
  const unsigned lds0=(unsigned)(uintptr_t)shm;
  float*wsf=(float*)(shm+LDS_WS)+wid*64;
  const bf16*ksrc=Kh+(long)lane*PQ+wid*8;
  const bf16*vsrc=Vh+(long)(16*(wid&3)+(lane>>2))*PQ+(wid>>2)*32+(lane&3)*8;
  const unsigned kdst=lds0+LDS_K+wid*1024, vdst=lds0+LDS_V+wid*1024;
  #define TIDX(u) (NT-1-(u))
  #define DMA_K(t,slot) glds16(ksrc+(long)TIDX(t)*KVBLK*PQ,(unsigned)__builtin_amdgcn_readfirstlane(kdst+(slot)))
  #define DMA_V(t,slot) glds16(vsrc+(long)TIDX(t)*KVBLK*PQ,(unsigned)__builtin_amdgcn_readfirstlane(vdst+(slot)))
  const int vb0=(int)(lds0+LDS_V)+((lane>>4)&1)*32+(lane&3)*8+(4*hi+((lane&15)>>2))*64;
  const char*Kbase=shm+LDS_K; bf16x8 kf[8];
  const lds_cptr shm3=(lds_cptr)shm; const lds_cptr kp0=shm3+LDS_K+hi*1024+r32*16; const lds_cptr vp0=shm3+LDS_V+((lane>>4)&1)*32+(lane&3)*8+(4*hi+((lane&15)>>2))*64;
  const int NT=(q0+QB)/KVBLK;
  DMA_K(0,0);DMA_V(0,0);DMA_K(1,SLOTB);
  bf16x8 qr[4];
  #pragma unroll
  for(int d0=0;d0<4;++d0)qr[d0]=*reinterpret_cast<const bf16x8*>(&Qw[(long)r32*PQ+d0*16+hi*8]);
  float mhat=0.f,l_reg=0.f;f32x16 o[2];o[0]=f32x16{};o[1]=f32x16{};const f32x16 negm=f32x16{};
  const int qrel=wid*QBLK+r32;
  #define CMASK(P0,P1,t) do{int jb_=3-(t); if(jb_>=0)cmask(P0,P1,jb_,qrel,hi);}while(0)
  #define ABIAS(P0,P1,t) do{ const __attribute__((address_space(3))) f32x4b*cbp_=(const __attribute__((address_space(3))) f32x4b*)(cb+64*TIDX(t)+4*hi); \
    _Pragma("unroll") for(int g_=0;g_<4;++g_){ const f32x4b b0_=cbp_[2*g_], b1_=cbp_[8+2*g_]; \
      P0[4*g_+0]+=b0_[0];P0[4*g_+1]+=b0_[1];P0[4*g_+2]+=b0_[2];P0[4*g_+3]+=b0_[3]; P1[4*g_+0]+=b1_[0];P1[4*g_+1]+=b1_[1];P1[4*g_+2]+=b1_[2];P1[4*g_+3]+=b1_[3]; } }while(0)
  #define BLD(G,t,h) f32x4b nb##h##_[4]; { const __attribute__((address_space(3))) f32x4b*cbp_=(const __attribute__((address_space(3))) f32x4b*)(cb+64*TIDX(t)+4*hi+32*(h)); \
      _Pragma("unroll") for(int g_=0;g_<4;++g_) nb##h##_[g_]=cbp_[2*g_]; }
  #define BSUB(G,P,h) if(G){ const float mh_=mhat; _Pragma("unroll") for(int g_=0;g_<4;++g_){ \
      P[4*g_+0]=nb##h##_[g_][0]-mh_;P[4*g_+1]=nb##h##_[g_][1]-mh_;P[4*g_+2]=nb##h##_[g_][2]-mh_;P[4*g_+3]=nb##h##_[g_][3]-mh_; } }
  bool resc=false;
  #define START(P0,P1) do{ const float rm=rowmax(P0,P1); resc=false; \
    { const float dl=(rm>-INFINITY)?rm:0.f; mhat=fadd_s(mhat,dl);     \
      _Pragma("unroll") for(int r=0;r<16;++r){P0[r]=fsub_s(P0[r],dl);P1[r]=fsub_s(P1[r],dl);} \
      } \
    _Pragma("unroll") for(int r=0;r<16;++r)P0[r]=__builtin_amdgcn_exp2f(P0[r]); }while(0)
  #define RESC() do{ if(resc){ asm volatile("s_waitcnt lgkmcnt(0)":::"memory"); \
      _Pragma("unroll") for(int d_=0;d_<2;++d_) _Pragma("unroll") for(int r=0;r<16;++r)o[d_][r]*=wsf[crow(r,hi)]; } }while(0)
  f32x16 pA0,pA1,pB0,pB1;
  int sl_prev=0,sl_cur=0,sl_next=SLOTB;
  #define ROT() do{sl_prev=sl_cur;sl_cur=sl_next;sl_next=(sl_next==(NSLOT-1)*SLOTB)?0:sl_next+SLOTB;}while(0)
  DMA_K(2,2*SLOTB);
  WAIT_BAR(3);
  qkt(pA0,pA1,Kbase,qr,negm,r32,hi);asm volatile("s_nop 15\n\ts_nop 7":"+v"(pA0),"+v"(pA1));ABIAS(pA0,pA1,0);CMASK(pA0,pA1,0);
  START(pA0,pA1);
  _Pragma("unroll") for(int r=0;r<16;++r)pA1[r]=__builtin_amdgcn_exp2f(pA1[r]);
  { BLD(true,1,0) BLD(true,1,1) BSUB(true,pB0,0) BSUB(true,pB1,1) }
  WAIT_BAR(0);
  DMA_K(3,0);DMA_V(1,SLOTB);
  ROT();
  kload8(kf,kp0+sl_cur);
  WAIT_BAR(2);
  s16x4 vlo[8],vhi[8]; u32x4 pw0,pw1,pw2,pw3;
  #define PKW(P,B) cvtpk_s(P[B],P[B+1])
  #define PAF(k) __builtin_bit_cast(bf16x8,pw##k)
  #define VFR(i) (bf16x8){vlo[i][0],vlo[i][1],vlo[i][2],vlo[i][3],vhi[i][0],vhi[i][1],vhi[i][2],vhi[i][3]}
  #define PIN(x) asm volatile("":"+v"(x))
  #define MX3(a,b,c) __builtin_fmaxf(__builtin_fmaxf((a),(b)),(c))
  #define GAPA(MF,A0,A1,A2,A3,W0,W1,PW) do{ MF; sacc+=A0; sacc+=A1; sacc+=A2; sacc+=A3; PIN(sacc); W0; W1; PIN(PW); SBAR(); }while(0)
  #define EX(v) __builtin_amdgcn_exp2f(v)
  #define GAPB(MF,X,B) do{ MF; X[B]=EX(X[B]); X[B+1]=EX(X[B+1]); X[B+2]=EX(X[B+2]); X[B+3]=EX(X[B+3]); PIN(X); SBAR(); }while(0)
  #define VRD(i) do{ vlo[i]=vtr(vp_+(((i)>>2)*4096+((i)&3)*1024)); vhi[i]=vtr(vp_+(((i)>>2)*4096+((i)&3)*1024+512)); }while(0)
  #define KRD(G,j) do{ if(G){ kload2(kf,kp0+sl_next,j); SBAR(); } }while(0)
  #define STEP(C0,C1,P0,P1,t,GK,GV,GL,GB) do{ SBAR(); \
    const lds_cptr vp_=vp0+sl_prev; \
    VRD(0); SBAR(); float sacc=(P0[0]+P0[1]); \
    GAPA(C0=__builtin_amdgcn_mfma_f32_32x32x16_bf16(kf[0],qr[0],C0,0,0,0), P0[2],P0[3],P0[4],P0[5],     pw0[0]=PKW(P0,0), pw0[1]=PKW(P0,2), pw0); \
    VRD(4); SBAR(); GAPA(C1=__builtin_amdgcn_mfma_f32_32x32x16_bf16(kf[1],qr[0],C1,0,0,0), P0[6],P0[7],P0[8],P0[9],     pw0[2]=PKW(P0,4), pw0[3]=PKW(P0,6), pw0); \
    VRD(1); SBAR(); GAPA(C0=__builtin_amdgcn_mfma_f32_32x32x16_bf16(kf[2],qr[1],C0,0,0,0),   P0[10],P0[11],P0[12],P0[13], pw1[0]=PKW(P0,8), pw1[1]=PKW(P0,10), pw1); \
    VRD(5); SBAR(); GAPA(C1=__builtin_amdgcn_mfma_f32_32x32x16_bf16(kf[3],qr[1],C1,0,0,0),   P0[14],P0[15],P1[0],P1[1],   pw1[2]=PKW(P0,12),pw1[3]=PKW(P0,14), pw1); \
    VRD(2); SBAR(); GAPA(C0=__builtin_amdgcn_mfma_f32_32x32x16_bf16(kf[4],qr[2],C0,0,0,0),   P1[2],P1[3],P1[4],P1[5],     pw2[0]=PKW(P1,0), pw2[1]=PKW(P1,2), pw2); \
    VRD(6); SBAR(); GAPA(C1=__builtin_amdgcn_mfma_f32_32x32x16_bf16(kf[5],qr[2],C1,0,0,0),   P1[6],P1[7],P1[8],P1[9],     pw2[2]=PKW(P1,4), pw2[3]=PKW(P1,6), pw2); \
    VRD(3); SBAR(); GAPA(C0=__builtin_amdgcn_mfma_f32_32x32x16_bf16(kf[6],qr[3],C0,0,0,0),   P1[10],P1[11],P1[12],P1[13], pw3[0]=PKW(P1,8), pw3[1]=PKW(P1,10), pw3); \
    VRD(7); SBAR(); GAPA(C1=__builtin_amdgcn_mfma_f32_32x32x16_bf16(kf[7],qr[3],C1,0,0,0),   P1[14],P1[15],0.f,0.f,       pw3[2]=PKW(P1,12),pw3[3]=PKW(P1,14), pw3); \
    l_reg+=sacc; \
    if(GK){DMA_K((t)+3,sl_cur);} if(GV){DMA_V((t)+1,sl_next);} \
    CMASK(C0,C1,t); \
    { float a=MX3(C0[0],C0[1],C1[0]),b=MX3(C0[2],C0[3],C1[1]); a=MX3(a,C1[2],C1[3]); \
      _Pragma("unroll") for(int r=4;r<16;r+=4){a=MX3(a,C0[r],C0[r+1]);b=MX3(b,C0[r+2],C0[r+3]);a=MX3(a,C1[r],C1[r+1]);b=MX3(b,C1[r+2],C1[r+3]);} \
      float rm=__builtin_fmaxf(a,b); { auto rr=__builtin_amdgcn_permlane32_swap(__float_as_uint(rm),__float_as_uint(rm),false,false); rm=__builtin_fmaxf(__uint_as_float(rr[0]),__uint_as_float(rr[1])); } \
      resc=false; \
      if(__builtin_expect(__any(rm>(float)THRL),0)){ const float dl=__builtin_fmaxf(rm,0.f); mhat+=dl; \
        _Pragma("unroll") for(int r=0;r<16;++r){C0[r]-=dl;C1[r]-=dl;} \
        const float f=__builtin_amdgcn_exp2f(-dl); l_reg*=f; if(hi==0)wsf[r32]=f; resc=true; } } \
    SBAR(); \
    BLD(GB,(t)+1,0) SBAR(); \
    GAPB(o[0]=__builtin_amdgcn_mfma_f32_32x32x16_bf16(PAF(0),VFR(0),o[0],0,0,0), C0,0); \
    GAPB(o[1]=__builtin_amdgcn_mfma_f32_32x32x16_bf16(PAF(0),VFR(4),o[1],0,0,0), C0,4); \
    KRD(GL,0); GAPB(o[0]=__builtin_amdgcn_mfma_f32_32x32x16_bf16(PAF(1),VFR(1),o[0],0,0,0), C0,8); \
    KRD(GL,1); GAPB(o[1]=__builtin_amdgcn_mfma_f32_32x32x16_bf16(PAF(1),VFR(5),o[1],0,0,0), C0,12); \
    BSUB(GB,P0,0) BLD(GB,(t)+1,1) SBAR(); \
    KRD(GL,2); GAPB(o[0]=__builtin_amdgcn_mfma_f32_32x32x16_bf16(PAF(2),VFR(2),o[0],0,0,0), C1,0); \
    KRD(GL,3); GAPB(o[1]=__builtin_amdgcn_mfma_f32_32x32x16_bf16(PAF(2),VFR(6),o[1],0,0,0), C1,4); \
    GAPB(o[0]=__builtin_amdgcn_mfma_f32_32x32x16_bf16(PAF(3),VFR(3),o[0],0,0,0), C1,8); \
    GAPB(o[1]=__builtin_amdgcn_mfma_f32_32x32x16_bf16(PAF(3),VFR(7),o[1],0,0,0), C1,12); \
    BSUB(GB,P1,1) \
    }while(0)
  int t=1;
  #define ENDW(tt) do{ if((tt)+3<NT){WAIT_BAR(2);} else if((tt)+2<NT){WAIT_BAR(1);} else {WAIT_BAR(0);} }while(0)
  for(;t+1<NT&&t<5;t+=2){
    STEP(pB0,pB1,pA0,pA1,t,(t+3<NT),(t+1<NT),(t+1<NT),(t+1<NT));       ENDW(t);   RESC(); ROT();
    STEP(pA0,pA1,pB0,pB1,t+1,(t+4<NT),(t+2<NT),(t+2<NT),(t+2<NT));     ENDW(t+1); RESC(); ROT();
  }
  #undef CMASK
  #define CMASK(P0,P1,t) do{}while(0)
  for(;t+5<NT;t+=2){
    STEP(pB0,pB1,pA0,pA1,t,true,true,true,true);     WAIT_BAR(2); RESC(); ROT();
    STEP(pA0,pA1,pB0,pB1,t+1,true,true,true,true);   WAIT_BAR(2); RESC(); ROT();
  }
  for(;t+1<NT;t+=2){
    STEP(pB0,pB1,pA0,pA1,t,(t+3<NT),(t+1<NT),(t+1<NT),(t+1<NT));       ENDW(t);   RESC(); ROT();
    STEP(pA0,pA1,pB0,pB1,t+1,(t+4<NT),(t+2<NT),(t+2<NT),(t+2<NT));     ENDW(t+1); RESC(); ROT();
  }
  #undef CMASK
  #define CMASK(P0,P1,t) do{int jb_=3-(t); if(jb_>=0)cmask(P0,P1,jb_,qrel,hi);}while(0)
  STEP(pB0,pB1,pA0,pA1,NT-1,false,false,false,false); RESC();
  { float sacc=pB0[0]+pB0[1]; _Pragma("unroll") for(int r=2;r<16;++r)sacc+=pB0[r]; _Pragma("unroll") for(int r=0;r<16;++r)sacc+=pB1[r]; l_reg+=sacc;
    pw0=(u32x4){PKW(pB0,0),PKW(pB0,2),PKW(pB0,4),PKW(pB0,6)};pw1=(u32x4){PKW(pB0,8),PKW(pB0,10),PKW(pB0,12),PKW(pB0,14)};pw2=(u32x4){PKW(pB1,0),PKW(pB1,2),PKW(pB1,4),PKW(pB1,6)};pw3=(u32x4){PKW(pB1,8),PKW(pB1,10),PKW(pB1,12),PKW(pB1,14)};
    SBAR(); pv(o,vb0+sl_cur,PAF(0),PAF(1),PAF(2),PAF(3)); }
  #undef PKW
  #undef PAF
  #undef VFR
  #undef PIN
  #undef MX3
  #undef GAPA
  #undef GAPB
  #undef EX
  #undef VRD
  #undef KRD
  #undef STEP
  #undef ENDW
  {auto rr=__builtin_amdgcn_permlane32_swap(__float_as_uint(l_reg),__float_as_uint(l_reg),false,false);l_reg=__uint_as_float(rr[0])+__uint_as_float(rr[1]);}
  if(hi==0)wsf[32+r32]=l_reg;asm volatile("s_waitcnt lgkmcnt(0)":::"memory");
  float rli[16];
  #pragma unroll
  for(int r=0;r<16;++r)rli[r]=__builtin_amdgcn_rcpf(wsf[32+crow(r,hi)]);
  bf16*Ow=O+(rowbase+q0+wid*QBLK)*DM+h*D;
  { bf16*stg=(bf16*)(shm+LDS_OST)+wid*2048;
    #pragma unroll
    for(int r=0;r<16;++r){const int orow=crow(r,hi);
      #pragma unroll
      for(int d0=0;d0<2;++d0)stg[orow*64+d0*32+r32]=__float2bfloat16(o[d0][r]*rli[r]);}
    asm volatile("s_waitcnt lgkmcnt(0)":::"memory");
    #pragma unroll
    for(int i=0;i<4;++i){const int row=i*8+(lane>>3),ch=lane&7; const u32x4 v=*(const u32x4*)(stg+row*64+ch*8); ATTN_STORE16(Ow+(long)row*DM+ch*8,v);} }
  asm volatile("s_waitcnt lgkmcnt(0)\n\ts_barrier":::"memory");
  #undef DMA_K
  #undef TIDX
  #undef DMA_V
  #undef CMASK
  #undef ABIAS
  #undef BLD
  #undef BSUB
  #undef START
  #undef RESC
  #undef ROT
}
constexpr int ATTN_LDS_BYTES=LDS_BYTES;
#undef SBAR
#undef WAIT_BAR
}

#ifndef LAS
#define LAS __attribute__((address_space(3)))
#endif
constexpr int MK_WAVES = 8;
#ifndef MK_NSB
#define MK_NSB 5
#endif
namespace pg8 { __device__ __forceinline__ unsigned cvt_pk_bf16(float lo, float hi); }

namespace sb_body {
typedef short bf16x8 __attribute__((ext_vector_type(8)));
typedef float f32x16 __attribute__((ext_vector_type(16)));
__device__ __forceinline__ void sb_head(LAS unsigned char* lds, int bh, const bf16_t* Q, const bf16_t* K, const bf16_t* V, bf16_t* O) {
    int tid_ = threadIdx.x; asm volatile("" : "+v"(tid_));
    const int lane = tid_ & 63, wid = __builtin_amdgcn_readfirstlane(tid_ >> 6), r32 = lane & 31, hi = lane >> 5;
    const int b = bh / NH, hh = bh % NH; const size_t rowb = (size_t)b * SEQ;
    constexpr int PQ = HD; const size_t hb_ = ((size_t)b * NH + hh) * SEQ;
    const bf16_t* Qh = Q + hb_ * PQ; const bf16_t* Kh = K + hb_ * PQ; const bf16_t* Vh = V + hb_ * PQ; bf16_t* Oh = O + rowb * DM + hh * HD;
    LAS unsigned char* slot0 = lds + wid * 16384;
    const int vb0 = (int)(unsigned)(size_t)slot0 + ((lane >> 4) & 1) * 32 + (lane & 3) * 8 + (4 * hi + ((lane & 15) >> 2)) * 64;
    const bf16_t* vsrc0 = Vh + (size_t)(lane >> 2) * PQ + (lane & 3) * 8;
#define SB_DMAV(t, sc) do { _Pragma("unroll") for (int p_ = 0; p_ < 8; ++p_) \
        __builtin_amdgcn_global_load_lds((const unsigned*)(vsrc0 + (size_t)(64 * (t) + 16 * (p_ & 3)) * PQ + 32 * (p_ >> 2)), (LAS unsigned*)(slot0 + (sc) * 8192 + p_ * 1024), 16, 0, 0); } while (0)
#define SB_LOADK(kf, t) do { const bf16_t* kp_ = Kh + (size_t)(64 * (t) + r32) * PQ + 8 * hi; _Pragma("unroll") for (int d0_ = 0; d0_ < 4; ++d0_) { \
        kf[2 * d0_] = *(const bf16x8*)(kp_ + 16 * d0_); kf[2 * d0_ + 1] = *(const bf16x8*)(kp_ + (size_t)32 * PQ + 16 * d0_); } } while (0)
    for (int uu = wid; uu < SEQ / 32; uu += MK_NSB) {
        const int q0w = uu * 32, qabs = q0w + r32;
        bf16x8 qr[4];
#pragma unroll
        for (int d0 = 0; d0 < 4; ++d0) qr[d0] = *(const bf16x8*)(Qh + (size_t)qabs * PQ + d0 * 16 + hi * 8);
        f32x16 o[2]; o[0] = f32x16{}; o[1] = f32x16{};
        float carry = 1.f; int jt = (q0w + 30) >> 6, sc = 0; bool first = true;
        bf16x8 kf[8], kfn[8];
        SB_DMAV(jt, 0); asm volatile("" ::: "memory"); SB_LOADK(kf, jt);
        for (;;) {
            f32x16 p0 = f32x16{}, p1 = f32x16{};
#pragma unroll
            for (int d0 = 0; d0 < 4; ++d0) { p0 = __builtin_amdgcn_mfma_f32_32x32x16_bf16(kf[2 * d0], qr[d0], p0, 0, 0, 0); p1 = __builtin_amdgcn_mfma_f32_32x32x16_bf16(kf[2 * d0 + 1], qr[d0], p1, 0, 0, 0); }
            const bool more = jt > 0;
            asm volatile("" ::: "memory");
            if (more) { SB_DMAV(jt - 1, sc ^ 1); asm volatile("" ::: "memory"); SB_LOADK(kfn, jt - 1); }
            asm volatile("" ::: "memory");
            float nb[8][4], be[8][4];
#pragma unroll
            for (int w = 0; w < 8; ++w)
#pragma unroll
                for (int i = 0; i < 4; ++i) { const int r = (w & 3) * 4 + i; float x = (w < 4) ? p0[r] : p1[r]; x = fminf(x, 64.f);
                    const float e = __builtin_amdgcn_exp2f(x), rr = __builtin_amdgcn_rcpf(1.f + e);
                    const int kv = 64 * jt + 32 * (w >> 2) + 8 * (w & 3) + 4 * hi + i; const bool valid = !first || (kv < qabs);
                    be[w][i] = valid ? e * rr : 0.f; nb[w][i] = valid ? rr : 1.f; }
            float Xs[8];
            float Te[8], To[8];
#pragma unroll
            for (int w = 0; w < 8; ++w) { const float s2 = nb[w][3], s1 = s2 * nb[w][2], s0 = s1 * nb[w][1], T = s0 * nb[w][0];
                be[w][2] *= s2; be[w][1] *= s1; be[w][0] *= s0;
                auto rr2 = __builtin_amdgcn_permlane32_swap(__float_as_uint(T), __float_as_uint(T), false, false); Te[w] = __uint_as_float(rr2[0]); To[w] = __uint_as_float(rr2[1]); }
            float W = 1.f;
#pragma unroll
            for (int w = 7; w >= 0; --w) { const float xe = W * To[w]; Xs[w] = hi ? W : xe; W = xe * Te[w]; }
            unsigned pw[16];
#pragma unroll
            for (int w = 0; w < 8; ++w) { const float sc2 = Xs[w] * carry; pw[2 * w] = pg8::cvt_pk_bf16(be[w][0] * sc2, be[w][1] * sc2); pw[2 * w + 1] = pg8::cvt_pk_bf16(be[w][2] * sc2, be[w][3] * sc2); }
            carry *= W;
            const bf16x8 pa0 = __builtin_bit_cast(bf16x8, (u32x4){pw[0], pw[1], pw[2], pw[3]}), pa1 = __builtin_bit_cast(bf16x8, (u32x4){pw[4], pw[5], pw[6], pw[7]});
            const bf16x8 pa2 = __builtin_bit_cast(bf16x8, (u32x4){pw[8], pw[9], pw[10], pw[11]}), pa3 = __builtin_bit_cast(bf16x8, (u32x4){pw[12], pw[13], pw[14], pw[15]});
            if (more) asm volatile("s_waitcnt vmcnt(16)" ::: "memory"); else asm volatile("s_waitcnt vmcnt(0)" ::: "memory");
            attn_body::pv(o, vb0 + sc * 8192, pa0, pa1, pa2, pa3);
            if (!more || __all(carry < 1e-12f)) break;
#pragma unroll
            for (int i = 0; i < 8; ++i) kf[i] = kfn[i];
            sc ^= 1; --jt; first = false;
        }
#pragma unroll
        for (int d0 = 0; d0 < 2; ++d0)
#pragma unroll
            for (int r = 0; r < 16; ++r) Oh[(size_t)(q0w + crow(r, hi)) * DM + d0 * 32 + r32] = (bf16_t)f2bf(o[d0][r]);
    }
#undef SB_DMAV
#undef SB_LOADK
}
}

#ifndef LAS
#define LAS __attribute__((address_space(3)))
#endif
#define GAS __attribute__((address_space(1)))
constexpr size_t WS_SS = WS_END;
constexpr size_t WS_WR = WS_SS + 2 * MiB;
constexpr size_t WS_WF = WS_WR + 1 * MiB;
constexpr size_t WS_HB2 = WS_WF + 1 * MiB;
constexpr size_t WS_WGU8 = WS_HB2 + 64 * MiB;
constexpr size_t WS_WD8 = WS_WGU8 + 128 * MiB;
constexpr size_t WS_HB8 = WS_WD8 + 64 * MiB;
constexpr size_t WS_ACT8 = WS_HB8 + 32 * MiB;
constexpr size_t WS_WG8 = WS_ACT8 + 136 * MiB;
constexpr size_t WS_END2 = WS_WG8 + 2 * MiB;
#ifndef MK_PLE8
#define MK_PLE8 1
#endif
#ifndef MK_FP8_MASK
#define MK_FP8_MASK 0
#endif
constexpr float W8SCALE = 256.f, W8INV = 1.f / 256.f;
constexpr int CW_BAR = 4096;
constexpr int CW_CNT2 = 16384, CNT_STRIDE = 64;


__device__ __forceinline__ float lperm(float v, int src) { return __builtin_bit_cast(float, __builtin_amdgcn_ds_bpermute(src << 2, __builtin_bit_cast(int, v))); }
__device__ __forceinline__ int lpermi(int v, int src) { return __builtin_amdgcn_ds_bpermute(src << 2, v); }
__device__ __forceinline__ float lwave_sum(float v, int lane) {
#pragma unroll
    for (int o = 1; o < 64; o <<= 1) v += lperm(v, lane ^ o);
    return v;
}
namespace pg8 {
constexpr int BM = 256, BK = 64, HALF = 128, HTB = HALF * BK * 2, STAGE_BYTES = 8 * HTB, NXCD = 8, WGM = 8;
__device__ __forceinline__ int lds_byte(int r, int c) { const int st = (r >> 4) * 2 + (c >> 5), rr = r & 15, cc = c & 31, ob = rr * 64 + cc * 2; return st * 1024 + (ob ^ (((ob >> 9) & 1) << 5)); }
__device__ __forceinline__ void stage_rc(int b, int& R, int& C) { const int st = b / 1024, sb = b % 1024, swz = sb ^ (((sb >> 9) & 1) << 5); R = (st >> 1) * 16 + swz / 64; C = (st & 1) * 32 + (swz % 64) / 2; }
__device__ __forceinline__ int perm32(int rho) { const int n = rho >> 4, i = rho & 15; return 8 * (i >> 2) + 4 * n + (i & 3); }
__device__ __forceinline__ unsigned cvt_pk_bf16(float lo, float hi) { unsigned r; asm volatile("v_cvt_pk_bf16_f32 %0, %1, %2" : "=v"(r) : "v"(lo), "v"(hi)); return r; }

struct Unit { int arow0, brow0, pn, e, rank0, cnt, ui; };

__device__ __forceinline__ int xcd_remap(int L, int nwg) { const int q = nwg / NXCD, r = nwg % NXCD, xcd = L % NXCD, off = L / NXCD; return (xcd < r ? xcd * (q + 1) : r * (q + 1) + (xcd - r) * q) + off; }

struct DenseOrder {
    int nM, nN, nwg, G, c;
    __device__ __forceinline__ void init(int M, int N, int G_, int c_) { nM = M / BM; nN = N / BM; nwg = nM * nN; G = G_; c = c_; }
    __device__ __forceinline__ bool next(int i, Unit& u) const {
        const long L = (long)i * G + c; if (L >= nwg) return false;
        const int wgid = xcd_remap((int)L, nwg);
        const int nig = WGM * nN, gid = wgid / nig, fm = gid * WGM, gsz = (nM - fm) < WGM ? (nM - fm) : WGM;
        const int pm = fm + ((wgid % nig) % gsz), pn = (wgid % nig) / gsz;
        u.arow0 = pm * BM; u.brow0 = pn * BM; u.pn = pn; u.e = 0; u.rank0 = 0; u.cnt = 0; u.ui = i; return true;
    }
    __device__ __forceinline__ int arow(const Unit& u, int lr) const { return u.arow0 + lr; }
};
struct HotOrder {
    DenseOrder d;
    __device__ __forceinline__ bool next(int i, Unit& u) const { const bool ok = d.next(i, u); u.arow0 = 0; u.brow0 = 0; u.pn = 0; return ok; }
    __device__ __forceinline__ int arow(const Unit& u, int lr) const { return lr; }
};
struct PJOrder {
    DenseOrder d; int G, c;
    __device__ __forceinline__ void init(int G_, int c_) { d.init(NTOK, DM, G_, 0); G = G_; c = c_; }
    __device__ __forceinline__ bool next(int i, Unit& u) const {
        const long L = (long)i * G + c; if (L >= 2 * d.nwg) return false;
        const int l2 = (L >= d.nwg) ? 1 : 0; const int wgid = xcd_remap((int)L - l2 * d.nwg, d.nwg);
        const int nig = WGM * d.nN, gid = wgid / nig, fm = gid * WGM, gsz = (d.nM - fm) < WGM ? (d.nM - fm) : WGM;
        const int pm = fm + ((wgid % nig) % gsz), pn = (wgid % nig) / gsz;
        u.arow0 = l2 * NTOK + pm * BM; u.brow0 = l2 * DM + pn * BM; u.pn = pn; u.e = 0; u.rank0 = 0; u.cnt = 0; u.ui = i; return true;
    }
    __device__ __forceinline__ int arow(const Unit& u, int lr) const { return u.arow0 + lr; }
};
struct MoeOrder {
    int NN, nwg, G, c, lane; const LAS int* tstartL; const LAS int* cntL; const LAS unsigned short* tokL; bool gather;
    __device__ __forceinline__ bool next(int i, Unit& u) const {
        const long L = (long)i * G + c; if (L >= nwg) return false;
        const int wgid = xcd_remap((int)L, nwg);
        const int T = wgid / NN, pn = wgid - T * NN;
        const int lo = (lane < NE) ? tstartL[lane] : 0x7fffffff, hi = (lane < NE) ? tstartL[lane + 1] : 0x7fffffff;
        const unsigned long long m = __ballot(lo <= T && T < hi);
        const int e = __builtin_amdgcn_readfirstlane((int)__builtin_ctzll(m | (1ull << 63)));
        u.e = e; u.rank0 = (T - __builtin_amdgcn_readfirstlane(tstartL[e])) * 256; u.cnt = __builtin_amdgcn_readfirstlane(cntL[e]); u.arow0 = T * 256; u.brow0 = (e * NN + pn) * 256; u.pn = pn; u.ui = i; return true;
    }
    __device__ __forceinline__ int arow(const Unit& u, int lr) const { return gather ? (int)tokL[u.ui * 256 + lr] : u.arow0 + lr; }
};

typedef const f32x4 (&AccRef)[2][2][4][2];
struct EpiQKV {
    bf16_t* Q; const LAS float* rowL; int probe;
    __device__ __forceinline__ void operator()(AccRef acc, const Unit& u, int wr, int wc, int fr, int fq) const {
        const int t = u.brow0 >> 10, colt = u.brow0 & 1023; bf16_t* base = Q + (size_t)t * ((size_t)NTOK * DM); const float sc = (t == 0) ? C2 : 1.f;
        const int col0 = colt + wc * 32 + 8 * fq;
#pragma unroll
        for (int ai = 0; ai < 2; ++ai)
#pragma unroll
            for (int m = 0; m < 4; ++m) { const int lr = ai * HALF + wr * 64 + m * 16 + fr; const int row = u.arow0 + lr; const int bb = row / SEQ, ss = row - bb * SEQ;
                const float rs = rowL[u.ui * 256 + lr] * sc;
#pragma unroll
                for (int bj = 0; bj < 2; ++bj) { const int c = col0 + bj * HALF; bf16_t* dst = base + (((size_t)(bb * NH + (c >> 6)) * SEQ + ss) * HD + (c & 63));
                    const f32x4 v0 = acc[ai][bj][m][0] * rs, v1 = acc[ai][bj][m][1] * rs; u32x4 w;
                    w.x = cvt_pk_bf16(v0[0], v0[1]); w.y = cvt_pk_bf16(v0[2], v0[3]); w.z = cvt_pk_bf16(v1[0], v1[1]); w.w = cvt_pk_bf16(v1[2], v1[3]);
                    if (probe == 1) asm volatile("" :: "v"(w)); else *(u32x4*)dst = w; } }
    }
};
struct EpiPJ {
    bf16_t* O;
    __device__ __forceinline__ void operator()(AccRef acc, const Unit& u, int wr, int wc, int fr, int fq) const {
        const int col0 = u.pn * BM + wc * 32 + 8 * fq;
#pragma unroll
        for (int ai = 0; ai < 2; ++ai)
#pragma unroll
            for (int m = 0; m < 4; ++m) { const int row = u.arow0 + ai * HALF + wr * 64 + m * 16 + fr; bf16_t* rowp = O + (size_t)row * DM + col0;
#pragma unroll
                for (int bj = 0; bj < 2; ++bj) { const f32x4 v0 = acc[ai][bj][m][0], v1 = acc[ai][bj][m][1]; u32x4 w;
                    w.x = cvt_pk_bf16(v0[0], v0[1]); w.y = cvt_pk_bf16(v0[2], v0[3]); w.z = cvt_pk_bf16(v1[0], v1[1]); w.w = cvt_pk_bf16(v1[2], v1[3]); *(u32x4*)(rowp + bj * HALF) = w; } }
    }
};
struct EpiWo {
    const bf16_t* hin; bf16_t* hb; unsigned char* hb8;
    __device__ __forceinline__ void operator()(AccRef acc, const Unit& u, int wr, int wc, int fr, int fq) const {
        const int col0 = u.brow0 + wc * 32 + 8 * fq;
        u32x4 hv[2][4][2];
#pragma unroll
        for (int ai = 0; ai < 2; ++ai)
#pragma unroll
            for (int m = 0; m < 4; ++m) { const size_t off = (size_t)(u.arow0 + ai * HALF + wr * 64 + m * 16 + fr) * DM + col0;
#pragma unroll
                for (int bj = 0; bj < 2; ++bj) hv[ai][m][bj] = *(const u32x4*)(hin + off + bj * HALF); }
#pragma unroll
        for (int ai = 0; ai < 2; ++ai)
#pragma unroll
            for (int m = 0; m < 4; ++m) { const size_t off = (size_t)(u.arow0 + ai * HALF + wr * 64 + m * 16 + fr) * DM + col0;
#pragma unroll
                for (int bj = 0; bj < 2; ++bj) { const size_t o = off + bj * HALF; const u32x4 h4 = hv[ai][m][bj]; const f32x4 a0 = acc[ai][bj][m][0], a1 = acc[ai][bj][m][1];
                    const float x0 = __uint_as_float(h4.x << 16) + a0[0], x1 = __uint_as_float(h4.x & 0xffff0000u) + a0[1], x2 = __uint_as_float(h4.y << 16) + a0[2], x3 = __uint_as_float(h4.y & 0xffff0000u) + a0[3];
                    const float x4 = __uint_as_float(h4.z << 16) + a1[0], x5 = __uint_as_float(h4.z & 0xffff0000u) + a1[1], x6 = __uint_as_float(h4.w << 16) + a1[2], x7 = __uint_as_float(h4.w & 0xffff0000u) + a1[3];
                    if (hb8) { unsigned p0 = 0u, p1 = 0u; p0 = __builtin_amdgcn_cvt_pk_fp8_f32(x0, x1, p0, false); p0 = __builtin_amdgcn_cvt_pk_fp8_f32(x2, x3, p0, true); p1 = __builtin_amdgcn_cvt_pk_fp8_f32(x4, x5, p1, false); p1 = __builtin_amdgcn_cvt_pk_fp8_f32(x6, x7, p1, true);
                        *(u32x2*)(hb8 + o) = (u32x2){p0, p1}; }
                    u32x4 w; w.x = cvt_pk_bf16(x0, x1); w.y = cvt_pk_bf16(x2, x3); w.z = cvt_pk_bf16(x4, x5); w.w = cvt_pk_bf16(x6, x7);
                    *(u32x4*)(hb + o) = w; } }
    }
};
__device__ __forceinline__ float fast_sigmoid(float x) { return __builtin_amdgcn_rcpf(1.f + __builtin_amdgcn_exp2f(-LOG2E * x)); }
struct EpiPLE {
    const bf16_t* hin; bf16_t* hb; const bf16_t* PJ; const LAS float* rowL; float* SS;
    __device__ __forceinline__ void operator()(AccRef acc, const Unit& u, int wr, int wc, int fr, int fq) const {
        const int col0 = u.brow0 + wc * 32 + 8 * fq;
#pragma unroll
        for (int ai = 0; ai < 2; ++ai) {
            u32x4 hv[4][2], pv[4][2];
#pragma unroll
            for (int m = 0; m < 4; ++m) { const size_t off = (size_t)(u.arow0 + ai * HALF + wr * 64 + m * 16 + fr) * DM + col0;
#pragma unroll
                for (int bj = 0; bj < 2; ++bj) { hv[m][bj] = *(const u32x4*)(hin + off + bj * HALF); pv[m][bj] = *(const u32x4*)(PJ + off + bj * HALF); } }
#pragma unroll
            for (int m = 0; m < 4; ++m) { const int lr = ai * HALF + wr * 64 + m * 16 + fr; const int row = u.arow0 + lr; const size_t off = (size_t)row * DM + col0; const float rs = rowL[u.ui * 256 + lr]; float ssq = 0.f;
#pragma unroll
                for (int bj = 0; bj < 2; ++bj) { const size_t o = off + bj * HALF; const u32x4 pj = pv[m][bj]; const u32x4 h4 = hv[m][bj];
                    const f32x4 a0 = acc[ai][bj][m][0] * rs, a1 = acc[ai][bj][m][1] * rs; float x[8];
                    x[0] = __uint_as_float(h4.x << 16) + fast_sigmoid(a0[0]) * __uint_as_float(pj.x << 16); x[1] = __uint_as_float(h4.x & 0xffff0000u) + fast_sigmoid(a0[1]) * __uint_as_float(pj.x & 0xffff0000u);
                    x[2] = __uint_as_float(h4.y << 16) + fast_sigmoid(a0[2]) * __uint_as_float(pj.y << 16); x[3] = __uint_as_float(h4.y & 0xffff0000u) + fast_sigmoid(a0[3]) * __uint_as_float(pj.y & 0xffff0000u);
                    x[4] = __uint_as_float(h4.z << 16) + fast_sigmoid(a1[0]) * __uint_as_float(pj.z << 16); x[5] = __uint_as_float(h4.z & 0xffff0000u) + fast_sigmoid(a1[1]) * __uint_as_float(pj.z & 0xffff0000u);
                    x[6] = __uint_as_float(h4.w << 16) + fast_sigmoid(a1[2]) * __uint_as_float(pj.w << 16); x[7] = __uint_as_float(h4.w & 0xffff0000u) + fast_sigmoid(a1[3]) * __uint_as_float(pj.w & 0xffff0000u);
                    u32x4 w; w.x = cvt_pk_bf16(x[0], x[1]); w.y = cvt_pk_bf16(x[2], x[3]); w.z = cvt_pk_bf16(x[4], x[5]); w.w = cvt_pk_bf16(x[6], x[7]); *(u32x4*)(hb + o) = w;
                    float q0 = __uint_as_float(w.x << 16), q1 = __uint_as_float(w.x & 0xffff0000u), q2 = __uint_as_float(w.y << 16), q3 = __uint_as_float(w.y & 0xffff0000u);
                    float q4 = __uint_as_float(w.z << 16), q5 = __uint_as_float(w.z & 0xffff0000u), q6 = __uint_as_float(w.w << 16), q7 = __uint_as_float(w.w & 0xffff0000u);
                    ssq += (q0 * q0 + q1 * q1) + (q2 * q2 + q3 * q3) + (q4 * q4 + q5 * q5) + (q6 * q6 + q7 * q7); }
                { const int ln_ = fr + 16 * fq; ssq += lperm(ssq, ln_ ^ 16); ssq += lperm(ssq, ln_ ^ 32); }
                if (fq == 0) SS[(size_t)row * 16 + u.pn * 4 + wc] = ssq; }
            asm volatile("" ::: "memory");
        }
    }
};
template <bool OUT8> struct EpiGU {
    void* ACT; const float* bgu; const LAS float* rowL;
    __device__ __forceinline__ void operator()(AccRef acc, const Unit& u, int wr, int wc, int fr, int fq) const {
        const int jc = u.pn * 128 + wc * 32 + 8 * fq; const float* bp = bgu + (size_t)u.e * (2 * FF) + jc;
        const f32x4 bg0 = *(const f32x4*)(bp), bg1 = *(const f32x4*)(bp + 4), bl0 = *(const f32x4*)(bp + FF), bl1 = *(const f32x4*)(bp + FF + 4);
#pragma unroll
        for (int ai = 0; ai < 2; ++ai)
#pragma unroll
            for (int m = 0; m < 4; ++m) { const int lr = ai * HALF + wr * 64 + m * 16 + fr; const float rs = rowL[u.ui * 256 + lr];
                const f32x4 g0 = __builtin_elementwise_min(acc[ai][0][m][0] * rs + bg0, (f32x4){7.f, 7.f, 7.f, 7.f}), g1 = __builtin_elementwise_min(acc[ai][0][m][1] * rs + bg1, (f32x4){7.f, 7.f, 7.f, 7.f});
                const f32x4 l0 = __builtin_elementwise_min(__builtin_elementwise_max(acc[ai][1][m][0] * rs + bl0, (f32x4){-7.f, -7.f, -7.f, -7.f}), (f32x4){7.f, 7.f, 7.f, 7.f}) + 1.f;
                const f32x4 l1 = __builtin_elementwise_min(__builtin_elementwise_max(acc[ai][1][m][1] * rs + bl1, (f32x4){-7.f, -7.f, -7.f, -7.f}), (f32x4){7.f, 7.f, 7.f, 7.f}) + 1.f;
                const f32x4 x0 = g0 * (-1.702f * LOG2E), x1 = g1 * (-1.702f * LOG2E); f32x4 e0, e1;
#pragma unroll
                for (int c = 0; c < 4; ++c) { e0[c] = __builtin_amdgcn_exp2f(x0[c]); e1[c] = __builtin_amdgcn_exp2f(x1[c]); }
                const f32x4 d0 = e0 + 1.f, d1 = e1 + 1.f; f32x4 s0, s1;
#pragma unroll
                for (int c = 0; c < 4; ++c) { s0[c] = __builtin_amdgcn_rcpf(d0[c]); s1[c] = __builtin_amdgcn_rcpf(d1[c]); }
                const f32x4 a0 = (g0 * l0) * s0, a1 = (g1 * l1) * s1; const float a[8] = {a0[0], a0[1], a0[2], a0[3], a1[0], a1[1], a1[2], a1[3]};
                if constexpr (OUT8) { unsigned p0 = 0u, p1 = 0u; p0 = __builtin_amdgcn_cvt_pk_fp8_f32(a[0], a[1], p0, false); p0 = __builtin_amdgcn_cvt_pk_fp8_f32(a[2], a[3], p0, true); p1 = __builtin_amdgcn_cvt_pk_fp8_f32(a[4], a[5], p1, false); p1 = __builtin_amdgcn_cvt_pk_fp8_f32(a[6], a[7], p1, true);
                    *(u32x2*)((unsigned char*)ACT + (size_t)(u.arow0 + lr) * FF + jc) = (u32x2){p0, p1}; }
                else { u32x4 w; w.x = cvt_pk_bf16(a[0], a[1]); w.y = cvt_pk_bf16(a[2], a[3]); w.z = cvt_pk_bf16(a[4], a[5]); w.w = cvt_pk_bf16(a[6], a[7]);
                    *(u32x4*)((bf16_t*)ACT + (size_t)(u.arow0 + lr) * FF + jc) = w; } }
    }
};
struct EpiDown {
    bf16_t* Y; const float* bd; const LAS float* rowL; float bscale; bool y8;
    __device__ __forceinline__ void operator()(AccRef acc, const Unit& u, int wr, int wc, int fr, int fq) const {
        const int col0 = u.pn * 256 + wc * 32 + 8 * fq; const float* bp = bd + (size_t)u.e * DM + col0;
        f32x4 bv[2][2];
#pragma unroll
        for (int bj = 0; bj < 2; ++bj) { bv[bj][0] = *(const f32x4*)(bp + bj * HALF) * bscale; bv[bj][1] = *(const f32x4*)(bp + bj * HALF + 4) * bscale; }
#pragma unroll
        for (int ai = 0; ai < 2; ++ai)
#pragma unroll
            for (int m = 0; m < 4; ++m) { const int lr = ai * HALF + wr * 64 + m * 16 + fr; const float gt = rowL[u.ui * 256 + lr];
                bf16_t* rowp = Y + (size_t)(u.arow0 + lr) * DM + col0; unsigned char* rowp8 = (unsigned char*)Y + (size_t)(u.arow0 + lr) * DM + col0;
#pragma unroll
                for (int bj = 0; bj < 2; ++bj) { const f32x4 v0 = (acc[ai][bj][m][0] + bv[bj][0]) * gt, v1 = (acc[ai][bj][m][1] + bv[bj][1]) * gt;
                    if (y8) { unsigned p0 = 0u, p1 = 0u; p0 = __builtin_amdgcn_cvt_pk_fp8_f32(v0[0], v0[1], p0, false); p0 = __builtin_amdgcn_cvt_pk_fp8_f32(v0[2], v0[3], p0, true); p1 = __builtin_amdgcn_cvt_pk_fp8_f32(v1[0], v1[1], p1, false); p1 = __builtin_amdgcn_cvt_pk_fp8_f32(v1[2], v1[3], p1, true);
                        *(u32x2*)(rowp8 + bj * HALF) = (u32x2){p0, p1}; }
                    else { u32x4 w; w.x = cvt_pk_bf16(v0[0], v0[1]); w.y = cvt_pk_bf16(v0[2], v0[3]); w.z = cvt_pk_bf16(v1[0], v1[1]); w.w = cvt_pk_bf16(v1[2], v1[3]); *(u32x4*)(rowp + bj * HALF) = w; } } }
    }
};

typedef int v8i_t __attribute__((ext_vector_type(8))); typedef int v4i_t __attribute__((ext_vector_type(4)));
template <class Epi, class Sched, bool FP8 = false>
__device__ __forceinline__ void gemm_phase(LAS unsigned char* lds, const void* gA, const void* gBt, const int KB, const Sched& S, const Epi& E, const bool skip_epi = false) {
    int tid_ = threadIdx.x; asm volatile("" : "+v"(tid_));
    const int tid = tid_, wid = __builtin_amdgcn_readfirstlane(tid >> 6), lane = tid & 63, wr = wid >> 2, wc = wid & 3, fr = lane & 15, fq = lane >> 4;
    const int nt = KB / (BK * 2);
    unsigned voffB[2];
#pragma unroll
    for (int i = 0; i < 2; ++i) { int R, C; stage_rc(tid * 16 + i * 8192, R, C); const int Rb = (R & ~31) + perm32(R & 31); voffB[i] = (unsigned)(Rb * 128 + C * 2); }
#define PG8_AOFF(u, o0, o1) do { int t2_ = threadIdx.x; asm volatile("" : "+v"(t2_)); _Pragma("unroll") for (int i = 0; i < 2; ++i) { int R, C; stage_rc(t2_ * 16 + i * 8192, R, C); \
        o0[i] = (unsigned)S.arow(u, R) * (unsigned)KB + (unsigned)C * 2u; o1[i] = (unsigned)S.arow(u, HALF + R) * (unsigned)KB + (unsigned)C * 2u; } } while (0)
    const unsigned kstep = (unsigned)(BK * 2);
    const unsigned hstepA_unused = (unsigned)HALF * (unsigned)KB; (void)hstepA_unused;
    const unsigned kstepB = 256u * 128u, hstep = 128u * 128u;
    const unsigned ldsw = (unsigned)wid * 1024u;
    unsigned rdA_ = (unsigned)(size_t)lds + (unsigned)lds_byte(wr * 64 + fr, fq * 8), rdB_ = (unsigned)(size_t)lds + 4u * HTB + (unsigned)lds_byte(wc * 32 + fr, fq * 8);
    asm volatile("" : "+v"(rdA_), "+v"(rdB_));
    const LAS unsigned char* const rdA = (const LAS unsigned char*)(size_t)rdA_; const LAS unsigned char* const rdB = (const LAS unsigned char*)(size_t)rdB_;
#define PG8_SA(b, h) (((b) * 2 + (h)) * HTB)
#define PG8_SB(b, h) ((4 + (b) * 2 + (h)) * HTB)
#define PG8_STAGE(bufoff, rs, voff, soff) do { _Pragma("unroll") for (int _i = 0; _i < 2; ++_i) \
        __builtin_amdgcn_raw_ptr_buffer_load_lds(rs, (LAS void*)(lds + (bufoff) + ldsw + _i * 8192), 16, (voff)[_i], (unsigned)(soff), 0, 0); } while (0)
#define PG8_RA(b, h) (((b) * 2 + (h)) * HTB)
#define PG8_LD16A(off) __builtin_bit_cast(v4i_t, *(const LAS bf16x8*)(rdA + (off)))
#define PG8_LD16B(off) __builtin_bit_cast(v4i_t, *(const LAS bf16x8*)(rdB + (off)))
#define PG8_LDA(dst, b, h) do { if constexpr (FP8) { _Pragma("unroll") for (int m = 0; m < 4; ++m) dst##8[m] = __builtin_shufflevector(PG8_LD16A(PG8_RA(b, h) + m * 2048), PG8_LD16A(PG8_RA(b, h) + m * 2048 + 1024), 0, 1, 2, 3, 4, 5, 6, 7); } \
        else { _Pragma("unroll") for (int m = 0; m < 4; ++m) _Pragma("unroll") for (int k = 0; k < 2; ++k) dst[m][k] = *(const LAS bf16x8*)(rdA + PG8_RA(b, h) + m * 2048 + k * 1024); } } while (0)
#define PG8_LDB(dst, b, h) do { if constexpr (FP8) { _Pragma("unroll") for (int n = 0; n < 2; ++n) dst##8[n] = __builtin_shufflevector(PG8_LD16B(PG8_RA(b, h) + n * 2048), PG8_LD16B(PG8_RA(b, h) + n * 2048 + 1024), 0, 1, 2, 3, 4, 5, 6, 7); } \
        else { _Pragma("unroll") for (int n = 0; n < 2; ++n) _Pragma("unroll") for (int k = 0; k < 2; ++k) dst[n][k] = *(const LAS bf16x8*)(rdB + PG8_RA(b, h) + n * 2048 + k * 1024); } } while (0)
#define PG8_MMA(ai, bj, At, Bt) do { __builtin_amdgcn_s_setprio(1); _Pragma("unroll") for (int m = 0; m < 4; ++m) _Pragma("unroll") for (int n = 0; n < 2; ++n) { \
            if constexpr (FP8) acc[ai][bj][m][n] = __builtin_amdgcn_mfma_scale_f32_16x16x128_f8f6f4(Bt##8[n], At##8[m], acc[ai][bj][m][n], 0, 0, 0, 0, 0, 0); \
            else { _Pragma("unroll") for (int k = 0; k < 2; ++k) acc[ai][bj][m][n] = __builtin_amdgcn_mfma_f32_16x16x32_bf16(Bt[n][k], At[m][k], acc[ai][bj][m][n], 0, 0, 0); } } __builtin_amdgcn_s_setprio(0); } while (0)
#define PG8_WAIT_V(n) asm volatile("s_waitcnt vmcnt(" #n ")" ::: "memory")
#define PG8_WAIT_L(n) asm volatile("s_waitcnt lgkmcnt(" #n ")" ::: "memory")
#define PG8_BAR __builtin_amdgcn_s_barrier()
#define PG8_SCHED __builtin_amdgcn_sched_barrier(0)
    Unit cur, nxt; int ui = 0;
    if (!S.next(0, cur)) return;
    f32x4 acc[2][2][4][2];
#pragma unroll
    for (int a = 0; a < 2; ++a)
#pragma unroll
        for (int b = 0; b < 2; ++b)
#pragma unroll
            for (int m = 0; m < 4; ++m)
#pragma unroll
                for (int n = 0; n < 2; ++n) acc[a][b][m][n] = (f32x4){0.f, 0.f, 0.f, 0.f};
    bf16x8 At[4][2], B0[2][2], B1[2][2];
    v8i_t At8[4], B08[2], B18[2];
    unsigned ao0[2], ao1[2];
    PG8_AOFF(cur, ao0, ao1);
    const __amdgpu_buffer_rsrc_t rsA = __builtin_amdgcn_make_buffer_rsrc((void*)gA, 0, 0x7fffffff, 0x00020000), rsB = __builtin_amdgcn_make_buffer_rsrc((void*)gBt, 0, 0x7fffffff, 0x00020000);
    unsigned cB = (unsigned)cur.brow0 * (unsigned)KB;
    PG8_STAGE(PG8_SB(0, 0), rsB, voffB, cB); PG8_STAGE(PG8_SB(0, 1), rsB, voffB, cB + hstep); PG8_STAGE(PG8_SA(0, 0), rsA, ao0, 0u); PG8_STAGE(PG8_SA(0, 1), rsA, ao1, 0u);
    if (wr == 1) PG8_BAR;
    PG8_WAIT_V(2); PG8_BAR;
    PG8_STAGE(PG8_SB(1, 0), rsB, voffB, cB + kstepB); PG8_STAGE(PG8_SA(1, 0), rsA, ao0, kstep); PG8_STAGE(PG8_SB(1, 1), rsB, voffB, cB + hstep + kstepB);
    PG8_WAIT_V(6); PG8_BAR;
    for (;;) {
        const bool has_next = S.next(ui + 1, nxt);
        const unsigned nB = has_next ? (unsigned)nxt.brow0 * (unsigned)KB : cB;
        _Pragma("clang loop unroll(disable)") for (int t = 0; t < nt; t += 2) {
            const bool last = (t == nt - 2);
            const unsigned a1 = (unsigned)(t + 1) * kstep;
            const unsigned a2 = last ? 0u : (unsigned)(t + 2) * kstep; const unsigned b2 = last ? nB : cB + (unsigned)(t + 2) * kstepB;
            const unsigned a3 = a2 + kstep; const unsigned b3 = b2 + kstepB;
            PG8_LDB(B0, 0, 0); PG8_LDB(B1, 0, 1); PG8_SCHED; PG8_LDA(At, 0, 0); PG8_STAGE(PG8_SA(1, 1), rsA, ao1, a1);
            if (last && has_next) { PG8_AOFF(nxt, ao0, ao1); }
            PG8_WAIT_V(8); PG8_WAIT_L(0); PG8_BAR; PG8_MMA(0, 0, At, B0); PG8_MMA(0, 1, At, B1); PG8_BAR; PG8_SCHED;
            PG8_LDA(At, 0, 1); PG8_STAGE(PG8_SB(0, 0), rsB, voffB, b2); PG8_STAGE(PG8_SB(0, 1), rsB, voffB, b2 + hstep); PG8_STAGE(PG8_SA(0, 0), rsA, ao0, a2);
            PG8_WAIT_V(8); PG8_WAIT_L(0); PG8_BAR; PG8_MMA(1, 0, At, B0); PG8_MMA(1, 1, At, B1); PG8_BAR; PG8_SCHED;
            PG8_LDB(B0, 1, 0); PG8_LDB(B1, 1, 1); PG8_SCHED; PG8_LDA(At, 1, 0); PG8_STAGE(PG8_SA(0, 1), rsA, ao1, a2);
            PG8_WAIT_V(8); PG8_WAIT_L(0); PG8_BAR; PG8_MMA(0, 0, At, B0); PG8_MMA(0, 1, At, B1); PG8_BAR; PG8_SCHED;
            PG8_LDA(At, 1, 1); PG8_STAGE(PG8_SB(1, 0), rsB, voffB, b3); PG8_STAGE(PG8_SB(1, 1), rsB, voffB, b3 + hstep); PG8_STAGE(PG8_SA(1, 0), rsA, ao0, a3);
            PG8_WAIT_V(8); PG8_WAIT_L(0); PG8_BAR; PG8_MMA(1, 0, At, B0); PG8_MMA(1, 1, At, B1); PG8_BAR; PG8_SCHED;
        }
        if (wr == 0) PG8_BAR;
        if (!skip_epi) E(acc, cur, wr, wc, fr, fq);
        if (!has_next) break;
#pragma unroll
        for (int a = 0; a < 2; ++a)
#pragma unroll
            for (int b = 0; b < 2; ++b)
#pragma unroll
                for (int m = 0; m < 4; ++m)
#pragma unroll
                    for (int n = 0; n < 2; ++n) acc[a][b][m][n] = (f32x4){0.f, 0.f, 0.f, 0.f};
        cur = nxt; cB = nB; ++ui;
        if (wr == 1) PG8_BAR;
    }
    PG8_WAIT_V(0);
    PG8_BAR;
#undef PG8_AOFF
#undef PG8_SA
#undef PG8_SB
#undef PG8_STAGE
#undef PG8_LDA
#undef PG8_LD16A
#undef PG8_LD16B
#undef PG8_RA
#undef PG8_LDB
#undef PG8_MMA
#undef PG8_WAIT_V
#undef PG8_WAIT_L
#undef PG8_BAR
#undef PG8_SCHED
}
}

#define XB_TMO      128
#define XB_XCNT(j)  (256  + 64 * (j))
#define XB_XSUB(j)  (1280 + 64 * (j))
#define XB_XGEN(j)  (2304 + 64 * (j))
#define XB_TOP      3328
#define XB_TOPGEN   3392
#define XCD_BAR_WORDS 3456
#define XB_SPIN_CAP (1u << 18)
__device__ __forceinline__ unsigned xb_ld(unsigned* p)              { return __hip_atomic_load(p, __ATOMIC_RELAXED, __HIP_MEMORY_SCOPE_AGENT); }
__device__ __forceinline__ unsigned xb_add(unsigned* p, unsigned v) { return __hip_atomic_fetch_add(p, v, __ATOMIC_RELAXED, __HIP_MEMORY_SCOPE_AGENT); }
__device__ __forceinline__ unsigned xb_xcc_id() { return (unsigned)__builtin_amdgcn_s_getreg((3 << 11) | 20) & 0xFu; }
#define XB_SPIN(cond, bar) do { unsigned _sp = 0; while (cond) { __builtin_amdgcn_s_sleep(1); \
    if ((++_sp & 255u) == 0u) { if (xb_ld(&(bar)[XB_TMO])) break; if (_sp > XB_SPIN_CAP) { atomicAdd(&(bar)[XB_TMO], 1u); break; } } } } while (0)
struct XcdBarrier { unsigned* bar; unsigned x; volatile LAS unsigned* st; };
__device__ __forceinline__ XcdBarrier xcd_barrier_post(unsigned* bar, volatile LAS unsigned* st) {
    XcdBarrier b; b.bar = bar; b.x = xb_xcc_id(); b.st = st;
    if (threadIdx.x == 0) (void)xb_add(&bar[XB_XCNT(b.x)], 1u);
    return b;
}
__device__ __forceinline__ void xcd_barrier_complete(unsigned* bar, unsigned x, unsigned& nloc, unsigned& nx) {
    const unsigned G = gridDim.x * gridDim.y * gridDim.z;
    unsigned sum, cnt, mine, sp = 0u;
    for (;;) {
        sum = 0u; cnt = 0u; mine = 0u;
#pragma unroll
        for (unsigned j = 0; j < 16; ++j) { const unsigned c = xb_ld(&bar[XB_XCNT(j)]); sum += c; cnt += (c > 0u) ? 1u : 0u; mine = (j == x) ? c : mine; }
        if (sum == G) break;
        __builtin_amdgcn_s_sleep(1);
        if ((++sp & 255u) == 0u) { if (xb_ld(&bar[XB_TMO])) break; if (sp > XB_SPIN_CAP) { atomicAdd(&bar[XB_TMO], 1u); break; } }
    }
    nloc = mine > 0u ? mine : 1u; nx = cnt > 0u ? cnt : 1u;
}
__device__ __forceinline__ void xcd_barrier(const XcdBarrier& b) {
    asm volatile("s_waitcnt vmcnt(0)" ::: "memory");
    __syncthreads();
    if (threadIdx.x == 0) {
        unsigned* bar = b.bar;
        __builtin_amdgcn_s_waitcnt(0);
        unsigned nloc = b.st[0], nx = b.st[1];
        if (nloc == 0u) { xcd_barrier_complete(bar, b.x, nloc, nx); b.st[0] = nloc; b.st[1] = nx; }
        const unsigned old = xb_add(&bar[XB_XSUB(b.x)], 1u);
        const unsigned gen = old / nloc;
        if (old + 1u == (gen + 1u) * nloc) {
            __builtin_amdgcn_fence(__ATOMIC_RELEASE, "agent");
            asm volatile("s_waitcnt vmcnt(0)" ::: "memory");
            const unsigned og = xb_add(&bar[XB_TOP], 1u);
            const unsigned tg = og / nx;
            if (og + 1u == (tg + 1u) * nx) xb_add(&bar[XB_TOPGEN], 1u);
            else XB_SPIN(xb_ld(&bar[XB_TOPGEN]) == tg, bar);
            __builtin_amdgcn_fence(__ATOMIC_ACQUIRE, "agent");
            xb_add(&bar[XB_XGEN(b.x)], 1u);
            asm volatile("s_waitcnt vmcnt(0)" ::: "memory");
        } else {
            XB_SPIN(xb_ld(&bar[XB_XGEN(b.x)]) == gen, bar);
            __builtin_amdgcn_fence(__ATOMIC_ACQUIRE, "agent");
            asm volatile("s_waitcnt vmcnt(0)" ::: "memory");
        }
    }
    __syncthreads();
}

constexpr int RING_BYTES = 131072;
constexpr int ROW_OFF = RING_BYTES, TOK_UNITS = 18;
constexpr int TOK_OFF = ROW_OFF + TOK_UNITS * 1024;
constexpr int TBL_OFF = TOK_OFF + TOK_UNITS * 512;
constexpr int LDSCTL_OFF = TBL_OFF + 512;
constexpr int MK_LDS_BYTES = LDSCTL_OFF + 256;
static_assert(MK_LDS_BYTES <= 160 * 1024, "LDS map");

struct MArgs { const float* in[18]; float* out; unsigned char* ws; int ph_lo, ph_hi; };
struct Frame {
    LAS unsigned char* lds; int tid, lane, wave, vcu, G;
    unsigned char* ws; unsigned* ctl;
};
__device__ __forceinline__ unsigned pkb(float lo, float hi) { return pg8::cvt_pk_bf16(lo, hi); }

struct P0Item { const float* W; const float* g; unsigned char* dst; int K, N, item, mode; };
__device__ __forceinline__ void p0_load32(const P0Item& d, int lane, float (&v)[32], float& g0) {
    const int nblk = d.N / 32, kb = d.item / nblk, nb = d.item - kb * nblk, k0 = 64 * kb, n0 = 32 * nb;
    const float* p = d.W + (size_t)(k0 + (lane >> 5)) * d.N + n0 + (lane & 31);
#pragma unroll
    for (int i = 0; i < 32; ++i) v[i] = p[(size_t)(2 * i) * d.N];
    g0 = d.g ? d.g[k0 + lane] : 1.f;
}
__device__ __forceinline__ void p0_store32(const P0Item& d, int lane, const float (&v)[32], float g0, LAS float* scr) {
    const int nblk = d.N / 32, kb = d.item / nblk, nb = d.item - kb * nblk, k0 = 64 * kb, n0 = 32 * nb;
#pragma unroll
    for (int i = 0; i < 32; ++i) { const int kk = 2 * i + (lane >> 5); scr[kk * 33 + (lane & 31)] = v[i] * lperm(g0, kk); }
    asm volatile("s_waitcnt lgkmcnt(0)" ::: "memory");
    const int c = lane & 7;
#pragma unroll
    for (int j = 0; j < 4; ++j) { const int n = (lane >> 3) + 8 * j; const LAS float* s = scr + (8 * c) * 33 + n;
        u32x4 o; o.x = pkb(s[0 * 33], s[1 * 33]); o.y = pkb(s[2 * 33], s[3 * 33]); o.z = pkb(s[4 * 33], s[5 * 33]); o.w = pkb(s[6 * 33], s[7 * 33]);
        const int nn = n0 + n;
        if (d.mode == 2) *(u32x4*)((bf16_t*)d.dst + (size_t)nn * d.K + k0 + 8 * c) = o;
        else *(u32x4*)(d.dst + ((size_t)((nn >> 8) * (d.K / 64) + (k0 >> 6)) * 256 + (nn & 255)) * 128 + 16 * c) = o; }
    asm volatile("s_waitcnt lgkmcnt(0)" ::: "memory");
}
__device__ __forceinline__ void p0_load64(const P0Item& d, int lane, f32x4 (&v)[16], float& g0) {
    const int nblk = d.N / 64, kb = d.item / nblk, nb = d.item - kb * nblk, k0 = 64 * kb, n0 = 64 * nb;
    const float* p = d.W + (size_t)(k0 + (lane >> 4)) * d.N + n0 + 4 * (lane & 15);
#pragma unroll
    for (int i = 0; i < 16; ++i) v[i] = __builtin_nontemporal_load((const f32x4*)(p + (size_t)(4 * i) * d.N));
    g0 = (d.g ? d.g[k0 + lane] : 1.f) * W8SCALE;
}
__device__ __forceinline__ void p0_store64(const P0Item& d, int lane, const f32x4 (&v)[16], float g0, LAS float* scr) {
    const int nblk = d.N / 64, kb = d.item / nblk, nb = d.item - kb * nblk, k0 = 64 * kb, n0 = 64 * nb;
#pragma unroll
    for (int i = 0; i < 16; ++i) { const int kk = 4 * i + (lane >> 4); const float gg = lperm(g0, kk); LAS float* w = scr + kk * 65 + 4 * (lane & 15); w[0] = v[i].x * gg; w[1] = v[i].y * gg; w[2] = v[i].z * gg; w[3] = v[i].w * gg; }
    asm volatile("s_waitcnt lgkmcnt(0)" ::: "memory");
#pragma unroll
    for (int j = 0; j < 4; ++j) { const int id = lane + 64 * j, n = id >> 2, c = id & 3; const LAS float* s = scr + (16 * c) * 65 + n; unsigned p[4];
#pragma unroll
        for (int q = 0; q < 4; ++q) { unsigned w = 0u; w = __builtin_amdgcn_cvt_pk_fp8_f32(s[(4 * q + 0) * 65], s[(4 * q + 1) * 65], w, false); w = __builtin_amdgcn_cvt_pk_fp8_f32(s[(4 * q + 2) * 65], s[(4 * q + 3) * 65], w, true); p[q] = w; }
        int nn = n0 + n; if (d.mode == 1) { const int half = nn / FF, j2 = nn % FF; nn = (j2 >> 7) * 256 + half * 128 + (j2 & 127); }
        *(u32x4*)(d.dst + ((size_t)((nn >> 8) * (d.K / 128) + (k0 >> 7)) * 256 + (nn & 255)) * 128 + (k0 & 127) + 16 * c) = (u32x4){p[0], p[1], p[2], p[3]}; }
    asm volatile("s_waitcnt lgkmcnt(0)" ::: "memory");
}
__device__ __forceinline__ void p0_big(Frame& F, const MArgs& args, int cw, int ncw, LAS float* scr) {
    const int gw = F.vcu * ncw + cw, NGW = F.G * ncw, lane = F.lane;
    unsigned char* ws = F.ws;
    const float* g_moe = args.in[7]; const float* w_gu = args.in[10]; const float* w_down = args.in[12]; const float* g_ple = args.in[14]; const float* w_ple_gate = args.in[15];
    {
        constexpr int J_GU = (DM / 64) * (2 * FF / 64), J_WD = (FF / 64) * (DM / 64), J_WG = (DM / 64) * (DM / 64);
        constexpr int PER_LAYER8 = NE * J_GU + NE * J_WD + J_WG, NIT = DEPTH * PER_LAYER8;
        auto decode = [&](int it) -> P0Item {
            const int L = it / PER_LAYER8; int r = it - L * PER_LAYER8;
            if (r < NE * J_GU) { const int e = r / J_GU; const size_t m = (size_t)L * NE + e; return P0Item{w_gu + m * DM * 2 * FF, g_moe + L * DM, ws + WS_WGU8 + m * 2 * FF * DM, DM, 2 * FF, r - e * J_GU, 1}; } r -= NE * J_GU;
            if (r < NE * J_WD) { const int e = r / J_WD; const size_t m = (size_t)L * NE + e; return P0Item{w_down + m * FF * DM, nullptr, ws + WS_WD8 + m * DM * FF, FF, DM, r - e * J_WD, 0}; } r -= NE * J_WD;
            return P0Item{w_ple_gate + (size_t)L * DM * DM, g_ple + L * DM, ws + WS_WG8 + (size_t)L * DM * DM, DM, DM, r, 0};
        };
        f32x4 va[16], vb[16]; float ga = 1.f, gb = 1.f; P0Item da{}, db{};
        int it = gw;
        if (it < NIT) { da = decode(it); p0_load64(da, lane, va, ga); }
        while (it < NIT) {
            const int itb = it + NGW; const bool hb = itb < NIT;
            if (hb) { db = decode(itb); p0_load64(db, lane, vb, gb); }
            p0_store64(da, lane, va, ga, scr);
            const int itc = itb + NGW; const bool hc = itc < NIT;
            if (hc) { da = decode(itc); p0_load64(da, lane, va, ga); }
            if (hb) p0_store64(db, lane, vb, gb, scr);
            it = itc;
        }
    }
}
__device__ __forceinline__ void p0_prologue(Frame& F, const MArgs& args) {
    static_assert(MK_FP8_MASK == 3 && MK_PLE8 == 1, "this prologue converts the expert and PLE gate matrices to fp8 only");
    LAS float* scr = (LAS float*)(F.lds + F.wave * 16896);
    const int gw = F.vcu * MK_WAVES + F.wave, NGW = F.G * MK_WAVES, lane = F.lane;
    unsigned char* ws = F.ws;
    const float* g_mix = args.in[2]; const float* w_qkv = args.in[3]; const float* w_fgate = args.in[4]; const float* w_o = args.in[6]; const float* g_moe = args.in[7]; const float* w_router = args.in[8];
    const float* w_gu = args.in[10]; const float* w_down = args.in[12]; const float* g_ple = args.in[14]; const float* w_ple_gate = args.in[15]; const float* w_ple_proj = args.in[16];
    {
        constexpr int I_QKV = (DM / 64) * (3 * DM / 32), I_SQ = (DM / 64) * (DM / 32), I_WP = (PLE / 64) * (DM / 32), I_WR = (DM / 64) * (NE / 32);
        constexpr int PER_LAYER = I_QKV + I_SQ + I_WP + I_WR, NIT = DEPTH * PER_LAYER;
        auto decode = [&](int it) -> P0Item {
            const int L = it / PER_LAYER; int r = it - L * PER_LAYER;
            if (r < I_QKV) return P0Item{w_qkv + (size_t)L * DM * 3 * DM, g_mix + L * DM, ws + WS_WQKV + (size_t)L * 3 * DM * DM * 2, DM, 3 * DM, r, 0}; r -= I_QKV;
            if (r < I_SQ) return P0Item{w_o + (size_t)L * DM * DM, nullptr, ws + WS_WO + (size_t)L * DM * DM * 2, DM, DM, r, 0}; r -= I_SQ;
            if (r < I_WP) return P0Item{w_ple_proj + (size_t)L * PLE * DM, nullptr, ws + WS_WP + (size_t)L * DM * PLE * 2, PLE, DM, r, 0}; r -= I_WP;
            return P0Item{w_router + (size_t)L * DM * NE, g_moe + L * DM, ws + WS_WR + (size_t)L * NE * DM * 2, DM, NE, r, 2};
        };
        float va[32]; float ga = 1.f;
        for (int it = gw; it < NIT; it += NGW) { const P0Item d = decode(it); p0_load32(d, lane, va, ga); p0_store32(d, lane, va, ga, scr); }
    }
    if (gw < 256) { bf16_t* WF = (bf16_t*)(ws + WS_WF); const int idx = gw * 64 + lane; const int n = idx >> 10, k = idx & 1023; WF[idx] = (bf16_t)f2bf(w_fgate[(size_t)k * NH + n] * g_mix[DM + k]); }
    {
        const float* x = args.in[0]; bf16_t* HB = (bf16_t*)(ws + WS_HB); float* SS = (float*)(ws + WS_SS);
        for (int row0 = gw * 4; row0 < NTOK; row0 += NGW * 4) {
            f32x4 v[4][4];
#pragma unroll
            for (int q = 0; q < 4; ++q) { const f32x4* p = (const f32x4*)(x + (size_t)(row0 + q) * DM) + lane;
#pragma unroll
                for (int j = 0; j < 4; ++j) v[q][j] = p[64 * j]; }
#pragma unroll
            for (int q = 0; q < 4; ++q) { float s = 0.f;
#pragma unroll
                for (int j = 0; j < 4; ++j) s += v[q][j].x * v[q][j].x + v[q][j].y * v[q][j].y + v[q][j].z * v[q][j].z + v[q][j].w * v[q][j].w;
                s = lwave_sum(s, lane);
                if (lane < 16) SS[(size_t)(row0 + q) * 16 + lane] = (lane == 0) ? s : 0.f;
                u32x2* o = (u32x2*)(HB + (size_t)(row0 + q) * DM) + lane;
#pragma unroll
                for (int j = 0; j < 4; ++j) { u32x2 w; w.x = pkb(v[q][j].x, v[q][j].y); w.y = pkb(v[q][j].z, v[q][j].w); o[64 * j] = w; } }
        }
        const float* pp = args.in[1]; bf16_t* PB = (bf16_t*)(ws + WS_PB);
        const size_t n4 = (size_t)DEPTH * NTOK * PLE / 4;
        for (size_t i = (size_t)gw * 64 + lane; i < n4; i += (size_t)NGW * 64 * 4) {
            f32x4 v[4];
#pragma unroll
            for (int q = 0; q < 4; ++q) { const size_t ii = i + (size_t)q * NGW * 64; if (ii < n4) v[q] = ((const f32x4*)pp)[ii]; }
#pragma unroll
            for (int q = 0; q < 4; ++q) { const size_t ii = i + (size_t)q * NGW * 64; if (ii < n4) { u32x2 w; w.x = pkb(v[q].x, v[q].y); w.y = pkb(v[q].z, v[q].w); ((u32x2*)PB)[ii] = w; } }
        }
    }
}

__device__ __forceinline__ void moe_tables(Frame& F, const unsigned* cnt) {
    LAS int* tstartL = (LAS int*)(F.lds + TBL_OFF); LAS int* cntL = tstartL + 64;
    if (F.wave == 0) {
        const int lane = F.lane; const int c = (lane < NE) ? (int)__hip_atomic_load(cnt + CNT_STRIDE * (lane & 31), __ATOMIC_RELAXED, __HIP_MEMORY_SCOPE_AGENT) : 0; const int nt = (c + 255) >> 8; int incl = nt;
#pragma unroll
        for (int o = 1; o < 32; o <<= 1) { const int t = lpermi(incl, lane - o); if ((lane & 31) >= o) incl += t; }
        if (lane < NE) { tstartL[lane] = incl - nt; cntL[lane] = c; if (lane == NE - 1) tstartL[NE] = incl; }
    }
    __syncthreads();
}
__device__ __forceinline__ void router_phase(Frame& F, const bf16_t* HB, const bf16_t* WR, const float* br, float* rstd, unsigned* cnt, int* tok_of, float* gate_of, unsigned* pair) {
    const int gw = F.vcu * MK_WAVES + F.wave, NGW = F.G * MK_WAVES, lane = F.lane, r = lane & 15, quad = lane >> 4;
    LAS unsigned* hist = (LAS unsigned*)(F.lds); LAS unsigned* gbase = hist + 32;
    LAS unsigned char* wl = F.lds + 1024; constexpr int WLS = 2064;
    for (int i = F.tid; i < NE * 128; i += MK_WAVES * 64) { const int row = i >> 7, ch = i & 127; *(LAS u32x4*)(wl + row * WLS + ch * 16) = *(const u32x4*)(WR + (size_t)row * DM + ch * 8); }
    __syncthreads();
    for (int it = 0; it * NGW < NTOK / 16; ++it) {
        const int blk = it * NGW + gw; const bool valid = blk < NTOK / 16;
        if (F.tid < 32) hist[F.tid] = 0u;
        __syncthreads();
        int see[4]; unsigned slr[4]; float sgt[4];
        const int t0 = blk * 16;
        if (valid) {
            const bf16_t* ap = HB + (size_t)(t0 + r) * DM + quad * 8; const LAS unsigned char* bl0 = wl + r * WLS + quad * 16; const LAS unsigned char* bl1 = bl0 + 16 * WLS;
            f32x4 acc0 = {0.f, 0.f, 0.f, 0.f}, acc1 = {0.f, 0.f, 0.f, 0.f}; float ssq = 0.f;
#pragma unroll 16
            for (int ks = 0; ks < 32; ++ks) { const bf16x8 a = *(const bf16x8*)(ap + 32 * ks), b0 = *(const LAS bf16x8*)(bl0 + 64 * ks), b1 = *(const LAS bf16x8*)(bl1 + 64 * ks);
                acc0 = __builtin_amdgcn_mfma_f32_16x16x32_bf16(a, b0, acc0, 0, 0, 0); acc1 = __builtin_amdgcn_mfma_f32_16x16x32_bf16(a, b1, acc1, 0, 0, 0);
#pragma unroll
                for (int j = 0; j < 8; ++j) { const float f = __uint_as_float(((unsigned)(unsigned short)a[j]) << 16); ssq += f * f; } }
            ssq += lperm(ssq, lane ^ 16); ssq += lperm(ssq, lane ^ 32);
            const float rs_r = rsqrtf(ssq * (1.f / DM) + EPS);
            const float b_lo = br[r], b_hi = br[16 + r];
#pragma unroll
            for (int j = 0; j < 4; ++j) {
                const float rsj = lperm(rs_r, quad * 4 + j); const int t = t0 + quad * 4 + j;
                float v0 = acc0[j] * rsj + b_lo, v1 = acc1[j] * rsj + b_hi; float tv[4]; int ti[4];
#pragma unroll
                for (int k = 0; k < 4; ++k) {
                    float bv = (v0 >= v1) ? v0 : v1; int bi = (v0 >= v1) ? r : 16 + r;
#pragma unroll
                    for (int o = 1; o < 16; o <<= 1) { const float ov = lperm(bv, lane ^ o); const int oi = lpermi(bi, lane ^ o); if (ov > bv || (ov == bv && oi < bi)) { bv = ov; bi = oi; } }
                    tv[k] = bv; ti[k] = bi; if (bi == r) v0 = -INFINITY; if (bi == 16 + r) v1 = -INFINITY;
                }
                float w[4], sw = 0.f;
#pragma unroll
                for (int k = 0; k < 4; ++k) { w[k] = __expf(tv[k] - tv[0]); sw += w[k]; }
                const int ee = (r == 0) ? ti[0] : (r == 1) ? ti[1] : (r == 2) ? ti[2] : ti[3]; const float ww = (r == 0) ? w[0] : (r == 1) ? w[1] : (r == 2) ? w[2] : w[3];
                see[j] = ee; sgt[j] = ww / sw; slr[j] = 0u;
                if (r < 4) slr[j] = __hip_atomic_fetch_add(hist + ee, 1u, __ATOMIC_RELAXED, __HIP_MEMORY_SCOPE_WORKGROUP);
                if (r == 4) rstd[t] = rsj;
            }
        }
        __syncthreads();
        if (F.tid < 32) { const unsigned n = hist[F.tid]; gbase[F.tid] = n ? __hip_atomic_fetch_add(cnt + CNT_STRIDE * F.tid, n, __ATOMIC_RELAXED, __HIP_MEMORY_SCOPE_AGENT) : 0u; }
        __syncthreads();
        if (valid && r < 4) {
#pragma unroll
            for (int j = 0; j < 4; ++j) { const int t = t0 + quad * 4 + j; const int ee = see[j]; const unsigned rk = gbase[ee] + slr[j];
                tok_of[(size_t)ee * CAP + rk] = t; gate_of[(size_t)ee * CAP + rk] = sgt[j]; pair[(size_t)t * 4 + r] = ((unsigned)ee << 16) | rk; }
        }
        __syncthreads();
    }
}
__device__ __forceinline__ void fgate_phase(Frame& F, const bf16_t* HB, const bf16_t* WF, const float* bfg, const float* SS, float* FL) {
    const int gw = F.vcu * MK_WAVES + F.wave, NGW = F.G * MK_WAVES, lane = F.lane, r = lane & 15, quad = lane >> 4;
    for (int blk = gw; blk < NTOK / 16; blk += NGW) {
        const int t0 = blk * 16;
        const bf16_t* ap = HB + (size_t)(t0 + r) * DM + quad * 8; const bf16_t* bp0 = WF + (size_t)r * DM + quad * 8;
        f32x4 acc0 = {0.f, 0.f, 0.f, 0.f};
#pragma unroll 8
        for (int ks = 0; ks < 32; ++ks) { const bf16x8 a = *(const bf16x8*)(ap + 32 * ks), b0 = *(const bf16x8*)(bp0 + 32 * ks); acc0 = __builtin_amdgcn_mfma_f32_16x16x32_bf16(a, b0, acc0, 0, 0, 0); }
        const f32x4 sp = *(const f32x4*)(SS + (size_t)(t0 + r) * 16 + quad * 4); float ss = (sp.x + sp.y) + (sp.z + sp.w); ss += lperm(ss, lane ^ 16); ss += lperm(ss, lane ^ 32);
        const float rs_r = rsqrtf(ss * (1.f / DM) + EPS); const float bb = bfg[r];
#pragma unroll
        for (int j = 0; j < 4; ++j) { const float rsj = lperm(rs_r, quad * 4 + j); FL[(size_t)(t0 + quad * 4 + j) * NH + r] = acc0[j] * rsj + bb; }
    }
}
__device__ __forceinline__ void combine_phase(Frame& F, const bf16_t* hin, bf16_t* hout, unsigned char* hout8, float* rstd, const unsigned* pair, const bf16_t* Y, const bool y8) {
    const int gw = F.vcu * MK_WAVES + F.wave, NGW = F.G * MK_WAVES, lane = F.lane; const LAS int* tstartL = (const LAS int*)(F.lds + TBL_OFF);
    constexpr int CMB_Q = 2;
    for (int t0 = gw; t0 < NTOK; t0 += CMB_Q * NGW) {
        int tt[CMB_Q];
#pragma unroll
        for (int q = 0; q < CMB_Q; ++q) tt[q] = (t0 + q * NGW < NTOK) ? t0 + q * NGW : t0;
        u32x4 pr4[CMB_Q]; u32x2 hw[CMB_Q][4]; u32x2 yw[CMB_Q][4][4];
#pragma unroll
        for (int q = 0; q < CMB_Q; ++q) pr4[q] = *(const u32x4*)(pair + (size_t)tt[q] * 4);
#pragma unroll
        for (int q = 0; q < CMB_Q; ++q) { const u32x2* hr = (const u32x2*)(hin + (size_t)tt[q] * DM) + lane;
#pragma unroll
            for (int j = 0; j < 4; ++j) hw[q][j] = hr[64 * j]; }
#pragma unroll
        for (int q = 0; q < CMB_Q; ++q)
#pragma unroll
            for (int k = 0; k < 4; ++k) { const unsigned pr = (k == 0) ? pr4[q].x : (k == 1) ? pr4[q].y : (k == 2) ? pr4[q].z : pr4[q].w; const int e = __builtin_amdgcn_readfirstlane((int)(pr >> 16)), rk = __builtin_amdgcn_readfirstlane((int)(pr & 0xffffu));
                const size_t slot = (size_t)tstartL[e] * 256 + rk;
                if (y8) { const unsigned* yr = (const unsigned*)((const unsigned char*)Y + slot * DM) + lane;
#pragma unroll
                    for (int j = 0; j < 4; ++j) { yw[q][k][j].x = yr[64 * j]; yw[q][k][j].y = 0u; } }
                else { const u32x2* yr = (const u32x2*)(Y + slot * DM) + lane;
#pragma unroll
                    for (int j = 0; j < 4; ++j) yw[q][k][j] = yr[64 * j]; } }
#pragma unroll
        for (int q = 0; q < CMB_Q; ++q) { const int t = tt[q]; f32x4 v[4];
#pragma unroll
            for (int j = 0; j < 4; ++j) { v[j].x = __uint_as_float(hw[q][j].x << 16); v[j].y = __uint_as_float(hw[q][j].x & 0xffff0000u); v[j].z = __uint_as_float(hw[q][j].y << 16); v[j].w = __uint_as_float(hw[q][j].y & 0xffff0000u);
#pragma unroll
                for (int k = 0; k < 4; ++k) { const u32x2 w = yw[q][k][j];
                    if (y8) { typedef float f32x2_ __attribute__((ext_vector_type(2))); const f32x2_ lo = __builtin_amdgcn_cvt_pk_f32_fp8((int)w.x, false), hi = __builtin_amdgcn_cvt_pk_f32_fp8((int)w.x, true); v[j].x += lo.x; v[j].y += lo.y; v[j].z += hi.x; v[j].w += hi.y; }
                    else { v[j].x += __uint_as_float(w.x << 16); v[j].y += __uint_as_float(w.x & 0xffff0000u); v[j].z += __uint_as_float(w.y << 16); v[j].w += __uint_as_float(w.y & 0xffff0000u); } } }
            float s = 0.f; u32x2* o = (u32x2*)(hout + (size_t)t * DM) + lane;
#pragma unroll
            for (int j = 0; j < 4; ++j) { u32x2 w; w.x = pkb(v[j].x, v[j].y); w.y = pkb(v[j].z, v[j].w); o[64 * j] = w;
                if (hout8) { unsigned p = 0u; p = __builtin_amdgcn_cvt_pk_fp8_f32(v[j].x, v[j].y, p, false); p = __builtin_amdgcn_cvt_pk_fp8_f32(v[j].z, v[j].w, p, true); ((unsigned*)(hout8 + (size_t)t * DM))[lane + 64 * j] = p; }
                const float q0 = __uint_as_float(w.x << 16), q1 = __uint_as_float(w.x & 0xffff0000u), q2 = __uint_as_float(w.y << 16), q3 = __uint_as_float(w.y & 0xffff0000u); s += (q0 * q0 + q1 * q1) + (q2 * q2 + q3 * q3); }
            s = lwave_sum(s, lane); if (lane == 0) rstd[t] = rsqrtf(s * (1.f / DM) + EPS); }
    }
}
__device__ __forceinline__ void final_phase(Frame& F, const bf16_t* hb, const float* SS, const float* g, float* out) {
    const int gw = F.vcu * MK_WAVES + F.wave, NGW = F.G * MK_WAVES, lane = F.lane;
    f32x4 gg[4];
#pragma unroll
    for (int j = 0; j < 4; ++j) gg[j] = ((const f32x4*)g)[lane + 64 * j];
    for (int row0 = gw; row0 < NTOK; row0 += 4 * NGW) {
        u32x2 w[4][4]; float ss[4]; int rr[4];
#pragma unroll
        for (int q = 0; q < 4; ++q) { rr[q] = (row0 + q * NGW < NTOK) ? row0 + q * NGW : row0; const u32x2* p = (const u32x2*)(hb + (size_t)rr[q] * DM) + lane;
#pragma unroll
            for (int j = 0; j < 4; ++j) w[q][j] = p[64 * j];
            ss[q] = (lane < 16) ? SS[(size_t)rr[q] * 16 + lane] : 0.f; }
#pragma unroll
        for (int q = 0; q < 4; ++q) { const float rs = rsqrtf(lwave_sum(ss[q], lane) * (1.f / DM) + EPS); f32x4* o = (f32x4*)(out + (size_t)rr[q] * DM) + lane;
#pragma unroll
            for (int j = 0; j < 4; ++j) { f32x4 v; v.x = __uint_as_float(w[q][j].x << 16); v.y = __uint_as_float(w[q][j].x & 0xffff0000u); v.z = __uint_as_float(w[q][j].y << 16); v.w = __uint_as_float(w[q][j].y & 0xffff0000u); o[64 * j] = v * rs * gg[j]; } }
    }
}
__device__ __forceinline__ void fox_head(Frame& F, unsigned char* lds_generic, int bh, const bf16_t* Q, const bf16_t* K, const bf16_t* V, const float* FL, bf16_t* O) {
    int tid_ = threadIdx.x; asm volatile("" : "+v"(tid_));
    const int lane = tid_ & 63, b = bh / NH, hh = bh % NH; const size_t rowb = (size_t)b * SEQ;
    LAS float* cbL = (LAS float*)(F.lds + attn_body::ATTN_LDS_BYTES); LAS float* wtot = cbL + SEQ;
    {
        float loc[4]; float run = 0.f;
#pragma unroll
        for (int i = 0; i < 4; ++i) { run += log_sigmoid(FL[(size_t)(rowb + tid_ * 4 + i) * NH + hh]); loc[i] = run; }
        float incl = run;
#pragma unroll
        for (int o = 1; o < 64; o <<= 1) { const float t = lperm(incl, lane - o); if (lane >= o) incl += t; }
        if (lane == 63) wtot[F.wave] = incl;
        __syncthreads();
        float base = incl - run;
        for (int w = 0; w < F.wave; ++w) base += wtot[w];
#pragma unroll
        for (int i = 0; i < 4; ++i) cbL[tid_ * 4 + i] = -(base + loc[i]) * LOG2E;
        __syncthreads();
    }
    for (int qb = 0; qb < SEQ / 256; ++qb)
        attn_body::attn_unit<8>(b, hh, qb, (const attn_body::bf16*)Q, (const attn_body::bf16*)K, (const attn_body::bf16*)V, (attn_body::bf16*)O, (char*)lds_generic, cbL);
}
constexpr int N_PHASES = 18;
__global__ void __launch_bounds__(MK_WAVES * 64, 2) mega_fwd(MArgs args) {
    extern __shared__ __attribute__((aligned(16))) unsigned char lds_raw[];
    Frame F;
    F.lds = (LAS unsigned char*)lds_raw;
    F.tid = threadIdx.x; F.lane = F.tid & 63; F.wave = __builtin_amdgcn_readfirstlane(F.tid >> 6);
    F.G = gridDim.x; { const int bx = blockIdx.x; F.vcu = (F.G % 8 == 0) ? (bx % 8) * (F.G / 8) + bx / 8 : bx; }
    F.ws = args.ws; F.ctl = (unsigned*)(args.ws + WS_CTL);
    unsigned char* ws = args.ws;
    for (int u = F.tid; u < (MK_LDS_BYTES - LDSCTL_OFF) / 4; u += MK_WAVES * 64) ((LAS unsigned*)(F.lds + LDSCTL_OFF))[u] = 0u;
    __syncthreads();
    const int lo = args.ph_lo, hi = args.ph_hi;
    const bool use_bar = (hi - lo) > 1;
    XcdBarrier bar; bar.bar = F.ctl + CW_BAR; bar.x = 0; bar.st = nullptr;
    if (use_bar) bar = xcd_barrier_post(F.ctl + CW_BAR, (volatile LAS unsigned*)(F.lds + LDSCTL_OFF + 32));
#ifndef MK_DUP
#define MK_DUP 0
#endif
#define NREP(j) (((MK_DUP >> (j)) & 1) ? 2 : 1)
#ifndef MK_QKVPROBE
#define MK_QKVPROBE 0
#endif
#ifndef MK_NSB
#define MK_NSB 5
#endif
#ifndef MK_Y8_MASK
#define MK_Y8_MASK 3
#endif
#ifndef MK_ATTSUB
#define MK_ATTSUB 3
#endif
#ifndef MK_P0SUB
#define MK_P0SUB 7
#endif
#ifndef MK_PHMASK
#define MK_PHMASK 0x3ff
#endif
#define IN(k) (lo <= (k) && (k) < hi)
#define EN(j) ((MK_PHMASK >> (j)) & 1)
#define PHASE_BEGIN() do { int t_ = threadIdx.x; asm volatile("" : "+v"(t_)); F.tid = t_; F.lane = t_ & 63; } while (0)
#define SEAM(k) do { if (IN(k) && IN((k) + 1)) xcd_barrier(bar); } while (0)
    bf16_t* const HB0 = (bf16_t*)(ws + WS_HB); bf16_t* const HB1 = (bf16_t*)(ws + WS_HB2); float* const SS = (float*)(ws + WS_SS);
    bf16_t* const Qb = (bf16_t*)(ws + WS_Q); bf16_t* const Kb = (bf16_t*)(ws + WS_K); bf16_t* const Vb = (bf16_t*)(ws + WS_V); bf16_t* const Ob = (bf16_t*)(ws + WS_O);
    float* const rstd_moe = (float*)(ws + WS_RSTD) + NTOK; float* const rstd_ple = rstd_moe + NTOK;
    int* const tok_of = (int*)(ws + WS_TOK); float* const gate_of = (float*)(ws + WS_GATE); unsigned* const pair = (unsigned*)(ws + WS_PAIR);
    bf16_t* const ACT = (bf16_t*)(ws + WS_ACT); bf16_t* const Yb = (bf16_t*)(ws + WS_Y); float* const FL = (float*)(ws + WS_FL);
    LAS int* const tstartL = (LAS int*)(F.lds + TBL_OFF); LAS int* const cntL = tstartL + 64; LAS unsigned short* const tokL = (LAS unsigned short*)(F.lds + TOK_OFF); LAS float* const rowL = (LAS float*)(F.lds + ROW_OFF);

    if (EN(8) && IN(0)) { for (int rep_ = 0; rep_ < NREP(8); ++rep_) p0_prologue(F, args); }
    SEAM(0);
    for (int L = 0; L < DEPTH; ++L) {
        const int pb = 1 + 8 * L;
        unsigned* const cnt = F.ctl + CW_CNT2 + 2048 * L;
        const bool f8 = (L == 0) ? bool(MK_FP8_MASK & 1) : bool(MK_FP8_MASK & 2);
        bf16_t* const HBa = (L & 1) ? HB1 : HB0; bf16_t* const HBb = (L & 1) ? HB0 : HB1;
        if (EN(0) && IN(pb + 0)) for (int rep_ = 0; rep_ < NREP(0); ++rep_) { PHASE_BEGIN();
            if (MK_P0SUB & 1) if (L == 1) fgate_phase(F, HBa, (const bf16_t*)(ws + WS_WF), args.in[5], SS, FL);
            if (MK_P0SUB & 2) { pg8::DenseOrder S; S.init(NTOK, 3 * DM, F.G, (int)blockIdx.x); pg8::EpiQKV E{Qb, rowL, 0}; pg8::EpiQKV Ep{Qb, rowL, MK_QKVPROBE};
              _Pragma("clang loop unroll(disable)") for (int i0 = 0; i0 < TOK_UNITS; i0 += 2) { const int i = i0 + (F.wave >> 2); pg8::Unit u; if (S.next(i, u)) { const int lr = F.tid & 255; const f32x4* sp = (const f32x4*)(SS + (size_t)(u.arow0 + lr) * 16);
                  const f32x4 s0 = sp[0], s1 = sp[1], s2 = sp[2], s3 = sp[3]; const float ss = ((s0.x + s0.y) + (s0.z + s0.w)) + ((s1.x + s1.y) + (s1.z + s1.w)) + ((s2.x + s2.y) + (s2.z + s2.w)) + ((s3.x + s3.y) + (s3.z + s3.w));
                  rowL[i * 256 + lr] = rsqrtf(ss * (1.f / DM) + EPS); } }
              __syncthreads();
              if (NREP(13) > 1) pg8::gemm_phase(F.lds, HBa, (const bf16_t*)(ws + WS_WQKV) + (size_t)L * 3 * DM * DM, 2 * DM, S, E, true);
              if (NREP(14) > 1) pg8::gemm_phase(F.lds, HBa, (const bf16_t*)(ws + WS_WQKV) + (size_t)L * 3 * DM * DM, 2 * DM, S, Ep, false);
              if (NREP(15) > 1) { pg8::HotOrder Sh; Sh.d = S; pg8::gemm_phase(F.lds, HBa, (const bf16_t*)(ws + WS_WQKV) + (size_t)L * 3 * DM * DM, 2 * DM, Sh, Ep, false); }
              pg8::gemm_phase(F.lds, HBa, (const bf16_t*)(ws + WS_WQKV) + (size_t)L * 3 * DM * DM, 2 * DM, S, E); }
            if (MK_P0SUB & 4) if (L == 0) { pg8::PJOrder S; S.init(F.G, (int)blockIdx.x); pg8::EpiPJ E{(bf16_t*)(ws + WS_PJ)};
                pg8::gemm_phase(F.lds, (const bf16_t*)(ws + WS_PB), (const bf16_t*)(ws + WS_WP), 2 * PLE, S, E); }
        }
        SEAM(pb + 0);
        if (EN(1) && IN(pb + 1)) for (int rep_ = 0; rep_ < (NREP(1) > 1 ? 2 : (L == 0 ? NREP(10) : NREP(11))); ++rep_) { PHASE_BEGIN();
            if (L == 0) {
                if (F.wave < MK_NSB) { if (MK_ATTSUB & 1) for (int bh = blockIdx.x; bh < NB * NH; bh += F.G) sb_body::sb_head(F.lds, bh, Qb, Kb, Vb, Ob); }
                else p0_big(F, args, F.wave - MK_NSB, MK_WAVES - MK_NSB, (LAS float*)(F.lds + MK_NSB * 16384 + (F.wave - MK_NSB) * 16896));
            }
            else { if (MK_ATTSUB & 2) for (int bh = blockIdx.x; bh < NB * NH; bh += F.G) { fox_head(F, lds_raw, bh, Qb, Kb, Vb, FL, Ob); __syncthreads(); } }
        }
        SEAM(pb + 1);
        if (EN(2) && IN(pb + 2)) for (int rep_ = NREP(2) - 1; rep_ >= 0; --rep_) { PHASE_BEGIN();
            pg8::DenseOrder S; S.init(NTOK, DM, F.G, (int)blockIdx.x); pg8::EpiWo E{HBa, rep_ ? (bf16_t*)(ws + WS_ACT + 128 * MiB) : HBb, f8 ? (rep_ ? ws + WS_ACT + 210 * MiB : ws + WS_HB8) : nullptr};
            pg8::gemm_phase(F.lds, Ob, (const bf16_t*)(ws + WS_WO) + (size_t)L * DM * DM, 2 * DM, S, E);
        }
        SEAM(pb + 2);
        if (EN(3) && IN(pb + 3)) for (int rep_ = NREP(3) - 1; rep_ >= 0; --rep_) { PHASE_BEGIN(); unsigned char* dd = ws + WS_ACT + 192 * MiB;
            if (rep_) router_phase(F, HBb, (const bf16_t*)(ws + WS_WR) + (size_t)L * NE * DM, args.in[9] + L * NE, (float*)(dd + 9 * MiB), F.ctl + CW_CNT2 + 4096 + 2048 * L, (int*)dd, (float*)(dd + 4 * MiB), (unsigned*)(dd + 8 * MiB));
            else router_phase(F, HBb, (const bf16_t*)(ws + WS_WR) + (size_t)L * NE * DM, args.in[9] + L * NE, rstd_moe, cnt, tok_of, gate_of, pair); }
        SEAM(pb + 3);
        if (EN(4) && IN(pb + 4)) for (int rep_ = (NREP(4) > 1 || NREP(12) > 1) ? 1 : 0; rep_ >= 0; --rep_) { PHASE_BEGIN(); const bool skip_ = rep_ && NREP(12) > 1;
            moe_tables(F, cnt);
            pg8::MoeOrder S; S.NN = 8; S.nwg = tstartL[NE] * 8; S.G = F.G; S.c = (int)blockIdx.x; S.lane = F.lane; S.tstartL = tstartL; S.cntL = cntL; S.tokL = tokL; S.gather = true;
            _Pragma("clang loop unroll(disable)") for (int k0 = 0; k0 < TOK_UNITS / 2; k0 += 3) {
                int tokv[3]; float rsv[3]; bool okv[3]; const int lr = F.tid & 255;
#pragma unroll
                for (int k = 0; k < 3; ++k) { pg8::Unit u; okv[k] = S.next(2 * (k0 + k) + (F.wave >> 2), u); const int rk = u.rank0 + lr; tokv[k] = okv[k] ? tok_of[(size_t)u.e * CAP + (rk < u.cnt ? rk : u.rank0)] : 0; }
#pragma unroll
                for (int k = 0; k < 3; ++k) rsv[k] = okv[k] ? rstd_moe[tokv[k]] : 0.f;
#pragma unroll
                for (int k = 0; k < 3; ++k) if (okv[k]) { const int i = 2 * (k0 + k) + (F.wave >> 2); tokL[i * 256 + lr] = (unsigned short)tokv[k]; rowL[i * 256 + lr] = rsv[k] * (f8 ? W8INV : 1.f); }
            }
            __syncthreads();
            if (f8) { pg8::EpiGU<true> E{ws + WS_ACT8, args.in[11] + (size_t)L * NE * 2 * FF, rowL};
                pg8::gemm_phase<pg8::EpiGU<true>, pg8::MoeOrder, true>(F.lds, ws + WS_HB8, ws + WS_WGU8 + (size_t)L * NE * 2 * FF * DM, DM, S, E, skip_); }
            else { pg8::EpiGU<false> E{ACT, args.in[11] + (size_t)L * NE * 2 * FF, rowL};
                pg8::gemm_phase(F.lds, HBb, (const bf16_t*)(ws + WS_WGU) + (size_t)L * NE * 2 * FF * DM, 2 * DM, S, E); }
        }
        SEAM(pb + 4);
        if (EN(5) && IN(pb + 5)) for (int rep_ = 0; rep_ < NREP(5); ++rep_) { PHASE_BEGIN();
            moe_tables(F, cnt);
            pg8::MoeOrder S; S.NN = 4; S.nwg = tstartL[NE] * 4; S.G = F.G; S.c = (int)blockIdx.x; S.lane = F.lane; S.tstartL = tstartL; S.cntL = cntL; S.tokL = tokL; S.gather = false;
            _Pragma("clang loop unroll(disable)") for (int k0 = 0; k0 < 6; k0 += 3) {
                float gv[3]; bool okv[3]; const int lr = F.tid & 255;
#pragma unroll
                for (int k = 0; k < 3; ++k) { pg8::Unit u; okv[k] = S.next(2 * (k0 + k) + (F.wave >> 2), u); const int rk = u.rank0 + lr; gv[k] = (okv[k] && rk < u.cnt) ? gate_of[(size_t)u.e * CAP + rk] : 0.f; }
#pragma unroll
                for (int k = 0; k < 3; ++k) if (okv[k]) rowL[(2 * (k0 + k) + (F.wave >> 2)) * 256 + lr] = gv[k] * (f8 ? W8INV : 1.f);
            }
            __syncthreads();
            const bool y8 = (MK_Y8_MASK >> L) & 1;
            pg8::EpiDown E{Yb, args.in[13] + (size_t)L * NE * DM, rowL, f8 ? W8SCALE : 1.f, y8};
            if (f8) pg8::gemm_phase<pg8::EpiDown, pg8::MoeOrder, true>(F.lds, ws + WS_ACT8, ws + WS_WD8 + (size_t)L * NE * DM * FF, FF, S, E);
            else pg8::gemm_phase(F.lds, ACT, (const bf16_t*)(ws + WS_WD) + (size_t)L * NE * DM * FF, 2 * FF, S, E);
        }
        SEAM(pb + 5);
        if (EN(6) && IN(pb + 6)) for (int rep_ = NREP(6) - 1; rep_ >= 0; --rep_) { PHASE_BEGIN(); moe_tables(F, cnt);
            if (rep_) combine_phase(F, HBb, (bf16_t*)(ws + WS_ACT + 128 * MiB), nullptr, (float*)(ws + WS_ACT + 201 * MiB), pair, Yb, (MK_Y8_MASK >> L) & 1);
            else combine_phase(F, HBb, HBa, MK_PLE8 ? ws + WS_HB8 : nullptr, rstd_ple, pair, Yb, (MK_Y8_MASK >> L) & 1); }
        SEAM(pb + 6);
        if (EN(7) && IN(pb + 7)) for (int rep_ = NREP(7) - 1; rep_ >= 0; --rep_) { PHASE_BEGIN();
            pg8::DenseOrder S; S.init(NTOK, DM, F.G, (int)blockIdx.x);
            pg8::EpiPLE E{HBa, rep_ ? (bf16_t*)(ws + WS_ACT + 128 * MiB) : HBb, (const bf16_t*)(ws + WS_PJ) + (size_t)L * NTOK * DM, rowL, rep_ ? (float*)(ws + WS_ACT + 202 * MiB) : SS};
            _Pragma("clang loop unroll(disable)") for (int i0 = 0; i0 < TOK_UNITS; i0 += 2) { const int i = i0 + (F.wave >> 2); pg8::Unit u; if (S.next(i, u)) { const int lr = F.tid & 255; rowL[i * 256 + lr] = rstd_ple[u.arow0 + lr] * (MK_PLE8 ? W8INV : 1.f); } }
            __syncthreads();
            if (MK_PLE8) pg8::gemm_phase<pg8::EpiPLE, pg8::DenseOrder, true>(F.lds, ws + WS_HB8, ws + WS_WG8 + (size_t)L * DM * DM, DM, S, E);
            else pg8::gemm_phase(F.lds, HBa, (const bf16_t*)(ws + WS_WG) + (size_t)L * DM * DM, 2 * DM, S, E);
        }
        SEAM(pb + 7);
    }
    if (EN(9) && IN(17)) for (int rep_ = 0; rep_ < NREP(9); ++rep_) { PHASE_BEGIN(); final_phase(F, HB0, SS, args.in[17], args.out); }
#undef IN
#undef SEAM
}
#define MK_MODE 2

#ifndef MK_MODE
#define MK_MODE 2
#endif
extern "C" void kernel_launch(void* const* d_in, const int* in_sizes, int n_in, void* d_out, int out_size, void* d_ws, size_t ws_size, hipStream_t stream) {
    if (n_in != 18 || in_sizes[0] != NTOK * DM || out_size != NTOK * DM || ws_size < WS_END2) { fprintf(stderr, "kernel_launch: unexpected shapes / workspace (%d inputs, ws %zu, need %zu)\n", n_in, ws_size, (size_t)WS_END2); return; }
    unsigned char* ws = (unsigned char*)d_ws;
    (void)hipMemsetAsync(ws + WS_CTL, 0, 1 * MiB, stream);
#if MK_MODE != 0
    static int grid = 0;
    if (grid == 0) {
        int dev = 0, cus = 0, per_cu = 0;
        if (hipGetDevice(&dev) != hipSuccess || hipDeviceGetAttribute(&cus, hipDeviceAttributeMultiprocessorCount, dev) != hipSuccess) { fprintf(stderr, "kernel_launch: device query failed\n"); grid = -1; return; }
        if (hipFuncSetAttribute((const void*)mega_fwd, hipFuncAttributeMaxDynamicSharedMemorySize, MK_LDS_BYTES) != hipSuccess) { fprintf(stderr, "kernel_launch: hipFuncSetAttribute failed\n"); grid = -1; return; }
        if (hipOccupancyMaxActiveBlocksPerMultiprocessor(&per_cu, (const void*)mega_fwd, MK_WAVES * 64, MK_LDS_BYTES) != hipSuccess || per_cu < 1) fprintf(stderr, "kernel_launch: occupancy query reports %d\n", per_cu);
        (void)hipGetLastError();
        grid = cus;
        grid -= grid % 8;
    }
    if (grid <= 0) return;
    MArgs a{};
    for (int i = 0; i < 18; ++i) a.in[i] = (const float*)d_in[i];
    a.out = (float*)d_out; a.ws = ws;
#if MK_MODE == 2
    a.ph_lo = 0; a.ph_hi = N_PHASES;
    hipLaunchKernelGGL(mega_fwd, dim3(grid), dim3(MK_WAVES * 64), MK_LDS_BYTES, stream, a);
#else
    for (int ph = 0; ph < N_PHASES; ++ph) { a.ph_lo = ph; a.ph_hi = ph + 1; hipLaunchKernelGGL(mega_fwd, dim3(grid), dim3(MK_WAVES * 64), MK_LDS_BYTES, stream, a); }
#endif
    { const hipError_t le = hipPeekAtLastError(); if (le != hipSuccess) fprintf(stderr, "kernel_launch: launch failed: %s\n", hipGetErrorName(le)); }
#else
    const float* x = (const float*)d_in[0]; const float* p = (const float*)d_in[1]; const float* g_mix = (const float*)d_in[2]; const float* w_qkv = (const float*)d_in[3];
    const float* w_fgate = (const float*)d_in[4]; const float* b_fgate = (const float*)d_in[5]; const float* w_o = (const float*)d_in[6]; const float* g_moe = (const float*)d_in[7];
    const float* w_router = (const float*)d_in[8]; const float* b_router = (const float*)d_in[9]; const float* w_gu = (const float*)d_in[10]; const float* b_gu = (const float*)d_in[11];
    const float* w_down = (const float*)d_in[12]; const float* b_down = (const float*)d_in[13]; const float* g_ple = (const float*)d_in[14]; const float* w_ple_gate = (const float*)d_in[15];
    const float* w_ple_proj = (const float*)d_in[16]; const float* g_final = (const float*)d_in[17];
    unsigned* ctl = (unsigned*)(ws + WS_CTL);
    bf16_t *Wqkv = (bf16_t*)(ws + WS_WQKV), *Wo = (bf16_t*)(ws + WS_WO), *Wg = (bf16_t*)(ws + WS_WG), *Wp = (bf16_t*)(ws + WS_WP), *Wgu = (bf16_t*)(ws + WS_WGU), *Wd = (bf16_t*)(ws + WS_WD);
    float* H = (float*)(ws + WS_H); bf16_t *HB = (bf16_t*)(ws + WS_HB), *Q = (bf16_t*)(ws + WS_Q), *Kb = (bf16_t*)(ws + WS_K), *Vb = (bf16_t*)(ws + WS_V), *O = (bf16_t*)(ws + WS_O);
    bf16_t *PB = (bf16_t*)(ws + WS_PB), *PJ = (bf16_t*)(ws + WS_PJ), *ACT = (bf16_t*)(ws + WS_ACT), *Y = (bf16_t*)(ws + WS_Y);
    int* tok_of = (int*)(ws + WS_TOK); float* gate_of = (float*)(ws + WS_GATE); unsigned* pair = (unsigned*)(ws + WS_PAIR);
    float* rstd_mix = (float*)(ws + WS_RSTD); float* rstd_moe = rstd_mix + NTOK; float* rstd_ple = rstd_moe + NTOK;
    float* FL = (float*)(ws + WS_FL); float* CB = (float*)(ws + WS_CB);
    for (int i = 0; i < DEPTH; ++i) {
        k_cvt_t<0><<<dim3(3 * DM / 64, DM / 64, 1), 256, 0, stream>>>(w_qkv + (size_t)i * DM * 3 * DM, g_mix + i * DM, Wqkv + (size_t)i * 3 * DM * DM, DM, 3 * DM);
        k_cvt_t<0><<<dim3(DM / 64, DM / 64, 1), 256, 0, stream>>>(w_o + (size_t)i * DM * DM, nullptr, Wo + (size_t)i * DM * DM, DM, DM);
        k_cvt_t<0><<<dim3(DM / 64, DM / 64, 1), 256, 0, stream>>>(w_ple_gate + (size_t)i * DM * DM, g_ple + i * DM, Wg + (size_t)i * DM * DM, DM, DM);
        k_cvt_t<0><<<dim3(DM / 64, PLE / 64, 1), 256, 0, stream>>>(w_ple_proj + (size_t)i * PLE * DM, nullptr, Wp + (size_t)i * DM * PLE, PLE, DM);
        k_cvt_t<1><<<dim3(2 * FF / 64, DM / 64, NE), 256, 0, stream>>>(w_gu + (size_t)i * NE * DM * 2 * FF, g_moe + i * DM, Wgu + (size_t)i * NE * 2 * FF * DM, DM, 2 * FF);
        k_cvt_t<0><<<dim3(DM / 64, FF / 64, NE), 256, 0, stream>>>(w_down + (size_t)i * NE * FF * DM, nullptr, Wd + (size_t)i * NE * DM * FF, FF, DM);
    }
    k_cvt<<<(unsigned)((size_t)DEPTH * NTOK * PLE / 4 / 256), 256, 0, stream>>>(p, PB, (size_t)DEPTH * NTOK * PLE / 4);
    for (int i = 0; i < DEPTH; ++i)
        k_gemm_pj<<<dim3(DM / 64, NTOK / 64), 64, 0, stream>>>(PB + (size_t)i * NTOK * PLE, Wp + (size_t)i * DM * PLE, PJ + (size_t)i * NTOK * DM);
    k_rowstat<<<NTOK / 4, 256, 0, stream>>>(x, HB, rstd_mix);
    for (int i = 0; i < DEPTH; ++i) {
        const float* hin = (i == 0) ? x : H;
        k_gemm_qkv<<<dim3(3 * DM / 64, NTOK / 64), 64, 0, stream>>>(HB, Wqkv + (size_t)i * 3 * DM * DM, rstd_mix, Q);
        if (i == 0) k_attn_sb<<<NB * NH * SEQ / 4, 256, 0, stream>>>(Q, Kb, Vb, O);
        else {
            k_fgate<<<NTOK / 4, 256, 0, stream>>>(hin, g_mix + i * DM, w_fgate, b_fgate, rstd_mix, FL);
            k_scan<<<NB * NH, 64, 0, stream>>>(FL, CB);
            k_attn_fox<<<NB * NH * SEQ / 4, 256, 0, stream>>>(Q, Kb, Vb, CB, O);
        }
        k_gemm_wo<<<dim3(DM / 64, NTOK / 64), 64, 0, stream>>>(O, Wo + (size_t)i * DM * DM, hin, H, HB);
        unsigned* cnt = ctl + CW_CNT + 64 * i;
        k_router<<<NTOK / 4, 256, 0, stream>>>(H, g_moe + i * DM, w_router + (size_t)i * DM * NE, b_router + i * NE, rstd_moe, cnt, tok_of, gate_of, pair);
        k_gemm_gu<<<dim3(FF / 64, MAXT * 4), 64, 0, stream>>>(HB, Wgu + (size_t)i * NE * 2 * FF * DM, b_gu + (size_t)i * NE * 2 * FF, rstd_moe, cnt, tok_of, ACT);
        k_gemm_down<<<dim3(DM / 64, MAXT * 4), 64, 0, stream>>>(ACT, Wd + (size_t)i * NE * DM * FF, b_down + (size_t)i * NE * DM, cnt, gate_of, Y);
        k_combine<<<NTOK / 4, 256, 0, stream>>>(H, HB, rstd_ple, cnt, pair, Y);
        k_gemm_ple<<<dim3(DM / 64, NTOK / 64), 64, 0, stream>>>(HB, Wg + (size_t)i * DM * DM, rstd_ple, PJ + (size_t)i * NTOK * DM, H, HB);
        if (i + 1 < DEPTH) k_rowstat<<<NTOK / 4, 256, 0, stream>>>(H, HB, rstd_mix);
    }
    k_final<<<NTOK / 4, 256, 0, stream>>>(H, g_final, (float*)d_out);
#endif
}
```

```cpp
#define MK_DUP 0
#define MK_FP8_MASK 3
#include <hip/hip_runtime.h>
#include <cstdio>
#include <cstdint>

typedef unsigned short bf16_t;
typedef short bf16x8 __attribute__((ext_vector_type(8)));
typedef float f32x4 __attribute__((ext_vector_type(4)));
typedef float f32x16 __attribute__((ext_vector_type(16)));
typedef unsigned u32x4 __attribute__((ext_vector_type(4)));
typedef unsigned u32x2 __attribute__((ext_vector_type(2)));

constexpr int NTOK = 32768, DM = 1024, SEQ = 2048, NB = 16, NH = 16, HD = 64, NE = 32, TOPK = 4, FF = 1024, PLE = 256, DEPTH = 2;
constexpr int CAP = NTOK;
constexpr int MAXT = 544;
constexpr int NSLOT = MAXT * 256;
constexpr float EPS = 1e-6f;
constexpr float LOG2E = 1.4426950408889634f;
constexpr float C2 = 0.125f * LOG2E;

constexpr size_t MiB = 1u << 20;
constexpr size_t WS_CTL = 0;
constexpr size_t WS_WQKV = 2 * MiB;
constexpr size_t WS_WO = WS_WQKV + 12 * MiB;
constexpr size_t WS_WG = WS_WO + 4 * MiB;
constexpr size_t WS_WP = WS_WG + 4 * MiB;
constexpr size_t WS_WGU = WS_WP + 2 * MiB;
constexpr size_t WS_WD = WS_WGU + 256 * MiB;
constexpr size_t WS_H = WS_WD + 128 * MiB;
constexpr size_t WS_HB = WS_H + 128 * MiB;
constexpr size_t WS_Q = WS_HB + 64 * MiB;
constexpr size_t WS_K = WS_Q + 64 * MiB;
constexpr size_t WS_V = WS_K + 64 * MiB;
constexpr size_t WS_O = WS_V + 64 * MiB;
constexpr size_t WS_PB = WS_O + 64 * MiB;
constexpr size_t WS_PJ = WS_PB + 32 * MiB;
constexpr size_t WS_ACT = WS_PJ + 128 * MiB;
constexpr size_t WS_Y = WS_ACT + 272 * MiB;
constexpr size_t WS_TOK = WS_Y + 272 * MiB;
constexpr size_t WS_GATE = WS_TOK + 4 * MiB;
constexpr size_t WS_PAIR = WS_GATE + 4 * MiB;
constexpr size_t WS_RSTD = WS_PAIR + 1 * MiB;
constexpr size_t WS_FL = WS_RSTD + 1 * MiB;
constexpr size_t WS_CB = WS_FL + 2 * MiB;
constexpr size_t WS_END = WS_CB + 2 * MiB;
constexpr int CW_CNT = 64;

__device__ __forceinline__ float bf2f(bf16_t v) { return __uint_as_float((unsigned)v << 16); }
__device__ __forceinline__ unsigned f2bf(float f) { unsigned u = __float_as_uint(f); return (u + 0x7fffu + ((u >> 16) & 1u)) >> 16; }
__device__ __forceinline__ unsigned pk2(float lo, float hi) { return f2bf(lo) | (f2bf(hi) << 16); }
__device__ __forceinline__ float wave_sum(float v) {
#pragma unroll
    for (int o = 1; o < 64; o <<= 1) v += __shfl_xor(v, o);
    return v;
}
__device__ __forceinline__ float wave_max(float v) {
#pragma unroll
    for (int o = 1; o < 64; o <<= 1) v = fmaxf(v, __shfl_xor(v, o));
    return v;
}
__device__ __forceinline__ int crow(int r, int hi) { return (r & 3) + 8 * (r >> 2) + 4 * hi; }
__device__ __forceinline__ float sigmoidf_(float x) { return 1.f / (1.f + __expf(-x)); }
__device__ __forceinline__ float log_sigmoid(float x) { return fminf(x, 0.f) - log1pf(__expf(-fabsf(x))); }

struct MoeTile { int e, rank0, cnt, tstart; bool ok; };
__device__ __forceinline__ MoeTile moe_tile(const unsigned* cnt, int T) {
    const int lane = threadIdx.x & 63;
    const int c = (lane < NE) ? (int)cnt[lane] : 0;
    const int nt = (c + 255) >> 8;
    int incl = nt;
#pragma unroll
    for (int o = 1; o < 32; o <<= 1) { int t = __shfl_up(incl, o); if ((lane & 31) >= o) incl += t; }
    const int excl = incl - nt;
    const unsigned long long m = __ballot(lane < NE && excl <= T && nt > 0 && T < incl);
    MoeTile r; r.ok = (m != 0ull);
    const int e = r.ok ? (int)__builtin_ctzll(m) : 0;
    r.e = e; r.tstart = __shfl(excl, e); r.cnt = __shfl(c, e); r.rank0 = (T - r.tstart) * 256;
    return r;
}
__device__ __forceinline__ int moe_tstart(const unsigned* cnt, int e) {
    const int lane = threadIdx.x & 63;
    const int c = (lane < NE) ? (int)cnt[lane] : 0;
    const int nt = (c + 255) >> 8;
    int incl = nt;
#pragma unroll
    for (int o = 1; o < 32; o <<= 1) { int t = __shfl_up(incl, o); if ((lane & 31) >= o) incl += t; }
    return __shfl(incl - nt, e);
}

__global__ void __launch_bounds__(256) k_rowstat(const float* __restrict__ h, bf16_t* __restrict__ hb, float* __restrict__ rstd) {
    const int lane = threadIdx.x & 63, row = blockIdx.x * 4 + (threadIdx.x >> 6);
    const f32x4* p = (const f32x4*)(h + (size_t)row * DM) + lane;
    f32x4 v[4]; float s = 0.f;
#pragma unroll
    for (int j = 0; j < 4; ++j) { v[j] = p[64 * j]; s += v[j].x * v[j].x + v[j].y * v[j].y + v[j].z * v[j].z + v[j].w * v[j].w; }
    s = wave_sum(s);
    if (lane == 0) rstd[row] = rsqrtf(s * (1.f / DM) + EPS);
    u32x2* o = (u32x2*)(hb + (size_t)row * DM) + lane;
#pragma unroll
    for (int j = 0; j < 4; ++j) { u32x2 w; w.x = pk2(v[j].x, v[j].y); w.y = pk2(v[j].z, v[j].w); o[64 * j] = w; }
}
__global__ void __launch_bounds__(256) k_cvt(const float* __restrict__ s, bf16_t* __restrict__ d, size_t n4) {
    size_t i = (size_t)blockIdx.x * 256 + threadIdx.x;
    if (i < n4) { f32x4 v = ((const f32x4*)s)[i]; u32x2 w; w.x = pk2(v.x, v.y); w.y = pk2(v.z, v.w); ((u32x2*)d)[i] = w; }
}
template <int MODE>
__global__ void __launch_bounds__(256) k_cvt_t(const float* __restrict__ src, const float* __restrict__ g, bf16_t* __restrict__ dst, int K, int N) {
    __shared__ float tile[64][65];
    const int n0 = blockIdx.x * 64, k0 = blockIdx.y * 64, b = blockIdx.z, tid = threadIdx.x;
    const float* s = src + (size_t)b * K * N; bf16_t* d = dst + (size_t)b * K * N;
#pragma unroll
    for (int i = 0; i < 16; ++i) { const int kk = i * 4 + (tid >> 6), nn = tid & 63; const float gg = g ? g[k0 + kk] : 1.f; tile[kk][nn] = s[(size_t)(k0 + kk) * N + n0 + nn] * gg; }
    __syncthreads();
#pragma unroll
    for (int j = 0; j < 2; ++j) {
        const int c = tid + 256 * j, n = c >> 3, kc = c & 7;
        u32x4 w; w.x = pk2(tile[kc * 8 + 0][n], tile[kc * 8 + 1][n]); w.y = pk2(tile[kc * 8 + 2][n], tile[kc * 8 + 3][n]);
        w.z = pk2(tile[kc * 8 + 4][n], tile[kc * 8 + 5][n]); w.w = pk2(tile[kc * 8 + 6][n], tile[kc * 8 + 7][n]);
        int nn = n0 + n;
        if (MODE == 1) { const int half = nn / FF, j2 = nn % FF; nn = (j2 >> 7) * 256 + half * 128 + (j2 & 127); }
        *(u32x4*)(d + (size_t)nn * K + k0 + kc * 8) = w;
    }
}

template <bool DUAL>
__device__ __forceinline__ void gemm_tile64(const bf16_t* a0, const bf16_t* a1, const bf16_t* B1, const bf16_t* B2, int K, f32x16 (&acc)[2][2], f32x16 (&acc2)[2][2]) {
    const int lane = threadIdx.x & 63, r32 = lane & 31, hi = lane >> 5;
    const bf16_t* b0 = B1 + (size_t)r32 * K + 8 * hi; const bf16_t* b1 = B1 + (size_t)(32 + r32) * K + 8 * hi;
    const bf16_t* c0 = DUAL ? B2 + (size_t)r32 * K + 8 * hi : nullptr; const bf16_t* c1 = DUAL ? B2 + (size_t)(32 + r32) * K + 8 * hi : nullptr;
    a0 += 8 * hi; a1 += 8 * hi;
#pragma unroll
    for (int i = 0; i < 2; ++i)
#pragma unroll
        for (int j = 0; j < 2; ++j) { acc[i][j] = f32x16{}; acc2[i][j] = f32x16{}; }
    for (int k = 0; k < K; k += 16) {
        const bf16x8 fa0 = *(const bf16x8*)(a0 + k), fa1 = *(const bf16x8*)(a1 + k), fb0 = *(const bf16x8*)(b0 + k), fb1 = *(const bf16x8*)(b1 + k);
        acc[0][0] = __builtin_amdgcn_mfma_f32_32x32x16_bf16(fa0, fb0, acc[0][0], 0, 0, 0);
        acc[0][1] = __builtin_amdgcn_mfma_f32_32x32x16_bf16(fa0, fb1, acc[0][1], 0, 0, 0);
        acc[1][0] = __builtin_amdgcn_mfma_f32_32x32x16_bf16(fa1, fb0, acc[1][0], 0, 0, 0);
        acc[1][1] = __builtin_amdgcn_mfma_f32_32x32x16_bf16(fa1, fb1, acc[1][1], 0, 0, 0);
        if (DUAL) {
            const bf16x8 fc0 = *(const bf16x8*)(c0 + k), fc1 = *(const bf16x8*)(c1 + k);
            acc2[0][0] = __builtin_amdgcn_mfma_f32_32x32x16_bf16(fa0, fc0, acc2[0][0], 0, 0, 0);
            acc2[0][1] = __builtin_amdgcn_mfma_f32_32x32x16_bf16(fa0, fc1, acc2[0][1], 0, 0, 0);
            acc2[1][0] = __builtin_amdgcn_mfma_f32_32x32x16_bf16(fa1, fc0, acc2[1][0], 0, 0, 0);
            acc2[1][1] = __builtin_amdgcn_mfma_f32_32x32x16_bf16(fa1, fc1, acc2[1][1], 0, 0, 0);
        }
    }
}
#define TILE_FOREACH(...) _Pragma("unroll") for (int mi = 0; mi < 2; ++mi) _Pragma("unroll") for (int ni = 0; ni < 2; ++ni) _Pragma("unroll") for (int r = 0; r < 16; ++r) { \
        const int lrow = 32 * mi + crow(r, hi), lcol = 32 * ni + r32; const float v = acc[mi][ni][r]; const float v2 = acc2[mi][ni][r]; (void)v2; __VA_ARGS__ }

__global__ void __launch_bounds__(64) k_gemm_qkv(const bf16_t* __restrict__ A, const bf16_t* __restrict__ Bt, const float* __restrict__ rstd, bf16_t* __restrict__ Q) {
    const int lane = threadIdx.x, r32 = lane & 31, hi = lane >> 5; const int m0 = blockIdx.y * 64, n0 = blockIdx.x * 64;
    f32x16 acc[2][2], acc2[2][2];
    gemm_tile64<false>(A + (size_t)(m0 + r32) * DM, A + (size_t)(m0 + 32 + r32) * DM, Bt + (size_t)n0 * DM, nullptr, DM, acc, acc2);
    const int t = n0 / DM; bf16_t* out = Q + (size_t)t * ((WS_K - WS_Q) / 2); const float sc = (t == 0) ? C2 : 1.f;
    TILE_FOREACH({ const int row = m0 + lrow, col = n0 - t * DM + lcol; out[(size_t)row * DM + col] = (bf16_t)f2bf(v * rstd[row] * sc); })
}
__global__ void __launch_bounds__(64) k_gemm_wo(const bf16_t* __restrict__ A, const bf16_t* __restrict__ Bt, const float* hin, float* hout, bf16_t* __restrict__ hb) {
    const int lane = threadIdx.x, r32 = lane & 31, hi = lane >> 5; const int m0 = blockIdx.y * 64, n0 = blockIdx.x * 64;
    f32x16 acc[2][2], acc2[2][2];
    gemm_tile64<false>(A + (size_t)(m0 + r32) * DM, A + (size_t)(m0 + 32 + r32) * DM, Bt + (size_t)n0 * DM, nullptr, DM, acc, acc2);
    TILE_FOREACH({ const size_t o = (size_t)(m0 + lrow) * DM + n0 + lcol; const float x = hin[o] + v; hout[o] = x; hb[o] = (bf16_t)f2bf(x); })
}
__global__ void __launch_bounds__(64) k_gemm_pj(const bf16_t* __restrict__ A, const bf16_t* __restrict__ Bt, bf16_t* __restrict__ PJ) {
    const int lane = threadIdx.x, r32 = lane & 31, hi = lane >> 5; const int m0 = blockIdx.y * 64, n0 = blockIdx.x * 64;
    f32x16 acc[2][2], acc2[2][2];
    gemm_tile64<false>(A + (size_t)(m0 + r32) * PLE, A + (size_t)(m0 + 32 + r32) * PLE, Bt + (size_t)n0 * PLE, nullptr, PLE, acc, acc2);
    TILE_FOREACH({ PJ[(size_t)(m0 + lrow) * DM + n0 + lcol] = (bf16_t)f2bf(v); })
}
__global__ void __launch_bounds__(64) k_gemm_ple(const bf16_t* __restrict__ A, const bf16_t* __restrict__ Bt, const float* __restrict__ rstd, const bf16_t* __restrict__ PJ, float* h, bf16_t* hb) {
    const int lane = threadIdx.x, r32 = lane & 31, hi = lane >> 5; const int m0 = blockIdx.y * 64, n0 = blockIdx.x * 64;
    f32x16 acc[2][2], acc2[2][2];
    gemm_tile64<false>(A + (size_t)(m0 + r32) * DM, A + (size_t)(m0 + 32 + r32) * DM, Bt + (size_t)n0 * DM, nullptr, DM, acc, acc2);
    TILE_FOREACH({ const int row = m0 + lrow; const size_t o = (size_t)row * DM + n0 + lcol; const float x = h[o] + sigmoidf_(v * rstd[row]) * bf2f(PJ[o]); h[o] = x; })
}
__global__ void __launch_bounds__(64) k_gemm_gu(const bf16_t* __restrict__ HB, const bf16_t* __restrict__ Wgu, const float* __restrict__ bgu, const float* __restrict__ rstd,
                                                const unsigned* __restrict__ cnt, const int* __restrict__ tok_of, bf16_t* __restrict__ ACT) {
    const int lane = threadIdx.x, r32 = lane & 31, hi = lane >> 5; const int rt = blockIdx.y, T = rt >> 2, j0 = blockIdx.x * 64;
    const MoeTile mt = moe_tile(cnt, T); if (!mt.ok) return;
    const int lr0 = (rt & 3) * 64; const int rk0 = mt.rank0 + lr0 + r32, rk1 = rk0 + 32;
    const int t0 = rk0 < mt.cnt ? tok_of[(size_t)mt.e * CAP + rk0] : 0, t1 = rk1 < mt.cnt ? tok_of[(size_t)mt.e * CAP + rk1] : 0;
    const bf16_t* Be = Wgu + (size_t)mt.e * 2048 * DM + (size_t)((j0 >> 7) * 256 + (j0 & 127)) * DM;
    f32x16 acc[2][2], acc2[2][2];
    gemm_tile64<true>(HB + (size_t)t0 * DM, HB + (size_t)t1 * DM, Be, Be + (size_t)128 * DM, DM, acc, acc2);
    const size_t slot0 = (size_t)T * 256 + lr0;
    TILE_FOREACH({ const int rk = mt.rank0 + lr0 + lrow; if (rk < mt.cnt) { const int tk = tok_of[(size_t)mt.e * CAP + rk]; const float rs = rstd[tk]; const int j = j0 + lcol;
        float gl = v * rs + bgu[(size_t)mt.e * 2048 + j], ln = v2 * rs + bgu[(size_t)mt.e * 2048 + FF + j];
        gl = fminf(gl, 7.f); ln = fminf(fmaxf(ln, -7.f), 7.f);
        const float a = gl * sigmoidf_(1.702f * gl) * (ln + 1.f);
        ACT[(slot0 + lrow) * FF + j] = (bf16_t)f2bf(a); } })
}
__global__ void __launch_bounds__(64) k_gemm_down(const bf16_t* __restrict__ ACT, const bf16_t* __restrict__ Wd, const float* __restrict__ bd, const unsigned* __restrict__ cnt,
                                                  const float* __restrict__ gate_of, bf16_t* __restrict__ Y) {
    const int lane = threadIdx.x, r32 = lane & 31, hi = lane >> 5; const int rt = blockIdx.y, T = rt >> 2, n0 = blockIdx.x * 64;
    const MoeTile mt = moe_tile(cnt, T); if (!mt.ok) return;
    const int lr0 = (rt & 3) * 64; const size_t slot0 = (size_t)T * 256 + lr0;
    const int rk0 = mt.rank0 + lr0 + r32, rk1 = rk0 + 32;
    const size_t s0 = rk0 < mt.cnt ? slot0 + r32 : (size_t)T * 256, s1 = rk1 < mt.cnt ? slot0 + 32 + r32 : (size_t)T * 256;
    f32x16 acc[2][2], acc2[2][2];
    gemm_tile64<false>(ACT + s0 * FF, ACT + s1 * FF, Wd + (size_t)mt.e * DM * FF + (size_t)n0 * FF, nullptr, FF, acc, acc2);
    TILE_FOREACH({ const int rk = mt.rank0 + lr0 + lrow; if (rk < mt.cnt) { const float gt = gate_of[(size_t)mt.e * CAP + rk]; const int n = n0 + lcol;
        Y[(slot0 + lrow) * DM + n] = (bf16_t)f2bf((v + bd[(size_t)mt.e * DM + n]) * gt); } })
}

__global__ void __launch_bounds__(256) k_router(const float* __restrict__ h, const float* __restrict__ g, const float* __restrict__ wr, const float* __restrict__ br,
                                                float* __restrict__ rstd, unsigned* cnt, int* __restrict__ tok_of, float* __restrict__ gate_of, unsigned* __restrict__ pair) {
    const int lane = threadIdx.x & 63, t = blockIdx.x * 4 + (threadIdx.x >> 6); const int e = lane & 31, half = lane >> 5;
    const float* hr = h + (size_t)t * DM;
    float ss = 0.f;
#pragma unroll
    for (int j = 0; j < 4; ++j) { const f32x4 v = ((const f32x4*)hr)[lane + 64 * j]; ss += v.x * v.x + v.y * v.y + v.z * v.z + v.w * v.w; }
    const float rs = rsqrtf(wave_sum(ss) * (1.f / DM) + EPS);
    float a = 0.f;
    for (int d = half * 512; d < half * 512 + 512; ++d) a += hr[d] * g[d] * wr[(size_t)d * NE + e];
    a += __shfl_xor(a, 32);
    float lg = a * rs + br[e];
    float tv[4]; int ti[4];
#pragma unroll
    for (int k = 0; k < 4; ++k) {
        float bv = lg; int bi = e;
#pragma unroll
        for (int o = 1; o < 32; o <<= 1) { const float ov = __shfl_xor(bv, o); const int oi = __shfl_xor(bi, o); if (ov > bv || (ov == bv && oi < bi)) { bv = ov; bi = oi; } }
        tv[k] = bv; ti[k] = bi; if (e == bi) lg = -INFINITY;
    }
    float w[4], sw = 0.f;
#pragma unroll
    for (int k = 0; k < 4; ++k) { w[k] = __expf(tv[k] - tv[0]); sw += w[k]; }
    if (lane == 0) rstd[t] = rs;
    if (lane < 4) {
        const int k = lane; const int ee = (k == 0) ? ti[0] : (k == 1) ? ti[1] : (k == 2) ? ti[2] : ti[3]; const float ww = (k == 0) ? w[0] : (k == 1) ? w[1] : (k == 2) ? w[2] : w[3];
        const unsigned rk = atomicAdd(&cnt[ee], 1u);
        tok_of[(size_t)ee * CAP + rk] = t; gate_of[(size_t)ee * CAP + rk] = ww / sw; pair[(size_t)t * 4 + k] = ((unsigned)ee << 16) | rk;
    }
}
__global__ void __launch_bounds__(256) k_combine(float* h, bf16_t* __restrict__ hb, float* __restrict__ rstd, const unsigned* __restrict__ cnt, const unsigned* __restrict__ pair, const bf16_t* __restrict__ Y) {
    const int lane = threadIdx.x & 63, t = blockIdx.x * 4 + (threadIdx.x >> 6);
    f32x4 v[4]; f32x4* hr = (f32x4*)(h + (size_t)t * DM) + lane;
#pragma unroll
    for (int j = 0; j < 4; ++j) v[j] = hr[64 * j];
    for (int k = 0; k < 4; ++k) {
        const unsigned pr = pair[(size_t)t * 4 + k]; const int e = pr >> 16, rk = pr & 0xffff;
        const size_t slot = (size_t)moe_tstart(cnt, e) * 256 + rk;
        const u32x2* yr = (const u32x2*)(Y + slot * DM) + lane;
#pragma unroll
        for (int j = 0; j < 4; ++j) { const u32x2 w = yr[64 * j]; v[j].x += __uint_as_float(w.x << 16); v[j].y += __uint_as_float(w.x & 0xffff0000u); v[j].z += __uint_as_float(w.y << 16); v[j].w += __uint_as_float(w.y & 0xffff0000u); }
    }
    float s = 0.f;
#pragma unroll
    for (int j = 0; j < 4; ++j) { hr[64 * j] = v[j]; s += v[j].x * v[j].x + v[j].y * v[j].y + v[j].z * v[j].z + v[j].w * v[j].w; }
    s = wave_sum(s); if (lane == 0) rstd[t] = rsqrtf(s * (1.f / DM) + EPS);
    u32x2* o = (u32x2*)(hb + (size_t)t * DM) + lane;
#pragma unroll
    for (int j = 0; j < 4; ++j) { u32x2 w; w.x = pk2(v[j].x, v[j].y); w.y = pk2(v[j].z, v[j].w); o[64 * j] = w; }
}
__global__ void __launch_bounds__(256) k_final(const float* __restrict__ h, const float* __restrict__ g, float* __restrict__ out) {
    const int lane = threadIdx.x & 63, row = blockIdx.x * 4 + (threadIdx.x >> 6);
    const f32x4* p = (const f32x4*)(h + (size_t)row * DM) + lane; f32x4 v[4]; float s = 0.f;
#pragma unroll
    for (int j = 0; j < 4; ++j) { v[j] = p[64 * j]; s += v[j].x * v[j].x + v[j].y * v[j].y + v[j].z * v[j].z + v[j].w * v[j].w; }
    const float rs = rsqrtf(wave_sum(s) * (1.f / DM) + EPS);
    f32x4* o = (f32x4*)(out + (size_t)row * DM) + lane;
#pragma unroll
    for (int j = 0; j < 4; ++j) { const f32x4 gg = ((const f32x4*)g)[lane + 64 * j]; o[64 * j] = v[j] * rs * gg; }
}
__global__ void __launch_bounds__(256) k_fgate(const float* __restrict__ h, const float* __restrict__ g, const float* __restrict__ wf, const float* __restrict__ bfg, const float* __restrict__ rstd, float* __restrict__ fl) {
    const int lane = threadIdx.x & 63, t = blockIdx.x * 4 + (threadIdx.x >> 6); const int hh = lane & 15, q = lane >> 4;
    const float* hr = h + (size_t)t * DM; float a = 0.f;
    for (int d = q * 256; d < q * 256 + 256; ++d) a += hr[d] * g[d] * wf[(size_t)d * NH + hh];
    a += __shfl_xor(a, 16); a += __shfl_xor(a, 32);
    if (lane < 16) fl[(size_t)t * NH + hh] = a * rstd[t] + bfg[hh];
}
__global__ void __launch_bounds__(64) k_scan(const float* __restrict__ fl, float* __restrict__ cb) {
    const int lane = threadIdx.x, bh = blockIdx.x, b = bh / NH, hh = bh % NH;
    float loc[32]; float run = 0.f;
#pragma unroll
    for (int i = 0; i < 32; ++i) { run += log_sigmoid(fl[(size_t)(b * SEQ + lane * 32 + i) * NH + hh]); loc[i] = run; }
    float incl = run;
#pragma unroll
    for (int o = 1; o < 64; o <<= 1) { const float t = __shfl_up(incl, o); if (lane >= o) incl += t; }
    const float base = incl - run;
#pragma unroll
    for (int i = 0; i < 32; ++i) cb[(size_t)bh * SEQ + lane * 32 + i] = (base + loc[i]) * LOG2E;
}

__device__ __forceinline__ float dot64(const float (&q)[64], const bf16_t* kr) {
    float a = 0.f;
#pragma unroll
    for (int c = 0; c < 8; ++c) { const u32x4 w = ((const u32x4*)kr)[c];
        a += q[8 * c + 0] * __uint_as_float(w.x << 16) + q[8 * c + 1] * __uint_as_float(w.x & 0xffff0000u) + q[8 * c + 2] * __uint_as_float(w.y << 16) + q[8 * c + 3] * __uint_as_float(w.y & 0xffff0000u)
           + q[8 * c + 4] * __uint_as_float(w.z << 16) + q[8 * c + 5] * __uint_as_float(w.z & 0xffff0000u) + q[8 * c + 6] * __uint_as_float(w.w << 16) + q[8 * c + 7] * __uint_as_float(w.w & 0xffff0000u); }
    return a;
}
__device__ __forceinline__ void loadq(float (&q)[64], const bf16_t* qr) {
#pragma unroll
    for (int c = 0; c < 8; ++c) { const u32x4 w = ((const u32x4*)qr)[c];
        q[8 * c + 0] = __uint_as_float(w.x << 16); q[8 * c + 1] = __uint_as_float(w.x & 0xffff0000u); q[8 * c + 2] = __uint_as_float(w.y << 16); q[8 * c + 3] = __uint_as_float(w.y & 0xffff0000u);
        q[8 * c + 4] = __uint_as_float(w.z << 16); q[8 * c + 5] = __uint_as_float(w.z & 0xffff0000u); q[8 * c + 6] = __uint_as_float(w.w << 16); q[8 * c + 7] = __uint_as_float(w.w & 0xffff0000u); }
}
__global__ void __launch_bounds__(256) k_attn_sb(const bf16_t* __restrict__ Q, const bf16_t* __restrict__ K, const bf16_t* __restrict__ V, bf16_t* __restrict__ O) {
    const int lane = threadIdx.x & 63; const int gw = blockIdx.x * 4 + (threadIdx.x >> 6); const int t = gw % SEQ, bh = gw / SEQ, b = bh / NH, hh = bh % NH;
    const size_t rowb = (size_t)b * SEQ; float q[64]; loadq(q, Q + (rowb + t) * DM + hh * HD);
    float o = 0.f, carry = 1.f;
    for (int jt = (t - 1) >> 6; jt >= 0 && t > 0; --jt) {
        const int s = 64 * jt + lane; const bool valid = s < t;
        float x = dot64(q, K + (rowb + s) * DM + hh * HD); x = fminf(x, 64.f);
        const float ex = exp2f(x), r = 1.f / (1.f + ex);
        const float beta = valid ? ex * r : 0.f, nb = valid ? r : 1.f;
        float P = nb;
#pragma unroll
        for (int off = 1; off < 64; off <<= 1) { const float t2 = __shfl_down(P, off); if (lane + off < 64) P *= t2; }
        float Pex = __shfl_down(P, 1); if (lane == 63) Pex = 1.f;
        const float a = beta * carry * Pex;
        carry *= __shfl(P, 0);
        const bf16_t* vb = V + (rowb + 64 * jt) * DM + hh * HD + lane;
        for (int l = 0; l < 64; ++l) { const float al = __shfl(a, l); o += al * bf2f(vb[(size_t)l * DM]); }
        if (carry < 1e-30f) break;
    }
    O[(rowb + t) * DM + hh * HD + lane] = (bf16_t)f2bf(o);
}
__global__ void __launch_bounds__(256) k_attn_fox(const bf16_t* __restrict__ Q, const bf16_t* __restrict__ K, const bf16_t* __restrict__ V, const float* __restrict__ cb, bf16_t* __restrict__ O) {
    const int lane = threadIdx.x & 63; const int gw = blockIdx.x * 4 + (threadIdx.x >> 6); const int t = gw % SEQ, bh = gw / SEQ, b = bh / NH, hh = bh % NH;
    const size_t rowb = (size_t)b * SEQ; float q[64]; loadq(q, Q + (rowb + t) * DM + hh * HD);
    float o = 0.f, m = -INFINITY, l = 0.f;
    for (int jt = 0; jt <= (t >> 6); ++jt) {
        const int s = 64 * jt + lane; const bool valid = s <= t;
        float x = dot64(q, K + (rowb + s) * DM + hh * HD) - cb[(size_t)bh * SEQ + s];
        x = valid ? x : -INFINITY;
        const float mn = fmaxf(m, wave_max(x)); const float alpha = exp2f(m - mn); const float p = exp2f(x - mn);
        l = l * alpha + wave_sum(p); o *= alpha; m = mn;
        const bf16_t* vb = V + (rowb + 64 * jt) * DM + hh * HD + lane;
        const int nl = min(64, t - 64 * jt + 1);
        for (int i = 0; i < nl; ++i) { const float pi = __shfl(p, i); o += pi * bf2f(vb[(size_t)i * DM]); }
    }
    O[(rowb + t) * DM + hh * HD + lane] = (bf16_t)f2bf(o / l);
}


#include <hip/hip_bf16.h>
#include <cmath>
namespace attn_body {
using bf16=__hip_bfloat16;
using bf16x8=__attribute__((ext_vector_type(8)))short;
using s16x4=__attribute__((ext_vector_type(4)))short;
using f32x16=__attribute__((ext_vector_type(16)))float;
using u32x4=__attribute__((ext_vector_type(4)))unsigned;
constexpr int BATCH=16,NHEAD=16,SEQ=2048,D=64,DM=NHEAD*D;
constexpr int NW=8,QBLK=32,QB=QBLK*NW,KVBLK=64,NQB=SEQ/QB;
constexpr int ATTN_PITCH=DM, ATTN_UNIT_ROWS=QB;
__device__ __forceinline__ int crow(int r,int hi){return (r&3)+8*(r>>2)+4*hi;}
#define SBAR() __builtin_amdgcn_sched_barrier(0)
__device__ __forceinline__ void cmask(f32x16&p0,f32x16&p1,int jb,int qrel,int hi){
  const float NEG=-INFINITY; int kb=64*jb+4*hi;
  #pragma unroll
  for(int r=0;r<16;++r){int kv=kb+(r&3)+8*(r>>2); if(kv>qrel)p0[r]=NEG; if(kv+32>qrel)p1[r]=NEG;}
}

constexpr int NSLOT=3, SLOTB=8192;
constexpr int LDS_K=0, LDS_V=NSLOT*SLOTB, LDS_WS=2*NSLOT*SLOTB, LDS_OST=LDS_WS+NW*64*4, LDS_BYTES=LDS_OST+NW*4096;
constexpr float C2=0.125f*1.4426950408889634f;
__device__ __forceinline__ void glds16(const void*gsrc,unsigned lds_dst){unsigned keep;
  asm volatile("s_mov_b32 %0, m0\n\ts_mov_b32 m0, %2\n\ts_nop 0\n\tglobal_load_lds_dwordx4 %1, off\n\ts_mov_b32 m0, %0":"=&s"(keep):"v"(gsrc),"s"(lds_dst):"memory");}
__device__ __forceinline__ float max3f(float a,float b,float c){float r;asm("v_max3_f32 %0, %1, %2, %3":"=v"(r):"v"(a),"v"(b),"v"(c));return r;}
__device__ __forceinline__ float max2f(float a,float b){float r;asm("v_max_f32_e32 %0, %1, %2":"=v"(r):"v"(a),"v"(b));return r;}
__device__ __forceinline__ float fadd_s(float a,float b){float r;asm("v_add_f32_e32 %0, %1, %2":"=v"(r):"v"(a),"v"(b));return r;}
__device__ __forceinline__ float fsub_s(float a,float b){float r;asm("v_sub_f32_e32 %0, %1, %2":"=v"(r):"v"(a),"v"(b));return r;}
typedef float f32x2_t __attribute__((ext_vector_type(2))); typedef __bf16 bf16x2_t __attribute__((ext_vector_type(2)));
__device__ __forceinline__ unsigned cvtpk_s(float lo,float hi){f32x2_t v={lo,hi};bf16x2_t b=__builtin_convertvector(v,bf16x2_t);return __builtin_bit_cast(unsigned,b);}
#define WAIT_BAR(N) asm volatile("s_waitcnt vmcnt(" #N ") lgkmcnt(0)\n\ts_barrier":::"memory")

__device__ __forceinline__ void qkt(f32x16&p0,f32x16&p1,const char*Kslot,const bf16x8*qr,const f32x16&negm,int r32,int hi){
  const char*kb=Kslot+hi*1024+r32*16;
  #pragma unroll
  for(int d0=0;d0<4;++d0){
    const bf16x8 b0=*reinterpret_cast<const bf16x8*>(kb+d0*2048);
    const bf16x8 b1=*reinterpret_cast<const bf16x8*>(kb+d0*2048+512);
    if(d0==0){p0=__builtin_amdgcn_mfma_f32_32x32x16_bf16(b0,qr[0],negm,0,0,0);p1=__builtin_amdgcn_mfma_f32_32x32x16_bf16(b1,qr[0],negm,0,0,0);}
    else{p0=__builtin_amdgcn_mfma_f32_32x32x16_bf16(b0,qr[d0],p0,0,0,0);p1=__builtin_amdgcn_mfma_f32_32x32x16_bf16(b1,qr[d0],p1,0,0,0);}}
}
typedef __attribute__((address_space(3))) const char* lds_cptr;
typedef short v4i16_t __attribute__((ext_vector_type(4)));
__device__ __forceinline__ void kload8(bf16x8*kf,lds_cptr kp){
  kf[0]=*(const __attribute__((address_space(3))) bf16x8*)(kp);      kf[1]=*(const __attribute__((address_space(3))) bf16x8*)(kp+512);
  kf[2]=*(const __attribute__((address_space(3))) bf16x8*)(kp+2048); kf[3]=*(const __attribute__((address_space(3))) bf16x8*)(kp+2560);
  kf[4]=*(const __attribute__((address_space(3))) bf16x8*)(kp+4096); kf[5]=*(const __attribute__((address_space(3))) bf16x8*)(kp+4608);
  kf[6]=*(const __attribute__((address_space(3))) bf16x8*)(kp+6144); kf[7]=*(const __attribute__((address_space(3))) bf16x8*)(kp+6656);
}
__device__ __forceinline__ void kload2(bf16x8*kf,lds_cptr kp,int j){ kf[2*j]=*(const __attribute__((address_space(3))) bf16x8*)(kp+j*2048); kf[2*j+1]=*(const __attribute__((address_space(3))) bf16x8*)(kp+j*2048+512); }
__device__ __forceinline__ s16x4 vtr(lds_cptr p){ return __builtin_bit_cast(s16x4,__builtin_amdgcn_ds_read_tr16_b64_v4i16((__attribute__((address_space(3))) v4i16_t*)p)); }
__device__ __forceinline__ float rowmax(const f32x16&p0,const f32x16&p1){
  float a=max3f(p0[0],p0[1],p1[0]),b=max3f(p0[2],p0[3],p1[1]);a=max3f(a,p1[2],p1[3]);
  #pragma unroll
  for(int r=4;r<16;r+=4){a=max3f(a,p0[r],p0[r+1]);b=max3f(b,p0[r+2],p0[r+3]);a=max3f(a,p1[r],p1[r+1]);b=max3f(b,p1[r+2],p1[r+3]);}
  const float m=max2f(a,b);
  auto rr=__builtin_amdgcn_permlane32_swap(__float_as_uint(m),__float_as_uint(m),false,false);
  return max2f(__uint_as_float(rr[0]),__uint_as_float(rr[1]));
}
__device__ __forceinline__ void pv(f32x16*o,int vb,bf16x8 pa0,bf16x8 pa1,bf16x8 pa2,bf16x8 pa3){
  #pragma unroll
  for(int d0=0;d0<2;++d0){s16x4 lo[4],hi[4];
    #pragma unroll
    for(int ks=0;ks<4;++ks){
      asm volatile("ds_read_b64_tr_b16 %0,%1 offset:%c2":"=&v"(lo[ks]):"v"(vb),"i"(d0*4096+ks*1024):"memory");
      asm volatile("ds_read_b64_tr_b16 %0,%1 offset:%c2":"=&v"(hi[ks]):"v"(vb),"i"(d0*4096+ks*1024+512):"memory");}
    asm volatile("s_waitcnt lgkmcnt(0)":::"memory");SBAR();
    #define PK(k) (bf16x8){lo[k][0],lo[k][1],lo[k][2],lo[k][3],hi[k][0],hi[k][1],hi[k][2],hi[k][3]}
    o[d0]=__builtin_amdgcn_mfma_f32_32x32x16_bf16(pa0,PK(0),o[d0],0,0,0);
    o[d0]=__builtin_amdgcn_mfma_f32_32x32x16_bf16(pa1,PK(1),o[d0],0,0,0);
    o[d0]=__builtin_amdgcn_mfma_f32_32x32x16_bf16(pa2,PK(2),o[d0],0,0,0);
    o[d0]=__builtin_amdgcn_mfma_f32_32x32x16_bf16(pa3,PK(3),o[d0],0,0,0);
    #undef PK
  }
}

#ifndef ATTN_STORE16
#define ATTN_STORE16(p,v) (*(u32x4*)(p)=(v))
#endif
typedef float f32x4b __attribute__((ext_vector_type(4)));
template<int THRL> __device__ __forceinline__ void attn_unit(int b,int h,int qb,const bf16*Q,const bf16*__restrict__ K,const bf16*__restrict__ V,bf16*O,char*shm,const __attribute__((address_space(3))) float*cb){
  int tid_=threadIdx.x; asm volatile("":"+v"(tid_));
  const int tid=tid_,lane=tid&63,r32=lane&31,hi=lane>>5; const int wid=__builtin_amdgcn_readfirstlane(tid>>6);
  const long rowbase=(long)b*SEQ; const int q0=qb*QB;
  const long hbase=((long)b*NHEAD+h)*SEQ;
  constexpr int PQ=D;
  const bf16*Qw=Q+(hbase+q0+wid*QBLK)*PQ;
  const bf16*Kh=K+hbase*PQ,*Vh=V+hbase*PQ;
  const unsigned lds0=(unsigned)(uintptr_t)shm;
  float*wsf=(float*)(shm+LDS_WS)+wid*64;
  const bf16*ksrc=Kh+(long)lane*PQ+wid*8;
  const bf16*vsrc=Vh+(long)(16*(wid&3)+(lane>>2))*PQ+(wid>>2)*32+(lane&3)*8;
  const unsigned kdst=lds0+LDS_K+wid*1024, vdst=lds0+LDS_V+wid*1024;
  #define TIDX(u) (NT-1-(u))
  #define DMA_K(t,slot) glds16(ksrc+(long)TIDX(t)*KVBLK*PQ,(unsigned)__builtin_amdgcn_readfirstlane(kdst+(slot)))
  #define DMA_V(t,slot) glds16(vsrc+(long)TIDX(t)*KVBLK*PQ,(unsigned)__builtin_amdgcn_readfirstlane(vdst+(slot)))
  const int vb0=(int)(lds0+LDS_V)+((lane>>4)&1)*32+(lane&3)*8+(4*hi+((lane&15)>>2))*64;
  const char*Kbase=shm+LDS_K; bf16x8 kf[8];
  const lds_cptr shm3=(lds_cptr)shm; const lds_cptr kp0=shm3+LDS_K+hi*1024+r32*16; const lds_cptr vp0=shm3+LDS_V+((lane>>4)&1)*32+(lane&3)*8+(4*hi+((lane&15)>>2))*64;
  const int NT=(q0+QB)/KVBLK;
  DMA_K(0,0);DMA_V(0,0);DMA_K(1,SLOTB);
  bf16x8 qr[4];
  #pragma unroll
  for(int d0=0;d0<4;++d0)qr[d0]=*reinterpret_cast<const bf16x8*>(&Qw[(long)r32*PQ+d0*16+hi*8]);
  float mhat=0.f,l_reg=0.f;f32x16 o[2];o[0]=f32x16{};o[1]=f32x16{};const f32x16 negm=f32x16{};
  const int qrel=wid*QBLK+r32;
  #define CMASK(P0,P1,t) do{int jb_=3-(t); if(jb_>=0)cmask(P0,P1,jb_,qrel,hi);}while(0)
  #define ABIAS(P0,P1,t) do{ const __attribute__((address_space(3))) f32x4b*cbp_=(const __attribute__((address_space(3))) f32x4b*)(cb+64*TIDX(t)+4*hi); \
    _Pragma("unroll") for(int g_=0;g_<4;++g_){ const f32x4b b0_=cbp_[2*g_], b1_=cbp_[8+2*g_]; \
      P0[4*g_+0]+=b0_[0];P0[4*g_+1]+=b0_[1];P0[4*g_+2]+=b0_[2];P0[4*g_+3]+=b0_[3]; P1[4*g_+0]+=b1_[0];P1[4*g_+1]+=b1_[1];P1[4*g_+2]+=b1_[2];P1[4*g_+3]+=b1_[3]; } }while(0)
  #define BLD(G,t,h) f32x4b nb##h##_[4]; { const __attribute__((address_space(3))) f32x4b*cbp_=(const __attribute__((address_space(3))) f32x4b*)(cb+64*TIDX(t)+4*hi+32*(h)); \
      _Pragma("unroll") for(int g_=0;g_<4;++g_) nb##h##_[g_]=cbp_[2*g_]; }
  #define BSUB(G,P,h) if(G){ const float mh_=mhat; _Pragma("unroll") for(int g_=0;g_<4;++g_){ \
      P[4*g_+0]=nb##h##_[g_][0]-mh_;P[4*g_+1]=nb##h##_[g_][1]-mh_;P[4*g_+2]=nb##h##_[g_][2]-mh_;P[4*g_+3]=nb##h##_[g_][3]-mh_; } }
  bool resc=false;
  #define START(P0,P1) do{ const float rm=rowmax(P0,P1); resc=false; \
    { const float dl=(rm>-INFINITY)?rm:0.f; mhat=fadd_s(mhat,dl);     \
      _Pragma("unroll") for(int r=0;r<16;++r){P0[r]=fsub_s(P0[r],dl);P1[r]=fsub_s(P1[r],dl);} \
      } \
    _Pragma("unroll") for(int r=0;r<16;++r)P0[r]=__builtin_amdgcn_exp2f(P0[r]); }while(0)
  #define RESC() do{ if(resc){ asm volatile("s_waitcnt lgkmcnt(0)":::"memory"); \
      _Pragma("unroll") for(int d_=0;d_<2;++d_) _Pragma("unroll") for(int r=0;r<16;++r)o[d_][r]*=wsf[crow(r,hi)]; } }while(0)
  f32x16 pA0,pA1,pB0,pB1;
  int sl_prev=0,sl_cur=0,sl_next=SLOTB;
  #define ROT() do{sl_prev=sl_cur;sl_cur=sl_next;sl_next=(sl_next==(NSLOT-1)*SLOTB)?0:sl_next+SLOTB;}while(0)
  DMA_K(2,2*SLOTB);
  WAIT_BAR(3);
  qkt(pA0,pA1,Kbase,qr,negm,r32,hi);asm volatile("s_nop 15\n\ts_nop 7":"+v"(pA0),"+v"(pA1));ABIAS(pA0,pA1,0);CMASK(pA0,pA1,0);
  START(pA0,pA1);
  _Pragma("unroll") for(int r=0;r<16;++r)pA1[r]=__builtin_amdgcn_exp2f(pA1[r]);
  { BLD(true,1,0) BLD(true,1,1) BSUB(true,pB0,0) BSUB(true,pB1,1) }
  WAIT_BAR(0);
  DMA_K(3,0);DMA_V(1,SLOTB);
  ROT();
  kload8(kf,kp0+sl_cur);
  WAIT_BAR(2);
  s16x4 vlo[8],vhi[8]; u32x4 pw0,pw1,pw2,pw3;
  #define PKW(P,B) cvtpk_s(P[B],P[B+1])
  #define PAF(k) __builtin_bit_cast(bf16x8,pw##k)
  #define VFR(i) (bf16x8){vlo[i][0],vlo[i][1],vlo[i][2],vlo[i][3],vhi[i][0],vhi[i][1],vhi[i][2],vhi[i][3]}
  #define PIN(x) asm volatile("":"+v"(x))
  #define MX3(a,b,c) __builtin_fmaxf(__builtin_fmaxf((a),(b)),(c))
  #define GAPA(MF,A0,A1,A2,A3,W0,W1,PW) do{ MF; sacc+=A0; sacc+=A1; sacc+=A2; sacc+=A3; PIN(sacc); W0; W1; PIN(PW); SBAR(); }while(0)
  #define EX(v) __builtin_amdgcn_exp2f(v)
  #define GAPB(MF,X,B) do{ MF; X[B]=EX(X[B]); X[B+1]=EX(X[B+1]); X[B+2]=EX(X[B+2]); X[B+3]=EX(X[B+3]); PIN(X); SBAR(); }while(0)
  #define VRD(i) do{ vlo[i]=vtr(vp_+(((i)>>2)*4096+((i)&3)*1024)); vhi[i]=vtr(vp_+(((i)>>2)*4096+((i)&3)*1024+512)); }while(0)
  #define KRD(G,j) do{ if(G){ kload2(kf,kp0+sl_next,j); SBAR(); } }while(0)
  #define STEP(C0,C1,P0,P1,t,GK,GV,GL,GB) do{ SBAR(); \
    const lds_cptr vp_=vp0+sl_prev; \
    VRD(0); SBAR(); float sacc=(P0[0]+P0[1]); \
    GAPA(C0=__builtin_amdgcn_mfma_f32_32x32x16_bf16(kf[0],qr[0],C0,0,0,0), P0[2],P0[3],P0[4],P0[5],     pw0[0]=PKW(P0,0), pw0[1]=PKW(P0,2), pw0); \
    VRD(4); SBAR(); GAPA(C1=__builtin_amdgcn_mfma_f32_32x32x16_bf16(kf[1],qr[0],C1,0,0,0), P0[6],P0[7],P0[8],P0[9],     pw0[2]=PKW(P0,4), pw0[3]=PKW(P0,6), pw0); \
    VRD(1); SBAR(); GAPA(C0=__builtin_amdgcn_mfma_f32_32x32x16_bf16(kf[2],qr[1],C0,0,0,0),   P0[10],P0[11],P0[12],P0[13], pw1[0]=PKW(P0,8), pw1[1]=PKW(P0,10), pw1); \
    VRD(5); SBAR(); GAPA(C1=__builtin_amdgcn_mfma_f32_32x32x16_bf16(kf[3],qr[1],C1,0,0,0),   P0[14],P0[15],P1[0],P1[1],   pw1[2]=PKW(P0,12),pw1[3]=PKW(P0,14), pw1); \
    VRD(2); SBAR(); GAPA(C0=__builtin_amdgcn_mfma_f32_32x32x16_bf16(kf[4],qr[2],C0,0,0,0),   P1[2],P1[3],P1[4],P1[5],     pw2[0]=PKW(P1,0), pw2[1]=PKW(P1,2), pw2); \
    VRD(6); SBAR(); GAPA(C1=__builtin_amdgcn_mfma_f32_32x32x16_bf16(kf[5],qr[2],C1,0,0,0),   P1[6],P1[7],P1[8],P1[9],     pw2[2]=PKW(P1,4), pw2[3]=PKW(P1,6), pw2); \
    VRD(3); SBAR(); GAPA(C0=__builtin_amdgcn_mfma_f32_32x32x16_bf16(kf[6],qr[3],C0,0,0,0),   P1[10],P1[11],P1[12],P1[13], pw3[0]=PKW(P1,8), pw3[1]=PKW(P1,10), pw3); \
    VRD(7); SBAR(); GAPA(C1=__builtin_amdgcn_mfma_f32_32x32x16_bf16(kf[7],qr[3],C1,0,0,0),   P1[14],P1[15],0.f,0.f,       pw3[2]=PKW(P1,12),pw3[3]=PKW(P1,14), pw3); \
    l_reg+=sacc; \
    if(GK){DMA_K((t)+3,sl_cur);} if(GV){DMA_V((t)+1,sl_next);} \
    CMASK(C0,C1,t); \
    { float a=MX3(C0[0],C0[1],C1[0]),b=MX3(C0[2],C0[3],C1[1]); a=MX3(a,C1[2],C1[3]); \
      _Pragma("unroll") for(int r=4;r<16;r+=4){a=MX3(a,C0[r],C0[r+1]);b=MX3(b,C0[r+2],C0[r+3]);a=MX3(a,C1[r],C1[r+1]);b=MX3(b,C1[r+2],C1[r+3]);} \
      float rm=__builtin_fmaxf(a,b); { auto rr=__builtin_amdgcn_permlane32_swap(__float_as_uint(rm),__float_as_uint(rm),false,false); rm=__builtin_fmaxf(__uint_as_float(rr[0]),__uint_as_float(rr[1])); } \
      resc=false; \
      if(__builtin_expect(__any(rm>(float)THRL),0)){ const float dl=__builtin_fmaxf(rm,0.f); mhat+=dl; \
        _Pragma("unroll") for(int r=0;r<16;++r){C0[r]-=dl;C1[r]-=dl;} \
        const float f=__builtin_amdgcn_exp2f(-dl); l_reg*=f; if(hi==0)wsf[r32]=f; resc=true; } } \
    SBAR(); \
    BLD(GB,(t)+1,0) SBAR(); \
    GAPB(o[0]=__builtin_amdgcn_mfma_f32_32x32x16_bf16(PAF(0),VFR(0),o[0],0,0,0), C0,0); \
    GAPB(o[1]=__builtin_amdgcn_mfma_f32_32x32x16_bf16(PAF(0),VFR(4),o[1],0,0,0), C0,4); \
    KRD(GL,0); GAPB(o[0]=__builtin_amdgcn_mfma_f32_32x32x16_bf16(PAF(1),VFR(1),o[0],0,0,0), C0,8); \
    KRD(GL,1); GAPB(o[1]=__builtin_amdgcn_mfma_f32_32x32x16_bf16(PAF(1),VFR(5),o[1],0,0,0), C0,12); \
    BSUB(GB,P0,0) BLD(GB,(t)+1,1) SBAR(); \
    KRD(GL,2); GAPB(o[0]=__builtin_amdgcn_mfma_f32_32x32x16_bf16(PAF(2),VFR(2),o[0],0,0,0), C1,0); \
    KRD(GL,3); GAPB(o[1]=__builtin_amdgcn_mfma_f32_32x32x16_bf16(PAF(2),VFR(6),o[1],0,0,0), C1,4); \
    GAPB(o[0]=__builtin_amdgcn_mfma_f32_32x32x16_bf16(PAF(3),VFR(3),o[0],0,0,0), C1,8); \
    GAPB(o[1]=__builtin_amdgcn_mfma_f32_32x32x16_bf16(PAF(3),VFR(7),o[1],0,0,0), C1,12); \
    BSUB(GB,P1,1) \
    }while(0)
  int t=1;
  #define ENDW(tt) do{ if((tt)+3<NT){WAIT_BAR(2);} else if((tt)+2<NT){WAIT_BAR(1);} else {WAIT_BAR(0);} }while(0)
  for(;t+1<NT&&t<5;t+=2){
    STEP(pB0,pB1,pA0,pA1,t,(t+3<NT),(t+1<NT),(t+1<NT),(t+1<NT));       ENDW(t);   RESC(); ROT();
    STEP(pA0,pA1,pB0,pB1,t+1,(t+4<NT),(t+2<NT),(t+2<NT),(t+2<NT));     ENDW(t+1); RESC(); ROT();
  }
  #undef CMASK
  #define CMASK(P0,P1,t) do{}while(0)
  for(;t+5<NT;t+=2){
    STEP(pB0,pB1,pA0,pA1,t,true,true,true,true);     WAIT_BAR(2); RESC(); ROT();
    STEP(pA0,pA1,pB0,pB1,t+1,true,true,true,true);   WAIT_BAR(2); RESC(); ROT();
  }
  for(;t+1<NT;t+=2){
    STEP(pB0,pB1,pA0,pA1,t,(t+3<NT),(t+1<NT),(t+1<NT),(t+1<NT));       ENDW(t);   RESC(); ROT();
    STEP(pA0,pA1,pB0,pB1,t+1,(t+4<NT),(t+2<NT),(t+2<NT),(t+2<NT));     ENDW(t+1); RESC(); ROT();
  }
  #undef CMASK
  #define CMASK(P0,P1,t) do{int jb_=3-(t); if(jb_>=0)cmask(P0,P1,jb_,qrel,hi);}while(0)
  STEP(pB0,pB1,pA0,pA1,NT-1,false,false,false,false); RESC();
  { float sacc=pB0[0]+pB0[1]; _Pragma("unroll") for(int r=2;r<16;++r)sacc+=pB0[r]; _Pragma("unroll") for(int r=0;r<16;++r)sacc+=pB1[r]; l_reg+=sacc;
    pw0=(u32x4){PKW(pB0,0),PKW(pB0,2),PKW(pB0,4),PKW(pB0,6)};pw1=(u32x4){PKW(pB0,8),PKW(pB0,10),PKW(pB0,12),PKW(pB0,14)};pw2=(u32x4){PKW(pB1,0),PKW(pB1,2),PKW(pB1,4),PKW(pB1,6)};pw3=(u32x4){PKW(pB1,8),PKW(pB1,10),PKW(pB1,12),PKW(pB1,14)};
    SBAR(); pv(o,vb0+sl_cur,PAF(0),PAF(1),PAF(2),PAF(3)); }
  #undef PKW
  #undef PAF
  #undef VFR
  #undef PIN
  #undef MX3
  #undef GAPA
  #undef GAPB
  #undef EX
  #undef VRD
  #undef KRD
  #undef STEP
  #undef ENDW
  {auto rr=__builtin_amdgcn_permlane32_swap(__float_as_uint(l_reg),__float_as_uint(l_reg),false,false);l_reg=__uint_as_float(rr[0])+__uint_as_float(rr[1]);}
  if(hi==0)wsf[32+r32]=l_reg;asm volatile("s_waitcnt lgkmcnt(0)":::"memory");
  float rli[16];
  #pragma unroll
  for(int r=0;r<16;++r)rli[r]=__builtin_amdgcn_rcpf(wsf[32+crow(r,hi)]);
  bf16*Ow=O+(rowbase+q0+wid*QBLK)*DM+h*D;
  { bf16*stg=(bf16*)(shm+LDS_OST)+wid*2048;
    #pragma unroll
    for(int r=0;r<16;++r){const int orow=crow(r,hi);
      #pragma unroll
      for(int d0=0;d0<2;++d0)stg[orow*64+d0*32+r32]=__float2bfloat16(o[d0][r]*rli[r]);}
    asm volatile("s_waitcnt lgkmcnt(0)":::"memory");
    #pragma unroll
    for(int i=0;i<4;++i){const int row=i*8+(lane>>3),ch=lane&7; const u32x4 v=*(const u32x4*)(stg+row*64+ch*8); ATTN_STORE16(Ow+(long)row*DM+ch*8,v);} }
  asm volatile("s_waitcnt lgkmcnt(0)\n\ts_barrier":::"memory");
  #undef DMA_K
  #undef TIDX
  #undef DMA_V
  #undef CMASK
  #undef ABIAS
  #undef BLD
  #undef BSUB
  #undef START
  #undef RESC
  #undef ROT
}
constexpr int ATTN_LDS_BYTES=LDS_BYTES;
#undef SBAR
#undef WAIT_BAR
}

#ifndef LAS
#define LAS __attribute__((address_space(3)))
#endif
constexpr int MK_WAVES = 8;
#ifndef MK_NSB
#define MK_NSB 5
#endif
namespace pg8 { __device__ __forceinline__ unsigned cvt_pk_bf16(float lo, float hi); }

namespace sb_body {
typedef short bf16x8 __attribute__((ext_vector_type(8)));
typedef float f32x16 __attribute__((ext_vector_type(16)));
__device__ __forceinline__ void sb_head(LAS unsigned char* lds, int bh, const bf16_t* Q, const bf16_t* K, const bf16_t* V, bf16_t* O) {
    int tid_ = threadIdx.x; asm volatile("" : "+v"(tid_));
    const int lane = tid_ & 63, wid = __builtin_amdgcn_readfirstlane(tid_ >> 6), r32 = lane & 31, hi = lane >> 5;
    const int b = bh / NH, hh = bh % NH; const size_t rowb = (size_t)b * SEQ;
    constexpr int PQ = HD; const size_t hb_ = ((size_t)b * NH + hh) * SEQ;
    const bf16_t* Qh = Q + hb_ * PQ; const bf16_t* Kh = K + hb_ * PQ; const bf16_t* Vh = V + hb_ * PQ; bf16_t* Oh = O + rowb * DM + hh * HD;
    LAS unsigned char* slot0 = lds + wid * 16384;
    const int vb0 = (int)(unsigned)(size_t)slot0 + ((lane >> 4) & 1) * 32 + (lane & 3) * 8 + (4 * hi + ((lane & 15) >> 2)) * 64;
    const bf16_t* vsrc0 = Vh + (size_t)(lane >> 2) * PQ + (lane & 3) * 8;
#define SB_DMAV(t, sc) do { _Pragma("unroll") for (int p_ = 0; p_ < 8; ++p_) \
        __builtin_amdgcn_global_load_lds((const unsigned*)(vsrc0 + (size_t)(64 * (t) + 16 * (p_ & 3)) * PQ + 32 * (p_ >> 2)), (LAS unsigned*)(slot0 + (sc) * 8192 + p_ * 1024), 16, 0, 0); } while (0)
#define SB_LOADK(kf, t) do { const bf16_t* kp_ = Kh + (size_t)(64 * (t) + r32) * PQ + 8 * hi; _Pragma("unroll") for (int d0_ = 0; d0_ < 4; ++d0_) { \
        kf[2 * d0_] = *(const bf16x8*)(kp_ + 16 * d0_); kf[2 * d0_ + 1] = *(const bf16x8*)(kp_ + (size_t)32 * PQ + 16 * d0_); } } while (0)
    for (int uu = wid; uu < SEQ / 32; uu += MK_NSB) {
        const int q0w = uu * 32, qabs = q0w + r32;
        bf16x8 qr[4];
#pragma unroll
        for (int d0 = 0; d0 < 4; ++d0) qr[d0] = *(const bf16x8*)(Qh + (size_t)qabs * PQ + d0 * 16 + hi * 8);
        f32x16 o[2]; o[0] = f32x16{}; o[1] = f32x16{};
        float carry = 1.f; int jt = (q0w + 30) >> 6, sc = 0; bool first = true;
        bf16x8 kf[8], kfn[8];
        SB_DMAV(jt, 0); asm volatile("" ::: "memory"); SB_LOADK(kf, jt);
        for (;;) {
            f32x16 p0 = f32x16{}, p1 = f32x16{};
#pragma unroll
            for (int d0 = 0; d0 < 4; ++d0) { p0 = __builtin_amdgcn_mfma_f32_32x32x16_bf16(kf[2 * d0], qr[d0], p0, 0, 0, 0); p1 = __builtin_amdgcn_mfma_f32_32x32x16_bf16(kf[2 * d0 + 1], qr[d0], p1, 0, 0, 0); }
            const bool more = jt > 0;
            asm volatile("" ::: "memory");
            if (more) { SB_DMAV(jt - 1, sc ^ 1); asm volatile("" ::: "memory"); SB_LOADK(kfn, jt - 1); }
            asm volatile("" ::: "memory");
            float nb[8][4], be[8][4];
#pragma unroll
            for (int w = 0; w < 8; ++w)
#pragma unroll
                for (int i = 0; i < 4; ++i) { const int r = (w & 3) * 4 + i; float x = (w < 4) ? p0[r] : p1[r]; x = fminf(x, 64.f);
                    const float e = __builtin_amdgcn_exp2f(x), rr = __builtin_amdgcn_rcpf(1.f + e);
                    const int kv = 64 * jt + 32 * (w >> 2) + 8 * (w & 3) + 4 * hi + i; const bool valid = !first || (kv < qabs);
                    be[w][i] = valid ? e * rr : 0.f; nb[w][i] = valid ? rr : 1.f; }
            float Xs[8];
            float Te[8], To[8];
#pragma unroll
            for (int w = 0; w < 8; ++w) { const float s2 = nb[w][3], s1 = s2 * nb[w][2], s0 = s1 * nb[w][1], T = s0 * nb[w][0];
                be[w][2] *= s2; be[w][1] *= s1; be[w][0] *= s0;
                auto rr2 = __builtin_amdgcn_permlane32_swap(__float_as_uint(T), __float_as_uint(T), false, false); Te[w] = __uint_as_float(rr2[0]); To[w] = __uint_as_float(rr2[1]); }
            float W = 1.f;
#pragma unroll
            for (int w = 7; w >= 0; --w) { const float xe = W * To[w]; Xs[w] = hi ? W : xe; W = xe * Te[w]; }
            unsigned pw[16];
#pragma unroll
            for (int w = 0; w < 8; ++w) { const float sc2 = Xs[w] * carry; pw[2 * w] = pg8::cvt_pk_bf16(be[w][0] * sc2, be[w][1] * sc2); pw[2 * w + 1] = pg8::cvt_pk_bf16(be[w][2] * sc2, be[w][3] * sc2); }
            carry *= W;
            const bf16x8 pa0 = __builtin_bit_cast(bf16x8, (u32x4){pw[0], pw[1], pw[2], pw[3]}), pa1 = __builtin_bit_cast(bf16x8, (u32x4){pw[4], pw[5], pw[6], pw[7]});
            const bf16x8 pa2 = __builtin_bit_cast(bf16x8, (u32x4){pw[8], pw[9], pw[10], pw[11]}), pa3 = __builtin_bit_cast(bf16x8, (u32x4){pw[12], pw[13], pw[14], pw[15]});
            if (more) asm volatile("s_waitcnt vmcnt(16)" ::: "memory"); else asm volatile("s_waitcnt vmcnt(0)" ::: "memory");
            attn_body::pv(o, vb0 + sc * 8192, pa0, pa1, pa2, pa3);
            if (!more || __all(carry < 1e-12f)) break;
#pragma unroll
            for (int i = 0; i < 8; ++i) kf[i] = kfn[i];
            sc ^= 1; --jt; first = false;
        }
#pragma unroll
        for (int d0 = 0; d0 < 2; ++d0)
#pragma unroll
            for (int r = 0; r < 16; ++r) Oh[(size_t)(q0w + crow(r, hi)) * DM + d0 * 32 + r32] = (bf16_t)f2bf(o[d0][r]);
    }
#undef SB_DMAV
#undef SB_LOADK
}
}

#ifndef LAS
#define LAS __attribute__((address_space(3)))
#endif
#define GAS __attribute__((address_space(1)))
constexpr size_t WS_SS = WS_END;
constexpr size_t WS_WR = WS_SS + 2 * MiB;
constexpr size_t WS_WF = WS_WR + 1 * MiB;
constexpr size_t WS_HB2 = WS_WF + 1 * MiB;
constexpr size_t WS_WGU8 = WS_HB2 + 64 * MiB;
constexpr size_t WS_WD8 = WS_WGU8 + 128 * MiB;
constexpr size_t WS_HB8 = WS_WD8 + 64 * MiB;
constexpr size_t WS_ACT8 = WS_HB8 + 32 * MiB;
constexpr size_t WS_WG8 = WS_ACT8 + 136 * MiB;
constexpr size_t WS_END2 = WS_WG8 + 2 * MiB;
#ifndef MK_PLE8
#define MK_PLE8 1
#endif
#ifndef MK_FP8_MASK
#define MK_FP8_MASK 0
#endif
constexpr float W8SCALE = 256.f, W8INV = 1.f / 256.f;
constexpr int CW_BAR = 4096;
constexpr int CW_CNT2 = 16384, CNT_STRIDE = 64;


__device__ __forceinline__ void st16_wt(void* p, u32x4 v) {
#ifdef MK_WT
    asm volatile("global_store_dwordx4 %0, %1, off sc1" :: "v"(p), "v"(v) : "memory");
#else
    *(u32x4*)p = v;
#endif
}
__device__ __forceinline__ float lperm(float v, int src) { return __builtin_bit_cast(float, __builtin_amdgcn_ds_bpermute(src << 2, __builtin_bit_cast(int, v))); }
__device__ __forceinline__ int lpermi(int v, int src) { return __builtin_amdgcn_ds_bpermute(src << 2, v); }
__device__ __forceinline__ float lwave_sum(float v, int lane) {
#pragma unroll
    for (int o = 1; o < 64; o <<= 1) v += lperm(v, lane ^ o);
    return v;
}
namespace pg8 {
constexpr int BM = 256, BK = 64, HALF = 128, HTB = HALF * BK * 2, STAGE_BYTES = 8 * HTB, NXCD = 8, WGM = 8;
__device__ __forceinline__ int lds_byte(int r, int c) { const int st = (r >> 4) * 2 + (c >> 5), rr = r & 15, cc = c & 31, ob = rr * 64 + cc * 2; return st * 1024 + (ob ^ (((ob >> 9) & 1) << 5)); }
__device__ __forceinline__ void stage_rc(int b, int& R, int& C) { const int st = b / 1024, sb = b % 1024, swz = sb ^ (((sb >> 9) & 1) << 5); R = (st >> 1) * 16 + swz / 64; C = (st & 1) * 32 + (swz % 64) / 2; }
__device__ __forceinline__ int perm32(int rho) { const int n = rho >> 4, i = rho & 15; return 8 * (i >> 2) + 4 * n + (i & 3); }
__device__ __forceinline__ unsigned cvt_pk_bf16(float lo, float hi) { unsigned r; asm volatile("v_cvt_pk_bf16_f32 %0, %1, %2" : "=v"(r) : "v"(lo), "v"(hi)); return r; }

struct Unit { int arow0, brow0, pn, e, rank0, cnt, ui; };

__device__ __forceinline__ int xcd_remap(int L, int nwg) { const int q = nwg / NXCD, r = nwg % NXCD, xcd = L % NXCD, off = L / NXCD; return (xcd < r ? xcd * (q + 1) : r * (q + 1) + (xcd - r) * q) + off; }

struct DenseOrder {
    int nM, nN, nwg, G, c;
    __device__ __forceinline__ void init(int M, int N, int G_, int c_) { nM = M / BM; nN = N / BM; nwg = nM * nN; G = G_; c = c_; }
    __device__ __forceinline__ bool next(int i, Unit& u) const {
        const long L = (long)i * G + c; if (L >= nwg) return false;
        const int wgid = xcd_remap((int)L, nwg);
        const int nig = WGM * nN, gid = wgid / nig, fm = gid * WGM, gsz = (nM - fm) < WGM ? (nM - fm) : WGM;
        const int pm = fm + ((wgid % nig) % gsz), pn = (wgid % nig) / gsz;
        u.arow0 = pm * BM; u.brow0 = pn * BM; u.pn = pn; u.e = 0; u.rank0 = 0; u.cnt = 0; u.ui = i; return true;
    }
    __device__ __forceinline__ int arow(const Unit& u, int lr) const { return u.arow0 + lr; }
};
struct HotOrder {
    DenseOrder d;
    __device__ __forceinline__ bool next(int i, Unit& u) const { const bool ok = d.next(i, u); u.arow0 = 0; u.brow0 = 0; u.pn = 0; return ok; }
    __device__ __forceinline__ int arow(const Unit& u, int lr) const { return lr; }
};
struct PJOrder {
    DenseOrder d; int G, c;
    __device__ __forceinline__ void init(int G_, int c_) { d.init(NTOK, DM, G_, 0); G = G_; c = c_; }
    __device__ __forceinline__ bool next(int i, Unit& u) const {
        const long L = (long)i * G + c; if (L >= 2 * d.nwg) return false;
        const int l2 = (L >= d.nwg) ? 1 : 0; const int wgid = xcd_remap((int)L - l2 * d.nwg, d.nwg);
        const int nig = WGM * d.nN, gid = wgid / nig, fm = gid * WGM, gsz = (d.nM - fm) < WGM ? (d.nM - fm) : WGM;
        const int pm = fm + ((wgid % nig) % gsz), pn = (wgid % nig) / gsz;
        u.arow0 = l2 * NTOK + pm * BM; u.brow0 = l2 * DM + pn * BM; u.pn = pn; u.e = 0; u.rank0 = 0; u.cnt = 0; u.ui = i; return true;
    }
    __device__ __forceinline__ int arow(const Unit& u, int lr) const { return u.arow0 + lr; }
};
struct MoeOrder {
    int NN, nwg, G, c, lane; const LAS int* tstartL; const LAS int* cntL; const LAS unsigned short* tokL; bool gather;
    __device__ __forceinline__ bool next(int i, Unit& u) const {
        const long L = (long)i * G + c; if (L >= nwg) return false;
        const int wgid = xcd_remap((int)L, nwg);
        const int T = wgid / NN, pn = wgid - T * NN;
        const int lo = (lane < NE) ? tstartL[lane] : 0x7fffffff, hi = (lane < NE) ? tstartL[lane + 1] : 0x7fffffff;
        const unsigned long long m = __ballot(lo <= T && T < hi);
        const int e = __builtin_amdgcn_readfirstlane((int)__builtin_ctzll(m | (1ull << 63)));
        u.e = e; u.rank0 = (T - __builtin_amdgcn_readfirstlane(tstartL[e])) * 256; u.cnt = __builtin_amdgcn_readfirstlane(cntL[e]); u.arow0 = T * 256; u.brow0 = (e * NN + pn) * 256; u.pn = pn; u.ui = i; return true;
    }
    __device__ __forceinline__ int arow(const Unit& u, int lr) const { return gather ? (int)tokL[u.ui * 256 + lr] : u.arow0 + lr; }
};

typedef const f32x4 (&AccRef)[2][2][4][2];
struct EpiQKV {
    bf16_t* Q; const LAS float* rowL; int probe;
    __device__ __forceinline__ void operator()(AccRef acc, const Unit& u, int wr, int wc, int fr, int fq) const {
        const int t = u.brow0 >> 10, colt = u.brow0 & 1023; bf16_t* base = Q + (size_t)t * ((size_t)NTOK * DM); const float sc = (t == 0) ? C2 : 1.f;
        const int col0 = colt + wc * 32 + 8 * fq;
#pragma unroll
        for (int ai = 0; ai < 2; ++ai)
#pragma unroll
            for (int m = 0; m < 4; ++m) { const int lr = ai * HALF + wr * 64 + m * 16 + fr; const int row = u.arow0 + lr; const int bb = row / SEQ, ss = row - bb * SEQ;
                const float rs = rowL[u.ui * 256 + lr] * sc;
#pragma unroll
                for (int bj = 0; bj < 2; ++bj) { const int c = col0 + bj * HALF; bf16_t* dst = base + (((size_t)(bb * NH + (c >> 6)) * SEQ + ss) * HD + (c & 63));
                    const f32x4 v0 = acc[ai][bj][m][0] * rs, v1 = acc[ai][bj][m][1] * rs; u32x4 w;
                    w.x = cvt_pk_bf16(v0[0], v0[1]); w.y = cvt_pk_bf16(v0[2], v0[3]); w.z = cvt_pk_bf16(v1[0], v1[1]); w.w = cvt_pk_bf16(v1[2], v1[3]);
                    if (probe == 1) asm volatile("" :: "v"(w)); else st16_wt(dst, w); } }
    }
};
struct EpiPJ {
    bf16_t* O;
    __device__ __forceinline__ void operator()(AccRef acc, const Unit& u, int wr, int wc, int fr, int fq) const {
        const int col0 = u.pn * BM + wc * 32 + 8 * fq;
#pragma unroll
        for (int ai = 0; ai < 2; ++ai)
#pragma unroll
            for (int m = 0; m < 4; ++m) { const int row = u.arow0 + ai * HALF + wr * 64 + m * 16 + fr; bf16_t* rowp = O + (size_t)row * DM + col0;
#pragma unroll
                for (int bj = 0; bj < 2; ++bj) { const f32x4 v0 = acc[ai][bj][m][0], v1 = acc[ai][bj][m][1]; u32x4 w;
                    w.x = cvt_pk_bf16(v0[0], v0[1]); w.y = cvt_pk_bf16(v0[2], v0[3]); w.z = cvt_pk_bf16(v1[0], v1[1]); w.w = cvt_pk_bf16(v1[2], v1[3]); st16_wt(rowp + bj * HALF, w); } }
    }
};
struct EpiWo {
    const bf16_t* hin; bf16_t* hb; unsigned char* hb8;
    __device__ __forceinline__ void operator()(AccRef acc, const Unit& u, int wr, int wc, int fr, int fq) const {
        const int col0 = u.brow0 + wc * 32 + 8 * fq;
        u32x4 hv[2][4][2];
#pragma unroll
        for (int ai = 0; ai < 2; ++ai)
#pragma unroll
            for (int m = 0; m < 4; ++m) { const size_t off = (size_t)(u.arow0 + ai * HALF + wr * 64 + m * 16 + fr) * DM + col0;
#pragma unroll
                for (int bj = 0; bj < 2; ++bj) hv[ai][m][bj] = *(const u32x4*)(hin + off + bj * HALF); }
#pragma unroll
        for (int ai = 0; ai < 2; ++ai)
#pragma unroll
            for (int m = 0; m < 4; ++m) { const size_t off = (size_t)(u.arow0 + ai * HALF + wr * 64 + m * 16 + fr) * DM + col0;
#pragma unroll
                for (int bj = 0; bj < 2; ++bj) { const size_t o = off + bj * HALF; const u32x4 h4 = hv[ai][m][bj]; const f32x4 a0 = acc[ai][bj][m][0], a1 = acc[ai][bj][m][1];
                    const float x0 = __uint_as_float(h4.x << 16) + a0[0], x1 = __uint_as_float(h4.x & 0xffff0000u) + a0[1], x2 = __uint_as_float(h4.y << 16) + a0[2], x3 = __uint_as_float(h4.y & 0xffff0000u) + a0[3];
                    const float x4 = __uint_as_float(h4.z << 16) + a1[0], x5 = __uint_as_float(h4.z & 0xffff0000u) + a1[1], x6 = __uint_as_float(h4.w << 16) + a1[2], x7 = __uint_as_float(h4.w & 0xffff0000u) + a1[3];
                    if (hb8) { unsigned p0 = 0u, p1 = 0u; p0 = __builtin_amdgcn_cvt_pk_fp8_f32(x0, x1, p0, false); p0 = __builtin_amdgcn_cvt_pk_fp8_f32(x2, x3, p0, true); p1 = __builtin_amdgcn_cvt_pk_fp8_f32(x4, x5, p1, false); p1 = __builtin_amdgcn_cvt_pk_fp8_f32(x6, x7, p1, true);
                        *(u32x2*)(hb8 + o) = (u32x2){p0, p1}; }
                    u32x4 w; w.x = cvt_pk_bf16(x0, x1); w.y = cvt_pk_bf16(x2, x3); w.z = cvt_pk_bf16(x4, x5); w.w = cvt_pk_bf16(x6, x7);
                    st16_wt(hb + o, w); } }
    }
};
__device__ __forceinline__ float fast_sigmoid(float x) { return __builtin_amdgcn_rcpf(1.f + __builtin_amdgcn_exp2f(-LOG2E * x)); }
struct EpiPLE {
    const bf16_t* hin; bf16_t* hb; const bf16_t* PJ; const LAS float* rowL; float* SS;
    __device__ __forceinline__ void operator()(AccRef acc, const Unit& u, int wr, int wc, int fr, int fq) const {
        const int col0 = u.brow0 + wc * 32 + 8 * fq;
#pragma unroll
        for (int ai = 0; ai < 2; ++ai) {
            u32x4 hv[4][2], pv[4][2];
#pragma unroll
            for (int m = 0; m < 4; ++m) { const size_t off = (size_t)(u.arow0 + ai * HALF + wr * 64 + m * 16 + fr) * DM + col0;
#pragma unroll
                for (int bj = 0; bj < 2; ++bj) { hv[m][bj] = *(const u32x4*)(hin + off + bj * HALF); pv[m][bj] = *(const u32x4*)(PJ + off + bj * HALF); } }
#pragma unroll
            for (int m = 0; m < 4; ++m) { const int lr = ai * HALF + wr * 64 + m * 16 + fr; const int row = u.arow0 + lr; const size_t off = (size_t)row * DM + col0; const float rs = rowL[u.ui * 256 + lr]; float ssq = 0.f;
#pragma unroll
                for (int bj = 0; bj < 2; ++bj) { const size_t o = off + bj * HALF; const u32x4 pj = pv[m][bj]; const u32x4 h4 = hv[m][bj];
                    const f32x4 a0 = acc[ai][bj][m][0] * rs, a1 = acc[ai][bj][m][1] * rs; float x[8];
                    x[0] = __uint_as_float(h4.x << 16) + fast_sigmoid(a0[0]) * __uint_as_float(pj.x << 16); x[1] = __uint_as_float(h4.x & 0xffff0000u) + fast_sigmoid(a0[1]) * __uint_as_float(pj.x & 0xffff0000u);
                    x[2] = __uint_as_float(h4.y << 16) + fast_sigmoid(a0[2]) * __uint_as_float(pj.y << 16); x[3] = __uint_as_float(h4.y & 0xffff0000u) + fast_sigmoid(a0[3]) * __uint_as_float(pj.y & 0xffff0000u);
                    x[4] = __uint_as_float(h4.z << 16) + fast_sigmoid(a1[0]) * __uint_as_float(pj.z << 16); x[5] = __uint_as_float(h4.z & 0xffff0000u) + fast_sigmoid(a1[1]) * __uint_as_float(pj.z & 0xffff0000u);
                    x[6] = __uint_as_float(h4.w << 16) + fast_sigmoid(a1[2]) * __uint_as_float(pj.w << 16); x[7] = __uint_as_float(h4.w & 0xffff0000u) + fast_sigmoid(a1[3]) * __uint_as_float(pj.w & 0xffff0000u);
                    u32x4 w; w.x = cvt_pk_bf16(x[0], x[1]); w.y = cvt_pk_bf16(x[2], x[3]); w.z = cvt_pk_bf16(x[4], x[5]); w.w = cvt_pk_bf16(x[6], x[7]); st16_wt(hb + o, w);
                    float q0 = __uint_as_float(w.x << 16), q1 = __uint_as_float(w.x & 0xffff0000u), q2 = __uint_as_float(w.y << 16), q3 = __uint_as_float(w.y & 0xffff0000u);
                    float q4 = __uint_as_float(w.z << 16), q5 = __uint_as_float(w.z & 0xffff0000u), q6 = __uint_as_float(w.w << 16), q7 = __uint_as_float(w.w & 0xffff0000u);
                    ssq += (q0 * q0 + q1 * q1) + (q2 * q2 + q3 * q3) + (q4 * q4 + q5 * q5) + (q6 * q6 + q7 * q7); }
                { const int ln_ = fr + 16 * fq; ssq += lperm(ssq, ln_ ^ 16); ssq += lperm(ssq, ln_ ^ 32); }
                if (fq == 0) SS[(size_t)row * 16 + u.pn * 4 + wc] = ssq; }
            asm volatile("" ::: "memory");
        }
    }
};
template <bool OUT8> struct EpiGU {
    void* ACT; const float* bgu; const LAS float* rowL;
    __device__ __forceinline__ void operator()(AccRef acc, const Unit& u, int wr, int wc, int fr, int fq) const {
        const int jc = u.pn * 128 + wc * 32 + 8 * fq; const float* bp = bgu + (size_t)u.e * (2 * FF) + jc;
        const f32x4 bg0 = *(const f32x4*)(bp), bg1 = *(const f32x4*)(bp + 4), bl0 = *(const f32x4*)(bp + FF), bl1 = *(const f32x4*)(bp + FF + 4);
#pragma unroll
        for (int ai = 0; ai < 2; ++ai)
#pragma unroll
            for (int m = 0; m < 4; ++m) { const int lr = ai * HALF + wr * 64 + m * 16 + fr; const float rs = rowL[u.ui * 256 + lr];
                const f32x4 g0 = __builtin_elementwise_min(acc[ai][0][m][0] * rs + bg0, (f32x4){7.f, 7.f, 7.f, 7.f}), g1 = __builtin_elementwise_min(acc[ai][0][m][1] * rs + bg1, (f32x4){7.f, 7.f, 7.f, 7.f});
                const f32x4 l0 = __builtin_elementwise_min(__builtin_elementwise_max(acc[ai][1][m][0] * rs + bl0, (f32x4){-7.f, -7.f, -7.f, -7.f}), (f32x4){7.f, 7.f, 7.f, 7.f}) + 1.f;
                const f32x4 l1 = __builtin_elementwise_min(__builtin_elementwise_max(acc[ai][1][m][1] * rs + bl1, (f32x4){-7.f, -7.f, -7.f, -7.f}), (f32x4){7.f, 7.f, 7.f, 7.f}) + 1.f;
                const f32x4 x0 = g0 * (-1.702f * LOG2E), x1 = g1 * (-1.702f * LOG2E); f32x4 e0, e1;
#pragma unroll
                for (int c = 0; c < 4; ++c) { e0[c] = __builtin_amdgcn_exp2f(x0[c]); e1[c] = __builtin_amdgcn_exp2f(x1[c]); }
                const f32x4 d0 = e0 + 1.f, d1 = e1 + 1.f; f32x4 s0, s1;
#pragma unroll
                for (int c = 0; c < 4; ++c) { s0[c] = __builtin_amdgcn_rcpf(d0[c]); s1[c] = __builtin_amdgcn_rcpf(d1[c]); }
                const f32x4 a0 = (g0 * l0) * s0, a1 = (g1 * l1) * s1; const float a[8] = {a0[0], a0[1], a0[2], a0[3], a1[0], a1[1], a1[2], a1[3]};
                if constexpr (OUT8) { unsigned p0 = 0u, p1 = 0u; p0 = __builtin_amdgcn_cvt_pk_fp8_f32(a[0], a[1], p0, false); p0 = __builtin_amdgcn_cvt_pk_fp8_f32(a[2], a[3], p0, true); p1 = __builtin_amdgcn_cvt_pk_fp8_f32(a[4], a[5], p1, false); p1 = __builtin_amdgcn_cvt_pk_fp8_f32(a[6], a[7], p1, true);
                    *(u32x2*)((unsigned char*)ACT + (size_t)(u.arow0 + lr) * FF + jc) = (u32x2){p0, p1}; }
                else { u32x4 w; w.x = cvt_pk_bf16(a[0], a[1]); w.y = cvt_pk_bf16(a[2], a[3]); w.z = cvt_pk_bf16(a[4], a[5]); w.w = cvt_pk_bf16(a[6], a[7]);
                    *(u32x4*)((bf16_t*)ACT + (size_t)(u.arow0 + lr) * FF + jc) = w; } }
    }
};
struct EpiDown {
    bf16_t* Y; const float* bd; const LAS float* rowL; float bscale; bool y8;
    __device__ __forceinline__ void operator()(AccRef acc, const Unit& u, int wr, int wc, int fr, int fq) const {
        const int col0 = u.pn * 256 + wc * 32 + 8 * fq; const float* bp = bd + (size_t)u.e * DM + col0;
        f32x4 bv[2][2];
#pragma unroll
        for (int bj = 0; bj < 2; ++bj) { bv[bj][0] = *(const f32x4*)(bp + bj * HALF) * bscale; bv[bj][1] = *(const f32x4*)(bp + bj * HALF + 4) * bscale; }
#pragma unroll
        for (int ai = 0; ai < 2; ++ai)
#pragma unroll
            for (int m = 0; m < 4; ++m) { const int lr = ai * HALF + wr * 64 + m * 16 + fr; const float gt = rowL[u.ui * 256 + lr];
                bf16_t* rowp = Y + (size_t)(u.arow0 + lr) * DM + col0; unsigned char* rowp8 = (unsigned char*)Y + (size_t)(u.arow0 + lr) * DM + col0;
#pragma unroll
                for (int bj = 0; bj < 2; ++bj) { const f32x4 v0 = (acc[ai][bj][m][0] + bv[bj][0]) * gt, v1 = (acc[ai][bj][m][1] + bv[bj][1]) * gt;
                    if (y8) { unsigned p0 = 0u, p1 = 0u; p0 = __builtin_amdgcn_cvt_pk_fp8_f32(v0[0], v0[1], p0, false); p0 = __builtin_amdgcn_cvt_pk_fp8_f32(v0[2], v0[3], p0, true); p1 = __builtin_amdgcn_cvt_pk_fp8_f32(v1[0], v1[1], p1, false); p1 = __builtin_amdgcn_cvt_pk_fp8_f32(v1[2], v1[3], p1, true);
                        *(u32x2*)(rowp8 + bj * HALF) = (u32x2){p0, p1}; }
                    else { u32x4 w; w.x = cvt_pk_bf16(v0[0], v0[1]); w.y = cvt_pk_bf16(v0[2], v0[3]); w.z = cvt_pk_bf16(v1[0], v1[1]); w.w = cvt_pk_bf16(v1[2], v1[3]); *(u32x4*)(rowp + bj * HALF) = w; } } }
    }
};

typedef int v8i_t __attribute__((ext_vector_type(8))); typedef int v4i_t __attribute__((ext_vector_type(4)));
template <class Epi, class Sched, bool FP8 = false>
__device__ __forceinline__ void gemm_phase(LAS unsigned char* lds, const void* gA, const void* gBt, const int KB, const Sched& S, const Epi& E, const bool skip_epi = false) {
    int tid_ = threadIdx.x; asm volatile("" : "+v"(tid_));
    const int tid = tid_, wid = __builtin_amdgcn_readfirstlane(tid >> 6), lane = tid & 63, wr = wid >> 2, wc = wid & 3, fr = lane & 15, fq = lane >> 4;
    const int nt = KB / (BK * 2);
    unsigned voffB[2];
#pragma unroll
    for (int i = 0; i < 2; ++i) { int R, C; stage_rc(tid * 16 + i * 8192, R, C); const int Rb = (R & ~31) + perm32(R & 31); voffB[i] = (unsigned)(Rb * 128 + C * 2); }
#define PG8_AOFF(u, o0, o1) do { int t2_ = threadIdx.x; asm volatile("" : "+v"(t2_)); _Pragma("unroll") for (int i = 0; i < 2; ++i) { int R, C; stage_rc(t2_ * 16 + i * 8192, R, C); \
        o0[i] = (unsigned)S.arow(u, R) * (unsigned)KB + (unsigned)C * 2u; o1[i] = (unsigned)S.arow(u, HALF + R) * (unsigned)KB + (unsigned)C * 2u; } } while (0)
    const unsigned kstep = (unsigned)(BK * 2);
    const unsigned hstepA_unused = (unsigned)HALF * (unsigned)KB; (void)hstepA_unused;
    const unsigned kstepB = 256u * 128u, hstep = 128u * 128u;
    const unsigned ldsw = (unsigned)wid * 1024u;
    unsigned rdA_ = (unsigned)(size_t)lds + (unsigned)lds_byte(wr * 64 + fr, fq * 8), rdB_ = (unsigned)(size_t)lds + 4u * HTB + (unsigned)lds_byte(wc * 32 + fr, fq * 8);
    asm volatile("" : "+v"(rdA_), "+v"(rdB_));
    const LAS unsigned char* const rdA = (const LAS unsigned char*)(size_t)rdA_; const LAS unsigned char* const rdB = (const LAS unsigned char*)(size_t)rdB_;
#define PG8_SA(b, h) (((b) * 2 + (h)) * HTB)
#define PG8_SB(b, h) ((4 + (b) * 2 + (h)) * HTB)
#define PG8_STAGE(bufoff, rs, voff, soff) do { _Pragma("unroll") for (int _i = 0; _i < 2; ++_i) \
        __builtin_amdgcn_raw_ptr_buffer_load_lds(rs, (LAS void*)(lds + (bufoff) + ldsw + _i * 8192), 16, (voff)[_i], (unsigned)(soff), 0, 0); } while (0)
#define PG8_RA(b, h) (((b) * 2 + (h)) * HTB)
#define PG8_LD16A(off) __builtin_bit_cast(v4i_t, *(const LAS bf16x8*)(rdA + (off)))
#define PG8_LD16B(off) __builtin_bit_cast(v4i_t, *(const LAS bf16x8*)(rdB + (off)))
#define PG8_LDA(dst, b, h) do { if constexpr (FP8) { _Pragma("unroll") for (int m = 0; m < 4; ++m) dst##8[m] = __builtin_shufflevector(PG8_LD16A(PG8_RA(b, h) + m * 2048), PG8_LD16A(PG8_RA(b, h) + m * 2048 + 1024), 0, 1, 2, 3, 4, 5, 6, 7); } \
        else { _Pragma("unroll") for (int m = 0; m < 4; ++m) _Pragma("unroll") for (int k = 0; k < 2; ++k) dst[m][k] = *(const LAS bf16x8*)(rdA + PG8_RA(b, h) + m * 2048 + k * 1024); } } while (0)
#define PG8_LDB(dst, b, h) do { if constexpr (FP8) { _Pragma("unroll") for (int n = 0; n < 2; ++n) dst##8[n] = __builtin_shufflevector(PG8_LD16B(PG8_RA(b, h) + n * 2048), PG8_LD16B(PG8_RA(b, h) + n * 2048 + 1024), 0, 1, 2, 3, 4, 5, 6, 7); } \
        else { _Pragma("unroll") for (int n = 0; n < 2; ++n) _Pragma("unroll") for (int k = 0; k < 2; ++k) dst[n][k] = *(const LAS bf16x8*)(rdB + PG8_RA(b, h) + n * 2048 + k * 1024); } } while (0)
#define PG8_MMA(ai, bj, At, Bt) do { __builtin_amdgcn_s_setprio(1); _Pragma("unroll") for (int m = 0; m < 4; ++m) _Pragma("unroll") for (int n = 0; n < 2; ++n) { \
            if constexpr (FP8) acc[ai][bj][m][n] = __builtin_amdgcn_mfma_scale_f32_16x16x128_f8f6f4(Bt##8[n], At##8[m], acc[ai][bj][m][n], 0, 0, 0, 0, 0, 0); \
            else { _Pragma("unroll") for (int k = 0; k < 2; ++k) acc[ai][bj][m][n] = __builtin_amdgcn_mfma_f32_16x16x32_bf16(Bt[n][k], At[m][k], acc[ai][bj][m][n], 0, 0, 0); } } __builtin_amdgcn_s_setprio(0); } while (0)
#define PG8_WAIT_V(n) asm volatile("s_waitcnt vmcnt(" #n ")" ::: "memory")
#define PG8_WAIT_L(n) asm volatile("s_waitcnt lgkmcnt(" #n ")" ::: "memory")
#define PG8_BAR __builtin_amdgcn_s_barrier()
#define PG8_SCHED __builtin_amdgcn_sched_barrier(0)
    Unit cur, nxt; int ui = 0;
    if (!S.next(0, cur)) return;
    f32x4 acc[2][2][4][2];
#pragma unroll
    for (int a = 0; a < 2; ++a)
#pragma unroll
        for (int b = 0; b < 2; ++b)
#pragma unroll
            for (int m = 0; m < 4; ++m)
#pragma unroll
                for (int n = 0; n < 2; ++n) acc[a][b][m][n] = (f32x4){0.f, 0.f, 0.f, 0.f};
    bf16x8 At[4][2], B0[2][2], B1[2][2];
    v8i_t At8[4], B08[2], B18[2];
    unsigned ao0[2], ao1[2];
    PG8_AOFF(cur, ao0, ao1);
    const __amdgpu_buffer_rsrc_t rsA = __builtin_amdgcn_make_buffer_rsrc((void*)gA, 0, 0x7fffffff, 0x00020000), rsB = __builtin_amdgcn_make_buffer_rsrc((void*)gBt, 0, 0x7fffffff, 0x00020000);
    unsigned cB = (unsigned)cur.brow0 * (unsigned)KB;
    PG8_STAGE(PG8_SB(0, 0), rsB, voffB, cB); PG8_STAGE(PG8_SB(0, 1), rsB, voffB, cB + hstep); PG8_STAGE(PG8_SA(0, 0), rsA, ao0, 0u); PG8_STAGE(PG8_SA(0, 1), rsA, ao1, 0u);
    if (wr == 1) PG8_BAR;
    PG8_WAIT_V(2); PG8_BAR;
    PG8_STAGE(PG8_SB(1, 0), rsB, voffB, cB + kstepB); PG8_STAGE(PG8_SA(1, 0), rsA, ao0, kstep); PG8_STAGE(PG8_SB(1, 1), rsB, voffB, cB + hstep + kstepB);
    PG8_WAIT_V(6); PG8_BAR;
    for (;;) {
        const bool has_next = S.next(ui + 1, nxt);
        const unsigned nB = has_next ? (unsigned)nxt.brow0 * (unsigned)KB : cB;
        _Pragma("clang loop unroll(disable)") for (int t = 0; t < nt; t += 2) {
            const bool last = (t == nt - 2);
            const unsigned a1 = (unsigned)(t + 1) * kstep;
            const unsigned a2 = last ? 0u : (unsigned)(t + 2) * kstep; const unsigned b2 = last ? nB : cB + (unsigned)(t + 2) * kstepB;
            const unsigned a3 = a2 + kstep; const unsigned b3 = b2 + kstepB;
            PG8_LDB(B0, 0, 0); PG8_LDB(B1, 0, 1); PG8_SCHED; PG8_LDA(At, 0, 0); PG8_STAGE(PG8_SA(1, 1), rsA, ao1, a1);
            if (last && has_next) { PG8_AOFF(nxt, ao0, ao1); }
            PG8_WAIT_V(8); PG8_WAIT_L(0); PG8_BAR; PG8_MMA(0, 0, At, B0); PG8_MMA(0, 1, At, B1); PG8_BAR; PG8_SCHED;
            PG8_LDA(At, 0, 1); PG8_STAGE(PG8_SB(0, 0), rsB, voffB, b2); PG8_STAGE(PG8_SB(0, 1), rsB, voffB, b2 + hstep); PG8_STAGE(PG8_SA(0, 0), rsA, ao0, a2);
            PG8_WAIT_V(8); PG8_WAIT_L(0); PG8_BAR; PG8_MMA(1, 0, At, B0); PG8_MMA(1, 1, At, B1); PG8_BAR; PG8_SCHED;
            PG8_LDB(B0, 1, 0); PG8_LDB(B1, 1, 1); PG8_SCHED; PG8_LDA(At, 1, 0); PG8_STAGE(PG8_SA(0, 1), rsA, ao1, a2);
            PG8_WAIT_V(8); PG8_WAIT_L(0); PG8_BAR; PG8_MMA(0, 0, At, B0); PG8_MMA(0, 1, At, B1); PG8_BAR; PG8_SCHED;
            PG8_LDA(At, 1, 1); PG8_STAGE(PG8_SB(1, 0), rsB, voffB, b3); PG8_STAGE(PG8_SB(1, 1), rsB, voffB, b3 + hstep); PG8_STAGE(PG8_SA(1, 0), rsA, ao0, a3);
            PG8_WAIT_V(8); PG8_WAIT_L(0); PG8_BAR; PG8_MMA(1, 0, At, B0); PG8_MMA(1, 1, At, B1); PG8_BAR; PG8_SCHED;
        }
        if (wr == 0) PG8_BAR;
        if (!skip_epi) E(acc, cur, wr, wc, fr, fq);
        if (!has_next) break;
#pragma unroll
        for (int a = 0; a < 2; ++a)
#pragma unroll
            for (int b = 0; b < 2; ++b)
#pragma unroll
                for (int m = 0; m < 4; ++m)
#pragma unroll
                    for (int n = 0; n < 2; ++n) acc[a][b][m][n] = (f32x4){0.f, 0.f, 0.f, 0.f};
        cur = nxt; cB = nB; ++ui;
        if (wr == 1) PG8_BAR;
    }
    PG8_WAIT_V(0);
    PG8_BAR;
#undef PG8_AOFF
#undef PG8_SA
#undef PG8_SB
#undef PG8_STAGE
#undef PG8_LDA
#undef PG8_LD16A
#undef PG8_LD16B
#undef PG8_RA
#undef PG8_LDB
#undef PG8_MMA
#undef PG8_WAIT_V
#undef PG8_WAIT_L
#undef PG8_BAR
#undef PG8_SCHED
}
}

#define XB_TMO      128
#define XB_XCNT(j)  (256  + 64 * (j))
#define XB_XSUB(j)  (1280 + 64 * (j))
#define XB_XGEN(j)  (2304 + 64 * (j))
#define XB_TOP      3328
#define XB_TOPGEN   3392
#define XCD_BAR_WORDS 3456
#define XB_SPIN_CAP (1u << 18)
__device__ __forceinline__ unsigned xb_ld(unsigned* p)              { return __hip_atomic_load(p, __ATOMIC_RELAXED, __HIP_MEMORY_SCOPE_AGENT); }
__device__ __forceinline__ unsigned xb_add(unsigned* p, unsigned v) { return __hip_atomic_fetch_add(p, v, __ATOMIC_RELAXED, __HIP_MEMORY_SCOPE_AGENT); }
__device__ __forceinline__ unsigned xb_xcc_id() { return (unsigned)__builtin_amdgcn_s_getreg((3 << 11) | 20) & 0xFu; }
#define XB_SPIN(cond, bar) do { unsigned _sp = 0; while (cond) { __builtin_amdgcn_s_sleep(1); \
    if ((++_sp & 255u) == 0u) { if (xb_ld(&(bar)[XB_TMO])) break; if (_sp > XB_SPIN_CAP) { atomicAdd(&(bar)[XB_TMO], 1u); break; } } } } while (0)
struct XcdBarrier { unsigned* bar; unsigned x; volatile LAS unsigned* st; };
__device__ __forceinline__ XcdBarrier xcd_barrier_post(unsigned* bar, volatile LAS unsigned* st) {
    XcdBarrier b; b.bar = bar; b.x = xb_xcc_id(); b.st = st;
    if (threadIdx.x == 0) (void)xb_add(&bar[XB_XCNT(b.x)], 1u);
    return b;
}
__device__ __forceinline__ void xcd_barrier_complete(unsigned* bar, unsigned x, unsigned& nloc, unsigned& nx) {
    const unsigned G = gridDim.x * gridDim.y * gridDim.z;
    unsigned sum, cnt, mine, sp = 0u;
    for (;;) {
        sum = 0u; cnt = 0u; mine = 0u;
#pragma unroll
        for (unsigned j = 0; j < 16; ++j) { const unsigned c = xb_ld(&bar[XB_XCNT(j)]); sum += c; cnt += (c > 0u) ? 1u : 0u; mine = (j == x) ? c : mine; }
        if (sum == G) break;
        __builtin_amdgcn_s_sleep(1);
        if ((++sp & 255u) == 0u) { if (xb_ld(&bar[XB_TMO])) break; if (sp > XB_SPIN_CAP) { atomicAdd(&bar[XB_TMO], 1u); break; } }
    }
    nloc = mine > 0u ? mine : 1u; nx = cnt > 0u ? cnt : 1u;
}
__device__ __forceinline__ void xcd_barrier(const XcdBarrier& b) {
    asm volatile("s_waitcnt vmcnt(0)" ::: "memory");
    __syncthreads();
    if (threadIdx.x == 0) {
        unsigned* bar = b.bar;
        __builtin_amdgcn_s_waitcnt(0);
        unsigned nloc = b.st[0], nx = b.st[1];
        if (nloc == 0u) { xcd_barrier_complete(bar, b.x, nloc, nx); b.st[0] = nloc; b.st[1] = nx; }
        const unsigned old = xb_add(&bar[XB_XSUB(b.x)], 1u);
        const unsigned gen = old / nloc;
        if (old + 1u == (gen + 1u) * nloc) {
            __builtin_amdgcn_fence(__ATOMIC_RELEASE, "agent");
            asm volatile("s_waitcnt vmcnt(0)" ::: "memory");
            const unsigned og = xb_add(&bar[XB_TOP], 1u);
            const unsigned tg = og / nx;
            if (og + 1u == (tg + 1u) * nx) xb_add(&bar[XB_TOPGEN], 1u);
            else XB_SPIN(xb_ld(&bar[XB_TOPGEN]) == tg, bar);
            __builtin_amdgcn_fence(__ATOMIC_ACQUIRE, "agent");
            xb_add(&bar[XB_XGEN(b.x)], 1u);
            asm volatile("s_waitcnt vmcnt(0)" ::: "memory");
        } else {
            XB_SPIN(xb_ld(&bar[XB_XGEN(b.x)]) == gen, bar);
            __builtin_amdgcn_fence(__ATOMIC_ACQUIRE, "agent");
            asm volatile("s_waitcnt vmcnt(0)" ::: "memory");
        }
    }
    __syncthreads();
}

constexpr int RING_BYTES = 131072;
constexpr int ROW_OFF = RING_BYTES, TOK_UNITS = 18;
constexpr int TOK_OFF = ROW_OFF + TOK_UNITS * 1024;
constexpr int TBL_OFF = TOK_OFF + TOK_UNITS * 512;
constexpr int LDSCTL_OFF = TBL_OFF + 512;
constexpr int MK_LDS_BYTES = LDSCTL_OFF + 256;
static_assert(MK_LDS_BYTES <= 160 * 1024, "LDS map");

struct MArgs { const float* in[18]; float* out; unsigned char* ws; int ph_lo, ph_hi; };
struct Frame {
    LAS unsigned char* lds; int tid, lane, wave, vcu, G;
    unsigned char* ws; unsigned* ctl;
};
__device__ __forceinline__ unsigned pkb(float lo, float hi) { return pg8::cvt_pk_bf16(lo, hi); }

struct P0Item { const float* W; const float* g; unsigned char* dst; int K, N, item, mode; };
__device__ __forceinline__ void p0_load32(const P0Item& d, int lane, float (&v)[32], float& g0) {
    const int nblk = d.N / 32, kb = d.item / nblk, nb = d.item - kb * nblk, k0 = 64 * kb, n0 = 32 * nb;
    const float* p = d.W + (size_t)(k0 + (lane >> 5)) * d.N + n0 + (lane & 31);
#pragma unroll
    for (int i = 0; i < 32; ++i) v[i] = p[(size_t)(2 * i) * d.N];
    g0 = d.g ? d.g[k0 + lane] : 1.f;
}
__device__ __forceinline__ void p0_store32(const P0Item& d, int lane, const float (&v)[32], float g0, LAS float* scr) {
    const int nblk = d.N / 32, kb = d.item / nblk, nb = d.item - kb * nblk, k0 = 64 * kb, n0 = 32 * nb;
#pragma unroll
    for (int i = 0; i < 32; ++i) { const int kk = 2 * i + (lane >> 5); scr[kk * 33 + (lane & 31)] = v[i] * lperm(g0, kk); }
    asm volatile("s_waitcnt lgkmcnt(0)" ::: "memory");
    const int c = lane & 7;
#pragma unroll
    for (int j = 0; j < 4; ++j) { const int n = (lane >> 3) + 8 * j; const LAS float* s = scr + (8 * c) * 33 + n;
        u32x4 o; o.x = pkb(s[0 * 33], s[1 * 33]); o.y = pkb(s[2 * 33], s[3 * 33]); o.z = pkb(s[4 * 33], s[5 * 33]); o.w = pkb(s[6 * 33], s[7 * 33]);
        const int nn = n0 + n;
        if (d.mode == 2) *(u32x4*)((bf16_t*)d.dst + (size_t)nn * d.K + k0 + 8 * c) = o;
        else *(u32x4*)(d.dst + ((size_t)((nn >> 8) * (d.K / 64) + (k0 >> 6)) * 256 + (nn & 255)) * 128 + 16 * c) = o; }
    asm volatile("s_waitcnt lgkmcnt(0)" ::: "memory");
}
__device__ __forceinline__ void p0_load64(const P0Item& d, int lane, f32x4 (&v)[16], float& g0) {
    const int nblk = d.N / 64, kb = d.item / nblk, nb = d.item - kb * nblk, k0 = 64 * kb, n0 = 64 * nb;
    const float* p = d.W + (size_t)(k0 + (lane >> 4)) * d.N + n0 + 4 * (lane & 15);
#pragma unroll
    for (int i = 0; i < 16; ++i) v[i] = __builtin_nontemporal_load((const f32x4*)(p + (size_t)(4 * i) * d.N));
    g0 = (d.g ? d.g[k0 + lane] : 1.f) * W8SCALE;
}
__device__ __forceinline__ void p0_store64(const P0Item& d, int lane, const f32x4 (&v)[16], float g0, LAS float* scr) {
    const int nblk = d.N / 64, kb = d.item / nblk, nb = d.item - kb * nblk, k0 = 64 * kb, n0 = 64 * nb;
#pragma unroll
    for (int i = 0; i < 16; ++i) { const int kk = 4 * i + (lane >> 4); const float gg = lperm(g0, kk); LAS float* w = scr + kk * 65 + 4 * (lane & 15); w[0] = v[i].x * gg; w[1] = v[i].y * gg; w[2] = v[i].z * gg; w[3] = v[i].w * gg; }
    asm volatile("s_waitcnt lgkmcnt(0)" ::: "memory");
#pragma unroll
    for (int j = 0; j < 4; ++j) { const int id = lane + 64 * j, n = id >> 2, c = id & 3; const LAS float* s = scr + (16 * c) * 65 + n; unsigned p[4];
#pragma unroll
        for (int q = 0; q < 4; ++q) { unsigned w = 0u; w = __builtin_amdgcn_cvt_pk_fp8_f32(s[(4 * q + 0) * 65], s[(4 * q + 1) * 65], w, false); w = __builtin_amdgcn_cvt_pk_fp8_f32(s[(4 * q + 2) * 65], s[(4 * q + 3) * 65], w, true); p[q] = w; }
        int nn = n0 + n; if (d.mode == 1) { const int half = nn / FF, j2 = nn % FF; nn = (j2 >> 7) * 256 + half * 128 + (j2 & 127); }
        st16_wt(d.dst + ((size_t)((nn >> 8) * (d.K / 128) + (k0 >> 7)) * 256 + (nn & 255)) * 128 + (k0 & 127) + 16 * c, (u32x4){p[0], p[1], p[2], p[3]}); }
    asm volatile("s_waitcnt lgkmcnt(0)" ::: "memory");
}
__device__ __forceinline__ void p0_big(Frame& F, const MArgs& args, int cw, int ncw, LAS float* scr) {
    const int gw = F.vcu * ncw + cw, NGW = F.G * ncw, lane = F.lane;
    unsigned char* ws = F.ws;
    const float* g_moe = args.in[7]; const float* w_gu = args.in[10]; const float* w_down = args.in[12]; const float* g_ple = args.in[14]; const float* w_ple_gate = args.in[15];
    {
        constexpr int J_GU = (DM / 64) * (2 * FF / 64), J_WD = (FF / 64) * (DM / 64), J_WG = (DM / 64) * (DM / 64);
        constexpr int PER_LAYER8 = NE * J_GU + NE * J_WD + J_WG, NIT = DEPTH * PER_LAYER8;
        auto decode = [&](int it) -> P0Item {
            const int L = it / PER_LAYER8; int r = it - L * PER_LAYER8;
            if (r < NE * J_GU) { const int e = r / J_GU; const size_t m = (size_t)L * NE + e; return P0Item{w_gu + m * DM * 2 * FF, g_moe + L * DM, ws + WS_WGU8 + m * 2 * FF * DM, DM, 2 * FF, r - e * J_GU, 1}; } r -= NE * J_GU;
            if (r < NE * J_WD) { const int e = r / J_WD; const size_t m = (size_t)L * NE + e; return P0Item{w_down + m * FF * DM, nullptr, ws + WS_WD8 + m * DM * FF, FF, DM, r - e * J_WD, 0}; } r -= NE * J_WD;
            return P0Item{w_ple_gate + (size_t)L * DM * DM, g_ple + L * DM, ws + WS_WG8 + (size_t)L * DM * DM, DM, DM, r, 0};
        };
        f32x4 va[16], vb[16]; float ga = 1.f, gb = 1.f; P0Item da{}, db{};
        int it = gw;
        if (it < NIT) { da = decode(it); p0_load64(da, lane, va, ga); }
        while (it < NIT) {
            const int itb = it + NGW; const bool hb = itb < NIT;
            if (hb) { db = decode(itb); p0_load64(db, lane, vb, gb); }
            p0_store64(da, lane, va, ga, scr);
            const int itc = itb + NGW; const bool hc = itc < NIT;
            if (hc) { da = decode(itc); p0_load64(da, lane, va, ga); }
            if (hb) p0_store64(db, lane, vb, gb, scr);
            it = itc;
        }
    }
}
__device__ __forceinline__ void p0_prologue(Frame& F, const MArgs& args) {
    static_assert(MK_FP8_MASK == 3 && MK_PLE8 == 1, "this prologue converts the expert and PLE gate matrices to fp8 only");
    LAS float* scr = (LAS float*)(F.lds + F.wave * 16896);
    const int gw = F.vcu * MK_WAVES + F.wave, NGW = F.G * MK_WAVES, lane = F.lane;
    unsigned char* ws = F.ws;
    const float* g_mix = args.in[2]; const float* w_qkv = args.in[3]; const float* w_fgate = args.in[4]; const float* w_o = args.in[6]; const float* g_moe = args.in[7]; const float* w_router = args.in[8];
    const float* w_gu = args.in[10]; const float* w_down = args.in[12]; const float* g_ple = args.in[14]; const float* w_ple_gate = args.in[15]; const float* w_ple_proj = args.in[16];
    {
        constexpr int I_QKV = (DM / 64) * (3 * DM / 32), I_SQ = (DM / 64) * (DM / 32), I_WP = (PLE / 64) * (DM / 32), I_WR = (DM / 64) * (NE / 32);
        constexpr int PER_LAYER = I_QKV + I_SQ + I_WP + I_WR, NIT = DEPTH * PER_LAYER;
        auto decode = [&](int it) -> P0Item {
            const int L = it / PER_LAYER; int r = it - L * PER_LAYER;
            if (r < I_QKV) return P0Item{w_qkv + (size_t)L * DM * 3 * DM, g_mix + L * DM, ws + WS_WQKV + (size_t)L * 3 * DM * DM * 2, DM, 3 * DM, r, 0}; r -= I_QKV;
            if (r < I_SQ) return P0Item{w_o + (size_t)L * DM * DM, nullptr, ws + WS_WO + (size_t)L * DM * DM * 2, DM, DM, r, 0}; r -= I_SQ;
            if (r < I_WP) return P0Item{w_ple_proj + (size_t)L * PLE * DM, nullptr, ws + WS_WP + (size_t)L * DM * PLE * 2, PLE, DM, r, 0}; r -= I_WP;
            return P0Item{w_router + (size_t)L * DM * NE, g_moe + L * DM, ws + WS_WR + (size_t)L * NE * DM * 2, DM, NE, r, 2};
        };
        float va[32]; float ga = 1.f;
        for (int it = gw; it < NIT; it += NGW) { const P0Item d = decode(it); p0_load32(d, lane, va, ga); p0_store32(d, lane, va, ga, scr); }
    }
    if (gw < 256) { bf16_t* WF = (bf16_t*)(ws + WS_WF); const int idx = gw * 64 + lane; const int n = idx >> 10, k = idx & 1023; WF[idx] = (bf16_t)f2bf(w_fgate[(size_t)k * NH + n] * g_mix[DM + k]); }
    {
        const float* x = args.in[0]; bf16_t* HB = (bf16_t*)(ws + WS_HB); float* SS = (float*)(ws + WS_SS);
        for (int row0 = gw * 4; row0 < NTOK; row0 += NGW * 4) {
            f32x4 v[4][4];
#pragma unroll
            for (int q = 0; q < 4; ++q) { const f32x4* p = (const f32x4*)(x + (size_t)(row0 + q) * DM) + lane;
#pragma unroll
                for (int j = 0; j < 4; ++j) v[q][j] = p[64 * j]; }
#pragma unroll
            for (int q = 0; q < 4; ++q) { float s = 0.f;
#pragma unroll
                for (int j = 0; j < 4; ++j) s += v[q][j].x * v[q][j].x + v[q][j].y * v[q][j].y + v[q][j].z * v[q][j].z + v[q][j].w * v[q][j].w;
                s = lwave_sum(s, lane);
                if (lane < 16) SS[(size_t)(row0 + q) * 16 + lane] = (lane == 0) ? s : 0.f;
                u32x2* o = (u32x2*)(HB + (size_t)(row0 + q) * DM) + lane;
#pragma unroll
                for (int j = 0; j < 4; ++j) { u32x2 w; w.x = pkb(v[q][j].x, v[q][j].y); w.y = pkb(v[q][j].z, v[q][j].w); o[64 * j] = w; } }
        }
        const float* pp = args.in[1]; bf16_t* PB = (bf16_t*)(ws + WS_PB);
        const size_t n4 = (size_t)DEPTH * NTOK * PLE / 4;
        for (size_t i = (size_t)gw * 64 + lane; i < n4; i += (size_t)NGW * 64 * 4) {
            f32x4 v[4];
#pragma unroll
            for (int q = 0; q < 4; ++q) { const size_t ii = i + (size_t)q * NGW * 64; if (ii < n4) v[q] = ((const f32x4*)pp)[ii]; }
#pragma unroll
            for (int q = 0; q < 4; ++q) { const size_t ii = i + (size_t)q * NGW * 64; if (ii < n4) { u32x2 w; w.x = pkb(v[q].x, v[q].y); w.y = pkb(v[q].z, v[q].w); ((u32x2*)PB)[ii] = w; } }
        }
    }
}

__device__ __forceinline__ void moe_tables(Frame& F, const unsigned* cnt) {
    LAS int* tstartL = (LAS int*)(F.lds + TBL_OFF); LAS int* cntL = tstartL + 64;
    if (F.wave == 0) {
        const int lane = F.lane; const int c = (lane < NE) ? (int)__hip_atomic_load(cnt + CNT_STRIDE * (lane & 31), __ATOMIC_RELAXED, __HIP_MEMORY_SCOPE_AGENT) : 0; const int nt = (c + 255) >> 8; int incl = nt;
#pragma unroll
        for (int o = 1; o < 32; o <<= 1) { const int t = lpermi(incl, lane - o); if ((lane & 31) >= o) incl += t; }
        if (lane < NE) { tstartL[lane] = incl - nt; cntL[lane] = c; if (lane == NE - 1) tstartL[NE] = incl; }
    }
    __syncthreads();
}
__device__ __forceinline__ void router_phase(Frame& F, const bf16_t* HB, const bf16_t* WR, const float* br, float* rstd, unsigned* cnt, int* tok_of, float* gate_of, unsigned* pair) {
    const int gw = F.vcu * MK_WAVES + F.wave, NGW = F.G * MK_WAVES, lane = F.lane, r = lane & 15, quad = lane >> 4;
    LAS unsigned* hist = (LAS unsigned*)(F.lds); LAS unsigned* gbase = hist + 32;
    LAS unsigned char* wl = F.lds + 1024; constexpr int WLS = 2064;
    for (int i = F.tid; i < NE * 128; i += MK_WAVES * 64) { const int row = i >> 7, ch = i & 127; *(LAS u32x4*)(wl + row * WLS + ch * 16) = *(const u32x4*)(WR + (size_t)row * DM + ch * 8); }
    __syncthreads();
    for (int it = 0; it * NGW < NTOK / 16; ++it) {
        const int blk = it * NGW + gw; const bool valid = blk < NTOK / 16;
        if (F.tid < 32) hist[F.tid] = 0u;
        __syncthreads();
        int see[4]; unsigned slr[4]; float sgt[4];
        const int t0 = blk * 16;
        if (valid) {
            const bf16_t* ap = HB + (size_t)(t0 + r) * DM + quad * 8; const LAS unsigned char* bl0 = wl + r * WLS + quad * 16; const LAS unsigned char* bl1 = bl0 + 16 * WLS;
            f32x4 acc0 = {0.f, 0.f, 0.f, 0.f}, acc1 = {0.f, 0.f, 0.f, 0.f}; float ssq = 0.f;
#pragma unroll 16
            for (int ks = 0; ks < 32; ++ks) { const bf16x8 a = *(const bf16x8*)(ap + 32 * ks), b0 = *(const LAS bf16x8*)(bl0 + 64 * ks), b1 = *(const LAS bf16x8*)(bl1 + 64 * ks);
                acc0 = __builtin_amdgcn_mfma_f32_16x16x32_bf16(a, b0, acc0, 0, 0, 0); acc1 = __builtin_amdgcn_mfma_f32_16x16x32_bf16(a, b1, acc1, 0, 0, 0);
#pragma unroll
                for (int j = 0; j < 8; ++j) { const float f = __uint_as_float(((unsigned)(unsigned short)a[j]) << 16); ssq += f * f; } }
            ssq += lperm(ssq, lane ^ 16); ssq += lperm(ssq, lane ^ 32);
            const float rs_r = rsqrtf(ssq * (1.f / DM) + EPS);
            const float b_lo = br[r], b_hi = br[16 + r];
#pragma unroll
            for (int j = 0; j < 4; ++j) {
                const float rsj = lperm(rs_r, quad * 4 + j); const int t = t0 + quad * 4 + j;
                float v0 = acc0[j] * rsj + b_lo, v1 = acc1[j] * rsj + b_hi; float tv[4]; int ti[4];
#pragma unroll
                for (int k = 0; k < 4; ++k) {
                    float bv = (v0 >= v1) ? v0 : v1; int bi = (v0 >= v1) ? r : 16 + r;
#pragma unroll
                    for (int o = 1; o < 16; o <<= 1) { const float ov = lperm(bv, lane ^ o); const int oi = lpermi(bi, lane ^ o); if (ov > bv || (ov == bv && oi < bi)) { bv = ov; bi = oi; } }
                    tv[k] = bv; ti[k] = bi; if (bi == r) v0 = -INFINITY; if (bi == 16 + r) v1 = -INFINITY;
                }
                float w[4], sw = 0.f;
#pragma unroll
                for (int k = 0; k < 4; ++k) { w[k] = __expf(tv[k] - tv[0]); sw += w[k]; }
                const int ee = (r == 0) ? ti[0] : (r == 1) ? ti[1] : (r == 2) ? ti[2] : ti[3]; const float ww = (r == 0) ? w[0] : (r == 1) ? w[1] : (r == 2) ? w[2] : w[3];
                see[j] = ee; sgt[j] = ww / sw; slr[j] = 0u;
                if (r < 4) slr[j] = __hip_atomic_fetch_add(hist + ee, 1u, __ATOMIC_RELAXED, __HIP_MEMORY_SCOPE_WORKGROUP);
                if (r == 4) rstd[t] = rsj;
            }
        }
        __syncthreads();
        if (F.tid < 32) { const unsigned n = hist[F.tid]; gbase[F.tid] = n ? __hip_atomic_fetch_add(cnt + CNT_STRIDE * F.tid, n, __ATOMIC_RELAXED, __HIP_MEMORY_SCOPE_AGENT) : 0u; }
        __syncthreads();
        if (valid && r < 4) {
#pragma unroll
            for (int j = 0; j < 4; ++j) { const int t = t0 + quad * 4 + j; const int ee = see[j]; const unsigned rk = gbase[ee] + slr[j];
                tok_of[(size_t)ee * CAP + rk] = t; gate_of[(size_t)ee * CAP + rk] = sgt[j]; pair[(size_t)t * 4 + r] = ((unsigned)ee << 16) | rk; }
        }
        __syncthreads();
    }
}
__device__ __forceinline__ void fgate_phase(Frame& F, const bf16_t* HB, const bf16_t* WF, const float* bfg, const float* SS, float* FL) {
    const int gw = F.vcu * MK_WAVES + F.wave, NGW = F.G * MK_WAVES, lane = F.lane, r = lane & 15, quad = lane >> 4;
    for (int blk = gw; blk < NTOK / 16; blk += NGW) {
        const int t0 = blk * 16;
        const bf16_t* ap = HB + (size_t)(t0 + r) * DM + quad * 8; const bf16_t* bp0 = WF + (size_t)r * DM + quad * 8;
        f32x4 acc0 = {0.f, 0.f, 0.f, 0.f};
#pragma unroll 8
        for (int ks = 0; ks < 32; ++ks) { const bf16x8 a = *(const bf16x8*)(ap + 32 * ks), b0 = *(const bf16x8*)(bp0 + 32 * ks); acc0 = __builtin_amdgcn_mfma_f32_16x16x32_bf16(a, b0, acc0, 0, 0, 0); }
        const f32x4 sp = *(const f32x4*)(SS + (size_t)(t0 + r) * 16 + quad * 4); float ss = (sp.x + sp.y) + (sp.z + sp.w); ss += lperm(ss, lane ^ 16); ss += lperm(ss, lane ^ 32);
        const float rs_r = rsqrtf(ss * (1.f / DM) + EPS); const float bb = bfg[r];
#pragma unroll
        for (int j = 0; j < 4; ++j) { const float rsj = lperm(rs_r, quad * 4 + j); FL[(size_t)(t0 + quad * 4 + j) * NH + r] = acc0[j] * rsj + bb; }
    }
}
__device__ __forceinline__ void combine_phase(Frame& F, const bf16_t* hin, bf16_t* hout, unsigned char* hout8, float* rstd, const unsigned* pair, const bf16_t* Y, const bool y8) {
    const int gw = F.vcu * MK_WAVES + F.wave, NGW = F.G * MK_WAVES, lane = F.lane; const LAS int* tstartL = (const LAS int*)(F.lds + TBL_OFF);
    constexpr int CMB_Q = 2;
    for (int t0 = gw; t0 < NTOK; t0 += CMB_Q * NGW) {
        int tt[CMB_Q];
#pragma unroll
        for (int q = 0; q < CMB_Q; ++q) tt[q] = (t0 + q * NGW < NTOK) ? t0 + q * NGW : t0;
        u32x4 pr4[CMB_Q]; u32x2 hw[CMB_Q][4]; u32x2 yw[CMB_Q][4][4];
#pragma unroll
        for (int q = 0; q < CMB_Q; ++q) pr4[q] = *(const u32x4*)(pair + (size_t)tt[q] * 4);
#pragma unroll
        for (int q = 0; q < CMB_Q; ++q) { const u32x2* hr = (const u32x2*)(hin + (size_t)tt[q] * DM) + lane;
#pragma unroll
            for (int j = 0; j < 4; ++j) hw[q][j] = hr[64 * j]; }
#pragma unroll
        for (int q = 0; q < CMB_Q; ++q)
#pragma unroll
            for (int k = 0; k < 4; ++k) { const unsigned pr = (k == 0) ? pr4[q].x : (k == 1) ? pr4[q].y : (k == 2) ? pr4[q].z : pr4[q].w; const int e = __builtin_amdgcn_readfirstlane((int)(pr >> 16)), rk = __builtin_amdgcn_readfirstlane((int)(pr & 0xffffu));
                const size_t slot = (size_t)tstartL[e] * 256 + rk;
                if (y8) { const unsigned* yr = (const unsigned*)((const unsigned char*)Y + slot * DM) + lane;
#pragma unroll
                    for (int j = 0; j < 4; ++j) { yw[q][k][j].x = yr[64 * j]; yw[q][k][j].y = 0u; } }
                else { const u32x2* yr = (const u32x2*)(Y + slot * DM) + lane;
#pragma unroll
                    for (int j = 0; j < 4; ++j) yw[q][k][j] = yr[64 * j]; } }
#pragma unroll
        for (int q = 0; q < CMB_Q; ++q) { const int t = tt[q]; f32x4 v[4];
#pragma unroll
            for (int j = 0; j < 4; ++j) { v[j].x = __uint_as_float(hw[q][j].x << 16); v[j].y = __uint_as_float(hw[q][j].x & 0xffff0000u); v[j].z = __uint_as_float(hw[q][j].y << 16); v[j].w = __uint_as_float(hw[q][j].y & 0xffff0000u);
#pragma unroll
                for (int k = 0; k < 4; ++k) { const u32x2 w = yw[q][k][j];
                    if (y8) { typedef float f32x2_ __attribute__((ext_vector_type(2))); const f32x2_ lo = __builtin_amdgcn_cvt_pk_f32_fp8((int)w.x, false), hi = __builtin_amdgcn_cvt_pk_f32_fp8((int)w.x, true); v[j].x += lo.x; v[j].y += lo.y; v[j].z += hi.x; v[j].w += hi.y; }
                    else { v[j].x += __uint_as_float(w.x << 16); v[j].y += __uint_as_float(w.x & 0xffff0000u); v[j].z += __uint_as_float(w.y << 16); v[j].w += __uint_as_float(w.y & 0xffff0000u); } } }
            float s = 0.f; u32x2* o = (u32x2*)(hout + (size_t)t * DM) + lane;
#pragma unroll
            for (int j = 0; j < 4; ++j) { u32x2 w; w.x = pkb(v[j].x, v[j].y); w.y = pkb(v[j].z, v[j].w); o[64 * j] = w;
                if (hout8) { unsigned p = 0u; p = __builtin_amdgcn_cvt_pk_fp8_f32(v[j].x, v[j].y, p, false); p = __builtin_amdgcn_cvt_pk_fp8_f32(v[j].z, v[j].w, p, true); ((unsigned*)(hout8 + (size_t)t * DM))[lane + 64 * j] = p; }
                const float q0 = __uint_as_float(w.x << 16), q1 = __uint_as_float(w.x & 0xffff0000u), q2 = __uint_as_float(w.y << 16), q3 = __uint_as_float(w.y & 0xffff0000u); s += (q0 * q0 + q1 * q1) + (q2 * q2 + q3 * q3); }
            s = lwave_sum(s, lane); if (lane == 0) rstd[t] = rsqrtf(s * (1.f / DM) + EPS); }
    }
}
__device__ __forceinline__ void final_phase(Frame& F, const bf16_t* hb, const float* SS, const float* g, float* out) {
    const int gw = F.vcu * MK_WAVES + F.wave, NGW = F.G * MK_WAVES, lane = F.lane;
    f32x4 gg[4];
#pragma unroll
    for (int j = 0; j < 4; ++j) gg[j] = ((const f32x4*)g)[lane + 64 * j];
    for (int row0 = gw; row0 < NTOK; row0 += 4 * NGW) {
        u32x2 w[4][4]; float ss[4]; int rr[4];
#pragma unroll
        for (int q = 0; q < 4; ++q) { rr[q] = (row0 + q * NGW < NTOK) ? row0 + q * NGW : row0; const u32x2* p = (const u32x2*)(hb + (size_t)rr[q] * DM) + lane;
#pragma unroll
            for (int j = 0; j < 4; ++j) w[q][j] = p[64 * j];
            ss[q] = (lane < 16) ? SS[(size_t)rr[q] * 16 + lane] : 0.f; }
#pragma unroll
        for (int q = 0; q < 4; ++q) { const float rs = rsqrtf(lwave_sum(ss[q], lane) * (1.f / DM) + EPS); f32x4* o = (f32x4*)(out + (size_t)rr[q] * DM) + lane;
#pragma unroll
            for (int j = 0; j < 4; ++j) { f32x4 v; v.x = __uint_as_float(w[q][j].x << 16); v.y = __uint_as_float(w[q][j].x & 0xffff0000u); v.z = __uint_as_float(w[q][j].y << 16); v.w = __uint_as_float(w[q][j].y & 0xffff0000u); o[64 * j] = v * rs * gg[j]; } }
    }
}
__device__ __forceinline__ void fox_head(Frame& F, unsigned char* lds_generic, int bh, const bf16_t* Q, const bf16_t* K, const bf16_t* V, const float* FL, bf16_t* O) {
    int tid_ = threadIdx.x; asm volatile("" : "+v"(tid_));
    const int lane = tid_ & 63, b = bh / NH, hh = bh % NH; const size_t rowb = (size_t)b * SEQ;
    LAS float* cbL = (LAS float*)(F.lds + attn_body::ATTN_LDS_BYTES); LAS float* wtot = cbL + SEQ;
    {
        float loc[4]; float run = 0.f;
#pragma unroll
        for (int i = 0; i < 4; ++i) { run += log_sigmoid(FL[(size_t)(rowb + tid_ * 4 + i) * NH + hh]); loc[i] = run; }
        float incl = run;
#pragma unroll
        for (int o = 1; o < 64; o <<= 1) { const float t = lperm(incl, lane - o); if (lane >= o) incl += t; }
        if (lane == 63) wtot[F.wave] = incl;
        __syncthreads();
        float base = incl - run;
        for (int w = 0; w < F.wave; ++w) base += wtot[w];
#pragma unroll
        for (int i = 0; i < 4; ++i) cbL[tid_ * 4 + i] = -(base + loc[i]) * LOG2E;
        __syncthreads();
    }
    for (int qb = 0; qb < SEQ / 256; ++qb)
        attn_body::attn_unit<8>(b, hh, qb, (const attn_body::bf16*)Q, (const attn_body::bf16*)K, (const attn_body::bf16*)V, (attn_body::bf16*)O, (char*)lds_generic, cbL);
}
constexpr int N_PHASES = 18;
__global__ void __launch_bounds__(MK_WAVES * 64, 2) mega_fwd(MArgs args) {
    extern __shared__ __attribute__((aligned(16))) unsigned char lds_raw[];
    Frame F;
    F.lds = (LAS unsigned char*)lds_raw;
    F.tid = threadIdx.x; F.lane = F.tid & 63; F.wave = __builtin_amdgcn_readfirstlane(F.tid >> 6);
    F.G = gridDim.x; { const int bx = blockIdx.x; F.vcu = (F.G % 8 == 0) ? (bx % 8) * (F.G / 8) + bx / 8 : bx; }
    F.ws = args.ws; F.ctl = (unsigned*)(args.ws + WS_CTL);
    unsigned char* ws = args.ws;
    for (int u = F.tid; u < (MK_LDS_BYTES - LDSCTL_OFF) / 4; u += MK_WAVES * 64) ((LAS unsigned*)(F.lds + LDSCTL_OFF))[u] = 0u;
    __syncthreads();
    const int lo = args.ph_lo, hi = args.ph_hi;
    const bool use_bar = (hi - lo) > 1;
    XcdBarrier bar; bar.bar = F.ctl + CW_BAR; bar.x = 0; bar.st = nullptr;
    if (use_bar) bar = xcd_barrier_post(F.ctl + CW_BAR, (volatile LAS unsigned*)(F.lds + LDSCTL_OFF + 32));
#ifndef MK_DUP
#define MK_DUP 0
#endif
#define NREP(j) (((MK_DUP >> (j)) & 1) ? 2 : 1)
#ifndef MK_QKVPROBE
#define MK_QKVPROBE 0
#endif
#ifndef MK_NSB
#define MK_NSB 5
#endif
#ifndef MK_Y8_MASK
#define MK_Y8_MASK 3
#endif
#ifndef MK_ATTSUB
#define MK_ATTSUB 3
#endif
#ifndef MK_P0SUB
#define MK_P0SUB 7
#endif
#ifndef MK_PHMASK
#define MK_PHMASK 0x3ff
#endif
#define IN(k) (lo <= (k) && (k) < hi)
#define EN(j) ((MK_PHMASK >> (j)) & 1)
#define PHASE_BEGIN() do { int t_ = threadIdx.x; asm volatile("" : "+v"(t_)); F.tid = t_; F.lane = t_ & 63; } while (0)
#define SEAM(k) do { if (IN(k) && IN((k) + 1)) xcd_barrier(bar); } while (0)
    bf16_t* const HB0 = (bf16_t*)(ws + WS_HB); bf16_t* const HB1 = (bf16_t*)(ws + WS_HB2); float* const SS = (float*)(ws + WS_SS);
    bf16_t* const Qb = (bf16_t*)(ws + WS_Q); bf16_t* const Kb = (bf16_t*)(ws + WS_K); bf16_t* const Vb = (bf16_t*)(ws + WS_V); bf16_t* const Ob = (bf16_t*)(ws + WS_O);
    float* const rstd_moe = (float*)(ws + WS_RSTD) + NTOK; float* const rstd_ple = rstd_moe + NTOK;
    int* const tok_of = (int*)(ws + WS_TOK); float* const gate_of = (float*)(ws + WS_GATE); unsigned* const pair = (unsigned*)(ws + WS_PAIR);
    bf16_t* const ACT = (bf16_t*)(ws + WS_ACT); bf16_t* const Yb = (bf16_t*)(ws + WS_Y); float* const FL = (float*)(ws + WS_FL);
    LAS int* const tstartL = (LAS int*)(F.lds + TBL_OFF); LAS int* const cntL = tstartL + 64; LAS unsigned short* const tokL = (LAS unsigned short*)(F.lds + TOK_OFF); LAS float* const rowL = (LAS float*)(F.lds + ROW_OFF);

    if (EN(8) && IN(0)) { for (int rep_ = 0; rep_ < NREP(8); ++rep_) p0_prologue(F, args); }
    SEAM(0);
    for (int L = 0; L < DEPTH; ++L) {
        const int pb = 1 + 8 * L;
        unsigned* const cnt = F.ctl + CW_CNT2 + 2048 * L;
        const bool f8 = (L == 0) ? bool(MK_FP8_MASK & 1) : bool(MK_FP8_MASK & 2);
        bf16_t* const HBa = (L & 1) ? HB1 : HB0; bf16_t* const HBb = (L & 1) ? HB0 : HB1;
        if (EN(0) && IN(pb + 0)) for (int rep_ = 0; rep_ < NREP(0); ++rep_) { PHASE_BEGIN();
            if (MK_P0SUB & 1) if (L == 1) fgate_phase(F, HBa, (const bf16_t*)(ws + WS_WF), args.in[5], SS, FL);
            if (MK_P0SUB & 2) { pg8::DenseOrder S; S.init(NTOK, 3 * DM, F.G, (int)blockIdx.x); pg8::EpiQKV E{Qb, rowL, 0}; pg8::EpiQKV Ep{Qb, rowL, MK_QKVPROBE};
              _Pragma("clang loop unroll(disable)") for (int i0 = 0; i0 < TOK_UNITS; i0 += 2) { const int i = i0 + (F.wave >> 2); pg8::Unit u; if (S.next(i, u)) { const int lr = F.tid & 255; const f32x4* sp = (const f32x4*)(SS + (size_t)(u.arow0 + lr) * 16);
                  const f32x4 s0 = sp[0], s1 = sp[1], s2 = sp[2], s3 = sp[3]; const float ss = ((s0.x + s0.y) + (s0.z + s0.w)) + ((s1.x + s1.y) + (s1.z + s1.w)) + ((s2.x + s2.y) + (s2.z + s2.w)) + ((s3.x + s3.y) + (s3.z + s3.w));
                  rowL[i * 256 + lr] = rsqrtf(ss * (1.f / DM) + EPS); } }
              __syncthreads();
              if (NREP(13) > 1) pg8::gemm_phase(F.lds, HBa, (const bf16_t*)(ws + WS_WQKV) + (size_t)L * 3 * DM * DM, 2 * DM, S, E, true);
              if (NREP(14) > 1) pg8::gemm_phase(F.lds, HBa, (const bf16_t*)(ws + WS_WQKV) + (size_t)L * 3 * DM * DM, 2 * DM, S, Ep, false);
              if (NREP(15) > 1) { pg8::HotOrder Sh; Sh.d = S; pg8::gemm_phase(F.lds, HBa, (const bf16_t*)(ws + WS_WQKV) + (size_t)L * 3 * DM * DM, 2 * DM, Sh, Ep, false); }
              pg8::gemm_phase(F.lds, HBa, (const bf16_t*)(ws + WS_WQKV) + (size_t)L * 3 * DM * DM, 2 * DM, S, E); }
            if (MK_P0SUB & 4) if (L == 0) { pg8::PJOrder S; S.init(F.G, (int)blockIdx.x); pg8::EpiPJ E{(bf16_t*)(ws + WS_PJ)};
                pg8::gemm_phase(F.lds, (const bf16_t*)(ws + WS_PB), (const bf16_t*)(ws + WS_WP), 2 * PLE, S, E); }
        }
        SEAM(pb + 0);
        if (EN(1) && IN(pb + 1)) for (int rep_ = 0; rep_ < (NREP(1) > 1 ? 2 : (L == 0 ? NREP(10) : NREP(11))); ++rep_) { PHASE_BEGIN();
            if (L == 0) {
                if (F.wave < MK_NSB) { if (MK_ATTSUB & 1) for (int bh = blockIdx.x; bh < NB * NH; bh += F.G) sb_body::sb_head(F.lds, bh, Qb, Kb, Vb, Ob); }
                else p0_big(F, args, F.wave - MK_NSB, MK_WAVES - MK_NSB, (LAS float*)(F.lds + MK_NSB * 16384 + (F.wave - MK_NSB) * 16896));
            }
            else { if (MK_ATTSUB & 2) for (int bh = blockIdx.x; bh < NB * NH; bh += F.G) { fox_head(F, lds_raw, bh, Qb, Kb, Vb, FL, Ob); __syncthreads(); } }
        }
        SEAM(pb + 1);
        if (EN(2) && IN(pb + 2)) for (int rep_ = NREP(2) - 1; rep_ >= 0; --rep_) { PHASE_BEGIN();
            pg8::DenseOrder S; S.init(NTOK, DM, F.G, (int)blockIdx.x); pg8::EpiWo E{HBa, rep_ ? (bf16_t*)(ws + WS_ACT + 128 * MiB) : HBb, f8 ? (rep_ ? ws + WS_ACT + 210 * MiB : ws + WS_HB8) : nullptr};
            pg8::gemm_phase(F.lds, Ob, (const bf16_t*)(ws + WS_WO) + (size_t)L * DM * DM, 2 * DM, S, E);
        }
        SEAM(pb + 2);
        if (EN(3) && IN(pb + 3)) for (int rep_ = NREP(3) - 1; rep_ >= 0; --rep_) { PHASE_BEGIN(); unsigned char* dd = ws + WS_ACT + 192 * MiB;
            if (rep_) router_phase(F, HBb, (const bf16_t*)(ws + WS_WR) + (size_t)L * NE * DM, args.in[9] + L * NE, (float*)(dd + 9 * MiB), F.ctl + CW_CNT2 + 4096 + 2048 * L, (int*)dd, (float*)(dd + 4 * MiB), (unsigned*)(dd + 8 * MiB));
            else router_phase(F, HBb, (const bf16_t*)(ws + WS_WR) + (size_t)L * NE * DM, args.in[9] + L * NE, rstd_moe, cnt, tok_of, gate_of, pair); }
        SEAM(pb + 3);
        if (EN(4) && IN(pb + 4)) for (int rep_ = (NREP(4) > 1 || NREP(12) > 1) ? 1 : 0; rep_ >= 0; --rep_) { PHASE_BEGIN(); const bool skip_ = rep_ && NREP(12) > 1;
            moe_tables(F, cnt);
            pg8::MoeOrder S; S.NN = 8; S.nwg = tstartL[NE] * 8; S.G = F.G; S.c = (int)blockIdx.x; S.lane = F.lane; S.tstartL = tstartL; S.cntL = cntL; S.tokL = tokL; S.gather = true;
            _Pragma("clang loop unroll(disable)") for (int k0 = 0; k0 < TOK_UNITS / 2; k0 += 3) {
                int tokv[3]; float rsv[3]; bool okv[3]; const int lr = F.tid & 255;
#pragma unroll
                for (int k = 0; k < 3; ++k) { pg8::Unit u; okv[k] = S.next(2 * (k0 + k) + (F.wave >> 2), u); const int rk = u.rank0 + lr; tokv[k] = okv[k] ? tok_of[(size_t)u.e * CAP + (rk < u.cnt ? rk : u.rank0)] : 0; }
#pragma unroll
                for (int k = 0; k < 3; ++k) rsv[k] = okv[k] ? rstd_moe[tokv[k]] : 0.f;
#pragma unroll
                for (int k = 0; k < 3; ++k) if (okv[k]) { const int i = 2 * (k0 + k) + (F.wave >> 2); tokL[i * 256 + lr] = (unsigned short)tokv[k]; rowL[i * 256 + lr] = rsv[k] * (f8 ? W8INV : 1.f); }
            }
            __syncthreads();
            if (f8) { pg8::EpiGU<true> E{ws + WS_ACT8, args.in[11] + (size_t)L * NE * 2 * FF, rowL};
                pg8::gemm_phase<pg8::EpiGU<true>, pg8::MoeOrder, true>(F.lds, ws + WS_HB8, ws + WS_WGU8 + (size_t)L * NE * 2 * FF * DM, DM, S, E, skip_); }
            else { pg8::EpiGU<false> E{ACT, args.in[11] + (size_t)L * NE * 2 * FF, rowL};
                pg8::gemm_phase(F.lds, HBb, (const bf16_t*)(ws + WS_WGU) + (size_t)L * NE * 2 * FF * DM, 2 * DM, S, E); }
        }
        SEAM(pb + 4);
        if (EN(5) && IN(pb + 5)) for (int rep_ = 0; rep_ < NREP(5); ++rep_) { PHASE_BEGIN();
            moe_tables(F, cnt);
            pg8::MoeOrder S; S.NN = 4; S.nwg = tstartL[NE] * 4; S.G = F.G; S.c = (int)blockIdx.x; S.lane = F.lane; S.tstartL = tstartL; S.cntL = cntL; S.tokL = tokL; S.gather = false;
            _Pragma("clang loop unroll(disable)") for (int k0 = 0; k0 < 6; k0 += 3) {
                float gv[3]; bool okv[3]; const int lr = F.tid & 255;
#pragma unroll
                for (int k = 0; k < 3; ++k) { pg8::Unit u; okv[k] = S.next(2 * (k0 + k) + (F.wave >> 2), u); const int rk = u.rank0 + lr; gv[k] = (okv[k] && rk < u.cnt) ? gate_of[(size_t)u.e * CAP + rk] : 0.f; }
#pragma unroll
                for (int k = 0; k < 3; ++k) if (okv[k]) rowL[(2 * (k0 + k) + (F.wave >> 2)) * 256 + lr] = gv[k] * (f8 ? W8INV : 1.f);
            }
            __syncthreads();
            const bool y8 = (MK_Y8_MASK >> L) & 1;
            pg8::EpiDown E{Yb, args.in[13] + (size_t)L * NE * DM, rowL, f8 ? W8SCALE : 1.f, y8};
            if (f8) pg8::gemm_phase<pg8::EpiDown, pg8::MoeOrder, true>(F.lds, ws + WS_ACT8, ws + WS_WD8 + (size_t)L * NE * DM * FF, FF, S, E);
            else pg8::gemm_phase(F.lds, ACT, (const bf16_t*)(ws + WS_WD) + (size_t)L * NE * DM * FF, 2 * FF, S, E);
        }
        SEAM(pb + 5);
        if (EN(6) && IN(pb + 6)) for (int rep_ = NREP(6) - 1; rep_ >= 0; --rep_) { PHASE_BEGIN(); moe_tables(F, cnt);
            if (rep_) combine_phase(F, HBb, (bf16_t*)(ws + WS_ACT + 128 * MiB), nullptr, (float*)(ws + WS_ACT + 201 * MiB), pair, Yb, (MK_Y8_MASK >> L) & 1);
            else combine_phase(F, HBb, HBa, MK_PLE8 ? ws + WS_HB8 : nullptr, rstd_ple, pair, Yb, (MK_Y8_MASK >> L) & 1); }
        SEAM(pb + 6);
        if (EN(7) && IN(pb + 7)) for (int rep_ = NREP(7) - 1; rep_ >= 0; --rep_) { PHASE_BEGIN();
            pg8::DenseOrder S; S.init(NTOK, DM, F.G, (int)blockIdx.x);
            pg8::EpiPLE E{HBa, rep_ ? (bf16_t*)(ws + WS_ACT + 128 * MiB) : HBb, (const bf16_t*)(ws + WS_PJ) + (size_t)L * NTOK * DM, rowL, rep_ ? (float*)(ws + WS_ACT + 202 * MiB) : SS};
            _Pragma("clang loop unroll(disable)") for (int i0 = 0; i0 < TOK_UNITS; i0 += 2) { const int i = i0 + (F.wave >> 2); pg8::Unit u; if (S.next(i, u)) { const int lr = F.tid & 255; rowL[i * 256 + lr] = rstd_ple[u.arow0 + lr] * (MK_PLE8 ? W8INV : 1.f); } }
            __syncthreads();
            if (MK_PLE8) pg8::gemm_phase<pg8::EpiPLE, pg8::DenseOrder, true>(F.lds, ws + WS_HB8, ws + WS_WG8 + (size_t)L * DM * DM, DM, S, E);
            else pg8::gemm_phase(F.lds, HBa, (const bf16_t*)(ws + WS_WG) + (size_t)L * DM * DM, 2 * DM, S, E);
        }
        SEAM(pb + 7);
    }
#ifdef MK_XBAR
    if (use_bar) for (int xb_ = 0; xb_ < MK_XBAR; ++xb_) xcd_barrier(bar);
#endif
    if (EN(9) && IN(17)) for (int rep_ = 0; rep_ < NREP(9); ++rep_) { PHASE_BEGIN(); final_phase(F, HB0, SS, args.in[17], args.out); }
#undef IN
#undef SEAM
}
#define MK_MODE 2

#ifndef MK_MODE
#define MK_MODE 2
#endif
extern "C" void kernel_launch(void* const* d_in, const int* in_sizes, int n_in, void* d_out, int out_size, void* d_ws, size_t ws_size, hipStream_t stream) {
    if (n_in != 18 || in_sizes[0] != NTOK * DM || out_size != NTOK * DM || ws_size < WS_END2) { fprintf(stderr, "kernel_launch: unexpected shapes / workspace (%d inputs, ws %zu, need %zu)\n", n_in, ws_size, (size_t)WS_END2); return; }
    unsigned char* ws = (unsigned char*)d_ws;
    (void)hipMemsetAsync(ws + WS_CTL, 0, 1 * MiB, stream);
#if MK_MODE != 0
    static int grid = 0;
    if (grid == 0) {
        int dev = 0, cus = 0, per_cu = 0;
        if (hipGetDevice(&dev) != hipSuccess || hipDeviceGetAttribute(&cus, hipDeviceAttributeMultiprocessorCount, dev) != hipSuccess) { fprintf(stderr, "kernel_launch: device query failed\n"); grid = -1; return; }
        if (hipFuncSetAttribute((const void*)mega_fwd, hipFuncAttributeMaxDynamicSharedMemorySize, MK_LDS_BYTES) != hipSuccess) { fprintf(stderr, "kernel_launch: hipFuncSetAttribute failed\n"); grid = -1; return; }
        if (hipOccupancyMaxActiveBlocksPerMultiprocessor(&per_cu, (const void*)mega_fwd, MK_WAVES * 64, MK_LDS_BYTES) != hipSuccess || per_cu < 1) fprintf(stderr, "kernel_launch: occupancy query reports %d\n", per_cu);
        (void)hipGetLastError();
        grid = cus;
        grid -= grid % 8;
    }
    if (grid <= 0) return;
    MArgs a{};
    for (int i = 0; i < 18; ++i) a.in[i] = (const float*)d_in[i];
    a.out = (float*)d_out; a.ws = ws;
#if MK_MODE == 2
    a.ph_lo = 0; a.ph_hi = N_PHASES;
    hipLaunchKernelGGL(mega_fwd, dim3(grid), dim3(MK_WAVES * 64), MK_LDS_BYTES, stream, a);
#else
    for (int ph = 0; ph < N_PHASES; ++ph) { a.ph_lo = ph; a.ph_hi = ph + 1; hipLaunchKernelGGL(mega_fwd, dim3(grid), dim3(MK_WAVES * 64), MK_LDS_BYTES, stream, a); }
#endif
    { const hipError_t le = hipPeekAtLastError(); if (le != hipSuccess) fprintf(stderr, "kernel_launch: launch failed: %s\n", hipGetErrorName(le)); }
#else
    const float* x = (const float*)d_in[0]; const float* p = (const float*)d_in[1]; const float* g_mix = (const float*)d_in[2]; const float* w_qkv = (const float*)d_in[3];
    const float* w_fgate = (const float*)d_in[4]; const float* b_fgate = (const float*)d_in[5]; const float* w_o = (const float*)d_in[6]; const float* g_moe = (const float*)d_in[7];
    const float* w_router = (const float*)d_in[8]; const float* b_router = (const float*)d_in[9]; const float* w_gu = (const float*)d_in[10]; const float* b_gu = (const float*)d_in[11];
    const float* w_down = (const float*)d_in[12]; const float* b_down = (const float*)d_in[13]; const float* g_ple = (const float*)d_in[14]; const float* w_ple_gate = (const float*)d_in[15];
    const float* w_ple_proj = (const float*)d_in[16]; const float* g_final = (const float*)d_in[17];
    unsigned* ctl = (unsigned*)(ws + WS_CTL);
    bf16_t *Wqkv = (bf16_t*)(ws + WS_WQKV), *Wo = (bf16_t*)(ws + WS_WO), *Wg = (bf16_t*)(ws + WS_WG), *Wp = (bf16_t*)(ws + WS_WP), *Wgu = (bf16_t*)(ws + WS_WGU), *Wd = (bf16_t*)(ws + WS_WD);
    float* H = (float*)(ws + WS_H); bf16_t *HB = (bf16_t*)(ws + WS_HB), *Q = (bf16_t*)(ws + WS_Q), *Kb = (bf16_t*)(ws + WS_K), *Vb = (bf16_t*)(ws + WS_V), *O = (bf16_t*)(ws + WS_O);
    bf16_t *PB = (bf16_t*)(ws + WS_PB), *PJ = (bf16_t*)(ws + WS_PJ), *ACT = (bf16_t*)(ws + WS_ACT), *Y = (bf16_t*)(ws + WS_Y);
    int* tok_of = (int*)(ws + WS_TOK); float* gate_of = (float*)(ws + WS_GATE); unsigned* pair = (unsigned*)(ws + WS_PAIR);
    float* rstd_mix = (float*)(ws + WS_RSTD); float* rstd_moe = rstd_mix + NTOK; float* rstd_ple = rstd_moe + NTOK;
    float* FL = (float*)(ws + WS_FL); float* CB = (float*)(ws + WS_CB);
    for (int i = 0; i < DEPTH; ++i) {
        k_cvt_t<0><<<dim3(3 * DM / 64, DM / 64, 1), 256, 0, stream>>>(w_qkv + (size_t)i * DM * 3 * DM, g_mix + i * DM, Wqkv + (size_t)i * 3 * DM * DM, DM, 3 * DM);
        k_cvt_t<0><<<dim3(DM / 64, DM / 64, 1), 256, 0, stream>>>(w_o + (size_t)i * DM * DM, nullptr, Wo + (size_t)i * DM * DM, DM, DM);
        k_cvt_t<0><<<dim3(DM / 64, DM / 64, 1), 256, 0, stream>>>(w_ple_gate + (size_t)i * DM * DM, g_ple + i * DM, Wg + (size_t)i * DM * DM, DM, DM);
        k_cvt_t<0><<<dim3(DM / 64, PLE / 64, 1), 256, 0, stream>>>(w_ple_proj + (size_t)i * PLE * DM, nullptr, Wp + (size_t)i * DM * PLE, PLE, DM);
        k_cvt_t<1><<<dim3(2 * FF / 64, DM / 64, NE), 256, 0, stream>>>(w_gu + (size_t)i * NE * DM * 2 * FF, g_moe + i * DM, Wgu + (size_t)i * NE * 2 * FF * DM, DM, 2 * FF);
        k_cvt_t<0><<<dim3(DM / 64, FF / 64, NE), 256, 0, stream>>>(w_down + (size_t)i * NE * FF * DM, nullptr, Wd + (size_t)i * NE * DM * FF, FF, DM);
    }
    k_cvt<<<(unsigned)((size_t)DEPTH * NTOK * PLE / 4 / 256), 256, 0, stream>>>(p, PB, (size_t)DEPTH * NTOK * PLE / 4);
    for (int i = 0; i < DEPTH; ++i)
        k_gemm_pj<<<dim3(DM / 64, NTOK / 64), 64, 0, stream>>>(PB + (size_t)i * NTOK * PLE, Wp + (size_t)i * DM * PLE, PJ + (size_t)i * NTOK * DM);
    k_rowstat<<<NTOK / 4, 256, 0, stream>>>(x, HB, rstd_mix);
    for (int i = 0; i < DEPTH; ++i) {
        const float* hin = (i == 0) ? x : H;
        k_gemm_qkv<<<dim3(3 * DM / 64, NTOK / 64), 64, 0, stream>>>(HB, Wqkv + (size_t)i * 3 * DM * DM, rstd_mix, Q);
        if (i == 0) k_attn_sb<<<NB * NH * SEQ / 4, 256, 0, stream>>>(Q, Kb, Vb, O);
        else {
            k_fgate<<<NTOK / 4, 256, 0, stream>>>(hin, g_mix + i * DM, w_fgate, b_fgate, rstd_mix, FL);
            k_scan<<<NB * NH, 64, 0, stream>>>(FL, CB);
            k_attn_fox<<<NB * NH * SEQ / 4, 256, 0, stream>>>(Q, Kb, Vb, CB, O);
        }
        k_gemm_wo<<<dim3(DM / 64, NTOK / 64), 64, 0, stream>>>(O, Wo + (size_t)i * DM * DM, hin, H, HB);
        unsigned* cnt = ctl + CW_CNT + 64 * i;
        k_router<<<NTOK / 4, 256, 0, stream>>>(H, g_moe + i * DM, w_router + (size_t)i * DM * NE, b_router + i * NE, rstd_moe, cnt, tok_of, gate_of, pair);
        k_gemm_gu<<<dim3(FF / 64, MAXT * 4), 64, 0, stream>>>(HB, Wgu + (size_t)i * NE * 2 * FF * DM, b_gu + (size_t)i * NE * 2 * FF, rstd_moe, cnt, tok_of, ACT);
        k_gemm_down<<<dim3(DM / 64, MAXT * 4), 64, 0, stream>>>(ACT, Wd + (size_t)i * NE * DM * FF, b_down + (size_t)i * NE * DM, cnt, gate_of, Y);
        k_combine<<<NTOK / 4, 256, 0, stream>>>(H, HB, rstd_ple, cnt, pair, Y);
        k_gemm_ple<<<dim3(DM / 64, NTOK / 64), 64, 0, stream>>>(HB, Wg + (size_t)i * DM * DM, rstd_ple, PJ + (size_t)i * NTOK * DM, H, HB);
        if (i + 1 < DEPTH) k_rowstat<<<NTOK / 4, 256, 0, stream>>>(H, HB, rstd_mix);
    }
    k_final<<<NTOK / 4, 256, 0, stream>>>(H, g_final, (float*)d_out);
#endif
}
```
